# Optimizing an MI355X kernel written in HIP

```python
import math
import jax, jax.numpy as jnp
from jax import lax
import numpy as np

D_MODEL = 1024
BATCH = 1
SEQ = 16384
DEPTH = 2

GRID_W = 64
ATT_HEADS = 8
ATT_KV_HEADS = 2
ATT_HEAD_DIM = 64
ATT_WIDTH = ATT_HEADS * ATT_HEAD_DIM
ATT_KV_WIDTH = ATT_KV_HEADS * ATT_HEAD_DIM
ROPE_AXIS_DIM = ATT_HEAD_DIM // 2
ROPE_THETA = 10000.0
Q_BLOCK = 128
HG_HEADS = 4
HG_F_DIM = 128
HG_I_DIM = 128
HG_F_WIDTH = HG_HEADS * HG_F_DIM
HG_WIDTH = HG_HEADS * HG_I_DIM
HG_CHUNK = 64
MIN_FORGET = 1e-6
N_BRANCHES = 2
N_EXPERTS = 16
EC_CAPACITY_FACTOR = 2
EXPERT_FF = 2048
NORM_EPS = 1e-6

IN_SPLITS = (ATT_WIDTH, ATT_KV_WIDTH, ATT_KV_WIDTH,
             HG_F_WIDTH, HG_F_WIDTH, HG_F_WIDTH,
             HG_WIDTH, HG_WIDTH,
             N_BRANCHES * D_MODEL)
IN_WIDTH = sum(IN_SPLITS)

kernel_name = "hybrid_gqa_hgrn2_ecmoe_encoder"


def rms_norm(x, w):
    xf = x.astype(jnp.float32)
    y = xf * lax.rsqrt(jnp.mean(xf * xf, axis=-1, keepdims=True) + NORM_EPS)
    return (y * w.astype(jnp.float32)).astype(x.dtype)


def axial_rope_tables(seq_len):
    rows = seq_len // GRID_W
    row_id = jnp.repeat(jnp.arange(rows, dtype=jnp.float32), GRID_W)
    col_id = jnp.tile(jnp.arange(GRID_W, dtype=jnp.float32), rows)
    inv_freq = ROPE_THETA ** (-jnp.arange(0, ROPE_AXIS_DIM, 2, dtype=jnp.float32) / ROPE_AXIS_DIM)
    ang = jnp.stack([row_id[:, None] * inv_freq, col_id[:, None] * inv_freq], axis=1)
    return jnp.cos(ang), jnp.sin(ang)


def apply_axial_rope(x, cos, sin):
    B, S, H, hd = x.shape
    xr = x.reshape(B, S, H, 2, 2, ROPE_AXIS_DIM // 2)
    x1, x2 = xr[..., 0, :], xr[..., 1, :]
    cs, sn = cos[None, :, None], sin[None, :, None]
    out = jnp.stack([x1 * cs - x2 * sn, x2 * cs + x1 * sn], axis=-2)
    return out.reshape(B, S, H, hd)


def blocked_bidirectional_gqa(q, k, v):
    B, S, _, _ = q.shape
    G = ATT_HEADS // ATT_KV_HEADS
    n_blk = S // Q_BLOCK
    qb = q.reshape(B, n_blk, Q_BLOCK, ATT_KV_HEADS, G, ATT_HEAD_DIM).transpose(1, 0, 3, 4, 2, 5)
    kt = k.transpose(0, 2, 1, 3)
    vt = v.transpose(0, 2, 1, 3)
    scale = ATT_HEAD_DIM ** -0.5

    def one_block(qblk):
        s = jnp.einsum('bhgqd,bhkd->bhgqk', qblk, kt) * scale
        p = jax.nn.softmax(s, axis=-1)
        return jnp.einsum('bhgqk,bhkd->bhgqd', p, vt)

    o = lax.map(one_block, qb)
    return o.transpose(1, 0, 4, 2, 3, 5).reshape(B, S, ATT_WIDTH)


def gla_chunk_scan(q, k, v, log_f):
    B, S, H, Dk = q.shape
    Dv = v.shape[-1]
    n = S // HG_CHUNK

    def to_chunks(a):
        return a.reshape(B, n, HG_CHUNK, H, a.shape[-1]).transpose(1, 0, 3, 2, 4)

    qc, kc, vc, gc = to_chunks(q), to_chunks(k), to_chunks(v), to_chunks(log_f)
    lower = jnp.tril(jnp.ones((HG_CHUNK, HG_CHUNK), dtype=bool))[:, :, None]
    lower_f = lower.astype(jnp.float32)

    def step(state, inp):
        qi, ki, vi, gi = inp
        b = jnp.cumsum(gi, axis=-2)
        o_inter = jnp.einsum('bhcd,bhde->bhce', qi * jnp.exp(b), state)
        diff = b[:, :, :, None, :] - b[:, :, None, :, :]
        decay = jnp.exp(jnp.where(lower, diff, 0.0)) * lower_f
        scores = jnp.einsum('bhid,bhjd,bhijd->bhij', qi, ki, decay)
        o_intra = jnp.einsum('bhij,bhje->bhie', scores, vi)
        b_last = b[:, :, -1:, :]
        new_state = (jnp.exp(b_last[:, :, 0, :])[..., None] * state
                     + jnp.einsum('bhcd,bhce->bhde', ki * jnp.exp(b_last - b), vi))
        return new_state, o_inter + o_intra

    init = jnp.zeros((B, H, Dk, Dv), jnp.float32)
    _, o = lax.scan(step, init, (qc, kc, vc, gc))
    return o.transpose(1, 0, 3, 2, 4).reshape(B, S, H, Dv)


def hgrn2_forget(z, lb):
    f = lb + (1.0 - lb) * jax.nn.sigmoid(z)
    log_f = jnp.log(jnp.maximum(f, MIN_FORGET))
    one_minus_f = (1.0 - lb) * jax.nn.sigmoid(-z)
    return log_f, one_minus_f


def token_mixer(h, lb, w_in, q_norm_w, k_norm_w, hg_norm_w, w_branch_att, w_branch_hg, w_out,
                rope_cos, rope_sin):
    B, S, D = h.shape
    f32 = jnp.float32
    split_idx = np.cumsum(IN_SPLITS)[:-1].tolist()
    proj = jnp.einsum('bsd,de->bse', h, w_in)
    aq, ak, av, hq, hz_f, hz_b, hi, hgate, gate_logits = jnp.split(proj, split_idx, axis=-1)

    q = aq.astype(f32).reshape(B, S, ATT_HEADS, ATT_HEAD_DIM)
    k = ak.astype(f32).reshape(B, S, ATT_KV_HEADS, ATT_HEAD_DIM)
    v = av.astype(f32).reshape(B, S, ATT_KV_HEADS, ATT_HEAD_DIM)
    q = apply_axial_rope(rms_norm(q, q_norm_w), rope_cos, rope_sin)
    k = apply_axial_rope(rms_norm(k, k_norm_w), rope_cos, rope_sin)
    o_att = blocked_bidirectional_gqa(q, k, v)

    lb = lb.astype(f32)
    hqh = jax.nn.silu(hq.astype(f32)).reshape(B, S, HG_HEADS, HG_F_DIM)
    hv = hi.astype(f32).reshape(B, S, HG_HEADS, HG_I_DIM)
    logf_f, kf = hgrn2_forget(hz_f.astype(f32), lb[0])
    logf_b, kb = hgrn2_forget(hz_b.astype(f32), lb[1])
    shp = (B, S, HG_HEADS, HG_F_DIM)
    o_fwd = gla_chunk_scan(hqh, kf.reshape(shp), hv, logf_f.reshape(shp))
    flip = lambda a: jnp.flip(a, axis=1)
    o_bwd = flip(gla_chunk_scan(flip(hqh), flip(kb.reshape(shp)), flip(hv), flip(logf_b.reshape(shp))))
    o_h = rms_norm(o_fwd + o_bwd, hg_norm_w) * jax.nn.silu(
        hgate.astype(f32).reshape(B, S, HG_HEADS, HG_I_DIM))
    o_hg = o_h.reshape(B, S, HG_WIDTH)

    ya = jnp.einsum('bsw,wd->bsd', o_att.astype(h.dtype), w_branch_att)
    yh = jnp.einsum('bsw,wd->bsd', o_hg.astype(h.dtype), w_branch_hg)
    g = jax.nn.sigmoid(gate_logits.astype(f32)).reshape(B, S, N_BRANCHES, D)
    merged = (g[:, :, 0] * ya.astype(f32) + g[:, :, 1] * yh.astype(f32)).astype(h.dtype)
    return jnp.einsum('bsd,de->bse', merged, w_out)


def expert_choice_ffn(h, w_router, w_gate, w_up, w_down):
    B, S, D = h.shape
    cap = EC_CAPACITY_FACTOR * S // N_EXPERTS
    logits = jnp.einsum('bsd,de->bse', h.astype(jnp.float32), w_router.astype(jnp.float32))
    affinity = jax.nn.softmax(logits, axis=-1)
    top_w, top_idx = lax.top_k(affinity.transpose(0, 2, 1), cap)
    xe = jax.vmap(lambda hb, ib: hb[ib])(h, top_idx)
    hid = jax.nn.silu(jnp.einsum('becd,edf->becf', xe, w_gate)) * jnp.einsum('becd,edf->becf', xe, w_up)
    ye = jnp.einsum('becf,efd->becd', hid, w_down) * top_w[..., None].astype(h.dtype)
    combine = lambda yb, ib: jnp.zeros((S, D), h.dtype).at[ib.reshape(-1)].add(yb.reshape(-1, D))
    return jax.vmap(combine)(ye, top_idx)


def setup_inputs(seed: int = 0) -> dict:
    key = jax.random.key(seed)
    ks = jax.random.split(key, 20)
    L, D = DEPTH, D_MODEL
    f32 = jnp.float32

    def nrm(k, shape, fan_in, scale=1.0):
        return jax.random.normal(k, shape, f32) * (scale * fan_in ** -0.5)

    def gain(k, shape):
        return 1.0 + 0.02 * jax.random.normal(k, shape, f32)

    return {
        "x": jax.random.normal(ks[0], (BATCH, SEQ, D), f32),
        "c": jax.random.normal(ks[1], (BATCH, D), f32),
        "ada_w": nrm(ks[2], (L, D, 6 * D), D, 0.5),
        "ada_b": 0.02 * jax.random.normal(ks[3], (L, 6 * D), f32),
        "norm_mix_w": gain(ks[4], (L, D)),
        "norm_ffn_w": gain(ks[5], (L, D)),
        "w_in": nrm(ks[6], (L, D, IN_WIDTH), D),
        "q_norm_w": gain(ks[7], (L, ATT_HEAD_DIM)),
        "k_norm_w": gain(ks[8], (L, ATT_HEAD_DIM)),
        "hg_lower_bounds": jax.random.normal(ks[9], (L, 2, HG_F_WIDTH), f32),
        "hg_norm_w": gain(ks[10], (L, HG_I_DIM)),
        "w_branch_att": nrm(ks[11], (L, ATT_WIDTH, D), ATT_WIDTH),
        "w_branch_hg": nrm(ks[12], (L, HG_WIDTH, D), HG_WIDTH),
        "w_out": nrm(ks[13], (L, D, D), D),
        "w_router": nrm(ks[14], (L, D, N_EXPERTS), D),
        "w_exp_gate": nrm(ks[15], (L, N_EXPERTS, D, EXPERT_FF), D),
        "w_exp_up": nrm(ks[16], (L, N_EXPERTS, D, EXPERT_FF), D),
        "w_exp_down": nrm(ks[17], (L, N_EXPERTS, EXPERT_FF, D), EXPERT_FF),
    }


def reference(x, c, ada_w, ada_b, norm_mix_w, norm_ffn_w, w_in, q_norm_w, k_norm_w,
              hg_lower_bounds, hg_norm_w, w_branch_att, w_branch_hg, w_out, w_router,
              w_exp_gate, w_exp_up, w_exp_down):
    rope_cos, rope_sin = axial_rope_tables(x.shape[1])
    lb_soft = jax.nn.softmax(hg_lower_bounds.astype(jnp.float32), axis=0)
    lb_all = jnp.cumsum(lb_soft, axis=0) - lb_soft[0]
    c_act = jax.nn.silu(c)
    for l in range(DEPTH):
        mod = (jnp.einsum('bd,de->be', c_act, ada_w[l]) + ada_b[l])[:, None, :]
        shift1, scale1, gate1, shift2, scale2, gate2 = jnp.split(mod, 6, axis=-1)
        h = rms_norm(x, norm_mix_w[l]) * (1.0 + scale1) + shift1
        x = x + gate1 * token_mixer(h, lb_all[l], w_in[l], q_norm_w[l], k_norm_w[l], hg_norm_w[l],
                                    w_branch_att[l], w_branch_hg[l], w_out[l], rope_cos, rope_sin)
        h = rms_norm(x, norm_ffn_w[l]) * (1.0 + scale2) + shift2
        x = x + gate2 * expert_choice_ffn(h, w_router[l], w_exp_gate[l], w_exp_up[l], w_exp_down[l])
    return x
```

```cpp
#include <hip/hip_runtime.h>
#include <cstdio>
#include <cstdint>

typedef unsigned short bf16_t;
typedef float f32x4 __attribute__((ext_vector_type(4)));
typedef float f32x16 __attribute__((ext_vector_type(16)));
typedef unsigned u32x4 __attribute__((ext_vector_type(4)));
typedef unsigned u32x2 __attribute__((ext_vector_type(2)));

constexpr int S = 16384, D = 1024, NL = 2, INW = 5376;
constexpr int NE = 16, CAP = 2048, FF = 2048;
constexpr float EPS = 1e-6f;
constexpr float C2 = 0.125f * 1.4426950408889634f;
constexpr int C_AQ = 0, C_AK = 512, C_AV = 640, C_HQ = 768, C_ZF = 1280, C_ZB = 1792, C_HI = 2304, C_HGT = 2816, C_GL = 3328;

constexpr size_t MiB = 1u << 20;
constexpr size_t WS_CTL = 0;
constexpr size_t WS_MOD = 1 * MiB;
constexpr size_t WS_LBV = WS_MOD + 64 * 1024;
constexpr size_t WS_IDX = WS_MOD + 128 * 1024;
constexpr size_t WS_TOPW = WS_IDX + 128 * 1024;
constexpr size_t WS_ROPE = WS_MOD + 512 * 1024;
constexpr size_t WS_AFF = 2 * MiB;
constexpr size_t WS_SLOT = 3 * MiB;
constexpr size_t WS_HB = 4 * MiB;
constexpr size_t WS_QR = 36 * MiB;
constexpr size_t WS_KR = 52 * MiB;
constexpr size_t WS_VV = 56 * MiB;
constexpr size_t WS_QN = 60 * MiB;
constexpr size_t WS_KN = 76 * MiB;
constexpr size_t WS_HQ = 80 * MiB;
constexpr size_t WS_LF = 96 * MiB;
constexpr size_t WS_KF = 160 * MiB;
constexpr size_t WS_HV = 192 * MiB;
constexpr size_t WS_HG = 208 * MiB;
constexpr size_t WS_GG = 224 * MiB;
constexpr size_t WS_OATT = 288 * MiB;
constexpr size_t WS_OF = 304 * MiB;
constexpr size_t WS_OHG = 368 * MiB;
constexpr size_t WS_MP = 384 * MiB;
constexpr size_t WS_MG = 448 * MiB;
constexpr size_t WS_XE = 36 * MiB;
constexpr size_t WS_HID = 100 * MiB;
constexpr size_t WS_YE = 228 * MiB;
constexpr size_t WS_X1 = 480 * MiB;
constexpr size_t WS_X2 = 544 * MiB;
constexpr size_t WS_WIN = 608 * MiB;
constexpr size_t WS_WBA = 630 * MiB;
constexpr size_t WS_WBH = 632 * MiB;
constexpr size_t WS_WOUT = 634 * MiB;
constexpr size_t WS_WGU = 638 * MiB;
constexpr size_t WS_WD = 766 * MiB;
constexpr size_t WS_HST = 830 * MiB;
constexpr size_t WS_END = 900 * MiB;
static_assert(WS_END <= 1024 * MiB, "workspace");

__device__ __forceinline__ float bf2f(bf16_t v) { return __uint_as_float((unsigned)v << 16); }
__device__ __forceinline__ bf16_t f2bf(float f) { unsigned u = __float_as_uint(f); return (bf16_t)((u + 0x7fffu + ((u >> 16) & 1u)) >> 16); }
__device__ __forceinline__ unsigned pk2(float lo, float hi) { return (unsigned)f2bf(lo) | ((unsigned)f2bf(hi) << 16); }
__device__ __forceinline__ float bflo(unsigned w) { return __uint_as_float(w << 16); }
__device__ __forceinline__ float bfhi(unsigned w) { return __uint_as_float(w & 0xffff0000u); }
__device__ __forceinline__ float sigmoidf_(float v) { return __builtin_amdgcn_rcpf(1.0f + __expf(-v)); }
__device__ __forceinline__ float siluf_(float v) { return v * __builtin_amdgcn_rcpf(1.0f + __expf(-v)); }
__device__ __forceinline__ float wave_sum(float v) {
#pragma unroll
    for (int o = 1; o < 64; o <<= 1) v += __shfl_xor(v, o);
    return v;
}
__device__ __forceinline__ int crow(int r, int hi) { return (r & 3) + 8 * (r >> 2) + 4 * hi; }
__device__ __forceinline__ int lane_id_opaque() { int l; asm volatile("v_mbcnt_lo_u32_b32 %0, -1, 0\n\tv_mbcnt_hi_u32_b32 %0, -1, %0" : "=v"(l)); return l; }

#define GAS __attribute__((address_space(1)))
#define LAS __attribute__((address_space(3)))

namespace pg8 {
#define PG8_LAS __attribute__((address_space(3)))
typedef unsigned short bf16_t;
typedef short bf16x8 __attribute__((ext_vector_type(8)));
typedef float f32x4 __attribute__((ext_vector_type(4)));
typedef unsigned u32x4 __attribute__((ext_vector_type(4)));
constexpr int BM = 256, BK = 64, HALF = 128, HTB = HALF * BK * 2  , STAGE_BYTES = 8 * HTB, NXCD = 8, WGM = 8;

__host__ __device__ __forceinline__ int lds_byte(int r, int c) { const int st = (r >> 4) * 2 + (c >> 5), rr = r & 15, cc = c & 31, ob = rr * 64 + cc * 2; return st * 1024 + (ob ^ (((ob >> 9) & 1) << 5)); }
__host__ __device__ __forceinline__ void stage_rc(int b, int& R, int& C) { const int st = b / 1024, sb = b % 1024, swz = sb ^ (((sb >> 9) & 1) << 5); R = (st >> 1) * 16 + swz / 64; C = (st & 1) * 32 + (swz % 64) / 2; }
__host__ __device__ __forceinline__ int perm32(int rho) { const int n = rho >> 4, i = rho & 15; return 8 * (i >> 2) + 4 * n + (i & 3); }

struct Unit { int pm, pn, pb; };
struct Gemm { const bf16_t* A; const bf16_t* Bt; int M, N, K; };

struct StaticOrder {
    int nM, nN, nwg, G, c;
    __host__ __device__ void init(int M, int N, int G_, int c_) { nM = M / BM; nN = N / BM; nwg = nM * nN; G = G_; c = c_; }
    __host__ __device__ bool next(int i, Unit& u) const {
        const long L = (long)i * G + c; if (L >= nwg) return false;
        int wgid = (int)L; { const int q = nwg / NXCD, r = nwg % NXCD, xcd = wgid % NXCD, off = wgid / NXCD; wgid = (xcd < r ? xcd * (q + 1) : r * (q + 1) + (xcd - r) * q) + off; }
        const int nig = WGM * nN, gid = wgid / nig, fm = gid * WGM, gsz = (nM - fm) < WGM ? (nM - fm) : WGM;
        u.pm = fm + ((wgid % nig) % gsz); u.pn = (wgid % nig) / gsz; u.pb = u.pn; return true;
    }
    __device__ __forceinline__ void a_ready(const Unit&) const {}
    __device__ __forceinline__ void done(const Unit&) const {}
};

typedef float f32x2_c __attribute__((ext_vector_type(2))); typedef __bf16 bf16x2_c __attribute__((ext_vector_type(2)));
__device__ __forceinline__ unsigned cvt_pk_bf16(float lo, float hi) { f32x2_c v = {lo, hi}; bf16x2_c b = __builtin_convertvector(v, bf16x2_c); return __builtin_bit_cast(unsigned, b); }

typedef unsigned u32x2 __attribute__((ext_vector_type(2)));
__device__ __forceinline__ float e_bflo(unsigned w) { return __uint_as_float(w << 16); }
__device__ __forceinline__ float e_bfhi(unsigned w) { return __uint_as_float(w & 0xffff0000u); }
__device__ __forceinline__ float e_sig(float v) { return __builtin_amdgcn_rcpf(1.0f + __expf(-v)); }
__device__ __forceinline__ u32x4 pack8(const f32x4 a, const f32x4 b) { u32x4 w; w.x = cvt_pk_bf16(a[0], a[1]); w.y = cvt_pk_bf16(a[2], a[3]); w.z = cvt_pk_bf16(b[0], b[1]); w.w = cvt_pk_bf16(b[2], b[3]); return w; }

struct EpiInproj {
    static constexpr bool PERM = true, AFTER_DRAIN = false;
    bf16_t *QR, *KR, *VV, *HQ, *KF, *HV, *HG, *GG; float* LF; const float* lbv;
    __device__ __forceinline__ void operator()(const f32x4 (&acc)[2][2][4][2], const Unit& u, int wr, int wc, int fr, int fq) const {
        const int row0 = u.pm * BM + wr * 64 + fr, cl = wc * 32 + 8 * fq;
#pragma unroll
        for (int bj = 0; bj < 2; ++bj) {
            const int colg = u.pn * BM + bj * HALF;
            int kind; bf16_t* dst; int pitch, c0; int dir = 0;
            if (colg < 512) { kind = 0; dst = QR; pitch = 512; c0 = colg; }
            else if (colg < 640) { kind = 0; dst = KR; pitch = 128; c0 = colg - 512; }
            else if (colg < 768) { kind = 0; dst = VV; pitch = 128; c0 = colg - 640; }
            else if (colg < 1280) { kind = 1; dst = HQ; pitch = 512; c0 = colg - 768; }
            else if (colg < 2304) { kind = 3; dir = colg >= 1792; dst = KF + (size_t)dir * 16384 * 512; pitch = 512; c0 = colg - (dir ? 1792 : 1280); }
            else if (colg < 2816) { kind = 0; dst = HV; pitch = 512; c0 = colg - 2304; }
            else if (colg < 3328) { kind = 1; dst = HG; pitch = 512; c0 = colg - 2816; }
            else { kind = 2; dst = GG; pitch = 2048; c0 = colg - 3328; }
            c0 += cl;
            if (kind == 0) {
#pragma unroll
                for (int ai = 0; ai < 2; ++ai)
#pragma unroll
                    for (int m = 0; m < 4; ++m) *(u32x4*)(dst + (size_t)(row0 + ai * HALF + m * 16) * pitch + c0) = pack8(acc[ai][bj][m][0], acc[ai][bj][m][1]);
            } else if (kind == 1) {
#pragma unroll
                for (int ai = 0; ai < 2; ++ai)
#pragma unroll
                    for (int m = 0; m < 4; ++m) { f32x4 a = acc[ai][bj][m][0], b = acc[ai][bj][m][1];
#pragma unroll
                        for (int i = 0; i < 4; ++i) { a[i] = a[i] * e_sig(a[i]); b[i] = b[i] * e_sig(b[i]); }
                        *(u32x4*)(dst + (size_t)(row0 + ai * HALF + m * 16) * pitch + c0) = pack8(a, b); }
            } else if (kind == 2) {
#pragma unroll
                for (int ai = 0; ai < 2; ++ai)
#pragma unroll
                    for (int m = 0; m < 4; ++m) { f32x4 a = acc[ai][bj][m][0], b = acc[ai][bj][m][1];
#pragma unroll
                        for (int i = 0; i < 4; ++i) { a[i] = e_sig(a[i]); b[i] = e_sig(b[i]); }
                        *(u32x4*)(dst + (size_t)(row0 + ai * HALF + m * 16) * pitch + c0) = pack8(a, b); }
            } else {
                const f32x4 lb0 = *(const f32x4*)(lbv + dir * 512 + c0), lb1 = *(const f32x4*)(lbv + dir * 512 + c0 + 4);
                float* lf = LF + (size_t)dir * 16384 * 512;
#pragma unroll
                for (int ai = 0; ai < 2; ++ai)
#pragma unroll
                    for (int m = 0; m < 4; ++m) { const f32x4 a = acc[ai][bj][m][0], b = acc[ai][bj][m][1]; f32x4 la, lb_, ka, kb;
#pragma unroll
                        for (int i = 0; i < 4; ++i) {
                            const float sa = e_sig(a[i]), sb = e_sig(b[i]);
                            la[i] = __logf(fmaxf(lb0[i] + (1.0f - lb0[i]) * sa, 1e-6f)); ka[i] = (1.0f - lb0[i]) * (1.0f - sa);
                            lb_[i] = __logf(fmaxf(lb1[i] + (1.0f - lb1[i]) * sb, 1e-6f)); kb[i] = (1.0f - lb1[i]) * (1.0f - sb); }
                        const size_t o = (size_t)(row0 + ai * HALF + m * 16) * 512 + c0;
                        *(f32x4*)(lf + o) = la; *(f32x4*)(lf + o + 4) = lb_;
                        *(u32x4*)(dst + o) = pack8(ka, kb); }
            }
        }
    }
};
struct EpiBrA {
    static constexpr bool PERM = true, AFTER_DRAIN = false;
    const bf16_t* GG; float* MP;
    __device__ __forceinline__ void operator()(const f32x4 (&acc)[2][2][4][2], const Unit& u, int wr, int wc, int fr, int fq) const {
        const int row0 = u.pm * BM + wr * 64 + fr, col0 = u.pn * BM + wc * 32 + 8 * fq;
#pragma unroll
        for (int ai = 0; ai < 2; ++ai)
#pragma unroll
            for (int m = 0; m < 4; ++m) { const size_t r = (size_t)(row0 + ai * HALF + m * 16);
#pragma unroll
                for (int bj = 0; bj < 2; ++bj) { const int c = col0 + bj * HALF; const u32x4 g = *(const u32x4*)(GG + r * 2048 + c);
                    f32x4 a = acc[ai][bj][m][0], b = acc[ai][bj][m][1];
                    a[0] *= e_bflo(g.x); a[1] *= e_bfhi(g.x); a[2] *= e_bflo(g.y); a[3] *= e_bfhi(g.y); b[0] *= e_bflo(g.z); b[1] *= e_bfhi(g.z); b[2] *= e_bflo(g.w); b[3] *= e_bfhi(g.w);
                    *(f32x4*)(MP + r * 1024 + c) = a; *(f32x4*)(MP + r * 1024 + c + 4) = b; } }
    }
};
struct EpiBrH {
    static constexpr bool PERM = true, AFTER_DRAIN = false;
    const bf16_t* GG; const float* MP; bf16_t* MG;
    __device__ __forceinline__ void operator()(const f32x4 (&acc)[2][2][4][2], const Unit& u, int wr, int wc, int fr, int fq) const {
        const int row0 = u.pm * BM + wr * 64 + fr, col0 = u.pn * BM + wc * 32 + 8 * fq;
#pragma unroll
        for (int ai = 0; ai < 2; ++ai)
#pragma unroll
            for (int m = 0; m < 4; ++m) { const size_t r = (size_t)(row0 + ai * HALF + m * 16);
#pragma unroll
                for (int bj = 0; bj < 2; ++bj) { const int c = col0 + bj * HALF; const u32x4 g = *(const u32x4*)(GG + r * 2048 + 1024 + c);
                    f32x4 a = acc[ai][bj][m][0], b = acc[ai][bj][m][1]; const f32x4 pa = *(const f32x4*)(MP + r * 1024 + c), pb = *(const f32x4*)(MP + r * 1024 + c + 4);
                    a[0] = pa[0] + a[0] * e_bflo(g.x); a[1] = pa[1] + a[1] * e_bfhi(g.x); a[2] = pa[2] + a[2] * e_bflo(g.y); a[3] = pa[3] + a[3] * e_bfhi(g.y);
                    b[0] = pb[0] + b[0] * e_bflo(g.z); b[1] = pb[1] + b[1] * e_bfhi(g.z); b[2] = pb[2] + b[2] * e_bflo(g.w); b[3] = pb[3] + b[3] * e_bfhi(g.w);
                    *(u32x4*)(MG + r * 1024 + c) = pack8(a, b); } }
    }
};
struct EpiOut {
    static constexpr bool PERM = true, AFTER_DRAIN = false;
    const float* xin; const float* gate; float* X1;
    __device__ __forceinline__ void operator()(const f32x4 (&acc)[2][2][4][2], const Unit& u, int wr, int wc, int fr, int fq) const {
        const int row0 = u.pm * BM + wr * 64 + fr, col0 = u.pn * BM + wc * 32 + 8 * fq;
#pragma unroll
        for (int bj = 0; bj < 2; ++bj) { const int c = col0 + bj * HALF; const f32x4 g0 = *(const f32x4*)(gate + c), g1 = *(const f32x4*)(gate + c + 4);
#pragma unroll
            for (int ai = 0; ai < 2; ++ai)
#pragma unroll
                for (int m = 0; m < 4; ++m) { const size_t o = (size_t)(row0 + ai * HALF + m * 16) * 1024 + c;
                    *(f32x4*)(X1 + o) = *(const f32x4*)(xin + o) + g0 * acc[ai][bj][m][0]; *(f32x4*)(X1 + o + 4) = *(const f32x4*)(xin + o + 4) + g1 * acc[ai][bj][m][1]; } }
    }
};
struct EpiGU {
    static constexpr bool PERM = true, AFTER_DRAIN = false;
    bf16_t* HID;
    __device__ __forceinline__ void operator()(const f32x4 (&acc)[2][2][4][2], const Unit& u, int wr, int wc, int fr, int fq) const {
        const int row0 = u.pm * BM + wr * 64 + fr, col0 = u.pn * HALF + wc * 32 + 8 * fq;
#pragma unroll
        for (int ai = 0; ai < 2; ++ai)
#pragma unroll
            for (int m = 0; m < 4; ++m) { f32x4 a = acc[ai][0][m][0], b = acc[ai][0][m][1]; const f32x4 ua = acc[ai][1][m][0], ub = acc[ai][1][m][1];
#pragma unroll
                for (int i = 0; i < 4; ++i) { a[i] = a[i] * e_sig(a[i]) * ua[i]; b[i] = b[i] * e_sig(b[i]) * ub[i]; }
                *(u32x4*)(HID + (size_t)(row0 + ai * HALF + m * 16) * 2048 + col0) = pack8(a, b); }
    }
};
struct EpiDown {
    static constexpr bool PERM = true, AFTER_DRAIN = false;
    bf16_t* YE; const float* topw;
    __device__ __forceinline__ void operator()(const f32x4 (&acc)[2][2][4][2], const Unit& u, int wr, int wc, int fr, int fq) const {
        const int row0 = u.pm * BM + wr * 64 + fr, col0 = u.pn * BM + wc * 32 + 8 * fq;
#pragma unroll
        for (int ai = 0; ai < 2; ++ai)
#pragma unroll
            for (int m = 0; m < 4; ++m) { const int r = row0 + ai * HALF + m * 16; const float w = topw[r];
#pragma unroll
                for (int bj = 0; bj < 2; ++bj) *(u32x4*)(YE + (size_t)r * 1024 + col0 + bj * HALF) = pack8(acc[ai][bj][m][0] * w, acc[ai][bj][m][1] * w); }
    }
};
struct GroupOrder {
    int nNe, nwg, G, c;
    __device__ void init(int nNe_, int G_, int c_) { nNe = nNe_; nwg = 16 * 8 * nNe_; G = G_; c = c_; }
    __device__ bool next(int i, Unit& u) const {
        const long L = (long)i * G + c; if (L >= nwg) return false;
        int wgid = (int)L; { const int q = nwg / NXCD, xcd = wgid % NXCD, off = wgid / NXCD; wgid = xcd * q + off; }
        const int per = 8 * nNe, e = wgid / per, w = wgid % per;
        u.pm = e * 8 + (w & 7); u.pn = w >> 3; u.pb = e * nNe + u.pn; return true;
    }
    __device__ __forceinline__ void a_ready(const Unit&) const {}
    __device__ __forceinline__ void done(const Unit&) const {}
};

template <class Epi, class Sched, bool ALIGN_EPI = false, bool SP2 = false>
__device__ __forceinline__ void gemm_phase(PG8_LAS unsigned char* lds, const Gemm g, const Sched& S, const Epi& E, int wave_) {
    const int tid_ = wave_ * 64 + lane_id_opaque();
    const int tid = tid_, wid = __builtin_amdgcn_readfirstlane(tid >> 6), lane = tid & 63, wr = wid >> 2, wc = wid & 3, fr = lane & 15, fq = lane >> 4;
    int K_ = g.K; asm volatile("" : "+s"(K_));
    const int K = K_, nt = K / BK;
    unsigned voffA[2], voffB[2];
#pragma unroll
    for (int i = 0; i < 2; ++i) { int R, C; stage_rc(tid * 16 + i * 8192, R, C); const int Rb = Epi::PERM ? ((R & ~31) + perm32(R & 31)) : R;
        voffA[i] = (unsigned)(R * K + C) * 2u; voffB[i] = (unsigned)(Rb * K + C) * 2u; }
    const size_t kstep = (size_t)(BK * 2);
    const size_t hstep = (size_t)HALF * K * 2;
    const size_t tstep = 2 * hstep;
    const unsigned ldsw = (unsigned)wid * 1024u;
    const int aoff = lds_byte(wr * 64 + fr, fq * 8), boff = lds_byte(wc * 32 + fr, fq * 8);
#define PG8_SA(b, h) (((b) * 2 + (h)) * HTB)
#define PG8_SB(b, h) ((4 + (b) * 2 + (h)) * HTB)
#define PG8_STAGE(bufoff, gbase, voff) do { _Pragma("unroll") for (int _i = 0; _i < 2; ++_i) \
        __builtin_amdgcn_global_load_lds((const unsigned*)((const char*)(gbase) + (voff)[_i]), (PG8_LAS unsigned*)(lds + (bufoff) + ldsw + _i * 8192), 16, 0, 0); } while (0)
#define PG8_LDA(dst, b, h) do { _Pragma("unroll") for (int m = 0; m < 4; ++m) _Pragma("unroll") for (int k = 0; k < 2; ++k) dst[m][k] = *(const PG8_LAS bf16x8*)(lds + PG8_SA(b, h) + aoff + m * 2048 + k * 1024); } while (0)
#define PG8_LDB(dst, b, h) do { _Pragma("unroll") for (int n = 0; n < 2; ++n) _Pragma("unroll") for (int k = 0; k < 2; ++k) dst[n][k] = *(const PG8_LAS bf16x8*)(lds + PG8_SB(b, h) + boff + n * 2048 + k * 1024); } while (0)
#define PG8_MMA(ai, bj, At, Bt) do { __builtin_amdgcn_s_setprio(1); _Pragma("unroll") for (int m = 0; m < 4; ++m) _Pragma("unroll") for (int n = 0; n < 2; ++n) _Pragma("unroll") for (int k = 0; k < 2; ++k) \
        acc[ai][bj][m][n] = __builtin_amdgcn_mfma_f32_16x16x32_bf16(Bt[n][k], At[m][k], acc[ai][bj][m][n], 0, 0, 0); __builtin_amdgcn_s_setprio(0); } while (0)
#define PG8_WAIT_V(n) asm volatile("s_waitcnt vmcnt(" #n ")" ::: "memory")
#define PG8_WAIT_L(n) asm volatile("s_waitcnt lgkmcnt(" #n ")" ::: "memory")
#define PG8_BAR __builtin_amdgcn_s_barrier()
#define PG8_SCHED __builtin_amdgcn_sched_barrier(0)
    Unit cur, nxt; int ui = 0;
    if (!S.next(0, cur)) return;
    f32x4 acc[2][2][4][2];
#pragma unroll
    for (int a = 0; a < 2; ++a)
#pragma unroll
        for (int b = 0; b < 2; ++b)
#pragma unroll
            for (int m = 0; m < 4; ++m)
#pragma unroll
                for (int n = 0; n < 2; ++n) acc[a][b][m][n] = (f32x4){0.f, 0.f, 0.f, 0.f};
    bf16x8 At[4][2], B0[2][2], B1[2][2];
    const char* cA = (const char*)g.A + (size_t)cur.pm * tstep; const char* cB = (const char*)g.Bt + (size_t)cur.pb * tstep;
    S.a_ready(cur);
    if constexpr (SP2) {
        PG8_STAGE(PG8_SB(0, 0), cB, voffB); PG8_STAGE(PG8_SB(0, 1), cB + hstep, voffB); PG8_STAGE(PG8_SA(0, 0), cA, voffA); PG8_STAGE(PG8_SA(0, 1), cA + hstep, voffA);
        if (wr == 1) PG8_BAR;
        PG8_WAIT_V(2); PG8_BAR;
        PG8_STAGE(PG8_SB(1, 0), cB + kstep, voffB); PG8_STAGE(PG8_SA(1, 0), cA + kstep, voffA); PG8_STAGE(PG8_SB(1, 1), cB + hstep + kstep, voffB);
        PG8_WAIT_V(6); PG8_BAR;
    } else {
        PG8_STAGE(PG8_SB(0, 0), cB, voffB); PG8_STAGE(PG8_SA(0, 0), cA, voffA); PG8_STAGE(PG8_SB(0, 1), cB + hstep, voffB); PG8_STAGE(PG8_SA(0, 1), cA + hstep, voffA);
        if (wr == 1) PG8_BAR;
        PG8_WAIT_V(4); PG8_BAR;
        PG8_STAGE(PG8_SB(1, 0), cB + kstep, voffB); PG8_STAGE(PG8_SA(1, 0), cA + kstep, voffA); PG8_STAGE(PG8_SB(1, 1), cB + hstep + kstep, voffB);
        PG8_WAIT_V(6); PG8_BAR;
    }
    for (;;) {
        const bool has_next = S.next(ui + 1, nxt);
        const char* nA = has_next ? (const char*)g.A + (size_t)nxt.pm * tstep : cA; const char* nB = has_next ? (const char*)g.Bt + (size_t)nxt.pb * tstep : cB;
#pragma unroll 1
        for (int t = 0; t < nt; t += 2) {
            const bool last = (t == nt - 2);
            const char* a1 = cA + (size_t)(t + 1) * kstep;
            const char* a2 = last ? nA : cA + (size_t)(t + 2) * kstep; const char* b2 = last ? nB : cB + (size_t)(t + 2) * kstep;
            const char* a3 = a2 + kstep; const char* b3 = b2 + kstep;
            if (last && has_next) S.a_ready(nxt);
            if constexpr (SP2) {
            PG8_LDB(B0, 0, 0); PG8_LDB(B1, 0, 1); PG8_SCHED; PG8_LDA(At, 0, 0); PG8_STAGE(PG8_SA(1, 1), a1 + hstep, voffA);
            PG8_WAIT_V(8); PG8_WAIT_L(0); PG8_BAR; PG8_MMA(0, 0, At, B0); PG8_MMA(0, 1, At, B1); PG8_BAR; PG8_SCHED;
            PG8_LDA(At, 0, 1); PG8_STAGE(PG8_SB(0, 0), b2, voffB); PG8_STAGE(PG8_SB(0, 1), b2 + hstep, voffB); PG8_STAGE(PG8_SA(0, 0), a2, voffA);
            PG8_WAIT_V(8); PG8_WAIT_L(0); PG8_BAR; PG8_MMA(1, 0, At, B0); PG8_MMA(1, 1, At, B1); PG8_BAR; PG8_SCHED;
            PG8_LDB(B0, 1, 0); PG8_LDB(B1, 1, 1); PG8_SCHED; PG8_LDA(At, 1, 0); PG8_STAGE(PG8_SA(0, 1), a2 + hstep, voffA);
            PG8_WAIT_V(8); PG8_WAIT_L(0); PG8_BAR; PG8_MMA(0, 0, At, B0); PG8_MMA(0, 1, At, B1); PG8_BAR; PG8_SCHED;
            PG8_LDA(At, 1, 1); PG8_STAGE(PG8_SB(1, 0), b3, voffB); PG8_STAGE(PG8_SB(1, 1), b3 + hstep, voffB); PG8_STAGE(PG8_SA(1, 0), a3, voffA);
            PG8_WAIT_V(8); PG8_WAIT_L(0); PG8_BAR; PG8_MMA(1, 0, At, B0); PG8_MMA(1, 1, At, B1); PG8_BAR; PG8_SCHED;
            } else {
            PG8_LDB(B0, 0, 0); PG8_SCHED; PG8_LDA(At, 0, 0); PG8_STAGE(PG8_SA(1, 1), a1 + hstep, voffA);
            PG8_WAIT_L(8); PG8_BAR; PG8_WAIT_L(0); PG8_MMA(0, 0, At, B0); PG8_BAR; PG8_SCHED;
            PG8_LDB(B1, 0, 1); PG8_STAGE(PG8_SB(0, 0), b2, voffB);
            PG8_BAR; PG8_WAIT_L(0); PG8_MMA(0, 1, At, B1); PG8_BAR;
            PG8_LDA(At, 0, 1); PG8_STAGE(PG8_SA(0, 0), a2, voffA);
            PG8_BAR; PG8_WAIT_L(0); PG8_MMA(1, 0, At, B0); PG8_BAR; PG8_SCHED;
            PG8_STAGE(PG8_SB(0, 1), b2 + hstep, voffB);
            PG8_WAIT_V(6); PG8_BAR; PG8_MMA(1, 1, At, B1); PG8_BAR;
            PG8_LDB(B0, 1, 0); PG8_SCHED; PG8_LDA(At, 1, 0); PG8_STAGE(PG8_SA(0, 1), a2 + hstep, voffA);
            PG8_WAIT_L(8); PG8_BAR; PG8_WAIT_L(0); PG8_MMA(0, 0, At, B0); PG8_BAR; PG8_SCHED;
            PG8_LDB(B1, 1, 1); PG8_STAGE(PG8_SB(1, 0), b3, voffB);
            PG8_BAR; PG8_WAIT_L(0); PG8_MMA(0, 1, At, B1); PG8_BAR;
            PG8_LDA(At, 1, 1); PG8_STAGE(PG8_SA(1, 0), a3, voffA);
            PG8_BAR; PG8_WAIT_L(0); PG8_MMA(1, 0, At, B0); PG8_BAR; PG8_SCHED;
            PG8_STAGE(PG8_SB(1, 1), b3 + hstep, voffB);
            PG8_WAIT_V(6); PG8_BAR; PG8_MMA(1, 1, At, B1); PG8_BAR;
            }
        }
        if constexpr (ALIGN_EPI) { if (wr == 0) PG8_BAR; }
        if constexpr (!Epi::AFTER_DRAIN) { E(acc, cur, wr, wc, fr, fq); S.done(cur); }
        if (!has_next) break;
#pragma unroll
        for (int a = 0; a < 2; ++a)
#pragma unroll
            for (int b = 0; b < 2; ++b)
#pragma unroll
                for (int m = 0; m < 4; ++m)
#pragma unroll
                    for (int n = 0; n < 2; ++n) acc[a][b][m][n] = (f32x4){0.f, 0.f, 0.f, 0.f};
        cur = nxt; cA = nA; cB = nB; ++ui;
        if constexpr (ALIGN_EPI) { if (wr == 1) PG8_BAR; }
    }
    PG8_WAIT_V(0);
    if constexpr (!ALIGN_EPI) { if (wr == 0) PG8_BAR; }
    PG8_BAR;
    if constexpr (Epi::AFTER_DRAIN) { E.fused(acc, cur, wr, wc, fr, fq, lds, wid, lane); S.done(cur); }
#undef PG8_SA
#undef PG8_SB
#undef PG8_STAGE
#undef PG8_LDA
#undef PG8_LDB
#undef PG8_MMA
#undef PG8_WAIT_V
#undef PG8_WAIT_L
#undef PG8_BAR
#undef PG8_SCHED
}
}

#include <hip/hip_bf16.h>
#include <cmath>

namespace attn_body {
using bf16=__hip_bfloat16;
using bf16x8=__attribute__((ext_vector_type(8)))short;
using s16x4=__attribute__((ext_vector_type(4)))short;
using f32x16=__attribute__((ext_vector_type(16)))float;
using u32x4=__attribute__((ext_vector_type(4)))unsigned;
constexpr int NHEAD=8,SEQ=16384,D=64,DMQ=NHEAD*D,DMK=2*D;
constexpr int NW=8,QBLK=32,QB=QBLK*NW,KVBLK=64,NQB=SEQ/QB;
constexpr int ATTN_UNIT_ROWS=QB;
__device__ __forceinline__ int crow(int r,int hi){return (r&3)+8*(r>>2)+4*hi;}
#define SBAR() __builtin_amdgcn_sched_barrier(0)
__device__ __forceinline__ void cmask(f32x16&p0,f32x16&p1,int jb,int qrel,int hi){
  const float NEG=-INFINITY; int kb=64*jb+4*hi;
  #pragma unroll
  for(int r=0;r<16;++r){int kv=kb+(r&3)+8*(r>>2); if(kv>qrel)p0[r]=NEG; if(kv+32>qrel)p1[r]=NEG;}
}

constexpr int NSLOT=3, SLOTB=8192;
constexpr int LDS_K=0, LDS_V=NSLOT*SLOTB, LDS_WS=2*NSLOT*SLOTB, LDS_OST=LDS_WS+NW*64*4, LDS_BYTES=LDS_OST+NW*4096;
constexpr float C2=0.125f*1.4426950408889634f;
__device__ __forceinline__ void glds16(const void*gsrc,unsigned lds_dst){unsigned keep;
  asm volatile("s_mov_b32 %0, m0\n\ts_mov_b32 m0, %2\n\ts_nop 0\n\tglobal_load_lds_dwordx4 %1, off\n\ts_mov_b32 m0, %0":"=&s"(keep):"v"(gsrc),"s"(lds_dst):"memory");}
__device__ __forceinline__ float max3f(float a,float b,float c){float r;asm("v_max3_f32 %0, %1, %2, %3":"=v"(r):"v"(a),"v"(b),"v"(c));return r;}
__device__ __forceinline__ float max2f(float a,float b){float r;asm("v_max_f32_e32 %0, %1, %2":"=v"(r):"v"(a),"v"(b));return r;}
__device__ __forceinline__ float fadd_s(float a,float b){float r;asm("v_add_f32_e32 %0, %1, %2":"=v"(r):"v"(a),"v"(b));return r;}
__device__ __forceinline__ float fsub_s(float a,float b){float r;asm("v_sub_f32_e32 %0, %1, %2":"=v"(r):"v"(a),"v"(b));return r;}
typedef float f32x2_t __attribute__((ext_vector_type(2))); typedef __bf16 bf16x2_t __attribute__((ext_vector_type(2)));
__device__ __forceinline__ unsigned cvtpk_s(float lo,float hi){f32x2_t v={lo,hi};bf16x2_t b=__builtin_convertvector(v,bf16x2_t);return __builtin_bit_cast(unsigned,b);}
#define WAIT_BAR(N) asm volatile("s_waitcnt vmcnt(" #N ") lgkmcnt(0)\n\ts_barrier":::"memory")

__device__ __forceinline__ void qkt(f32x16&p0,f32x16&p1,const char*Kslot,const bf16x8*qr,const f32x16&negm,int r32,int hi){
  const char*kb=Kslot+hi*1024+r32*16;
  #pragma unroll
  for(int d0=0;d0<4;++d0){
    const bf16x8 b0=*reinterpret_cast<const bf16x8*>(kb+d0*2048);
    const bf16x8 b1=*reinterpret_cast<const bf16x8*>(kb+d0*2048+512);
    if(d0==0){p0=__builtin_amdgcn_mfma_f32_32x32x16_bf16(b0,qr[0],negm,0,0,0);p1=__builtin_amdgcn_mfma_f32_32x32x16_bf16(b1,qr[0],negm,0,0,0);}
    else{p0=__builtin_amdgcn_mfma_f32_32x32x16_bf16(b0,qr[d0],p0,0,0,0);p1=__builtin_amdgcn_mfma_f32_32x32x16_bf16(b1,qr[d0],p1,0,0,0);}}
}
typedef __attribute__((address_space(3))) const char* lds_cptr;
typedef short v4i16_t __attribute__((ext_vector_type(4)));
__device__ __forceinline__ void kload8(bf16x8*kf,lds_cptr kp){
  kf[0]=*(const __attribute__((address_space(3))) bf16x8*)(kp);      kf[1]=*(const __attribute__((address_space(3))) bf16x8*)(kp+512);
  kf[2]=*(const __attribute__((address_space(3))) bf16x8*)(kp+2048); kf[3]=*(const __attribute__((address_space(3))) bf16x8*)(kp+2560);
  kf[4]=*(const __attribute__((address_space(3))) bf16x8*)(kp+4096); kf[5]=*(const __attribute__((address_space(3))) bf16x8*)(kp+4608);
  kf[6]=*(const __attribute__((address_space(3))) bf16x8*)(kp+6144); kf[7]=*(const __attribute__((address_space(3))) bf16x8*)(kp+6656);
}
__device__ __forceinline__ void kload2(bf16x8*kf,lds_cptr kp,int j){ kf[2*j]=*(const __attribute__((address_space(3))) bf16x8*)(kp+j*2048); kf[2*j+1]=*(const __attribute__((address_space(3))) bf16x8*)(kp+j*2048+512); }
__device__ __forceinline__ s16x4 vtr(lds_cptr p){ return __builtin_bit_cast(s16x4,__builtin_amdgcn_ds_read_tr16_b64_v4i16((__attribute__((address_space(3))) v4i16_t*)p)); }
__device__ __forceinline__ float rowmax(const f32x16&p0,const f32x16&p1){
  float a=max3f(p0[0],p0[1],p1[0]),b=max3f(p0[2],p0[3],p1[1]);a=max3f(a,p1[2],p1[3]);
  #pragma unroll
  for(int r=4;r<16;r+=4){a=max3f(a,p0[r],p0[r+1]);b=max3f(b,p0[r+2],p0[r+3]);a=max3f(a,p1[r],p1[r+1]);b=max3f(b,p1[r+2],p1[r+3]);}
  const float m=max2f(a,b);
  auto rr=__builtin_amdgcn_permlane32_swap(__float_as_uint(m),__float_as_uint(m),false,false);
  return max2f(__uint_as_float(rr[0]),__uint_as_float(rr[1]));
}
__device__ __forceinline__ void pv(f32x16*o,int vb,bf16x8 pa0,bf16x8 pa1,bf16x8 pa2,bf16x8 pa3){
  #pragma unroll
  for(int d0=0;d0<2;++d0){s16x4 lo[4],hi[4];
    #pragma unroll
    for(int ks=0;ks<4;++ks){
      asm volatile("ds_read_b64_tr_b16 %0,%1 offset:%c2":"=&v"(lo[ks]):"v"(vb),"i"(d0*4096+ks*1024):"memory");
      asm volatile("ds_read_b64_tr_b16 %0,%1 offset:%c2":"=&v"(hi[ks]):"v"(vb),"i"(d0*4096+ks*1024+512):"memory");}
    asm volatile("s_waitcnt lgkmcnt(0)":::"memory");SBAR();
    #define PK(k) (bf16x8){lo[k][0],lo[k][1],lo[k][2],lo[k][3],hi[k][0],hi[k][1],hi[k][2],hi[k][3]}
    o[d0]=__builtin_amdgcn_mfma_f32_32x32x16_bf16(pa0,PK(0),o[d0],0,0,0);
    o[d0]=__builtin_amdgcn_mfma_f32_32x32x16_bf16(pa1,PK(1),o[d0],0,0,0);
    o[d0]=__builtin_amdgcn_mfma_f32_32x32x16_bf16(pa2,PK(2),o[d0],0,0,0);
    o[d0]=__builtin_amdgcn_mfma_f32_32x32x16_bf16(pa3,PK(3),o[d0],0,0,0);
    #undef PK
  }
}

#ifndef ATTN_STORE16
#define ATTN_STORE16(p,v) (*(u32x4*)(p)=(v))
#endif
template<int THRL> __device__ __forceinline__ void attn_unit(int b,int h,int qb,const bf16*Q,const bf16*__restrict__ K,const bf16*__restrict__ V,bf16*O,char*shm,int wave_){
  const int tid_=wave_*64+lane_id_opaque();
  const int tid=tid_,lane=tid&63,r32=lane&31,hi=lane>>5; const int wid=__builtin_amdgcn_readfirstlane(tid>>6);
  const long rowbase=0; const int q0=qb*QB; (void)b;
  const bf16*Qw=Q+(rowbase+q0+wid*QBLK)*DMQ+h*D;
  const bf16*Kh=K+(h>>2)*D,*Vh=V+(h>>2)*D;
  const unsigned lds0=(unsigned)(uintptr_t)shm;
  float*wsf=(float*)(shm+LDS_WS)+wid*64;
  const bf16*ksrc=Kh+(long)lane*DMK+wid*8;
  const bf16*vsrc=Vh+(long)(16*(wid&3)+(lane>>2))*DMK+(wid>>2)*32+(lane&3)*8;
  const unsigned kdst=lds0+LDS_K+wid*1024, vdst=lds0+LDS_V+wid*1024;
  #define DMA_K(t,slot) glds16(ksrc+(long)(t)*KVBLK*DMK,(unsigned)__builtin_amdgcn_readfirstlane(kdst+(slot)))
  #define DMA_V(t,slot) glds16(vsrc+(long)(t)*KVBLK*DMK,(unsigned)__builtin_amdgcn_readfirstlane(vdst+(slot)))
  const int vb0=(int)(lds0+LDS_V)+((lane>>4)&1)*32+(lane&3)*8+(4*hi+((lane&15)>>2))*64;
  const char*Kbase=shm+LDS_K; bf16x8 kf[8];
  const lds_cptr shm3=(lds_cptr)shm; const lds_cptr kp0=shm3+LDS_K+hi*1024+r32*16; const lds_cptr vp0=shm3+LDS_V+((lane>>4)&1)*32+(lane&3)*8+(4*hi+((lane&15)>>2))*64;
  const int NT=SEQ/KVBLK;
  DMA_K(0,0);DMA_V(0,0);DMA_K(1,SLOTB);
  bf16x8 qr[4];
  #pragma unroll
  for(int d0=0;d0<4;++d0)qr[d0]=*reinterpret_cast<const bf16x8*>(&Qw[(long)r32*DMQ+d0*16+hi*8]);
  float mhat=0.f,l_reg=0.f;f32x16 o[2];o[0]=f32x16{};o[1]=f32x16{};f32x16 negm=f32x16{};asm volatile("":"+v"(negm));
  const int qrel=wid*QBLK+r32; (void)qrel;
  #define CMASK(P0,P1,t) do{}while(0)
  bool resc=false;
  #define START(P0,P1) do{ const float rm=rowmax(P0,P1); resc=false; \
    { const float dl=rm; mhat=fadd_s(mhat,dl); \
      _Pragma("unroll") for(int r=0;r<16;++r){P0[r]=fsub_s(P0[r],dl);P1[r]=fsub_s(P1[r],dl);} \
      _Pragma("unroll") for(int r=0;r<16;++r)negm[r]=-mhat; asm volatile("":"+v"(negm)); } \
    _Pragma("unroll") for(int r=0;r<16;++r)P0[r]=__builtin_amdgcn_exp2f(P0[r]); }while(0)
  #define RESC() do{ if(resc){ asm volatile("s_waitcnt lgkmcnt(0)":::"memory"); \
      _Pragma("unroll") for(int d_=0;d_<2;++d_) _Pragma("unroll") for(int r=0;r<16;++r)o[d_][r]*=wsf[crow(r,hi)]; } }while(0)
  f32x16 pA0,pA1,pB0,pB1;
  int sl_prev=0,sl_cur=0,sl_next=SLOTB;
  #define ROT() do{sl_prev=sl_cur;sl_cur=sl_next;sl_next=(sl_next==(NSLOT-1)*SLOTB)?0:sl_next+SLOTB;}while(0)
  DMA_K(2,2*SLOTB);
  WAIT_BAR(3);
  qkt(pA0,pA1,Kbase,qr,negm,r32,hi);asm volatile("s_nop 15\n\ts_nop 7":"+v"(pA0),"+v"(pA1));CMASK(pA0,pA1,0);
  START(pA0,pA1);
  _Pragma("unroll") for(int r=0;r<16;++r)pA1[r]=__builtin_amdgcn_exp2f(pA1[r]);
  WAIT_BAR(0);
  DMA_K(3,0);DMA_V(1,SLOTB);
  ROT();
  kload8(kf,kp0+sl_cur);
  WAIT_BAR(2);
  s16x4 vlo[8],vhi[8]; u32x4 pw0,pw1,pw2,pw3;
  #define PKW(P,B) cvtpk_s(P[B],P[B+1])
  #define PAF(k) __builtin_bit_cast(bf16x8,pw##k)
  #define VFR(i) (bf16x8){vlo[i][0],vlo[i][1],vlo[i][2],vlo[i][3],vhi[i][0],vhi[i][1],vhi[i][2],vhi[i][3]}
  #define PIN(x) asm volatile("":"+v"(x))
  #define MX3(a,b,c) __builtin_fmaxf(__builtin_fmaxf((a),(b)),(c))
  #define GAPA(MF,A0,A1,A2,A3,W0,W1,PW) do{ MF; sacc+=A0; sacc+=A1; sacc+=A2; sacc+=A3; PIN(sacc); W0; W1; PIN(PW); SBAR(); }while(0)
  #define EX(v) __builtin_amdgcn_exp2f(v)
  #define GAPB(MF,X,B) do{ MF; X[B]=EX(X[B]); X[B+1]=EX(X[B+1]); X[B+2]=EX(X[B+2]); X[B+3]=EX(X[B+3]); PIN(X); SBAR(); }while(0)
  #define VRD(i) do{ vlo[i]=vtr(vp_+(((i)>>2)*4096+((i)&3)*1024)); vhi[i]=vtr(vp_+(((i)>>2)*4096+((i)&3)*1024+512)); }while(0)
  #define KRD(G,j) do{ if(G){ kload2(kf,kp0+sl_next,j); SBAR(); } }while(0)
  #define STEP(C0,C1,P0,P1,t,GK,GV,GL) do{ SBAR(); \
    const lds_cptr vp_=vp0+sl_prev; \
    VRD(0); SBAR(); float sacc=(P0[0]+P0[1]); \
    GAPA(C0=__builtin_amdgcn_mfma_f32_32x32x16_bf16(kf[0],qr[0],negm,0,0,0), P0[2],P0[3],P0[4],P0[5],     pw0[0]=PKW(P0,0), pw0[1]=PKW(P0,2), pw0); \
    VRD(4); SBAR(); GAPA(C1=__builtin_amdgcn_mfma_f32_32x32x16_bf16(kf[1],qr[0],negm,0,0,0), P0[6],P0[7],P0[8],P0[9],     pw0[2]=PKW(P0,4), pw0[3]=PKW(P0,6), pw0); \
    VRD(1); SBAR(); GAPA(C0=__builtin_amdgcn_mfma_f32_32x32x16_bf16(kf[2],qr[1],C0,0,0,0),   P0[10],P0[11],P0[12],P0[13], pw1[0]=PKW(P0,8), pw1[1]=PKW(P0,10), pw1); \
    VRD(5); SBAR(); GAPA(C1=__builtin_amdgcn_mfma_f32_32x32x16_bf16(kf[3],qr[1],C1,0,0,0),   P0[14],P0[15],P1[0],P1[1],   pw1[2]=PKW(P0,12),pw1[3]=PKW(P0,14), pw1); \
    VRD(2); SBAR(); GAPA(C0=__builtin_amdgcn_mfma_f32_32x32x16_bf16(kf[4],qr[2],C0,0,0,0),   P1[2],P1[3],P1[4],P1[5],     pw2[0]=PKW(P1,0), pw2[1]=PKW(P1,2), pw2); \
    VRD(6); SBAR(); GAPA(C1=__builtin_amdgcn_mfma_f32_32x32x16_bf16(kf[5],qr[2],C1,0,0,0),   P1[6],P1[7],P1[8],P1[9],     pw2[2]=PKW(P1,4), pw2[3]=PKW(P1,6), pw2); \
    VRD(3); SBAR(); GAPA(C0=__builtin_amdgcn_mfma_f32_32x32x16_bf16(kf[6],qr[3],C0,0,0,0),   P1[10],P1[11],P1[12],P1[13], pw3[0]=PKW(P1,8), pw3[1]=PKW(P1,10), pw3); \
    VRD(7); SBAR(); GAPA(C1=__builtin_amdgcn_mfma_f32_32x32x16_bf16(kf[7],qr[3],C1,0,0,0),   P1[14],P1[15],0.f,0.f,       pw3[2]=PKW(P1,12),pw3[3]=PKW(P1,14), pw3); \
    l_reg+=sacc; \
    if(GK){DMA_K((t)+3,sl_cur);} if(GV){DMA_V((t)+1,sl_next);} \
    CMASK(C0,C1,t); \
    { float a=MX3(C0[0],C0[1],C1[0]),b=MX3(C0[2],C0[3],C1[1]); a=MX3(a,C1[2],C1[3]); \
      _Pragma("unroll") for(int r=4;r<16;r+=4){a=MX3(a,C0[r],C0[r+1]);b=MX3(b,C0[r+2],C0[r+3]);a=MX3(a,C1[r],C1[r+1]);b=MX3(b,C1[r+2],C1[r+3]);} \
      float rm=__builtin_fmaxf(a,b); { auto rr=__builtin_amdgcn_permlane32_swap(__float_as_uint(rm),__float_as_uint(rm),false,false); rm=__builtin_fmaxf(__uint_as_float(rr[0]),__uint_as_float(rr[1])); } \
      resc=false; \
      if(__builtin_expect(__any(rm>(float)THRL),0)){ const float dl=__builtin_fmaxf(rm,0.f); mhat+=dl; \
        _Pragma("unroll") for(int r=0;r<16;++r){C0[r]-=dl;C1[r]-=dl;} \
        _Pragma("unroll") for(int r=0;r<16;++r)negm[r]=-mhat; asm volatile("":"+v"(negm)); \
        const float f=__builtin_amdgcn_exp2f(-dl); l_reg*=f; if(hi==0)wsf[r32]=f; resc=true; } } \
    SBAR(); \
    GAPB(o[0]=__builtin_amdgcn_mfma_f32_32x32x16_bf16(PAF(0),VFR(0),o[0],0,0,0), C0,0); \
    GAPB(o[1]=__builtin_amdgcn_mfma_f32_32x32x16_bf16(PAF(0),VFR(4),o[1],0,0,0), C0,4); \
    KRD(GL,0); GAPB(o[0]=__builtin_amdgcn_mfma_f32_32x32x16_bf16(PAF(1),VFR(1),o[0],0,0,0), C0,8); \
    KRD(GL,1); GAPB(o[1]=__builtin_amdgcn_mfma_f32_32x32x16_bf16(PAF(1),VFR(5),o[1],0,0,0), C0,12); \
    KRD(GL,2); GAPB(o[0]=__builtin_amdgcn_mfma_f32_32x32x16_bf16(PAF(2),VFR(2),o[0],0,0,0), C1,0); \
    KRD(GL,3); GAPB(o[1]=__builtin_amdgcn_mfma_f32_32x32x16_bf16(PAF(2),VFR(6),o[1],0,0,0), C1,4); \
    GAPB(o[0]=__builtin_amdgcn_mfma_f32_32x32x16_bf16(PAF(3),VFR(3),o[0],0,0,0), C1,8); \
    GAPB(o[1]=__builtin_amdgcn_mfma_f32_32x32x16_bf16(PAF(3),VFR(7),o[1],0,0,0), C1,12); \
    }while(0)
  int t=1;
  #undef CMASK
  #define CMASK(P0,P1,t) do{}while(0)
  for(;t+5<NT;t+=2){
    STEP(pB0,pB1,pA0,pA1,t,true,true,true);     WAIT_BAR(2); RESC(); ROT();
    STEP(pA0,pA1,pB0,pB1,t+1,true,true,true);   WAIT_BAR(2); RESC(); ROT();
  }
  #undef CMASK
  #define CMASK(P0,P1,t) do{}while(0)
  #define ENDW(tt) do{ if((tt)+3<NT){WAIT_BAR(2);} else if((tt)+2<NT){WAIT_BAR(1);} else {WAIT_BAR(0);} }while(0)
  for(;t+1<NT;t+=2){
    STEP(pB0,pB1,pA0,pA1,t,(t+3<NT),(t+1<NT),(t+1<NT));       ENDW(t);   RESC(); ROT();
    STEP(pA0,pA1,pB0,pB1,t+1,(t+4<NT),(t+2<NT),(t+2<NT));     ENDW(t+1); RESC(); ROT();
  }
  STEP(pB0,pB1,pA0,pA1,NT-1,false,false,false); RESC();
  { float sacc=pB0[0]+pB0[1]; _Pragma("unroll") for(int r=2;r<16;++r)sacc+=pB0[r]; _Pragma("unroll") for(int r=0;r<16;++r)sacc+=pB1[r]; l_reg+=sacc;
    pw0=(u32x4){PKW(pB0,0),PKW(pB0,2),PKW(pB0,4),PKW(pB0,6)};pw1=(u32x4){PKW(pB0,8),PKW(pB0,10),PKW(pB0,12),PKW(pB0,14)};pw2=(u32x4){PKW(pB1,0),PKW(pB1,2),PKW(pB1,4),PKW(pB1,6)};pw3=(u32x4){PKW(pB1,8),PKW(pB1,10),PKW(pB1,12),PKW(pB1,14)};
    SBAR(); pv(o,vb0+sl_cur,PAF(0),PAF(1),PAF(2),PAF(3)); }
  #undef PKW
  #undef PAF
  #undef VFR
  #undef PIN
  #undef MX3
  #undef GAPA
  #undef GAPB
  #undef EX
  #undef VRD
  #undef KRD
  #undef STEP
  #undef ENDW
  {auto rr=__builtin_amdgcn_permlane32_swap(__float_as_uint(l_reg),__float_as_uint(l_reg),false,false);l_reg=__uint_as_float(rr[0])+__uint_as_float(rr[1]);}
  if(hi==0)wsf[32+r32]=l_reg;asm volatile("s_waitcnt lgkmcnt(0)":::"memory");
  float rli[16];
  #pragma unroll
  for(int r=0;r<16;++r)rli[r]=__builtin_amdgcn_rcpf(wsf[32+crow(r,hi)]);
  bf16*Ow=O+(rowbase+q0+wid*QBLK)*DMQ+h*D;
  { bf16*stg=(bf16*)(shm+LDS_OST)+wid*2048;
    #pragma unroll
    for(int r=0;r<16;++r){const int orow=crow(r,hi);
      #pragma unroll
      for(int d0=0;d0<2;++d0)stg[orow*64+d0*32+r32]=__float2bfloat16(o[d0][r]*rli[r]);}
    asm volatile("s_waitcnt lgkmcnt(0)":::"memory");
    #pragma unroll
    for(int i=0;i<4;++i){const int row=i*8+(lane>>3),ch=lane&7; const u32x4 v=*(const u32x4*)(stg+row*64+ch*8); ATTN_STORE16(Ow+(long)row*DMQ+ch*8,v);} }
  asm volatile("s_waitcnt lgkmcnt(0)\n\ts_barrier":::"memory");
  #undef DMA_K
  #undef DMA_V
  #undef CMASK
  #undef START
  #undef RESC
  #undef ROT
}
constexpr int ATTN_LDS_BYTES=LDS_BYTES;
struct AttnTensors { const bf16* Q; const bf16* K; const bf16* V; bf16* O; };
struct AttnUnit { int bh; int qb; };
struct StaticOrder {
  int vcu, G;
  __device__ __forceinline__ explicit StaticOrder(int grid,int block):vcu((grid%8==0)?(block%8)*(grid/8)+block/8:block),G(grid){}
  __device__ __forceinline__ bool next(int i,AttnUnit&u)const{ constexpr int NU=NHEAD*NQB; int uu; if(NU%G==0){ const int per=NU/G; if(i>=per)return false; uu=vcu*per+i; } else { uu=i*G+vcu; if(uu>=NU)return false; } u.bh=uu/NQB; u.qb=uu%NQB; return true; }
  __device__ __forceinline__ void a_ready(const AttnUnit&)const{}
  __device__ __forceinline__ void done(const AttnUnit&)const{}
};
template<class Sched,int THRL=8> __device__ __forceinline__ void attn_phase(char*lds,const AttnTensors&T,const Sched&S,int wave_){
  AttnUnit u;
  for(int i=0;S.next(i,u);++i){ S.a_ready(u); attn_unit<THRL>(0,u.bh,u.qb,T.Q,T.K,T.V,T.O,lds,wave_); S.done(u); }
}
#undef SBAR
#undef WAIT_BAR
}

namespace hg {
typedef short bf16x8 __attribute__((ext_vector_type(8)));
typedef short s16x4 __attribute__((ext_vector_type(4)));
constexpr int CH = 32, SEGT = 512, NSEG = S / SEGT, NCH = SEGT / CH;
constexpr int RS = 272, TS = 80;
constexpr int QOFF = 0, KOFF = 32 * RS, KTOFF = 2 * 32 * RS, VTOFF = KTOFF + 128 * TS, DOFF = VTOFF + 128 * TS, GOFF = DOFF + 512, BUFB = GOFF + 2048;
static_assert(2 * BUFB <= 131072, "hgrn LDS");
#define HG_MFMA(a, b, c) __builtin_amdgcn_mfma_f32_16x16x32_bf16((a), (b), (c), 0, 0, 0)
__device__ __forceinline__ unsigned pkbf(float lo, float hi) { typedef float f2 __attribute__((ext_vector_type(2))); typedef __bf16 b2 __attribute__((ext_vector_type(2))); f2 v = {lo, hi}; b2 b = __builtin_convertvector(v, b2); return __builtin_bit_cast(unsigned, b); }

template <bool OUT>
__device__ __forceinline__ void segment(LAS unsigned char* lds, int unit, const bf16_t* __restrict__ HQ, const float* __restrict__ LF, const bf16_t* __restrict__ KF,
                                        const bf16_t* __restrict__ HV, float* __restrict__ HST, float* __restrict__ HSD, float* __restrict__ OF, int wave_) {
    const int tid_ = wave_ * 64 + lane_id_opaque();
    const int tid = tid_, lane = tid & 63, w = __builtin_amdgcn_readfirstlane(tid >> 6), c16 = lane & 15, g = lane >> 4;
    const int dir = unit >> 7, h = (unit >> 5) & 3, seg = unit & 31;
    const int d = tid & 127, tg = tid >> 7;
    const size_t cb = (size_t)h * 128 + d;
    const float* lf = LF + (size_t)dir * S * 512 + cb;
    const bf16_t* kf = KF + (size_t)dir * S * 512 + cb;
    const bf16_t* hq = HQ + cb; const bf16_t* hv = HV + cb;
    f32x4 Sacc[8];
    float* hst = HST + (size_t)unit * 16384 + (size_t)w * 2048 + lane;
    if (OUT) {
#pragma unroll
        for (int dt = 0; dt < 8; ++dt) { Sacc[dt][0] = hst[(dt * 4 + 0) * 64]; Sacc[dt][1] = hst[(dt * 4 + 1) * 64]; Sacc[dt][2] = hst[(dt * 4 + 2) * 64]; Sacc[dt][3] = hst[(dt * 4 + 3) * 64]; }
    } else {
#pragma unroll
        for (int dt = 0; dt < 8; ++dt) Sacc[dt] = f32x4{0.f, 0.f, 0.f, 0.f};
    }
    float segsum = 0.f;
    const int e0 = 16 * w;
    for (int c = 0; c < NCH; ++c) {
        LAS unsigned char* B = lds + (c & 1) * BUFB;
        float lg[8], kk[8], qq[8]; unsigned short vv[8];
#pragma unroll
        for (int jj = 0; jj < 8; ++jj) {
            const int p = seg * SEGT + c * CH + 8 * tg + jj, t = dir ? (S - 1 - p) : p;
            lg[jj] = lf[(size_t)t * 512]; kk[jj] = bf2f(kf[(size_t)t * 512]); vv[jj] = hv[(size_t)t * 512];
            qq[jj] = OUT ? bf2f(hq[(size_t)t * 512]) : 0.f;
        }
#pragma unroll
        for (int jj = 1; jj < 8; ++jj) lg[jj] += lg[jj - 1];
        LAS float* gs = (LAS float*)(B + GOFF);
        gs[tg * 128 + d] = lg[7];
        __syncthreads();
        const float g0 = gs[d], g1 = gs[128 + d], g2 = gs[256 + d], g3 = gs[384 + d];
        const float off = (tg > 0 ? g0 : 0.f) + (tg > 1 ? g1 : 0.f) + (tg > 2 ? g2 : 0.f), tot = (g0 + g1) + (g2 + g3);
        float kt[8];
#pragma unroll
        for (int jj = 0; jj < 8; ++jj) {
            const float b = fmaxf(off + lg[jj], -80.f);
            kt[jj] = kk[jj] * __expf(-b);
            if (OUT) {
                *(LAS bf16_t*)(B + QOFF + (8 * tg + jj) * RS + d * 2) = (bf16_t)(pkbf(qq[jj] * __expf(b), 0.f) & 0xffffu);
                *(LAS bf16_t*)(B + KOFF + (8 * tg + jj) * RS + d * 2) = (bf16_t)(pkbf(kt[jj], 0.f) & 0xffffu);
            }
        }
        { u32x4 o; o.x = pkbf(kt[0], kt[1]); o.y = pkbf(kt[2], kt[3]); o.z = pkbf(kt[4], kt[5]); o.w = pkbf(kt[6], kt[7]);
          *(LAS u32x4*)(B + KTOFF + d * TS + 16 * tg) = o;
          u32x4 v; v.x = (unsigned)vv[0] | ((unsigned)vv[1] << 16); v.y = (unsigned)vv[2] | ((unsigned)vv[3] << 16); v.z = (unsigned)vv[4] | ((unsigned)vv[5] << 16); v.w = (unsigned)vv[6] | ((unsigned)vv[7] << 16);
          *(LAS u32x4*)(B + VTOFF + d * TS + 16 * tg) = v; }
        if (tg == 0) *(LAS float*)(B + DOFF + d * 4) = __expf(fmaxf(tot, -80.f));
        segsum += tot;
        __syncthreads();
        if (OUT) {
            f32x4 X00 = {0.f, 0.f, 0.f, 0.f}, X01 = X00, X11 = X00;
#pragma unroll
            for (int s = 0; s < 4; ++s) {
                const bf16x8 aK0 = *(const LAS bf16x8*)(B + KOFF + c16 * RS + (32 * s + 8 * g) * 2), aK1 = *(const LAS bf16x8*)(B + KOFF + (16 + c16) * RS + (32 * s + 8 * g) * 2);
                const bf16x8 bQ0 = *(const LAS bf16x8*)(B + QOFF + c16 * RS + (32 * s + 8 * g) * 2), bQ1 = *(const LAS bf16x8*)(B + QOFF + (16 + c16) * RS + (32 * s + 8 * g) * 2);
                X00 = HG_MFMA(aK0, bQ0, X00); X01 = HG_MFMA(aK0, bQ1, X01); X11 = HG_MFMA(aK1, bQ1, X11);
            }
#pragma unroll
            for (int r = 0; r < 4; ++r) { const bool keep = (4 * g + r) <= c16; X00[r] = keep ? X00[r] : 0.f; X11[r] = keep ? X11[r] : 0.f; }
            u32x4 a0w, a1w; a0w.x = pkbf(X00[0], X00[1]); a0w.y = pkbf(X00[2], X00[3]); a0w.z = 0u; a0w.w = 0u;
            a1w.x = pkbf(X01[0], X01[1]); a1w.y = pkbf(X01[2], X01[3]); a1w.z = pkbf(X11[0], X11[1]); a1w.w = pkbf(X11[2], X11[3]);
            const u32x2 vlo = *(const LAS u32x2*)(B + VTOFF + (e0 + c16) * TS + (4 * g) * 2), vhi = *(const LAS u32x2*)(B + VTOFF + (e0 + c16) * TS + (16 + 4 * g) * 2);
            u32x4 vbw; vbw.x = vlo.x; vbw.y = vlo.y; vbw.z = vhi.x; vbw.w = vhi.y;
            const bf16x8 vb = __builtin_bit_cast(bf16x8, vbw);
            f32x4 O0 = {0.f, 0.f, 0.f, 0.f}, O1 = O0;
            O0 = HG_MFMA(__builtin_bit_cast(bf16x8, a0w), vb, O0); O1 = HG_MFMA(__builtin_bit_cast(bf16x8, a1w), vb, O1);
#pragma unroll
            for (int s = 0; s < 4; ++s) {
                u32x4 sw; sw.x = pkbf(Sacc[2 * s][0], Sacc[2 * s][1]); sw.y = pkbf(Sacc[2 * s][2], Sacc[2 * s][3]); sw.z = pkbf(Sacc[2 * s + 1][0], Sacc[2 * s + 1][1]); sw.w = pkbf(Sacc[2 * s + 1][2], Sacc[2 * s + 1][3]);
                const bf16x8 sb = __builtin_bit_cast(bf16x8, sw);
                const u32x2 q0l = *(const LAS u32x2*)(B + QOFF + c16 * RS + (32 * s + 4 * g) * 2), q0h = *(const LAS u32x2*)(B + QOFF + c16 * RS + (32 * s + 16 + 4 * g) * 2);
                const u32x2 q1l = *(const LAS u32x2*)(B + QOFF + (16 + c16) * RS + (32 * s + 4 * g) * 2), q1h = *(const LAS u32x2*)(B + QOFF + (16 + c16) * RS + (32 * s + 16 + 4 * g) * 2);
                u32x4 q0w, q1w; q0w.x = q0l.x; q0w.y = q0l.y; q0w.z = q0h.x; q0w.w = q0h.y; q1w.x = q1l.x; q1w.y = q1l.y; q1w.z = q1h.x; q1w.w = q1h.y;
                O0 = HG_MFMA(__builtin_bit_cast(bf16x8, q0w), sb, O0); O1 = HG_MFMA(__builtin_bit_cast(bf16x8, q1w), sb, O1);
            }
#pragma unroll
            for (int r = 0; r < 4; ++r) {
                const int p0 = seg * SEGT + c * CH + 4 * g + r, p1 = p0 + 16;
                const int t0 = dir ? (S - 1 - p0) : p0, t1 = dir ? (S - 1 - p1) : p1;
                OF[((size_t)dir * S + t0) * 512 + h * 128 + e0 + c16] = O0[r];
                OF[((size_t)dir * S + t1) * 512 + h * 128 + e0 + c16] = O1[r];
            }
        }
        {
            const bf16x8 vB = *(const LAS bf16x8*)(B + VTOFF + (e0 + c16) * TS + (8 * g) * 2);
#pragma unroll
            for (int dt = 0; dt < 8; ++dt) {
                const bf16x8 aT = *(const LAS bf16x8*)(B + KTOFF + (16 * dt + c16) * TS + (8 * g) * 2);
                Sacc[dt] = HG_MFMA(aT, vB, Sacc[dt]);
                const f32x4 dv = *(const LAS f32x4*)(B + DOFF + (16 * dt + 4 * g) * 4);
                Sacc[dt] = Sacc[dt] * dv;
            }
        }
    }
    if (!OUT) {
#pragma unroll
        for (int dt = 0; dt < 8; ++dt) { hst[(dt * 4 + 0) * 64] = Sacc[dt][0]; hst[(dt * 4 + 1) * 64] = Sacc[dt][1]; hst[(dt * 4 + 2) * 64] = Sacc[dt][2]; hst[(dt * 4 + 3) * 64] = Sacc[dt][3]; }
        if (tid < 128) HSD[(size_t)unit * 128 + d] = __expf(fmaxf(segsum, -80.f));
    }
    __syncthreads();
}
__device__ __forceinline__ void carry(float* __restrict__ HST, const float* __restrict__ HSD, int gid) {
    const int chain = gid >> 14, el = gid & 16383, dt = (el >> 8) & 7, r = (el >> 6) & 3, ln = el & 63, d = 16 * dt + 4 * (ln >> 4) + r;
    float cy = 0.f;
    for (int sg = 0; sg < NSEG; ++sg) {
        const int u = chain * NSEG + sg;
        const float tmp = HST[(size_t)u * 16384 + el];
        HST[(size_t)u * 16384 + el] = cy;
        cy = HSD[(size_t)u * 128 + d] * cy + tmp;
    }
}
#undef HG_MFMA
}

#define XB_TMO      128
#define XB_XCNT(j)  (256  + 64 * (j))
#define XB_XSUB(j)  (1280 + 64 * (j))
#define XB_XGEN(j)  (2304 + 64 * (j))
#define XB_TOP      3328
#define XB_TOPGEN   3392
#define XCD_BAR_WORDS 3456
#define XB_SPIN_CAP (1u << 18)

__device__ __forceinline__ unsigned xb_ld(unsigned* p)              { return __hip_atomic_load(p, __ATOMIC_RELAXED, __HIP_MEMORY_SCOPE_AGENT); }
__device__ __forceinline__ unsigned xb_add(unsigned* p, unsigned v) { return __hip_atomic_fetch_add(p, v, __ATOMIC_RELAXED, __HIP_MEMORY_SCOPE_AGENT); }
__device__ __forceinline__ unsigned xb_xcc_id() { return (unsigned)__builtin_amdgcn_s_getreg((3 << 11) | 20) & 0xFu; }
#define XB_SPIN(cond, bar) do { unsigned _sp = 0; while (cond) { __builtin_amdgcn_s_sleep(1); \
    if ((++_sp & 255u) == 0u) { if (xb_ld(&(bar)[XB_TMO])) break; if (_sp > XB_SPIN_CAP) { atomicAdd(&(bar)[XB_TMO], 1u); break; } } } } while (0)

struct XcdBarrier {
    int wv;
    unsigned* bar; unsigned x;
    volatile LAS unsigned* st;
};

__device__ __forceinline__ XcdBarrier xcd_barrier_post(unsigned* bar, volatile LAS unsigned* st) {
    XcdBarrier b; b.bar = bar; b.x = xb_xcc_id(); b.st = st; b.wv = __builtin_amdgcn_readfirstlane((int)threadIdx.x >> 6);
    if (threadIdx.x == 0) (void)xb_add(&bar[XB_XCNT(b.x)], 1u);
    return b;
}
__device__ __forceinline__ void xcd_barrier_complete(unsigned* bar, unsigned x, unsigned& nloc, unsigned& nx) {
    const unsigned G = gridDim.x * gridDim.y * gridDim.z;
    unsigned sum, cnt, mine, sp = 0u;
    for (;;) {
        sum = 0u; cnt = 0u; mine = 0u;
#pragma unroll
        for (unsigned j = 0; j < 16; ++j) { const unsigned c = xb_ld(&bar[XB_XCNT(j)]); sum += c; cnt += (c > 0u) ? 1u : 0u; mine = (j == x) ? c : mine; }
        if (sum == G) break;
        __builtin_amdgcn_s_sleep(1);
        if ((++sp & 255u) == 0u) { if (xb_ld(&bar[XB_TMO])) break; if (sp > XB_SPIN_CAP) { atomicAdd(&bar[XB_TMO], 1u); break; } }
    }
    nloc = mine > 0u ? mine : 1u; nx = cnt > 0u ? cnt : 1u;
}

__device__ __forceinline__ void xcd_barrier(const XcdBarrier& b) {
    asm volatile("s_waitcnt vmcnt(0)" ::: "memory");
    __syncthreads();
    if (b.wv == 0 && lane_id_opaque() == 0) {
        unsigned* bar = b.bar;
        __builtin_amdgcn_s_waitcnt(0);
        unsigned nloc = b.st[0], nx = b.st[1];
        if (nloc == 0u) { xcd_barrier_complete(bar, b.x, nloc, nx); b.st[0] = nloc; b.st[1] = nx; }
        const unsigned old = xb_add(&bar[XB_XSUB(b.x)], 1u);
        const unsigned gen = old / nloc;
        if (old + 1u == (gen + 1u) * nloc) {
            __builtin_amdgcn_fence(__ATOMIC_RELEASE, "agent");
            asm volatile("s_waitcnt vmcnt(0)" ::: "memory");
            const unsigned og = xb_add(&bar[XB_TOP], 1u);
            const unsigned tg = og / nx;
            if (og + 1u == (tg + 1u) * nx) xb_add(&bar[XB_TOPGEN], 1u);
            else XB_SPIN(xb_ld(&bar[XB_TOPGEN]) == tg, bar);
            __builtin_amdgcn_fence(__ATOMIC_ACQUIRE, "agent");
            xb_add(&bar[XB_XGEN(b.x)], 1u);
            asm volatile("s_waitcnt vmcnt(0)" ::: "memory");
        } else {
            XB_SPIN(xb_ld(&bar[XB_XGEN(b.x)]) == gen, bar);
            __builtin_amdgcn_fence(__ATOMIC_ACQUIRE, "agent");
            asm volatile("s_waitcnt vmcnt(0)" ::: "memory");
        }
    }
    __syncthreads();
}

constexpr int NWAVES = 8;
constexpr int RING_OFF = 0, RING_BYTES = 131072;
constexpr int LDSCTL_OFF = RING_BYTES, MISC_OFF = LDSCTL_OFF + 320;
constexpr int LDS_BYTES = 147456;
constexpr int CW_BAR = 4096;
constexpr int NPL = 13;
constexpr int PH_PRO = 0, PH_NORM1 = 1, PH_L0 = 2, PH_END = PH_L0 + NL * NPL;
enum { P_G1 = 0, P_QKP = 1, P_HGB = 2, P_HGC = 3, P_ATT = 4, P_G2 = 5, P_G3 = 6, P_N2R = 7, P_TOPK = 8, P_GATH = 9, P_G4 = 10, P_G5 = 11, P_COMB = 12 };

struct Params {
    const float *x, *c, *ada_w, *ada_b, *norm_mix_w, *norm_ffn_w, *w_in, *q_norm_w, *k_norm_w, *hlb, *hg_norm_w, *w_ba, *w_bh, *w_out, *w_router, *w_eg, *w_eu, *w_ed;
    float* out; unsigned char* ws;
    int ph_lo, ph_hi, li, pad;
};
struct Frame {
    LAS unsigned char* lds;
    int tid, lane, wave, vcu, G;
};

__device__ __forceinline__ void tr_tile(const float* __restrict__ src, int ldw, bf16_t* __restrict__ dst, int Kd, LAS float* scr, int lane) {
#pragma unroll 8
    for (int i = 0; i < 32; ++i) { const int kk = 2 * i + (lane >> 5); scr[kk * 33 + (lane & 31)] = src[(size_t)kk * ldw + (lane & 31)]; }
    asm volatile("s_waitcnt lgkmcnt(0)" ::: "memory");
    const int cch = lane & 7;
#pragma unroll
    for (int j = 0; j < 4; ++j) { const int n = (lane >> 3) + 8 * j; const LAS float* s = scr + (8 * cch) * 33 + n;
        u32x4 o; o.x = pk2(s[0 * 33], s[1 * 33]); o.y = pk2(s[2 * 33], s[3 * 33]); o.z = pk2(s[4 * 33], s[5 * 33]); o.w = pk2(s[6 * 33], s[7 * 33]);
        *(u32x4*)(dst + (size_t)n * Kd + 8 * cch) = o; }
    asm volatile("s_waitcnt lgkmcnt(0)" ::: "memory");
}
__device__ __forceinline__ void conv_matrix(Frame& F, const float* W, int K, int N, bf16_t* WT, LAS float* scr) {
    const int gw = F.vcu * NWAVES + F.wave, NGW = F.G * NWAVES, nblk = N / 32, nitems = (K / 64) * nblk;
    for (int it = gw; it < nitems; it += NGW) { const int kb = it / nblk, nb = it % nblk;
        tr_tile(W + (size_t)(64 * kb) * N + 32 * nb, N, WT + (size_t)(32 * nb) * K + 64 * kb, K, scr, F.lane); }
}
__device__ __forceinline__ void conv_experts(Frame& F, const Params& p, int l, LAS float* scr) {
    const int gw = F.vcu * NWAVES + F.wave, NGW = F.G * NWAVES;
    bf16_t* WGU = (bf16_t*)(p.ws + WS_WGU); bf16_t* WD = (bf16_t*)(p.ws + WS_WD);
    for (int it = gw; it < 3 * NE * 1024; it += NGW) {
        const int which = it / (NE * 1024), r0 = it % (NE * 1024), e = r0 >> 10, r = r0 & 1023;
        if (which < 2) {
            const int kb = r >> 6, nb = r & 63, n0 = 32 * nb;
            const float* W = (which == 0 ? p.w_eg : p.w_eu) + (size_t)(l * NE + e) * D * FF;
            const int rho = e * 4096 + (n0 >> 7) * 256 + which * 128 + (n0 & 127);
            tr_tile(W + (size_t)(64 * kb) * FF + n0, FF, WGU + (size_t)rho * D + 64 * kb, D, scr, F.lane);
        } else {
            const int kb = r >> 5, nb = r & 31, n0 = 32 * nb;
            const float* W = p.w_ed + (size_t)(l * NE + e) * FF * D;
            tr_tile(W + (size_t)(64 * kb) * D + n0, D, WD + (size_t)(e * 1024 + n0) * FF + 64 * kb, FF, scr, F.lane);
        }
    }
}
__device__ __forceinline__ void mod_units(Frame& F, const Params& p) {
    LAS float* sc = (LAS float*)(F.lds + 96 * 1024);
    LAS float* red = sc + 1024;
    float* MOD = (float*)(p.ws + WS_MOD); float* LBV = (float*)(p.ws + WS_LBV);
    for (int u = blockIdx.x; u < NL * 96; u += F.G) {
        for (int i = F.tid; i < D; i += 512) sc[i] = siluf_(p.c[i]);
        __syncthreads();
        const int l = u / 96, j = (u % 96) * 64 + (F.tid & 63), kp = F.tid >> 6;
        const float* w = p.ada_w + (size_t)l * D * 6 * D + (size_t)(kp * 128) * 6 * D + j;
        float acc = 0.f;
#pragma unroll 8
        for (int k = 0; k < 128; ++k) acc += sc[kp * 128 + k] * w[(size_t)k * 6 * D];
        red[kp * 64 + (F.tid & 63)] = acc;
        __syncthreads();
        if (F.tid < 64) { float s = 0.f;
#pragma unroll
            for (int q = 0; q < 8; ++q) s += red[q * 64 + F.tid];
            MOD[l * 6 * D + j] = s + p.ada_b[l * 6 * D + j]; }
        __syncthreads();
    }
    const int n = blockIdx.x * 512 + F.tid;
    if (n < NL * 1024) { const int l = n / 1024, r = n % 1024; float v = 0.f;
        if (l == 1) { const float b0 = p.hlb[r], b1 = p.hlb[1024 + r]; v = 1.0f / (1.0f + __expf(b0 - b1)); }
        LBV[n] = v; }
}

__device__ __forceinline__ void norm_mod_row(const f32x4 (&v)[4], float ss, const float* __restrict__ w, const float* __restrict__ scale,
                                             const float* __restrict__ shift, bf16_t* __restrict__ orow, int lane, f32x4 (&h)[4]) {
    const float r = rsqrtf(ss * (1.0f / D) + EPS);
#pragma unroll
    for (int j = 0; j < 4; ++j) {
        const int c0 = 4 * lane + 256 * j;
        const f32x4 wv = *(const f32x4*)(w + c0), sv = *(const f32x4*)(scale + c0), bv = *(const f32x4*)(shift + c0);
        h[j] = (v[j] * r) * wv * (sv + 1.0f) + bv;
        u32x2 o; o.x = pk2(h[j].x, h[j].y); o.y = pk2(h[j].z, h[j].w);
        *(u32x2*)(orow + c0) = o;
    }
}
__device__ __forceinline__ void ph_norm1(Frame& F, const float* x, const float* w, const float* scale, const float* shift, bf16_t* HB) {
    const int gw = F.vcu * NWAVES + F.wave, NGW = F.G * NWAVES;
    for (int row = gw; row < S; row += NGW) {
        const f32x4* xr = (const f32x4*)(x + (size_t)row * D) + F.lane;
        f32x4 v[4], h[4]; float ss = 0.f;
#pragma unroll
        for (int j = 0; j < 4; ++j) { v[j] = xr[64 * j]; ss += (v[j].x * v[j].x + v[j].y * v[j].y) + (v[j].z * v[j].z + v[j].w * v[j].w); }
        ss = wave_sum(ss);
        norm_mod_row(v, ss, w, scale, shift, HB + (size_t)row * D, F.lane, h);
    }
}
__device__ __forceinline__ void ph_gather(Frame& F, const bf16_t* HB, const int* IDX, bf16_t* XE) {
    const int gw = F.vcu * NWAVES + F.wave, NGW = F.G * NWAVES;
    for (int r = gw; r < NE * CAP; r += NGW) {
        const int t = IDX[r];
        const u32x4* src = (const u32x4*)(HB + (size_t)t * D) + F.lane; u32x4* dst = (u32x4*)(XE + (size_t)r * D) + F.lane;
        const u32x4 a = src[0], b = src[64]; dst[0] = a; dst[64] = b;
    }
}


#define OPAQUE_LANE() const int lane = lane_id_opaque(); const int t_ = F.wave * 64 + lane
__device__ __forceinline__ void ph_rope_table(Frame& F, float* ROPE) {
    OPAQUE_LANE();
    const int n = blockIdx.x * 512 + t_;
    if (n < 4096) { const int pos = n >> 4, i = n & 15; const float inv = exp2f(-(float)i * (13.287712379549449f / 16.0f)); float sn, cs; sincosf((float)pos * inv, &sn, &cs); ROPE[2 * n] = cs; ROPE[2 * n + 1] = sn; }
}
__device__ __forceinline__ void ph_qkprep(Frame& F, const bf16_t* __restrict__ QR, const bf16_t* __restrict__ KR, const float* __restrict__ qw, const float* __restrict__ kw,
                                          const float* __restrict__ ROPE, bf16_t* __restrict__ QN, bf16_t* __restrict__ KN) {
    OPAQUE_LANE(); (void)lane;
    for (int gid = blockIdx.x * 512 + t_; gid < S * 10; gid += F.G * 512) {
        const int t = gid / 10, hh = gid % 10;
        const bool isq = hh < 8;
        const bf16_t* src = isq ? QR + (size_t)t * 512 + hh * 64 : KR + (size_t)t * 128 + (hh - 8) * 64;
        bf16_t* dst = isq ? QN + (size_t)t * 512 + hh * 64 : KN + (size_t)t * 128 + (hh - 8) * 64;
        const float* w = isq ? qw : kw;
        float f[64]; float ss = 0.f;
#pragma unroll
        for (int i = 0; i < 8; ++i) { const u32x4 q = *(const u32x4*)(src + 8 * i);
#pragma unroll
            for (int j = 0; j < 4; ++j) { f[8 * i + 2 * j] = bflo(q[j]); f[8 * i + 2 * j + 1] = bfhi(q[j]); } }
#pragma unroll
        for (int i = 0; i < 64; ++i) ss += f[i] * f[i];
        const float rn = rsqrtf(ss * (1.0f / 64.0f) + EPS), sc = isq ? C2 : 1.0f;
#pragma unroll
        for (int i = 0; i < 16; ++i) { const f32x4 wv = *(const f32x4*)(w + 4 * i);
            f[4 * i] *= rn * wv.x; f[4 * i + 1] *= rn * wv.y; f[4 * i + 2] *= rn * wv.z; f[4 * i + 3] *= rn * wv.w; }
        float o[64];
#pragma unroll
        for (int ax = 0; ax < 2; ++ax) {
            const float* tb = ROPE + (size_t)(ax == 0 ? (t >> 6) : (t & 63)) * 32;
#pragma unroll
            for (int i2 = 0; i2 < 8; ++i2) { const f32x4 cs = *(const f32x4*)(tb + 4 * i2);
#pragma unroll
                for (int k = 0; k < 2; ++k) { const int i = 2 * i2 + k; const float c_ = k ? cs.z : cs.x, s_ = k ? cs.w : cs.y;
                    const float x1 = f[ax * 32 + i], x2 = f[ax * 32 + 16 + i];
                    o[ax * 32 + i] = (x1 * c_ - x2 * s_) * sc; o[ax * 32 + 16 + i] = (x2 * c_ + x1 * s_) * sc; } }
        }
#pragma unroll
        for (int i = 0; i < 8; ++i) { u32x4 q;
#pragma unroll
            for (int j = 0; j < 4; ++j) q[j] = pk2(o[8 * i + 2 * j], o[8 * i + 2 * j + 1]);
            *(u32x4*)(dst + 8 * i) = q; }
    }
}
__device__ __forceinline__ void ph_hgfin(Frame& F, const float* __restrict__ OF, const bf16_t* __restrict__ HG, const float* __restrict__ w, bf16_t* __restrict__ OHG) {
    OPAQUE_LANE();
    const int gw = F.vcu * NWAVES + F.wave, NGW = F.G * NWAVES;
    const int e0 = (lane & 15) * 8;
    const f32x4 w0 = *(const f32x4*)(w + e0), w1 = *(const f32x4*)(w + e0 + 4);
    for (int t = gw; t < S; t += NGW) {
        const size_t off = (size_t)t * 512 + lane * 8;
        const f32x4 a0 = *(const f32x4*)(OF + off), a1 = *(const f32x4*)(OF + off + 4), b0 = *(const f32x4*)(OF + (size_t)S * 512 + off), b1 = *(const f32x4*)(OF + (size_t)S * 512 + off + 4);
        const f32x4 s0 = a0 + b0, s1 = a1 + b1;
        float ss = (s0.x * s0.x + s0.y * s0.y) + (s0.z * s0.z + s0.w * s0.w) + (s1.x * s1.x + s1.y * s1.y) + (s1.z * s1.z + s1.w * s1.w);
        ss += __shfl_xor(ss, 1); ss += __shfl_xor(ss, 2); ss += __shfl_xor(ss, 4); ss += __shfl_xor(ss, 8);
        const float r = rsqrtf(ss * (1.0f / 128.0f) + EPS);
        const u32x4 g = *(const u32x4*)(HG + off);
        u32x4 o;
        o.x = pk2(s0.x * r * w0.x * bflo(g.x), s0.y * r * w0.y * bfhi(g.x));
        o.y = pk2(s0.z * r * w0.z * bflo(g.y), s0.w * r * w0.w * bfhi(g.y));
        o.z = pk2(s1.x * r * w1.x * bflo(g.z), s1.y * r * w1.y * bfhi(g.z));
        o.w = pk2(s1.z * r * w1.z * bflo(g.w), s1.w * r * w1.w * bfhi(g.w));
        *(u32x4*)(OHG + off) = o;
    }
}
__device__ __forceinline__ void ph_norm2_router(Frame& F, const float* __restrict__ X1, const float* __restrict__ w, const float* __restrict__ scale, const float* __restrict__ shift,
                                                const float* __restrict__ wr, bf16_t* __restrict__ HB, float* __restrict__ AFF) {
    OPAQUE_LANE();
    const int gw = F.vcu * NWAVES + F.wave, NGW = F.G * NWAVES;
    for (int row = gw; row < S; row += NGW) {
        const f32x4* xr = (const f32x4*)(X1 + (size_t)row * D) + lane;
        f32x4 v[4], h[4]; float ss = 0.f;
#pragma unroll
        for (int j = 0; j < 4; ++j) { v[j] = xr[64 * j]; ss += (v[j].x * v[j].x + v[j].y * v[j].y) + (v[j].z * v[j].z + v[j].w * v[j].w); }
        ss = wave_sum(ss);
        norm_mod_row(v, ss, w, scale, shift, HB + (size_t)row * D, lane, h);
        f32x4 lgv[4];
#pragma unroll
        for (int e4 = 0; e4 < 4; ++e4) lgv[e4] = f32x4{0.f, 0.f, 0.f, 0.f};
        const GAS float* wro = (const GAS float*)wr + (size_t)(4 * lane) * 16; asm volatile("" : "+v"(wro));
#pragma unroll
        for (int j = 0; j < 4; ++j)
#pragma unroll
            for (int i = 0; i < 4; ++i) {
                const float hv = h[j][i]; const GAS float* wp = wro + (size_t)(256 * j + i) * 16;
#pragma unroll
                for (int e4 = 0; e4 < 4; ++e4) lgv[e4] += *(const GAS f32x4*)(wp + 4 * e4) * hv;
            }
        float mx = -1e30f;
#pragma unroll
        for (int e4 = 0; e4 < 4; ++e4) { lgv[e4].x = wave_sum(lgv[e4].x); lgv[e4].y = wave_sum(lgv[e4].y); lgv[e4].z = wave_sum(lgv[e4].z); lgv[e4].w = wave_sum(lgv[e4].w);
            mx = fmaxf(mx, fmaxf(fmaxf(lgv[e4].x, lgv[e4].y), fmaxf(lgv[e4].z, lgv[e4].w))); }
        float den = 0.f;
#pragma unroll
        for (int e4 = 0; e4 < 4; ++e4) { lgv[e4].x = __expf(lgv[e4].x - mx); lgv[e4].y = __expf(lgv[e4].y - mx); lgv[e4].z = __expf(lgv[e4].z - mx); lgv[e4].w = __expf(lgv[e4].w - mx);
            den += (lgv[e4].x + lgv[e4].y) + (lgv[e4].z + lgv[e4].w); }
        const float inv = 1.0f / den;
        const f32x4 s8a = (lane & 8) ? lgv[2] : lgv[0], s8b = (lane & 8) ? lgv[3] : lgv[1];
        const f32x4 s4 = (lane & 4) ? s8b : s8a;
        const float s2a = (lane & 2) ? s4.z : s4.x, s2b = (lane & 2) ? s4.w : s4.y;
        const float mine = ((lane & 1) ? s2b : s2a) * inv;
        if (lane < 16) AFF[(size_t)lane * S + row] = mine;
    }
}
__device__ __forceinline__ void ph_topk(Frame& F, LAS unsigned char* lds, int e, const float* __restrict__ AFF, int* __restrict__ IDX, float* __restrict__ TOPW, int* __restrict__ SLOT) {
    LAS unsigned* hist = (LAS unsigned*)lds;
    LAS unsigned* shv = hist + 256;
    LAS unsigned* scan = hist + 512;
    OPAQUE_LANE(); (void)lane; const int tid = t_;
    const unsigned* vals = (const unsigned*)(AFF + (size_t)e * S);
    unsigned u[32];
#pragma unroll
    for (int i = 0; i < 8; ++i) { const u32x4 q = *(const u32x4*)(vals + tid * 32 + 4 * i); u[4 * i] = q.x; u[4 * i + 1] = q.y; u[4 * i + 2] = q.z; u[4 * i + 3] = q.w; }
    if (tid == 0) { shv[0] = 0u; shv[1] = CAP; }
    __syncthreads();
    for (int pass = 3; pass >= 0; --pass) {
        const int shift = pass * 8;
        const unsigned mask = pass == 3 ? 0u : (0xFFFFFFFFu << (shift + 8));
        if (tid < 256) hist[tid] = 0u;
        __syncthreads();
        const unsigned prefix = shv[0];
#pragma unroll
        for (int i = 0; i < 32; ++i) if ((u[i] & mask) == (prefix & mask)) __hip_atomic_fetch_add(&hist[(u[i] >> shift) & 255u], 1u, __ATOMIC_RELAXED, __HIP_MEMORY_SCOPE_WORKGROUP);
        __syncthreads();
        if (tid == 0) {
            unsigned kk = shv[1], cum = 0u; int b = 255;
            for (; b > 0; --b) { const unsigned hb = hist[b]; if (cum + hb >= kk) break; cum += hb; }
            shv[1] = kk - cum; shv[0] = prefix | ((unsigned)b << shift);
        }
        __syncthreads();
    }
    const unsigned T = shv[0], need_eq = shv[1];
    unsigned ceq = 0u;
#pragma unroll
    for (int i = 0; i < 32; ++i) ceq += (u[i] == T) ? 1u : 0u;
    scan[tid] = ceq; __syncthreads();
    for (int off = 1; off < 512; off <<= 1) { const unsigned tv = tid >= off ? scan[tid - off] : 0u; __syncthreads(); scan[tid] += tv; __syncthreads(); }
    unsigned eq_rank = scan[tid] - ceq;
    __syncthreads();
    unsigned selmask = 0u, csel = 0u;
#pragma unroll
    for (int i = 0; i < 32; ++i) { bool sel = u[i] > T; if (u[i] == T) { sel = eq_rank < need_eq; ++eq_rank; } if (sel) { selmask |= 1u << i; ++csel; } }
    scan[tid] = csel; __syncthreads();
    for (int off = 1; off < 512; off <<= 1) { const unsigned tv = tid >= off ? scan[tid - off] : 0u; __syncthreads(); scan[tid] += tv; __syncthreads(); }
    unsigned slot = scan[tid] - csel;
#pragma unroll
    for (int i = 0; i < 32; ++i) {
        const int t = tid * 32 + i; int sl = -1;
        if (selmask & (1u << i)) { sl = (int)slot; ++slot; if (sl < CAP) { IDX[e * CAP + sl] = t; TOPW[e * CAP + sl] = __uint_as_float(u[i]); } }
        SLOT[(size_t)e * S + t] = sl < CAP ? sl : -1;
    }
    __syncthreads();
}
__device__ __forceinline__ void ph_combine(Frame& F, const float* __restrict__ X1, const bf16_t* __restrict__ YE, const int* __restrict__ SLOT, const float* __restrict__ gate,
                                           float* __restrict__ xout, const float* __restrict__ w, const float* __restrict__ scale, const float* __restrict__ shift, bf16_t* __restrict__ HB, bool do_norm) {
    OPAQUE_LANE();
    const int gw = F.vcu * NWAVES + F.wave, NGW = F.G * NWAVES;
    for (int row = gw; row < S; row += NGW) {
        f32x4 acc[4];
#pragma unroll
        for (int j = 0; j < 4; ++j) acc[j] = f32x4{0.f, 0.f, 0.f, 0.f};
        const int myslot = lane < NE ? SLOT[(size_t)lane * S + row] : -1;
        for (int e = 0; e < NE; ++e) {
            const int sl = __builtin_amdgcn_readlane(myslot, e);
            if (sl >= 0) {
                const bf16_t* yr = YE + ((size_t)e * CAP + sl) * D + 4 * lane;
#pragma unroll
                for (int j = 0; j < 4; ++j) { const u32x2 q = *(const u32x2*)(yr + 256 * j);
                    acc[j].x += bflo(q.x); acc[j].y += bfhi(q.x); acc[j].z += bflo(q.y); acc[j].w += bfhi(q.y); }
            }
        }
        const f32x4* xr = (const f32x4*)(X1 + (size_t)row * D) + lane;
        f32x4 v[4], h[4]; float ss = 0.f;
#pragma unroll
        for (int j = 0; j < 4; ++j) { const f32x4 gv = *(const f32x4*)(gate + 4 * lane + 256 * j); v[j] = xr[64 * j] + gv * acc[j];
            ((f32x4*)(xout + (size_t)row * D) + lane)[64 * j] = v[j]; ss += (v[j].x * v[j].x + v[j].y * v[j].y) + (v[j].z * v[j].z + v[j].w * v[j].w); }
        if (do_norm) { ss = wave_sum(ss); norm_mod_row(v, ss, w, scale, shift, HB + (size_t)row * D, lane, h); }
    }
}

__global__ void __launch_bounds__(NWAVES * 64, 2) mega(Params p) {
    extern __shared__ __attribute__((aligned(16))) unsigned char lds[];
    Frame F;
    F.lds = (LAS unsigned char*)lds;
    volatile LAS unsigned* MISC = (volatile LAS unsigned*)(F.lds + MISC_OFF);
    F.tid = threadIdx.x; F.lane = F.tid & 63; F.wave = __builtin_amdgcn_readfirstlane(F.tid >> 6);
    F.G = gridDim.x; { const int bx = blockIdx.x; F.vcu = (F.G % 8 == 0) ? (bx % 8) * (F.G / 8) + bx / 8 : bx; }
    unsigned char* ws = p.ws;
    unsigned* ctl = (unsigned*)(ws + WS_CTL);
    for (int u = F.tid; u < (LDS_BYTES - LDSCTL_OFF) / 4; u += NWAVES * 64) ((LAS unsigned*)(F.lds + LDSCTL_OFF))[u] = 0u;
    __syncthreads();
    XcdBarrier bar = xcd_barrier_post(ctl + CW_BAR + p.li * XCD_BAR_WORDS, MISC + 8);
    const int lo = p.ph_lo, hi = p.ph_hi;
#define IN(k) (lo <= (k) && (k) < hi)
#define SEAM(k) do { if (IN(k) && IN((k) + 1)) xcd_barrier(bar); } while (0)
#define REFRESH() do { F.lane = lane_id_opaque(); F.tid = F.wave * 64 + F.lane; } while (0)

#define WSP(T, off) ((T*)(GAS T*)(wsl + (off)))
#define WSL() unsigned char* wsl = p.ws; asm volatile("" : "+s"(wsl))
    LAS float* scr = (LAS float*)(F.lds + RING_OFF + F.wave * 8704);

    if (IN(PH_PRO)) { REFRESH(); WSL();
        mod_units(F, p);
        for (int l = 0; l < NL; ++l) {
            conv_matrix(F, p.w_in + (size_t)l * D * INW, D, INW, WSP(bf16_t, WS_WIN) + (size_t)l * INW * D, scr);
            conv_matrix(F, p.w_ba + (size_t)l * 512 * D, 512, D, WSP(bf16_t, WS_WBA) + (size_t)l * D * 512, scr);
            conv_matrix(F, p.w_bh + (size_t)l * 512 * D, 512, D, WSP(bf16_t, WS_WBH) + (size_t)l * D * 512, scr);
            conv_matrix(F, p.w_out + (size_t)l * D * D, D, D, WSP(bf16_t, WS_WOUT) + (size_t)l * D * D, scr);
        }
        conv_experts(F, p, 0, scr);
        ph_rope_table(F, WSP(float, WS_ROPE));
    }
    SEAM(PH_PRO);
    if (IN(PH_NORM1)) { REFRESH(); WSL(); ph_norm1(F, p.x, p.norm_mix_w, WSP(float, WS_MOD) + 1 * D, WSP(float, WS_MOD) + 0 * D, WSP(bf16_t, WS_HB)); }
    SEAM(PH_NORM1);

    for (int l = 0; l < NL; ++l) {
        const int pb = PH_L0 + l * NPL;
        if (IN(pb + P_G1)) { WSL();
            pg8::Gemm g{WSP(bf16_t, WS_HB), WSP(bf16_t, WS_WIN) + (size_t)l * INW * D, S, INW, D}; pg8::StaticOrder So; So.init(S, INW, F.G, (int)blockIdx.x);
            pg8::EpiInproj E{WSP(bf16_t, WS_QR), WSP(bf16_t, WS_KR), WSP(bf16_t, WS_VV), WSP(bf16_t, WS_HQ), WSP(bf16_t, WS_KF), WSP(bf16_t, WS_HV), WSP(bf16_t, WS_HG), WSP(bf16_t, WS_GG), WSP(float, WS_LF), WSP(float, WS_LBV) + l * 1024};
            pg8::gemm_phase<pg8::EpiInproj, pg8::StaticOrder, true, true>(F.lds + RING_OFF, g, So, E, F.wave);
        }
        SEAM(pb + P_G1);
        if (IN(pb + P_QKP)) { WSL();
            ph_qkprep(F, WSP(bf16_t, WS_QR), WSP(bf16_t, WS_KR), p.q_norm_w + l * 64, p.k_norm_w + l * 64, WSP(float, WS_ROPE), WSP(bf16_t, WS_QN), WSP(bf16_t, WS_KN));
            for (int u = blockIdx.x; u < 256; u += F.G) hg::segment<false>(F.lds, u, WSP(bf16_t, WS_HQ), WSP(float, WS_LF), WSP(bf16_t, WS_KF), WSP(bf16_t, WS_HV), WSP(float, WS_HST), WSP(float, WS_HST + 16 * MiB), nullptr, F.wave);
        }
        SEAM(pb + P_QKP);
        if (IN(pb + P_HGB)) { WSL(); OPAQUE_LANE(); (void)lane;
            for (int gid = blockIdx.x * 512 + t_; gid < 8 * 16384; gid += F.G * 512) hg::carry(WSP(float, WS_HST), WSP(float, WS_HST + 16 * MiB), gid);
        }
        SEAM(pb + P_HGB);
        if (IN(pb + P_HGC)) { WSL();
            for (int u = blockIdx.x; u < 256; u += F.G) hg::segment<true>(F.lds, u, WSP(bf16_t, WS_HQ), WSP(float, WS_LF), WSP(bf16_t, WS_KF), WSP(bf16_t, WS_HV), WSP(float, WS_HST), WSP(float, WS_HST + 16 * MiB), WSP(float, WS_OF), F.wave);
        }
        SEAM(pb + P_HGC);
        if (IN(pb + P_ATT)) { WSL();
            ph_hgfin(F, WSP(float, WS_OF), WSP(bf16_t, WS_HG), p.hg_norm_w + l * 128, WSP(bf16_t, WS_OHG));
            const attn_body::AttnTensors AT{(const attn_body::bf16*)WSP(bf16_t, WS_QN), (const attn_body::bf16*)WSP(bf16_t, WS_KN), (const attn_body::bf16*)WSP(bf16_t, WS_VV), (attn_body::bf16*)WSP(bf16_t, WS_OATT)};
            const attn_body::StaticOrder So((int)F.G, (int)blockIdx.x);
            attn_body::attn_phase<attn_body::StaticOrder>((char*)lds + RING_OFF, AT, So, F.wave);
        }
        SEAM(pb + P_ATT);
        if (IN(pb + P_G2)) { WSL();
            { pg8::Gemm g{WSP(bf16_t, WS_OATT), WSP(bf16_t, WS_WBA) + (size_t)l * D * 512, S, D, 512}; pg8::StaticOrder So; So.init(S, D, F.G, (int)blockIdx.x);
              pg8::EpiBrA E{WSP(bf16_t, WS_GG), WSP(float, WS_MP)};
              pg8::gemm_phase<pg8::EpiBrA, pg8::StaticOrder, false, true>(F.lds + RING_OFF, g, So, E, F.wave); }
            __syncthreads();
            { pg8::Gemm g{WSP(bf16_t, WS_OHG), WSP(bf16_t, WS_WBH) + (size_t)l * D * 512, S, D, 512}; pg8::StaticOrder So; So.init(S, D, F.G, (int)blockIdx.x);
              pg8::EpiBrH E{WSP(bf16_t, WS_GG), WSP(float, WS_MP), WSP(bf16_t, WS_MG)};
              pg8::gemm_phase<pg8::EpiBrH, pg8::StaticOrder, false, true>(F.lds + RING_OFF, g, So, E, F.wave); }
        }
        SEAM(pb + P_G2);
        if (IN(pb + P_G3)) { WSL();
            pg8::Gemm g{WSP(bf16_t, WS_MG), WSP(bf16_t, WS_WOUT) + (size_t)l * D * D, S, D, D}; pg8::StaticOrder So; So.init(S, D, F.G, (int)blockIdx.x);
            pg8::EpiOut E{l == 0 ? p.x : WSP(float, WS_X2), WSP(float, WS_MOD) + l * 6 * D + 2 * D, WSP(float, WS_X1)};
            pg8::gemm_phase<pg8::EpiOut, pg8::StaticOrder, false, true>(F.lds + RING_OFF, g, So, E, F.wave);
        }
        SEAM(pb + P_G3);
        if (IN(pb + P_N2R)) { WSL();
            ph_norm2_router(F, WSP(float, WS_X1), p.norm_ffn_w + l * D, WSP(float, WS_MOD) + l * 6 * D + 4 * D, WSP(float, WS_MOD) + l * 6 * D + 3 * D, p.w_router + (size_t)l * D * NE, WSP(bf16_t, WS_HB), WSP(float, WS_AFF));
        }
        SEAM(pb + P_N2R);
        if (IN(pb + P_TOPK)) { WSL();
            for (int e = blockIdx.x; e < NE; e += F.G) ph_topk(F, F.lds, e, WSP(float, WS_AFF), WSP(int, WS_IDX), WSP(float, WS_TOPW), WSP(int, WS_SLOT));
        }
        SEAM(pb + P_TOPK);
        if (IN(pb + P_GATH)) { REFRESH(); WSL(); ph_gather(F, WSP(bf16_t, WS_HB), WSP(int, WS_IDX), WSP(bf16_t, WS_XE)); }
        SEAM(pb + P_GATH);
        if (IN(pb + P_G4)) { WSL();
            pg8::Gemm g{WSP(bf16_t, WS_XE), WSP(bf16_t, WS_WGU), NE * CAP, NE * 4096, D}; pg8::GroupOrder So; So.init(16, F.G, (int)blockIdx.x);
            pg8::EpiGU E{WSP(bf16_t, WS_HID)};
            pg8::gemm_phase<pg8::EpiGU, pg8::GroupOrder, true, true>(F.lds + RING_OFF, g, So, E, F.wave);
        }
        SEAM(pb + P_G4);
        if (IN(pb + P_G5)) { WSL();
            pg8::Gemm g{WSP(bf16_t, WS_HID), WSP(bf16_t, WS_WD), NE * CAP, NE * 1024, FF}; pg8::GroupOrder So; So.init(4, F.G, (int)blockIdx.x);
            pg8::EpiDown E{WSP(bf16_t, WS_YE), WSP(float, WS_TOPW)};
            pg8::gemm_phase<pg8::EpiDown, pg8::GroupOrder, true, true>(F.lds + RING_OFF, g, So, E, F.wave);
        }
        SEAM(pb + P_G5);
        if (IN(pb + P_COMB)) { WSL();
            const bool last = (l + 1 == NL); const int ln = last ? l : l + 1;
            ph_combine(F, WSP(float, WS_X1), WSP(bf16_t, WS_YE), WSP(int, WS_SLOT), WSP(float, WS_MOD) + l * 6 * D + 5 * D, last ? p.out : WSP(float, WS_X2),
                       p.norm_mix_w + ln * D, WSP(float, WS_MOD) + ln * 6 * D + 1 * D, WSP(float, WS_MOD) + ln * 6 * D + 0 * D, WSP(bf16_t, WS_HB), !last);
            if (!last) { REFRESH(); conv_experts(F, p, l + 1, scr); }
        }
        SEAM(pb + P_COMB);
    }
#undef IN
#undef SEAM
}

#ifndef N_LAUNCH_MODE
#define N_LAUNCH_MODE 1
#endif
static int g_grid = 0;
extern "C" void kernel_launch(void* const* d_in, const int* in_sizes, int n_in, void* d_out, int out_size, void* d_ws, size_t ws_size, hipStream_t stream) {
    if (n_in != 18 || out_size != S * D || ws_size < WS_END) { fprintf(stderr, "kernel_launch: unexpected shapes (n_in %d out %d ws %zu)\n", n_in, out_size, ws_size); return; }
    if (g_grid == 0) {
        int dev = 0, cus = 0;
        if (hipGetDevice(&dev) != hipSuccess || hipDeviceGetAttribute(&cus, hipDeviceAttributeMultiprocessorCount, dev) != hipSuccess) { g_grid = -1; return; }
        if (hipFuncSetAttribute((const void*)mega, hipFuncAttributeMaxDynamicSharedMemorySize, LDS_BYTES) != hipSuccess) { g_grid = -1; return; }
        int per_cu = 0;
        if (hipOccupancyMaxActiveBlocksPerMultiprocessor(&per_cu, (const void*)mega, NWAVES * 64, LDS_BYTES) != hipSuccess || per_cu < 1) { fprintf(stderr, "occupancy query: %d\n", per_cu); }
        (void)hipGetLastError();
        g_grid = cus;
    }
    if (g_grid < 0) return;
    unsigned char* ws = (unsigned char*)d_ws;
    (void)hipMemsetAsync(ws + WS_CTL, 0, 1 * MiB, stream);
    Params p{};
    p.x = (const float*)d_in[0]; p.c = (const float*)d_in[1]; p.ada_w = (const float*)d_in[2]; p.ada_b = (const float*)d_in[3]; p.norm_mix_w = (const float*)d_in[4];
    p.norm_ffn_w = (const float*)d_in[5]; p.w_in = (const float*)d_in[6]; p.q_norm_w = (const float*)d_in[7]; p.k_norm_w = (const float*)d_in[8]; p.hlb = (const float*)d_in[9];
    p.hg_norm_w = (const float*)d_in[10]; p.w_ba = (const float*)d_in[11]; p.w_bh = (const float*)d_in[12]; p.w_out = (const float*)d_in[13]; p.w_router = (const float*)d_in[14];
    p.w_eg = (const float*)d_in[15]; p.w_eu = (const float*)d_in[16]; p.w_ed = (const float*)d_in[17];
    p.out = (float*)d_out; p.ws = ws;
#if N_LAUNCH_MODE == 1
    p.ph_lo = 0; p.ph_hi = PH_END; p.li = 0; p.pad = 0;
    hipLaunchKernelGGL(mega, dim3(g_grid), dim3(NWAVES * 64), LDS_BYTES, stream, p);
#else
    for (int k = 0; k < PH_END; ++k) { p.ph_lo = k; p.ph_hi = k + 1; p.li = k; p.pad = 0; hipLaunchKernelGGL(mega, dim3(g_grid), dim3(NWAVES * 64), LDS_BYTES, stream, p); }
#endif
}
```

```cpp
#include <hip/hip_runtime.h>
#include <cstdio>
#include <cstdint>

typedef unsigned short bf16_t;
typedef float f32x4 __attribute__((ext_vector_type(4)));
typedef float f32x16 __attribute__((ext_vector_type(16)));
typedef unsigned u32x4 __attribute__((ext_vector_type(4)));
typedef unsigned u32x2 __attribute__((ext_vector_type(2)));

constexpr int S = 16384, D = 1024, NL = 2, INW = 5376;
constexpr int NE = 16, CAP = 2048, FF = 2048;
constexpr float EPS = 1e-6f;
constexpr float C2 = 0.125f * 1.4426950408889634f;
constexpr int C_AQ = 0, C_AK = 512, C_AV = 640, C_HQ = 768, C_ZF = 1280, C_ZB = 1792, C_HI = 2304, C_HGT = 2816, C_GL = 3328;

constexpr size_t MiB = 1u << 20;
constexpr size_t WS_CTL = 0;
constexpr size_t WS_MOD = 1 * MiB;
constexpr size_t WS_LBV = WS_MOD + 64 * 1024;
constexpr size_t WS_IDX = WS_MOD + 128 * 1024;
constexpr size_t WS_TOPW = WS_IDX + 128 * 1024;
constexpr size_t WS_ROPE = WS_MOD + 512 * 1024;
constexpr size_t WS_AFF = 2 * MiB;
constexpr size_t WS_SLOT = 3 * MiB;
constexpr size_t WS_HB = 4 * MiB;
constexpr size_t WS_QR = 36 * MiB;
constexpr size_t WS_KR = 52 * MiB;
constexpr size_t WS_VV = 56 * MiB;
constexpr size_t WS_QN = 60 * MiB;
constexpr size_t WS_KN = 76 * MiB;
constexpr size_t WS_HQ = 80 * MiB;
constexpr size_t WS_LF = 96 * MiB;
constexpr size_t WS_KF = 160 * MiB;
constexpr size_t WS_HV = 192 * MiB;
constexpr size_t WS_HG = 208 * MiB;
constexpr size_t WS_GG = 224 * MiB;
constexpr size_t WS_OATT = 288 * MiB;
constexpr size_t WS_OF = 304 * MiB;
constexpr size_t WS_OHG = 368 * MiB;
constexpr size_t WS_MP = 384 * MiB;
constexpr size_t WS_MG = 448 * MiB;
constexpr size_t WS_XE = 36 * MiB;
constexpr size_t WS_HID = 100 * MiB;
constexpr size_t WS_YE = 228 * MiB;
constexpr size_t WS_X1 = 480 * MiB;
constexpr size_t WS_X2 = 544 * MiB;
constexpr size_t WS_WIN = 608 * MiB;
constexpr size_t WS_WBA = 630 * MiB;
constexpr size_t WS_WBH = 632 * MiB;
constexpr size_t WS_WOUT = 634 * MiB;
constexpr size_t WS_WGU = 638 * MiB;
constexpr size_t WS_WD = 766 * MiB;
constexpr size_t WS_HST = 830 * MiB;
constexpr size_t WS_END = 900 * MiB;
static_assert(WS_END <= 1024 * MiB, "workspace");

__device__ __forceinline__ float bf2f(bf16_t v) { return __uint_as_float((unsigned)v << 16); }
__device__ __forceinline__ bf16_t f2bf(float f) { unsigned u = __float_as_uint(f); return (bf16_t)((u + 0x7fffu + ((u >> 16) & 1u)) >> 16); }
__device__ __forceinline__ unsigned pk2(float lo, float hi) { return (unsigned)f2bf(lo) | ((unsigned)f2bf(hi) << 16); }
__device__ __forceinline__ float bflo(unsigned w) { return __uint_as_float(w << 16); }
__device__ __forceinline__ float bfhi(unsigned w) { return __uint_as_float(w & 0xffff0000u); }
__device__ __forceinline__ float sigmoidf_(float v) { return __builtin_amdgcn_rcpf(1.0f + __expf(-v)); }
__device__ __forceinline__ float siluf_(float v) { return v * __builtin_amdgcn_rcpf(1.0f + __expf(-v)); }
__device__ __forceinline__ float wave_sum(float v) {
#pragma unroll
    for (int o = 1; o < 64; o <<= 1) v += __shfl_xor(v, o);
    return v;
}
__device__ __forceinline__ int crow(int r, int hi) { return (r & 3) + 8 * (r >> 2) + 4 * hi; }
__device__ __forceinline__ int lane_id_opaque() { int l; asm volatile("v_mbcnt_lo_u32_b32 %0, -1, 0\n\tv_mbcnt_hi_u32_b32 %0, -1, %0" : "=v"(l)); return l; }

#define GAS __attribute__((address_space(1)))
#define LAS __attribute__((address_space(3)))

namespace pg8 {
#define PG8_LAS __attribute__((address_space(3)))
typedef unsigned short bf16_t;
typedef short bf16x8 __attribute__((ext_vector_type(8)));
typedef float f32x4 __attribute__((ext_vector_type(4)));
typedef unsigned u32x4 __attribute__((ext_vector_type(4)));
constexpr int BM = 256, BK = 64, HALF = 128, HTB = HALF * BK * 2  , STAGE_BYTES = 8 * HTB, NXCD = 8, WGM = 8;

__host__ __device__ __forceinline__ int lds_byte(int r, int c) { const int st = (r >> 4) * 2 + (c >> 5), rr = r & 15, cc = c & 31, ob = rr * 64 + cc * 2; return st * 1024 + (ob ^ (((ob >> 9) & 1) << 5)); }
__host__ __device__ __forceinline__ void stage_rc(int b, int& R, int& C) { const int st = b / 1024, sb = b % 1024, swz = sb ^ (((sb >> 9) & 1) << 5); R = (st >> 1) * 16 + swz / 64; C = (st & 1) * 32 + (swz % 64) / 2; }
__host__ __device__ __forceinline__ int perm32(int rho) { const int n = rho >> 4, i = rho & 15; return 8 * (i >> 2) + 4 * n + (i & 3); }

struct Unit { int pm, pn, pb; };
struct Gemm { const bf16_t* A; const bf16_t* Bt; int M, N, K; };

struct StaticOrder {
    int nM, nN, nwg, G, c;
    __host__ __device__ void init(int M, int N, int G_, int c_) { nM = M / BM; nN = N / BM; nwg = nM * nN; G = G_; c = c_; }
    __host__ __device__ bool next(int i, Unit& u) const {
        const long L = (long)i * G + c; if (L >= nwg) return false;
        int wgid = (int)L; { const int q = nwg / NXCD, r = nwg % NXCD, xcd = wgid % NXCD, off = wgid / NXCD; wgid = (xcd < r ? xcd * (q + 1) : r * (q + 1) + (xcd - r) * q) + off; }
        const int nig = WGM * nN, gid = wgid / nig, fm = gid * WGM, gsz = (nM - fm) < WGM ? (nM - fm) : WGM;
        u.pm = fm + ((wgid % nig) % gsz); u.pn = (wgid % nig) / gsz; u.pb = u.pn; return true;
    }
    __device__ __forceinline__ void a_ready(const Unit&) const {}
    __device__ __forceinline__ void done(const Unit&) const {}
};

typedef float f32x2_c __attribute__((ext_vector_type(2))); typedef __bf16 bf16x2_c __attribute__((ext_vector_type(2)));
__device__ __forceinline__ unsigned cvt_pk_bf16(float lo, float hi) { f32x2_c v = {lo, hi}; bf16x2_c b = __builtin_convertvector(v, bf16x2_c); return __builtin_bit_cast(unsigned, b); }

typedef unsigned u32x2 __attribute__((ext_vector_type(2)));
__device__ __forceinline__ float e_bflo(unsigned w) { return __uint_as_float(w << 16); }
__device__ __forceinline__ float e_bfhi(unsigned w) { return __uint_as_float(w & 0xffff0000u); }
__device__ __forceinline__ float e_sig(float v) { return __builtin_amdgcn_rcpf(1.0f + __expf(-v)); }
__device__ __forceinline__ u32x4 pack8(const f32x4 a, const f32x4 b) { u32x4 w; w.x = cvt_pk_bf16(a[0], a[1]); w.y = cvt_pk_bf16(a[2], a[3]); w.z = cvt_pk_bf16(b[0], b[1]); w.w = cvt_pk_bf16(b[2], b[3]); return w; }

struct EpiInproj {
    static constexpr bool PERM = true, AFTER_DRAIN = false;
    bf16_t *QR, *KR, *VV, *HQ, *KF, *HV, *HG, *GG; float* LF; const float* lbv;
    __device__ __forceinline__ void operator()(const f32x4 (&acc)[2][2][4][2], const Unit& u, int wr, int wc, int fr, int fq) const {
        const int row0 = u.pm * BM + wr * 64 + fr, cl = wc * 32 + 8 * fq;
#pragma unroll
        for (int bj = 0; bj < 2; ++bj) {
            const int colg = u.pn * BM + bj * HALF;
            int kind; bf16_t* dst; int pitch, c0; int dir = 0;
            if (colg < 512) { kind = 0; dst = QR; pitch = 512; c0 = colg; }
            else if (colg < 640) { kind = 0; dst = KR; pitch = 128; c0 = colg - 512; }
            else if (colg < 768) { kind = 0; dst = VV; pitch = 128; c0 = colg - 640; }
            else if (colg < 1280) { kind = 1; dst = HQ; pitch = 512; c0 = colg - 768; }
            else if (colg < 2304) { kind = 3; dir = colg >= 1792; dst = KF + (size_t)dir * 16384 * 512; pitch = 512; c0 = colg - (dir ? 1792 : 1280); }
            else if (colg < 2816) { kind = 0; dst = HV; pitch = 512; c0 = colg - 2304; }
            else if (colg < 3328) { kind = 1; dst = HG; pitch = 512; c0 = colg - 2816; }
            else { kind = 2; dst = GG; pitch = 2048; c0 = colg - 3328; }
            c0 += cl;
            if (kind == 0) {
#pragma unroll
                for (int ai = 0; ai < 2; ++ai)
#pragma unroll
                    for (int m = 0; m < 4; ++m) *(u32x4*)(dst + (size_t)(row0 + ai * HALF + m * 16) * pitch + c0) = pack8(acc[ai][bj][m][0], acc[ai][bj][m][1]);
            } else if (kind == 1) {
#pragma unroll
                for (int ai = 0; ai < 2; ++ai)
#pragma unroll
                    for (int m = 0; m < 4; ++m) { f32x4 a = acc[ai][bj][m][0], b = acc[ai][bj][m][1];
#pragma unroll
                        for (int i = 0; i < 4; ++i) { a[i] = a[i] * e_sig(a[i]); b[i] = b[i] * e_sig(b[i]); }
                        *(u32x4*)(dst + (size_t)(row0 + ai * HALF + m * 16) * pitch + c0) = pack8(a, b); }
            } else if (kind == 2) {
#pragma unroll
                for (int ai = 0; ai < 2; ++ai)
#pragma unroll
                    for (int m = 0; m < 4; ++m) { f32x4 a = acc[ai][bj][m][0], b = acc[ai][bj][m][1];
#pragma unroll
                        for (int i = 0; i < 4; ++i) { a[i] = e_sig(a[i]); b[i] = e_sig(b[i]); }
                        *(u32x4*)(dst + (size_t)(row0 + ai * HALF + m * 16) * pitch + c0) = pack8(a, b); }
            } else {
                const f32x4 lb0 = *(const f32x4*)(lbv + dir * 512 + c0), lb1 = *(const f32x4*)(lbv + dir * 512 + c0 + 4);
                float* lf = LF + (size_t)dir * 16384 * 512;
#pragma unroll
                for (int ai = 0; ai < 2; ++ai)
#pragma unroll
                    for (int m = 0; m < 4; ++m) { const f32x4 a = acc[ai][bj][m][0], b = acc[ai][bj][m][1]; f32x4 la, lb_, ka, kb;
#pragma unroll
                        for (int i = 0; i < 4; ++i) {
                            const float sa = e_sig(a[i]), sb = e_sig(b[i]);
                            la[i] = __logf(fmaxf(lb0[i] + (1.0f - lb0[i]) * sa, 1e-6f)); ka[i] = (1.0f - lb0[i]) * (1.0f - sa);
                            lb_[i] = __logf(fmaxf(lb1[i] + (1.0f - lb1[i]) * sb, 1e-6f)); kb[i] = (1.0f - lb1[i]) * (1.0f - sb); }
                        const size_t o = (size_t)(row0 + ai * HALF + m * 16) * 512 + c0;
                        *(f32x4*)(lf + o) = la; *(f32x4*)(lf + o + 4) = lb_;
                        *(u32x4*)(dst + o) = pack8(ka, kb); }
            }
        }
    }
};
struct EpiBrA {
    static constexpr bool PERM = true, AFTER_DRAIN = false;
    const bf16_t* GG; float* MP;
    __device__ __forceinline__ void operator()(const f32x4 (&acc)[2][2][4][2], const Unit& u, int wr, int wc, int fr, int fq) const {
        const int row0 = u.pm * BM + wr * 64 + fr, col0 = u.pn * BM + wc * 32 + 8 * fq;
#pragma unroll
        for (int ai = 0; ai < 2; ++ai)
#pragma unroll
            for (int m = 0; m < 4; ++m) { const size_t r = (size_t)(row0 + ai * HALF + m * 16);
#pragma unroll
                for (int bj = 0; bj < 2; ++bj) { const int c = col0 + bj * HALF; const u32x4 g = *(const u32x4*)(GG + r * 2048 + c);
                    f32x4 a = acc[ai][bj][m][0], b = acc[ai][bj][m][1];
                    a[0] *= e_bflo(g.x); a[1] *= e_bfhi(g.x); a[2] *= e_bflo(g.y); a[3] *= e_bfhi(g.y); b[0] *= e_bflo(g.z); b[1] *= e_bfhi(g.z); b[2] *= e_bflo(g.w); b[3] *= e_bfhi(g.w);
                    *(f32x4*)(MP + r * 1024 + c) = a; *(f32x4*)(MP + r * 1024 + c + 4) = b; } }
    }
};
struct EpiBrH {
    static constexpr bool PERM = true, AFTER_DRAIN = false;
    const bf16_t* GG; const float* MP; bf16_t* MG;
    __device__ __forceinline__ void operator()(const f32x4 (&acc)[2][2][4][2], const Unit& u, int wr, int wc, int fr, int fq) const {
        const int row0 = u.pm * BM + wr * 64 + fr, col0 = u.pn * BM + wc * 32 + 8 * fq;
#pragma unroll
        for (int ai = 0; ai < 2; ++ai)
#pragma unroll
            for (int m = 0; m < 4; ++m) { const size_t r = (size_t)(row0 + ai * HALF + m * 16);
#pragma unroll
                for (int bj = 0; bj < 2; ++bj) { const int c = col0 + bj * HALF; const u32x4 g = *(const u32x4*)(GG + r * 2048 + 1024 + c);
                    f32x4 a = acc[ai][bj][m][0], b = acc[ai][bj][m][1]; const f32x4 pa = *(const f32x4*)(MP + r * 1024 + c), pb = *(const f32x4*)(MP + r * 1024 + c + 4);
                    a[0] = pa[0] + a[0] * e_bflo(g.x); a[1] = pa[1] + a[1] * e_bfhi(g.x); a[2] = pa[2] + a[2] * e_bflo(g.y); a[3] = pa[3] + a[3] * e_bfhi(g.y);
                    b[0] = pb[0] + b[0] * e_bflo(g.z); b[1] = pb[1] + b[1] * e_bfhi(g.z); b[2] = pb[2] + b[2] * e_bflo(g.w); b[3] = pb[3] + b[3] * e_bfhi(g.w);
                    *(u32x4*)(MG + r * 1024 + c) = pack8(a, b); } }
    }
};
struct EpiOut {
    static constexpr bool PERM = true, AFTER_DRAIN = false;
    const float* xin; const float* gate; float* X1;
    __device__ __forceinline__ void operator()(const f32x4 (&acc)[2][2][4][2], const Unit& u, int wr, int wc, int fr, int fq) const {
        const int row0 = u.pm * BM + wr * 64 + fr, col0 = u.pn * BM + wc * 32 + 8 * fq;
#pragma unroll
        for (int bj = 0; bj < 2; ++bj) { const int c = col0 + bj * HALF; const f32x4 g0 = *(const f32x4*)(gate + c), g1 = *(const f32x4*)(gate + c + 4);
#pragma unroll
            for (int ai = 0; ai < 2; ++ai)
#pragma unroll
                for (int m = 0; m < 4; ++m) { const size_t o = (size_t)(row0 + ai * HALF + m * 16) * 1024 + c;
                    *(f32x4*)(X1 + o) = *(const f32x4*)(xin + o) + g0 * acc[ai][bj][m][0]; *(f32x4*)(X1 + o + 4) = *(const f32x4*)(xin + o + 4) + g1 * acc[ai][bj][m][1]; } }
    }
};
struct EpiGU {
    static constexpr bool PERM = true, AFTER_DRAIN = false;
    bf16_t* HID;
    __device__ __forceinline__ void operator()(const f32x4 (&acc)[2][2][4][2], const Unit& u, int wr, int wc, int fr, int fq) const {
        const int row0 = u.pm * BM + wr * 64 + fr, col0 = u.pn * HALF + wc * 32 + 8 * fq;
#pragma unroll
        for (int ai = 0; ai < 2; ++ai)
#pragma unroll
            for (int m = 0; m < 4; ++m) { f32x4 a = acc[ai][0][m][0], b = acc[ai][0][m][1]; const f32x4 ua = acc[ai][1][m][0], ub = acc[ai][1][m][1];
#pragma unroll
                for (int i = 0; i < 4; ++i) { a[i] = a[i] * e_sig(a[i]) * ua[i]; b[i] = b[i] * e_sig(b[i]) * ub[i]; }
                *(u32x4*)(HID + (size_t)(row0 + ai * HALF + m * 16) * 2048 + col0) = pack8(a, b); }
    }
};
struct EpiDown {
    static constexpr bool PERM = true, AFTER_DRAIN = false;
    bf16_t* YE; const float* topw;
    __device__ __forceinline__ void operator()(const f32x4 (&acc)[2][2][4][2], const Unit& u, int wr, int wc, int fr, int fq) const {
        const int row0 = u.pm * BM + wr * 64 + fr, col0 = u.pn * BM + wc * 32 + 8 * fq;
#pragma unroll
        for (int ai = 0; ai < 2; ++ai)
#pragma unroll
            for (int m = 0; m < 4; ++m) { const int r = row0 + ai * HALF + m * 16; const float w = topw[r];
#pragma unroll
                for (int bj = 0; bj < 2; ++bj) *(u32x4*)(YE + (size_t)r * 1024 + col0 + bj * HALF) = pack8(acc[ai][bj][m][0] * w, acc[ai][bj][m][1] * w); }
    }
};
struct GroupOrder {
    int nNe, nwg, G, c;
    __device__ void init(int nNe_, int G_, int c_) { nNe = nNe_; nwg = 16 * 8 * nNe_; G = G_; c = c_; }
    __device__ bool next(int i, Unit& u) const {
        const long L = (long)i * G + c; if (L >= nwg) return false;
        int wgid = (int)L; { const int q = nwg / NXCD, xcd = wgid % NXCD, off = wgid / NXCD; wgid = xcd * q + off; }
        const int per = 8 * nNe, e = wgid / per, w = wgid % per;
        u.pm = e * 8 + (w & 7); u.pn = w >> 3; u.pb = e * nNe + u.pn; return true;
    }
    __device__ __forceinline__ void a_ready(const Unit&) const {}
    __device__ __forceinline__ void done(const Unit&) const {}
};

template <class Epi, class Sched, bool ALIGN_EPI = false, bool SP2 = false>
__device__ __forceinline__ void gemm_phase(PG8_LAS unsigned char* lds, const Gemm g, const Sched& S, const Epi& E, int wave_) {
    const int tid_ = wave_ * 64 + lane_id_opaque();
    const int tid = tid_, wid = __builtin_amdgcn_readfirstlane(tid >> 6), lane = tid & 63, wr = wid >> 2, wc = wid & 3, fr = lane & 15, fq = lane >> 4;
    int K_ = g.K; asm volatile("" : "+s"(K_));
    const int K = K_, nt = K / BK;
    unsigned voffA[2], voffB[2];
#pragma unroll
    for (int i = 0; i < 2; ++i) { int R, C; stage_rc(tid * 16 + i * 8192, R, C); const int Rb = Epi::PERM ? ((R & ~31) + perm32(R & 31)) : R;
        voffA[i] = (unsigned)(R * K + C) * 2u; voffB[i] = (unsigned)(Rb * K + C) * 2u; }
    const size_t kstep = (size_t)(BK * 2);
    const size_t hstep = (size_t)HALF * K * 2;
    const size_t tstep = 2 * hstep;
    const unsigned ldsw = (unsigned)wid * 1024u;
    const int aoff = lds_byte(wr * 64 + fr, fq * 8), boff = lds_byte(wc * 32 + fr, fq * 8);
#define PG8_SA(b, h) (((b) * 2 + (h)) * HTB)
#define PG8_SB(b, h) ((4 + (b) * 2 + (h)) * HTB)
#define PG8_STAGE(bufoff, gbase, voff) do { _Pragma("unroll") for (int _i = 0; _i < 2; ++_i) \
        __builtin_amdgcn_global_load_lds((const unsigned*)((const char*)(gbase) + (voff)[_i]), (PG8_LAS unsigned*)(lds + (bufoff) + ldsw + _i * 8192), 16, 0, 0); } while (0)
#define PG8_LDA(dst, b, h) do { _Pragma("unroll") for (int m = 0; m < 4; ++m) _Pragma("unroll") for (int k = 0; k < 2; ++k) dst[m][k] = *(const PG8_LAS bf16x8*)(lds + PG8_SA(b, h) + aoff + m * 2048 + k * 1024); } while (0)
#define PG8_LDB(dst, b, h) do { _Pragma("unroll") for (int n = 0; n < 2; ++n) _Pragma("unroll") for (int k = 0; k < 2; ++k) dst[n][k] = *(const PG8_LAS bf16x8*)(lds + PG8_SB(b, h) + boff + n * 2048 + k * 1024); } while (0)
#define PG8_MMA(ai, bj, At, Bt) do { __builtin_amdgcn_s_setprio(1); _Pragma("unroll") for (int m = 0; m < 4; ++m) _Pragma("unroll") for (int n = 0; n < 2; ++n) _Pragma("unroll") for (int k = 0; k < 2; ++k) \
        acc[ai][bj][m][n] = __builtin_amdgcn_mfma_f32_16x16x32_bf16(Bt[n][k], At[m][k], acc[ai][bj][m][n], 0, 0, 0); __builtin_amdgcn_s_setprio(0); } while (0)
#define PG8_WAIT_V(n) asm volatile("s_waitcnt vmcnt(" #n ")" ::: "memory")
#define PG8_WAIT_L(n) asm volatile("s_waitcnt lgkmcnt(" #n ")" ::: "memory")
#define PG8_BAR __builtin_amdgcn_s_barrier()
#define PG8_SCHED __builtin_amdgcn_sched_barrier(0)
    Unit cur, nxt; int ui = 0;
    if (!S.next(0, cur)) return;
    f32x4 acc[2][2][4][2];
#pragma unroll
    for (int a = 0; a < 2; ++a)
#pragma unroll
        for (int b = 0; b < 2; ++b)
#pragma unroll
            for (int m = 0; m < 4; ++m)
#pragma unroll
                for (int n = 0; n < 2; ++n) acc[a][b][m][n] = (f32x4){0.f, 0.f, 0.f, 0.f};
    bf16x8 At[4][2], B0[2][2], B1[2][2];
    const char* cA = (const char*)g.A + (size_t)cur.pm * tstep; const char* cB = (const char*)g.Bt + (size_t)cur.pb * tstep;
    S.a_ready(cur);
    if constexpr (SP2) {
        PG8_STAGE(PG8_SB(0, 0), cB, voffB); PG8_STAGE(PG8_SB(0, 1), cB + hstep, voffB); PG8_STAGE(PG8_SA(0, 0), cA, voffA); PG8_STAGE(PG8_SA(0, 1), cA + hstep, voffA);
        if (wr == 1) PG8_BAR;
        PG8_WAIT_V(2); PG8_BAR;
        PG8_STAGE(PG8_SB(1, 0), cB + kstep, voffB); PG8_STAGE(PG8_SA(1, 0), cA + kstep, voffA); PG8_STAGE(PG8_SB(1, 1), cB + hstep + kstep, voffB);
        PG8_WAIT_V(6); PG8_BAR;
    } else {
        PG8_STAGE(PG8_SB(0, 0), cB, voffB); PG8_STAGE(PG8_SA(0, 0), cA, voffA); PG8_STAGE(PG8_SB(0, 1), cB + hstep, voffB); PG8_STAGE(PG8_SA(0, 1), cA + hstep, voffA);
        if (wr == 1) PG8_BAR;
        PG8_WAIT_V(4); PG8_BAR;
        PG8_STAGE(PG8_SB(1, 0), cB + kstep, voffB); PG8_STAGE(PG8_SA(1, 0), cA + kstep, voffA); PG8_STAGE(PG8_SB(1, 1), cB + hstep + kstep, voffB);
        PG8_WAIT_V(6); PG8_BAR;
    }
    for (;;) {
        const bool has_next = S.next(ui + 1, nxt);
        const char* nA = has_next ? (const char*)g.A + (size_t)nxt.pm * tstep : cA; const char* nB = has_next ? (const char*)g.Bt + (size_t)nxt.pb * tstep : cB;
#pragma unroll 1
        for (int t = 0; t < nt; t += 2) {
            const bool last = (t == nt - 2);
            const char* a1 = cA + (size_t)(t + 1) * kstep;
            const char* a2 = last ? nA : cA + (size_t)(t + 2) * kstep; const char* b2 = last ? nB : cB + (size_t)(t + 2) * kstep;
            const char* a3 = a2 + kstep; const char* b3 = b2 + kstep;
            if (last && has_next) S.a_ready(nxt);
            if constexpr (SP2) {
            PG8_LDB(B0, 0, 0); PG8_LDB(B1, 0, 1); PG8_SCHED; PG8_LDA(At, 0, 0); PG8_STAGE(PG8_SA(1, 1), a1 + hstep, voffA);
            PG8_WAIT_V(8); PG8_WAIT_L(0); PG8_BAR; PG8_MMA(0, 0, At, B0); PG8_MMA(0, 1, At, B1); PG8_BAR; PG8_SCHED;
            PG8_LDA(At, 0, 1); PG8_STAGE(PG8_SB(0, 0), b2, voffB); PG8_STAGE(PG8_SB(0, 1), b2 + hstep, voffB); PG8_STAGE(PG8_SA(0, 0), a2, voffA);
            PG8_WAIT_V(8); PG8_WAIT_L(0); PG8_BAR; PG8_MMA(1, 0, At, B0); PG8_MMA(1, 1, At, B1); PG8_BAR; PG8_SCHED;
            PG8_LDB(B0, 1, 0); PG8_LDB(B1, 1, 1); PG8_SCHED; PG8_LDA(At, 1, 0); PG8_STAGE(PG8_SA(0, 1), a2 + hstep, voffA);
            PG8_WAIT_V(8); PG8_WAIT_L(0); PG8_BAR; PG8_MMA(0, 0, At, B0); PG8_MMA(0, 1, At, B1); PG8_BAR; PG8_SCHED;
            PG8_LDA(At, 1, 1); PG8_STAGE(PG8_SB(1, 0), b3, voffB); PG8_STAGE(PG8_SB(1, 1), b3 + hstep, voffB); PG8_STAGE(PG8_SA(1, 0), a3, voffA);
            PG8_WAIT_V(8); PG8_WAIT_L(0); PG8_BAR; PG8_MMA(1, 0, At, B0); PG8_MMA(1, 1, At, B1); PG8_BAR; PG8_SCHED;
            } else {
            PG8_LDB(B0, 0, 0); PG8_SCHED; PG8_LDA(At, 0, 0); PG8_STAGE(PG8_SA(1, 1), a1 + hstep, voffA);
            PG8_WAIT_L(8); PG8_BAR; PG8_WAIT_L(0); PG8_MMA(0, 0, At, B0); PG8_BAR; PG8_SCHED;
            PG8_LDB(B1, 0, 1); PG8_STAGE(PG8_SB(0, 0), b2, voffB);
            PG8_BAR; PG8_WAIT_L(0); PG8_MMA(0, 1, At, B1); PG8_BAR;
            PG8_LDA(At, 0, 1); PG8_STAGE(PG8_SA(0, 0), a2, voffA);
            PG8_BAR; PG8_WAIT_L(0); PG8_MMA(1, 0, At, B0); PG8_BAR; PG8_SCHED;
            PG8_STAGE(PG8_SB(0, 1), b2 + hstep, voffB);
            PG8_WAIT_V(6); PG8_BAR; PG8_MMA(1, 1, At, B1); PG8_BAR;
            PG8_LDB(B0, 1, 0); PG8_SCHED; PG8_LDA(At, 1, 0); PG8_STAGE(PG8_SA(0, 1), a2 + hstep, voffA);
            PG8_WAIT_L(8); PG8_BAR; PG8_WAIT_L(0); PG8_MMA(0, 0, At, B0); PG8_BAR; PG8_SCHED;
            PG8_LDB(B1, 1, 1); PG8_STAGE(PG8_SB(1, 0), b3, voffB);
            PG8_BAR; PG8_WAIT_L(0); PG8_MMA(0, 1, At, B1); PG8_BAR;
            PG8_LDA(At, 1, 1); PG8_STAGE(PG8_SA(1, 0), a3, voffA);
            PG8_BAR; PG8_WAIT_L(0); PG8_MMA(1, 0, At, B0); PG8_BAR; PG8_SCHED;
            PG8_STAGE(PG8_SB(1, 1), b3 + hstep, voffB);
            PG8_WAIT_V(6); PG8_BAR; PG8_MMA(1, 1, At, B1); PG8_BAR;
            }
        }
        if constexpr (ALIGN_EPI) { if (wr == 0) PG8_BAR; }
        if constexpr (!Epi::AFTER_DRAIN) { E(acc, cur, wr, wc, fr, fq); S.done(cur); }
        if (!has_next) break;
#pragma unroll
        for (int a = 0; a < 2; ++a)
#pragma unroll
            for (int b = 0; b < 2; ++b)
#pragma unroll
                for (int m = 0; m < 4; ++m)
#pragma unroll
                    for (int n = 0; n < 2; ++n) acc[a][b][m][n] = (f32x4){0.f, 0.f, 0.f, 0.f};
        cur = nxt; cA = nA; cB = nB; ++ui;
        if constexpr (ALIGN_EPI) { if (wr == 1) PG8_BAR; }
    }
    PG8_WAIT_V(0);
    if constexpr (!ALIGN_EPI) { if (wr == 0) PG8_BAR; }
    PG8_BAR;
    if constexpr (Epi::AFTER_DRAIN) { E.fused(acc, cur, wr, wc, fr, fq, lds, wid, lane); S.done(cur); }
#undef PG8_SA
#undef PG8_SB
#undef PG8_STAGE
#undef PG8_LDA
#undef PG8_LDB
#undef PG8_MMA
#undef PG8_WAIT_V
#undef PG8_WAIT_L
#undef PG8_BAR
#undef PG8_SCHED
}
}

#include <hip/hip_bf16.h>
#include <cmath>

namespace attn_body {
using bf16=__hip_bfloat16;
using bf16x8=__attribute__((ext_vector_type(8)))short;
using s16x4=__attribute__((ext_vector_type(4)))short;
using f32x16=__attribute__((ext_vector_type(16)))float;
using u32x4=__attribute__((ext_vector_type(4)))unsigned;
constexpr int NHEAD=8,SEQ=16384,D=64,DMQ=NHEAD*D,DMK=2*D;
constexpr int NW=8,QBLK=32,QB=QBLK*NW,KVBLK=64,NQB=SEQ/QB;
constexpr int ATTN_UNIT_ROWS=QB;
__device__ __forceinline__ int crow(int r,int hi){return (r&3)+8*(r>>2)+4*hi;}
#define SBAR() __builtin_amdgcn_sched_barrier(0)
__device__ __forceinline__ void cmask(f32x16&p0,f32x16&p1,int jb,int qrel,int hi){
  const float NEG=-INFINITY; int kb=64*jb+4*hi;
  #pragma unroll
  for(int r=0;r<16;++r){int kv=kb+(r&3)+8*(r>>2); if(kv>qrel)p0[r]=NEG; if(kv+32>qrel)p1[r]=NEG;}
}

constexpr int NSLOT=3, SLOTB=8192;
constexpr int LDS_K=0, LDS_V=NSLOT*SLOTB, LDS_WS=2*NSLOT*SLOTB, LDS_OST=LDS_WS+NW*64*4, LDS_BYTES=LDS_OST+NW*4096;
constexpr float C2=0.125f*1.4426950408889634f;
__device__ __forceinline__ void glds16(const void*gsrc,unsigned lds_dst){unsigned keep;
  asm volatile("s_mov_b32 %0, m0\n\ts_mov_b32 m0, %2\n\ts_nop 0\n\tglobal_load_lds_dwordx4 %1, off\n\ts_mov_b32 m0, %0":"=&s"(keep):"v"(gsrc),"s"(lds_dst):"memory");}
__device__ __forceinline__ float max3f(float a,float b,float c){float r;asm("v_max3_f32 %0, %1, %2, %3":"=v"(r):"v"(a),"v"(b),"v"(c));return r;}
__device__ __forceinline__ float max2f(float a,float b){float r;asm("v_max_f32_e32 %0, %1, %2":"=v"(r):"v"(a),"v"(b));return r;}
__device__ __forceinline__ float fadd_s(float a,float b){float r;asm("v_add_f32_e32 %0, %1, %2":"=v"(r):"v"(a),"v"(b));return r;}
__device__ __forceinline__ float fsub_s(float a,float b){float r;asm("v_sub_f32_e32 %0, %1, %2":"=v"(r):"v"(a),"v"(b));return r;}
typedef float f32x2_t __attribute__((ext_vector_type(2))); typedef __bf16 bf16x2_t __attribute__((ext_vector_type(2)));
__device__ __forceinline__ unsigned cvtpk_s(float lo,float hi){f32x2_t v={lo,hi};bf16x2_t b=__builtin_convertvector(v,bf16x2_t);return __builtin_bit_cast(unsigned,b);}
#define WAIT_BAR(N) asm volatile("s_waitcnt vmcnt(" #N ") lgkmcnt(0)\n\ts_barrier":::"memory")

__device__ __forceinline__ void qkt(f32x16&p0,f32x16&p1,const char*Kslot,const bf16x8*qr,const f32x16&negm,int r32,int hi){
  const char*kb=Kslot+hi*1024+r32*16;
  #pragma unroll
  for(int d0=0;d0<4;++d0){
    const bf16x8 b0=*reinterpret_cast<const bf16x8*>(kb+d0*2048);
    const bf16x8 b1=*reinterpret_cast<const bf16x8*>(kb+d0*2048+512);
    if(d0==0){p0=__builtin_amdgcn_mfma_f32_32x32x16_bf16(b0,qr[0],negm,0,0,0);p1=__builtin_amdgcn_mfma_f32_32x32x16_bf16(b1,qr[0],negm,0,0,0);}
    else{p0=__builtin_amdgcn_mfma_f32_32x32x16_bf16(b0,qr[d0],p0,0,0,0);p1=__builtin_amdgcn_mfma_f32_32x32x16_bf16(b1,qr[d0],p1,0,0,0);}}
}
typedef __attribute__((address_space(3))) const char* lds_cptr;
typedef short v4i16_t __attribute__((ext_vector_type(4)));
__device__ __forceinline__ void kload8(bf16x8*kf,lds_cptr kp){
  kf[0]=*(const __attribute__((address_space(3))) bf16x8*)(kp);      kf[1]=*(const __attribute__((address_space(3))) bf16x8*)(kp+512);
  kf[2]=*(const __attribute__((address_space(3))) bf16x8*)(kp+2048); kf[3]=*(const __attribute__((address_space(3))) bf16x8*)(kp+2560);
  kf[4]=*(const __attribute__((address_space(3))) bf16x8*)(kp+4096); kf[5]=*(const __attribute__((address_space(3))) bf16x8*)(kp+4608);
  kf[6]=*(const __attribute__((address_space(3))) bf16x8*)(kp+6144); kf[7]=*(const __attribute__((address_space(3))) bf16x8*)(kp+6656);
}
__device__ __forceinline__ void kload2(bf16x8*kf,lds_cptr kp,int j){ kf[2*j]=*(const __attribute__((address_space(3))) bf16x8*)(kp+j*2048); kf[2*j+1]=*(const __attribute__((address_space(3))) bf16x8*)(kp+j*2048+512); }
__device__ __forceinline__ s16x4 vtr(lds_cptr p){ return __builtin_bit_cast(s16x4,__builtin_amdgcn_ds_read_tr16_b64_v4i16((__attribute__((address_space(3))) v4i16_t*)p)); }
__device__ __forceinline__ float rowmax(const f32x16&p0,const f32x16&p1){
  float a=max3f(p0[0],p0[1],p1[0]),b=max3f(p0[2],p0[3],p1[1]);a=max3f(a,p1[2],p1[3]);
  #pragma unroll
  for(int r=4;r<16;r+=4){a=max3f(a,p0[r],p0[r+1]);b=max3f(b,p0[r+2],p0[r+3]);a=max3f(a,p1[r],p1[r+1]);b=max3f(b,p1[r+2],p1[r+3]);}
  const float m=max2f(a,b);
  auto rr=__builtin_amdgcn_permlane32_swap(__float_as_uint(m),__float_as_uint(m),false,false);
  return max2f(__uint_as_float(rr[0]),__uint_as_float(rr[1]));
}
__device__ __forceinline__ void pv(f32x16*o,int vb,bf16x8 pa0,bf16x8 pa1,bf16x8 pa2,bf16x8 pa3){
  #pragma unroll
  for(int d0=0;d0<2;++d0){s16x4 lo[4],hi[4];
    #pragma unroll
    for(int ks=0;ks<4;++ks){
      asm volatile("ds_read_b64_tr_b16 %0,%1 offset:%c2":"=&v"(lo[ks]):"v"(vb),"i"(d0*4096+ks*1024):"memory");
      asm volatile("ds_read_b64_tr_b16 %0,%1 offset:%c2":"=&v"(hi[ks]):"v"(vb),"i"(d0*4096+ks*1024+512):"memory");}
    asm volatile("s_waitcnt lgkmcnt(0)":::"memory");SBAR();
    #define PK(k) (bf16x8){lo[k][0],lo[k][1],lo[k][2],lo[k][3],hi[k][0],hi[k][1],hi[k][2],hi[k][3]}
    o[d0]=__builtin_amdgcn_mfma_f32_32x32x16_bf16(pa0,PK(0),o[d0],0,0,0);
    o[d0]=__builtin_amdgcn_mfma_f32_32x32x16_bf16(pa1,PK(1),o[d0],0,0,0);
    o[d0]=__builtin_amdgcn_mfma_f32_32x32x16_bf16(pa2,PK(2),o[d0],0,0,0);
    o[d0]=__builtin_amdgcn_mfma_f32_32x32x16_bf16(pa3,PK(3),o[d0],0,0,0);
    #undef PK
  }
}

#ifndef ATTN_STORE16
#define ATTN_STORE16(p,v) (*(u32x4*)(p)=(v))
#endif
template<int THRL> __device__ __forceinline__ void attn_unit(int b,int h,int qb,const bf16*Q,const bf16*__restrict__ K,const bf16*__restrict__ V,bf16*O,char*shm,int wave_){
  const int tid_=wave_*64+lane_id_opaque();
  const int tid=tid_,lane=tid&63,r32=lane&31,hi=lane>>5; const int wid=__builtin_amdgcn_readfirstlane(tid>>6);
  const long rowbase=0; const int q0=qb*QB; (void)b;
  const bf16*Qw=Q+(rowbase+q0+wid*QBLK)*DMQ+h*D;
  const bf16*Kh=K+(h>>2)*D,*Vh=V+(h>>2)*D;
  const unsigned lds0=(unsigned)(uintptr_t)shm;
  float*wsf=(float*)(shm+LDS_WS)+wid*64;
  const bf16*ksrc=Kh+(long)lane*DMK+wid*8;
  const bf16*vsrc=Vh+(long)(16*(wid&3)+(lane>>2))*DMK+(wid>>2)*32+(lane&3)*8;
  const unsigned kdst=lds0+LDS_K+wid*1024, vdst=lds0+LDS_V+wid*1024;
  #define DMA_K(t,slot) glds16(ksrc+(long)(t)*KVBLK*DMK,(unsigned)__builtin_amdgcn_readfirstlane(kdst+(slot)))
  #define DMA_V(t,slot) glds16(vsrc+(long)(t)*KVBLK*DMK,(unsigned)__builtin_amdgcn_readfirstlane(vdst+(slot)))
  const int vb0=(int)(lds0+LDS_V)+((lane>>4)&1)*32+(lane&3)*8+(4*hi+((lane&15)>>2))*64;
  const char*Kbase=shm+LDS_K; bf16x8 kf[8];
  const lds_cptr shm3=(lds_cptr)shm; const lds_cptr kp0=shm3+LDS_K+hi*1024+r32*16; const lds_cptr vp0=shm3+LDS_V+((lane>>4)&1)*32+(lane&3)*8+(4*hi+((lane&15)>>2))*64;
  const int NT=SEQ/KVBLK;
  DMA_K(0,0);DMA_V(0,0);DMA_K(1,SLOTB);
  bf16x8 qr[4];
  #pragma unroll
  for(int d0=0;d0<4;++d0)qr[d0]=*reinterpret_cast<const bf16x8*>(&Qw[(long)r32*DMQ+d0*16+hi*8]);
  float mhat=0.f,l_reg=0.f;f32x16 o[2];o[0]=f32x16{};o[1]=f32x16{};f32x16 negm=f32x16{};asm volatile("":"+v"(negm));
  const int qrel=wid*QBLK+r32; (void)qrel;
  #define CMASK(P0,P1,t) do{}while(0)
  bool resc=false;
  #define START(P0,P1) do{ const float rm=rowmax(P0,P1); resc=false; \
    { const float dl=rm; mhat=fadd_s(mhat,dl); \
      _Pragma("unroll") for(int r=0;r<16;++r){P0[r]=fsub_s(P0[r],dl);P1[r]=fsub_s(P1[r],dl);} \
      _Pragma("unroll") for(int r=0;r<16;++r)negm[r]=-mhat; asm volatile("":"+v"(negm)); } \
    _Pragma("unroll") for(int r=0;r<16;++r)P0[r]=__builtin_amdgcn_exp2f(P0[r]); }while(0)
  #define RESC() do{ if(resc){ asm volatile("s_waitcnt lgkmcnt(0)":::"memory"); \
      _Pragma("unroll") for(int d_=0;d_<2;++d_) _Pragma("unroll") for(int r=0;r<16;++r)o[d_][r]*=wsf[crow(r,hi)]; } }while(0)
  f32x16 pA0,pA1,pB0,pB1;
  int sl_prev=0,sl_cur=0,sl_next=SLOTB;
  #define ROT() do{sl_prev=sl_cur;sl_cur=sl_next;sl_next=(sl_next==(NSLOT-1)*SLOTB)?0:sl_next+SLOTB;}while(0)
  DMA_K(2,2*SLOTB);
  WAIT_BAR(3);
  qkt(pA0,pA1,Kbase,qr,negm,r32,hi);asm volatile("s_nop 15\n\ts_nop 7":"+v"(pA0),"+v"(pA1));CMASK(pA0,pA1,0);
  START(pA0,pA1);
  _Pragma("unroll") for(int r=0;r<16;++r)pA1[r]=__builtin_amdgcn_exp2f(pA1[r]);
  WAIT_BAR(0);
  DMA_K(3,0);DMA_V(1,SLOTB);
  ROT();
  kload8(kf,kp0+sl_cur);
  WAIT_BAR(2);
  s16x4 vlo[8],vhi[8]; u32x4 pw0,pw1,pw2,pw3;
  #define PKW(P,B) cvtpk_s(P[B],P[B+1])
  #define PAF(k) __builtin_bit_cast(bf16x8,pw##k)
  #define VFR(i) (bf16x8){vlo[i][0],vlo[i][1],vlo[i][2],vlo[i][3],vhi[i][0],vhi[i][1],vhi[i][2],vhi[i][3]}
  #define PIN(x) asm volatile("":"+v"(x))
  #define MX3(a,b,c) __builtin_fmaxf(__builtin_fmaxf((a),(b)),(c))
  #define GAPA(MF,A0,A1,A2,A3,W0,W1,PW) do{ MF; sacc+=A0; sacc+=A1; sacc+=A2; sacc+=A3; PIN(sacc); W0; W1; PIN(PW); SBAR(); }while(0)
  #define EX(v) __builtin_amdgcn_exp2f(v)
  #define GAPB(MF,X,B) do{ MF; X[B]=EX(X[B]); X[B+1]=EX(X[B+1]); X[B+2]=EX(X[B+2]); X[B+3]=EX(X[B+3]); PIN(X); SBAR(); }while(0)
  #define VRD(i) do{ vlo[i]=vtr(vp_+(((i)>>2)*4096+((i)&3)*1024)); vhi[i]=vtr(vp_+(((i)>>2)*4096+((i)&3)*1024+512)); }while(0)
  #define KRD(G,j) do{ if(G){ kload2(kf,kp0+sl_next,j); SBAR(); } }while(0)
  #define STEP(C0,C1,P0,P1,t,GK,GV,GL) do{ SBAR(); \
    const lds_cptr vp_=vp0+sl_prev; \
    VRD(0); SBAR(); float sacc=(P0[0]+P0[1]); \
    GAPA(C0=__builtin_amdgcn_mfma_f32_32x32x16_bf16(kf[0],qr[0],negm,0,0,0), P0[2],P0[3],P0[4],P0[5],     pw0[0]=PKW(P0,0), pw0[1]=PKW(P0,2), pw0); \
    VRD(4); SBAR(); GAPA(C1=__builtin_amdgcn_mfma_f32_32x32x16_bf16(kf[1],qr[0],negm,0,0,0), P0[6],P0[7],P0[8],P0[9],     pw0[2]=PKW(P0,4), pw0[3]=PKW(P0,6), pw0); \
    VRD(1); SBAR(); GAPA(C0=__builtin_amdgcn_mfma_f32_32x32x16_bf16(kf[2],qr[1],C0,0,0,0),   P0[10],P0[11],P0[12],P0[13], pw1[0]=PKW(P0,8), pw1[1]=PKW(P0,10), pw1); \
    VRD(5); SBAR(); GAPA(C1=__builtin_amdgcn_mfma_f32_32x32x16_bf16(kf[3],qr[1],C1,0,0,0),   P0[14],P0[15],P1[0],P1[1],   pw1[2]=PKW(P0,12),pw1[3]=PKW(P0,14), pw1); \
    VRD(2); SBAR(); GAPA(C0=__builtin_amdgcn_mfma_f32_32x32x16_bf16(kf[4],qr[2],C0,0,0,0),   P1[2],P1[3],P1[4],P1[5],     pw2[0]=PKW(P1,0), pw2[1]=PKW(P1,2), pw2); \
    VRD(6); SBAR(); GAPA(C1=__builtin_amdgcn_mfma_f32_32x32x16_bf16(kf[5],qr[2],C1,0,0,0),   P1[6],P1[7],P1[8],P1[9],     pw2[2]=PKW(P1,4), pw2[3]=PKW(P1,6), pw2); \
    VRD(3); SBAR(); GAPA(C0=__builtin_amdgcn_mfma_f32_32x32x16_bf16(kf[6],qr[3],C0,0,0,0),   P1[10],P1[11],P1[12],P1[13], pw3[0]=PKW(P1,8), pw3[1]=PKW(P1,10), pw3); \
    VRD(7); SBAR(); GAPA(C1=__builtin_amdgcn_mfma_f32_32x32x16_bf16(kf[7],qr[3],C1,0,0,0),   P1[14],P1[15],0.f,0.f,       pw3[2]=PKW(P1,12),pw3[3]=PKW(P1,14), pw3); \
    l_reg+=sacc; \
    if(GK){DMA_K((t)+3,sl_cur);} if(GV){DMA_V((t)+1,sl_next);} \
    CMASK(C0,C1,t); \
    { float a=MX3(C0[0],C0[1],C1[0]),b=MX3(C0[2],C0[3],C1[1]); a=MX3(a,C1[2],C1[3]); \
      _Pragma("unroll") for(int r=4;r<16;r+=4){a=MX3(a,C0[r],C0[r+1]);b=MX3(b,C0[r+2],C0[r+3]);a=MX3(a,C1[r],C1[r+1]);b=MX3(b,C1[r+2],C1[r+3]);} \
      float rm=__builtin_fmaxf(a,b); { auto rr=__builtin_amdgcn_permlane32_swap(__float_as_uint(rm),__float_as_uint(rm),false,false); rm=__builtin_fmaxf(__uint_as_float(rr[0]),__uint_as_float(rr[1])); } \
      resc=false; \
      if(__builtin_expect(__any(rm>(float)THRL),0)){ const float dl=__builtin_fmaxf(rm,0.f); mhat+=dl; \
        _Pragma("unroll") for(int r=0;r<16;++r){C0[r]-=dl;C1[r]-=dl;} \
        _Pragma("unroll") for(int r=0;r<16;++r)negm[r]=-mhat; asm volatile("":"+v"(negm)); \
        const float f=__builtin_amdgcn_exp2f(-dl); l_reg*=f; if(hi==0)wsf[r32]=f; resc=true; } } \
    SBAR(); \
    GAPB(o[0]=__builtin_amdgcn_mfma_f32_32x32x16_bf16(PAF(0),VFR(0),o[0],0,0,0), C0,0); \
    GAPB(o[1]=__builtin_amdgcn_mfma_f32_32x32x16_bf16(PAF(0),VFR(4),o[1],0,0,0), C0,4); \
    KRD(GL,0); GAPB(o[0]=__builtin_amdgcn_mfma_f32_32x32x16_bf16(PAF(1),VFR(1),o[0],0,0,0), C0,8); \
    KRD(GL,1); GAPB(o[1]=__builtin_amdgcn_mfma_f32_32x32x16_bf16(PAF(1),VFR(5),o[1],0,0,0), C0,12); \
    KRD(GL,2); GAPB(o[0]=__builtin_amdgcn_mfma_f32_32x32x16_bf16(PAF(2),VFR(2),o[0],0,0,0), C1,0); \
    KRD(GL,3); GAPB(o[1]=__builtin_amdgcn_mfma_f32_32x32x16_bf16(PAF(2),VFR(6),o[1],0,0,0), C1,4); \
    GAPB(o[0]=__builtin_amdgcn_mfma_f32_32x32x16_bf16(PAF(3),VFR(3),o[0],0,0,0), C1,8); \
    GAPB(o[1]=__builtin_amdgcn_mfma_f32_32x32x16_bf16(PAF(3),VFR(7),o[1],0,0,0), C1,12); \
    }while(0)
  int t=1;
  #undef CMASK
  #define CMASK(P0,P1,t) do{}while(0)
  for(;t+5<NT;t+=2){
    STEP(pB0,pB1,pA0,pA1,t,true,true,true);     WAIT_BAR(2); RESC(); ROT();
    STEP(pA0,pA1,pB0,pB1,t+1,true,true,true);   WAIT_BAR(2); RESC(); ROT();
  }
  #undef CMASK
  #define CMASK(P0,P1,t) do{}while(0)
  #define ENDW(tt) do{ if((tt)+3<NT){WAIT_BAR(2);} else if((tt)+2<NT){WAIT_BAR(1);} else {WAIT_BAR(0);} }while(0)
  for(;t+1<NT;t+=2){
    STEP(pB0,pB1,pA0,pA1,t,(t+3<NT),(t+1<NT),(t+1<NT));       ENDW(t);   RESC(); ROT();
    STEP(pA0,pA1,pB0,pB1,t+1,(t+4<NT),(t+2<NT),(t+2<NT));     ENDW(t+1); RESC(); ROT();
  }
  STEP(pB0,pB1,pA0,pA1,NT-1,false,false,false); RESC();
  { float sacc=pB0[0]+pB0[1]; _Pragma("unroll") for(int r=2;r<16;++r)sacc+=pB0[r]; _Pragma("unroll") for(int r=0;r<16;++r)sacc+=pB1[r]; l_reg+=sacc;
    pw0=(u32x4){PKW(pB0,0),PKW(pB0,2),PKW(pB0,4),PKW(pB0,6)};pw1=(u32x4){PKW(pB0,8),PKW(pB0,10),PKW(pB0,12),PKW(pB0,14)};pw2=(u32x4){PKW(pB1,0),PKW(pB1,2),PKW(pB1,4),PKW(pB1,6)};pw3=(u32x4){PKW(pB1,8),PKW(pB1,10),PKW(pB1,12),PKW(pB1,14)};
    SBAR(); pv(o,vb0+sl_cur,PAF(0),PAF(1),PAF(2),PAF(3)); }
  #undef PKW
  #undef PAF
  #undef VFR
  #undef PIN
  #undef MX3
  #undef GAPA
  #undef GAPB
  #undef EX
  #undef VRD
  #undef KRD
  #undef STEP
  #undef ENDW
  {auto rr=__builtin_amdgcn_permlane32_swap(__float_as_uint(l_reg),__float_as_uint(l_reg),false,false);l_reg=__uint_as_float(rr[0])+__uint_as_float(rr[1]);}
  if(hi==0)wsf[32+r32]=l_reg;asm volatile("s_waitcnt lgkmcnt(0)":::"memory");
  float rli[16];
  #pragma unroll
  for(int r=0;r<16;++r)rli[r]=__builtin_amdgcn_rcpf(wsf[32+crow(r,hi)]);
  bf16*Ow=O+(rowbase+q0+wid*QBLK)*DMQ+h*D;
  { bf16*stg=(bf16*)(shm+LDS_OST)+wid*2048;
    #pragma unroll
    for(int r=0;r<16;++r){const int orow=crow(r,hi);
      #pragma unroll
      for(int d0=0;d0<2;++d0)stg[orow*64+d0*32+r32]=__float2bfloat16(o[d0][r]*rli[r]);}
    asm volatile("s_waitcnt lgkmcnt(0)":::"memory");
    #pragma unroll
    for(int i=0;i<4;++i){const int row=i*8+(lane>>3),ch=lane&7; const u32x4 v=*(const u32x4*)(stg+row*64+ch*8); ATTN_STORE16(Ow+(long)row*DMQ+ch*8,v);} }
  asm volatile("s_waitcnt lgkmcnt(0)\n\ts_barrier":::"memory");
  #undef DMA_K
  #undef DMA_V
  #undef CMASK
  #undef START
  #undef RESC
  #undef ROT
}
constexpr int ATTN_LDS_BYTES=LDS_BYTES;
struct AttnTensors { const bf16* Q; const bf16* K; const bf16* V; bf16* O; };
struct AttnUnit { int bh; int qb; };
struct StaticOrder {
  int vcu, G;
  __device__ __forceinline__ explicit StaticOrder(int grid,int block):vcu((grid%8==0)?(block%8)*(grid/8)+block/8:block),G(grid){}
  __device__ __forceinline__ bool next(int i,AttnUnit&u)const{ constexpr int NU=NHEAD*NQB; int uu; if(NU%G==0){ const int per=NU/G; if(i>=per)return false; uu=vcu*per+i; } else { uu=i*G+vcu; if(uu>=NU)return false; } u.bh=uu/NQB; u.qb=uu%NQB; return true; }
  __device__ __forceinline__ void a_ready(const AttnUnit&)const{}
  __device__ __forceinline__ void done(const AttnUnit&)const{}
};
template<class Sched,int THRL=8> __device__ __forceinline__ void attn_phase(char*lds,const AttnTensors&T,const Sched&S,int wave_){
  AttnUnit u;
  for(int i=0;S.next(i,u);++i){ S.a_ready(u); attn_unit<THRL>(0,u.bh,u.qb,T.Q,T.K,T.V,T.O,lds,wave_); S.done(u); }
}
#undef SBAR
#undef WAIT_BAR
}

namespace hg {
typedef short bf16x8 __attribute__((ext_vector_type(8)));
typedef short s16x4 __attribute__((ext_vector_type(4)));
constexpr int CH = 32, SEGT = 512, NSEG = S / SEGT, NCH = SEGT / CH;
constexpr int RS = 272, TS = 80;
constexpr int QOFF = 0, KOFF = 32 * RS, KTOFF = 2 * 32 * RS, VTOFF = KTOFF + 128 * TS, DOFF = VTOFF + 128 * TS, GOFF = DOFF + 512, BUFB = GOFF + 2048;
static_assert(2 * BUFB <= 131072, "hgrn LDS");
#define HG_MFMA(a, b, c) __builtin_amdgcn_mfma_f32_16x16x32_bf16((a), (b), (c), 0, 0, 0)
__device__ __forceinline__ unsigned pkbf(float lo, float hi) { typedef float f2 __attribute__((ext_vector_type(2))); typedef __bf16 b2 __attribute__((ext_vector_type(2))); f2 v = {lo, hi}; b2 b = __builtin_convertvector(v, b2); return __builtin_bit_cast(unsigned, b); }

template <bool OUT>
__device__ __forceinline__ void segment(LAS unsigned char* lds, int unit, const bf16_t* __restrict__ HQ, const float* __restrict__ LF, const bf16_t* __restrict__ KF,
                                        const bf16_t* __restrict__ HV, float* __restrict__ HST, float* __restrict__ HSD, float* __restrict__ OF, int wave_) {
    const int tid_ = wave_ * 64 + lane_id_opaque();
    const int tid = tid_, lane = tid & 63, w = __builtin_amdgcn_readfirstlane(tid >> 6), c16 = lane & 15, g = lane >> 4;
    const int dir = unit >> 7, h = (unit >> 5) & 3, seg = unit & 31;
    const int d = tid & 127, tg = tid >> 7;
    const size_t cb = (size_t)h * 128 + d;
    const float* lf = LF + (size_t)dir * S * 512 + cb;
    const bf16_t* kf = KF + (size_t)dir * S * 512 + cb;
    const bf16_t* hq = HQ + cb; const bf16_t* hv = HV + cb;
    f32x4 Sacc[8];
    float* hst = HST + (size_t)unit * 16384 + (size_t)w * 2048 + lane;
    if (OUT) {
#pragma unroll
        for (int dt = 0; dt < 8; ++dt) { Sacc[dt][0] = hst[(dt * 4 + 0) * 64]; Sacc[dt][1] = hst[(dt * 4 + 1) * 64]; Sacc[dt][2] = hst[(dt * 4 + 2) * 64]; Sacc[dt][3] = hst[(dt * 4 + 3) * 64]; }
    } else {
#pragma unroll
        for (int dt = 0; dt < 8; ++dt) Sacc[dt] = f32x4{0.f, 0.f, 0.f, 0.f};
    }
    float segsum = 0.f;
    const int e0 = 16 * w;
    for (int c = 0; c < NCH; ++c) {
        LAS unsigned char* B = lds + (c & 1) * BUFB;
        float lg[8], kk[8], qq[8]; unsigned short vv[8];
#pragma unroll
        for (int jj = 0; jj < 8; ++jj) {
            const int p = seg * SEGT + c * CH + 8 * tg + jj, t = dir ? (S - 1 - p) : p;
            lg[jj] = lf[(size_t)t * 512]; kk[jj] = bf2f(kf[(size_t)t * 512]); vv[jj] = hv[(size_t)t * 512];
            qq[jj] = OUT ? bf2f(hq[(size_t)t * 512]) : 0.f;
        }
#pragma unroll
        for (int jj = 1; jj < 8; ++jj) lg[jj] += lg[jj - 1];
        LAS float* gs = (LAS float*)(B + GOFF);
        gs[tg * 128 + d] = lg[7];
        __syncthreads();
        const float g0 = gs[d], g1 = gs[128 + d], g2 = gs[256 + d], g3 = gs[384 + d];
        const float off = (tg > 0 ? g0 : 0.f) + (tg > 1 ? g1 : 0.f) + (tg > 2 ? g2 : 0.f), tot = (g0 + g1) + (g2 + g3);
        float kt[8];
#pragma unroll
        for (int jj = 0; jj < 8; ++jj) {
            const float b = fmaxf(off + lg[jj], -80.f);
            kt[jj] = kk[jj] * __expf(-b);
            if (OUT) {
                *(LAS bf16_t*)(B + QOFF + (8 * tg + jj) * RS + d * 2) = (bf16_t)(pkbf(qq[jj] * __expf(b), 0.f) & 0xffffu);
                *(LAS bf16_t*)(B + KOFF + (8 * tg + jj) * RS + d * 2) = (bf16_t)(pkbf(kt[jj], 0.f) & 0xffffu);
            }
        }
        { u32x4 o; o.x = pkbf(kt[0], kt[1]); o.y = pkbf(kt[2], kt[3]); o.z = pkbf(kt[4], kt[5]); o.w = pkbf(kt[6], kt[7]);
          *(LAS u32x4*)(B + KTOFF + d * TS + 16 * tg) = o;
          u32x4 v; v.x = (unsigned)vv[0] | ((unsigned)vv[1] << 16); v.y = (unsigned)vv[2] | ((unsigned)vv[3] << 16); v.z = (unsigned)vv[4] | ((unsigned)vv[5] << 16); v.w = (unsigned)vv[6] | ((unsigned)vv[7] << 16);
          *(LAS u32x4*)(B + VTOFF + d * TS + 16 * tg) = v; }
        if (tg == 0) *(LAS float*)(B + DOFF + d * 4) = __expf(fmaxf(tot, -80.f));
        segsum += tot;
        __syncthreads();
        if (OUT) {
            f32x4 X00 = {0.f, 0.f, 0.f, 0.f}, X01 = X00, X11 = X00;
#pragma unroll
            for (int s = 0; s < 4; ++s) {
                const bf16x8 aK0 = *(const LAS bf16x8*)(B + KOFF + c16 * RS + (32 * s + 8 * g) * 2), aK1 = *(const LAS bf16x8*)(B + KOFF + (16 + c16) * RS + (32 * s + 8 * g) * 2);
                const bf16x8 bQ0 = *(const LAS bf16x8*)(B + QOFF + c16 * RS + (32 * s + 8 * g) * 2), bQ1 = *(const LAS bf16x8*)(B + QOFF + (16 + c16) * RS + (32 * s + 8 * g) * 2);
                X00 = HG_MFMA(aK0, bQ0, X00); X01 = HG_MFMA(aK0, bQ1, X01); X11 = HG_MFMA(aK1, bQ1, X11);
            }
#pragma unroll
            for (int r = 0; r < 4; ++r) { const bool keep = (4 * g + r) <= c16; X00[r] = keep ? X00[r] : 0.f; X11[r] = keep ? X11[r] : 0.f; }
            u32x4 a0w, a1w; a0w.x = pkbf(X00[0], X00[1]); a0w.y = pkbf(X00[2], X00[3]); a0w.z = 0u; a0w.w = 0u;
            a1w.x = pkbf(X01[0], X01[1]); a1w.y = pkbf(X01[2], X01[3]); a1w.z = pkbf(X11[0], X11[1]); a1w.w = pkbf(X11[2], X11[3]);
            const u32x2 vlo = *(const LAS u32x2*)(B + VTOFF + (e0 + c16) * TS + (4 * g) * 2), vhi = *(const LAS u32x2*)(B + VTOFF + (e0 + c16) * TS + (16 + 4 * g) * 2);
            u32x4 vbw; vbw.x = vlo.x; vbw.y = vlo.y; vbw.z = vhi.x; vbw.w = vhi.y;
            const bf16x8 vb = __builtin_bit_cast(bf16x8, vbw);
            f32x4 O0 = {0.f, 0.f, 0.f, 0.f}, O1 = O0;
            O0 = HG_MFMA(__builtin_bit_cast(bf16x8, a0w), vb, O0); O1 = HG_MFMA(__builtin_bit_cast(bf16x8, a1w), vb, O1);
#pragma unroll
            for (int s = 0; s < 4; ++s) {
                u32x4 sw; sw.x = pkbf(Sacc[2 * s][0], Sacc[2 * s][1]); sw.y = pkbf(Sacc[2 * s][2], Sacc[2 * s][3]); sw.z = pkbf(Sacc[2 * s + 1][0], Sacc[2 * s + 1][1]); sw.w = pkbf(Sacc[2 * s + 1][2], Sacc[2 * s + 1][3]);
                const bf16x8 sb = __builtin_bit_cast(bf16x8, sw);
                const u32x2 q0l = *(const LAS u32x2*)(B + QOFF + c16 * RS + (32 * s + 4 * g) * 2), q0h = *(const LAS u32x2*)(B + QOFF + c16 * RS + (32 * s + 16 + 4 * g) * 2);
                const u32x2 q1l = *(const LAS u32x2*)(B + QOFF + (16 + c16) * RS + (32 * s + 4 * g) * 2), q1h = *(const LAS u32x2*)(B + QOFF + (16 + c16) * RS + (32 * s + 16 + 4 * g) * 2);
                u32x4 q0w, q1w; q0w.x = q0l.x; q0w.y = q0l.y; q0w.z = q0h.x; q0w.w = q0h.y; q1w.x = q1l.x; q1w.y = q1l.y; q1w.z = q1h.x; q1w.w = q1h.y;
                O0 = HG_MFMA(__builtin_bit_cast(bf16x8, q0w), sb, O0); O1 = HG_MFMA(__builtin_bit_cast(bf16x8, q1w), sb, O1);
            }
#pragma unroll
            for (int r = 0; r < 4; ++r) {
                const int p0 = seg * SEGT + c * CH + 4 * g + r, p1 = p0 + 16;
                const int t0 = dir ? (S - 1 - p0) : p0, t1 = dir ? (S - 1 - p1) : p1;
                OF[((size_t)dir * S + t0) * 512 + h * 128 + e0 + c16] = O0[r];
                OF[((size_t)dir * S + t1) * 512 + h * 128 + e0 + c16] = O1[r];
            }
        }
        {
            const bf16x8 vB = *(const LAS bf16x8*)(B + VTOFF + (e0 + c16) * TS + (8 * g) * 2);
#pragma unroll
            for (int dt = 0; dt < 8; ++dt) {
                const bf16x8 aT = *(const LAS bf16x8*)(B + KTOFF + (16 * dt + c16) * TS + (8 * g) * 2);
                Sacc[dt] = HG_MFMA(aT, vB, Sacc[dt]);
                const f32x4 dv = *(const LAS f32x4*)(B + DOFF + (16 * dt + 4 * g) * 4);
                Sacc[dt] = Sacc[dt] * dv;
            }
        }
    }
    if (!OUT) {
#pragma unroll
        for (int dt = 0; dt < 8; ++dt) { hst[(dt * 4 + 0) * 64] = Sacc[dt][0]; hst[(dt * 4 + 1) * 64] = Sacc[dt][1]; hst[(dt * 4 + 2) * 64] = Sacc[dt][2]; hst[(dt * 4 + 3) * 64] = Sacc[dt][3]; }
        if (tid < 128) HSD[(size_t)unit * 128 + d] = __expf(fmaxf(segsum, -80.f));
    }
    __syncthreads();
}
__device__ __forceinline__ void carry(float* __restrict__ HST, const float* __restrict__ HSD, int gid) {
    const int chain = gid >> 14, el = gid & 16383, dt = (el >> 8) & 7, r = (el >> 6) & 3, ln = el & 63, d = 16 * dt + 4 * (ln >> 4) + r;
    float cy = 0.f;
    for (int sg = 0; sg < NSEG; ++sg) {
        const int u = chain * NSEG + sg;
        const float tmp = HST[(size_t)u * 16384 + el];
        HST[(size_t)u * 16384 + el] = cy;
        cy = HSD[(size_t)u * 128 + d] * cy + tmp;
    }
}
#undef HG_MFMA
}

#define XB_TMO      128
#define XB_XCNT(j)  (256  + 64 * (j))
#define XB_XSUB(j)  (1280 + 64 * (j))
#define XB_XGEN(j)  (2304 + 64 * (j))
#define XB_TOP      3328
#define XB_TOPGEN   3392
#define XCD_BAR_WORDS 3456
#define XB_SPIN_CAP (1u << 18)

__device__ __forceinline__ unsigned xb_ld(unsigned* p)              { return __hip_atomic_load(p, __ATOMIC_RELAXED, __HIP_MEMORY_SCOPE_AGENT); }
__device__ __forceinline__ unsigned xb_add(unsigned* p, unsigned v) { return __hip_atomic_fetch_add(p, v, __ATOMIC_RELAXED, __HIP_MEMORY_SCOPE_AGENT); }
__device__ __forceinline__ unsigned xb_xcc_id() { return (unsigned)__builtin_amdgcn_s_getreg((3 << 11) | 20) & 0xFu; }
#define XB_SPIN(cond, bar) do { unsigned _sp = 0; while (cond) { __builtin_amdgcn_s_sleep(1); \
    if ((++_sp & 255u) == 0u) { if (xb_ld(&(bar)[XB_TMO])) break; if (_sp > XB_SPIN_CAP) { atomicAdd(&(bar)[XB_TMO], 1u); break; } } } } while (0)

struct XcdBarrier {
    int wv;
    unsigned* bar; unsigned x;
    volatile LAS unsigned* st;
};

__device__ __forceinline__ XcdBarrier xcd_barrier_post(unsigned* bar, volatile LAS unsigned* st) {
    XcdBarrier b; b.bar = bar; b.x = xb_xcc_id(); b.st = st; b.wv = __builtin_amdgcn_readfirstlane((int)threadIdx.x >> 6);
    if (threadIdx.x == 0) (void)xb_add(&bar[XB_XCNT(b.x)], 1u);
    return b;
}
__device__ __forceinline__ void xcd_barrier_complete(unsigned* bar, unsigned x, unsigned& nloc, unsigned& nx) {
    const unsigned G = gridDim.x * gridDim.y * gridDim.z;
    unsigned sum, cnt, mine, sp = 0u;
    for (;;) {
        sum = 0u; cnt = 0u; mine = 0u;
#pragma unroll
        for (unsigned j = 0; j < 16; ++j) { const unsigned c = xb_ld(&bar[XB_XCNT(j)]); sum += c; cnt += (c > 0u) ? 1u : 0u; mine = (j == x) ? c : mine; }
        if (sum == G) break;
        __builtin_amdgcn_s_sleep(1);
        if ((++sp & 255u) == 0u) { if (xb_ld(&bar[XB_TMO])) break; if (sp > XB_SPIN_CAP) { atomicAdd(&bar[XB_TMO], 1u); break; } }
    }
    nloc = mine > 0u ? mine : 1u; nx = cnt > 0u ? cnt : 1u;
}

__device__ __forceinline__ void xcd_barrier(const XcdBarrier& b) {
    asm volatile("s_waitcnt vmcnt(0)" ::: "memory");
    __syncthreads();
    if (b.wv == 0 && lane_id_opaque() == 0) {
        unsigned* bar = b.bar;
        __builtin_amdgcn_s_waitcnt(0);
        unsigned nloc = b.st[0], nx = b.st[1];
        if (nloc == 0u) { xcd_barrier_complete(bar, b.x, nloc, nx); b.st[0] = nloc; b.st[1] = nx; }
        const unsigned old = xb_add(&bar[XB_XSUB(b.x)], 1u);
        const unsigned gen = old / nloc;
        if (old + 1u == (gen + 1u) * nloc) {
            __builtin_amdgcn_fence(__ATOMIC_RELEASE, "agent");
            asm volatile("s_waitcnt vmcnt(0)" ::: "memory");
            const unsigned og = xb_add(&bar[XB_TOP], 1u);
            const unsigned tg = og / nx;
            if (og + 1u == (tg + 1u) * nx) xb_add(&bar[XB_TOPGEN], 1u);
            else XB_SPIN(xb_ld(&bar[XB_TOPGEN]) == tg, bar);
            __builtin_amdgcn_fence(__ATOMIC_ACQUIRE, "agent");
            xb_add(&bar[XB_XGEN(b.x)], 1u);
            asm volatile("s_waitcnt vmcnt(0)" ::: "memory");
        } else {
            XB_SPIN(xb_ld(&bar[XB_XGEN(b.x)]) == gen, bar);
            __builtin_amdgcn_fence(__ATOMIC_ACQUIRE, "agent");
            asm volatile("s_waitcnt vmcnt(0)" ::: "memory");
        }
    }
    __syncthreads();
}

constexpr int NWAVES = 8;
constexpr int RING_OFF = 0, RING_BYTES = 131072;
constexpr int LDSCTL_OFF = RING_BYTES, MISC_OFF = LDSCTL_OFF + 320;
constexpr int LDS_BYTES = 147456;
constexpr int CW_BAR = 4096;
constexpr int NPL = 13;
constexpr int PH_PRO = 0, PH_NORM1 = 1, PH_L0 = 2, PH_END = PH_L0 + NL * NPL;
enum { P_G1 = 0, P_QKP = 1, P_HGB = 2, P_HGC = 3, P_ATT = 4, P_G2 = 5, P_G3 = 6, P_N2R = 7, P_TOPK = 8, P_GATH = 9, P_G4 = 10, P_G5 = 11, P_COMB = 12 };

#ifndef REP_HG
#define REP_HG 1
#endif
#ifndef REP_PRO
#define REP_PRO 1
#endif
#ifndef REP_ROW
#define REP_ROW 1
#endif
#ifndef REP_ATT
#define REP_ATT 1
#endif
struct Params {
    const float *x, *c, *ada_w, *ada_b, *norm_mix_w, *norm_ffn_w, *w_in, *q_norm_w, *k_norm_w, *hlb, *hg_norm_w, *w_ba, *w_bh, *w_out, *w_router, *w_eg, *w_eu, *w_ed;
    float* out; unsigned char* ws;
    int ph_lo, ph_hi, li, pad;
};
struct Frame {
    LAS unsigned char* lds;
    int tid, lane, wave, vcu, G;
};

__device__ __forceinline__ void tr_tile(const float* __restrict__ src, int ldw, bf16_t* __restrict__ dst, int Kd, LAS float* scr, int lane) {
    f32x4 v[8];
#pragma unroll
    for (int i = 0; i < 8; ++i) v[i] = *(const f32x4*)(src + (size_t)(8 * i + (lane >> 3)) * ldw + 4 * (lane & 7));
#pragma unroll
    for (int i = 0; i < 8; ++i) { LAS float* s = scr + (8 * i + (lane >> 3)) * 33 + 4 * (lane & 7); s[0] = v[i].x; s[1] = v[i].y; s[2] = v[i].z; s[3] = v[i].w; }
    asm volatile("s_waitcnt lgkmcnt(0)" ::: "memory");
    const int cch = lane & 7;
#pragma unroll
    for (int j = 0; j < 4; ++j) { const int n = (lane >> 3) + 8 * j; const LAS float* s = scr + (8 * cch) * 33 + n;
        u32x4 o; o.x = pk2(s[0 * 33], s[1 * 33]); o.y = pk2(s[2 * 33], s[3 * 33]); o.z = pk2(s[4 * 33], s[5 * 33]); o.w = pk2(s[6 * 33], s[7 * 33]);
        *(u32x4*)(dst + (size_t)n * Kd + 8 * cch) = o; }
    asm volatile("s_waitcnt lgkmcnt(0)" ::: "memory");
}
__device__ __forceinline__ void conv_matrix(Frame& F, const float* W, int K, int N, bf16_t* WT, LAS float* scr) {
    const int gw = F.vcu * NWAVES + F.wave, NGW = F.G * NWAVES, nblk = N / 32, nitems = (K / 64) * nblk;
    for (int it = gw; it < nitems; it += NGW) { const int kb = it / nblk, nb = it % nblk;
        tr_tile(W + (size_t)(64 * kb) * N + 32 * nb, N, WT + (size_t)(32 * nb) * K + 64 * kb, K, scr, F.lane); }
}
__device__ __forceinline__ void conv_experts(Frame& F, const Params& p, int l, LAS float* scr) {
    const int gw = F.vcu * NWAVES + F.wave, NGW = F.G * NWAVES;
    bf16_t* WGU = (bf16_t*)(p.ws + WS_WGU); bf16_t* WD = (bf16_t*)(p.ws + WS_WD);
    for (int it = gw; it < 3 * NE * 1024; it += NGW) {
        const int which = it / (NE * 1024), r0 = it % (NE * 1024), e = r0 >> 10, r = r0 & 1023;
        if (which < 2) {
            const int kb = r >> 6, nb = r & 63, n0 = 32 * nb;
            const float* W = (which == 0 ? p.w_eg : p.w_eu) + (size_t)(l * NE + e) * D * FF;
            const int rho = e * 4096 + (n0 >> 7) * 256 + which * 128 + (n0 & 127);
            tr_tile(W + (size_t)(64 * kb) * FF + n0, FF, WGU + (size_t)rho * D + 64 * kb, D, scr, F.lane);
        } else {
            const int kb = r >> 5, nb = r & 31, n0 = 32 * nb;
            const float* W = p.w_ed + (size_t)(l * NE + e) * FF * D;
            tr_tile(W + (size_t)(64 * kb) * D + n0, D, WD + (size_t)(e * 1024 + n0) * FF + 64 * kb, FF, scr, F.lane);
        }
    }
}
__device__ __forceinline__ void mod_units(Frame& F, const Params& p) {
    LAS float* sc = (LAS float*)(F.lds + 96 * 1024);
    LAS float* red = sc + 1024;
    float* MOD = (float*)(p.ws + WS_MOD); float* LBV = (float*)(p.ws + WS_LBV);
    for (int u = blockIdx.x; u < NL * 96; u += F.G) {
        for (int i = F.tid; i < D; i += 512) sc[i] = siluf_(p.c[i]);
        __syncthreads();
        const int l = u / 96, j = (u % 96) * 64 + (F.tid & 63), kp = F.tid >> 6;
        const float* w = p.ada_w + (size_t)l * D * 6 * D + (size_t)(kp * 128) * 6 * D + j;
        float acc = 0.f;
#pragma unroll 8
        for (int k = 0; k < 128; ++k) acc += sc[kp * 128 + k] * w[(size_t)k * 6 * D];
        red[kp * 64 + (F.tid & 63)] = acc;
        __syncthreads();
        if (F.tid < 64) { float s = 0.f;
#pragma unroll
            for (int q = 0; q < 8; ++q) s += red[q * 64 + F.tid];
            MOD[l * 6 * D + j] = s + p.ada_b[l * 6 * D + j]; }
        __syncthreads();
    }
    const int n = blockIdx.x * 512 + F.tid;
    if (n < NL * 1024) { const int l = n / 1024, r = n % 1024; float v = 0.f;
        if (l == 1) { const float b0 = p.hlb[r], b1 = p.hlb[1024 + r]; v = 1.0f / (1.0f + __expf(b0 - b1)); }
        LBV[n] = v; }
}

__device__ __forceinline__ void norm_mod_row(const f32x4 (&v)[4], float ss, const float* __restrict__ w, const float* __restrict__ scale,
                                             const float* __restrict__ shift, bf16_t* __restrict__ orow, int lane, f32x4 (&h)[4]) {
    const float r = rsqrtf(ss * (1.0f / D) + EPS);
#pragma unroll
    for (int j = 0; j < 4; ++j) {
        const int c0 = 4 * lane + 256 * j;
        const f32x4 wv = *(const f32x4*)(w + c0), sv = *(const f32x4*)(scale + c0), bv = *(const f32x4*)(shift + c0);
        h[j] = (v[j] * r) * wv * (sv + 1.0f) + bv;
        u32x2 o; o.x = pk2(h[j].x, h[j].y); o.y = pk2(h[j].z, h[j].w);
        *(u32x2*)(orow + c0) = o;
    }
}
__device__ __forceinline__ void ph_norm1(Frame& F, const float* x, const float* w, const float* scale, const float* shift, bf16_t* HB) {
    const int gw = F.vcu * NWAVES + F.wave, NGW = F.G * NWAVES;
    for (int row = gw; row < S; row += NGW) {
        const f32x4* xr = (const f32x4*)(x + (size_t)row * D) + F.lane;
        f32x4 v[4], h[4]; float ss = 0.f;
#pragma unroll
        for (int j = 0; j < 4; ++j) { v[j] = xr[64 * j]; ss += (v[j].x * v[j].x + v[j].y * v[j].y) + (v[j].z * v[j].z + v[j].w * v[j].w); }
        ss = wave_sum(ss);
        norm_mod_row(v, ss, w, scale, shift, HB + (size_t)row * D, F.lane, h);
    }
}
__device__ __forceinline__ void ph_gather(Frame& F, const bf16_t* HB, const int* IDX, bf16_t* XE) {
    const int gw = F.vcu * NWAVES + F.wave, NGW = F.G * NWAVES;
    constexpr int PER = NE * CAP / 2048;
    if (NGW * PER == NE * CAP) {
        const int r0 = gw * PER;
        const int mine = IDX[r0 + (F.lane & 15)];
#pragma unroll
        for (int q = 0; q < PER; q += 4) {
            u32x4 a[4], b[4];
#pragma unroll
            for (int k = 0; k < 4; ++k) { const int t = __builtin_amdgcn_readlane(mine, q + k); const u32x4* src = (const u32x4*)(HB + (size_t)t * D) + F.lane; a[k] = src[0]; b[k] = src[64]; }
#pragma unroll
            for (int k = 0; k < 4; ++k) { u32x4* dst = (u32x4*)(XE + (size_t)(r0 + q + k) * D) + F.lane; dst[0] = a[k]; dst[64] = b[k]; }
        }
    } else {
        for (int r = gw; r < NE * CAP; r += NGW) {
            const int t = IDX[r];
            const u32x4* src = (const u32x4*)(HB + (size_t)t * D) + F.lane; u32x4* dst = (u32x4*)(XE + (size_t)r * D) + F.lane;
            const u32x4 a = src[0], b = src[64]; dst[0] = a; dst[64] = b;
        }
    }
}

#define OPAQUE_LANE() const int lane = lane_id_opaque(); const int t_ = F.wave * 64 + lane
__device__ __forceinline__ void ph_rope_table(Frame& F, float* ROPE) {
    OPAQUE_LANE();
    const int n = blockIdx.x * 512 + t_;
    if (n < 4096) { const int pos = n >> 4, i = n & 15; const float inv = exp2f(-(float)i * (13.287712379549449f / 16.0f)); float sn, cs; sincosf((float)pos * inv, &sn, &cs); ROPE[2 * n] = cs; ROPE[2 * n + 1] = sn; }
}
__device__ __forceinline__ void ph_qkprep(Frame& F, const bf16_t* __restrict__ QR, const bf16_t* __restrict__ KR, const float* __restrict__ qw, const float* __restrict__ kw,
                                          const float* __restrict__ ROPE, bf16_t* __restrict__ QN, bf16_t* __restrict__ KN) {
    OPAQUE_LANE(); (void)lane;
    for (int gid = blockIdx.x * 512 + t_; gid < S * 10; gid += F.G * 512) {
        const int t = gid / 10, hh = gid % 10;
        const bool isq = hh < 8;
        const bf16_t* src = isq ? QR + (size_t)t * 512 + hh * 64 : KR + (size_t)t * 128 + (hh - 8) * 64;
        bf16_t* dst = isq ? QN + (size_t)t * 512 + hh * 64 : KN + (size_t)t * 128 + (hh - 8) * 64;
        const float* w = isq ? qw : kw;
        float f[64]; float ss = 0.f;
#pragma unroll
        for (int i = 0; i < 8; ++i) { const u32x4 q = *(const u32x4*)(src + 8 * i);
#pragma unroll
            for (int j = 0; j < 4; ++j) { f[8 * i + 2 * j] = bflo(q[j]); f[8 * i + 2 * j + 1] = bfhi(q[j]); } }
#pragma unroll
        for (int i = 0; i < 64; ++i) ss += f[i] * f[i];
        const float rn = rsqrtf(ss * (1.0f / 64.0f) + EPS), sc = isq ? C2 : 1.0f;
#pragma unroll
        for (int i = 0; i < 16; ++i) { const f32x4 wv = *(const f32x4*)(w + 4 * i);
            f[4 * i] *= rn * wv.x; f[4 * i + 1] *= rn * wv.y; f[4 * i + 2] *= rn * wv.z; f[4 * i + 3] *= rn * wv.w; }
        float o[64];
#pragma unroll
        for (int ax = 0; ax < 2; ++ax) {
            const float* tb = ROPE + (size_t)(ax == 0 ? (t >> 6) : (t & 63)) * 32;
#pragma unroll
            for (int i2 = 0; i2 < 8; ++i2) { const f32x4 cs = *(const f32x4*)(tb + 4 * i2);
#pragma unroll
                for (int k = 0; k < 2; ++k) { const int i = 2 * i2 + k; const float c_ = k ? cs.z : cs.x, s_ = k ? cs.w : cs.y;
                    const float x1 = f[ax * 32 + i], x2 = f[ax * 32 + 16 + i];
                    o[ax * 32 + i] = (x1 * c_ - x2 * s_) * sc; o[ax * 32 + 16 + i] = (x2 * c_ + x1 * s_) * sc; } }
        }
#pragma unroll
        for (int i = 0; i < 8; ++i) { u32x4 q;
#pragma unroll
            for (int j = 0; j < 4; ++j) q[j] = pk2(o[8 * i + 2 * j], o[8 * i + 2 * j + 1]);
            *(u32x4*)(dst + 8 * i) = q; }
    }
}
__device__ __forceinline__ void ph_hgfin(Frame& F, const float* __restrict__ OF, const bf16_t* __restrict__ HG, const float* __restrict__ w, bf16_t* __restrict__ OHG) {
    OPAQUE_LANE();
    const int gw = F.vcu * NWAVES + F.wave, NGW = F.G * NWAVES;
    const int e0 = (lane & 15) * 8;
    const f32x4 w0 = *(const f32x4*)(w + e0), w1 = *(const f32x4*)(w + e0 + 4);
    for (int t = gw; t < S; t += NGW) {
        const size_t off = (size_t)t * 512 + lane * 8;
        const f32x4 a0 = *(const f32x4*)(OF + off), a1 = *(const f32x4*)(OF + off + 4), b0 = *(const f32x4*)(OF + (size_t)S * 512 + off), b1 = *(const f32x4*)(OF + (size_t)S * 512 + off + 4);
        const f32x4 s0 = a0 + b0, s1 = a1 + b1;
        float ss = (s0.x * s0.x + s0.y * s0.y) + (s0.z * s0.z + s0.w * s0.w) + (s1.x * s1.x + s1.y * s1.y) + (s1.z * s1.z + s1.w * s1.w);
        ss += __shfl_xor(ss, 1); ss += __shfl_xor(ss, 2); ss += __shfl_xor(ss, 4); ss += __shfl_xor(ss, 8);
        const float r = rsqrtf(ss * (1.0f / 128.0f) + EPS);
        const u32x4 g = *(const u32x4*)(HG + off);
        u32x4 o;
        o.x = pk2(s0.x * r * w0.x * bflo(g.x), s0.y * r * w0.y * bfhi(g.x));
        o.y = pk2(s0.z * r * w0.z * bflo(g.y), s0.w * r * w0.w * bfhi(g.y));
        o.z = pk2(s1.x * r * w1.x * bflo(g.z), s1.y * r * w1.y * bfhi(g.z));
        o.w = pk2(s1.z * r * w1.z * bflo(g.w), s1.w * r * w1.w * bfhi(g.w));
        *(u32x4*)(OHG + off) = o;
    }
}
__device__ __forceinline__ void ph_norm2_router(Frame& F, const float* __restrict__ X1, const float* __restrict__ w, const float* __restrict__ scale, const float* __restrict__ shift,
                                                const float* __restrict__ wr, bf16_t* __restrict__ HB, float* __restrict__ AFF) {
    OPAQUE_LANE();
    LAS float* WT = (LAS float*)F.lds;
    for (int dd = t_; dd < D; dd += NWAVES * 64) {
        const GAS f32x4* s = (const GAS f32x4*)((const GAS float*)wr + (size_t)dd * 16);
        const f32x4 a = s[0], b = s[1], c = s[2], e = s[3];
        WT[0 * D + dd] = a.x; WT[1 * D + dd] = a.y; WT[2 * D + dd] = a.z; WT[3 * D + dd] = a.w; WT[4 * D + dd] = b.x; WT[5 * D + dd] = b.y; WT[6 * D + dd] = b.z; WT[7 * D + dd] = b.w;
        WT[8 * D + dd] = c.x; WT[9 * D + dd] = c.y; WT[10 * D + dd] = c.z; WT[11 * D + dd] = c.w; WT[12 * D + dd] = e.x; WT[13 * D + dd] = e.y; WT[14 * D + dd] = e.z; WT[15 * D + dd] = e.w;
    }
    __syncthreads();
    const int gw = F.vcu * NWAVES + F.wave, NGW = F.G * NWAVES;
    for (int row = gw; row < S; row += 2 * NGW) {
        const int row1 = (row + NGW < S) ? row + NGW : row;
        const f32x4* xr0 = (const f32x4*)(X1 + (size_t)row * D) + lane; const f32x4* xr1 = (const f32x4*)(X1 + (size_t)row1 * D) + lane;
        f32x4 v0[4], v1[4], h0[4], h1[4]; float ss0 = 0.f, ss1 = 0.f;
#pragma unroll
        for (int j = 0; j < 4; ++j) { v0[j] = xr0[64 * j]; v1[j] = xr1[64 * j]; }
#pragma unroll
        for (int j = 0; j < 4; ++j) { ss0 += (v0[j].x * v0[j].x + v0[j].y * v0[j].y) + (v0[j].z * v0[j].z + v0[j].w * v0[j].w); ss1 += (v1[j].x * v1[j].x + v1[j].y * v1[j].y) + (v1[j].z * v1[j].z + v1[j].w * v1[j].w); }
        ss0 = wave_sum(ss0); ss1 = wave_sum(ss1);
        norm_mod_row(v0, ss0, w, scale, shift, HB + (size_t)row * D, lane, h0);
        norm_mod_row(v1, ss1, w, scale, shift, HB + (size_t)row1 * D, lane, h1);
        LAS float* wt = WT + 4 * lane; asm volatile("" : "+v"(wt));
        f32x4 lg0[4], lg1[4];
#pragma unroll
        for (int e = 0; e < 16; ++e) {
            float a0 = 0.f, a1 = 0.f;
#pragma unroll
            for (int j = 0; j < 4; ++j) { const f32x4 ww = *(const LAS f32x4*)(wt + e * D + 256 * j);
                a0 += (h0[j].x * ww.x + h0[j].y * ww.y) + (h0[j].z * ww.z + h0[j].w * ww.w); a1 += (h1[j].x * ww.x + h1[j].y * ww.y) + (h1[j].z * ww.z + h1[j].w * ww.w); }
            lg0[e >> 2][e & 3] = wave_sum(a0); lg1[e >> 2][e & 3] = wave_sum(a1);
        }
#pragma unroll
        for (int rr = 0; rr < 2; ++rr) {
            f32x4 (&lgv)[4] = rr ? lg1 : lg0;
            float mx = -1e30f;
#pragma unroll
            for (int e4 = 0; e4 < 4; ++e4) mx = fmaxf(mx, fmaxf(fmaxf(lgv[e4].x, lgv[e4].y), fmaxf(lgv[e4].z, lgv[e4].w)));
            float den = 0.f;
#pragma unroll
            for (int e4 = 0; e4 < 4; ++e4) { lgv[e4].x = __expf(lgv[e4].x - mx); lgv[e4].y = __expf(lgv[e4].y - mx); lgv[e4].z = __expf(lgv[e4].z - mx); lgv[e4].w = __expf(lgv[e4].w - mx);
                den += (lgv[e4].x + lgv[e4].y) + (lgv[e4].z + lgv[e4].w); }
            const float inv = 1.0f / den;
            const f32x4 s8a = (lane & 8) ? lgv[2] : lgv[0], s8b = (lane & 8) ? lgv[3] : lgv[1];
            const f32x4 s4 = (lane & 4) ? s8b : s8a;
            const float s2a = (lane & 2) ? s4.z : s4.x, s2b = (lane & 2) ? s4.w : s4.y;
            const float mine = ((lane & 1) ? s2b : s2a) * inv;
            const int rw = rr ? row1 : row;
            if (lane < 16 && (rr == 0 || row1 != row)) AFF[(size_t)lane * S + rw] = mine;
        }
    }
    __syncthreads();
}
__device__ __forceinline__ void ph_topk(Frame& F, LAS unsigned char* lds, int e, const float* __restrict__ AFF, int* __restrict__ IDX, float* __restrict__ TOPW, int* __restrict__ SLOT) {
    LAS unsigned* hist = (LAS unsigned*)lds;
    LAS unsigned* shv = hist + 256;
    LAS unsigned* scan = hist + 512;
    OPAQUE_LANE(); (void)lane; const int tid = t_;
    const unsigned* vals = (const unsigned*)(AFF + (size_t)e * S);
    unsigned u[32];
#pragma unroll
    for (int i = 0; i < 8; ++i) { const u32x4 q = *(const u32x4*)(vals + tid * 32 + 4 * i); u[4 * i] = q.x; u[4 * i + 1] = q.y; u[4 * i + 2] = q.z; u[4 * i + 3] = q.w; }
    if (tid == 0) { shv[0] = 0u; shv[1] = CAP; }
    __syncthreads();
    for (int pass = 3; pass >= 0; --pass) {
        const int shift = pass * 8;
        const unsigned mask = pass == 3 ? 0u : (0xFFFFFFFFu << (shift + 8));
        if (tid < 256) hist[tid] = 0u;
        __syncthreads();
        const unsigned prefix = shv[0];
#pragma unroll
        for (int i = 0; i < 32; ++i) if ((u[i] & mask) == (prefix & mask)) __hip_atomic_fetch_add(&hist[(u[i] >> shift) & 255u], 1u, __ATOMIC_RELAXED, __HIP_MEMORY_SCOPE_WORKGROUP);
        __syncthreads();
        if (tid == 0) {
            unsigned kk = shv[1], cum = 0u; int b = 255;
            for (; b > 0; --b) { const unsigned hb = hist[b]; if (cum + hb >= kk) break; cum += hb; }
            shv[1] = kk - cum; shv[0] = prefix | ((unsigned)b << shift);
        }
        __syncthreads();
    }
    const unsigned T = shv[0], need_eq = shv[1];
    unsigned ceq = 0u;
#pragma unroll
    for (int i = 0; i < 32; ++i) ceq += (u[i] == T) ? 1u : 0u;
    scan[tid] = ceq; __syncthreads();
    for (int off = 1; off < 512; off <<= 1) { const unsigned tv = tid >= off ? scan[tid - off] : 0u; __syncthreads(); scan[tid] += tv; __syncthreads(); }
    unsigned eq_rank = scan[tid] - ceq;
    __syncthreads();
    unsigned selmask = 0u, csel = 0u;
#pragma unroll
    for (int i = 0; i < 32; ++i) { bool sel = u[i] > T; if (u[i] == T) { sel = eq_rank < need_eq; ++eq_rank; } if (sel) { selmask |= 1u << i; ++csel; } }
    scan[tid] = csel; __syncthreads();
    for (int off = 1; off < 512; off <<= 1) { const unsigned tv = tid >= off ? scan[tid - off] : 0u; __syncthreads(); scan[tid] += tv; __syncthreads(); }
    unsigned slot = scan[tid] - csel;
#pragma unroll
    for (int i = 0; i < 32; ++i) {
        const int t = tid * 32 + i; int sl = -1;
        if (selmask & (1u << i)) { sl = (int)slot; ++slot; if (sl < CAP) { IDX[e * CAP + sl] = t; TOPW[e * CAP + sl] = __uint_as_float(u[i]); } }
        SLOT[(size_t)e * S + t] = sl < CAP ? sl : -1;
    }
    __syncthreads();
}
__device__ __forceinline__ void ph_combine(Frame& F, const float* __restrict__ X1, const bf16_t* __restrict__ YE, const int* __restrict__ SLOT, const float* __restrict__ gate,
                                           float* __restrict__ xout, const float* __restrict__ w, const float* __restrict__ scale, const float* __restrict__ shift, bf16_t* __restrict__ HB, bool do_norm) {
    OPAQUE_LANE();
    const int gw = F.vcu * NWAVES + F.wave, NGW = F.G * NWAVES;
    for (int row = gw; row < S; row += 2 * NGW) {
        const bool two = row + NGW < S; const int row1 = two ? row + NGW : row;
        const int sl0 = lane < NE ? SLOT[(size_t)lane * S + row] : -1, sl1 = lane < NE ? SLOT[(size_t)lane * S + row1] : -1;
        const f32x4* xr0 = (const f32x4*)(X1 + (size_t)row * D) + lane; const f32x4* xr1 = (const f32x4*)(X1 + (size_t)row1 * D) + lane;
        f32x4 v0[4], v1[4];
#pragma unroll
        for (int j = 0; j < 4; ++j) { v0[j] = xr0[64 * j]; v1[j] = xr1[64 * j]; }
        f32x4 acc0[4], acc1[4];
#pragma unroll
        for (int j = 0; j < 4; ++j) { acc0[j] = f32x4{0.f, 0.f, 0.f, 0.f}; acc1[j] = acc0[j]; }
        unsigned m0 = (unsigned)__ballot(sl0 >= 0) & 0xffffu, m1 = (unsigned)__ballot(sl1 >= 0) & 0xffffu;
        while (m0 | m1) {
            const int e0 = m0 ? __builtin_ctz(m0) : 0, e1 = m1 ? __builtin_ctz(m1) : 0;
            const float f0 = m0 ? 1.f : 0.f, f1 = m1 ? 1.f : 0.f;
            const int s0 = m0 ? __builtin_amdgcn_readlane(sl0, e0) : 0, s1 = m1 ? __builtin_amdgcn_readlane(sl1, e1) : 0;
            m0 &= m0 - 1u; m1 &= m1 - 1u;
            const bf16_t* y0 = YE + ((size_t)e0 * CAP + s0) * D + 4 * lane; const bf16_t* y1 = YE + ((size_t)e1 * CAP + s1) * D + 4 * lane;
            u32x2 q0[4], q1[4];
#pragma unroll
            for (int j = 0; j < 4; ++j) { q0[j] = *(const u32x2*)(y0 + 256 * j); q1[j] = *(const u32x2*)(y1 + 256 * j); }
#pragma unroll
            for (int j = 0; j < 4; ++j) { acc0[j].x += f0 * bflo(q0[j].x); acc0[j].y += f0 * bfhi(q0[j].x); acc0[j].z += f0 * bflo(q0[j].y); acc0[j].w += f0 * bfhi(q0[j].y);
                                          acc1[j].x += f1 * bflo(q1[j].x); acc1[j].y += f1 * bfhi(q1[j].x); acc1[j].z += f1 * bflo(q1[j].y); acc1[j].w += f1 * bfhi(q1[j].y); }
        }
        f32x4 h[4]; float ss0 = 0.f, ss1 = 0.f;
#pragma unroll
        for (int j = 0; j < 4; ++j) { const f32x4 gv = *(const f32x4*)(gate + 4 * lane + 256 * j); v0[j] = v0[j] + gv * acc0[j]; v1[j] = v1[j] + gv * acc1[j];
            ((f32x4*)(xout + (size_t)row * D) + lane)[64 * j] = v0[j]; if (two) ((f32x4*)(xout + (size_t)row1 * D) + lane)[64 * j] = v1[j];
            ss0 += (v0[j].x * v0[j].x + v0[j].y * v0[j].y) + (v0[j].z * v0[j].z + v0[j].w * v0[j].w); ss1 += (v1[j].x * v1[j].x + v1[j].y * v1[j].y) + (v1[j].z * v1[j].z + v1[j].w * v1[j].w); }
        if (do_norm) { ss0 = wave_sum(ss0); ss1 = wave_sum(ss1); norm_mod_row(v0, ss0, w, scale, shift, HB + (size_t)row * D, lane, h); if (two) norm_mod_row(v1, ss1, w, scale, shift, HB + (size_t)row1 * D, lane, h); }
    }
}

__global__ void __launch_bounds__(NWAVES * 64, 2) mega(Params p) {
    extern __shared__ __attribute__((aligned(16))) unsigned char lds[];
    Frame F;
    F.lds = (LAS unsigned char*)lds;
    volatile LAS unsigned* MISC = (volatile LAS unsigned*)(F.lds + MISC_OFF);
    F.tid = threadIdx.x; F.lane = F.tid & 63; F.wave = __builtin_amdgcn_readfirstlane(F.tid >> 6);
    F.G = gridDim.x; { const int bx = blockIdx.x; F.vcu = (F.G % 8 == 0) ? (bx % 8) * (F.G / 8) + bx / 8 : bx; }
    unsigned char* ws = p.ws;
    unsigned* ctl = (unsigned*)(ws + WS_CTL);
    for (int u = F.tid; u < (LDS_BYTES - LDSCTL_OFF) / 4; u += NWAVES * 64) ((LAS unsigned*)(F.lds + LDSCTL_OFF))[u] = 0u;
    __syncthreads();
    XcdBarrier bar = xcd_barrier_post(ctl + CW_BAR + p.li * XCD_BAR_WORDS, MISC + 8);
    const int lo = p.ph_lo, hi = p.ph_hi;
#define IN(k) (lo <= (k) && (k) < hi)
#define SEAM(k) do { if (IN(k) && IN((k) + 1)) xcd_barrier(bar); } while (0)
#define REFRESH() do { F.lane = lane_id_opaque(); F.tid = F.wave * 64 + F.lane; } while (0)

#define WSP(T, off) ((T*)(GAS T*)(wsl + (off)))
#define WSL() unsigned char* wsl = p.ws; asm volatile("" : "+s"(wsl))
    LAS float* scr = (LAS float*)(F.lds + RING_OFF + F.wave * 8704);

    if (IN(PH_PRO)) { REFRESH(); WSL();
        mod_units(F, p);
        for (int l = 0; l < NL; ++l) {
            conv_matrix(F, p.w_in + (size_t)l * D * INW, D, INW, WSP(bf16_t, WS_WIN) + (size_t)l * INW * D, scr);
            conv_matrix(F, p.w_ba + (size_t)l * 512 * D, 512, D, WSP(bf16_t, WS_WBA) + (size_t)l * D * 512, scr);
            conv_matrix(F, p.w_bh + (size_t)l * 512 * D, 512, D, WSP(bf16_t, WS_WBH) + (size_t)l * D * 512, scr);
            conv_matrix(F, p.w_out + (size_t)l * D * D, D, D, WSP(bf16_t, WS_WOUT) + (size_t)l * D * D, scr);
        }
        for (int rep_ = 0; rep_ < REP_PRO; ++rep_) conv_experts(F, p, 0, scr);
        ph_rope_table(F, WSP(float, WS_ROPE));
    }
    SEAM(PH_PRO);
    if (IN(PH_NORM1)) { REFRESH(); WSL(); ph_norm1(F, p.x, p.norm_mix_w, WSP(float, WS_MOD) + 1 * D, WSP(float, WS_MOD) + 0 * D, WSP(bf16_t, WS_HB)); }
    SEAM(PH_NORM1);

    for (int l = 0; l < NL; ++l) {
        const int pb = PH_L0 + l * NPL;
        if (IN(pb + P_G1)) { WSL();
            pg8::Gemm g{WSP(bf16_t, WS_HB), WSP(bf16_t, WS_WIN) + (size_t)l * INW * D, S, INW, D}; pg8::StaticOrder So; So.init(S, INW, F.G, (int)blockIdx.x);
            pg8::EpiInproj E{WSP(bf16_t, WS_QR), WSP(bf16_t, WS_KR), WSP(bf16_t, WS_VV), WSP(bf16_t, WS_HQ), WSP(bf16_t, WS_KF), WSP(bf16_t, WS_HV), WSP(bf16_t, WS_HG), WSP(bf16_t, WS_GG), WSP(float, WS_LF), WSP(float, WS_LBV) + l * 1024};
            pg8::gemm_phase<pg8::EpiInproj, pg8::StaticOrder, true, true>(F.lds + RING_OFF, g, So, E, F.wave);
        }
        SEAM(pb + P_G1);
        if (IN(pb + P_QKP)) { WSL();
            ph_qkprep(F, WSP(bf16_t, WS_QR), WSP(bf16_t, WS_KR), p.q_norm_w + l * 64, p.k_norm_w + l * 64, WSP(float, WS_ROPE), WSP(bf16_t, WS_QN), WSP(bf16_t, WS_KN));
            for (int rep_ = 0; rep_ < REP_HG; ++rep_) for (int u = blockIdx.x; u < 256; u += F.G) hg::segment<false>(F.lds, u, WSP(bf16_t, WS_HQ), WSP(float, WS_LF), WSP(bf16_t, WS_KF), WSP(bf16_t, WS_HV), WSP(float, WS_HST), WSP(float, WS_HST + 16 * MiB), nullptr, F.wave);
        }
        SEAM(pb + P_QKP);
        if (IN(pb + P_HGB)) { WSL(); OPAQUE_LANE(); (void)lane;
            for (int gid = blockIdx.x * 512 + t_; gid < 8 * 16384; gid += F.G * 512) hg::carry(WSP(float, WS_HST), WSP(float, WS_HST + 16 * MiB), gid);
        }
        SEAM(pb + P_HGB);
        if (IN(pb + P_HGC)) { WSL();
            for (int rep_ = 0; rep_ < REP_HG; ++rep_) for (int u = blockIdx.x; u < 256; u += F.G) hg::segment<true>(F.lds, u, WSP(bf16_t, WS_HQ), WSP(float, WS_LF), WSP(bf16_t, WS_KF), WSP(bf16_t, WS_HV), WSP(float, WS_HST), WSP(float, WS_HST + 16 * MiB), WSP(float, WS_OF), F.wave);
        }
        SEAM(pb + P_HGC);
        if (IN(pb + P_ATT)) { WSL();
            ph_hgfin(F, WSP(float, WS_OF), WSP(bf16_t, WS_HG), p.hg_norm_w + l * 128, WSP(bf16_t, WS_OHG));
            const attn_body::AttnTensors AT{(const attn_body::bf16*)WSP(bf16_t, WS_QN), (const attn_body::bf16*)WSP(bf16_t, WS_KN), (const attn_body::bf16*)WSP(bf16_t, WS_VV), (attn_body::bf16*)WSP(bf16_t, WS_OATT)};
            const attn_body::StaticOrder So((int)F.G, (int)blockIdx.x);
            for (int rep_ = 0; rep_ < REP_ATT; ++rep_) attn_body::attn_phase<attn_body::StaticOrder>((char*)lds + RING_OFF, AT, So, F.wave);
        }
        SEAM(pb + P_ATT);
        if (IN(pb + P_G2)) { WSL();
            { pg8::Gemm g{WSP(bf16_t, WS_OATT), WSP(bf16_t, WS_WBA) + (size_t)l * D * 512, S, D, 512}; pg8::StaticOrder So; So.init(S, D, F.G, (int)blockIdx.x);
              pg8::EpiBrA E{WSP(bf16_t, WS_GG), WSP(float, WS_MP)};
              pg8::gemm_phase<pg8::EpiBrA, pg8::StaticOrder, false, true>(F.lds + RING_OFF, g, So, E, F.wave); }
            __syncthreads();
            { pg8::Gemm g{WSP(bf16_t, WS_OHG), WSP(bf16_t, WS_WBH) + (size_t)l * D * 512, S, D, 512}; pg8::StaticOrder So; So.init(S, D, F.G, (int)blockIdx.x);
              pg8::EpiBrH E{WSP(bf16_t, WS_GG), WSP(float, WS_MP), WSP(bf16_t, WS_MG)};
              pg8::gemm_phase<pg8::EpiBrH, pg8::StaticOrder, false, true>(F.lds + RING_OFF, g, So, E, F.wave); }
        }
        SEAM(pb + P_G2);
        if (IN(pb + P_G3)) { WSL();
            pg8::Gemm g{WSP(bf16_t, WS_MG), WSP(bf16_t, WS_WOUT) + (size_t)l * D * D, S, D, D}; pg8::StaticOrder So; So.init(S, D, F.G, (int)blockIdx.x);
            pg8::EpiOut E{l == 0 ? p.x : WSP(float, WS_X2), WSP(float, WS_MOD) + l * 6 * D + 2 * D, WSP(float, WS_X1)};
            pg8::gemm_phase<pg8::EpiOut, pg8::StaticOrder, false, true>(F.lds + RING_OFF, g, So, E, F.wave);
        }
        SEAM(pb + P_G3);
        if (IN(pb + P_N2R)) { WSL();
            for (int rep_ = 0; rep_ < REP_ROW; ++rep_) ph_norm2_router(F, WSP(float, WS_X1), p.norm_ffn_w + l * D, WSP(float, WS_MOD) + l * 6 * D + 4 * D, WSP(float, WS_MOD) + l * 6 * D + 3 * D, p.w_router + (size_t)l * D * NE, WSP(bf16_t, WS_HB), WSP(float, WS_AFF));
        }
        SEAM(pb + P_N2R);
        if (IN(pb + P_TOPK)) { WSL();
            for (int e = blockIdx.x; e < NE; e += F.G) ph_topk(F, F.lds, e, WSP(float, WS_AFF), WSP(int, WS_IDX), WSP(float, WS_TOPW), WSP(int, WS_SLOT));
        }
        SEAM(pb + P_TOPK);
        if (IN(pb + P_GATH)) { REFRESH(); WSL(); for (int rep_ = 0; rep_ < REP_ROW; ++rep_) ph_gather(F, WSP(bf16_t, WS_HB), WSP(int, WS_IDX), WSP(bf16_t, WS_XE)); }
        SEAM(pb + P_GATH);
        if (IN(pb + P_G4)) { WSL();
            pg8::Gemm g{WSP(bf16_t, WS_XE), WSP(bf16_t, WS_WGU), NE * CAP, NE * 4096, D}; pg8::GroupOrder So; So.init(16, F.G, (int)blockIdx.x);
            pg8::EpiGU E{WSP(bf16_t, WS_HID)};
            pg8::gemm_phase<pg8::EpiGU, pg8::GroupOrder, true, true>(F.lds + RING_OFF, g, So, E, F.wave);
        }
        SEAM(pb + P_G4);
        if (IN(pb + P_G5)) { WSL();
            pg8::Gemm g{WSP(bf16_t, WS_HID), WSP(bf16_t, WS_WD), NE * CAP, NE * 1024, FF}; pg8::GroupOrder So; So.init(4, F.G, (int)blockIdx.x);
            pg8::EpiDown E{WSP(bf16_t, WS_YE), WSP(float, WS_TOPW)};
            pg8::gemm_phase<pg8::EpiDown, pg8::GroupOrder, true, true>(F.lds + RING_OFF, g, So, E, F.wave);
        }
        SEAM(pb + P_G5);
        if (IN(pb + P_COMB)) { WSL();
            const bool last = (l + 1 == NL); const int ln = last ? l : l + 1;
            for (int rep_ = 0; rep_ < REP_ROW; ++rep_) ph_combine(F, WSP(float, WS_X1), WSP(bf16_t, WS_YE), WSP(int, WS_SLOT), WSP(float, WS_MOD) + l * 6 * D + 5 * D, last ? p.out : WSP(float, WS_X2),
                       p.norm_mix_w + ln * D, WSP(float, WS_MOD) + ln * 6 * D + 1 * D, WSP(float, WS_MOD) + ln * 6 * D + 0 * D, WSP(bf16_t, WS_HB), !last);
            if (!last) { REFRESH(); conv_experts(F, p, l + 1, scr); }
        }
        SEAM(pb + P_COMB);
    }
#undef IN
#undef SEAM
}

#ifndef N_LAUNCH_MODE
#define N_LAUNCH_MODE 1
#endif
static int g_grid = 0;
extern "C" void kernel_launch(void* const* d_in, const int* in_sizes, int n_in, void* d_out, int out_size, void* d_ws, size_t ws_size, hipStream_t stream) {
    if (n_in != 18 || out_size != S * D || ws_size < WS_END) { fprintf(stderr, "kernel_launch: unexpected shapes (n_in %d out %d ws %zu)\n", n_in, out_size, ws_size); return; }
    if (g_grid == 0) {
        int dev = 0, cus = 0;
        if (hipGetDevice(&dev) != hipSuccess || hipDeviceGetAttribute(&cus, hipDeviceAttributeMultiprocessorCount, dev) != hipSuccess) { g_grid = -1; return; }
        if (hipFuncSetAttribute((const void*)mega, hipFuncAttributeMaxDynamicSharedMemorySize, LDS_BYTES) != hipSuccess) { g_grid = -1; return; }
        int per_cu = 0;
        if (hipOccupancyMaxActiveBlocksPerMultiprocessor(&per_cu, (const void*)mega, NWAVES * 64, LDS_BYTES) != hipSuccess || per_cu < 1) { fprintf(stderr, "occupancy query: %d\n", per_cu); }
        (void)hipGetLastError();
        g_grid = cus;
    }
    if (g_grid < 0) return;
    unsigned char* ws = (unsigned char*)d_ws;
    (void)hipMemsetAsync(ws + WS_CTL, 0, 1 * MiB, stream);
    Params p{};
    p.x = (const float*)d_in[0]; p.c = (const float*)d_in[1]; p.ada_w = (const float*)d_in[2]; p.ada_b = (const float*)d_in[3]; p.norm_mix_w = (const float*)d_in[4];
    p.norm_ffn_w = (const float*)d_in[5]; p.w_in = (const float*)d_in[6]; p.q_norm_w = (const float*)d_in[7]; p.k_norm_w = (const float*)d_in[8]; p.hlb = (const float*)d_in[9];
    p.hg_norm_w = (const float*)d_in[10]; p.w_ba = (const float*)d_in[11]; p.w_bh = (const float*)d_in[12]; p.w_out = (const float*)d_in[13]; p.w_router = (const float*)d_in[14];
    p.w_eg = (const float*)d_in[15]; p.w_eu = (const float*)d_in[16]; p.w_ed = (const float*)d_in[17];
    p.out = (float*)d_out; p.ws = ws;
#if N_LAUNCH_MODE == 1
    p.ph_lo = 0; p.ph_hi = PH_END; p.li = 0; p.pad = 0;
    hipLaunchKernelGGL(mega, dim3(g_grid), dim3(NWAVES * 64), LDS_BYTES, stream, p);
#else
    for (int k = 0; k < PH_END; ++k) { p.ph_lo = k; p.ph_hi = k + 1; p.li = k; p.pad = 0; hipLaunchKernelGGL(mega, dim3(g_grid), dim3(NWAVES * 64), LDS_BYTES, stream, p); }
#endif
}
```

```cpp
#include <hip/hip_runtime.h>
#include <cstdio>
#include <cstdint>

typedef unsigned short bf16_t;
typedef float f32x4 __attribute__((ext_vector_type(4)));
typedef float f32x16 __attribute__((ext_vector_type(16)));
typedef unsigned u32x4 __attribute__((ext_vector_type(4)));
typedef unsigned u32x2 __attribute__((ext_vector_type(2)));

constexpr int S = 16384, D = 1024, NL = 2, INW = 5376;
constexpr int NE = 16, CAP = 2048, FF = 2048;
constexpr float EPS = 1e-6f;
constexpr float C2 = 0.125f * 1.4426950408889634f;
constexpr int C_AQ = 0, C_AK = 512, C_AV = 640, C_HQ = 768, C_ZF = 1280, C_ZB = 1792, C_HI = 2304, C_HGT = 2816, C_GL = 3328;

constexpr size_t MiB = 1u << 20;
constexpr size_t WS_CTL = 0;
constexpr size_t WS_MOD = 1 * MiB;
constexpr size_t WS_LBV = WS_MOD + 64 * 1024;
constexpr size_t WS_IDX = WS_MOD + 128 * 1024;
constexpr size_t WS_TOPW = WS_IDX + 128 * 1024;
constexpr size_t WS_ROPE = WS_MOD + 512 * 1024;
constexpr size_t WS_AFF = 2 * MiB;
constexpr size_t WS_SLOT = 3 * MiB;
constexpr size_t WS_HB = 4 * MiB;
constexpr size_t WS_QR = 36 * MiB;
constexpr size_t WS_KR = 52 * MiB;
constexpr size_t WS_VV = 56 * MiB;
constexpr size_t WS_QN = 60 * MiB;
constexpr size_t WS_KN = 76 * MiB;
constexpr size_t WS_HQ = 80 * MiB;
constexpr size_t WS_LF = 96 * MiB;
constexpr size_t WS_KF = 160 * MiB;
constexpr size_t WS_HV = 192 * MiB;
constexpr size_t WS_HG = 208 * MiB;
constexpr size_t WS_GG = 224 * MiB;
constexpr size_t WS_OATT = 288 * MiB;
constexpr size_t WS_OF = 304 * MiB;
constexpr size_t WS_OHG = 368 * MiB;
constexpr size_t WS_MP = 384 * MiB;
constexpr size_t WS_MG = 448 * MiB;
constexpr size_t WS_HB8 = 36 * MiB;
constexpr size_t WS_XE8 = 52 * MiB;
constexpr size_t WS_HID8 = 100 * MiB;
constexpr size_t WS_XE = 36 * MiB;
constexpr size_t WS_HID = 100 * MiB;
constexpr size_t WS_YE = 228 * MiB;
constexpr size_t WS_X1 = 480 * MiB;
constexpr size_t WS_X2 = 544 * MiB;
constexpr size_t WS_WIN = 608 * MiB;
constexpr size_t WS_WBA = 630 * MiB;
constexpr size_t WS_WBH = 632 * MiB;
constexpr size_t WS_WOUT = 634 * MiB;
constexpr size_t WS_WGU = 638 * MiB;
constexpr size_t WS_WD = 766 * MiB;
constexpr size_t WS_HST = 830 * MiB;
constexpr size_t WS_END = 900 * MiB;
static_assert(WS_END <= 1024 * MiB, "workspace");

__device__ __forceinline__ float bf2f(bf16_t v) { return __uint_as_float((unsigned)v << 16); }
__device__ __forceinline__ bf16_t f2bf(float f) { unsigned u = __float_as_uint(f); return (bf16_t)((u + 0x7fffu + ((u >> 16) & 1u)) >> 16); }
__device__ __forceinline__ unsigned pk2(float lo, float hi) { return (unsigned)f2bf(lo) | ((unsigned)f2bf(hi) << 16); }
__device__ __forceinline__ float bflo(unsigned w) { return __uint_as_float(w << 16); }
__device__ __forceinline__ float bfhi(unsigned w) { return __uint_as_float(w & 0xffff0000u); }
__device__ __forceinline__ float sigmoidf_(float v) { return __builtin_amdgcn_rcpf(1.0f + __expf(-v)); }
__device__ __forceinline__ float siluf_(float v) { return v * __builtin_amdgcn_rcpf(1.0f + __expf(-v)); }
__device__ __forceinline__ float wave_sum(float v) {
#pragma unroll
    for (int o = 1; o < 64; o <<= 1) v += __shfl_xor(v, o);
    return v;
}
__device__ __forceinline__ int crow(int r, int hi) { return (r & 3) + 8 * (r >> 2) + 4 * hi; }
__device__ __forceinline__ int lane_id_opaque() { int l; asm volatile("v_mbcnt_lo_u32_b32 %0, -1, 0\n\tv_mbcnt_hi_u32_b32 %0, -1, %0" : "=v"(l)); return l; }

#define GAS __attribute__((address_space(1)))
#define LAS __attribute__((address_space(3)))

namespace pg8 {
#define PG8_LAS __attribute__((address_space(3)))
typedef unsigned short bf16_t;
typedef short bf16x8 __attribute__((ext_vector_type(8)));
typedef float f32x4 __attribute__((ext_vector_type(4)));
typedef unsigned u32x4 __attribute__((ext_vector_type(4)));
constexpr int BM = 256, BK = 64, HALF = 128, HTB = HALF * BK * 2  , STAGE_BYTES = 8 * HTB, NXCD = 8, WGM = 8;

__host__ __device__ __forceinline__ int lds_byte(int r, int c) { const int st = (r >> 4) * 2 + (c >> 5), rr = r & 15, cc = c & 31, ob = rr * 64 + cc * 2; return st * 1024 + (ob ^ (((ob >> 9) & 1) << 5)); }
__host__ __device__ __forceinline__ void stage_rc(int b, int& R, int& C) { const int st = b / 1024, sb = b % 1024, swz = sb ^ (((sb >> 9) & 1) << 5); R = (st >> 1) * 16 + swz / 64; C = (st & 1) * 32 + (swz % 64) / 2; }
__host__ __device__ __forceinline__ int perm32(int rho) { const int n = rho >> 4, i = rho & 15; return 8 * (i >> 2) + 4 * n + (i & 3); }

struct Unit { int pm, pn, pb; };
struct Gemm { const bf16_t* A; const bf16_t* Bt; int M, N, K; };

struct StaticOrder {
    int nM, nN, nwg, G, c;
    __host__ __device__ void init(int M, int N, int G_, int c_) { nM = M / BM; nN = N / BM; nwg = nM * nN; G = G_; c = c_; }
    __host__ __device__ bool next(int i, Unit& u) const {
        const long L = (long)i * G + c; if (L >= nwg) return false;
        int wgid = (int)L; { const int q = nwg / NXCD, r = nwg % NXCD, xcd = wgid % NXCD, off = wgid / NXCD; wgid = (xcd < r ? xcd * (q + 1) : r * (q + 1) + (xcd - r) * q) + off; }
        const int nig = WGM * nN, gid = wgid / nig, fm = gid * WGM, gsz = (nM - fm) < WGM ? (nM - fm) : WGM;
        u.pm = fm + ((wgid % nig) % gsz); u.pn = (wgid % nig) / gsz; u.pb = u.pn; return true;
    }
    __device__ __forceinline__ void a_ready(const Unit&) const {}
    __device__ __forceinline__ void done(const Unit&) const {}
};

typedef float f32x2_c __attribute__((ext_vector_type(2))); typedef __bf16 bf16x2_c __attribute__((ext_vector_type(2)));
__device__ __forceinline__ unsigned cvt_pk_bf16(float lo, float hi) { f32x2_c v = {lo, hi}; bf16x2_c b = __builtin_convertvector(v, bf16x2_c); return __builtin_bit_cast(unsigned, b); }

typedef unsigned u32x2 __attribute__((ext_vector_type(2)));
__device__ __forceinline__ float e_bflo(unsigned w) { return __uint_as_float(w << 16); }
__device__ __forceinline__ float e_bfhi(unsigned w) { return __uint_as_float(w & 0xffff0000u); }
__device__ __forceinline__ float e_sig(float v) { return __builtin_amdgcn_rcpf(1.0f + __expf(-v)); }
__device__ __forceinline__ u32x4 pack8(const f32x4 a, const f32x4 b) { u32x4 w; w.x = cvt_pk_bf16(a[0], a[1]); w.y = cvt_pk_bf16(a[2], a[3]); w.z = cvt_pk_bf16(b[0], b[1]); w.w = cvt_pk_bf16(b[2], b[3]); return w; }

typedef int i32x4_ __attribute__((ext_vector_type(4))); typedef int i32x8_ __attribute__((ext_vector_type(8)));
__device__ __forceinline__ i32x8_ pg8_cat(const bf16x8 lo, const bf16x8 hi) { return __builtin_shufflevector(__builtin_bit_cast(i32x4_, lo), __builtin_bit_cast(i32x4_, hi), 0, 1, 2, 3, 4, 5, 6, 7); }
__device__ __forceinline__ u32x2 pack8_fp8(const f32x4 a, const f32x4 b) { int w0 = 0, w1 = 0;
    w0 = __builtin_amdgcn_cvt_pk_fp8_f32(a[0], a[1], w0, false); w0 = __builtin_amdgcn_cvt_pk_fp8_f32(a[2], a[3], w0, true);
    w1 = __builtin_amdgcn_cvt_pk_fp8_f32(b[0], b[1], w1, false); w1 = __builtin_amdgcn_cvt_pk_fp8_f32(b[2], b[3], w1, true);
    u32x2 r; r.x = (unsigned)w0; r.y = (unsigned)w1; return r; }
struct EpiInproj {
    static constexpr bool PERM = true, AFTER_DRAIN = false;
    bf16_t *QR, *KR, *VV, *HQ, *KF, *HV, *HG, *GG; float* LF; const float* lbv;
    __device__ __forceinline__ void operator()(const f32x4 (&acc)[2][2][4][2], const Unit& u, int wr, int wc, int fr, int fq) const {
        const int row0 = u.pm * BM + wr * 64 + fr, cl = wc * 32 + 8 * fq;
#pragma unroll
        for (int bj = 0; bj < 2; ++bj) {
            const int colg = u.pn * BM + bj * HALF;
            int kind; bf16_t* dst; int pitch, c0; int dir = 0;
            if (colg < 512) { kind = 0; dst = QR; pitch = 512; c0 = colg; }
            else if (colg < 640) { kind = 0; dst = KR; pitch = 128; c0 = colg - 512; }
            else if (colg < 768) { kind = 0; dst = VV; pitch = 128; c0 = colg - 640; }
            else if (colg < 1280) { kind = 1; dst = HQ; pitch = 512; c0 = colg - 768; }
            else if (colg < 2304) { kind = 3; dir = colg >= 1792; dst = KF + (size_t)dir * 16384 * 512; pitch = 512; c0 = colg - (dir ? 1792 : 1280); }
            else if (colg < 2816) { kind = 0; dst = HV; pitch = 512; c0 = colg - 2304; }
            else if (colg < 3328) { kind = 1; dst = HG; pitch = 512; c0 = colg - 2816; }
            else { kind = 2; dst = GG; pitch = 2048; c0 = colg - 3328; }
            c0 += cl;
            if (kind == 0) {
#pragma unroll
                for (int ai = 0; ai < 2; ++ai)
#pragma unroll
                    for (int m = 0; m < 4; ++m) *(u32x4*)(dst + (size_t)(row0 + ai * HALF + m * 16) * pitch + c0) = pack8(acc[ai][bj][m][0], acc[ai][bj][m][1]);
            } else if (kind == 1) {
#pragma unroll
                for (int ai = 0; ai < 2; ++ai)
#pragma unroll
                    for (int m = 0; m < 4; ++m) { f32x4 a = acc[ai][bj][m][0], b = acc[ai][bj][m][1];
#pragma unroll
                        for (int i = 0; i < 4; ++i) { a[i] = a[i] * e_sig(a[i]); b[i] = b[i] * e_sig(b[i]); }
                        *(u32x4*)(dst + (size_t)(row0 + ai * HALF + m * 16) * pitch + c0) = pack8(a, b); }
            } else if (kind == 2) {
#pragma unroll
                for (int ai = 0; ai < 2; ++ai)
#pragma unroll
                    for (int m = 0; m < 4; ++m) { f32x4 a = acc[ai][bj][m][0], b = acc[ai][bj][m][1];
#pragma unroll
                        for (int i = 0; i < 4; ++i) { a[i] = e_sig(a[i]); b[i] = e_sig(b[i]); }
                        *(u32x4*)(dst + (size_t)(row0 + ai * HALF + m * 16) * pitch + c0) = pack8(a, b); }
            } else {
                const f32x4 lb0 = *(const f32x4*)(lbv + dir * 512 + c0), lb1 = *(const f32x4*)(lbv + dir * 512 + c0 + 4);
                float* lf = LF + (size_t)dir * 16384 * 512;
#pragma unroll
                for (int ai = 0; ai < 2; ++ai)
#pragma unroll
                    for (int m = 0; m < 4; ++m) { const f32x4 a = acc[ai][bj][m][0], b = acc[ai][bj][m][1]; f32x4 la, lb_, ka, kb;
#pragma unroll
                        for (int i = 0; i < 4; ++i) {
                            const float sa = e_sig(a[i]), sb = e_sig(b[i]);
                            la[i] = __logf(fmaxf(lb0[i] + (1.0f - lb0[i]) * sa, 1e-6f)); ka[i] = (1.0f - lb0[i]) * (1.0f - sa);
                            lb_[i] = __logf(fmaxf(lb1[i] + (1.0f - lb1[i]) * sb, 1e-6f)); kb[i] = (1.0f - lb1[i]) * (1.0f - sb); }
                        const size_t o = (size_t)(row0 + ai * HALF + m * 16) * 512 + c0;
                        *(f32x4*)(lf + o) = la; *(f32x4*)(lf + o + 4) = lb_;
                        *(u32x4*)(dst + o) = pack8(ka, kb); }
            }
        }
    }
};
struct EpiBrA {
    static constexpr bool PERM = true, AFTER_DRAIN = false;
    const bf16_t* GG; float* MP;
    __device__ __forceinline__ void operator()(const f32x4 (&acc)[2][2][4][2], const Unit& u, int wr, int wc, int fr, int fq) const {
        const int row0 = u.pm * BM + wr * 64 + fr, col0 = u.pn * BM + wc * 32 + 8 * fq;
#pragma unroll
        for (int ai = 0; ai < 2; ++ai)
#pragma unroll
            for (int m = 0; m < 4; ++m) { const size_t r = (size_t)(row0 + ai * HALF + m * 16);
#pragma unroll
                for (int bj = 0; bj < 2; ++bj) { const int c = col0 + bj * HALF; const u32x4 g = *(const u32x4*)(GG + r * 2048 + c);
                    f32x4 a = acc[ai][bj][m][0], b = acc[ai][bj][m][1];
                    a[0] *= e_bflo(g.x); a[1] *= e_bfhi(g.x); a[2] *= e_bflo(g.y); a[3] *= e_bfhi(g.y); b[0] *= e_bflo(g.z); b[1] *= e_bfhi(g.z); b[2] *= e_bflo(g.w); b[3] *= e_bfhi(g.w);
                    *(f32x4*)(MP + r * 1024 + c) = a; *(f32x4*)(MP + r * 1024 + c + 4) = b; } }
    }
};
struct EpiBrH {
    static constexpr bool PERM = true, AFTER_DRAIN = false;
    const bf16_t* GG; const float* MP; bf16_t* MG;
    __device__ __forceinline__ void operator()(const f32x4 (&acc)[2][2][4][2], const Unit& u, int wr, int wc, int fr, int fq) const {
        const int row0 = u.pm * BM + wr * 64 + fr, col0 = u.pn * BM + wc * 32 + 8 * fq;
#pragma unroll
        for (int ai = 0; ai < 2; ++ai)
#pragma unroll
            for (int m = 0; m < 4; ++m) { const size_t r = (size_t)(row0 + ai * HALF + m * 16);
#pragma unroll
                for (int bj = 0; bj < 2; ++bj) { const int c = col0 + bj * HALF; const u32x4 g = *(const u32x4*)(GG + r * 2048 + 1024 + c);
                    f32x4 a = acc[ai][bj][m][0], b = acc[ai][bj][m][1]; const f32x4 pa = *(const f32x4*)(MP + r * 1024 + c), pb = *(const f32x4*)(MP + r * 1024 + c + 4);
                    a[0] = pa[0] + a[0] * e_bflo(g.x); a[1] = pa[1] + a[1] * e_bfhi(g.x); a[2] = pa[2] + a[2] * e_bflo(g.y); a[3] = pa[3] + a[3] * e_bfhi(g.y);
                    b[0] = pb[0] + b[0] * e_bflo(g.z); b[1] = pb[1] + b[1] * e_bfhi(g.z); b[2] = pb[2] + b[2] * e_bflo(g.w); b[3] = pb[3] + b[3] * e_bfhi(g.w);
                    *(u32x4*)(MG + r * 1024 + c) = pack8(a, b); } }
    }
};
struct EpiOut {
    static constexpr bool PERM = true, AFTER_DRAIN = false;
    const float* xin; const float* gate; float* X1;
    __device__ __forceinline__ void operator()(const f32x4 (&acc)[2][2][4][2], const Unit& u, int wr, int wc, int fr, int fq) const {
        const int row0 = u.pm * BM + wr * 64 + fr, col0 = u.pn * BM + wc * 32 + 8 * fq;
#pragma unroll
        for (int bj = 0; bj < 2; ++bj) { const int c = col0 + bj * HALF; const f32x4 g0 = *(const f32x4*)(gate + c), g1 = *(const f32x4*)(gate + c + 4);
#pragma unroll
            for (int ai = 0; ai < 2; ++ai)
#pragma unroll
                for (int m = 0; m < 4; ++m) { const size_t o = (size_t)(row0 + ai * HALF + m * 16) * 1024 + c;
                    *(f32x4*)(X1 + o) = *(const f32x4*)(xin + o) + g0 * acc[ai][bj][m][0]; *(f32x4*)(X1 + o + 4) = *(const f32x4*)(xin + o + 4) + g1 * acc[ai][bj][m][1]; } }
    }
};
struct EpiGU {
    static constexpr bool PERM = true, AFTER_DRAIN = false;
    bf16_t* HID;
    __device__ __forceinline__ void operator()(const f32x4 (&acc)[2][2][4][2], const Unit& u, int wr, int wc, int fr, int fq) const {
        const int row0 = u.pm * BM + wr * 64 + fr, col0 = u.pn * HALF + wc * 32 + 8 * fq;
#pragma unroll
        for (int ai = 0; ai < 2; ++ai)
#pragma unroll
            for (int m = 0; m < 4; ++m) { f32x4 a = acc[ai][0][m][0], b = acc[ai][0][m][1]; const f32x4 ua = acc[ai][1][m][0], ub = acc[ai][1][m][1];
#pragma unroll
                for (int i = 0; i < 4; ++i) { a[i] = a[i] * e_sig(a[i]) * ua[i]; b[i] = b[i] * e_sig(b[i]) * ub[i]; }
                *(u32x4*)(HID + (size_t)(row0 + ai * HALF + m * 16) * 2048 + col0) = pack8(a, b); }
    }
};
struct EpiGU8 {
    static constexpr bool PERM = true, AFTER_DRAIN = false;
    unsigned char* HID;
    __device__ __forceinline__ void operator()(const f32x4 (&acc)[2][2][4][2], const Unit& u, int wr, int wc, int fr, int fq) const {
        const int row0 = u.pm * BM + wr * 64 + fr, col0 = u.pn * HALF + wc * 32 + 8 * fq;
#pragma unroll
        for (int ai = 0; ai < 2; ++ai)
#pragma unroll
            for (int m = 0; m < 4; ++m) { f32x4 a = acc[ai][0][m][0], b = acc[ai][0][m][1]; const f32x4 ua = acc[ai][1][m][0], ub = acc[ai][1][m][1];
#pragma unroll
                for (int i = 0; i < 4; ++i) { const float ga = a[i] * 0.015625f, gb = b[i] * 0.015625f; a[i] = ga * e_sig(ga) * (ua[i] * 0.015625f); b[i] = gb * e_sig(gb) * (ub[i] * 0.015625f); }
                *(u32x2*)(HID + (size_t)(row0 + ai * HALF + m * 16) * 2048 + col0) = pack8_fp8(a, b); }
    }
};
struct EpiDown {
    static constexpr bool PERM = true, AFTER_DRAIN = false;
    bf16_t* YE; const float* topw; float wscale;
    __device__ __forceinline__ void operator()(const f32x4 (&acc)[2][2][4][2], const Unit& u, int wr, int wc, int fr, int fq) const {
        const int row0 = u.pm * BM + wr * 64 + fr, col0 = u.pn * BM + wc * 32 + 8 * fq;
#pragma unroll
        for (int ai = 0; ai < 2; ++ai)
#pragma unroll
            for (int m = 0; m < 4; ++m) { const int r = row0 + ai * HALF + m * 16; const float w = topw[r] * wscale;
#pragma unroll
                for (int bj = 0; bj < 2; ++bj) *(u32x4*)(YE + (size_t)r * 1024 + col0 + bj * HALF) = pack8(acc[ai][bj][m][0] * w, acc[ai][bj][m][1] * w); }
    }
};
struct GroupOrder {
    int nNe, nwg, G, c;
    __device__ void init(int nNe_, int G_, int c_) { nNe = nNe_; nwg = 16 * 8 * nNe_; G = G_; c = c_; }
    __device__ bool next(int i, Unit& u) const {
        const long L = (long)i * G + c; if (L >= nwg) return false;
        int wgid = (int)L; { const int q = nwg / NXCD, xcd = wgid % NXCD, off = wgid / NXCD; wgid = xcd * q + off; }
        const int per = 8 * nNe, e = wgid / per, w = wgid % per;
        u.pm = e * 8 + (w & 7); u.pn = w >> 3; u.pb = e * nNe + u.pn; return true;
    }
    __device__ __forceinline__ void a_ready(const Unit&) const {}
    __device__ __forceinline__ void done(const Unit&) const {}
};

template <class Epi, class Sched, bool ALIGN_EPI = false, bool SP2 = false, bool FP8 = false>
__device__ __forceinline__ void gemm_phase(PG8_LAS unsigned char* lds, const Gemm g, const Sched& S, const Epi& E, int wave_) {
    const int tid_ = wave_ * 64 + lane_id_opaque();
    const int tid = tid_, wid = __builtin_amdgcn_readfirstlane(tid >> 6), lane = tid & 63, wr = wid >> 2, wc = wid & 3, fr = lane & 15, fq = lane >> 4;
    int K_ = g.K; asm volatile("" : "+s"(K_));
    const int K = K_, nt = K / BK;
    unsigned voffA[2], voffB[2];
#pragma unroll
    for (int i = 0; i < 2; ++i) { int R, C; stage_rc(tid * 16 + i * 8192, R, C); const int Rb = Epi::PERM ? ((R & ~31) + perm32(R & 31)) : R;
        voffA[i] = (unsigned)(R * K + C) * 2u; voffB[i] = (unsigned)(Rb * K + C) * 2u; }
    const size_t kstep = (size_t)(BK * 2);
    const size_t hstep = (size_t)HALF * K * 2;
    const size_t tstep = 2 * hstep;
    const unsigned ldsw = (unsigned)wid * 1024u;
    const int aoff = lds_byte(wr * 64 + fr, fq * 8), boff = lds_byte(wc * 32 + fr, fq * 8);
#define PG8_SA(b, h) (((b) * 2 + (h)) * HTB)
#define PG8_SB(b, h) ((4 + (b) * 2 + (h)) * HTB)
#define PG8_STAGE(bufoff, gbase, voff) do { _Pragma("unroll") for (int _i = 0; _i < 2; ++_i) \
        __builtin_amdgcn_global_load_lds((const unsigned*)((const char*)(gbase) + (voff)[_i]), (PG8_LAS unsigned*)(lds + (bufoff) + ldsw + _i * 8192), 16, 0, 0); } while (0)
#define PG8_LDA(dst, b, h) do { if constexpr (FP8) { _Pragma("unroll") for (int m = 0; m < 4; ++m) dst##8[m] = pg8_cat(*(const PG8_LAS bf16x8*)(lds + PG8_SA(b, h) + aoff + m * 2048), *(const PG8_LAS bf16x8*)(lds + PG8_SA(b, h) + aoff + m * 2048 + 1024)); } else { \
        _Pragma("unroll") for (int m = 0; m < 4; ++m) _Pragma("unroll") for (int k = 0; k < 2; ++k) dst[m][k] = *(const PG8_LAS bf16x8*)(lds + PG8_SA(b, h) + aoff + m * 2048 + k * 1024); } } while (0)
#define PG8_LDB(dst, b, h) do { if constexpr (FP8) { _Pragma("unroll") for (int n = 0; n < 2; ++n) dst##8[n] = pg8_cat(*(const PG8_LAS bf16x8*)(lds + PG8_SB(b, h) + boff + n * 2048), *(const PG8_LAS bf16x8*)(lds + PG8_SB(b, h) + boff + n * 2048 + 1024)); } else { \
        _Pragma("unroll") for (int n = 0; n < 2; ++n) _Pragma("unroll") for (int k = 0; k < 2; ++k) dst[n][k] = *(const PG8_LAS bf16x8*)(lds + PG8_SB(b, h) + boff + n * 2048 + k * 1024); } } while (0)
#define PG8_MMA(ai, bj, At, Bt) do { __builtin_amdgcn_s_setprio(1); if constexpr (FP8) { \
        _Pragma("unroll") for (int m = 0; m < 4; ++m) _Pragma("unroll") for (int n = 0; n < 2; ++n) \
        asm volatile("v_mfma_f32_16x16x128_f8f6f4 %0, %1, %2, %0" : "+v"(acc[ai][bj][m][n]) : "v"(Bt##8[n]), "v"(At##8[m])); } else {     \
        _Pragma("unroll") for (int m = 0; m < 4; ++m) _Pragma("unroll") for (int n = 0; n < 2; ++n) _Pragma("unroll") for (int k = 0; k < 2; ++k) \
        acc[ai][bj][m][n] = __builtin_amdgcn_mfma_f32_16x16x32_bf16(Bt[n][k], At[m][k], acc[ai][bj][m][n], 0, 0, 0); } __builtin_amdgcn_s_setprio(0); } while (0)
#define PG8_WAIT_V(n) asm volatile("s_waitcnt vmcnt(" #n ")" ::: "memory")
#define PG8_WAIT_L(n) asm volatile("s_waitcnt lgkmcnt(" #n ")" ::: "memory")
#define PG8_BAR __builtin_amdgcn_s_barrier()
#define PG8_SCHED __builtin_amdgcn_sched_barrier(0)
    Unit cur, nxt; int ui = 0;
    if (!S.next(0, cur)) return;
    f32x4 acc[2][2][4][2];
#pragma unroll
    for (int a = 0; a < 2; ++a)
#pragma unroll
        for (int b = 0; b < 2; ++b)
#pragma unroll
            for (int m = 0; m < 4; ++m)
#pragma unroll
                for (int n = 0; n < 2; ++n) acc[a][b][m][n] = (f32x4){0.f, 0.f, 0.f, 0.f};
    bf16x8 At[4][2], B0[2][2], B1[2][2]; i32x8_ At8[4], B08[2], B18[2];
    const char* cA = (const char*)g.A + (size_t)cur.pm * tstep; const char* cB = (const char*)g.Bt + (size_t)cur.pb * tstep;
    S.a_ready(cur);
    if constexpr (SP2) {
        PG8_STAGE(PG8_SB(0, 0), cB, voffB); PG8_STAGE(PG8_SB(0, 1), cB + hstep, voffB); PG8_STAGE(PG8_SA(0, 0), cA, voffA); PG8_STAGE(PG8_SA(0, 1), cA + hstep, voffA);
        if (wr == 1) PG8_BAR;
        PG8_WAIT_V(2); PG8_BAR;
        PG8_STAGE(PG8_SB(1, 0), cB + kstep, voffB); PG8_STAGE(PG8_SA(1, 0), cA + kstep, voffA); PG8_STAGE(PG8_SB(1, 1), cB + hstep + kstep, voffB);
        PG8_WAIT_V(6); PG8_BAR;
    } else {
        PG8_STAGE(PG8_SB(0, 0), cB, voffB); PG8_STAGE(PG8_SA(0, 0), cA, voffA); PG8_STAGE(PG8_SB(0, 1), cB + hstep, voffB); PG8_STAGE(PG8_SA(0, 1), cA + hstep, voffA);
        if (wr == 1) PG8_BAR;
        PG8_WAIT_V(4); PG8_BAR;
        PG8_STAGE(PG8_SB(1, 0), cB + kstep, voffB); PG8_STAGE(PG8_SA(1, 0), cA + kstep, voffA); PG8_STAGE(PG8_SB(1, 1), cB + hstep + kstep, voffB);
        PG8_WAIT_V(6); PG8_BAR;
    }
    for (;;) {
        const bool has_next = S.next(ui + 1, nxt);
        const char* nA = has_next ? (const char*)g.A + (size_t)nxt.pm * tstep : cA; const char* nB = has_next ? (const char*)g.Bt + (size_t)nxt.pb * tstep : cB;
#pragma unroll 1
        for (int t = 0; t < nt; t += 2) {
            const bool last = (t == nt - 2);
            const char* a1 = cA + (size_t)(t + 1) * kstep;
            const char* a2 = last ? nA : cA + (size_t)(t + 2) * kstep; const char* b2 = last ? nB : cB + (size_t)(t + 2) * kstep;
            const char* a3 = a2 + kstep; const char* b3 = b2 + kstep;
            if (last && has_next) S.a_ready(nxt);
            if constexpr (SP2) {
            PG8_LDB(B0, 0, 0); PG8_LDB(B1, 0, 1); PG8_SCHED; PG8_LDA(At, 0, 0); PG8_STAGE(PG8_SA(1, 1), a1 + hstep, voffA);
            PG8_WAIT_V(8); PG8_WAIT_L(0); PG8_BAR; PG8_MMA(0, 0, At, B0); PG8_MMA(0, 1, At, B1); PG8_BAR; PG8_SCHED;
            PG8_LDA(At, 0, 1); PG8_STAGE(PG8_SB(0, 0), b2, voffB); PG8_STAGE(PG8_SB(0, 1), b2 + hstep, voffB); PG8_STAGE(PG8_SA(0, 0), a2, voffA);
            PG8_WAIT_V(8); PG8_WAIT_L(0); PG8_BAR; PG8_MMA(1, 0, At, B0); PG8_MMA(1, 1, At, B1); PG8_BAR; PG8_SCHED;
            PG8_LDB(B0, 1, 0); PG8_LDB(B1, 1, 1); PG8_SCHED; PG8_LDA(At, 1, 0); PG8_STAGE(PG8_SA(0, 1), a2 + hstep, voffA);
            PG8_WAIT_V(8); PG8_WAIT_L(0); PG8_BAR; PG8_MMA(0, 0, At, B0); PG8_MMA(0, 1, At, B1); PG8_BAR; PG8_SCHED;
            PG8_LDA(At, 1, 1); PG8_STAGE(PG8_SB(1, 0), b3, voffB); PG8_STAGE(PG8_SB(1, 1), b3 + hstep, voffB); PG8_STAGE(PG8_SA(1, 0), a3, voffA);
            PG8_WAIT_V(8); PG8_WAIT_L(0); PG8_BAR; PG8_MMA(1, 0, At, B0); PG8_MMA(1, 1, At, B1); PG8_BAR; PG8_SCHED;
            } else {
            PG8_LDB(B0, 0, 0); PG8_SCHED; PG8_LDA(At, 0, 0); PG8_STAGE(PG8_SA(1, 1), a1 + hstep, voffA);
            PG8_WAIT_L(8); PG8_BAR; PG8_WAIT_L(0); PG8_MMA(0, 0, At, B0); PG8_BAR; PG8_SCHED;
            PG8_LDB(B1, 0, 1); PG8_STAGE(PG8_SB(0, 0), b2, voffB);
            PG8_BAR; PG8_WAIT_L(0); PG8_MMA(0, 1, At, B1); PG8_BAR;
            PG8_LDA(At, 0, 1); PG8_STAGE(PG8_SA(0, 0), a2, voffA);
            PG8_BAR; PG8_WAIT_L(0); PG8_MMA(1, 0, At, B0); PG8_BAR; PG8_SCHED;
            PG8_STAGE(PG8_SB(0, 1), b2 + hstep, voffB);
            PG8_WAIT_V(6); PG8_BAR; PG8_MMA(1, 1, At, B1); PG8_BAR;
            PG8_LDB(B0, 1, 0); PG8_SCHED; PG8_LDA(At, 1, 0); PG8_STAGE(PG8_SA(0, 1), a2 + hstep, voffA);
            PG8_WAIT_L(8); PG8_BAR; PG8_WAIT_L(0); PG8_MMA(0, 0, At, B0); PG8_BAR; PG8_SCHED;
            PG8_LDB(B1, 1, 1); PG8_STAGE(PG8_SB(1, 0), b3, voffB);
            PG8_BAR; PG8_WAIT_L(0); PG8_MMA(0, 1, At, B1); PG8_BAR;
            PG8_LDA(At, 1, 1); PG8_STAGE(PG8_SA(1, 0), a3, voffA);
            PG8_BAR; PG8_WAIT_L(0); PG8_MMA(1, 0, At, B0); PG8_BAR; PG8_SCHED;
            PG8_STAGE(PG8_SB(1, 1), b3 + hstep, voffB);
            PG8_WAIT_V(6); PG8_BAR; PG8_MMA(1, 1, At, B1); PG8_BAR;
            }
        }
        if constexpr (FP8) asm volatile("s_nop 15\n\ts_nop 7" ::: "memory");
        if constexpr (ALIGN_EPI) { if (wr == 0) PG8_BAR; }
        if constexpr (!Epi::AFTER_DRAIN) { E(acc, cur, wr, wc, fr, fq); S.done(cur); }
        if (!has_next) break;
#pragma unroll
        for (int a = 0; a < 2; ++a)
#pragma unroll
            for (int b = 0; b < 2; ++b)
#pragma unroll
                for (int m = 0; m < 4; ++m)
#pragma unroll
                    for (int n = 0; n < 2; ++n) acc[a][b][m][n] = (f32x4){0.f, 0.f, 0.f, 0.f};
        cur = nxt; cA = nA; cB = nB; ++ui;
        if constexpr (ALIGN_EPI) { if (wr == 1) PG8_BAR; }
    }
    PG8_WAIT_V(0);
    if constexpr (!ALIGN_EPI) { if (wr == 0) PG8_BAR; }
    PG8_BAR;
    if constexpr (Epi::AFTER_DRAIN) { E.fused(acc, cur, wr, wc, fr, fq, lds, wid, lane); S.done(cur); }
#undef PG8_SA
#undef PG8_SB
#undef PG8_STAGE
#undef PG8_LDA
#undef PG8_LDB
#undef PG8_MMA
#undef PG8_WAIT_V
#undef PG8_WAIT_L
#undef PG8_BAR
#undef PG8_SCHED
}
}

#include <hip/hip_bf16.h>
#include <cmath>

namespace attn_body {
using bf16=__hip_bfloat16;
using bf16x8=__attribute__((ext_vector_type(8)))short;
using s16x4=__attribute__((ext_vector_type(4)))short;
using f32x16=__attribute__((ext_vector_type(16)))float;
using u32x4=__attribute__((ext_vector_type(4)))unsigned;
constexpr int NHEAD=8,SEQ=16384,D=64,DMQ=NHEAD*D,DMK=2*D;
constexpr int NW=8,QBLK=32,QB=QBLK*NW,KVBLK=64,NQB=SEQ/QB;
constexpr int ATTN_UNIT_ROWS=QB;
__device__ __forceinline__ int crow(int r,int hi){return (r&3)+8*(r>>2)+4*hi;}
#define SBAR() __builtin_amdgcn_sched_barrier(0)
__device__ __forceinline__ void cmask(f32x16&p0,f32x16&p1,int jb,int qrel,int hi){
  const float NEG=-INFINITY; int kb=64*jb+4*hi;
  #pragma unroll
  for(int r=0;r<16;++r){int kv=kb+(r&3)+8*(r>>2); if(kv>qrel)p0[r]=NEG; if(kv+32>qrel)p1[r]=NEG;}
}

constexpr int NSLOT=3, SLOTB=8192;
constexpr int LDS_K=0, LDS_V=NSLOT*SLOTB, LDS_WS=2*NSLOT*SLOTB, LDS_OST=LDS_WS+NW*64*4, LDS_BYTES=LDS_OST+NW*4096;
constexpr float C2=0.125f*1.4426950408889634f;
__device__ __forceinline__ void glds16(const void*gsrc,unsigned lds_dst){unsigned keep;
  asm volatile("s_mov_b32 %0, m0\n\ts_mov_b32 m0, %2\n\ts_nop 0\n\tglobal_load_lds_dwordx4 %1, off\n\ts_mov_b32 m0, %0":"=&s"(keep):"v"(gsrc),"s"(lds_dst):"memory");}
__device__ __forceinline__ float max3f(float a,float b,float c){float r;asm("v_max3_f32 %0, %1, %2, %3":"=v"(r):"v"(a),"v"(b),"v"(c));return r;}
__device__ __forceinline__ float max2f(float a,float b){float r;asm("v_max_f32_e32 %0, %1, %2":"=v"(r):"v"(a),"v"(b));return r;}
__device__ __forceinline__ float fadd_s(float a,float b){float r;asm("v_add_f32_e32 %0, %1, %2":"=v"(r):"v"(a),"v"(b));return r;}
__device__ __forceinline__ float fsub_s(float a,float b){float r;asm("v_sub_f32_e32 %0, %1, %2":"=v"(r):"v"(a),"v"(b));return r;}
typedef float f32x2_t __attribute__((ext_vector_type(2))); typedef __bf16 bf16x2_t __attribute__((ext_vector_type(2)));
__device__ __forceinline__ unsigned cvtpk_s(float lo,float hi){f32x2_t v={lo,hi};bf16x2_t b=__builtin_convertvector(v,bf16x2_t);return __builtin_bit_cast(unsigned,b);}
#define WAIT_BAR(N) asm volatile("s_waitcnt vmcnt(" #N ") lgkmcnt(0)\n\ts_barrier":::"memory")

__device__ __forceinline__ void qkt(f32x16&p0,f32x16&p1,const char*Kslot,const bf16x8*qr,const f32x16&negm,int r32,int hi){
  const char*kb=Kslot+hi*1024+r32*16;
  #pragma unroll
  for(int d0=0;d0<4;++d0){
    const bf16x8 b0=*reinterpret_cast<const bf16x8*>(kb+d0*2048);
    const bf16x8 b1=*reinterpret_cast<const bf16x8*>(kb+d0*2048+512);
    if(d0==0){p0=__builtin_amdgcn_mfma_f32_32x32x16_bf16(b0,qr[0],negm,0,0,0);p1=__builtin_amdgcn_mfma_f32_32x32x16_bf16(b1,qr[0],negm,0,0,0);}
    else{p0=__builtin_amdgcn_mfma_f32_32x32x16_bf16(b0,qr[d0],p0,0,0,0);p1=__builtin_amdgcn_mfma_f32_32x32x16_bf16(b1,qr[d0],p1,0,0,0);}}
}
typedef __attribute__((address_space(3))) const char* lds_cptr;
typedef short v4i16_t __attribute__((ext_vector_type(4)));
__device__ __forceinline__ void kload8(bf16x8*kf,lds_cptr kp){
  kf[0]=*(const __attribute__((address_space(3))) bf16x8*)(kp);      kf[1]=*(const __attribute__((address_space(3))) bf16x8*)(kp+512);
  kf[2]=*(const __attribute__((address_space(3))) bf16x8*)(kp+2048); kf[3]=*(const __attribute__((address_space(3))) bf16x8*)(kp+2560);
  kf[4]=*(const __attribute__((address_space(3))) bf16x8*)(kp+4096); kf[5]=*(const __attribute__((address_space(3))) bf16x8*)(kp+4608);
  kf[6]=*(const __attribute__((address_space(3))) bf16x8*)(kp+6144); kf[7]=*(const __attribute__((address_space(3))) bf16x8*)(kp+6656);
}
__device__ __forceinline__ void kload2(bf16x8*kf,lds_cptr kp,int j){ kf[2*j]=*(const __attribute__((address_space(3))) bf16x8*)(kp+j*2048); kf[2*j+1]=*(const __attribute__((address_space(3))) bf16x8*)(kp+j*2048+512); }
__device__ __forceinline__ s16x4 vtr(lds_cptr p){ return __builtin_bit_cast(s16x4,__builtin_amdgcn_ds_read_tr16_b64_v4i16((__attribute__((address_space(3))) v4i16_t*)p)); }
__device__ __forceinline__ float rowmax(const f32x16&p0,const f32x16&p1){
  float a=max3f(p0[0],p0[1],p1[0]),b=max3f(p0[2],p0[3],p1[1]);a=max3f(a,p1[2],p1[3]);
  #pragma unroll
  for(int r=4;r<16;r+=4){a=max3f(a,p0[r],p0[r+1]);b=max3f(b,p0[r+2],p0[r+3]);a=max3f(a,p1[r],p1[r+1]);b=max3f(b,p1[r+2],p1[r+3]);}
  const float m=max2f(a,b);
  auto rr=__builtin_amdgcn_permlane32_swap(__float_as_uint(m),__float_as_uint(m),false,false);
  return max2f(__uint_as_float(rr[0]),__uint_as_float(rr[1]));
}
__device__ __forceinline__ void pv(f32x16*o,int vb,bf16x8 pa0,bf16x8 pa1,bf16x8 pa2,bf16x8 pa3){
  #pragma unroll
  for(int d0=0;d0<2;++d0){s16x4 lo[4],hi[4];
    #pragma unroll
    for(int ks=0;ks<4;++ks){
      asm volatile("ds_read_b64_tr_b16 %0,%1 offset:%c2":"=&v"(lo[ks]):"v"(vb),"i"(d0*4096+ks*1024):"memory");
      asm volatile("ds_read_b64_tr_b16 %0,%1 offset:%c2":"=&v"(hi[ks]):"v"(vb),"i"(d0*4096+ks*1024+512):"memory");}
    asm volatile("s_waitcnt lgkmcnt(0)":::"memory");SBAR();
    #define PK(k) (bf16x8){lo[k][0],lo[k][1],lo[k][2],lo[k][3],hi[k][0],hi[k][1],hi[k][2],hi[k][3]}
    o[d0]=__builtin_amdgcn_mfma_f32_32x32x16_bf16(pa0,PK(0),o[d0],0,0,0);
    o[d0]=__builtin_amdgcn_mfma_f32_32x32x16_bf16(pa1,PK(1),o[d0],0,0,0);
    o[d0]=__builtin_amdgcn_mfma_f32_32x32x16_bf16(pa2,PK(2),o[d0],0,0,0);
    o[d0]=__builtin_amdgcn_mfma_f32_32x32x16_bf16(pa3,PK(3),o[d0],0,0,0);
    #undef PK
  }
}

#ifndef ATTN_STORE16
#define ATTN_STORE16(p,v) (*(u32x4*)(p)=(v))
#endif
template<int THRL> __device__ __forceinline__ void attn_unit(int b,int h,int qb,const bf16*Q,const bf16*__restrict__ K,const bf16*__restrict__ V,bf16*O,char*shm,int wave_){
  const int tid_=wave_*64+lane_id_opaque();
  const int tid=tid_,lane=tid&63,r32=lane&31,hi=lane>>5; const int wid=__builtin_amdgcn_readfirstlane(tid>>6);
  const long rowbase=0; const int q0=qb*QB; (void)b;
  const bf16*Qw=Q+(rowbase+q0+wid*QBLK)*DMQ+h*D;
  const bf16*Kh=K+(h>>2)*D,*Vh=V+(h>>2)*D;
  const unsigned lds0=(unsigned)(uintptr_t)shm;
  float*wsf=(float*)(shm+LDS_WS)+wid*64;
  const bf16*ksrc=Kh+(long)lane*DMK+wid*8;
  const bf16*vsrc=Vh+(long)(16*(wid&3)+(lane>>2))*DMK+(wid>>2)*32+(lane&3)*8;
  const unsigned kdst=lds0+LDS_K+wid*1024, vdst=lds0+LDS_V+wid*1024;
  #define DMA_K(t,slot) glds16(ksrc+(long)(t)*KVBLK*DMK,(unsigned)__builtin_amdgcn_readfirstlane(kdst+(slot)))
  #define DMA_V(t,slot) glds16(vsrc+(long)(t)*KVBLK*DMK,(unsigned)__builtin_amdgcn_readfirstlane(vdst+(slot)))
  const int vb0=(int)(lds0+LDS_V)+((lane>>4)&1)*32+(lane&3)*8+(4*hi+((lane&15)>>2))*64;
  const char*Kbase=shm+LDS_K; bf16x8 kf[8];
  const lds_cptr shm3=(lds_cptr)shm; const lds_cptr kp0=shm3+LDS_K+hi*1024+r32*16; const lds_cptr vp0=shm3+LDS_V+((lane>>4)&1)*32+(lane&3)*8+(4*hi+((lane&15)>>2))*64;
  const int NT=SEQ/KVBLK;
  DMA_K(0,0);DMA_V(0,0);DMA_K(1,SLOTB);
  bf16x8 qr[4];
  #pragma unroll
  for(int d0=0;d0<4;++d0)qr[d0]=*reinterpret_cast<const bf16x8*>(&Qw[(long)r32*DMQ+d0*16+hi*8]);
  float mhat=0.f,l_reg=0.f;f32x16 o[2];o[0]=f32x16{};o[1]=f32x16{};f32x16 negm=f32x16{};asm volatile("":"+v"(negm));
  const int qrel=wid*QBLK+r32; (void)qrel;
  #define CMASK(P0,P1,t) do{}while(0)
  bool resc=false;
  #define START(P0,P1) do{ const float rm=rowmax(P0,P1); resc=false; \
    { const float dl=rm; mhat=fadd_s(mhat,dl); \
      _Pragma("unroll") for(int r=0;r<16;++r){P0[r]=fsub_s(P0[r],dl);P1[r]=fsub_s(P1[r],dl);} \
      _Pragma("unroll") for(int r=0;r<16;++r)negm[r]=-mhat; asm volatile("":"+v"(negm)); } \
    _Pragma("unroll") for(int r=0;r<16;++r)P0[r]=__builtin_amdgcn_exp2f(P0[r]); }while(0)
  #define RESC() do{ if(resc){ asm volatile("s_waitcnt lgkmcnt(0)":::"memory"); \
      _Pragma("unroll") for(int d_=0;d_<2;++d_) _Pragma("unroll") for(int r=0;r<16;++r)o[d_][r]*=wsf[crow(r,hi)]; } }while(0)
  f32x16 pA0,pA1,pB0,pB1;
  int sl_prev=0,sl_cur=0,sl_next=SLOTB;
  #define ROT() do{sl_prev=sl_cur;sl_cur=sl_next;sl_next=(sl_next==(NSLOT-1)*SLOTB)?0:sl_next+SLOTB;}while(0)
  DMA_K(2,2*SLOTB);
  WAIT_BAR(3);
  qkt(pA0,pA1,Kbase,qr,negm,r32,hi);asm volatile("s_nop 15\n\ts_nop 7":"+v"(pA0),"+v"(pA1));CMASK(pA0,pA1,0);
  START(pA0,pA1);
  _Pragma("unroll") for(int r=0;r<16;++r)pA1[r]=__builtin_amdgcn_exp2f(pA1[r]);
  WAIT_BAR(0);
  DMA_K(3,0);DMA_V(1,SLOTB);
  ROT();
  kload8(kf,kp0+sl_cur);
  WAIT_BAR(2);
  s16x4 vlo[8],vhi[8]; u32x4 pw0,pw1,pw2,pw3;
  #define PKW(P,B) cvtpk_s(P[B],P[B+1])
  #define PAF(k) __builtin_bit_cast(bf16x8,pw##k)
  #define VFR(i) (bf16x8){vlo[i][0],vlo[i][1],vlo[i][2],vlo[i][3],vhi[i][0],vhi[i][1],vhi[i][2],vhi[i][3]}
  #define PIN(x) asm volatile("":"+v"(x))
  #define MX3(a,b,c) __builtin_fmaxf(__builtin_fmaxf((a),(b)),(c))
  #define GAPA(MF,A0,A1,A2,A3,W0,W1,PW) do{ MF; sacc+=A0; sacc+=A1; sacc+=A2; sacc+=A3; PIN(sacc); W0; W1; PIN(PW); SBAR(); }while(0)
  #define EX(v) __builtin_amdgcn_exp2f(v)
  #define GAPB(MF,X,B) do{ MF; X[B]=EX(X[B]); X[B+1]=EX(X[B+1]); X[B+2]=EX(X[B+2]); X[B+3]=EX(X[B+3]); PIN(X); SBAR(); }while(0)
  #define VRD(i) do{ vlo[i]=vtr(vp_+(((i)>>2)*4096+((i)&3)*1024)); vhi[i]=vtr(vp_+(((i)>>2)*4096+((i)&3)*1024+512)); }while(0)
  #define KRD(G,j) do{ if(G){ kload2(kf,kp0+sl_next,j); SBAR(); } }while(0)
  #define STEP(C0,C1,P0,P1,t,GK,GV,GL) do{ SBAR(); \
    const lds_cptr vp_=vp0+sl_prev; \
    VRD(0); SBAR(); float sacc=(P0[0]+P0[1]); \
    GAPA(C0=__builtin_amdgcn_mfma_f32_32x32x16_bf16(kf[0],qr[0],negm,0,0,0), P0[2],P0[3],P0[4],P0[5],     pw0[0]=PKW(P0,0), pw0[1]=PKW(P0,2), pw0); \
    VRD(4); SBAR(); GAPA(C1=__builtin_amdgcn_mfma_f32_32x32x16_bf16(kf[1],qr[0],negm,0,0,0), P0[6],P0[7],P0[8],P0[9],     pw0[2]=PKW(P0,4), pw0[3]=PKW(P0,6), pw0); \
    VRD(1); SBAR(); GAPA(C0=__builtin_amdgcn_mfma_f32_32x32x16_bf16(kf[2],qr[1],C0,0,0,0),   P0[10],P0[11],P0[12],P0[13], pw1[0]=PKW(P0,8), pw1[1]=PKW(P0,10), pw1); \
    VRD(5); SBAR(); GAPA(C1=__builtin_amdgcn_mfma_f32_32x32x16_bf16(kf[3],qr[1],C1,0,0,0),   P0[14],P0[15],P1[0],P1[1],   pw1[2]=PKW(P0,12),pw1[3]=PKW(P0,14), pw1); \
    VRD(2); SBAR(); GAPA(C0=__builtin_amdgcn_mfma_f32_32x32x16_bf16(kf[4],qr[2],C0,0,0,0),   P1[2],P1[3],P1[4],P1[5],     pw2[0]=PKW(P1,0), pw2[1]=PKW(P1,2), pw2); \
    VRD(6); SBAR(); GAPA(C1=__builtin_amdgcn_mfma_f32_32x32x16_bf16(kf[5],qr[2],C1,0,0,0),   P1[6],P1[7],P1[8],P1[9],     pw2[2]=PKW(P1,4), pw2[3]=PKW(P1,6), pw2); \
    VRD(3); SBAR(); GAPA(C0=__builtin_amdgcn_mfma_f32_32x32x16_bf16(kf[6],qr[3],C0,0,0,0),   P1[10],P1[11],P1[12],P1[13], pw3[0]=PKW(P1,8), pw3[1]=PKW(P1,10), pw3); \
    VRD(7); SBAR(); GAPA(C1=__builtin_amdgcn_mfma_f32_32x32x16_bf16(kf[7],qr[3],C1,0,0,0),   P1[14],P1[15],0.f,0.f,       pw3[2]=PKW(P1,12),pw3[3]=PKW(P1,14), pw3); \
    l_reg+=sacc; \
    if(GK){DMA_K((t)+3,sl_cur);} if(GV){DMA_V((t)+1,sl_next);} \
    CMASK(C0,C1,t); \
    { float a=MX3(C0[0],C0[1],C1[0]),b=MX3(C0[2],C0[3],C1[1]); a=MX3(a,C1[2],C1[3]); \
      _Pragma("unroll") for(int r=4;r<16;r+=4){a=MX3(a,C0[r],C0[r+1]);b=MX3(b,C0[r+2],C0[r+3]);a=MX3(a,C1[r],C1[r+1]);b=MX3(b,C1[r+2],C1[r+3]);} \
      float rm=__builtin_fmaxf(a,b); { auto rr=__builtin_amdgcn_permlane32_swap(__float_as_uint(rm),__float_as_uint(rm),false,false); rm=__builtin_fmaxf(__uint_as_float(rr[0]),__uint_as_float(rr[1])); } \
      resc=false; \
      if(__builtin_expect(__any(rm>(float)THRL),0)){ const float dl=__builtin_fmaxf(rm,0.f); mhat+=dl; \
        _Pragma("unroll") for(int r=0;r<16;++r){C0[r]-=dl;C1[r]-=dl;} \
        _Pragma("unroll") for(int r=0;r<16;++r)negm[r]=-mhat; asm volatile("":"+v"(negm)); \
        const float f=__builtin_amdgcn_exp2f(-dl); l_reg*=f; if(hi==0)wsf[r32]=f; resc=true; } } \
    SBAR(); \
    GAPB(o[0]=__builtin_amdgcn_mfma_f32_32x32x16_bf16(PAF(0),VFR(0),o[0],0,0,0), C0,0); \
    GAPB(o[1]=__builtin_amdgcn_mfma_f32_32x32x16_bf16(PAF(0),VFR(4),o[1],0,0,0), C0,4); \
    KRD(GL,0); GAPB(o[0]=__builtin_amdgcn_mfma_f32_32x32x16_bf16(PAF(1),VFR(1),o[0],0,0,0), C0,8); \
    KRD(GL,1); GAPB(o[1]=__builtin_amdgcn_mfma_f32_32x32x16_bf16(PAF(1),VFR(5),o[1],0,0,0), C0,12); \
    KRD(GL,2); GAPB(o[0]=__builtin_amdgcn_mfma_f32_32x32x16_bf16(PAF(2),VFR(2),o[0],0,0,0), C1,0); \
    KRD(GL,3); GAPB(o[1]=__builtin_amdgcn_mfma_f32_32x32x16_bf16(PAF(2),VFR(6),o[1],0,0,0), C1,4); \
    GAPB(o[0]=__builtin_amdgcn_mfma_f32_32x32x16_bf16(PAF(3),VFR(3),o[0],0,0,0), C1,8); \
    GAPB(o[1]=__builtin_amdgcn_mfma_f32_32x32x16_bf16(PAF(3),VFR(7),o[1],0,0,0), C1,12); \
    }while(0)
  int t=1;
  #undef CMASK
  #define CMASK(P0,P1,t) do{}while(0)
  for(;t+5<NT;t+=2){
    STEP(pB0,pB1,pA0,pA1,t,true,true,true);     WAIT_BAR(2); RESC(); ROT();
    STEP(pA0,pA1,pB0,pB1,t+1,true,true,true);   WAIT_BAR(2); RESC(); ROT();
  }
  #undef CMASK
  #define CMASK(P0,P1,t) do{}while(0)
  #define ENDW(tt) do{ if((tt)+3<NT){WAIT_BAR(2);} else if((tt)+2<NT){WAIT_BAR(1);} else {WAIT_BAR(0);} }while(0)
  for(;t+1<NT;t+=2){
    STEP(pB0,pB1,pA0,pA1,t,(t+3<NT),(t+1<NT),(t+1<NT));       ENDW(t);   RESC(); ROT();
    STEP(pA0,pA1,pB0,pB1,t+1,(t+4<NT),(t+2<NT),(t+2<NT));     ENDW(t+1); RESC(); ROT();
  }
  STEP(pB0,pB1,pA0,pA1,NT-1,false,false,false); RESC();
  { float sacc=pB0[0]+pB0[1]; _Pragma("unroll") for(int r=2;r<16;++r)sacc+=pB0[r]; _Pragma("unroll") for(int r=0;r<16;++r)sacc+=pB1[r]; l_reg+=sacc;
    pw0=(u32x4){PKW(pB0,0),PKW(pB0,2),PKW(pB0,4),PKW(pB0,6)};pw1=(u32x4){PKW(pB0,8),PKW(pB0,10),PKW(pB0,12),PKW(pB0,14)};pw2=(u32x4){PKW(pB1,0),PKW(pB1,2),PKW(pB1,4),PKW(pB1,6)};pw3=(u32x4){PKW(pB1,8),PKW(pB1,10),PKW(pB1,12),PKW(pB1,14)};
    SBAR(); pv(o,vb0+sl_cur,PAF(0),PAF(1),PAF(2),PAF(3)); }
  #undef PKW
  #undef PAF
  #undef VFR
  #undef PIN
  #undef MX3
  #undef GAPA
  #undef GAPB
  #undef EX
  #undef VRD
  #undef KRD
  #undef STEP
  #undef ENDW
  {auto rr=__builtin_amdgcn_permlane32_swap(__float_as_uint(l_reg),__float_as_uint(l_reg),false,false);l_reg=__uint_as_float(rr[0])+__uint_as_float(rr[1]);}
  if(hi==0)wsf[32+r32]=l_reg;asm volatile("s_waitcnt lgkmcnt(0)":::"memory");
  float rli[16];
  #pragma unroll
  for(int r=0;r<16;++r)rli[r]=__builtin_amdgcn_rcpf(wsf[32+crow(r,hi)]);
  bf16*Ow=O+(rowbase+q0+wid*QBLK)*DMQ+h*D;
  { bf16*stg=(bf16*)(shm+LDS_OST)+wid*2048;
    #pragma unroll
    for(int r=0;r<16;++r){const int orow=crow(r,hi);
      #pragma unroll
      for(int d0=0;d0<2;++d0)stg[orow*64+d0*32+r32]=__float2bfloat16(o[d0][r]*rli[r]);}
    asm volatile("s_waitcnt lgkmcnt(0)":::"memory");
    #pragma unroll
    for(int i=0;i<4;++i){const int row=i*8+(lane>>3),ch=lane&7; const u32x4 v=*(const u32x4*)(stg+row*64+ch*8); ATTN_STORE16(Ow+(long)row*DMQ+ch*8,v);} }
  asm volatile("s_waitcnt lgkmcnt(0)\n\ts_barrier":::"memory");
  #undef DMA_K
  #undef DMA_V
  #undef CMASK
  #undef START
  #undef RESC
  #undef ROT
}
constexpr int ATTN_LDS_BYTES=LDS_BYTES;
struct AttnTensors { const bf16* Q; const bf16* K; const bf16* V; bf16* O; };
struct AttnUnit { int bh; int qb; };
struct StaticOrder {
  int vcu, G;
  __device__ __forceinline__ explicit StaticOrder(int grid,int block):vcu((grid%8==0)?(block%8)*(grid/8)+block/8:block),G(grid){}
  __device__ __forceinline__ bool next(int i,AttnUnit&u)const{ constexpr int NU=NHEAD*NQB; int uu; if(NU%G==0){ const int per=NU/G; if(i>=per)return false; uu=vcu*per+i; } else { uu=i*G+vcu; if(uu>=NU)return false; } u.bh=uu/NQB; u.qb=uu%NQB; return true; }
  __device__ __forceinline__ void a_ready(const AttnUnit&)const{}
  __device__ __forceinline__ void done(const AttnUnit&)const{}
};
template<class Sched,int THRL=8> __device__ __forceinline__ void attn_phase(char*lds,const AttnTensors&T,const Sched&S,int wave_){
  AttnUnit u;
  for(int i=0;S.next(i,u);++i){ S.a_ready(u); attn_unit<THRL>(0,u.bh,u.qb,T.Q,T.K,T.V,T.O,lds,wave_); S.done(u); }
}
#undef SBAR
#undef WAIT_BAR
}

namespace hg {
typedef short bf16x8 __attribute__((ext_vector_type(8)));
typedef short s16x4 __attribute__((ext_vector_type(4)));
constexpr int CH = 32, SEGT = 512, NSEG = S / SEGT, NCH = SEGT / CH;
constexpr int RS = 272, TS = 80;
constexpr int QOFF = 0, KOFF = 32 * RS, KTOFF = 2 * 32 * RS, VTOFF = KTOFF + 128 * TS, DOFF = VTOFF + 128 * TS, GOFF = DOFF + 512, BUFB = GOFF + 2048;
static_assert(2 * BUFB <= 131072, "hgrn LDS");
#define HG_MFMA(a, b, c) __builtin_amdgcn_mfma_f32_16x16x32_bf16((a), (b), (c), 0, 0, 0)
__device__ __forceinline__ unsigned pkbf(float lo, float hi) { typedef float f2 __attribute__((ext_vector_type(2))); typedef __bf16 b2 __attribute__((ext_vector_type(2))); f2 v = {lo, hi}; b2 b = __builtin_convertvector(v, b2); return __builtin_bit_cast(unsigned, b); }

template <bool OUT>
__device__ __forceinline__ void segment(LAS unsigned char* lds, int unit, const bf16_t* __restrict__ HQ, const float* __restrict__ LF, const bf16_t* __restrict__ KF,
                                        const bf16_t* __restrict__ HV, float* __restrict__ HST, float* __restrict__ HSD, float* __restrict__ OF, int wave_) {
    const int tid_ = wave_ * 64 + lane_id_opaque();
    const int tid = tid_, lane = tid & 63, w = __builtin_amdgcn_readfirstlane(tid >> 6), c16 = lane & 15, g = lane >> 4;
    const int dir = unit >> 7, h = (unit >> 5) & 3, seg = unit & 31;
    const int d = tid & 127, tg = tid >> 7;
    const size_t cb = (size_t)h * 128 + d;
    const float* lf = LF + (size_t)dir * S * 512 + cb;
    const bf16_t* kf = KF + (size_t)dir * S * 512 + cb;
    const bf16_t* hq = HQ + cb; const bf16_t* hv = HV + cb;
    f32x4 Sacc[8];
    float* hst = HST + (size_t)unit * 16384 + (size_t)w * 2048 + lane;
    if (OUT) {
#pragma unroll
        for (int dt = 0; dt < 8; ++dt) { Sacc[dt][0] = hst[(dt * 4 + 0) * 64]; Sacc[dt][1] = hst[(dt * 4 + 1) * 64]; Sacc[dt][2] = hst[(dt * 4 + 2) * 64]; Sacc[dt][3] = hst[(dt * 4 + 3) * 64]; }
    } else {
#pragma unroll
        for (int dt = 0; dt < 8; ++dt) Sacc[dt] = f32x4{0.f, 0.f, 0.f, 0.f};
    }
    float segsum = 0.f;
    const int e0 = 16 * w;
    for (int c = 0; c < NCH; ++c) {
        LAS unsigned char* B = lds + (c & 1) * BUFB;
        float lg[8], kk[8], qq[8]; unsigned short vv[8];
#pragma unroll
        for (int jj = 0; jj < 8; ++jj) {
            const int p = seg * SEGT + c * CH + 8 * tg + jj, t = dir ? (S - 1 - p) : p;
            lg[jj] = lf[(size_t)t * 512]; kk[jj] = bf2f(kf[(size_t)t * 512]); vv[jj] = hv[(size_t)t * 512];
            qq[jj] = OUT ? bf2f(hq[(size_t)t * 512]) : 0.f;
        }
#pragma unroll
        for (int jj = 1; jj < 8; ++jj) lg[jj] += lg[jj - 1];
        LAS float* gs = (LAS float*)(B + GOFF);
        gs[tg * 128 + d] = lg[7];
        __syncthreads();
        const float g0 = gs[d], g1 = gs[128 + d], g2 = gs[256 + d], g3 = gs[384 + d];
        const float off = (tg > 0 ? g0 : 0.f) + (tg > 1 ? g1 : 0.f) + (tg > 2 ? g2 : 0.f), tot = (g0 + g1) + (g2 + g3);
        float kt[8];
#pragma unroll
        for (int jj = 0; jj < 8; ++jj) {
            const float b = fmaxf(off + lg[jj], -80.f);
            kt[jj] = kk[jj] * __expf(-b);
            if (OUT) {
                *(LAS bf16_t*)(B + QOFF + (8 * tg + jj) * RS + d * 2) = (bf16_t)(pkbf(qq[jj] * __expf(b), 0.f) & 0xffffu);
                *(LAS bf16_t*)(B + KOFF + (8 * tg + jj) * RS + d * 2) = (bf16_t)(pkbf(kt[jj], 0.f) & 0xffffu);
            }
        }
        { u32x4 o; o.x = pkbf(kt[0], kt[1]); o.y = pkbf(kt[2], kt[3]); o.z = pkbf(kt[4], kt[5]); o.w = pkbf(kt[6], kt[7]);
          *(LAS u32x4*)(B + KTOFF + d * TS + 16 * tg) = o;
          u32x4 v; v.x = (unsigned)vv[0] | ((unsigned)vv[1] << 16); v.y = (unsigned)vv[2] | ((unsigned)vv[3] << 16); v.z = (unsigned)vv[4] | ((unsigned)vv[5] << 16); v.w = (unsigned)vv[6] | ((unsigned)vv[7] << 16);
          *(LAS u32x4*)(B + VTOFF + d * TS + 16 * tg) = v; }
        if (tg == 0) *(LAS float*)(B + DOFF + d * 4) = __expf(fmaxf(tot, -80.f));
        segsum += tot;
        __syncthreads();
        if (OUT) {
            f32x4 X00 = {0.f, 0.f, 0.f, 0.f}, X01 = X00, X11 = X00;
#pragma unroll
            for (int s = 0; s < 4; ++s) {
                const bf16x8 aK0 = *(const LAS bf16x8*)(B + KOFF + c16 * RS + (32 * s + 8 * g) * 2), aK1 = *(const LAS bf16x8*)(B + KOFF + (16 + c16) * RS + (32 * s + 8 * g) * 2);
                const bf16x8 bQ0 = *(const LAS bf16x8*)(B + QOFF + c16 * RS + (32 * s + 8 * g) * 2), bQ1 = *(const LAS bf16x8*)(B + QOFF + (16 + c16) * RS + (32 * s + 8 * g) * 2);
                X00 = HG_MFMA(aK0, bQ0, X00); X01 = HG_MFMA(aK0, bQ1, X01); X11 = HG_MFMA(aK1, bQ1, X11);
            }
#pragma unroll
            for (int r = 0; r < 4; ++r) { const bool keep = (4 * g + r) <= c16; X00[r] = keep ? X00[r] : 0.f; X11[r] = keep ? X11[r] : 0.f; }
            u32x4 a0w, a1w; a0w.x = pkbf(X00[0], X00[1]); a0w.y = pkbf(X00[2], X00[3]); a0w.z = 0u; a0w.w = 0u;
            a1w.x = pkbf(X01[0], X01[1]); a1w.y = pkbf(X01[2], X01[3]); a1w.z = pkbf(X11[0], X11[1]); a1w.w = pkbf(X11[2], X11[3]);
            const u32x2 vlo = *(const LAS u32x2*)(B + VTOFF + (e0 + c16) * TS + (4 * g) * 2), vhi = *(const LAS u32x2*)(B + VTOFF + (e0 + c16) * TS + (16 + 4 * g) * 2);
            u32x4 vbw; vbw.x = vlo.x; vbw.y = vlo.y; vbw.z = vhi.x; vbw.w = vhi.y;
            const bf16x8 vb = __builtin_bit_cast(bf16x8, vbw);
            f32x4 O0 = {0.f, 0.f, 0.f, 0.f}, O1 = O0;
            O0 = HG_MFMA(__builtin_bit_cast(bf16x8, a0w), vb, O0); O1 = HG_MFMA(__builtin_bit_cast(bf16x8, a1w), vb, O1);
#pragma unroll
            for (int s = 0; s < 4; ++s) {
                u32x4 sw; sw.x = pkbf(Sacc[2 * s][0], Sacc[2 * s][1]); sw.y = pkbf(Sacc[2 * s][2], Sacc[2 * s][3]); sw.z = pkbf(Sacc[2 * s + 1][0], Sacc[2 * s + 1][1]); sw.w = pkbf(Sacc[2 * s + 1][2], Sacc[2 * s + 1][3]);
                const bf16x8 sb = __builtin_bit_cast(bf16x8, sw);
                const u32x2 q0l = *(const LAS u32x2*)(B + QOFF + c16 * RS + (32 * s + 4 * g) * 2), q0h = *(const LAS u32x2*)(B + QOFF + c16 * RS + (32 * s + 16 + 4 * g) * 2);
                const u32x2 q1l = *(const LAS u32x2*)(B + QOFF + (16 + c16) * RS + (32 * s + 4 * g) * 2), q1h = *(const LAS u32x2*)(B + QOFF + (16 + c16) * RS + (32 * s + 16 + 4 * g) * 2);
                u32x4 q0w, q1w; q0w.x = q0l.x; q0w.y = q0l.y; q0w.z = q0h.x; q0w.w = q0h.y; q1w.x = q1l.x; q1w.y = q1l.y; q1w.z = q1h.x; q1w.w = q1h.y;
                O0 = HG_MFMA(__builtin_bit_cast(bf16x8, q0w), sb, O0); O1 = HG_MFMA(__builtin_bit_cast(bf16x8, q1w), sb, O1);
            }
#pragma unroll
            for (int r = 0; r < 4; ++r) {
                const int p0 = seg * SEGT + c * CH + 4 * g + r, p1 = p0 + 16;
                const int t0 = dir ? (S - 1 - p0) : p0, t1 = dir ? (S - 1 - p1) : p1;
                OF[((size_t)dir * S + t0) * 512 + h * 128 + e0 + c16] = O0[r];
                OF[((size_t)dir * S + t1) * 512 + h * 128 + e0 + c16] = O1[r];
            }
        }
        {
            const bf16x8 vB = *(const LAS bf16x8*)(B + VTOFF + (e0 + c16) * TS + (8 * g) * 2);
#pragma unroll
            for (int dt = 0; dt < 8; ++dt) {
                const bf16x8 aT = *(const LAS bf16x8*)(B + KTOFF + (16 * dt + c16) * TS + (8 * g) * 2);
                Sacc[dt] = HG_MFMA(aT, vB, Sacc[dt]);
                const f32x4 dv = *(const LAS f32x4*)(B + DOFF + (16 * dt + 4 * g) * 4);
                Sacc[dt] = Sacc[dt] * dv;
            }
        }
    }
    if (!OUT) {
#pragma unroll
        for (int dt = 0; dt < 8; ++dt) { hst[(dt * 4 + 0) * 64] = Sacc[dt][0]; hst[(dt * 4 + 1) * 64] = Sacc[dt][1]; hst[(dt * 4 + 2) * 64] = Sacc[dt][2]; hst[(dt * 4 + 3) * 64] = Sacc[dt][3]; }
        if (tid < 128) HSD[(size_t)unit * 128 + d] = __expf(fmaxf(segsum, -80.f));
    }
    __syncthreads();
}
__device__ __forceinline__ void carry(float* __restrict__ HST, const float* __restrict__ HSD, int gid) {
    const int chain = gid >> 14, el = gid & 16383, dt = (el >> 8) & 7, r = (el >> 6) & 3, ln = el & 63, d = 16 * dt + 4 * (ln >> 4) + r;
    float cy = 0.f;
    for (int sg = 0; sg < NSEG; ++sg) {
        const int u = chain * NSEG + sg;
        const float tmp = HST[(size_t)u * 16384 + el];
        HST[(size_t)u * 16384 + el] = cy;
        cy = HSD[(size_t)u * 128 + d] * cy + tmp;
    }
}
#undef HG_MFMA
}

#define XB_TMO      128
#define XB_XCNT(j)  (256  + 64 * (j))
#define XB_XSUB(j)  (1280 + 64 * (j))
#define XB_XGEN(j)  (2304 + 64 * (j))
#define XB_TOP      3328
#define XB_TOPGEN   3392
#define XCD_BAR_WORDS 3456
#define XB_SPIN_CAP (1u << 18)

__device__ __forceinline__ unsigned xb_ld(unsigned* p)              { return __hip_atomic_load(p, __ATOMIC_RELAXED, __HIP_MEMORY_SCOPE_AGENT); }
__device__ __forceinline__ unsigned xb_add(unsigned* p, unsigned v) { return __hip_atomic_fetch_add(p, v, __ATOMIC_RELAXED, __HIP_MEMORY_SCOPE_AGENT); }
__device__ __forceinline__ unsigned xb_xcc_id() { return (unsigned)__builtin_amdgcn_s_getreg((3 << 11) | 20) & 0xFu; }
#define XB_SPIN(cond, bar) do { unsigned _sp = 0; while (cond) { __builtin_amdgcn_s_sleep(1); \
    if ((++_sp & 255u) == 0u) { if (xb_ld(&(bar)[XB_TMO])) break; if (_sp > XB_SPIN_CAP) { atomicAdd(&(bar)[XB_TMO], 1u); break; } } } } while (0)

struct XcdBarrier {
    int wv;
    unsigned* bar; unsigned x;
    volatile LAS unsigned* st;
};

__device__ __forceinline__ XcdBarrier xcd_barrier_post(unsigned* bar, volatile LAS unsigned* st) {
    XcdBarrier b; b.bar = bar; b.x = xb_xcc_id(); b.st = st; b.wv = __builtin_amdgcn_readfirstlane((int)threadIdx.x >> 6);
    if (threadIdx.x == 0) (void)xb_add(&bar[XB_XCNT(b.x)], 1u);
    return b;
}
__device__ __forceinline__ void xcd_barrier_complete(unsigned* bar, unsigned x, unsigned& nloc, unsigned& nx) {
    const unsigned G = gridDim.x * gridDim.y * gridDim.z;
    unsigned sum, cnt, mine, sp = 0u;
    for (;;) {
        sum = 0u; cnt = 0u; mine = 0u;
#pragma unroll
        for (unsigned j = 0; j < 16; ++j) { const unsigned c = xb_ld(&bar[XB_XCNT(j)]); sum += c; cnt += (c > 0u) ? 1u : 0u; mine = (j == x) ? c : mine; }
        if (sum == G) break;
        __builtin_amdgcn_s_sleep(1);
        if ((++sp & 255u) == 0u) { if (xb_ld(&bar[XB_TMO])) break; if (sp > XB_SPIN_CAP) { atomicAdd(&bar[XB_TMO], 1u); break; } }
    }
    nloc = mine > 0u ? mine : 1u; nx = cnt > 0u ? cnt : 1u;
}

__device__ __forceinline__ void xcd_barrier(const XcdBarrier& b) {
    asm volatile("s_waitcnt vmcnt(0)" ::: "memory");
    __syncthreads();
    if (b.wv == 0 && lane_id_opaque() == 0) {
        unsigned* bar = b.bar;
        __builtin_amdgcn_s_waitcnt(0);
        unsigned nloc = b.st[0], nx = b.st[1];
        if (nloc == 0u) { xcd_barrier_complete(bar, b.x, nloc, nx); b.st[0] = nloc; b.st[1] = nx; }
        const unsigned old = xb_add(&bar[XB_XSUB(b.x)], 1u);
        const unsigned gen = old / nloc;
        if (old + 1u == (gen + 1u) * nloc) {
            __builtin_amdgcn_fence(__ATOMIC_RELEASE, "agent");
            asm volatile("s_waitcnt vmcnt(0)" ::: "memory");
            const unsigned og = xb_add(&bar[XB_TOP], 1u);
            const unsigned tg = og / nx;
            if (og + 1u == (tg + 1u) * nx) xb_add(&bar[XB_TOPGEN], 1u);
            else XB_SPIN(xb_ld(&bar[XB_TOPGEN]) == tg, bar);
            __builtin_amdgcn_fence(__ATOMIC_ACQUIRE, "agent");
            xb_add(&bar[XB_XGEN(b.x)], 1u);
            asm volatile("s_waitcnt vmcnt(0)" ::: "memory");
        } else {
            XB_SPIN(xb_ld(&bar[XB_XGEN(b.x)]) == gen, bar);
            __builtin_amdgcn_fence(__ATOMIC_ACQUIRE, "agent");
            asm volatile("s_waitcnt vmcnt(0)" ::: "memory");
        }
    }
    __syncthreads();
}

constexpr int NWAVES = 8;
constexpr int RING_OFF = 0, RING_BYTES = 131072;
constexpr int LDSCTL_OFF = RING_BYTES, MISC_OFF = LDSCTL_OFF + 320;
constexpr int LDS_BYTES = 147456;
constexpr int CW_BAR = 4096;
constexpr int NPL = 13;
constexpr int PH_PRO = 0, PH_NORM1 = 1, PH_L0 = 2, PH_END = PH_L0 + NL * NPL;
enum { P_G1 = 0, P_QKP = 1, P_HGB = 2, P_HGC = 3, P_ATT = 4, P_G2 = 5, P_G3 = 6, P_N2R = 7, P_TOPK = 8, P_GATH = 9, P_G4 = 10, P_G5 = 11, P_COMB = 12 };

#ifndef REP_HG
#define REP_HG 1
#endif
#ifndef REP_PRO
#define REP_PRO 1
#endif
#ifndef REP_ROW
#define REP_ROW 1
#endif
#ifndef REP_G
#define REP_G 1
#endif
#ifndef REP_TK
#define REP_TK 1
#endif
#ifndef REP_QK
#define REP_QK 1
#endif
#ifndef REP_ATT
#define REP_ATT 1
#endif
struct Params {
    const float *x, *c, *ada_w, *ada_b, *norm_mix_w, *norm_ffn_w, *w_in, *q_norm_w, *k_norm_w, *hlb, *hg_norm_w, *w_ba, *w_bh, *w_out, *w_router, *w_eg, *w_eu, *w_ed;
    float* out; unsigned char* ws;
    int ph_lo, ph_hi, li, pad;
};
struct Frame {
    LAS unsigned char* lds;
    int tid, lane, wave, vcu, G;
};

__device__ __forceinline__ void tr_tile(const float* __restrict__ src, int ldw, bf16_t* __restrict__ dst, int Kd, LAS float* scr, int lane) {
    f32x4 v[8];
#pragma unroll
    for (int i = 0; i < 8; ++i) v[i] = *(const f32x4*)(src + (size_t)(8 * i + (lane >> 3)) * ldw + 4 * (lane & 7));
#pragma unroll
    for (int i = 0; i < 8; ++i) { LAS float* s = scr + (8 * i + (lane >> 3)) * 33 + 4 * (lane & 7); s[0] = v[i].x; s[1] = v[i].y; s[2] = v[i].z; s[3] = v[i].w; }
    asm volatile("s_waitcnt lgkmcnt(0)" ::: "memory");
    const int cch = lane & 7;
#pragma unroll
    for (int j = 0; j < 4; ++j) { const int n = (lane >> 3) + 8 * j; const LAS float* s = scr + (8 * cch) * 33 + n;
        u32x4 o; o.x = pk2(s[0 * 33], s[1 * 33]); o.y = pk2(s[2 * 33], s[3 * 33]); o.z = pk2(s[4 * 33], s[5 * 33]); o.w = pk2(s[6 * 33], s[7 * 33]);
        *(u32x4*)(dst + (size_t)n * Kd + 8 * cch) = o; }
    asm volatile("s_waitcnt lgkmcnt(0)" ::: "memory");
}
__device__ __forceinline__ void tr_tile_f8(const float* __restrict__ src, int ldw, unsigned char* __restrict__ dst, int Kd, LAS float* scr, int lane, float scale) {
    f32x4 v[8];
#pragma unroll
    for (int i = 0; i < 8; ++i) v[i] = *(const f32x4*)(src + (size_t)(8 * i + (lane >> 3)) * ldw + 4 * (lane & 7));
#pragma unroll
    for (int i = 0; i < 8; ++i) { LAS float* s = scr + (8 * i + (lane >> 3)) * 33 + 4 * (lane & 7); s[0] = v[i].x; s[1] = v[i].y; s[2] = v[i].z; s[3] = v[i].w; }
    asm volatile("s_waitcnt lgkmcnt(0)" ::: "memory");
    const int cch = lane & 7;
#pragma unroll
    for (int j = 0; j < 4; ++j) { const int n = (lane >> 3) + 8 * j; const LAS float* s = scr + (8 * cch) * 33 + n;
        const f32x4 a = {s[0 * 33] * scale, s[1 * 33] * scale, s[2 * 33] * scale, s[3 * 33] * scale}, b = {s[4 * 33] * scale, s[5 * 33] * scale, s[6 * 33] * scale, s[7 * 33] * scale};
        *(u32x2*)(dst + (size_t)n * Kd + 8 * cch) = pg8::pack8_fp8(a, b); }
    asm volatile("s_waitcnt lgkmcnt(0)" ::: "memory");
}
__device__ __forceinline__ void conv_experts_f8(Frame& F, const Params& p, int l, LAS float* scr) {
    const int gw = F.vcu * NWAVES + F.wave, NGW = F.G * NWAVES;
    unsigned char* WGU = p.ws + WS_WGU + (size_t)l * 64 * MiB; unsigned char* WD = p.ws + WS_WD + (size_t)l * 32 * MiB;
    for (int it = gw; it < 3 * NE * 1024; it += NGW) {
        const int which = it / (NE * 1024), r0 = it % (NE * 1024), e = r0 >> 10, r = r0 & 1023;
        if (which < 2) {
            const int kb = r >> 6, nb = r & 63, n0 = 32 * nb;
            const float* W = (which == 0 ? p.w_eg : p.w_eu) + (size_t)(l * NE + e) * D * FF;
            const int rho = e * 4096 + (n0 >> 7) * 256 + which * 128 + (n0 & 127);
            tr_tile_f8(W + (size_t)(64 * kb) * FF + n0, FF, WGU + (size_t)rho * D + 64 * kb, D, scr, F.lane, 64.0f);
        } else {
            const int kb = r >> 5, nb = r & 31, n0 = 32 * nb;
            const float* W = p.w_ed + (size_t)(l * NE + e) * FF * D;
            tr_tile_f8(W + (size_t)(64 * kb) * D + n0, D, WD + (size_t)(e * 1024 + n0) * FF + 64 * kb, FF, scr, F.lane, 64.0f);
        }
    }
}
__device__ __forceinline__ void conv_matrix(Frame& F, const float* W, int K, int N, bf16_t* WT, LAS float* scr) {
    const int gw = F.vcu * NWAVES + F.wave, NGW = F.G * NWAVES, nblk = N / 32, nitems = (K / 64) * nblk;
    for (int it = gw; it < nitems; it += NGW) { const int kb = it / nblk, nb = it % nblk;
        tr_tile(W + (size_t)(64 * kb) * N + 32 * nb, N, WT + (size_t)(32 * nb) * K + 64 * kb, K, scr, F.lane); }
}
__device__ __forceinline__ void conv_experts(Frame& F, const Params& p, int l, LAS float* scr) {
    const int gw = F.vcu * NWAVES + F.wave, NGW = F.G * NWAVES;
    bf16_t* WGU = (bf16_t*)(p.ws + WS_WGU); bf16_t* WD = (bf16_t*)(p.ws + WS_WD);
    for (int it = gw; it < 3 * NE * 1024; it += NGW) {
        const int which = it / (NE * 1024), r0 = it % (NE * 1024), e = r0 >> 10, r = r0 & 1023;
        if (which < 2) {
            const int kb = r >> 6, nb = r & 63, n0 = 32 * nb;
            const float* W = (which == 0 ? p.w_eg : p.w_eu) + (size_t)(l * NE + e) * D * FF;
            const int rho = e * 4096 + (n0 >> 7) * 256 + which * 128 + (n0 & 127);
            tr_tile(W + (size_t)(64 * kb) * FF + n0, FF, WGU + (size_t)rho * D + 64 * kb, D, scr, F.lane);
        } else {
            const int kb = r >> 5, nb = r & 31, n0 = 32 * nb;
            const float* W = p.w_ed + (size_t)(l * NE + e) * FF * D;
            tr_tile(W + (size_t)(64 * kb) * D + n0, D, WD + (size_t)(e * 1024 + n0) * FF + 64 * kb, FF, scr, F.lane);
        }
    }
}
__device__ __forceinline__ void mod_units(Frame& F, const Params& p) {
    LAS float* sc = (LAS float*)(F.lds + 96 * 1024);
    LAS float* red = sc + 1024;
    float* MOD = (float*)(p.ws + WS_MOD); float* LBV = (float*)(p.ws + WS_LBV);
    for (int u = blockIdx.x; u < NL * 96; u += F.G) {
        for (int i = F.tid; i < D; i += 512) sc[i] = siluf_(p.c[i]);
        __syncthreads();
        const int l = u / 96, j = (u % 96) * 64 + (F.tid & 63), kp = F.tid >> 6;
        const float* w = p.ada_w + (size_t)l * D * 6 * D + (size_t)(kp * 128) * 6 * D + j;
        float acc = 0.f;
#pragma unroll 8
        for (int k = 0; k < 128; ++k) acc += sc[kp * 128 + k] * w[(size_t)k * 6 * D];
        red[kp * 64 + (F.tid & 63)] = acc;
        __syncthreads();
        if (F.tid < 64) { float s = 0.f;
#pragma unroll
            for (int q = 0; q < 8; ++q) s += red[q * 64 + F.tid];
            MOD[l * 6 * D + j] = s + p.ada_b[l * 6 * D + j]; }
        __syncthreads();
    }
    const int n = blockIdx.x * 512 + F.tid;
    if (n < NL * 1024) { const int l = n / 1024, r = n % 1024; float v = 0.f;
        if (l == 1) { const float b0 = p.hlb[r], b1 = p.hlb[1024 + r]; v = 1.0f / (1.0f + __expf(b0 - b1)); }
        LBV[n] = v; }
}

__device__ __forceinline__ void norm_mod_row(const f32x4 (&v)[4], float ss, const float* __restrict__ w, const float* __restrict__ scale,
                                             const float* __restrict__ shift, bf16_t* __restrict__ orow, int lane, f32x4 (&h)[4]) {
    const float r = rsqrtf(ss * (1.0f / D) + EPS);
#pragma unroll
    for (int j = 0; j < 4; ++j) {
        const int c0 = 4 * lane + 256 * j;
        const f32x4 wv = *(const f32x4*)(w + c0), sv = *(const f32x4*)(scale + c0), bv = *(const f32x4*)(shift + c0);
        h[j] = (v[j] * r) * wv * (sv + 1.0f) + bv;
        u32x2 o; o.x = pk2(h[j].x, h[j].y); o.y = pk2(h[j].z, h[j].w);
        *(u32x2*)(orow + c0) = o;
    }
}
__device__ __forceinline__ void norm_mod_row_f8(const f32x4 (&v)[4], float ss, const float* __restrict__ w, const float* __restrict__ scale,
                                                const float* __restrict__ shift, unsigned char* __restrict__ orow, int lane, f32x4 (&h)[4]) {
    const float r = rsqrtf(ss * (1.0f / D) + EPS);
#pragma unroll
    for (int j = 0; j < 4; ++j) {
        const int c0 = 4 * lane + 256 * j;
        const f32x4 wv = *(const f32x4*)(w + c0), sv = *(const f32x4*)(scale + c0), bv = *(const f32x4*)(shift + c0);
        h[j] = (v[j] * r) * wv * (sv + 1.0f) + bv;
        int wd = 0; wd = __builtin_amdgcn_cvt_pk_fp8_f32(h[j].x, h[j].y, wd, false); wd = __builtin_amdgcn_cvt_pk_fp8_f32(h[j].z, h[j].w, wd, true);
        *(int*)(orow + c0) = wd;
    }
}
__device__ __forceinline__ void ph_norm1(Frame& F, const float* x, const float* w, const float* scale, const float* shift, bf16_t* HB) {
    const int gw = F.vcu * NWAVES + F.wave, NGW = F.G * NWAVES;
    for (int row = gw; row < S; row += NGW) {
        const f32x4* xr = (const f32x4*)(x + (size_t)row * D) + F.lane;
        f32x4 v[4], h[4]; float ss = 0.f;
#pragma unroll
        for (int j = 0; j < 4; ++j) { v[j] = xr[64 * j]; ss += (v[j].x * v[j].x + v[j].y * v[j].y) + (v[j].z * v[j].z + v[j].w * v[j].w); }
        ss = wave_sum(ss);
        norm_mod_row(v, ss, w, scale, shift, HB + (size_t)row * D, F.lane, h);
    }
}
__device__ __forceinline__ void ph_gather(Frame& F, const unsigned char* HB8, const int* IDX, unsigned char* XE8) {
    const int gw = F.vcu * NWAVES + F.wave, NGW = F.G * NWAVES;
    constexpr int PER = NE * CAP / 2048;
    if (NGW * PER == NE * CAP) {
        const int r0 = gw * PER;
        const int mine = IDX[r0 + (F.lane & 15)];
#pragma unroll
        for (int q = 0; q < PER; q += 8) {
            u32x4 a[8];
#pragma unroll
            for (int k = 0; k < 8; ++k) { const int t = __builtin_amdgcn_readlane(mine, q + k); a[k] = ((const u32x4*)(HB8 + (size_t)t * D))[F.lane]; }
#pragma unroll
            for (int k = 0; k < 8; ++k) ((u32x4*)(XE8 + (size_t)(r0 + q + k) * D))[F.lane] = a[k];
        }
    } else {
        for (int r = gw; r < NE * CAP; r += NGW) { const int t = IDX[r]; ((u32x4*)(XE8 + (size_t)r * D))[F.lane] = ((const u32x4*)(HB8 + (size_t)t * D))[F.lane]; }
    }
}

#define OPAQUE_LANE() const int lane = lane_id_opaque(); const int t_ = F.wave * 64 + lane
__device__ __forceinline__ void ph_rope_table(Frame& F, float* ROPE) {
    OPAQUE_LANE();
    const int n = blockIdx.x * 512 + t_;
    if (n < 4096) { const int pos = n >> 4, i = n & 15; const float inv = exp2f(-(float)i * (13.287712379549449f / 16.0f)); float sn, cs; sincosf((float)pos * inv, &sn, &cs); ROPE[2 * n] = cs; ROPE[2 * n + 1] = sn; }
}
__device__ __forceinline__ void ph_qkprep(Frame& F, const bf16_t* __restrict__ QR, const bf16_t* __restrict__ KR, const float* __restrict__ qw, const float* __restrict__ kw,
                                          const float* __restrict__ ROPE, bf16_t* __restrict__ QN, bf16_t* __restrict__ KN) {
    OPAQUE_LANE(); (void)lane;
    for (int gid = blockIdx.x * 512 + t_; gid < S * 10; gid += F.G * 512) {
        const int t = gid / 10, hh = gid % 10;
        const bool isq = hh < 8;
        const bf16_t* src = isq ? QR + (size_t)t * 512 + hh * 64 : KR + (size_t)t * 128 + (hh - 8) * 64;
        bf16_t* dst = isq ? QN + (size_t)t * 512 + hh * 64 : KN + (size_t)t * 128 + (hh - 8) * 64;
        const float* w = isq ? qw : kw;
        float f[64]; float ss = 0.f;
#pragma unroll
        for (int i = 0; i < 8; ++i) { const u32x4 q = *(const u32x4*)(src + 8 * i);
#pragma unroll
            for (int j = 0; j < 4; ++j) { f[8 * i + 2 * j] = bflo(q[j]); f[8 * i + 2 * j + 1] = bfhi(q[j]); } }
#pragma unroll
        for (int i = 0; i < 64; ++i) ss += f[i] * f[i];
        const float rn = rsqrtf(ss * (1.0f / 64.0f) + EPS), sc = isq ? C2 : 1.0f;
#pragma unroll
        for (int i = 0; i < 16; ++i) { const f32x4 wv = *(const f32x4*)(w + 4 * i);
            f[4 * i] *= rn * wv.x; f[4 * i + 1] *= rn * wv.y; f[4 * i + 2] *= rn * wv.z; f[4 * i + 3] *= rn * wv.w; }
        float o[64];
#pragma unroll
        for (int ax = 0; ax < 2; ++ax) {
            const float* tb = ROPE + (size_t)(ax == 0 ? (t >> 6) : (t & 63)) * 32;
#pragma unroll
            for (int i2 = 0; i2 < 8; ++i2) { const f32x4 cs = *(const f32x4*)(tb + 4 * i2);
#pragma unroll
                for (int k = 0; k < 2; ++k) { const int i = 2 * i2 + k; const float c_ = k ? cs.z : cs.x, s_ = k ? cs.w : cs.y;
                    const float x1 = f[ax * 32 + i], x2 = f[ax * 32 + 16 + i];
                    o[ax * 32 + i] = (x1 * c_ - x2 * s_) * sc; o[ax * 32 + 16 + i] = (x2 * c_ + x1 * s_) * sc; } }
        }
#pragma unroll
        for (int i = 0; i < 8; ++i) { u32x4 q;
#pragma unroll
            for (int j = 0; j < 4; ++j) q[j] = pk2(o[8 * i + 2 * j], o[8 * i + 2 * j + 1]);
            *(u32x4*)(dst + 8 * i) = q; }
    }
}
__device__ __forceinline__ void ph_hgfin(Frame& F, const float* __restrict__ OF, const bf16_t* __restrict__ HG, const float* __restrict__ w, bf16_t* __restrict__ OHG) {
    OPAQUE_LANE();
    const int gw = F.vcu * NWAVES + F.wave, NGW = F.G * NWAVES;
    const int e0 = (lane & 15) * 8;
    const f32x4 w0 = *(const f32x4*)(w + e0), w1 = *(const f32x4*)(w + e0 + 4);
    for (int t = gw; t < S; t += NGW) {
        const size_t off = (size_t)t * 512 + lane * 8;
        const f32x4 a0 = *(const f32x4*)(OF + off), a1 = *(const f32x4*)(OF + off + 4), b0 = *(const f32x4*)(OF + (size_t)S * 512 + off), b1 = *(const f32x4*)(OF + (size_t)S * 512 + off + 4);
        const f32x4 s0 = a0 + b0, s1 = a1 + b1;
        float ss = (s0.x * s0.x + s0.y * s0.y) + (s0.z * s0.z + s0.w * s0.w) + (s1.x * s1.x + s1.y * s1.y) + (s1.z * s1.z + s1.w * s1.w);
        ss += __shfl_xor(ss, 1); ss += __shfl_xor(ss, 2); ss += __shfl_xor(ss, 4); ss += __shfl_xor(ss, 8);
        const float r = rsqrtf(ss * (1.0f / 128.0f) + EPS);
        const u32x4 g = *(const u32x4*)(HG + off);
        u32x4 o;
        o.x = pk2(s0.x * r * w0.x * bflo(g.x), s0.y * r * w0.y * bfhi(g.x));
        o.y = pk2(s0.z * r * w0.z * bflo(g.y), s0.w * r * w0.w * bfhi(g.y));
        o.z = pk2(s1.x * r * w1.x * bflo(g.z), s1.y * r * w1.y * bfhi(g.z));
        o.w = pk2(s1.z * r * w1.z * bflo(g.w), s1.w * r * w1.w * bfhi(g.w));
        *(u32x4*)(OHG + off) = o;
    }
}
__device__ __forceinline__ void ph_norm2_router(Frame& F, const float* __restrict__ X1, const float* __restrict__ w, const float* __restrict__ scale, const float* __restrict__ shift,
                                                const float* __restrict__ wr, unsigned char* __restrict__ HB, float* __restrict__ AFF) {
    OPAQUE_LANE();
    LAS float* WT = (LAS float*)F.lds;
    for (int dd = t_; dd < D; dd += NWAVES * 64) {
        const GAS f32x4* s = (const GAS f32x4*)((const GAS float*)wr + (size_t)dd * 16);
        const f32x4 a = s[0], b = s[1], c = s[2], e = s[3];
        WT[0 * D + dd] = a.x; WT[1 * D + dd] = a.y; WT[2 * D + dd] = a.z; WT[3 * D + dd] = a.w; WT[4 * D + dd] = b.x; WT[5 * D + dd] = b.y; WT[6 * D + dd] = b.z; WT[7 * D + dd] = b.w;
        WT[8 * D + dd] = c.x; WT[9 * D + dd] = c.y; WT[10 * D + dd] = c.z; WT[11 * D + dd] = c.w; WT[12 * D + dd] = e.x; WT[13 * D + dd] = e.y; WT[14 * D + dd] = e.z; WT[15 * D + dd] = e.w;
    }
    __syncthreads();
    const int gw = F.vcu * NWAVES + F.wave, NGW = F.G * NWAVES;
    for (int row = gw; row < S; row += 2 * NGW) {
        const int row1 = (row + NGW < S) ? row + NGW : row;
        const f32x4* xr0 = (const f32x4*)(X1 + (size_t)row * D) + lane; const f32x4* xr1 = (const f32x4*)(X1 + (size_t)row1 * D) + lane;
        f32x4 v0[4], v1[4], h0[4], h1[4]; float ss0 = 0.f, ss1 = 0.f;
#pragma unroll
        for (int j = 0; j < 4; ++j) { v0[j] = xr0[64 * j]; v1[j] = xr1[64 * j]; }
#pragma unroll
        for (int j = 0; j < 4; ++j) { ss0 += (v0[j].x * v0[j].x + v0[j].y * v0[j].y) + (v0[j].z * v0[j].z + v0[j].w * v0[j].w); ss1 += (v1[j].x * v1[j].x + v1[j].y * v1[j].y) + (v1[j].z * v1[j].z + v1[j].w * v1[j].w); }
        ss0 = wave_sum(ss0); ss1 = wave_sum(ss1);
        norm_mod_row_f8(v0, ss0, w, scale, shift, HB + (size_t)row * D, lane, h0);
        norm_mod_row_f8(v1, ss1, w, scale, shift, HB + (size_t)row1 * D, lane, h1);
        LAS float* wt = WT + 4 * lane; asm volatile("" : "+v"(wt));
        f32x4 lg0[4], lg1[4];
#pragma unroll
        for (int e = 0; e < 16; ++e) {
            float a0 = 0.f, a1 = 0.f;
#pragma unroll
            for (int j = 0; j < 4; ++j) { const f32x4 ww = *(const LAS f32x4*)(wt + e * D + 256 * j);
                a0 += (h0[j].x * ww.x + h0[j].y * ww.y) + (h0[j].z * ww.z + h0[j].w * ww.w); a1 += (h1[j].x * ww.x + h1[j].y * ww.y) + (h1[j].z * ww.z + h1[j].w * ww.w); }
            lg0[e >> 2][e & 3] = wave_sum(a0); lg1[e >> 2][e & 3] = wave_sum(a1);
        }
#pragma unroll
        for (int rr = 0; rr < 2; ++rr) {
            f32x4 (&lgv)[4] = rr ? lg1 : lg0;
            float mx = -1e30f;
#pragma unroll
            for (int e4 = 0; e4 < 4; ++e4) mx = fmaxf(mx, fmaxf(fmaxf(lgv[e4].x, lgv[e4].y), fmaxf(lgv[e4].z, lgv[e4].w)));
            float den = 0.f;
#pragma unroll
            for (int e4 = 0; e4 < 4; ++e4) { lgv[e4].x = __expf(lgv[e4].x - mx); lgv[e4].y = __expf(lgv[e4].y - mx); lgv[e4].z = __expf(lgv[e4].z - mx); lgv[e4].w = __expf(lgv[e4].w - mx);
                den += (lgv[e4].x + lgv[e4].y) + (lgv[e4].z + lgv[e4].w); }
            const float inv = 1.0f / den;
            const f32x4 s8a = (lane & 8) ? lgv[2] : lgv[0], s8b = (lane & 8) ? lgv[3] : lgv[1];
            const f32x4 s4 = (lane & 4) ? s8b : s8a;
            const float s2a = (lane & 2) ? s4.z : s4.x, s2b = (lane & 2) ? s4.w : s4.y;
            const float mine = ((lane & 1) ? s2b : s2a) * inv;
            const int rw = rr ? row1 : row;
            if (lane < 16 && (rr == 0 || row1 != row)) AFF[(size_t)lane * S + rw] = mine;
        }
    }
    __syncthreads();
}
__device__ __forceinline__ void ph_topk(Frame& F, LAS unsigned char* lds, int e, const float* __restrict__ AFF, int* __restrict__ IDX, float* __restrict__ TOPW, int* __restrict__ SLOT) {
    LAS unsigned* hist = (LAS unsigned*)lds;
    LAS unsigned* shv = hist + 256;
    LAS unsigned* scan = hist + 512;
    OPAQUE_LANE(); (void)lane; const int tid = t_;
    const unsigned* vals = (const unsigned*)(AFF + (size_t)e * S);
    unsigned u[32];
#pragma unroll
    for (int i = 0; i < 8; ++i) { const u32x4 q = *(const u32x4*)(vals + tid * 32 + 4 * i); u[4 * i] = q.x; u[4 * i + 1] = q.y; u[4 * i + 2] = q.z; u[4 * i + 3] = q.w; }
    if (tid == 0) { shv[0] = 0u; shv[1] = CAP; }
    __syncthreads();
    for (int pass = 3; pass >= 0; --pass) {
        const int shift = pass * 8;
        const unsigned mask = pass == 3 ? 0u : (0xFFFFFFFFu << (shift + 8));
        if (tid < 256) hist[tid] = 0u;
        __syncthreads();
        const unsigned prefix = shv[0];
#pragma unroll
        for (int i = 0; i < 32; ++i) if ((u[i] & mask) == (prefix & mask)) __hip_atomic_fetch_add(&hist[(u[i] >> shift) & 255u], 1u, __ATOMIC_RELAXED, __HIP_MEMORY_SCOPE_WORKGROUP);
        __syncthreads();
        if (tid == 0) {
            unsigned kk = shv[1], cum = 0u; int b = 255;
            for (; b > 0; --b) { const unsigned hb = hist[b]; if (cum + hb >= kk) break; cum += hb; }
            shv[1] = kk - cum; shv[0] = prefix | ((unsigned)b << shift);
        }
        __syncthreads();
    }
    const unsigned T = shv[0], need_eq = shv[1];
    unsigned ceq = 0u;
#pragma unroll
    for (int i = 0; i < 32; ++i) ceq += (u[i] == T) ? 1u : 0u;
    scan[tid] = ceq; __syncthreads();
    for (int off = 1; off < 512; off <<= 1) { const unsigned tv = tid >= off ? scan[tid - off] : 0u; __syncthreads(); scan[tid] += tv; __syncthreads(); }
    unsigned eq_rank = scan[tid] - ceq;
    __syncthreads();
    unsigned selmask = 0u, csel = 0u;
#pragma unroll
    for (int i = 0; i < 32; ++i) { bool sel = u[i] > T; if (u[i] == T) { sel = eq_rank < need_eq; ++eq_rank; } if (sel) { selmask |= 1u << i; ++csel; } }
    scan[tid] = csel; __syncthreads();
    for (int off = 1; off < 512; off <<= 1) { const unsigned tv = tid >= off ? scan[tid - off] : 0u; __syncthreads(); scan[tid] += tv; __syncthreads(); }
    unsigned slot = scan[tid] - csel;
#pragma unroll
    for (int i = 0; i < 32; ++i) {
        const int t = tid * 32 + i; int sl = -1;
        if (selmask & (1u << i)) { sl = (int)slot; ++slot; if (sl < CAP) { IDX[e * CAP + sl] = t; TOPW[e * CAP + sl] = __uint_as_float(u[i]); } }
        SLOT[(size_t)e * S + t] = sl < CAP ? sl : -1;
    }
    __syncthreads();
}
__device__ __forceinline__ void ph_combine(Frame& F, const float* __restrict__ X1, const bf16_t* __restrict__ YE, const int* __restrict__ SLOT, const float* __restrict__ gate,
                                           float* __restrict__ xout, const float* __restrict__ w, const float* __restrict__ scale, const float* __restrict__ shift, bf16_t* __restrict__ HB, bool do_norm) {
    OPAQUE_LANE();
    const int gw = F.vcu * NWAVES + F.wave, NGW = F.G * NWAVES;
    for (int row = gw; row < S; row += 2 * NGW) {
        const bool two = row + NGW < S; const int row1 = two ? row + NGW : row;
        const int sl0 = lane < NE ? SLOT[(size_t)lane * S + row] : -1, sl1 = lane < NE ? SLOT[(size_t)lane * S + row1] : -1;
        const f32x4* xr0 = (const f32x4*)(X1 + (size_t)row * D) + lane; const f32x4* xr1 = (const f32x4*)(X1 + (size_t)row1 * D) + lane;
        f32x4 v0[4], v1[4];
#pragma unroll
        for (int j = 0; j < 4; ++j) { v0[j] = xr0[64 * j]; v1[j] = xr1[64 * j]; }
        f32x4 acc0[4], acc1[4];
#pragma unroll
        for (int j = 0; j < 4; ++j) { acc0[j] = f32x4{0.f, 0.f, 0.f, 0.f}; acc1[j] = acc0[j]; }
        unsigned m0 = (unsigned)__ballot(sl0 >= 0) & 0xffffu, m1 = (unsigned)__ballot(sl1 >= 0) & 0xffffu;
        while (m0 | m1) {
            const int e0 = m0 ? __builtin_ctz(m0) : 0, e1 = m1 ? __builtin_ctz(m1) : 0;
            const float f0 = m0 ? 1.f : 0.f, f1 = m1 ? 1.f : 0.f;
            const int s0 = m0 ? __builtin_amdgcn_readlane(sl0, e0) : 0, s1 = m1 ? __builtin_amdgcn_readlane(sl1, e1) : 0;
            m0 &= m0 - 1u; m1 &= m1 - 1u;
            const bf16_t* y0 = YE + ((size_t)e0 * CAP + s0) * D + 4 * lane; const bf16_t* y1 = YE + ((size_t)e1 * CAP + s1) * D + 4 * lane;
            u32x2 q0[4], q1[4];
#pragma unroll
            for (int j = 0; j < 4; ++j) { q0[j] = *(const u32x2*)(y0 + 256 * j); q1[j] = *(const u32x2*)(y1 + 256 * j); }
#pragma unroll
            for (int j = 0; j < 4; ++j) { acc0[j].x += f0 * bflo(q0[j].x); acc0[j].y += f0 * bfhi(q0[j].x); acc0[j].z += f0 * bflo(q0[j].y); acc0[j].w += f0 * bfhi(q0[j].y);
                                          acc1[j].x += f1 * bflo(q1[j].x); acc1[j].y += f1 * bfhi(q1[j].x); acc1[j].z += f1 * bflo(q1[j].y); acc1[j].w += f1 * bfhi(q1[j].y); }
        }
        f32x4 h[4]; float ss0 = 0.f, ss1 = 0.f;
#pragma unroll
        for (int j = 0; j < 4; ++j) { const f32x4 gv = *(const f32x4*)(gate + 4 * lane + 256 * j); v0[j] = v0[j] + gv * acc0[j]; v1[j] = v1[j] + gv * acc1[j];
            ((f32x4*)(xout + (size_t)row * D) + lane)[64 * j] = v0[j]; if (two) ((f32x4*)(xout + (size_t)row1 * D) + lane)[64 * j] = v1[j];
            ss0 += (v0[j].x * v0[j].x + v0[j].y * v0[j].y) + (v0[j].z * v0[j].z + v0[j].w * v0[j].w); ss1 += (v1[j].x * v1[j].x + v1[j].y * v1[j].y) + (v1[j].z * v1[j].z + v1[j].w * v1[j].w); }
        if (do_norm) { ss0 = wave_sum(ss0); ss1 = wave_sum(ss1); norm_mod_row(v0, ss0, w, scale, shift, HB + (size_t)row * D, lane, h); if (two) norm_mod_row(v1, ss1, w, scale, shift, HB + (size_t)row1 * D, lane, h); }
    }
}

__global__ void __launch_bounds__(NWAVES * 64, 2) mega(Params p) {
    extern __shared__ __attribute__((aligned(16))) unsigned char lds[];
    Frame F;
    F.lds = (LAS unsigned char*)lds;
    volatile LAS unsigned* MISC = (volatile LAS unsigned*)(F.lds + MISC_OFF);
    F.tid = threadIdx.x; F.lane = F.tid & 63; F.wave = __builtin_amdgcn_readfirstlane(F.tid >> 6);
    F.G = gridDim.x; { const int bx = blockIdx.x; F.vcu = (F.G % 8 == 0) ? (bx % 8) * (F.G / 8) + bx / 8 : bx; }
    unsigned char* ws = p.ws;
    unsigned* ctl = (unsigned*)(ws + WS_CTL);
    for (int u = F.tid; u < (LDS_BYTES - LDSCTL_OFF) / 4; u += NWAVES * 64) ((LAS unsigned*)(F.lds + LDSCTL_OFF))[u] = 0u;
    __syncthreads();
    XcdBarrier bar = xcd_barrier_post(ctl + CW_BAR + p.li * XCD_BAR_WORDS, MISC + 8);
    const int lo = p.ph_lo, hi = p.ph_hi;
#define IN(k) (lo <= (k) && (k) < hi)
#define SEAM(k) do { if (IN(k) && IN((k) + 1)) xcd_barrier(bar); } while (0)
#define REFRESH() do { F.lane = lane_id_opaque(); F.tid = F.wave * 64 + F.lane; } while (0)

#define WSP(T, off) ((T*)(GAS T*)(wsl + (off)))
#define WSL() unsigned char* wsl = p.ws; asm volatile("" : "+s"(wsl))
    LAS float* scr = (LAS float*)(F.lds + RING_OFF + F.wave * 8704);

    if (IN(PH_PRO)) { REFRESH(); WSL();
        mod_units(F, p);
        for (int l = 0; l < NL; ++l) {
            conv_matrix(F, p.w_in + (size_t)l * D * INW, D, INW, WSP(bf16_t, WS_WIN) + (size_t)l * INW * D, scr);
            conv_matrix(F, p.w_ba + (size_t)l * 512 * D, 512, D, WSP(bf16_t, WS_WBA) + (size_t)l * D * 512, scr);
            conv_matrix(F, p.w_bh + (size_t)l * 512 * D, 512, D, WSP(bf16_t, WS_WBH) + (size_t)l * D * 512, scr);
            conv_matrix(F, p.w_out + (size_t)l * D * D, D, D, WSP(bf16_t, WS_WOUT) + (size_t)l * D * D, scr);
        }
        for (int rep_ = 0; rep_ < REP_PRO; ++rep_) { conv_experts_f8(F, p, 0, scr); conv_experts_f8(F, p, 1, scr); }
        ph_rope_table(F, WSP(float, WS_ROPE));
    }
    SEAM(PH_PRO);
    if (IN(PH_NORM1)) { REFRESH(); WSL(); ph_norm1(F, p.x, p.norm_mix_w, WSP(float, WS_MOD) + 1 * D, WSP(float, WS_MOD) + 0 * D, WSP(bf16_t, WS_HB)); }
    SEAM(PH_NORM1);

    for (int l = 0; l < NL; ++l) {
        const int pb = PH_L0 + l * NPL;
        if (IN(pb + P_G1)) { WSL();
            pg8::Gemm g{WSP(bf16_t, WS_HB), WSP(bf16_t, WS_WIN) + (size_t)l * INW * D, S, INW, D}; pg8::StaticOrder So; So.init(S, INW, F.G, (int)blockIdx.x);
            pg8::EpiInproj E{WSP(bf16_t, WS_QR), WSP(bf16_t, WS_KR), WSP(bf16_t, WS_VV), WSP(bf16_t, WS_HQ), WSP(bf16_t, WS_KF), WSP(bf16_t, WS_HV), WSP(bf16_t, WS_HG), WSP(bf16_t, WS_GG), WSP(float, WS_LF), WSP(float, WS_LBV) + l * 1024};
            for (int rep_ = 0; rep_ < REP_G; ++rep_) pg8::gemm_phase<pg8::EpiInproj, pg8::StaticOrder, true, true>(F.lds + RING_OFF, g, So, E, F.wave);
        }
        SEAM(pb + P_G1);
        if (IN(pb + P_QKP)) { WSL();
            for (int rep_ = 0; rep_ < REP_QK; ++rep_) ph_qkprep(F, WSP(bf16_t, WS_QR), WSP(bf16_t, WS_KR), p.q_norm_w + l * 64, p.k_norm_w + l * 64, WSP(float, WS_ROPE), WSP(bf16_t, WS_QN), WSP(bf16_t, WS_KN));
            for (int rep_ = 0; rep_ < REP_HG; ++rep_) for (int u = blockIdx.x; u < 256; u += F.G) hg::segment<false>(F.lds, u, WSP(bf16_t, WS_HQ), WSP(float, WS_LF), WSP(bf16_t, WS_KF), WSP(bf16_t, WS_HV), WSP(float, WS_HST), WSP(float, WS_HST + 16 * MiB), nullptr, F.wave);
        }
        SEAM(pb + P_QKP);
        if (IN(pb + P_HGB)) { WSL(); OPAQUE_LANE(); (void)lane;
            for (int gid = blockIdx.x * 512 + t_; gid < 8 * 16384; gid += F.G * 512) hg::carry(WSP(float, WS_HST), WSP(float, WS_HST + 16 * MiB), gid);
        }
        SEAM(pb + P_HGB);
        if (IN(pb + P_HGC)) { WSL();
            for (int rep_ = 0; rep_ < REP_HG; ++rep_) for (int u = blockIdx.x; u < 256; u += F.G) hg::segment<true>(F.lds, u, WSP(bf16_t, WS_HQ), WSP(float, WS_LF), WSP(bf16_t, WS_KF), WSP(bf16_t, WS_HV), WSP(float, WS_HST), WSP(float, WS_HST + 16 * MiB), WSP(float, WS_OF), F.wave);
        }
        SEAM(pb + P_HGC);
        if (IN(pb + P_ATT)) { WSL();
            for (int rep_ = 0; rep_ < REP_QK; ++rep_) ph_hgfin(F, WSP(float, WS_OF), WSP(bf16_t, WS_HG), p.hg_norm_w + l * 128, WSP(bf16_t, WS_OHG));
            const attn_body::AttnTensors AT{(const attn_body::bf16*)WSP(bf16_t, WS_QN), (const attn_body::bf16*)WSP(bf16_t, WS_KN), (const attn_body::bf16*)WSP(bf16_t, WS_VV), (attn_body::bf16*)WSP(bf16_t, WS_OATT)};
            const attn_body::StaticOrder So((int)F.G, (int)blockIdx.x);
            for (int rep_ = 0; rep_ < REP_ATT; ++rep_) attn_body::attn_phase<attn_body::StaticOrder>((char*)lds + RING_OFF, AT, So, F.wave);
        }
        SEAM(pb + P_ATT);
        if (IN(pb + P_G2)) { WSL();
            { pg8::Gemm g{WSP(bf16_t, WS_OATT), WSP(bf16_t, WS_WBA) + (size_t)l * D * 512, S, D, 512}; pg8::StaticOrder So; So.init(S, D, F.G, (int)blockIdx.x);
              pg8::EpiBrA E{WSP(bf16_t, WS_GG), WSP(float, WS_MP)};
              for (int rep_ = 0; rep_ < REP_G; ++rep_) pg8::gemm_phase<pg8::EpiBrA, pg8::StaticOrder, false, true>(F.lds + RING_OFF, g, So, E, F.wave); }
            __syncthreads();
            { pg8::Gemm g{WSP(bf16_t, WS_OHG), WSP(bf16_t, WS_WBH) + (size_t)l * D * 512, S, D, 512}; pg8::StaticOrder So; So.init(S, D, F.G, (int)blockIdx.x);
              pg8::EpiBrH E{WSP(bf16_t, WS_GG), WSP(float, WS_MP), WSP(bf16_t, WS_MG)};
              for (int rep_ = 0; rep_ < REP_G; ++rep_) pg8::gemm_phase<pg8::EpiBrH, pg8::StaticOrder, false, true>(F.lds + RING_OFF, g, So, E, F.wave); }
        }
        SEAM(pb + P_G2);
        if (IN(pb + P_G3)) { WSL();
            pg8::Gemm g{WSP(bf16_t, WS_MG), WSP(bf16_t, WS_WOUT) + (size_t)l * D * D, S, D, D}; pg8::StaticOrder So; So.init(S, D, F.G, (int)blockIdx.x);
            pg8::EpiOut E{l == 0 ? p.x : WSP(float, WS_X2), WSP(float, WS_MOD) + l * 6 * D + 2 * D, WSP(float, WS_X1)};
            for (int rep_ = 0; rep_ < REP_G; ++rep_) pg8::gemm_phase<pg8::EpiOut, pg8::StaticOrder, false, true>(F.lds + RING_OFF, g, So, E, F.wave);
        }
        SEAM(pb + P_G3);
        if (IN(pb + P_N2R)) { WSL();
            for (int rep_ = 0; rep_ < REP_ROW; ++rep_) ph_norm2_router(F, WSP(float, WS_X1), p.norm_ffn_w + l * D, WSP(float, WS_MOD) + l * 6 * D + 4 * D, WSP(float, WS_MOD) + l * 6 * D + 3 * D, p.w_router + (size_t)l * D * NE, WSP(unsigned char, WS_HB8), WSP(float, WS_AFF));
        }
        SEAM(pb + P_N2R);
        if (IN(pb + P_TOPK)) { WSL();
            for (int rep_ = 0; rep_ < REP_TK; ++rep_) for (int e = blockIdx.x; e < NE; e += F.G) ph_topk(F, F.lds, e, WSP(float, WS_AFF), WSP(int, WS_IDX), WSP(float, WS_TOPW), WSP(int, WS_SLOT));
        }
        SEAM(pb + P_TOPK);
        if (IN(pb + P_GATH)) { REFRESH(); WSL(); for (int rep_ = 0; rep_ < REP_ROW; ++rep_) ph_gather(F, WSP(unsigned char, WS_HB8), WSP(int, WS_IDX), WSP(unsigned char, WS_XE8)); }
        SEAM(pb + P_GATH);
        if (IN(pb + P_G4)) { WSL();
            pg8::Gemm g{(const bf16_t*)WSP(unsigned char, WS_XE8), (const bf16_t*)(WSP(unsigned char, WS_WGU) + (size_t)l * 64 * MiB), NE * CAP, NE * 4096, D / 2}; pg8::GroupOrder So; So.init(16, F.G, (int)blockIdx.x);
            pg8::EpiGU8 E{WSP(unsigned char, WS_HID8)};
            for (int rep_ = 0; rep_ < REP_G; ++rep_) pg8::gemm_phase<pg8::EpiGU8, pg8::GroupOrder, true, true, true>(F.lds + RING_OFF, g, So, E, F.wave);
        }
        SEAM(pb + P_G4);
        if (IN(pb + P_G5)) { WSL();
            pg8::Gemm g{(const bf16_t*)WSP(unsigned char, WS_HID8), (const bf16_t*)(WSP(unsigned char, WS_WD) + (size_t)l * 32 * MiB), NE * CAP, NE * 1024, FF / 2}; pg8::GroupOrder So; So.init(4, F.G, (int)blockIdx.x);
            pg8::EpiDown E{WSP(bf16_t, WS_YE), WSP(float, WS_TOPW), 0.015625f};
            for (int rep_ = 0; rep_ < REP_G; ++rep_) pg8::gemm_phase<pg8::EpiDown, pg8::GroupOrder, true, true, true>(F.lds + RING_OFF, g, So, E, F.wave);
        }
        SEAM(pb + P_G5);
        if (IN(pb + P_COMB)) { WSL();
            const bool last = (l + 1 == NL); const int ln = last ? l : l + 1;
            for (int rep_ = 0; rep_ < REP_ROW; ++rep_) ph_combine(F, WSP(float, WS_X1), WSP(bf16_t, WS_YE), WSP(int, WS_SLOT), WSP(float, WS_MOD) + l * 6 * D + 5 * D, last ? p.out : WSP(float, WS_X2),
                       p.norm_mix_w + ln * D, WSP(float, WS_MOD) + ln * 6 * D + 1 * D, WSP(float, WS_MOD) + ln * 6 * D + 0 * D, WSP(bf16_t, WS_HB), !last);
        }
        SEAM(pb + P_COMB);
    }
#undef IN
#undef SEAM
}

#ifndef N_LAUNCH_MODE
#define N_LAUNCH_MODE 1
#endif
static int g_grid = 0;
extern "C" void kernel_launch(void* const* d_in, const int* in_sizes, int n_in, void* d_out, int out_size, void* d_ws, size_t ws_size, hipStream_t stream) {
    if (n_in != 18 || out_size != S * D || ws_size < WS_END) { fprintf(stderr, "kernel_launch: unexpected shapes (n_in %d out %d ws %zu)\n", n_in, out_size, ws_size); return; }
    if (g_grid == 0) {
        int dev = 0, cus = 0;
        if (hipGetDevice(&dev) != hipSuccess || hipDeviceGetAttribute(&cus, hipDeviceAttributeMultiprocessorCount, dev) != hipSuccess) { g_grid = -1; return; }
        if (hipFuncSetAttribute((const void*)mega, hipFuncAttributeMaxDynamicSharedMemorySize, LDS_BYTES) != hipSuccess) { g_grid = -1; return; }
        int per_cu = 0;
        if (hipOccupancyMaxActiveBlocksPerMultiprocessor(&per_cu, (const void*)mega, NWAVES * 64, LDS_BYTES) != hipSuccess || per_cu < 1) { fprintf(stderr, "occupancy query: %d\n", per_cu); }
        (void)hipGetLastError();
        g_grid = cus;
    }
    if (g_grid < 0) return;
    unsigned char* ws = (unsigned char*)d_ws;
    (void)hipMemsetAsync(ws + WS_CTL, 0, 1 * MiB, stream);
    Params p{};
    p.x = (const float*)d_in[0]; p.c = (const float*)d_in[1]; p.ada_w = (const float*)d_in[2]; p.ada_b = (const float*)d_in[3]; p.norm_mix_w = (const float*)d_in[4];
    p.norm_ffn_w = (const float*)d_in[5]; p.w_in = (const float*)d_in[6]; p.q_norm_w = (const float*)d_in[7]; p.k_norm_w = (const float*)d_in[8]; p.hlb = (const float*)d_in[9];
    p.hg_norm_w = (const float*)d_in[10]; p.w_ba = (const float*)d_in[11]; p.w_bh = (const float*)d_in[12]; p.w_out = (const float*)d_in[13]; p.w_router = (const float*)d_in[14];
    p.w_eg = (const float*)d_in[15]; p.w_eu = (const float*)d_in[16]; p.w_ed = (const float*)d_in[17];
    p.out = (float*)d_out; p.ws = ws;
#if N_LAUNCH_MODE == 1
    p.ph_lo = 0; p.ph_hi = PH_END; p.li = 0; p.pad = 0;
    hipLaunchKernelGGL(mega, dim3(g_grid), dim3(NWAVES * 64), LDS_BYTES, stream, p);
#else
    for (int k = 0; k < PH_END; ++k) { p.ph_lo = k; p.ph_hi = k + 1; p.li = k; p.pad = 0; hipLaunchKernelGGL(mega, dim3(g_grid), dim3(NWAVES * 64), LDS_BYTES, stream, p); }
#endif
}
```

```cpp
#include <hip/hip_runtime.h>
#include <cstdio>
#include <cstdint>

typedef unsigned short bf16_t;
typedef float f32x4 __attribute__((ext_vector_type(4)));
typedef float f32x16 __attribute__((ext_vector_type(16)));
typedef unsigned u32x4 __attribute__((ext_vector_type(4)));
typedef unsigned u32x2 __attribute__((ext_vector_type(2)));

constexpr int S = 16384, D = 1024, NL = 2, INW = 5376;
constexpr int NE = 16, CAP = 2048, FF = 2048;
constexpr float EPS = 1e-6f;
constexpr float C2 = 0.125f * 1.4426950408889634f;
constexpr int C_AQ = 0, C_AK = 512, C_AV = 640, C_HQ = 768, C_ZF = 1280, C_ZB = 1792, C_HI = 2304, C_HGT = 2816, C_GL = 3328;

constexpr size_t MiB = 1u << 20;
constexpr size_t WS_CTL = 0;
constexpr size_t WS_MOD = 1 * MiB;
constexpr size_t WS_LBV = WS_MOD + 64 * 1024;
constexpr size_t WS_IDX = WS_MOD + 128 * 1024;
constexpr size_t WS_TOPW = WS_IDX + 128 * 1024;
constexpr size_t WS_ROPE = WS_MOD + 512 * 1024;
constexpr size_t WS_AFF = 2 * MiB;
constexpr size_t WS_SLOT = 3 * MiB;
constexpr size_t WS_HB = 4 * MiB;
constexpr size_t WS_QR = 36 * MiB;
constexpr size_t WS_KR = 52 * MiB;
constexpr size_t WS_VV = 56 * MiB;
constexpr size_t WS_QN = 60 * MiB;
constexpr size_t WS_KN = 76 * MiB;
constexpr size_t WS_HQ = 80 * MiB;
constexpr size_t WS_LF = 96 * MiB;
constexpr size_t WS_KF = 160 * MiB;
constexpr size_t WS_HV = 192 * MiB;
constexpr size_t WS_HG = 208 * MiB;
constexpr size_t WS_GG = 224 * MiB;
constexpr size_t WS_OATT = 288 * MiB;
constexpr size_t WS_OF = 304 * MiB;
constexpr size_t WS_OHG = 368 * MiB;
constexpr size_t WS_MP = 384 * MiB;
constexpr size_t WS_MG = 448 * MiB;
constexpr size_t WS_HB8 = 36 * MiB;
constexpr size_t WS_XE8 = 52 * MiB;
constexpr size_t WS_HID8 = 100 * MiB;
constexpr size_t WS_XE = 36 * MiB;
constexpr size_t WS_HID = 100 * MiB;
constexpr size_t WS_YE = 228 * MiB;
constexpr size_t WS_X1 = 480 * MiB;
constexpr size_t WS_X2 = 544 * MiB;
constexpr size_t WS_WIN = 608 * MiB;
constexpr size_t WS_WBA = 630 * MiB;
constexpr size_t WS_WBH = 632 * MiB;
constexpr size_t WS_WOUT = 634 * MiB;
constexpr size_t WS_WGU = 638 * MiB;
constexpr size_t WS_WD = 766 * MiB;
constexpr size_t WS_HST = 830 * MiB;
constexpr size_t WS_END = 900 * MiB;
static_assert(WS_END <= 1024 * MiB, "workspace");

__device__ __forceinline__ float bf2f(bf16_t v) { return __uint_as_float((unsigned)v << 16); }
__device__ __forceinline__ bf16_t f2bf(float f) { unsigned u = __float_as_uint(f); return (bf16_t)((u + 0x7fffu + ((u >> 16) & 1u)) >> 16); }
__device__ __forceinline__ unsigned pk2(float lo, float hi) { return (unsigned)f2bf(lo) | ((unsigned)f2bf(hi) << 16); }
__device__ __forceinline__ float bflo(unsigned w) { return __uint_as_float(w << 16); }
__device__ __forceinline__ float bfhi(unsigned w) { return __uint_as_float(w & 0xffff0000u); }
__device__ __forceinline__ float sigmoidf_(float v) { return __builtin_amdgcn_rcpf(1.0f + __expf(-v)); }
__device__ __forceinline__ float siluf_(float v) { return v * __builtin_amdgcn_rcpf(1.0f + __expf(-v)); }
__device__ __forceinline__ float wave_sum(float v) {
#pragma unroll
    for (int o = 1; o < 64; o <<= 1) v += __shfl_xor(v, o);
    return v;
}
__device__ __forceinline__ int crow(int r, int hi) { return (r & 3) + 8 * (r >> 2) + 4 * hi; }
__device__ __forceinline__ int lane_id_opaque() { int l; asm volatile("v_mbcnt_lo_u32_b32 %0, -1, 0\n\tv_mbcnt_hi_u32_b32 %0, -1, %0" : "=v"(l)); return l; }

#define GAS __attribute__((address_space(1)))
#define LAS __attribute__((address_space(3)))

namespace pg8 {
#define PG8_LAS __attribute__((address_space(3)))
typedef unsigned short bf16_t;
typedef short bf16x8 __attribute__((ext_vector_type(8)));
typedef float f32x4 __attribute__((ext_vector_type(4)));
typedef unsigned u32x4 __attribute__((ext_vector_type(4)));
constexpr int BM = 256, BK = 64, HALF = 128, HTB = HALF * BK * 2  , STAGE_BYTES = 8 * HTB, NXCD = 8, WGM = 8;

__host__ __device__ __forceinline__ int lds_byte(int r, int c) { const int st = (r >> 4) * 2 + (c >> 5), rr = r & 15, cc = c & 31, ob = rr * 64 + cc * 2; return st * 1024 + (ob ^ (((ob >> 9) & 1) << 5)); }
__host__ __device__ __forceinline__ void stage_rc(int b, int& R, int& C) { const int st = b / 1024, sb = b % 1024, swz = sb ^ (((sb >> 9) & 1) << 5); R = (st >> 1) * 16 + swz / 64; C = (st & 1) * 32 + (swz % 64) / 2; }
__host__ __device__ __forceinline__ int perm32(int rho) { const int n = rho >> 4, i = rho & 15; return 8 * (i >> 2) + 4 * n + (i & 3); }

struct Unit { int pm, pn, pb; };
struct Gemm { const bf16_t* A; const bf16_t* Bt; int M, N, K; };

struct StaticOrder {
    int nM, nN, nwg, G, c;
    __host__ __device__ void init(int M, int N, int G_, int c_) { nM = M / BM; nN = N / BM; nwg = nM * nN; G = G_; c = c_; }
    __host__ __device__ bool next(int i, Unit& u) const {
        const long L = (long)i * G + c; if (L >= nwg) return false;
        int wgid = (int)L; { const int q = nwg / NXCD, r = nwg % NXCD, xcd = wgid % NXCD, off = wgid / NXCD; wgid = (xcd < r ? xcd * (q + 1) : r * (q + 1) + (xcd - r) * q) + off; }
        const int nig = WGM * nN, gid = wgid / nig, fm = gid * WGM, gsz = (nM - fm) < WGM ? (nM - fm) : WGM;
        u.pm = fm + ((wgid % nig) % gsz); u.pn = (wgid % nig) / gsz; u.pb = u.pn; return true;
    }
    __device__ __forceinline__ void a_ready(const Unit&) const {}
    __device__ __forceinline__ void done(const Unit&) const {}
};

typedef float f32x2_c __attribute__((ext_vector_type(2))); typedef __bf16 bf16x2_c __attribute__((ext_vector_type(2)));
__device__ __forceinline__ unsigned cvt_pk_bf16(float lo, float hi) { f32x2_c v = {lo, hi}; bf16x2_c b = __builtin_convertvector(v, bf16x2_c); return __builtin_bit_cast(unsigned, b); }

typedef unsigned u32x2 __attribute__((ext_vector_type(2)));
__device__ __forceinline__ float e_bflo(unsigned w) { return __uint_as_float(w << 16); }
__device__ __forceinline__ float e_bfhi(unsigned w) { return __uint_as_float(w & 0xffff0000u); }
__device__ __forceinline__ float e_sig(float v) { return __builtin_amdgcn_rcpf(1.0f + __expf(-v)); }
__device__ __forceinline__ u32x4 pack8(const f32x4 a, const f32x4 b) { u32x4 w; w.x = cvt_pk_bf16(a[0], a[1]); w.y = cvt_pk_bf16(a[2], a[3]); w.z = cvt_pk_bf16(b[0], b[1]); w.w = cvt_pk_bf16(b[2], b[3]); return w; }

typedef int i32x4_ __attribute__((ext_vector_type(4))); typedef int i32x8_ __attribute__((ext_vector_type(8)));
__device__ __forceinline__ i32x8_ pg8_cat(const bf16x8 lo, const bf16x8 hi) { return __builtin_shufflevector(__builtin_bit_cast(i32x4_, lo), __builtin_bit_cast(i32x4_, hi), 0, 1, 2, 3, 4, 5, 6, 7); }
__device__ __forceinline__ u32x2 pack8_fp8(const f32x4 a, const f32x4 b) { int w0 = 0, w1 = 0;
    w0 = __builtin_amdgcn_cvt_pk_fp8_f32(a[0], a[1], w0, false); w0 = __builtin_amdgcn_cvt_pk_fp8_f32(a[2], a[3], w0, true);
    w1 = __builtin_amdgcn_cvt_pk_fp8_f32(b[0], b[1], w1, false); w1 = __builtin_amdgcn_cvt_pk_fp8_f32(b[2], b[3], w1, true);
    u32x2 r; r.x = (unsigned)w0; r.y = (unsigned)w1; return r; }
struct EpiInproj {
    static constexpr bool PERM = true, AFTER_DRAIN = false;
    bf16_t *QR, *KR, *VV, *HQ, *KF, *HV, *HG, *GG; float* LF; const float* lbv;
    __device__ __forceinline__ void operator()(const f32x4 (&acc)[2][2][4][2], const Unit& u, int wr, int wc, int fr, int fq) const {
        const int row0 = u.pm * BM + wr * 64 + fr, cl = wc * 32 + 8 * fq;
#pragma unroll
        for (int bj = 0; bj < 2; ++bj) {
            const int colg = u.pn * BM + bj * HALF;
            int kind; bf16_t* dst; int pitch, c0; int dir = 0;
            if (colg < 512) { kind = 0; dst = QR; pitch = 512; c0 = colg; }
            else if (colg < 640) { kind = 0; dst = KR; pitch = 128; c0 = colg - 512; }
            else if (colg < 768) { kind = 0; dst = VV; pitch = 128; c0 = colg - 640; }
            else if (colg < 1280) { kind = 1; dst = HQ; pitch = 512; c0 = colg - 768; }
            else if (colg < 2304) { kind = 3; dir = colg >= 1792; dst = KF + (size_t)dir * 16384 * 512; pitch = 512; c0 = colg - (dir ? 1792 : 1280); }
            else if (colg < 2816) { kind = 0; dst = HV; pitch = 512; c0 = colg - 2304; }
            else if (colg < 3328) { kind = 1; dst = HG; pitch = 512; c0 = colg - 2816; }
            else { kind = 2; dst = GG; pitch = 2048; c0 = colg - 3328; }
            c0 += cl;
            if (kind == 0) {
#pragma unroll
                for (int ai = 0; ai < 2; ++ai)
#pragma unroll
                    for (int m = 0; m < 4; ++m) *(u32x4*)(dst + (size_t)(row0 + ai * HALF + m * 16) * pitch + c0) = pack8(acc[ai][bj][m][0], acc[ai][bj][m][1]);
            } else if (kind == 1) {
#pragma unroll
                for (int ai = 0; ai < 2; ++ai)
#pragma unroll
                    for (int m = 0; m < 4; ++m) { f32x4 a = acc[ai][bj][m][0], b = acc[ai][bj][m][1];
#pragma unroll
                        for (int i = 0; i < 4; ++i) { a[i] = a[i] * e_sig(a[i]); b[i] = b[i] * e_sig(b[i]); }
                        *(u32x4*)(dst + (size_t)(row0 + ai * HALF + m * 16) * pitch + c0) = pack8(a, b); }
            } else if (kind == 2) {
#pragma unroll
                for (int ai = 0; ai < 2; ++ai)
#pragma unroll
                    for (int m = 0; m < 4; ++m) { f32x4 a = acc[ai][bj][m][0], b = acc[ai][bj][m][1];
#pragma unroll
                        for (int i = 0; i < 4; ++i) { a[i] = e_sig(a[i]); b[i] = e_sig(b[i]); }
                        *(u32x4*)(dst + (size_t)(row0 + ai * HALF + m * 16) * pitch + c0) = pack8(a, b); }
            } else {
                const f32x4 lb0 = *(const f32x4*)(lbv + dir * 512 + c0), lb1 = *(const f32x4*)(lbv + dir * 512 + c0 + 4);
                float* lf = LF + (size_t)dir * 16384 * 512;
#pragma unroll
                for (int ai = 0; ai < 2; ++ai)
#pragma unroll
                    for (int m = 0; m < 4; ++m) { const f32x4 a = acc[ai][bj][m][0], b = acc[ai][bj][m][1]; f32x4 la, lb_, ka, kb;
#pragma unroll
                        for (int i = 0; i < 4; ++i) {
                            const float sa = e_sig(a[i]), sb = e_sig(b[i]);
                            la[i] = __logf(fmaxf(lb0[i] + (1.0f - lb0[i]) * sa, 1e-6f)); ka[i] = (1.0f - lb0[i]) * (1.0f - sa);
                            lb_[i] = __logf(fmaxf(lb1[i] + (1.0f - lb1[i]) * sb, 1e-6f)); kb[i] = (1.0f - lb1[i]) * (1.0f - sb); }
                        const size_t o = (size_t)(row0 + ai * HALF + m * 16) * 512 + c0;
                        *(f32x4*)(lf + o) = la; *(f32x4*)(lf + o + 4) = lb_;
                        *(u32x4*)(dst + o) = pack8(ka, kb); }
            }
        }
    }
};
struct EpiBrA {
    static constexpr bool PERM = true, AFTER_DRAIN = false;
    const bf16_t* GG; float* MP;
    __device__ __forceinline__ void operator()(const f32x4 (&acc)[2][2][4][2], const Unit& u, int wr, int wc, int fr, int fq) const {
        const int row0 = u.pm * BM + wr * 64 + fr, col0 = u.pn * BM + wc * 32 + 8 * fq;
#pragma unroll
        for (int ai = 0; ai < 2; ++ai)
#pragma unroll
            for (int m = 0; m < 4; ++m) { const size_t r = (size_t)(row0 + ai * HALF + m * 16);
#pragma unroll
                for (int bj = 0; bj < 2; ++bj) { const int c = col0 + bj * HALF; const u32x4 g = *(const u32x4*)(GG + r * 2048 + c);
                    f32x4 a = acc[ai][bj][m][0], b = acc[ai][bj][m][1];
                    a[0] *= e_bflo(g.x); a[1] *= e_bfhi(g.x); a[2] *= e_bflo(g.y); a[3] *= e_bfhi(g.y); b[0] *= e_bflo(g.z); b[1] *= e_bfhi(g.z); b[2] *= e_bflo(g.w); b[3] *= e_bfhi(g.w);
                    *(f32x4*)(MP + r * 1024 + c) = a; *(f32x4*)(MP + r * 1024 + c + 4) = b; } }
    }
};
struct EpiBrH {
    static constexpr bool PERM = true, AFTER_DRAIN = false;
    const bf16_t* GG; const float* MP; bf16_t* MG;
    __device__ __forceinline__ void operator()(const f32x4 (&acc)[2][2][4][2], const Unit& u, int wr, int wc, int fr, int fq) const {
        const int row0 = u.pm * BM + wr * 64 + fr, col0 = u.pn * BM + wc * 32 + 8 * fq;
#pragma unroll
        for (int ai = 0; ai < 2; ++ai)
#pragma unroll
            for (int m = 0; m < 4; ++m) { const size_t r = (size_t)(row0 + ai * HALF + m * 16);
#pragma unroll
                for (int bj = 0; bj < 2; ++bj) { const int c = col0 + bj * HALF; const u32x4 g = *(const u32x4*)(GG + r * 2048 + 1024 + c);
                    f32x4 a = acc[ai][bj][m][0], b = acc[ai][bj][m][1]; const f32x4 pa = *(const f32x4*)(MP + r * 1024 + c), pb = *(const f32x4*)(MP + r * 1024 + c + 4);
                    a[0] = pa[0] + a[0] * e_bflo(g.x); a[1] = pa[1] + a[1] * e_bfhi(g.x); a[2] = pa[2] + a[2] * e_bflo(g.y); a[3] = pa[3] + a[3] * e_bfhi(g.y);
                    b[0] = pb[0] + b[0] * e_bflo(g.z); b[1] = pb[1] + b[1] * e_bfhi(g.z); b[2] = pb[2] + b[2] * e_bflo(g.w); b[3] = pb[3] + b[3] * e_bfhi(g.w);
                    *(u32x4*)(MG + r * 1024 + c) = pack8(a, b); } }
    }
};
struct EpiOut {
    static constexpr bool PERM = true, AFTER_DRAIN = false;
    const float* xin; const float* gate; float* X1;
    __device__ __forceinline__ void operator()(const f32x4 (&acc)[2][2][4][2], const Unit& u, int wr, int wc, int fr, int fq) const {
        const int row0 = u.pm * BM + wr * 64 + fr, col0 = u.pn * BM + wc * 32 + 8 * fq;
#pragma unroll
        for (int bj = 0; bj < 2; ++bj) { const int c = col0 + bj * HALF; const f32x4 g0 = *(const f32x4*)(gate + c), g1 = *(const f32x4*)(gate + c + 4);
#pragma unroll
            for (int ai = 0; ai < 2; ++ai)
#pragma unroll
                for (int m = 0; m < 4; ++m) { const size_t o = (size_t)(row0 + ai * HALF + m * 16) * 1024 + c;
                    *(f32x4*)(X1 + o) = *(const f32x4*)(xin + o) + g0 * acc[ai][bj][m][0]; *(f32x4*)(X1 + o + 4) = *(const f32x4*)(xin + o + 4) + g1 * acc[ai][bj][m][1]; } }
    }
};
struct EpiGU {
    static constexpr bool PERM = true, AFTER_DRAIN = false;
    bf16_t* HID;
    __device__ __forceinline__ void operator()(const f32x4 (&acc)[2][2][4][2], const Unit& u, int wr, int wc, int fr, int fq) const {
        const int row0 = u.pm * BM + wr * 64 + fr, col0 = u.pn * HALF + wc * 32 + 8 * fq;
#pragma unroll
        for (int ai = 0; ai < 2; ++ai)
#pragma unroll
            for (int m = 0; m < 4; ++m) { f32x4 a = acc[ai][0][m][0], b = acc[ai][0][m][1]; const f32x4 ua = acc[ai][1][m][0], ub = acc[ai][1][m][1];
#pragma unroll
                for (int i = 0; i < 4; ++i) { a[i] = a[i] * e_sig(a[i]) * ua[i]; b[i] = b[i] * e_sig(b[i]) * ub[i]; }
                *(u32x4*)(HID + (size_t)(row0 + ai * HALF + m * 16) * 2048 + col0) = pack8(a, b); }
    }
};
struct EpiGU8 {
    static constexpr bool PERM = true, AFTER_DRAIN = false;
    unsigned char* HID;
    __device__ __forceinline__ void operator()(const f32x4 (&acc)[2][2][4][2], const Unit& u, int wr, int wc, int fr, int fq) const {
        const int row0 = u.pm * BM + wr * 64 + fr, col0 = u.pn * HALF + wc * 32 + 8 * fq;
#pragma unroll
        for (int ai = 0; ai < 2; ++ai)
#pragma unroll
            for (int m = 0; m < 4; ++m) { f32x4 a = acc[ai][0][m][0], b = acc[ai][0][m][1]; const f32x4 ua = acc[ai][1][m][0], ub = acc[ai][1][m][1];
#pragma unroll
                for (int i = 0; i < 4; ++i) { const float ga = a[i] * 0.015625f, gb = b[i] * 0.015625f; a[i] = ga * e_sig(ga) * (ua[i] * 0.015625f); b[i] = gb * e_sig(gb) * (ub[i] * 0.015625f); }
                *(u32x2*)(HID + (size_t)(row0 + ai * HALF + m * 16) * 2048 + col0) = pack8_fp8(a, b); }
    }
};
struct EpiDown {
    static constexpr bool PERM = true, AFTER_DRAIN = false;
    bf16_t* YE; const float* topw; float wscale;
    __device__ __forceinline__ void operator()(const f32x4 (&acc)[2][2][4][2], const Unit& u, int wr, int wc, int fr, int fq) const {
        const int row0 = u.pm * BM + wr * 64 + fr, col0 = u.pn * BM + wc * 32 + 8 * fq;
#pragma unroll
        for (int ai = 0; ai < 2; ++ai)
#pragma unroll
            for (int m = 0; m < 4; ++m) { const int r = row0 + ai * HALF + m * 16; const float w = topw[r] * wscale;
#pragma unroll
                for (int bj = 0; bj < 2; ++bj) *(u32x4*)(YE + (size_t)r * 1024 + col0 + bj * HALF) = pack8(acc[ai][bj][m][0] * w, acc[ai][bj][m][1] * w); }
    }
};
struct GroupOrder {
    int nNe, nwg, G, c;
    __device__ void init(int nNe_, int G_, int c_) { nNe = nNe_; nwg = 16 * 8 * nNe_; G = G_; c = c_; }
    __device__ bool next(int i, Unit& u) const {
        const long L = (long)i * G + c; if (L >= nwg) return false;
        int wgid = (int)L; { const int q = nwg / NXCD, xcd = wgid % NXCD, off = wgid / NXCD; wgid = xcd * q + off; }
        const int per = 8 * nNe, e = wgid / per, w = wgid % per;
        u.pm = e * 8 + (w & 7); u.pn = w >> 3; u.pb = e * nNe + u.pn; return true;
    }
    __device__ __forceinline__ void a_ready(const Unit&) const {}
    __device__ __forceinline__ void done(const Unit&) const {}
};

template <class Epi, class Sched, bool ALIGN_EPI = false, bool SP2 = false, bool FP8 = false>
__device__ __forceinline__ void gemm_phase(PG8_LAS unsigned char* lds, const Gemm g, const Sched& S, const Epi& E, int wave_) {
    const int tid_ = wave_ * 64 + lane_id_opaque();
    const int tid = tid_, wid = __builtin_amdgcn_readfirstlane(tid >> 6), lane = tid & 63, wr = wid >> 2, wc = wid & 3, fr = lane & 15, fq = lane >> 4;
    int K_ = g.K; asm volatile("" : "+s"(K_));
    const int K = K_, nt = K / BK;
    unsigned voffA[2], voffB[2];
#pragma unroll
    for (int i = 0; i < 2; ++i) { int R, C; stage_rc(tid * 16 + i * 8192, R, C); const int Rb = Epi::PERM ? ((R & ~31) + perm32(R & 31)) : R;
        voffA[i] = (unsigned)(R * K + C) * 2u; voffB[i] = (unsigned)(Rb * K + C) * 2u; }
    const size_t kstep = (size_t)(BK * 2);
    const size_t hstep = (size_t)HALF * K * 2;
    const size_t tstep = 2 * hstep;
    const unsigned ldsw = (unsigned)wid * 1024u;
    const int aoff = lds_byte(wr * 64 + fr, fq * 8), boff = lds_byte(wc * 32 + fr, fq * 8);
#define PG8_SA(b, h) (((b) * 2 + (h)) * HTB)
#define PG8_SB(b, h) ((4 + (b) * 2 + (h)) * HTB)
#define PG8_STAGE(bufoff, gbase, voff) do { _Pragma("unroll") for (int _i = 0; _i < 2; ++_i) \
        __builtin_amdgcn_global_load_lds((const unsigned*)((const char*)(gbase) + (voff)[_i]), (PG8_LAS unsigned*)(lds + (bufoff) + ldsw + _i * 8192), 16, 0, 0); } while (0)
#define PG8_LDA(dst, b, h) do { if constexpr (FP8) { _Pragma("unroll") for (int m = 0; m < 4; ++m) dst##8[m] = pg8_cat(*(const PG8_LAS bf16x8*)(lds + PG8_SA(b, h) + aoff + m * 2048), *(const PG8_LAS bf16x8*)(lds + PG8_SA(b, h) + aoff + m * 2048 + 1024)); } else { \
        _Pragma("unroll") for (int m = 0; m < 4; ++m) _Pragma("unroll") for (int k = 0; k < 2; ++k) dst[m][k] = *(const PG8_LAS bf16x8*)(lds + PG8_SA(b, h) + aoff + m * 2048 + k * 1024); } } while (0)
#define PG8_LDB(dst, b, h) do { if constexpr (FP8) { _Pragma("unroll") for (int n = 0; n < 2; ++n) dst##8[n] = pg8_cat(*(const PG8_LAS bf16x8*)(lds + PG8_SB(b, h) + boff + n * 2048), *(const PG8_LAS bf16x8*)(lds + PG8_SB(b, h) + boff + n * 2048 + 1024)); } else { \
        _Pragma("unroll") for (int n = 0; n < 2; ++n) _Pragma("unroll") for (int k = 0; k < 2; ++k) dst[n][k] = *(const PG8_LAS bf16x8*)(lds + PG8_SB(b, h) + boff + n * 2048 + k * 1024); } } while (0)
#define PG8_MMA(ai, bj, At, Bt) do { __builtin_amdgcn_s_setprio(1); if constexpr (FP8) { \
        _Pragma("unroll") for (int m = 0; m < 4; ++m) _Pragma("unroll") for (int n = 0; n < 2; ++n) \
        asm volatile("v_mfma_f32_16x16x128_f8f6f4 %0, %1, %2, %0" : "+v"(acc[ai][bj][m][n]) : "v"(Bt##8[n]), "v"(At##8[m])); } else {     \
        _Pragma("unroll") for (int m = 0; m < 4; ++m) _Pragma("unroll") for (int n = 0; n < 2; ++n) _Pragma("unroll") for (int k = 0; k < 2; ++k) \
        acc[ai][bj][m][n] = __builtin_amdgcn_mfma_f32_16x16x32_bf16(Bt[n][k], At[m][k], acc[ai][bj][m][n], 0, 0, 0); } __builtin_amdgcn_s_setprio(0); } while (0)
#define PG8_WAIT_V(n) asm volatile("s_waitcnt vmcnt(" #n ")" ::: "memory")
#define PG8_WAIT_L(n) asm volatile("s_waitcnt lgkmcnt(" #n ")" ::: "memory")
#define PG8_BAR __builtin_amdgcn_s_barrier()
#define PG8_SCHED __builtin_amdgcn_sched_barrier(0)
    Unit cur, nxt; int ui = 0;
    if (!S.next(0, cur)) return;
    f32x4 acc[2][2][4][2];
#pragma unroll
    for (int a = 0; a < 2; ++a)
#pragma unroll
        for (int b = 0; b < 2; ++b)
#pragma unroll
            for (int m = 0; m < 4; ++m)
#pragma unroll
                for (int n = 0; n < 2; ++n) acc[a][b][m][n] = (f32x4){0.f, 0.f, 0.f, 0.f};
    bf16x8 At[4][2], B0[2][2], B1[2][2]; i32x8_ At8[4], B08[2], B18[2];
    const char* cA = (const char*)g.A + (size_t)cur.pm * tstep; const char* cB = (const char*)g.Bt + (size_t)cur.pb * tstep;
    S.a_ready(cur);
    if constexpr (SP2) {
        PG8_STAGE(PG8_SB(0, 0), cB, voffB); PG8_STAGE(PG8_SB(0, 1), cB + hstep, voffB); PG8_STAGE(PG8_SA(0, 0), cA, voffA); PG8_STAGE(PG8_SA(0, 1), cA + hstep, voffA);
        if (wr == 1) PG8_BAR;
        PG8_WAIT_V(2); PG8_BAR;
        PG8_STAGE(PG8_SB(1, 0), cB + kstep, voffB); PG8_STAGE(PG8_SA(1, 0), cA + kstep, voffA); PG8_STAGE(PG8_SB(1, 1), cB + hstep + kstep, voffB);
        PG8_WAIT_V(6); PG8_BAR;
    } else {
        PG8_STAGE(PG8_SB(0, 0), cB, voffB); PG8_STAGE(PG8_SA(0, 0), cA, voffA); PG8_STAGE(PG8_SB(0, 1), cB + hstep, voffB); PG8_STAGE(PG8_SA(0, 1), cA + hstep, voffA);
        if (wr == 1) PG8_BAR;
        PG8_WAIT_V(4); PG8_BAR;
        PG8_STAGE(PG8_SB(1, 0), cB + kstep, voffB); PG8_STAGE(PG8_SA(1, 0), cA + kstep, voffA); PG8_STAGE(PG8_SB(1, 1), cB + hstep + kstep, voffB);
        PG8_WAIT_V(6); PG8_BAR;
    }
    for (;;) {
        const bool has_next = S.next(ui + 1, nxt);
        const char* nA = has_next ? (const char*)g.A + (size_t)nxt.pm * tstep : cA; const char* nB = has_next ? (const char*)g.Bt + (size_t)nxt.pb * tstep : cB;
#pragma unroll 1
        for (int t = 0; t < nt; t += 2) {
            const bool last = (t == nt - 2);
            const char* a1 = cA + (size_t)(t + 1) * kstep;
            const char* a2 = last ? nA : cA + (size_t)(t + 2) * kstep; const char* b2 = last ? nB : cB + (size_t)(t + 2) * kstep;
            const char* a3 = a2 + kstep; const char* b3 = b2 + kstep;
            if (last && has_next) S.a_ready(nxt);
            if constexpr (SP2) {
            PG8_LDB(B0, 0, 0); PG8_LDB(B1, 0, 1); PG8_SCHED; PG8_LDA(At, 0, 0); PG8_STAGE(PG8_SA(1, 1), a1 + hstep, voffA);
            PG8_WAIT_V(8); PG8_WAIT_L(0); PG8_BAR; PG8_MMA(0, 0, At, B0); PG8_MMA(0, 1, At, B1); PG8_BAR; PG8_SCHED;
            PG8_LDA(At, 0, 1); PG8_STAGE(PG8_SB(0, 0), b2, voffB); PG8_STAGE(PG8_SB(0, 1), b2 + hstep, voffB); PG8_STAGE(PG8_SA(0, 0), a2, voffA);
            PG8_WAIT_V(8); PG8_WAIT_L(0); PG8_BAR; PG8_MMA(1, 0, At, B0); PG8_MMA(1, 1, At, B1); PG8_BAR; PG8_SCHED;
            PG8_LDB(B0, 1, 0); PG8_LDB(B1, 1, 1); PG8_SCHED; PG8_LDA(At, 1, 0); PG8_STAGE(PG8_SA(0, 1), a2 + hstep, voffA);
            PG8_WAIT_V(8); PG8_WAIT_L(0); PG8_BAR; PG8_MMA(0, 0, At, B0); PG8_MMA(0, 1, At, B1); PG8_BAR; PG8_SCHED;
            PG8_LDA(At, 1, 1); PG8_STAGE(PG8_SB(1, 0), b3, voffB); PG8_STAGE(PG8_SB(1, 1), b3 + hstep, voffB); PG8_STAGE(PG8_SA(1, 0), a3, voffA);
            PG8_WAIT_V(8); PG8_WAIT_L(0); PG8_BAR; PG8_MMA(1, 0, At, B0); PG8_MMA(1, 1, At, B1); PG8_BAR; PG8_SCHED;
            } else {
            PG8_LDB(B0, 0, 0); PG8_SCHED; PG8_LDA(At, 0, 0); PG8_STAGE(PG8_SA(1, 1), a1 + hstep, voffA);
            PG8_WAIT_L(8); PG8_BAR; PG8_WAIT_L(0); PG8_MMA(0, 0, At, B0); PG8_BAR; PG8_SCHED;
            PG8_LDB(B1, 0, 1); PG8_STAGE(PG8_SB(0, 0), b2, voffB);
            PG8_BAR; PG8_WAIT_L(0); PG8_MMA(0, 1, At, B1); PG8_BAR;
            PG8_LDA(At, 0, 1); PG8_STAGE(PG8_SA(0, 0), a2, voffA);
            PG8_BAR; PG8_WAIT_L(0); PG8_MMA(1, 0, At, B0); PG8_BAR; PG8_SCHED;
            PG8_STAGE(PG8_SB(0, 1), b2 + hstep, voffB);
            PG8_WAIT_V(6); PG8_BAR; PG8_MMA(1, 1, At, B1); PG8_BAR;
            PG8_LDB(B0, 1, 0); PG8_SCHED; PG8_LDA(At, 1, 0); PG8_STAGE(PG8_SA(0, 1), a2 + hstep, voffA);
            PG8_WAIT_L(8); PG8_BAR; PG8_WAIT_L(0); PG8_MMA(0, 0, At, B0); PG8_BAR; PG8_SCHED;
            PG8_LDB(B1, 1, 1); PG8_STAGE(PG8_SB(1, 0), b3, voffB);
            PG8_BAR; PG8_WAIT_L(0); PG8_MMA(0, 1, At, B1); PG8_BAR;
            PG8_LDA(At, 1, 1); PG8_STAGE(PG8_SA(1, 0), a3, voffA);
            PG8_BAR; PG8_WAIT_L(0); PG8_MMA(1, 0, At, B0); PG8_BAR; PG8_SCHED;
            PG8_STAGE(PG8_SB(1, 1), b3 + hstep, voffB);
            PG8_WAIT_V(6); PG8_BAR; PG8_MMA(1, 1, At, B1); PG8_BAR;
            }
        }
        if constexpr (FP8) asm volatile("s_nop 15\n\ts_nop 7" ::: "memory");
        if constexpr (ALIGN_EPI) { if (wr == 0) PG8_BAR; }
        if constexpr (!Epi::AFTER_DRAIN) { E(acc, cur, wr, wc, fr, fq); S.done(cur); }
        if (!has_next) break;
#pragma unroll
        for (int a = 0; a < 2; ++a)
#pragma unroll
            for (int b = 0; b < 2; ++b)
#pragma unroll
                for (int m = 0; m < 4; ++m)
#pragma unroll
                    for (int n = 0; n < 2; ++n) acc[a][b][m][n] = (f32x4){0.f, 0.f, 0.f, 0.f};
        cur = nxt; cA = nA; cB = nB; ++ui;
        if constexpr (ALIGN_EPI) { if (wr == 1) PG8_BAR; }
    }
    PG8_WAIT_V(0);
    if constexpr (!ALIGN_EPI) { if (wr == 0) PG8_BAR; }
    PG8_BAR;
    if constexpr (Epi::AFTER_DRAIN) { E.fused(acc, cur, wr, wc, fr, fq, lds, wid, lane); S.done(cur); }
#undef PG8_SA
#undef PG8_SB
#undef PG8_STAGE
#undef PG8_LDA
#undef PG8_LDB
#undef PG8_MMA
#undef PG8_WAIT_V
#undef PG8_WAIT_L
#undef PG8_BAR
#undef PG8_SCHED
}
}

#include <hip/hip_bf16.h>
#include <cmath>

namespace attn_body {
using bf16=__hip_bfloat16;
using bf16x8=__attribute__((ext_vector_type(8)))short;
using s16x4=__attribute__((ext_vector_type(4)))short;
using f32x16=__attribute__((ext_vector_type(16)))float;
using u32x4=__attribute__((ext_vector_type(4)))unsigned;
constexpr int NHEAD=8,SEQ=16384,D=64,DMQ=NHEAD*D,DMK=2*D;
constexpr int NW=8,QBLK=32,QB=QBLK*NW,KVBLK=64,NQB=SEQ/QB;
constexpr int ATTN_UNIT_ROWS=QB;
__device__ __forceinline__ int crow(int r,int hi){return (r&3)+8*(r>>2)+4*hi;}
#define SBAR() __builtin_amdgcn_sched_barrier(0)
__device__ __forceinline__ void cmask(f32x16&p0,f32x16&p1,int jb,int qrel,int hi){
  const float NEG=-INFINITY; int kb=64*jb+4*hi;
  #pragma unroll
  for(int r=0;r<16;++r){int kv=kb+(r&3)+8*(r>>2); if(kv>qrel)p0[r]=NEG; if(kv+32>qrel)p1[r]=NEG;}
}

constexpr int NSLOT=3, SLOTB=8192;
constexpr int LDS_K=0, LDS_V=NSLOT*SLOTB, LDS_WS=2*NSLOT*SLOTB, LDS_OST=LDS_WS+NW*64*4, LDS_BYTES=LDS_OST+NW*4096;
constexpr float C2=0.125f*1.4426950408889634f;
__device__ __forceinline__ void glds16(const void*gsrc,unsigned lds_dst){unsigned keep;
  asm volatile("s_mov_b32 %0, m0\n\ts_mov_b32 m0, %2\n\ts_nop 0\n\tglobal_load_lds_dwordx4 %1, off\n\ts_mov_b32 m0, %0":"=&s"(keep):"v"(gsrc),"s"(lds_dst):"memory");}
__device__ __forceinline__ float max3f(float a,float b,float c){float r;asm("v_max3_f32 %0, %1, %2, %3":"=v"(r):"v"(a),"v"(b),"v"(c));return r;}
__device__ __forceinline__ float max2f(float a,float b){float r;asm("v_max_f32_e32 %0, %1, %2":"=v"(r):"v"(a),"v"(b));return r;}
__device__ __forceinline__ float fadd_s(float a,float b){float r;asm("v_add_f32_e32 %0, %1, %2":"=v"(r):"v"(a),"v"(b));return r;}
__device__ __forceinline__ float fsub_s(float a,float b){float r;asm("v_sub_f32_e32 %0, %1, %2":"=v"(r):"v"(a),"v"(b));return r;}
typedef float f32x2_t __attribute__((ext_vector_type(2))); typedef __bf16 bf16x2_t __attribute__((ext_vector_type(2)));
__device__ __forceinline__ unsigned cvtpk_s(float lo,float hi){f32x2_t v={lo,hi};bf16x2_t b=__builtin_convertvector(v,bf16x2_t);return __builtin_bit_cast(unsigned,b);}
#define WAIT_BAR(N) asm volatile("s_waitcnt vmcnt(" #N ") lgkmcnt(0)\n\ts_barrier":::"memory")

__device__ __forceinline__ void qkt(f32x16&p0,f32x16&p1,const char*Kslot,const bf16x8*qr,const f32x16&negm,int r32,int hi){
  const char*kb=Kslot+hi*1024+r32*16;
  #pragma unroll
  for(int d0=0;d0<4;++d0){
    const bf16x8 b0=*reinterpret_cast<const bf16x8*>(kb+d0*2048);
    const bf16x8 b1=*reinterpret_cast<const bf16x8*>(kb+d0*2048+512);
    if(d0==0){p0=__builtin_amdgcn_mfma_f32_32x32x16_bf16(b0,qr[0],negm,0,0,0);p1=__builtin_amdgcn_mfma_f32_32x32x16_bf16(b1,qr[0],negm,0,0,0);}
    else{p0=__builtin_amdgcn_mfma_f32_32x32x16_bf16(b0,qr[d0],p0,0,0,0);p1=__builtin_amdgcn_mfma_f32_32x32x16_bf16(b1,qr[d0],p1,0,0,0);}}
}
typedef __attribute__((address_space(3))) const char* lds_cptr;
typedef short v4i16_t __attribute__((ext_vector_type(4)));
__device__ __forceinline__ void kload8(bf16x8*kf,lds_cptr kp){
  kf[0]=*(const __attribute__((address_space(3))) bf16x8*)(kp);      kf[1]=*(const __attribute__((address_space(3))) bf16x8*)(kp+512);
  kf[2]=*(const __attribute__((address_space(3))) bf16x8*)(kp+2048); kf[3]=*(const __attribute__((address_space(3))) bf16x8*)(kp+2560);
  kf[4]=*(const __attribute__((address_space(3))) bf16x8*)(kp+4096); kf[5]=*(const __attribute__((address_space(3))) bf16x8*)(kp+4608);
  kf[6]=*(const __attribute__((address_space(3))) bf16x8*)(kp+6144); kf[7]=*(const __attribute__((address_space(3))) bf16x8*)(kp+6656);
}
__device__ __forceinline__ void kload2(bf16x8*kf,lds_cptr kp,int j){ kf[2*j]=*(const __attribute__((address_space(3))) bf16x8*)(kp+j*2048); kf[2*j+1]=*(const __attribute__((address_space(3))) bf16x8*)(kp+j*2048+512); }
__device__ __forceinline__ s16x4 vtr(lds_cptr p){ return __builtin_bit_cast(s16x4,__builtin_amdgcn_ds_read_tr16_b64_v4i16((__attribute__((address_space(3))) v4i16_t*)p)); }
__device__ __forceinline__ float rowmax(const f32x16&p0,const f32x16&p1){
  float a=max3f(p0[0],p0[1],p1[0]),b=max3f(p0[2],p0[3],p1[1]);a=max3f(a,p1[2],p1[3]);
  #pragma unroll
  for(int r=4;r<16;r+=4){a=max3f(a,p0[r],p0[r+1]);b=max3f(b,p0[r+2],p0[r+3]);a=max3f(a,p1[r],p1[r+1]);b=max3f(b,p1[r+2],p1[r+3]);}
  const float m=max2f(a,b);
  auto rr=__builtin_amdgcn_permlane32_swap(__float_as_uint(m),__float_as_uint(m),false,false);
  return max2f(__uint_as_float(rr[0]),__uint_as_float(rr[1]));
}
__device__ __forceinline__ void pv(f32x16*o,int vb,bf16x8 pa0,bf16x8 pa1,bf16x8 pa2,bf16x8 pa3){
  #pragma unroll
  for(int d0=0;d0<2;++d0){s16x4 lo[4],hi[4];
    #pragma unroll
    for(int ks=0;ks<4;++ks){
      asm volatile("ds_read_b64_tr_b16 %0,%1 offset:%c2":"=&v"(lo[ks]):"v"(vb),"i"(d0*4096+ks*1024):"memory");
      asm volatile("ds_read_b64_tr_b16 %0,%1 offset:%c2":"=&v"(hi[ks]):"v"(vb),"i"(d0*4096+ks*1024+512):"memory");}
    asm volatile("s_waitcnt lgkmcnt(0)":::"memory");SBAR();
    #define PK(k) (bf16x8){lo[k][0],lo[k][1],lo[k][2],lo[k][3],hi[k][0],hi[k][1],hi[k][2],hi[k][3]}
    o[d0]=__builtin_amdgcn_mfma_f32_32x32x16_bf16(pa0,PK(0),o[d0],0,0,0);
    o[d0]=__builtin_amdgcn_mfma_f32_32x32x16_bf16(pa1,PK(1),o[d0],0,0,0);
    o[d0]=__builtin_amdgcn_mfma_f32_32x32x16_bf16(pa2,PK(2),o[d0],0,0,0);
    o[d0]=__builtin_amdgcn_mfma_f32_32x32x16_bf16(pa3,PK(3),o[d0],0,0,0);
    #undef PK
  }
}

#ifndef ATTN_STORE16
#define ATTN_STORE16(p,v) (*(u32x4*)(p)=(v))
#endif
template<int THRL> __device__ __forceinline__ void attn_unit(int b,int h,int qb,const bf16*Q,const bf16*__restrict__ K,const bf16*__restrict__ V,bf16*O,char*shm,int wave_,float negM){
  const int tid_=wave_*64+lane_id_opaque();
  const int tid=tid_,lane=tid&63,r32=lane&31,hi=lane>>5; const int wid=__builtin_amdgcn_readfirstlane(tid>>6);
  const long rowbase=0; const int q0=qb*QB; (void)b;
  const bf16*Qw=Q+(rowbase+q0+wid*QBLK)*DMQ+h*D;
  const bf16*Kh=K+(h>>2)*D,*Vh=V+(h>>2)*D;
  const unsigned lds0=(unsigned)(uintptr_t)shm;
  float*wsf=(float*)(shm+LDS_WS)+wid*64;
  const bf16*ksrc=Kh+(long)lane*DMK+wid*8;
  const bf16*vsrc=Vh+(long)(16*(wid&3)+(lane>>2))*DMK+(wid>>2)*32+(lane&3)*8;
  const unsigned kdst=lds0+LDS_K+wid*1024, vdst=lds0+LDS_V+wid*1024;
  #define DMA_K(t,slot) glds16(ksrc+(long)(t)*KVBLK*DMK,(unsigned)__builtin_amdgcn_readfirstlane(kdst+(slot)))
  #define DMA_V(t,slot) glds16(vsrc+(long)(t)*KVBLK*DMK,(unsigned)__builtin_amdgcn_readfirstlane(vdst+(slot)))
  const int vb0=(int)(lds0+LDS_V)+((lane>>4)&1)*32+(lane&3)*8+(4*hi+((lane&15)>>2))*64;
  const char*Kbase=shm+LDS_K; bf16x8 kf[8];
  const lds_cptr shm3=(lds_cptr)shm; const lds_cptr kp0=shm3+LDS_K+hi*1024+r32*16; const lds_cptr vp0=shm3+LDS_V+((lane>>4)&1)*32+(lane&3)*8+(4*hi+((lane&15)>>2))*64;
  const int NT=SEQ/KVBLK;
  DMA_K(0,0);DMA_V(0,0);DMA_K(1,SLOTB);
  bf16x8 qr[4];
  #pragma unroll
  for(int d0=0;d0<4;++d0)qr[d0]=*reinterpret_cast<const bf16x8*>(&Qw[(long)r32*DMQ+d0*16+hi*8]);
  float l_reg=0.f;f32x16 o[2];o[0]=f32x16{};o[1]=f32x16{};f32x16 negm;
  #pragma unroll
  for(int r=0;r<16;++r)negm[r]=negM;
  asm volatile("":"+v"(negm));
  const int qrel=wid*QBLK+r32; (void)qrel;
  #define CMASK(P0,P1,t) do{}while(0)
  #define START(P0,P1) do{ _Pragma("unroll") for(int r=0;r<16;++r)P0[r]=__builtin_amdgcn_exp2f(P0[r]); }while(0)
  #define RESC() do{}while(0)
  f32x16 pA0,pA1,pB0,pB1;
  int sl_prev=0,sl_cur=0,sl_next=SLOTB;
  #define ROT() do{sl_prev=sl_cur;sl_cur=sl_next;sl_next=(sl_next==(NSLOT-1)*SLOTB)?0:sl_next+SLOTB;}while(0)
  DMA_K(2,2*SLOTB);
  WAIT_BAR(3);
  qkt(pA0,pA1,Kbase,qr,negm,r32,hi);asm volatile("s_nop 15\n\ts_nop 7":"+v"(pA0),"+v"(pA1));CMASK(pA0,pA1,0);
  START(pA0,pA1);
  _Pragma("unroll") for(int r=0;r<16;++r)pA1[r]=__builtin_amdgcn_exp2f(pA1[r]);
  WAIT_BAR(0);
  DMA_K(3,0);DMA_V(1,SLOTB);
  ROT();
  kload8(kf,kp0+sl_cur);
  WAIT_BAR(2);
  s16x4 vlo[8],vhi[8]; u32x4 pw0,pw1,pw2,pw3;
  #define PKW(P,B) cvtpk_s(P[B],P[B+1])
  #define PAF(k) __builtin_bit_cast(bf16x8,pw##k)
  #define VFR(i) (bf16x8){vlo[i][0],vlo[i][1],vlo[i][2],vlo[i][3],vhi[i][0],vhi[i][1],vhi[i][2],vhi[i][3]}
  #define PIN(x) asm volatile("":"+v"(x))
  #define MX3(a,b,c) __builtin_fmaxf(__builtin_fmaxf((a),(b)),(c))
  #define GAPA(MF,A0,A1,A2,A3,W0,W1,PW) do{ MF; sacc+=A0; sacc+=A1; sacc+=A2; sacc+=A3; PIN(sacc); W0; W1; PIN(PW); SBAR(); }while(0)
  #define EX(v) __builtin_amdgcn_exp2f(v)
  #define GAPB(MF,X,B) do{ MF; X[B]=EX(X[B]); X[B+1]=EX(X[B+1]); X[B+2]=EX(X[B+2]); X[B+3]=EX(X[B+3]); PIN(X); SBAR(); }while(0)
  #define VRD(i) do{ vlo[i]=vtr(vp_+(((i)>>2)*4096+((i)&3)*1024)); vhi[i]=vtr(vp_+(((i)>>2)*4096+((i)&3)*1024+512)); }while(0)
  #define KRD(G,j) do{ if(G){ kload2(kf,kp0+sl_next,j); SBAR(); } }while(0)
  #define STEP(C0,C1,P0,P1,t,GK,GV,GL) do{ SBAR(); \
    const lds_cptr vp_=vp0+sl_prev; \
    VRD(0); SBAR(); float sacc=(P0[0]+P0[1]); \
    GAPA(C0=__builtin_amdgcn_mfma_f32_32x32x16_bf16(kf[0],qr[0],negm,0,0,0), P0[2],P0[3],P0[4],P0[5],     pw0[0]=PKW(P0,0), pw0[1]=PKW(P0,2), pw0); \
    VRD(4); SBAR(); GAPA(C1=__builtin_amdgcn_mfma_f32_32x32x16_bf16(kf[1],qr[0],negm,0,0,0), P0[6],P0[7],P0[8],P0[9],     pw0[2]=PKW(P0,4), pw0[3]=PKW(P0,6), pw0); \
    VRD(1); SBAR(); GAPA(C0=__builtin_amdgcn_mfma_f32_32x32x16_bf16(kf[2],qr[1],C0,0,0,0),   P0[10],P0[11],P0[12],P0[13], pw1[0]=PKW(P0,8), pw1[1]=PKW(P0,10), pw1); \
    VRD(5); SBAR(); GAPA(C1=__builtin_amdgcn_mfma_f32_32x32x16_bf16(kf[3],qr[1],C1,0,0,0),   P0[14],P0[15],P1[0],P1[1],   pw1[2]=PKW(P0,12),pw1[3]=PKW(P0,14), pw1); \
    VRD(2); SBAR(); GAPA(C0=__builtin_amdgcn_mfma_f32_32x32x16_bf16(kf[4],qr[2],C0,0,0,0),   P1[2],P1[3],P1[4],P1[5],     pw2[0]=PKW(P1,0), pw2[1]=PKW(P1,2), pw2); \
    VRD(6); SBAR(); GAPA(C1=__builtin_amdgcn_mfma_f32_32x32x16_bf16(kf[5],qr[2],C1,0,0,0),   P1[6],P1[7],P1[8],P1[9],     pw2[2]=PKW(P1,4), pw2[3]=PKW(P1,6), pw2); \
    VRD(3); SBAR(); GAPA(C0=__builtin_amdgcn_mfma_f32_32x32x16_bf16(kf[6],qr[3],C0,0,0,0),   P1[10],P1[11],P1[12],P1[13], pw3[0]=PKW(P1,8), pw3[1]=PKW(P1,10), pw3); \
    VRD(7); SBAR(); GAPA(C1=__builtin_amdgcn_mfma_f32_32x32x16_bf16(kf[7],qr[3],C1,0,0,0),   P1[14],P1[15],0.f,0.f,       pw3[2]=PKW(P1,12),pw3[3]=PKW(P1,14), pw3); \
    l_reg+=sacc; \
    if(GK){DMA_K((t)+3,sl_cur);} if(GV){DMA_V((t)+1,sl_next);} \
    CMASK(C0,C1,t); \
    SBAR(); \
    GAPB(o[0]=__builtin_amdgcn_mfma_f32_32x32x16_bf16(PAF(0),VFR(0),o[0],0,0,0), C0,0); \
    GAPB(o[1]=__builtin_amdgcn_mfma_f32_32x32x16_bf16(PAF(0),VFR(4),o[1],0,0,0), C0,4); \
    KRD(GL,0); GAPB(o[0]=__builtin_amdgcn_mfma_f32_32x32x16_bf16(PAF(1),VFR(1),o[0],0,0,0), C0,8); \
    KRD(GL,1); GAPB(o[1]=__builtin_amdgcn_mfma_f32_32x32x16_bf16(PAF(1),VFR(5),o[1],0,0,0), C0,12); \
    KRD(GL,2); GAPB(o[0]=__builtin_amdgcn_mfma_f32_32x32x16_bf16(PAF(2),VFR(2),o[0],0,0,0), C1,0); \
    KRD(GL,3); GAPB(o[1]=__builtin_amdgcn_mfma_f32_32x32x16_bf16(PAF(2),VFR(6),o[1],0,0,0), C1,4); \
    GAPB(o[0]=__builtin_amdgcn_mfma_f32_32x32x16_bf16(PAF(3),VFR(3),o[0],0,0,0), C1,8); \
    GAPB(o[1]=__builtin_amdgcn_mfma_f32_32x32x16_bf16(PAF(3),VFR(7),o[1],0,0,0), C1,12); \
    }while(0)
  int t=1;
  #undef CMASK
  #define CMASK(P0,P1,t) do{}while(0)
  for(;t+5<NT;t+=2){
    STEP(pB0,pB1,pA0,pA1,t,true,true,true);     WAIT_BAR(2); RESC(); ROT();
    STEP(pA0,pA1,pB0,pB1,t+1,true,true,true);   WAIT_BAR(2); RESC(); ROT();
  }
  #undef CMASK
  #define CMASK(P0,P1,t) do{}while(0)
  #define ENDW(tt) do{ if((tt)+3<NT){WAIT_BAR(2);} else if((tt)+2<NT){WAIT_BAR(1);} else {WAIT_BAR(0);} }while(0)
  for(;t+1<NT;t+=2){
    STEP(pB0,pB1,pA0,pA1,t,(t+3<NT),(t+1<NT),(t+1<NT));       ENDW(t);   RESC(); ROT();
    STEP(pA0,pA1,pB0,pB1,t+1,(t+4<NT),(t+2<NT),(t+2<NT));     ENDW(t+1); RESC(); ROT();
  }
  STEP(pB0,pB1,pA0,pA1,NT-1,false,false,false); RESC();
  { float sacc=pB0[0]+pB0[1]; _Pragma("unroll") for(int r=2;r<16;++r)sacc+=pB0[r]; _Pragma("unroll") for(int r=0;r<16;++r)sacc+=pB1[r]; l_reg+=sacc;
    pw0=(u32x4){PKW(pB0,0),PKW(pB0,2),PKW(pB0,4),PKW(pB0,6)};pw1=(u32x4){PKW(pB0,8),PKW(pB0,10),PKW(pB0,12),PKW(pB0,14)};pw2=(u32x4){PKW(pB1,0),PKW(pB1,2),PKW(pB1,4),PKW(pB1,6)};pw3=(u32x4){PKW(pB1,8),PKW(pB1,10),PKW(pB1,12),PKW(pB1,14)};
    SBAR(); pv(o,vb0+sl_cur,PAF(0),PAF(1),PAF(2),PAF(3)); }
  #undef PKW
  #undef PAF
  #undef VFR
  #undef PIN
  #undef MX3
  #undef GAPA
  #undef GAPB
  #undef EX
  #undef VRD
  #undef KRD
  #undef STEP
  #undef ENDW
  {auto rr=__builtin_amdgcn_permlane32_swap(__float_as_uint(l_reg),__float_as_uint(l_reg),false,false);l_reg=__uint_as_float(rr[0])+__uint_as_float(rr[1]);}
  if(hi==0)wsf[32+r32]=l_reg;asm volatile("s_waitcnt lgkmcnt(0)":::"memory");
  float rli[16];
  #pragma unroll
  for(int r=0;r<16;++r)rli[r]=__builtin_amdgcn_rcpf(wsf[32+crow(r,hi)]);
  bf16*Ow=O+(rowbase+q0+wid*QBLK)*DMQ+h*D;
  { bf16*stg=(bf16*)(shm+LDS_OST)+wid*2048;
    #pragma unroll
    for(int r=0;r<16;++r){const int orow=crow(r,hi);
      #pragma unroll
      for(int d0=0;d0<2;++d0)stg[orow*64+d0*32+r32]=__float2bfloat16(o[d0][r]*rli[r]);}
    asm volatile("s_waitcnt lgkmcnt(0)":::"memory");
    #pragma unroll
    for(int i=0;i<4;++i){const int row=i*8+(lane>>3),ch=lane&7; const u32x4 v=*(const u32x4*)(stg+row*64+ch*8); ATTN_STORE16(Ow+(long)row*DMQ+ch*8,v);} }
  asm volatile("s_waitcnt lgkmcnt(0)\n\ts_barrier":::"memory");
  #undef DMA_K
  #undef DMA_V
  #undef CMASK
  #undef START
  #undef RESC
  #undef ROT
}
constexpr int ATTN_LDS_BYTES=LDS_BYTES;
struct AttnTensors { const bf16* Q; const bf16* K; const bf16* V; bf16* O; };
struct AttnUnit { int bh; int qb; };
struct StaticOrder {
  int vcu, G;
  __device__ __forceinline__ explicit StaticOrder(int grid,int block):vcu((grid%8==0)?(block%8)*(grid/8)+block/8:block),G(grid){}
  __device__ __forceinline__ bool next(int i,AttnUnit&u)const{ constexpr int NU=NHEAD*NQB; int uu; if(NU%G==0){ const int per=NU/G; if(i>=per)return false; uu=vcu*per+i; } else { uu=i*G+vcu; if(uu>=NU)return false; } u.bh=uu/NQB; u.qb=uu%NQB; return true; }
  __device__ __forceinline__ void a_ready(const AttnUnit&)const{}
  __device__ __forceinline__ void done(const AttnUnit&)const{}
};
template<class Sched,int THRL=8> __device__ __forceinline__ void attn_phase(char*lds,const AttnTensors&T,const Sched&S,int wave_,float negM){
  AttnUnit u;
  for(int i=0;S.next(i,u);++i){ S.a_ready(u); attn_unit<THRL>(0,u.bh,u.qb,T.Q,T.K,T.V,T.O,lds,wave_,negM); S.done(u); }
}
#undef SBAR
#undef WAIT_BAR
}

namespace hg {
typedef short bf16x8 __attribute__((ext_vector_type(8)));
typedef short s16x4 __attribute__((ext_vector_type(4)));
constexpr int CH = 32, SEGT = 512, NSEG = S / SEGT, NCH = SEGT / CH;
constexpr int RS = 272, TS = 80;
constexpr int QOFF = 0, KOFF = 32 * RS, KTOFF = 2 * 32 * RS, VTOFF = KTOFF + 128 * TS, DOFF = VTOFF + 128 * TS, GOFF = DOFF + 512, BUFB = GOFF + 2048;
static_assert(2 * BUFB <= 131072, "hgrn LDS");
#define HG_MFMA(a, b, c) __builtin_amdgcn_mfma_f32_16x16x32_bf16((a), (b), (c), 0, 0, 0)
__device__ __forceinline__ unsigned pkbf(float lo, float hi) { typedef float f2 __attribute__((ext_vector_type(2))); typedef __bf16 b2 __attribute__((ext_vector_type(2))); f2 v = {lo, hi}; b2 b = __builtin_convertvector(v, b2); return __builtin_bit_cast(unsigned, b); }

template <bool OUT>
__device__ __forceinline__ void segment(LAS unsigned char* lds, int unit, const bf16_t* __restrict__ HQ, const float* __restrict__ LF, const bf16_t* __restrict__ KF,
                                        const bf16_t* __restrict__ HV, float* __restrict__ HST, float* __restrict__ HSD, float* __restrict__ OF, int wave_) {
    const int tid_ = wave_ * 64 + lane_id_opaque();
    const int tid = tid_, lane = tid & 63, w = __builtin_amdgcn_readfirstlane(tid >> 6), c16 = lane & 15, g = lane >> 4;
    const int dir = unit >> 7, h = (unit >> 5) & 3, seg = unit & 31;
    const int d = tid & 127, tg = tid >> 7;
    const size_t cb = (size_t)h * 128 + d;
    const float* lf = LF + (size_t)dir * S * 512 + cb;
    const bf16_t* kf = KF + (size_t)dir * S * 512 + cb;
    const bf16_t* hq = HQ + cb; const bf16_t* hv = HV + cb;
    f32x4 Sacc[8];
    float* hst = HST + (size_t)unit * 16384 + (size_t)w * 2048 + lane;
    if (OUT) {
#pragma unroll
        for (int dt = 0; dt < 8; ++dt) { Sacc[dt][0] = hst[(dt * 4 + 0) * 64]; Sacc[dt][1] = hst[(dt * 4 + 1) * 64]; Sacc[dt][2] = hst[(dt * 4 + 2) * 64]; Sacc[dt][3] = hst[(dt * 4 + 3) * 64]; }
    } else {
#pragma unroll
        for (int dt = 0; dt < 8; ++dt) Sacc[dt] = f32x4{0.f, 0.f, 0.f, 0.f};
    }
    float segsum = 0.f;
    const int e0 = 16 * w;
    for (int c = 0; c < NCH; ++c) {
        LAS unsigned char* B = lds + (c & 1) * BUFB;
        float lg[8], kk[8], qq[8]; unsigned short vv[8];
#pragma unroll
        for (int jj = 0; jj < 8; ++jj) {
            const int p = seg * SEGT + c * CH + 8 * tg + jj, t = dir ? (S - 1 - p) : p;
            lg[jj] = lf[(size_t)t * 512]; kk[jj] = bf2f(kf[(size_t)t * 512]); vv[jj] = hv[(size_t)t * 512];
            qq[jj] = OUT ? bf2f(hq[(size_t)t * 512]) : 0.f;
        }
#pragma unroll
        for (int jj = 1; jj < 8; ++jj) lg[jj] += lg[jj - 1];
        LAS float* gs = (LAS float*)(B + GOFF);
        gs[tg * 128 + d] = lg[7];
        __syncthreads();
        const float g0 = gs[d], g1 = gs[128 + d], g2 = gs[256 + d], g3 = gs[384 + d];
        const float off = (tg > 0 ? g0 : 0.f) + (tg > 1 ? g1 : 0.f) + (tg > 2 ? g2 : 0.f), tot = (g0 + g1) + (g2 + g3);
        float kt[8];
#pragma unroll
        for (int jj = 0; jj < 8; ++jj) {
            const float b = fmaxf(off + lg[jj], -80.f);
            kt[jj] = kk[jj] * __expf(-b);
            if (OUT) {
                *(LAS bf16_t*)(B + QOFF + (8 * tg + jj) * RS + d * 2) = (bf16_t)(pkbf(qq[jj] * __expf(b), 0.f) & 0xffffu);
                *(LAS bf16_t*)(B + KOFF + (8 * tg + jj) * RS + d * 2) = (bf16_t)(pkbf(kt[jj], 0.f) & 0xffffu);
            }
        }
        { u32x4 o; o.x = pkbf(kt[0], kt[1]); o.y = pkbf(kt[2], kt[3]); o.z = pkbf(kt[4], kt[5]); o.w = pkbf(kt[6], kt[7]);
          *(LAS u32x4*)(B + KTOFF + d * TS + 16 * tg) = o;
          u32x4 v; v.x = (unsigned)vv[0] | ((unsigned)vv[1] << 16); v.y = (unsigned)vv[2] | ((unsigned)vv[3] << 16); v.z = (unsigned)vv[4] | ((unsigned)vv[5] << 16); v.w = (unsigned)vv[6] | ((unsigned)vv[7] << 16);
          *(LAS u32x4*)(B + VTOFF + d * TS + 16 * tg) = v; }
        if (tg == 0) *(LAS float*)(B + DOFF + d * 4) = __expf(fmaxf(tot, -80.f));
        segsum += tot;
        __syncthreads();
        if (OUT) {
            f32x4 X00 = {0.f, 0.f, 0.f, 0.f}, X01 = X00, X11 = X00;
#pragma unroll
            for (int s = 0; s < 4; ++s) {
                const bf16x8 aK0 = *(const LAS bf16x8*)(B + KOFF + c16 * RS + (32 * s + 8 * g) * 2), aK1 = *(const LAS bf16x8*)(B + KOFF + (16 + c16) * RS + (32 * s + 8 * g) * 2);
                const bf16x8 bQ0 = *(const LAS bf16x8*)(B + QOFF + c16 * RS + (32 * s + 8 * g) * 2), bQ1 = *(const LAS bf16x8*)(B + QOFF + (16 + c16) * RS + (32 * s + 8 * g) * 2);
                X00 = HG_MFMA(aK0, bQ0, X00); X01 = HG_MFMA(aK0, bQ1, X01); X11 = HG_MFMA(aK1, bQ1, X11);
            }
#pragma unroll
            for (int r = 0; r < 4; ++r) { const bool keep = (4 * g + r) <= c16; X00[r] = keep ? X00[r] : 0.f; X11[r] = keep ? X11[r] : 0.f; }
            u32x4 a0w, a1w; a0w.x = pkbf(X00[0], X00[1]); a0w.y = pkbf(X00[2], X00[3]); a0w.z = 0u; a0w.w = 0u;
            a1w.x = pkbf(X01[0], X01[1]); a1w.y = pkbf(X01[2], X01[3]); a1w.z = pkbf(X11[0], X11[1]); a1w.w = pkbf(X11[2], X11[3]);
            const u32x2 vlo = *(const LAS u32x2*)(B + VTOFF + (e0 + c16) * TS + (4 * g) * 2), vhi = *(const LAS u32x2*)(B + VTOFF + (e0 + c16) * TS + (16 + 4 * g) * 2);
            u32x4 vbw; vbw.x = vlo.x; vbw.y = vlo.y; vbw.z = vhi.x; vbw.w = vhi.y;
            const bf16x8 vb = __builtin_bit_cast(bf16x8, vbw);
            f32x4 O0 = {0.f, 0.f, 0.f, 0.f}, O1 = O0;
            O0 = HG_MFMA(__builtin_bit_cast(bf16x8, a0w), vb, O0); O1 = HG_MFMA(__builtin_bit_cast(bf16x8, a1w), vb, O1);
#pragma unroll
            for (int s = 0; s < 4; ++s) {
                u32x4 sw; sw.x = pkbf(Sacc[2 * s][0], Sacc[2 * s][1]); sw.y = pkbf(Sacc[2 * s][2], Sacc[2 * s][3]); sw.z = pkbf(Sacc[2 * s + 1][0], Sacc[2 * s + 1][1]); sw.w = pkbf(Sacc[2 * s + 1][2], Sacc[2 * s + 1][3]);
                const bf16x8 sb = __builtin_bit_cast(bf16x8, sw);
                const u32x2 q0l = *(const LAS u32x2*)(B + QOFF + c16 * RS + (32 * s + 4 * g) * 2), q0h = *(const LAS u32x2*)(B + QOFF + c16 * RS + (32 * s + 16 + 4 * g) * 2);
                const u32x2 q1l = *(const LAS u32x2*)(B + QOFF + (16 + c16) * RS + (32 * s + 4 * g) * 2), q1h = *(const LAS u32x2*)(B + QOFF + (16 + c16) * RS + (32 * s + 16 + 4 * g) * 2);
                u32x4 q0w, q1w; q0w.x = q0l.x; q0w.y = q0l.y; q0w.z = q0h.x; q0w.w = q0h.y; q1w.x = q1l.x; q1w.y = q1l.y; q1w.z = q1h.x; q1w.w = q1h.y;
                O0 = HG_MFMA(__builtin_bit_cast(bf16x8, q0w), sb, O0); O1 = HG_MFMA(__builtin_bit_cast(bf16x8, q1w), sb, O1);
            }
#pragma unroll
            for (int r = 0; r < 4; ++r) {
                const int p0 = seg * SEGT + c * CH + 4 * g + r, p1 = p0 + 16;
                const int t0 = dir ? (S - 1 - p0) : p0, t1 = dir ? (S - 1 - p1) : p1;
                OF[((size_t)dir * S + t0) * 512 + h * 128 + e0 + c16] = O0[r];
                OF[((size_t)dir * S + t1) * 512 + h * 128 + e0 + c16] = O1[r];
            }
        }
        {
            const bf16x8 vB = *(const LAS bf16x8*)(B + VTOFF + (e0 + c16) * TS + (8 * g) * 2);
#pragma unroll
            for (int dt = 0; dt < 8; ++dt) {
                const bf16x8 aT = *(const LAS bf16x8*)(B + KTOFF + (16 * dt + c16) * TS + (8 * g) * 2);
                Sacc[dt] = HG_MFMA(aT, vB, Sacc[dt]);
                const f32x4 dv = *(const LAS f32x4*)(B + DOFF + (16 * dt + 4 * g) * 4);
                Sacc[dt] = Sacc[dt] * dv;
            }
        }
    }
    if (!OUT) {
#pragma unroll
        for (int dt = 0; dt < 8; ++dt) { hst[(dt * 4 + 0) * 64] = Sacc[dt][0]; hst[(dt * 4 + 1) * 64] = Sacc[dt][1]; hst[(dt * 4 + 2) * 64] = Sacc[dt][2]; hst[(dt * 4 + 3) * 64] = Sacc[dt][3]; }
        if (tid < 128) HSD[(size_t)unit * 128 + d] = __expf(fmaxf(segsum, -80.f));
    }
    __syncthreads();
}
__device__ __forceinline__ void carry(float* __restrict__ HST, const float* __restrict__ HSD, int gid) {
    const int chain = gid >> 14, el = gid & 16383, dt = (el >> 8) & 7, r = (el >> 6) & 3, ln = el & 63, d = 16 * dt + 4 * (ln >> 4) + r;
    float cy = 0.f;
    for (int sg = 0; sg < NSEG; ++sg) {
        const int u = chain * NSEG + sg;
        const float tmp = HST[(size_t)u * 16384 + el];
        HST[(size_t)u * 16384 + el] = cy;
        cy = HSD[(size_t)u * 128 + d] * cy + tmp;
    }
}
#undef HG_MFMA
}

#define XB_TMO      128
#define XB_XCNT(j)  (256  + 64 * (j))
#define XB_XSUB(j)  (1280 + 64 * (j))
#define XB_XGEN(j)  (2304 + 64 * (j))
#define XB_TOP      3328
#define XB_TOPGEN   3392
#define XCD_BAR_WORDS 3456
#define XB_SPIN_CAP (1u << 18)

__device__ __forceinline__ unsigned xb_ld(unsigned* p)              { return __hip_atomic_load(p, __ATOMIC_RELAXED, __HIP_MEMORY_SCOPE_AGENT); }
__device__ __forceinline__ unsigned xb_add(unsigned* p, unsigned v) { return __hip_atomic_fetch_add(p, v, __ATOMIC_RELAXED, __HIP_MEMORY_SCOPE_AGENT); }
__device__ __forceinline__ unsigned xb_xcc_id() { return (unsigned)__builtin_amdgcn_s_getreg((3 << 11) | 20) & 0xFu; }
#define XB_SPIN(cond, bar) do { unsigned _sp = 0; while (cond) { __builtin_amdgcn_s_sleep(1); \
    if ((++_sp & 255u) == 0u) { if (xb_ld(&(bar)[XB_TMO])) break; if (_sp > XB_SPIN_CAP) { atomicAdd(&(bar)[XB_TMO], 1u); break; } } } } while (0)

struct XcdBarrier {
    int wv;
    unsigned* bar; unsigned x;
    volatile LAS unsigned* st;
};

__device__ __forceinline__ XcdBarrier xcd_barrier_post(unsigned* bar, volatile LAS unsigned* st) {
    XcdBarrier b; b.bar = bar; b.x = xb_xcc_id(); b.st = st; b.wv = __builtin_amdgcn_readfirstlane((int)threadIdx.x >> 6);
    if (threadIdx.x == 0) (void)xb_add(&bar[XB_XCNT(b.x)], 1u);
    return b;
}
__device__ __forceinline__ void xcd_barrier_complete(unsigned* bar, unsigned x, unsigned& nloc, unsigned& nx) {
    const unsigned G = gridDim.x * gridDim.y * gridDim.z;
    unsigned sum, cnt, mine, sp = 0u;
    for (;;) {
        sum = 0u; cnt = 0u; mine = 0u;
#pragma unroll
        for (unsigned j = 0; j < 16; ++j) { const unsigned c = xb_ld(&bar[XB_XCNT(j)]); sum += c; cnt += (c > 0u) ? 1u : 0u; mine = (j == x) ? c : mine; }
        if (sum == G) break;
        __builtin_amdgcn_s_sleep(1);
        if ((++sp & 255u) == 0u) { if (xb_ld(&bar[XB_TMO])) break; if (sp > XB_SPIN_CAP) { atomicAdd(&bar[XB_TMO], 1u); break; } }
    }
    nloc = mine > 0u ? mine : 1u; nx = cnt > 0u ? cnt : 1u;
}

__device__ __forceinline__ void xcd_barrier(const XcdBarrier& b) {
    asm volatile("s_waitcnt vmcnt(0)" ::: "memory");
    __syncthreads();
    if (b.wv == 0 && lane_id_opaque() == 0) {
        unsigned* bar = b.bar;
        __builtin_amdgcn_s_waitcnt(0);
        unsigned nloc = b.st[0], nx = b.st[1];
        if (nloc == 0u) { xcd_barrier_complete(bar, b.x, nloc, nx); b.st[0] = nloc; b.st[1] = nx; }
        const unsigned old = xb_add(&bar[XB_XSUB(b.x)], 1u);
        const unsigned gen = old / nloc;
        if (old + 1u == (gen + 1u) * nloc) {
            __builtin_amdgcn_fence(__ATOMIC_RELEASE, "agent");
            asm volatile("s_waitcnt vmcnt(0)" ::: "memory");
            const unsigned og = xb_add(&bar[XB_TOP], 1u);
            const unsigned tg = og / nx;
            if (og + 1u == (tg + 1u) * nx) xb_add(&bar[XB_TOPGEN], 1u);
            else XB_SPIN(xb_ld(&bar[XB_TOPGEN]) == tg, bar);
            __builtin_amdgcn_fence(__ATOMIC_ACQUIRE, "agent");
            xb_add(&bar[XB_XGEN(b.x)], 1u);
            asm volatile("s_waitcnt vmcnt(0)" ::: "memory");
        } else {
            XB_SPIN(xb_ld(&bar[XB_XGEN(b.x)]) == gen, bar);
            __builtin_amdgcn_fence(__ATOMIC_ACQUIRE, "agent");
            asm volatile("s_waitcnt vmcnt(0)" ::: "memory");
        }
    }
    __syncthreads();
}

constexpr int NWAVES = 8;
constexpr int RING_OFF = 0, RING_BYTES = 131072;
constexpr int LDSCTL_OFF = RING_BYTES, MISC_OFF = LDSCTL_OFF + 320;
constexpr int LDS_BYTES = 147456;
constexpr int CW_BAR = 4096;
constexpr int NPL = 13;
constexpr int PH_PRO = 0, PH_NORM1 = 1, PH_L0 = 2, PH_END = PH_L0 + NL * NPL;
enum { P_G1 = 0, P_QKP = 1, P_HGB = 2, P_HGC = 3, P_ATT = 4, P_G2 = 5, P_G3 = 6, P_N2R = 7, P_TOPK = 8, P_GATH = 9, P_G4 = 10, P_G5 = 11, P_COMB = 12 };

#ifndef REP_HG
#define REP_HG 1
#endif
#ifndef REP_PRO
#define REP_PRO 1
#endif
#ifndef REP_ROW
#define REP_ROW 1
#endif
#ifndef REP_G
#define REP_G 1
#endif
#ifndef REP_TK
#define REP_TK 1
#endif
#ifndef REP_QK
#define REP_QK 1
#endif
#ifndef REP_ATT
#define REP_ATT 1
#endif
struct Params {
    const float *x, *c, *ada_w, *ada_b, *norm_mix_w, *norm_ffn_w, *w_in, *q_norm_w, *k_norm_w, *hlb, *hg_norm_w, *w_ba, *w_bh, *w_out, *w_router, *w_eg, *w_eu, *w_ed;
    float* out; unsigned char* ws;
    int ph_lo, ph_hi, li, pad;
};
struct Frame {
    LAS unsigned char* lds;
    int tid, lane, wave, vcu, G;
};

__device__ __forceinline__ void tr_tile(const float* __restrict__ src, int ldw, bf16_t* __restrict__ dst, int Kd, LAS float* scr, int lane) {
    f32x4 v[8];
#pragma unroll
    for (int i = 0; i < 8; ++i) v[i] = *(const f32x4*)(src + (size_t)(8 * i + (lane >> 3)) * ldw + 4 * (lane & 7));
#pragma unroll
    for (int i = 0; i < 8; ++i) { LAS float* s = scr + (8 * i + (lane >> 3)) * 33 + 4 * (lane & 7); s[0] = v[i].x; s[1] = v[i].y; s[2] = v[i].z; s[3] = v[i].w; }
    asm volatile("s_waitcnt lgkmcnt(0)" ::: "memory");
    const int cch = lane & 7;
#pragma unroll
    for (int j = 0; j < 4; ++j) { const int n = (lane >> 3) + 8 * j; const LAS float* s = scr + (8 * cch) * 33 + n;
        u32x4 o; o.x = pk2(s[0 * 33], s[1 * 33]); o.y = pk2(s[2 * 33], s[3 * 33]); o.z = pk2(s[4 * 33], s[5 * 33]); o.w = pk2(s[6 * 33], s[7 * 33]);
        *(u32x4*)(dst + (size_t)n * Kd + 8 * cch) = o; }
    asm volatile("s_waitcnt lgkmcnt(0)" ::: "memory");
}
__device__ __forceinline__ void tr_tile_f8(const float* __restrict__ src, int ldw, unsigned char* __restrict__ dst, int Kd, LAS float* scr, int lane, float scale) {
    f32x4 v[8];
#pragma unroll
    for (int i = 0; i < 8; ++i) v[i] = *(const f32x4*)(src + (size_t)(8 * i + (lane >> 3)) * ldw + 4 * (lane & 7));
#pragma unroll
    for (int i = 0; i < 8; ++i) { LAS float* s = scr + (8 * i + (lane >> 3)) * 33 + 4 * (lane & 7); s[0] = v[i].x; s[1] = v[i].y; s[2] = v[i].z; s[3] = v[i].w; }
    asm volatile("s_waitcnt lgkmcnt(0)" ::: "memory");
    const int cch = lane & 7;
#pragma unroll
    for (int j = 0; j < 4; ++j) { const int n = (lane >> 3) + 8 * j; const LAS float* s = scr + (8 * cch) * 33 + n;
        const f32x4 a = {s[0 * 33] * scale, s[1 * 33] * scale, s[2 * 33] * scale, s[3 * 33] * scale}, b = {s[4 * 33] * scale, s[5 * 33] * scale, s[6 * 33] * scale, s[7 * 33] * scale};
        *(u32x2*)(dst + (size_t)n * Kd + 8 * cch) = pg8::pack8_fp8(a, b); }
    asm volatile("s_waitcnt lgkmcnt(0)" ::: "memory");
}
__device__ __forceinline__ void conv_experts_f8(Frame& F, const Params& p, int l, LAS float* scr) {
    const int gw = F.vcu * NWAVES + F.wave, NGW = F.G * NWAVES;
    unsigned char* WGU = p.ws + WS_WGU + (size_t)l * 64 * MiB; unsigned char* WD = p.ws + WS_WD + (size_t)l * 32 * MiB;
    for (int it = gw; it < 3 * NE * 1024; it += NGW) {
        const int which = it / (NE * 1024), r0 = it % (NE * 1024), e = r0 >> 10, r = r0 & 1023;
        if (which < 2) {
            const int kb = r >> 6, nb = r & 63, n0 = 32 * nb;
            const float* W = (which == 0 ? p.w_eg : p.w_eu) + (size_t)(l * NE + e) * D * FF;
            const int rho = e * 4096 + (n0 >> 7) * 256 + which * 128 + (n0 & 127);
            tr_tile_f8(W + (size_t)(64 * kb) * FF + n0, FF, WGU + (size_t)rho * D + 64 * kb, D, scr, F.lane, 64.0f);
        } else {
            const int kb = r >> 5, nb = r & 31, n0 = 32 * nb;
            const float* W = p.w_ed + (size_t)(l * NE + e) * FF * D;
            tr_tile_f8(W + (size_t)(64 * kb) * D + n0, D, WD + (size_t)(e * 1024 + n0) * FF + 64 * kb, FF, scr, F.lane, 64.0f);
        }
    }
}
__device__ __forceinline__ void conv_matrix(Frame& F, const float* W, int K, int N, bf16_t* WT, LAS float* scr) {
    const int gw = F.vcu * NWAVES + F.wave, NGW = F.G * NWAVES, nblk = N / 32, nitems = (K / 64) * nblk;
    for (int it = gw; it < nitems; it += NGW) { const int kb = it / nblk, nb = it % nblk;
        tr_tile(W + (size_t)(64 * kb) * N + 32 * nb, N, WT + (size_t)(32 * nb) * K + 64 * kb, K, scr, F.lane); }
}
__device__ __forceinline__ void conv_experts(Frame& F, const Params& p, int l, LAS float* scr) {
    const int gw = F.vcu * NWAVES + F.wave, NGW = F.G * NWAVES;
    bf16_t* WGU = (bf16_t*)(p.ws + WS_WGU); bf16_t* WD = (bf16_t*)(p.ws + WS_WD);
    for (int it = gw; it < 3 * NE * 1024; it += NGW) {
        const int which = it / (NE * 1024), r0 = it % (NE * 1024), e = r0 >> 10, r = r0 & 1023;
        if (which < 2) {
            const int kb = r >> 6, nb = r & 63, n0 = 32 * nb;
            const float* W = (which == 0 ? p.w_eg : p.w_eu) + (size_t)(l * NE + e) * D * FF;
            const int rho = e * 4096 + (n0 >> 7) * 256 + which * 128 + (n0 & 127);
            tr_tile(W + (size_t)(64 * kb) * FF + n0, FF, WGU + (size_t)rho * D + 64 * kb, D, scr, F.lane);
        } else {
            const int kb = r >> 5, nb = r & 31, n0 = 32 * nb;
            const float* W = p.w_ed + (size_t)(l * NE + e) * FF * D;
            tr_tile(W + (size_t)(64 * kb) * D + n0, D, WD + (size_t)(e * 1024 + n0) * FF + 64 * kb, FF, scr, F.lane);
        }
    }
}
__device__ __forceinline__ void mod_units(Frame& F, const Params& p) {
    LAS float* sc = (LAS float*)(F.lds + 96 * 1024);
    LAS float* red = sc + 1024;
    float* MOD = (float*)(p.ws + WS_MOD); float* LBV = (float*)(p.ws + WS_LBV);
    for (int u = blockIdx.x; u < NL * 96; u += F.G) {
        for (int i = F.tid; i < D; i += 512) sc[i] = siluf_(p.c[i]);
        __syncthreads();
        const int l = u / 96, j = (u % 96) * 64 + (F.tid & 63), kp = F.tid >> 6;
        const float* w = p.ada_w + (size_t)l * D * 6 * D + (size_t)(kp * 128) * 6 * D + j;
        float acc = 0.f;
#pragma unroll 8
        for (int k = 0; k < 128; ++k) acc += sc[kp * 128 + k] * w[(size_t)k * 6 * D];
        red[kp * 64 + (F.tid & 63)] = acc;
        __syncthreads();
        if (F.tid < 64) { float s = 0.f;
#pragma unroll
            for (int q = 0; q < 8; ++q) s += red[q * 64 + F.tid];
            MOD[l * 6 * D + j] = s + p.ada_b[l * 6 * D + j]; }
        __syncthreads();
    }
    const int n = blockIdx.x * 512 + F.tid;
    if (n < NL * 1024) { const int l = n / 1024, r = n % 1024; float v = 0.f;
        if (l == 1) { const float b0 = p.hlb[r], b1 = p.hlb[1024 + r]; v = 1.0f / (1.0f + __expf(b0 - b1)); }
        LBV[n] = v; }
}

__device__ __forceinline__ void norm_mod_row(const f32x4 (&v)[4], float ss, const float* __restrict__ w, const float* __restrict__ scale,
                                             const float* __restrict__ shift, bf16_t* __restrict__ orow, int lane, f32x4 (&h)[4]) {
    const float r = rsqrtf(ss * (1.0f / D) + EPS);
#pragma unroll
    for (int j = 0; j < 4; ++j) {
        const int c0 = 4 * lane + 256 * j;
        const f32x4 wv = *(const f32x4*)(w + c0), sv = *(const f32x4*)(scale + c0), bv = *(const f32x4*)(shift + c0);
        h[j] = (v[j] * r) * wv * (sv + 1.0f) + bv;
        u32x2 o; o.x = pk2(h[j].x, h[j].y); o.y = pk2(h[j].z, h[j].w);
        *(u32x2*)(orow + c0) = o;
    }
}
__device__ __forceinline__ void norm_mod_row_f8(const f32x4 (&v)[4], float ss, const float* __restrict__ w, const float* __restrict__ scale,
                                                const float* __restrict__ shift, unsigned char* __restrict__ orow, int lane, f32x4 (&h)[4]) {
    const float r = rsqrtf(ss * (1.0f / D) + EPS);
#pragma unroll
    for (int j = 0; j < 4; ++j) {
        const int c0 = 4 * lane + 256 * j;
        const f32x4 wv = *(const f32x4*)(w + c0), sv = *(const f32x4*)(scale + c0), bv = *(const f32x4*)(shift + c0);
        h[j] = (v[j] * r) * wv * (sv + 1.0f) + bv;
        int wd = 0; wd = __builtin_amdgcn_cvt_pk_fp8_f32(h[j].x, h[j].y, wd, false); wd = __builtin_amdgcn_cvt_pk_fp8_f32(h[j].z, h[j].w, wd, true);
        *(int*)(orow + c0) = wd;
    }
}
__device__ __forceinline__ void ph_norm1(Frame& F, const float* x, const float* w, const float* scale, const float* shift, bf16_t* HB) {
    const int gw = F.vcu * NWAVES + F.wave, NGW = F.G * NWAVES;
    for (int row = gw; row < S; row += NGW) {
        const f32x4* xr = (const f32x4*)(x + (size_t)row * D) + F.lane;
        f32x4 v[4], h[4]; float ss = 0.f;
#pragma unroll
        for (int j = 0; j < 4; ++j) { v[j] = xr[64 * j]; ss += (v[j].x * v[j].x + v[j].y * v[j].y) + (v[j].z * v[j].z + v[j].w * v[j].w); }
        ss = wave_sum(ss);
        norm_mod_row(v, ss, w, scale, shift, HB + (size_t)row * D, F.lane, h);
    }
}
__device__ __forceinline__ void ph_gather(Frame& F, const unsigned char* HB8, const int* IDX, unsigned char* XE8) {
    const int gw = F.vcu * NWAVES + F.wave, NGW = F.G * NWAVES;
    constexpr int PER = NE * CAP / 2048;
    if (NGW * PER == NE * CAP) {
        const int r0 = gw * PER;
        const int mine = IDX[r0 + (F.lane & 15)];
#pragma unroll
        for (int q = 0; q < PER; q += 8) {
            u32x4 a[8];
#pragma unroll
            for (int k = 0; k < 8; ++k) { const int t = __builtin_amdgcn_readlane(mine, q + k); a[k] = ((const u32x4*)(HB8 + (size_t)t * D))[F.lane]; }
#pragma unroll
            for (int k = 0; k < 8; ++k) ((u32x4*)(XE8 + (size_t)(r0 + q + k) * D))[F.lane] = a[k];
        }
    } else {
        for (int r = gw; r < NE * CAP; r += NGW) { const int t = IDX[r]; ((u32x4*)(XE8 + (size_t)r * D))[F.lane] = ((const u32x4*)(HB8 + (size_t)t * D))[F.lane]; }
    }
}

#define OPAQUE_LANE() const int lane = lane_id_opaque(); const int t_ = F.wave * 64 + lane
__device__ __forceinline__ void ph_rope_table(Frame& F, float* ROPE) {
    OPAQUE_LANE();
    const int n = blockIdx.x * 512 + t_;
    if (n < 4096) { const int pos = n >> 4, i = n & 15; const float inv = exp2f(-(float)i * (13.287712379549449f / 16.0f)); float sn, cs; sincosf((float)pos * inv, &sn, &cs); ROPE[2 * n] = cs; ROPE[2 * n + 1] = sn; }
}
__device__ __forceinline__ void ph_qkprep(Frame& F, const bf16_t* __restrict__ QR, const bf16_t* __restrict__ KR, const float* __restrict__ qw, const float* __restrict__ kw,
                                          const float* __restrict__ ROPE, bf16_t* __restrict__ QN, bf16_t* __restrict__ KN) {
    OPAQUE_LANE(); (void)lane;
    for (int gid = blockIdx.x * 512 + t_; gid < S * 10; gid += F.G * 512) {
        const int t = gid / 10, hh = gid % 10;
        const bool isq = hh < 8;
        const bf16_t* src = isq ? QR + (size_t)t * 512 + hh * 64 : KR + (size_t)t * 128 + (hh - 8) * 64;
        bf16_t* dst = isq ? QN + (size_t)t * 512 + hh * 64 : KN + (size_t)t * 128 + (hh - 8) * 64;
        const float* w = isq ? qw : kw;
        float f[64]; float ss = 0.f;
#pragma unroll
        for (int i = 0; i < 8; ++i) { const u32x4 q = *(const u32x4*)(src + 8 * i);
#pragma unroll
            for (int j = 0; j < 4; ++j) { f[8 * i + 2 * j] = bflo(q[j]); f[8 * i + 2 * j + 1] = bfhi(q[j]); } }
#pragma unroll
        for (int i = 0; i < 64; ++i) ss += f[i] * f[i];
        const float rn = rsqrtf(ss * (1.0f / 64.0f) + EPS), sc = isq ? C2 : 1.0f;
#pragma unroll
        for (int i = 0; i < 16; ++i) { const f32x4 wv = *(const f32x4*)(w + 4 * i);
            f[4 * i] *= rn * wv.x; f[4 * i + 1] *= rn * wv.y; f[4 * i + 2] *= rn * wv.z; f[4 * i + 3] *= rn * wv.w; }
        float o[64];
#pragma unroll
        for (int ax = 0; ax < 2; ++ax) {
            const float* tb = ROPE + (size_t)(ax == 0 ? (t >> 6) : (t & 63)) * 32;
#pragma unroll
            for (int i2 = 0; i2 < 8; ++i2) { const f32x4 cs = *(const f32x4*)(tb + 4 * i2);
#pragma unroll
                for (int k = 0; k < 2; ++k) { const int i = 2 * i2 + k; const float c_ = k ? cs.z : cs.x, s_ = k ? cs.w : cs.y;
                    const float x1 = f[ax * 32 + i], x2 = f[ax * 32 + 16 + i];
                    o[ax * 32 + i] = (x1 * c_ - x2 * s_) * sc; o[ax * 32 + 16 + i] = (x2 * c_ + x1 * s_) * sc; } }
        }
#pragma unroll
        for (int i = 0; i < 8; ++i) { u32x4 q;
#pragma unroll
            for (int j = 0; j < 4; ++j) q[j] = pk2(o[8 * i + 2 * j], o[8 * i + 2 * j + 1]);
            *(u32x4*)(dst + 8 * i) = q; }
    }
}
__device__ __forceinline__ void ph_hgfin(Frame& F, const float* __restrict__ OF, const bf16_t* __restrict__ HG, const float* __restrict__ w, bf16_t* __restrict__ OHG) {
    OPAQUE_LANE();
    const int gw = F.vcu * NWAVES + F.wave, NGW = F.G * NWAVES;
    const int e0 = (lane & 15) * 8;
    const f32x4 w0 = *(const f32x4*)(w + e0), w1 = *(const f32x4*)(w + e0 + 4);
    for (int t = gw; t < S; t += NGW) {
        const size_t off = (size_t)t * 512 + lane * 8;
        const f32x4 a0 = *(const f32x4*)(OF + off), a1 = *(const f32x4*)(OF + off + 4), b0 = *(const f32x4*)(OF + (size_t)S * 512 + off), b1 = *(const f32x4*)(OF + (size_t)S * 512 + off + 4);
        const f32x4 s0 = a0 + b0, s1 = a1 + b1;
        float ss = (s0.x * s0.x + s0.y * s0.y) + (s0.z * s0.z + s0.w * s0.w) + (s1.x * s1.x + s1.y * s1.y) + (s1.z * s1.z + s1.w * s1.w);
        ss += __shfl_xor(ss, 1); ss += __shfl_xor(ss, 2); ss += __shfl_xor(ss, 4); ss += __shfl_xor(ss, 8);
        const float r = rsqrtf(ss * (1.0f / 128.0f) + EPS);
        const u32x4 g = *(const u32x4*)(HG + off);
        u32x4 o;
        o.x = pk2(s0.x * r * w0.x * bflo(g.x), s0.y * r * w0.y * bfhi(g.x));
        o.y = pk2(s0.z * r * w0.z * bflo(g.y), s0.w * r * w0.w * bfhi(g.y));
        o.z = pk2(s1.x * r * w1.x * bflo(g.z), s1.y * r * w1.y * bfhi(g.z));
        o.w = pk2(s1.z * r * w1.z * bflo(g.w), s1.w * r * w1.w * bfhi(g.w));
        *(u32x4*)(OHG + off) = o;
    }
}
__device__ __forceinline__ void ph_norm2_router(Frame& F, const float* __restrict__ X1, const float* __restrict__ w, const float* __restrict__ scale, const float* __restrict__ shift,
                                                const float* __restrict__ wr, unsigned char* __restrict__ HB, float* __restrict__ AFF) {
    OPAQUE_LANE();
    LAS float* WT = (LAS float*)F.lds;
    for (int dd = t_; dd < D; dd += NWAVES * 64) {
        const GAS f32x4* s = (const GAS f32x4*)((const GAS float*)wr + (size_t)dd * 16);
        const f32x4 a = s[0], b = s[1], c = s[2], e = s[3];
        WT[0 * D + dd] = a.x; WT[1 * D + dd] = a.y; WT[2 * D + dd] = a.z; WT[3 * D + dd] = a.w; WT[4 * D + dd] = b.x; WT[5 * D + dd] = b.y; WT[6 * D + dd] = b.z; WT[7 * D + dd] = b.w;
        WT[8 * D + dd] = c.x; WT[9 * D + dd] = c.y; WT[10 * D + dd] = c.z; WT[11 * D + dd] = c.w; WT[12 * D + dd] = e.x; WT[13 * D + dd] = e.y; WT[14 * D + dd] = e.z; WT[15 * D + dd] = e.w;
    }
    __syncthreads();
    const int gw = F.vcu * NWAVES + F.wave, NGW = F.G * NWAVES;
    for (int row = gw; row < S; row += 2 * NGW) {
        const int row1 = (row + NGW < S) ? row + NGW : row;
        const f32x4* xr0 = (const f32x4*)(X1 + (size_t)row * D) + lane; const f32x4* xr1 = (const f32x4*)(X1 + (size_t)row1 * D) + lane;
        f32x4 v0[4], v1[4], h0[4], h1[4]; float ss0 = 0.f, ss1 = 0.f;
#pragma unroll
        for (int j = 0; j < 4; ++j) { v0[j] = xr0[64 * j]; v1[j] = xr1[64 * j]; }
#pragma unroll
        for (int j = 0; j < 4; ++j) { ss0 += (v0[j].x * v0[j].x + v0[j].y * v0[j].y) + (v0[j].z * v0[j].z + v0[j].w * v0[j].w); ss1 += (v1[j].x * v1[j].x + v1[j].y * v1[j].y) + (v1[j].z * v1[j].z + v1[j].w * v1[j].w); }
        ss0 = wave_sum(ss0); ss1 = wave_sum(ss1);
        norm_mod_row_f8(v0, ss0, w, scale, shift, HB + (size_t)row * D, lane, h0);
        norm_mod_row_f8(v1, ss1, w, scale, shift, HB + (size_t)row1 * D, lane, h1);
        LAS float* wt = WT + 4 * lane; asm volatile("" : "+v"(wt));
        f32x4 lg0[4], lg1[4];
#pragma unroll
        for (int e = 0; e < 16; ++e) {
            float a0 = 0.f, a1 = 0.f;
#pragma unroll
            for (int j = 0; j < 4; ++j) { const f32x4 ww = *(const LAS f32x4*)(wt + e * D + 256 * j);
                a0 += (h0[j].x * ww.x + h0[j].y * ww.y) + (h0[j].z * ww.z + h0[j].w * ww.w); a1 += (h1[j].x * ww.x + h1[j].y * ww.y) + (h1[j].z * ww.z + h1[j].w * ww.w); }
            lg0[e >> 2][e & 3] = wave_sum(a0); lg1[e >> 2][e & 3] = wave_sum(a1);
        }
#pragma unroll
        for (int rr = 0; rr < 2; ++rr) {
            f32x4 (&lgv)[4] = rr ? lg1 : lg0;
            float mx = -1e30f;
#pragma unroll
            for (int e4 = 0; e4 < 4; ++e4) mx = fmaxf(mx, fmaxf(fmaxf(lgv[e4].x, lgv[e4].y), fmaxf(lgv[e4].z, lgv[e4].w)));
            float den = 0.f;
#pragma unroll
            for (int e4 = 0; e4 < 4; ++e4) { lgv[e4].x = __expf(lgv[e4].x - mx); lgv[e4].y = __expf(lgv[e4].y - mx); lgv[e4].z = __expf(lgv[e4].z - mx); lgv[e4].w = __expf(lgv[e4].w - mx);
                den += (lgv[e4].x + lgv[e4].y) + (lgv[e4].z + lgv[e4].w); }
            const float inv = 1.0f / den;
            const f32x4 s8a = (lane & 8) ? lgv[2] : lgv[0], s8b = (lane & 8) ? lgv[3] : lgv[1];
            const f32x4 s4 = (lane & 4) ? s8b : s8a;
            const float s2a = (lane & 2) ? s4.z : s4.x, s2b = (lane & 2) ? s4.w : s4.y;
            const float mine = ((lane & 1) ? s2b : s2a) * inv;
            const int rw = rr ? row1 : row;
            if (lane < 16 && (rr == 0 || row1 != row)) AFF[(size_t)lane * S + rw] = mine;
        }
    }
    __syncthreads();
}
__device__ __forceinline__ void ph_topk(Frame& F, LAS unsigned char* lds, int e, const float* __restrict__ AFF, int* __restrict__ IDX, float* __restrict__ TOPW, int* __restrict__ SLOT) {
    LAS unsigned* hist = (LAS unsigned*)lds;
    LAS unsigned* shv = hist + 256;
    LAS unsigned* scan = hist + 512;
    OPAQUE_LANE(); (void)lane; const int tid = t_;
    const unsigned* vals = (const unsigned*)(AFF + (size_t)e * S);
    unsigned u[32];
#pragma unroll
    for (int i = 0; i < 8; ++i) { const u32x4 q = *(const u32x4*)(vals + tid * 32 + 4 * i); u[4 * i] = q.x; u[4 * i + 1] = q.y; u[4 * i + 2] = q.z; u[4 * i + 3] = q.w; }
    if (tid == 0) { shv[0] = 0u; shv[1] = CAP; }
    __syncthreads();
    for (int pass = 3; pass >= 0; --pass) {
        const int shift = pass * 8;
        const unsigned mask = pass == 3 ? 0u : (0xFFFFFFFFu << (shift + 8));
        if (tid < 256) hist[tid] = 0u;
        __syncthreads();
        const unsigned prefix = shv[0];
#pragma unroll
        for (int i = 0; i < 32; ++i) if ((u[i] & mask) == (prefix & mask)) __hip_atomic_fetch_add(&hist[(u[i] >> shift) & 255u], 1u, __ATOMIC_RELAXED, __HIP_MEMORY_SCOPE_WORKGROUP);
        __syncthreads();
        if (tid == 0) {
            unsigned kk = shv[1], cum = 0u; int b = 255;
            for (; b > 0; --b) { const unsigned hb = hist[b]; if (cum + hb >= kk) break; cum += hb; }
            shv[1] = kk - cum; shv[0] = prefix | ((unsigned)b << shift);
        }
        __syncthreads();
    }
    const unsigned T = shv[0], need_eq = shv[1];
    unsigned ceq = 0u;
#pragma unroll
    for (int i = 0; i < 32; ++i) ceq += (u[i] == T) ? 1u : 0u;
    scan[tid] = ceq; __syncthreads();
    for (int off = 1; off < 512; off <<= 1) { const unsigned tv = tid >= off ? scan[tid - off] : 0u; __syncthreads(); scan[tid] += tv; __syncthreads(); }
    unsigned eq_rank = scan[tid] - ceq;
    __syncthreads();
    unsigned selmask = 0u, csel = 0u;
#pragma unroll
    for (int i = 0; i < 32; ++i) { bool sel = u[i] > T; if (u[i] == T) { sel = eq_rank < need_eq; ++eq_rank; } if (sel) { selmask |= 1u << i; ++csel; } }
    scan[tid] = csel; __syncthreads();
    for (int off = 1; off < 512; off <<= 1) { const unsigned tv = tid >= off ? scan[tid - off] : 0u; __syncthreads(); scan[tid] += tv; __syncthreads(); }
    unsigned slot = scan[tid] - csel;
#pragma unroll
    for (int i = 0; i < 32; ++i) {
        const int t = tid * 32 + i; int sl = -1;
        if (selmask & (1u << i)) { sl = (int)slot; ++slot; if (sl < CAP) { IDX[e * CAP + sl] = t; TOPW[e * CAP + sl] = __uint_as_float(u[i]); } }
        SLOT[(size_t)e * S + t] = sl < CAP ? sl : -1;
    }
    __syncthreads();
}
__device__ __forceinline__ void ph_combine(Frame& F, const float* __restrict__ X1, const bf16_t* __restrict__ YE, const int* __restrict__ SLOT, const float* __restrict__ gate,
                                           float* __restrict__ xout, const float* __restrict__ w, const float* __restrict__ scale, const float* __restrict__ shift, bf16_t* __restrict__ HB, bool do_norm) {
    OPAQUE_LANE();
    const int gw = F.vcu * NWAVES + F.wave, NGW = F.G * NWAVES;
    for (int row = gw; row < S; row += 2 * NGW) {
        const bool two = row + NGW < S; const int row1 = two ? row + NGW : row;
        const int sl0 = lane < NE ? SLOT[(size_t)lane * S + row] : -1, sl1 = lane < NE ? SLOT[(size_t)lane * S + row1] : -1;
        const f32x4* xr0 = (const f32x4*)(X1 + (size_t)row * D) + lane; const f32x4* xr1 = (const f32x4*)(X1 + (size_t)row1 * D) + lane;
        f32x4 v0[4], v1[4];
#pragma unroll
        for (int j = 0; j < 4; ++j) { v0[j] = xr0[64 * j]; v1[j] = xr1[64 * j]; }
        f32x4 acc0[4], acc1[4];
#pragma unroll
        for (int j = 0; j < 4; ++j) { acc0[j] = f32x4{0.f, 0.f, 0.f, 0.f}; acc1[j] = acc0[j]; }
        unsigned m0 = (unsigned)__ballot(sl0 >= 0) & 0xffffu, m1 = (unsigned)__ballot(sl1 >= 0) & 0xffffu;
        while (m0 | m1) {
            const int e0 = m0 ? __builtin_ctz(m0) : 0, e1 = m1 ? __builtin_ctz(m1) : 0;
            const float f0 = m0 ? 1.f : 0.f, f1 = m1 ? 1.f : 0.f;
            const int s0 = m0 ? __builtin_amdgcn_readlane(sl0, e0) : 0, s1 = m1 ? __builtin_amdgcn_readlane(sl1, e1) : 0;
            m0 &= m0 - 1u; m1 &= m1 - 1u;
            const bf16_t* y0 = YE + ((size_t)e0 * CAP + s0) * D + 4 * lane; const bf16_t* y1 = YE + ((size_t)e1 * CAP + s1) * D + 4 * lane;
            u32x2 q0[4], q1[4];
#pragma unroll
            for (int j = 0; j < 4; ++j) { q0[j] = *(const u32x2*)(y0 + 256 * j); q1[j] = *(const u32x2*)(y1 + 256 * j); }
#pragma unroll
            for (int j = 0; j < 4; ++j) { acc0[j].x += f0 * bflo(q0[j].x); acc0[j].y += f0 * bfhi(q0[j].x); acc0[j].z += f0 * bflo(q0[j].y); acc0[j].w += f0 * bfhi(q0[j].y);
                                          acc1[j].x += f1 * bflo(q1[j].x); acc1[j].y += f1 * bfhi(q1[j].x); acc1[j].z += f1 * bflo(q1[j].y); acc1[j].w += f1 * bfhi(q1[j].y); }
        }
        f32x4 h[4]; float ss0 = 0.f, ss1 = 0.f;
#pragma unroll
        for (int j = 0; j < 4; ++j) { const f32x4 gv = *(const f32x4*)(gate + 4 * lane + 256 * j); v0[j] = v0[j] + gv * acc0[j]; v1[j] = v1[j] + gv * acc1[j];
            ((f32x4*)(xout + (size_t)row * D) + lane)[64 * j] = v0[j]; if (two) ((f32x4*)(xout + (size_t)row1 * D) + lane)[64 * j] = v1[j];
            ss0 += (v0[j].x * v0[j].x + v0[j].y * v0[j].y) + (v0[j].z * v0[j].z + v0[j].w * v0[j].w); ss1 += (v1[j].x * v1[j].x + v1[j].y * v1[j].y) + (v1[j].z * v1[j].z + v1[j].w * v1[j].w); }
        if (do_norm) { ss0 = wave_sum(ss0); ss1 = wave_sum(ss1); norm_mod_row(v0, ss0, w, scale, shift, HB + (size_t)row * D, lane, h); if (two) norm_mod_row(v1, ss1, w, scale, shift, HB + (size_t)row1 * D, lane, h); }
    }
}

__global__ void __launch_bounds__(NWAVES * 64, 2) mega(Params p) {
    extern __shared__ __attribute__((aligned(16))) unsigned char lds[];
    Frame F;
    F.lds = (LAS unsigned char*)lds;
    volatile LAS unsigned* MISC = (volatile LAS unsigned*)(F.lds + MISC_OFF);
    F.tid = threadIdx.x; F.lane = F.tid & 63; F.wave = __builtin_amdgcn_readfirstlane(F.tid >> 6);
    F.G = gridDim.x; { const int bx = blockIdx.x; F.vcu = (F.G % 8 == 0) ? (bx % 8) * (F.G / 8) + bx / 8 : bx; }
    unsigned char* ws = p.ws;
    unsigned* ctl = (unsigned*)(ws + WS_CTL);
    for (int u = F.tid; u < (LDS_BYTES - LDSCTL_OFF) / 4; u += NWAVES * 64) ((LAS unsigned*)(F.lds + LDSCTL_OFF))[u] = 0u;
    __syncthreads();
    XcdBarrier bar = xcd_barrier_post(ctl + CW_BAR + p.li * XCD_BAR_WORDS, MISC + 8);
    const int lo = p.ph_lo, hi = p.ph_hi;
#define IN(k) (lo <= (k) && (k) < hi)
#define SEAM(k) do { if (IN(k) && IN((k) + 1)) xcd_barrier(bar); } while (0)
#define REFRESH() do { F.lane = lane_id_opaque(); F.tid = F.wave * 64 + F.lane; } while (0)

#define WSP(T, off) ((T*)(GAS T*)(wsl + (off)))
#define WSL() unsigned char* wsl = p.ws; asm volatile("" : "+s"(wsl))
    LAS float* scr = (LAS float*)(F.lds + RING_OFF + F.wave * 8704);

    if (IN(PH_PRO)) { REFRESH(); WSL();
        mod_units(F, p);
        for (int l = 0; l < NL; ++l) {
            conv_matrix(F, p.w_in + (size_t)l * D * INW, D, INW, WSP(bf16_t, WS_WIN) + (size_t)l * INW * D, scr);
            conv_matrix(F, p.w_ba + (size_t)l * 512 * D, 512, D, WSP(bf16_t, WS_WBA) + (size_t)l * D * 512, scr);
            conv_matrix(F, p.w_bh + (size_t)l * 512 * D, 512, D, WSP(bf16_t, WS_WBH) + (size_t)l * D * 512, scr);
            conv_matrix(F, p.w_out + (size_t)l * D * D, D, D, WSP(bf16_t, WS_WOUT) + (size_t)l * D * D, scr);
        }
        for (int rep_ = 0; rep_ < REP_PRO; ++rep_) { conv_experts_f8(F, p, 0, scr); conv_experts_f8(F, p, 1, scr); }
        ph_rope_table(F, WSP(float, WS_ROPE));
    }
    SEAM(PH_PRO);
    if (IN(PH_NORM1)) { REFRESH(); WSL(); ph_norm1(F, p.x, p.norm_mix_w, WSP(float, WS_MOD) + 1 * D, WSP(float, WS_MOD) + 0 * D, WSP(bf16_t, WS_HB)); }
    SEAM(PH_NORM1);

    for (int l = 0; l < NL; ++l) {
        const int pb = PH_L0 + l * NPL;
        if (IN(pb + P_G1)) { WSL();
            pg8::Gemm g{WSP(bf16_t, WS_HB), WSP(bf16_t, WS_WIN) + (size_t)l * INW * D, S, INW, D}; pg8::StaticOrder So; So.init(S, INW, F.G, (int)blockIdx.x);
            pg8::EpiInproj E{WSP(bf16_t, WS_QR), WSP(bf16_t, WS_KR), WSP(bf16_t, WS_VV), WSP(bf16_t, WS_HQ), WSP(bf16_t, WS_KF), WSP(bf16_t, WS_HV), WSP(bf16_t, WS_HG), WSP(bf16_t, WS_GG), WSP(float, WS_LF), WSP(float, WS_LBV) + l * 1024};
            for (int rep_ = 0; rep_ < REP_G; ++rep_) pg8::gemm_phase<pg8::EpiInproj, pg8::StaticOrder, true, true>(F.lds + RING_OFF, g, So, E, F.wave);
        }
        SEAM(pb + P_G1);
        if (IN(pb + P_QKP)) { WSL();
            for (int rep_ = 0; rep_ < REP_QK; ++rep_) ph_qkprep(F, WSP(bf16_t, WS_QR), WSP(bf16_t, WS_KR), p.q_norm_w + l * 64, p.k_norm_w + l * 64, WSP(float, WS_ROPE), WSP(bf16_t, WS_QN), WSP(bf16_t, WS_KN));
            for (int rep_ = 0; rep_ < REP_HG; ++rep_) for (int u = blockIdx.x; u < 256; u += F.G) hg::segment<false>(F.lds, u, WSP(bf16_t, WS_HQ), WSP(float, WS_LF), WSP(bf16_t, WS_KF), WSP(bf16_t, WS_HV), WSP(float, WS_HST), WSP(float, WS_HST + 16 * MiB), nullptr, F.wave);
        }
        SEAM(pb + P_QKP);
        if (IN(pb + P_HGB)) { WSL(); OPAQUE_LANE(); (void)lane;
            for (int gid = blockIdx.x * 512 + t_; gid < 8 * 16384; gid += F.G * 512) hg::carry(WSP(float, WS_HST), WSP(float, WS_HST + 16 * MiB), gid);
        }
        SEAM(pb + P_HGB);
        if (IN(pb + P_HGC)) { WSL();
            for (int rep_ = 0; rep_ < REP_HG; ++rep_) for (int u = blockIdx.x; u < 256; u += F.G) hg::segment<true>(F.lds, u, WSP(bf16_t, WS_HQ), WSP(float, WS_LF), WSP(bf16_t, WS_KF), WSP(bf16_t, WS_HV), WSP(float, WS_HST), WSP(float, WS_HST + 16 * MiB), WSP(float, WS_OF), F.wave);
        }
        SEAM(pb + P_HGC);
        if (IN(pb + P_ATT)) { WSL();
            for (int rep_ = 0; rep_ < REP_QK; ++rep_) ph_hgfin(F, WSP(float, WS_OF), WSP(bf16_t, WS_HG), p.hg_norm_w + l * 128, WSP(bf16_t, WS_OHG));
            const attn_body::AttnTensors AT{(const attn_body::bf16*)WSP(bf16_t, WS_QN), (const attn_body::bf16*)WSP(bf16_t, WS_KN), (const attn_body::bf16*)WSP(bf16_t, WS_VV), (attn_body::bf16*)WSP(bf16_t, WS_OATT)};
            const attn_body::StaticOrder So((int)F.G, (int)blockIdx.x);
            float negM;
            { const int ln = lane_id_opaque(); float mq = fabsf(p.q_norm_w[l * 64 + ln]), mk = fabsf(p.k_norm_w[l * 64 + ln]);
#pragma unroll
              for (int o_ = 1; o_ < 64; o_ <<= 1) { mq = fmaxf(mq, __shfl_xor(mq, o_)); mk = fmaxf(mk, __shfl_xor(mk, o_)); }
              negM = -(64.0f * C2) * mq * mk * 1.0001f; }
            for (int rep_ = 0; rep_ < REP_ATT; ++rep_) attn_body::attn_phase<attn_body::StaticOrder>((char*)lds + RING_OFF, AT, So, F.wave, negM);
        }
        SEAM(pb + P_ATT);
        if (IN(pb + P_G2)) { WSL();
            { pg8::Gemm g{WSP(bf16_t, WS_OATT), WSP(bf16_t, WS_WBA) + (size_t)l * D * 512, S, D, 512}; pg8::StaticOrder So; So.init(S, D, F.G, (int)blockIdx.x);
              pg8::EpiBrA E{WSP(bf16_t, WS_GG), WSP(float, WS_MP)};
              for (int rep_ = 0; rep_ < REP_G; ++rep_) pg8::gemm_phase<pg8::EpiBrA, pg8::StaticOrder, false, true>(F.lds + RING_OFF, g, So, E, F.wave); }
            __syncthreads();
            { pg8::Gemm g{WSP(bf16_t, WS_OHG), WSP(bf16_t, WS_WBH) + (size_t)l * D * 512, S, D, 512}; pg8::StaticOrder So; So.init(S, D, F.G, (int)blockIdx.x);
              pg8::EpiBrH E{WSP(bf16_t, WS_GG), WSP(float, WS_MP), WSP(bf16_t, WS_MG)};
              for (int rep_ = 0; rep_ < REP_G; ++rep_) pg8::gemm_phase<pg8::EpiBrH, pg8::StaticOrder, false, true>(F.lds + RING_OFF, g, So, E, F.wave); }
        }
        SEAM(pb + P_G2);
        if (IN(pb + P_G3)) { WSL();
            pg8::Gemm g{WSP(bf16_t, WS_MG), WSP(bf16_t, WS_WOUT) + (size_t)l * D * D, S, D, D}; pg8::StaticOrder So; So.init(S, D, F.G, (int)blockIdx.x);
            pg8::EpiOut E{l == 0 ? p.x : WSP(float, WS_X2), WSP(float, WS_MOD) + l * 6 * D + 2 * D, WSP(float, WS_X1)};
            for (int rep_ = 0; rep_ < REP_G; ++rep_) pg8::gemm_phase<pg8::EpiOut, pg8::StaticOrder, false, true>(F.lds + RING_OFF, g, So, E, F.wave);
        }
        SEAM(pb + P_G3);
        if (IN(pb + P_N2R)) { WSL();
            for (int rep_ = 0; rep_ < REP_ROW; ++rep_) ph_norm2_router(F, WSP(float, WS_X1), p.norm_ffn_w + l * D, WSP(float, WS_MOD) + l * 6 * D + 4 * D, WSP(float, WS_MOD) + l * 6 * D + 3 * D, p.w_router + (size_t)l * D * NE, WSP(unsigned char, WS_HB8), WSP(float, WS_AFF));
        }
        SEAM(pb + P_N2R);
        if (IN(pb + P_TOPK)) { WSL();
            for (int rep_ = 0; rep_ < REP_TK; ++rep_) for (int e = blockIdx.x; e < NE; e += F.G) ph_topk(F, F.lds, e, WSP(float, WS_AFF), WSP(int, WS_IDX), WSP(float, WS_TOPW), WSP(int, WS_SLOT));
        }
        SEAM(pb + P_TOPK);
        if (IN(pb + P_GATH)) { REFRESH(); WSL(); for (int rep_ = 0; rep_ < REP_ROW; ++rep_) ph_gather(F, WSP(unsigned char, WS_HB8), WSP(int, WS_IDX), WSP(unsigned char, WS_XE8)); }
        SEAM(pb + P_GATH);
        if (IN(pb + P_G4)) { WSL();
            pg8::Gemm g{(const bf16_t*)WSP(unsigned char, WS_XE8), (const bf16_t*)(WSP(unsigned char, WS_WGU) + (size_t)l * 64 * MiB), NE * CAP, NE * 4096, D / 2}; pg8::GroupOrder So; So.init(16, F.G, (int)blockIdx.x);
            pg8::EpiGU8 E{WSP(unsigned char, WS_HID8)};
            for (int rep_ = 0; rep_ < REP_G; ++rep_) pg8::gemm_phase<pg8::EpiGU8, pg8::GroupOrder, true, true, true>(F.lds + RING_OFF, g, So, E, F.wave);
        }
        SEAM(pb + P_G4);
        if (IN(pb + P_G5)) { WSL();
            pg8::Gemm g{(const bf16_t*)WSP(unsigned char, WS_HID8), (const bf16_t*)(WSP(unsigned char, WS_WD) + (size_t)l * 32 * MiB), NE * CAP, NE * 1024, FF / 2}; pg8::GroupOrder So; So.init(4, F.G, (int)blockIdx.x);
            pg8::EpiDown E{WSP(bf16_t, WS_YE), WSP(float, WS_TOPW), 0.015625f};
            for (int rep_ = 0; rep_ < REP_G; ++rep_) pg8::gemm_phase<pg8::EpiDown, pg8::GroupOrder, true, true, true>(F.lds + RING_OFF, g, So, E, F.wave);
        }
        SEAM(pb + P_G5);
        if (IN(pb + P_COMB)) { WSL();
            const bool last = (l + 1 == NL); const int ln = last ? l : l + 1;
            for (int rep_ = 0; rep_ < REP_ROW; ++rep_) ph_combine(F, WSP(float, WS_X1), WSP(bf16_t, WS_YE), WSP(int, WS_SLOT), WSP(float, WS_MOD) + l * 6 * D + 5 * D, last ? p.out : WSP(float, WS_X2),
                       p.norm_mix_w + ln * D, WSP(float, WS_MOD) + ln * 6 * D + 1 * D, WSP(float, WS_MOD) + ln * 6 * D + 0 * D, WSP(bf16_t, WS_HB), !last);
        }
        SEAM(pb + P_COMB);
    }
#undef IN
#undef SEAM
}

#ifndef N_LAUNCH_MODE
#define N_LAUNCH_MODE 1
#endif
static int g_grid = 0;
extern "C" void kernel_launch(void* const* d_in, const int* in_sizes, int n_in, void* d_out, int out_size, void* d_ws, size_t ws_size, hipStream_t stream) {
    if (n_in != 18 || out_size != S * D || ws_size < WS_END) { fprintf(stderr, "kernel_launch: unexpected shapes (n_in %d out %d ws %zu)\n", n_in, out_size, ws_size); return; }
    if (g_grid == 0) {
        int dev = 0, cus = 0;
        if (hipGetDevice(&dev) != hipSuccess || hipDeviceGetAttribute(&cus, hipDeviceAttributeMultiprocessorCount, dev) != hipSuccess) { g_grid = -1; return; }
        if (hipFuncSetAttribute((const void*)mega, hipFuncAttributeMaxDynamicSharedMemorySize, LDS_BYTES) != hipSuccess) { g_grid = -1; return; }
        int per_cu = 0;
        if (hipOccupancyMaxActiveBlocksPerMultiprocessor(&per_cu, (const void*)mega, NWAVES * 64, LDS_BYTES) != hipSuccess || per_cu < 1) { fprintf(stderr, "occupancy query: %d\n", per_cu); }
        (void)hipGetLastError();
        g_grid = cus;
    }
    if (g_grid < 0) return;
    unsigned char* ws = (unsigned char*)d_ws;
    (void)hipMemsetAsync(ws + WS_CTL, 0, 1 * MiB, stream);
    Params p{};
    p.x = (const float*)d_in[0]; p.c = (const float*)d_in[1]; p.ada_w = (const float*)d_in[2]; p.ada_b = (const float*)d_in[3]; p.norm_mix_w = (const float*)d_in[4];
    p.norm_ffn_w = (const float*)d_in[5]; p.w_in = (const float*)d_in[6]; p.q_norm_w = (const float*)d_in[7]; p.k_norm_w = (const float*)d_in[8]; p.hlb = (const float*)d_in[9];
    p.hg_norm_w = (const float*)d_in[10]; p.w_ba = (const float*)d_in[11]; p.w_bh = (const float*)d_in[12]; p.w_out = (const float*)d_in[13]; p.w_router = (const float*)d_in[14];
    p.w_eg = (const float*)d_in[15]; p.w_eu = (const float*)d_in[16]; p.w_ed = (const float*)d_in[17];
    p.out = (float*)d_out; p.ws = ws;
#if defined(DBG_ATT)
    { const int cut = PH_L0 + P_ATT + 1;
      p.ph_lo = 0; p.ph_hi = cut; p.li = 0; p.pad = 0; hipLaunchKernelGGL(mega, dim3(g_grid), dim3(NWAVES * 64), LDS_BYTES, stream, p);
      hipMemcpyAsync(ws + 900 * MiB, ws + WS_OATT, 16 * MiB, hipMemcpyDeviceToDevice, stream);
      k_attn_naive<<<dim3(S / 64, 8), dim3(64), 0, stream>>>((const bf16_t*)(ws + WS_QN), (const bf16_t*)(ws + WS_KN), (const bf16_t*)(ws + WS_VV), (bf16_t*)(ws + WS_OATT));
      k_cmp_bf16<<<dim3(2048), dim3(256), 0, stream>>>((const bf16_t*)(ws + 900 * MiB), (const bf16_t*)(ws + WS_OATT), (size_t)8 * MiB, 512, 0, 512, (float*)(ws + 512 * 1024));
      p.ph_lo = cut; p.ph_hi = PH_END; p.li = 1; hipLaunchKernelGGL(mega, dim3(g_grid), dim3(NWAVES * 64), LDS_BYTES, stream, p);
      k_scale_out<<<dim3(2048), dim3(256), 0, stream>>>((float*)d_out, (size_t)S * D, (const float*)(ws + 512 * 1024)); }
#elif N_LAUNCH_MODE == 1
    p.ph_lo = 0; p.ph_hi = PH_END; p.li = 0; p.pad = 0;
    hipLaunchKernelGGL(mega, dim3(g_grid), dim3(NWAVES * 64), LDS_BYTES, stream, p);
#else
    for (int k = 0; k < PH_END; ++k) { p.ph_lo = k; p.ph_hi = k + 1; p.li = k; p.pad = 0; hipLaunchKernelGGL(mega, dim3(g_grid), dim3(NWAVES * 64), LDS_BYTES, stream, p); }
#endif
}
```

```cpp
#include <hip/hip_runtime.h>
#include <cstdio>
#include <cstdint>

typedef unsigned short bf16_t;
typedef float f32x4 __attribute__((ext_vector_type(4)));
typedef float f32x16 __attribute__((ext_vector_type(16)));
typedef unsigned u32x4 __attribute__((ext_vector_type(4)));
typedef unsigned u32x2 __attribute__((ext_vector_type(2)));

constexpr int S = 16384, D = 1024, NL = 2, INW = 5376;
constexpr int NE = 16, CAP = 2048, FF = 2048;
constexpr float EPS = 1e-6f;
constexpr float C2 = 0.125f * 1.4426950408889634f;
constexpr int C_AQ = 0, C_AK = 512, C_AV = 640, C_HQ = 768, C_ZF = 1280, C_ZB = 1792, C_HI = 2304, C_HGT = 2816, C_GL = 3328;

constexpr size_t MiB = 1u << 20;
constexpr size_t WS_CTL = 0;
constexpr size_t WS_MOD = 1 * MiB;
constexpr size_t WS_LBV = WS_MOD + 64 * 1024;
constexpr size_t WS_IDX = WS_MOD + 128 * 1024;
constexpr size_t WS_TOPW = WS_IDX + 128 * 1024;
constexpr size_t WS_ROPE = WS_MOD + 512 * 1024;
constexpr size_t WS_AFF = 2 * MiB;
constexpr size_t WS_SLOT = 3 * MiB;
constexpr size_t WS_HB = 4 * MiB;
constexpr size_t WS_QR = 36 * MiB;
constexpr size_t WS_KR = 52 * MiB;
constexpr size_t WS_VV = 56 * MiB;
constexpr size_t WS_QN = 60 * MiB;
constexpr size_t WS_KN = 76 * MiB;
constexpr size_t WS_HQ = 80 * MiB;
constexpr size_t WS_LF = 96 * MiB;
constexpr size_t WS_KF = 160 * MiB;
constexpr size_t WS_HV = 192 * MiB;
constexpr size_t WS_HG = 208 * MiB;
constexpr size_t WS_GG = 224 * MiB;
constexpr size_t WS_OATT = 288 * MiB;
constexpr size_t WS_OF = 304 * MiB;
constexpr size_t WS_OHG = 368 * MiB;
constexpr size_t WS_MP = 384 * MiB;
constexpr size_t WS_MG = 448 * MiB;
constexpr size_t WS_HB8 = 36 * MiB;
constexpr size_t WS_XE8 = 52 * MiB;
constexpr size_t WS_HID8 = 100 * MiB;
constexpr size_t WS_XE = 36 * MiB;
constexpr size_t WS_HID = 100 * MiB;
constexpr size_t WS_YE = 228 * MiB;
constexpr size_t WS_X1 = 480 * MiB;
constexpr size_t WS_X2 = 544 * MiB;
constexpr size_t WS_WIN = 608 * MiB;
constexpr size_t WS_WBA = 630 * MiB;
constexpr size_t WS_WBH = 632 * MiB;
constexpr size_t WS_WOUT = 634 * MiB;
constexpr size_t WS_WGU = 638 * MiB;
constexpr size_t WS_WD = 766 * MiB;
constexpr size_t WS_HST = 830 * MiB;
constexpr size_t WS_WIN8 = 900 * MiB;
constexpr size_t WS_HBF8 = 906 * MiB;
constexpr size_t WS_END = 924 * MiB;
static_assert(WS_END <= 1024 * MiB, "workspace");

__device__ __forceinline__ float bf2f(bf16_t v) { return __uint_as_float((unsigned)v << 16); }
__device__ __forceinline__ bf16_t f2bf(float f) { unsigned u = __float_as_uint(f); return (bf16_t)((u + 0x7fffu + ((u >> 16) & 1u)) >> 16); }
__device__ __forceinline__ unsigned pk2(float lo, float hi) { return (unsigned)f2bf(lo) | ((unsigned)f2bf(hi) << 16); }
__device__ __forceinline__ float bflo(unsigned w) { return __uint_as_float(w << 16); }
__device__ __forceinline__ float bfhi(unsigned w) { return __uint_as_float(w & 0xffff0000u); }
__device__ __forceinline__ float sigmoidf_(float v) { return __builtin_amdgcn_rcpf(1.0f + __expf(-v)); }
__device__ __forceinline__ float siluf_(float v) { return v * __builtin_amdgcn_rcpf(1.0f + __expf(-v)); }
__device__ __forceinline__ float wave_sum(float v) {
#pragma unroll
    for (int o = 1; o < 64; o <<= 1) v += __shfl_xor(v, o);
    return v;
}
__device__ __forceinline__ int crow(int r, int hi) { return (r & 3) + 8 * (r >> 2) + 4 * hi; }
__device__ __forceinline__ int lane_id_opaque() { int l; asm volatile("v_mbcnt_lo_u32_b32 %0, -1, 0\n\tv_mbcnt_hi_u32_b32 %0, -1, %0" : "=v"(l)); return l; }

#define GAS __attribute__((address_space(1)))
#define LAS __attribute__((address_space(3)))

namespace pg8 {
#define PG8_LAS __attribute__((address_space(3)))
typedef unsigned short bf16_t;
typedef short bf16x8 __attribute__((ext_vector_type(8)));
typedef float f32x4 __attribute__((ext_vector_type(4)));
typedef unsigned u32x4 __attribute__((ext_vector_type(4)));
constexpr int BM = 256, BK = 64, HALF = 128, HTB = HALF * BK * 2  , STAGE_BYTES = 8 * HTB, NXCD = 8, WGM = 8;

__host__ __device__ __forceinline__ int lds_byte(int r, int c) { const int st = (r >> 4) * 2 + (c >> 5), rr = r & 15, cc = c & 31, ob = rr * 64 + cc * 2; return st * 1024 + (ob ^ (((ob >> 9) & 1) << 5)); }
__host__ __device__ __forceinline__ void stage_rc(int b, int& R, int& C) { const int st = b / 1024, sb = b % 1024, swz = sb ^ (((sb >> 9) & 1) << 5); R = (st >> 1) * 16 + swz / 64; C = (st & 1) * 32 + (swz % 64) / 2; }
__host__ __device__ __forceinline__ int perm32(int rho) { const int n = rho >> 4, i = rho & 15; return 8 * (i >> 2) + 4 * n + (i & 3); }

struct Unit { int pm, pn, pb, sel; };
struct Gemm { const bf16_t* A; const bf16_t* Bt; int M, N, K; const bf16_t* A2 = nullptr; const bf16_t* Bt2 = nullptr; const int* rowidx = nullptr; };

struct StaticOrder {
    int nM, nN, nwg, G, c;
    __host__ __device__ void init(int M, int N, int G_, int c_) { nM = M / BM; nN = N / BM; nwg = nM * nN; G = G_; c = c_; }
    __host__ __device__ bool next(int i, Unit& u) const {
        const long L = (long)i * G + c; if (L >= nwg) return false;
        int wgid = (int)L; { const int q = nwg / NXCD, r = nwg % NXCD, xcd = wgid % NXCD, off = wgid / NXCD; wgid = (xcd < r ? xcd * (q + 1) : r * (q + 1) + (xcd - r) * q) + off; }
        const int nig = WGM * nN, gid = wgid / nig, fm = gid * WGM, gsz = (nM - fm) < WGM ? (nM - fm) : WGM;
        u.pm = fm + ((wgid % nig) % gsz); u.pn = (wgid % nig) / gsz; u.pb = u.pn; u.sel = 0; return true;
    }
    __device__ __forceinline__ void a_ready(const Unit&) const {}
    __device__ __forceinline__ void done(const Unit&) const {}
};

typedef float f32x2_c __attribute__((ext_vector_type(2))); typedef __bf16 bf16x2_c __attribute__((ext_vector_type(2)));
__device__ __forceinline__ unsigned cvt_pk_bf16(float lo, float hi) { f32x2_c v = {lo, hi}; bf16x2_c b = __builtin_convertvector(v, bf16x2_c); return __builtin_bit_cast(unsigned, b); }

typedef unsigned u32x2 __attribute__((ext_vector_type(2)));
__device__ __forceinline__ float e_bflo(unsigned w) { return __uint_as_float(w << 16); }
__device__ __forceinline__ float e_bfhi(unsigned w) { return __uint_as_float(w & 0xffff0000u); }
__device__ __forceinline__ float e_sig(float v) { return __builtin_amdgcn_rcpf(1.0f + __expf(-v)); }
__device__ __forceinline__ u32x4 pack8(const f32x4 a, const f32x4 b) { u32x4 w; w.x = cvt_pk_bf16(a[0], a[1]); w.y = cvt_pk_bf16(a[2], a[3]); w.z = cvt_pk_bf16(b[0], b[1]); w.w = cvt_pk_bf16(b[2], b[3]); return w; }

typedef int i32x4_ __attribute__((ext_vector_type(4))); typedef int i32x8_ __attribute__((ext_vector_type(8)));
__device__ __forceinline__ i32x8_ pg8_cat(const bf16x8 lo, const bf16x8 hi) { return __builtin_shufflevector(__builtin_bit_cast(i32x4_, lo), __builtin_bit_cast(i32x4_, hi), 0, 1, 2, 3, 4, 5, 6, 7); }
__device__ __forceinline__ u32x2 pack8_fp8(const f32x4 a, const f32x4 b) { int w0 = 0, w1 = 0;
    w0 = __builtin_amdgcn_cvt_pk_fp8_f32(a[0], a[1], w0, false); w0 = __builtin_amdgcn_cvt_pk_fp8_f32(a[2], a[3], w0, true);
    w1 = __builtin_amdgcn_cvt_pk_fp8_f32(b[0], b[1], w1, false); w1 = __builtin_amdgcn_cvt_pk_fp8_f32(b[2], b[3], w1, true);
    u32x2 r; r.x = (unsigned)w0; r.y = (unsigned)w1; return r; }
struct EpiInproj {
    static constexpr bool PERM = true, AFTER_DRAIN = false, CHAIN = false;
    bf16_t *QR, *KR, *VV, *HQ, *KF, *HV, *HG, *GG; float* LF; const float* lbv; float ascale;
    __device__ __forceinline__ void operator()(const f32x4 (&acc)[2][2][4][2], const Unit& u, int wr, int wc, int fr, int fq) const {
        const int row0 = u.pm * BM + wr * 64 + fr, cl = wc * 32 + 8 * fq;
#pragma unroll
        for (int bj = 0; bj < 2; ++bj) {
            const int colg = u.pn * BM + bj * HALF;
            int kind; bf16_t* dst; int pitch, c0; int dir = 0;
            if (colg < 512) { kind = 0; dst = QR; pitch = 512; c0 = colg; }
            else if (colg < 640) { kind = 0; dst = KR; pitch = 128; c0 = colg - 512; }
            else if (colg < 768) { kind = 0; dst = VV; pitch = 128; c0 = colg - 640; }
            else if (colg < 1280) { kind = 1; dst = HQ; pitch = 512; c0 = colg - 768; }
            else if (colg < 2304) { kind = 3; dir = colg >= 1792; dst = KF + (size_t)dir * 16384 * 512; pitch = 512; c0 = colg - (dir ? 1792 : 1280); }
            else if (colg < 2816) { kind = 0; dst = HV; pitch = 512; c0 = colg - 2304; }
            else if (colg < 3328) { kind = 1; dst = HG; pitch = 512; c0 = colg - 2816; }
            else { kind = 2; dst = GG; pitch = 2048; c0 = colg - 3328; }
            c0 += cl;
            if (kind == 0) {
#pragma unroll
                for (int ai = 0; ai < 2; ++ai)
#pragma unroll
                    for (int m = 0; m < 4; ++m) *(u32x4*)(dst + (size_t)(row0 + ai * HALF + m * 16) * pitch + c0) = pack8(acc[ai][bj][m][0] * ascale, acc[ai][bj][m][1] * ascale);
            } else if (kind == 1) {
#pragma unroll
                for (int ai = 0; ai < 2; ++ai)
#pragma unroll
                    for (int m = 0; m < 4; ++m) { f32x4 a = acc[ai][bj][m][0] * ascale, b = acc[ai][bj][m][1] * ascale;
#pragma unroll
                        for (int i = 0; i < 4; ++i) { a[i] = a[i] * e_sig(a[i]); b[i] = b[i] * e_sig(b[i]); }
                        *(u32x4*)(dst + (size_t)(row0 + ai * HALF + m * 16) * pitch + c0) = pack8(a, b); }
            } else if (kind == 2) {
#pragma unroll
                for (int ai = 0; ai < 2; ++ai)
#pragma unroll
                    for (int m = 0; m < 4; ++m) { f32x4 a = acc[ai][bj][m][0] * ascale, b = acc[ai][bj][m][1] * ascale;
#pragma unroll
                        for (int i = 0; i < 4; ++i) { a[i] = e_sig(a[i]); b[i] = e_sig(b[i]); }
                        *(u32x4*)(dst + (size_t)(row0 + ai * HALF + m * 16) * pitch + c0) = pack8(a, b); }
            } else {
                const f32x4 lb0 = *(const f32x4*)(lbv + dir * 512 + c0), lb1 = *(const f32x4*)(lbv + dir * 512 + c0 + 4);
                float* lf = LF + (size_t)dir * 16384 * 512;
#pragma unroll
                for (int ai = 0; ai < 2; ++ai)
#pragma unroll
                    for (int m = 0; m < 4; ++m) { const f32x4 a = acc[ai][bj][m][0] * ascale, b = acc[ai][bj][m][1] * ascale; f32x4 la, lb_, ka, kb;
#pragma unroll
                        for (int i = 0; i < 4; ++i) {
                            const float sa = e_sig(a[i]), sb = e_sig(b[i]);
                            la[i] = __logf(fmaxf(lb0[i] + (1.0f - lb0[i]) * sa, 1e-6f)); ka[i] = (1.0f - lb0[i]) * (1.0f - sa);
                            lb_[i] = __logf(fmaxf(lb1[i] + (1.0f - lb1[i]) * sb, 1e-6f)); kb[i] = (1.0f - lb1[i]) * (1.0f - sb); }
                        const size_t o = (size_t)(row0 + ai * HALF + m * 16) * 512 + c0;
                        *(f32x4*)(lf + o) = la; *(f32x4*)(lf + o + 4) = lb_;
                        *(u32x4*)(dst + o) = pack8(ka, kb); }
            }
        }
    }
};
struct EpiBrA {
    static constexpr bool PERM = true, AFTER_DRAIN = false, CHAIN = false;
    const bf16_t* GG; float* MP;
    __device__ __forceinline__ void operator()(const f32x4 (&acc)[2][2][4][2], const Unit& u, int wr, int wc, int fr, int fq) const {
        const int row0 = u.pm * BM + wr * 64 + fr, col0 = u.pn * BM + wc * 32 + 8 * fq;
#pragma unroll
        for (int ai = 0; ai < 2; ++ai)
#pragma unroll
            for (int m = 0; m < 4; ++m) { const size_t r = (size_t)(row0 + ai * HALF + m * 16);
#pragma unroll
                for (int bj = 0; bj < 2; ++bj) { const int c = col0 + bj * HALF; const u32x4 g = *(const u32x4*)(GG + r * 2048 + c);
                    f32x4 a = acc[ai][bj][m][0], b = acc[ai][bj][m][1];
                    a[0] *= e_bflo(g.x); a[1] *= e_bfhi(g.x); a[2] *= e_bflo(g.y); a[3] *= e_bfhi(g.y); b[0] *= e_bflo(g.z); b[1] *= e_bfhi(g.z); b[2] *= e_bflo(g.w); b[3] *= e_bfhi(g.w);
                    *(f32x4*)(MP + r * 1024 + c) = a; *(f32x4*)(MP + r * 1024 + c + 4) = b; } }
    }
};
struct EpiBrH {
    static constexpr bool PERM = true, AFTER_DRAIN = false, CHAIN = false;
    const bf16_t* GG; const float* MP; bf16_t* MG;
    __device__ __forceinline__ void operator()(const f32x4 (&acc)[2][2][4][2], const Unit& u, int wr, int wc, int fr, int fq) const {
        const int row0 = u.pm * BM + wr * 64 + fr, col0 = u.pn * BM + wc * 32 + 8 * fq;
#pragma unroll
        for (int ai = 0; ai < 2; ++ai)
#pragma unroll
            for (int m = 0; m < 4; ++m) { const size_t r = (size_t)(row0 + ai * HALF + m * 16);
#pragma unroll
                for (int bj = 0; bj < 2; ++bj) { const int c = col0 + bj * HALF; const u32x4 g = *(const u32x4*)(GG + r * 2048 + 1024 + c);
                    f32x4 a = acc[ai][bj][m][0], b = acc[ai][bj][m][1]; const f32x4 pa = *(const f32x4*)(MP + r * 1024 + c), pb = *(const f32x4*)(MP + r * 1024 + c + 4);
                    a[0] = pa[0] + a[0] * e_bflo(g.x); a[1] = pa[1] + a[1] * e_bfhi(g.x); a[2] = pa[2] + a[2] * e_bflo(g.y); a[3] = pa[3] + a[3] * e_bfhi(g.y);
                    b[0] = pb[0] + b[0] * e_bflo(g.z); b[1] = pb[1] + b[1] * e_bfhi(g.z); b[2] = pb[2] + b[2] * e_bflo(g.w); b[3] = pb[3] + b[3] * e_bfhi(g.w);
                    *(u32x4*)(MG + r * 1024 + c) = pack8(a, b); } }
    }
};
struct EpiMerge {
    static constexpr bool PERM = true, AFTER_DRAIN = false, CHAIN = true;
    const bf16_t* GG; bf16_t* MG;
    __device__ __forceinline__ void mid(f32x4 (&acc)[2][2][4][2], const Unit& u, int wr, int wc, int fr, int fq) const {
        const int row0 = u.pm * BM + wr * 64 + fr, col0 = u.pn * BM + wc * 32 + 8 * fq;
#pragma unroll
        for (int ai = 0; ai < 2; ++ai)
#pragma unroll
            for (int m = 0; m < 4; ++m) { const size_t r = (size_t)(row0 + ai * HALF + m * 16);
#pragma unroll
                for (int bj = 0; bj < 2; ++bj) { const int c = col0 + bj * HALF; const u32x4 g0 = *(const u32x4*)(GG + r * 2048 + c), g1 = *(const u32x4*)(GG + r * 2048 + 1024 + c);
                    f32x4& a = acc[ai][bj][m][0]; f32x4& b = acc[ai][bj][m][1];
                    a[0] *= e_bflo(g0.x) * __builtin_amdgcn_rcpf(e_bflo(g1.x)); a[1] *= e_bfhi(g0.x) * __builtin_amdgcn_rcpf(e_bfhi(g1.x));
                    a[2] *= e_bflo(g0.y) * __builtin_amdgcn_rcpf(e_bflo(g1.y)); a[3] *= e_bfhi(g0.y) * __builtin_amdgcn_rcpf(e_bfhi(g1.y));
                    b[0] *= e_bflo(g0.z) * __builtin_amdgcn_rcpf(e_bflo(g1.z)); b[1] *= e_bfhi(g0.z) * __builtin_amdgcn_rcpf(e_bfhi(g1.z));
                    b[2] *= e_bflo(g0.w) * __builtin_amdgcn_rcpf(e_bflo(g1.w)); b[3] *= e_bfhi(g0.w) * __builtin_amdgcn_rcpf(e_bfhi(g1.w)); } }
    }
    __device__ __forceinline__ void operator()(const f32x4 (&acc)[2][2][4][2], const Unit& u, int wr, int wc, int fr, int fq) const {
        const int row0 = u.pm * BM + wr * 64 + fr, col0 = u.pn * BM + wc * 32 + 8 * fq;
#pragma unroll
        for (int ai = 0; ai < 2; ++ai)
#pragma unroll
            for (int m = 0; m < 4; ++m) { const size_t r = (size_t)(row0 + ai * HALF + m * 16);
#pragma unroll
                for (int bj = 0; bj < 2; ++bj) { const int c = col0 + bj * HALF; const u32x4 g = *(const u32x4*)(GG + r * 2048 + 1024 + c);
                    f32x4 a = acc[ai][bj][m][0], b = acc[ai][bj][m][1];
                    a[0] *= e_bflo(g.x); a[1] *= e_bfhi(g.x); a[2] *= e_bflo(g.y); a[3] *= e_bfhi(g.y); b[0] *= e_bflo(g.z); b[1] *= e_bfhi(g.z); b[2] *= e_bflo(g.w); b[3] *= e_bfhi(g.w);
                    *(u32x4*)(MG + r * 1024 + c) = pack8(a, b); } }
    }
};
struct OffOrder {
    StaticOrder So; int off;
    __device__ bool next(int i, Unit& u) const { if (!So.next(i, u)) return false; u.pb = u.pn; u.pn += off; return true; }
    __device__ __forceinline__ void a_ready(const Unit&) const {}
    __device__ __forceinline__ void done(const Unit&) const {}
};
struct ChainOrder {
    StaticOrder So;
    __device__ bool next(int i, Unit& u) const { if (!So.next(i >> 1, u)) return false; u.sel = i & 1; return true; }
    __device__ __forceinline__ void a_ready(const Unit&) const {}
    __device__ __forceinline__ void done(const Unit&) const {}
};
struct EpiOut {
    static constexpr bool PERM = true, AFTER_DRAIN = false, CHAIN = false;
    const float* xin; const float* gate; float* X1;
    __device__ __forceinline__ void operator()(const f32x4 (&acc)[2][2][4][2], const Unit& u, int wr, int wc, int fr, int fq) const {
        const int row0 = u.pm * BM + wr * 64 + fr, col0 = u.pn * BM + wc * 32 + 8 * fq;
#pragma unroll
        for (int bj = 0; bj < 2; ++bj) { const int c = col0 + bj * HALF; const f32x4 g0 = *(const f32x4*)(gate + c), g1 = *(const f32x4*)(gate + c + 4);
#pragma unroll
            for (int ai = 0; ai < 2; ++ai)
#pragma unroll
                for (int m = 0; m < 4; ++m) { const size_t o = (size_t)(row0 + ai * HALF + m * 16) * 1024 + c;
                    *(f32x4*)(X1 + o) = *(const f32x4*)(xin + o) + g0 * acc[ai][bj][m][0]; *(f32x4*)(X1 + o + 4) = *(const f32x4*)(xin + o + 4) + g1 * acc[ai][bj][m][1]; } }
    }
};
struct EpiGU {
    static constexpr bool PERM = true, AFTER_DRAIN = false, CHAIN = false;
    bf16_t* HID;
    __device__ __forceinline__ void operator()(const f32x4 (&acc)[2][2][4][2], const Unit& u, int wr, int wc, int fr, int fq) const {
        const int row0 = u.pm * BM + wr * 64 + fr, col0 = u.pn * HALF + wc * 32 + 8 * fq;
#pragma unroll
        for (int ai = 0; ai < 2; ++ai)
#pragma unroll
            for (int m = 0; m < 4; ++m) { f32x4 a = acc[ai][0][m][0], b = acc[ai][0][m][1]; const f32x4 ua = acc[ai][1][m][0], ub = acc[ai][1][m][1];
#pragma unroll
                for (int i = 0; i < 4; ++i) { a[i] = a[i] * e_sig(a[i]) * ua[i]; b[i] = b[i] * e_sig(b[i]) * ub[i]; }
                *(u32x4*)(HID + (size_t)(row0 + ai * HALF + m * 16) * 2048 + col0) = pack8(a, b); }
    }
};
struct EpiGU8 {
    static constexpr bool PERM = true, AFTER_DRAIN = false, CHAIN = false;
    unsigned char* HID;
    __device__ __forceinline__ void operator()(const f32x4 (&acc)[2][2][4][2], const Unit& u, int wr, int wc, int fr, int fq) const {
        const int row0 = u.pm * BM + wr * 64 + fr, col0 = u.pn * HALF + wc * 32 + 8 * fq;
#pragma unroll
        for (int ai = 0; ai < 2; ++ai)
#pragma unroll
            for (int m = 0; m < 4; ++m) { f32x4 a = acc[ai][0][m][0], b = acc[ai][0][m][1]; const f32x4 ua = acc[ai][1][m][0], ub = acc[ai][1][m][1];
#pragma unroll
                for (int i = 0; i < 4; ++i) { const float ga = a[i] * 0.015625f, gb = b[i] * 0.015625f; a[i] = ga * e_sig(ga) * (ua[i] * 0.015625f); b[i] = gb * e_sig(gb) * (ub[i] * 0.015625f); }
                *(u32x2*)(HID + (size_t)(row0 + ai * HALF + m * 16) * 2048 + col0) = pack8_fp8(a, b); }
    }
};
struct EpiDown {
    static constexpr bool PERM = true, AFTER_DRAIN = false, CHAIN = false;
    bf16_t* YE; const float* topw; float wscale;
    __device__ __forceinline__ void operator()(const f32x4 (&acc)[2][2][4][2], const Unit& u, int wr, int wc, int fr, int fq) const {
        const int row0 = u.pm * BM + wr * 64 + fr, col0 = u.pn * BM + wc * 32 + 8 * fq;
#pragma unroll
        for (int ai = 0; ai < 2; ++ai)
#pragma unroll
            for (int m = 0; m < 4; ++m) { const int r = row0 + ai * HALF + m * 16; const float w = topw[r] * wscale;
#pragma unroll
                for (int bj = 0; bj < 2; ++bj) *(u32x4*)(YE + (size_t)r * 1024 + col0 + bj * HALF) = pack8(acc[ai][bj][m][0] * w, acc[ai][bj][m][1] * w); }
    }
};
struct GroupOrder {
    int nNe, nwg, G, c;
    __device__ void init(int nNe_, int G_, int c_) { nNe = nNe_; nwg = 16 * 8 * nNe_; G = G_; c = c_; }
    __device__ bool next(int i, Unit& u) const {
        const long L = (long)i * G + c; if (L >= nwg) return false;
        int wgid = (int)L; { const int q = nwg / NXCD, xcd = wgid % NXCD, off = wgid / NXCD; wgid = xcd * q + off; }
        const int per = 8 * nNe, e = wgid / per, w = wgid % per;
        u.pm = e * 8 + (w & 7); u.pn = w >> 3; u.pb = e * nNe + u.pn; u.sel = 0; return true;
    }
    __device__ __forceinline__ void a_ready(const Unit&) const {}
    __device__ __forceinline__ void done(const Unit&) const {}
};

template <class Epi, class Sched, bool ALIGN_EPI = false, bool SP2 = false, bool FP8 = false, bool GATHER = false>
__device__ __forceinline__ void gemm_phase(PG8_LAS unsigned char* lds, const Gemm g, const Sched& S, const Epi& E, int wave_) {
    const int tid_ = wave_ * 64 + lane_id_opaque();
    const int tid = tid_, wid = __builtin_amdgcn_readfirstlane(tid >> 6), lane = tid & 63, wr = wid >> 2, wc = wid & 3, fr = lane & 15, fq = lane >> 4;
    int K_ = g.K; asm volatile("" : "+s"(K_));
    const int K = K_, nt = K / BK;
    unsigned voffA[2], voffB[2]; int rA[2]; unsigned cA2[2];
#pragma unroll
    for (int i = 0; i < 2; ++i) { int R, C; stage_rc(tid * 16 + i * 8192, R, C); const int Rb = Epi::PERM ? ((R & ~31) + perm32(R & 31)) : R;
        voffA[i] = (unsigned)(R * K + C) * 2u; voffB[i] = (unsigned)(Rb * K + C) * 2u; rA[i] = R; cA2[i] = (unsigned)C * 2u; }
    unsigned vA[2][2] = {{0u, 0u}, {0u, 0u}}, vN[2][2] = {{0u, 0u}, {0u, 0u}};
#define PG8_GOFF(dst, u_) do { if constexpr (GATHER) { _Pragma("unroll") for (int h_ = 0; h_ < 2; ++h_) _Pragma("unroll") for (int i_ = 0; i_ < 2; ++i_) \
        dst[h_][i_] = (unsigned)g.rowidx[(u_).pm * BM + h_ * HALF + rA[i_]] * (unsigned)(K * 2) + cA2[i_]; } } while (0)
    const size_t kstep = (size_t)(BK * 2);
    const size_t hstep = (size_t)HALF * K * 2;
    const size_t tstep = 2 * hstep;
    const unsigned ldsw = (unsigned)wid * 1024u;
    const int aoff = lds_byte(wr * 64 + fr, fq * 8), boff = lds_byte(wc * 32 + fr, fq * 8);
#define PG8_SA(b, h) (((b) * 2 + (h)) * HTB)
#define PG8_SB(b, h) ((4 + (b) * 2 + (h)) * HTB)
#define PG8_STAGE(bufoff, gbase, voff) do { _Pragma("unroll") for (int _i = 0; _i < 2; ++_i) \
        __builtin_amdgcn_global_load_lds((const unsigned*)((const char*)(gbase) + (voff)[_i]), (PG8_LAS unsigned*)(lds + (bufoff) + ldsw + _i * 8192), 16, 0, 0); } while (0)
#define PG8_STAGE_A(bufoff, gptr, half, nsel) do { if constexpr (GATHER) { unsigned vs_[2]; vs_[0] = (nsel) ? vN[half][0] : vA[half][0]; vs_[1] = (nsel) ? vN[half][1] : vA[half][1]; PG8_STAGE(bufoff, gptr, vs_); } \
        else { PG8_STAGE(bufoff, (gptr) + (half) * hstep, voffA); } } while (0)
#define PG8_LDA(dst, b, h) do { if constexpr (FP8) { _Pragma("unroll") for (int m = 0; m < 4; ++m) dst##8[m] = pg8_cat(*(const PG8_LAS bf16x8*)(lds + PG8_SA(b, h) + aoff + m * 2048), *(const PG8_LAS bf16x8*)(lds + PG8_SA(b, h) + aoff + m * 2048 + 1024)); } else { \
        _Pragma("unroll") for (int m = 0; m < 4; ++m) _Pragma("unroll") for (int k = 0; k < 2; ++k) dst[m][k] = *(const PG8_LAS bf16x8*)(lds + PG8_SA(b, h) + aoff + m * 2048 + k * 1024); } } while (0)
#define PG8_LDB(dst, b, h) do { if constexpr (FP8) { _Pragma("unroll") for (int n = 0; n < 2; ++n) dst##8[n] = pg8_cat(*(const PG8_LAS bf16x8*)(lds + PG8_SB(b, h) + boff + n * 2048), *(const PG8_LAS bf16x8*)(lds + PG8_SB(b, h) + boff + n * 2048 + 1024)); } else { \
        _Pragma("unroll") for (int n = 0; n < 2; ++n) _Pragma("unroll") for (int k = 0; k < 2; ++k) dst[n][k] = *(const PG8_LAS bf16x8*)(lds + PG8_SB(b, h) + boff + n * 2048 + k * 1024); } } while (0)
#define PG8_MMA(ai, bj, At, Bt) do { __builtin_amdgcn_s_setprio(1); if constexpr (FP8) { \
        _Pragma("unroll") for (int m = 0; m < 4; ++m) _Pragma("unroll") for (int n = 0; n < 2; ++n) \
        asm volatile("v_mfma_f32_16x16x128_f8f6f4 %0, %1, %2, %0" : "+v"(acc[ai][bj][m][n]) : "v"(Bt##8[n]), "v"(At##8[m])); } else {     \
        _Pragma("unroll") for (int m = 0; m < 4; ++m) _Pragma("unroll") for (int n = 0; n < 2; ++n) _Pragma("unroll") for (int k = 0; k < 2; ++k) \
        acc[ai][bj][m][n] = __builtin_amdgcn_mfma_f32_16x16x32_bf16(Bt[n][k], At[m][k], acc[ai][bj][m][n], 0, 0, 0); } __builtin_amdgcn_s_setprio(0); } while (0)
#define PG8_WAIT_V(n) asm volatile("s_waitcnt vmcnt(" #n ")" ::: "memory")
#define PG8_WAIT_L(n) asm volatile("s_waitcnt lgkmcnt(" #n ")" ::: "memory")
#define PG8_BAR __builtin_amdgcn_s_barrier()
#define PG8_SCHED __builtin_amdgcn_sched_barrier(0)
    Unit cur, nxt; int ui = 0;
    if (!S.next(0, cur)) return;
    f32x4 acc[2][2][4][2];
#pragma unroll
    for (int a = 0; a < 2; ++a)
#pragma unroll
        for (int b = 0; b < 2; ++b)
#pragma unroll
            for (int m = 0; m < 4; ++m)
#pragma unroll
                for (int n = 0; n < 2; ++n) acc[a][b][m][n] = (f32x4){0.f, 0.f, 0.f, 0.f};
    bf16x8 At[4][2], B0[2][2], B1[2][2]; i32x8_ At8[4], B08[2], B18[2];
    const char* cA = GATHER ? (const char*)g.A : (const char*)(cur.sel ? g.A2 : g.A) + (size_t)cur.pm * tstep; PG8_GOFF(vA, cur); const char* cB = (const char*)(cur.sel ? g.Bt2 : g.Bt) + (size_t)cur.pb * tstep;
    S.a_ready(cur);
    if constexpr (SP2) {
        PG8_STAGE(PG8_SB(0, 0), cB, voffB); PG8_STAGE(PG8_SB(0, 1), cB + hstep, voffB); PG8_STAGE_A(PG8_SA(0, 0), cA, 0, false); PG8_STAGE_A(PG8_SA(0, 1), cA, 1, false);
        if (wr == 1) PG8_BAR;
        PG8_WAIT_V(2); PG8_BAR;
        PG8_STAGE(PG8_SB(1, 0), cB + kstep, voffB); PG8_STAGE_A(PG8_SA(1, 0), cA + kstep, 0, false); PG8_STAGE(PG8_SB(1, 1), cB + hstep + kstep, voffB);
        PG8_WAIT_V(6); PG8_BAR;
    } else {
        PG8_STAGE(PG8_SB(0, 0), cB, voffB); PG8_STAGE_A(PG8_SA(0, 0), cA, 0, false); PG8_STAGE(PG8_SB(0, 1), cB + hstep, voffB); PG8_STAGE_A(PG8_SA(0, 1), cA, 1, false);
        if (wr == 1) PG8_BAR;
        PG8_WAIT_V(4); PG8_BAR;
        PG8_STAGE(PG8_SB(1, 0), cB + kstep, voffB); PG8_STAGE_A(PG8_SA(1, 0), cA + kstep, 0, false); PG8_STAGE(PG8_SB(1, 1), cB + hstep + kstep, voffB);
        PG8_WAIT_V(6); PG8_BAR;
    }
    for (;;) {
        const bool has_next = S.next(ui + 1, nxt);
        if (has_next) PG8_GOFF(vN, nxt); else { if constexpr (GATHER) { vN[0][0] = vA[0][0]; vN[0][1] = vA[0][1]; vN[1][0] = vA[1][0]; vN[1][1] = vA[1][1]; } }
        const char* nA = GATHER ? (const char*)g.A : has_next ? (const char*)(nxt.sel ? g.A2 : g.A) + (size_t)nxt.pm * tstep : cA; const char* nB = has_next ? (const char*)(nxt.sel ? g.Bt2 : g.Bt) + (size_t)nxt.pb * tstep : cB;
#pragma unroll 1
        for (int t = 0; t < nt; t += 2) {
            const bool last = (t == nt - 2);
            const char* a1 = cA + (size_t)(t + 1) * kstep;
            const char* a2 = last ? nA : cA + (size_t)(t + 2) * kstep; const char* b2 = last ? nB : cB + (size_t)(t + 2) * kstep;
            const char* a3 = a2 + kstep; const char* b3 = b2 + kstep;
            if (last && has_next) S.a_ready(nxt);
            if constexpr (SP2) {
            PG8_LDB(B0, 0, 0); PG8_LDB(B1, 0, 1); PG8_SCHED; PG8_LDA(At, 0, 0); PG8_STAGE_A(PG8_SA(1, 1), a1, 1, false);
            PG8_WAIT_V(8); PG8_WAIT_L(0); PG8_BAR; PG8_MMA(0, 0, At, B0); PG8_MMA(0, 1, At, B1); PG8_BAR; PG8_SCHED;
            PG8_LDA(At, 0, 1); PG8_STAGE(PG8_SB(0, 0), b2, voffB); PG8_STAGE(PG8_SB(0, 1), b2 + hstep, voffB); PG8_STAGE_A(PG8_SA(0, 0), a2, 0, last);
            PG8_WAIT_V(8); PG8_WAIT_L(0); PG8_BAR; PG8_MMA(1, 0, At, B0); PG8_MMA(1, 1, At, B1); PG8_BAR; PG8_SCHED;
            PG8_LDB(B0, 1, 0); PG8_LDB(B1, 1, 1); PG8_SCHED; PG8_LDA(At, 1, 0); PG8_STAGE_A(PG8_SA(0, 1), a2, 1, last);
            PG8_WAIT_V(8); PG8_WAIT_L(0); PG8_BAR; PG8_MMA(0, 0, At, B0); PG8_MMA(0, 1, At, B1); PG8_BAR; PG8_SCHED;
            PG8_LDA(At, 1, 1); PG8_STAGE(PG8_SB(1, 0), b3, voffB); PG8_STAGE(PG8_SB(1, 1), b3 + hstep, voffB); PG8_STAGE_A(PG8_SA(1, 0), a3, 0, last);
            PG8_WAIT_V(8); PG8_WAIT_L(0); PG8_BAR; PG8_MMA(1, 0, At, B0); PG8_MMA(1, 1, At, B1); PG8_BAR; PG8_SCHED;
            } else {
            PG8_LDB(B0, 0, 0); PG8_SCHED; PG8_LDA(At, 0, 0); PG8_STAGE_A(PG8_SA(1, 1), a1, 1, false);
            PG8_WAIT_L(8); PG8_BAR; PG8_WAIT_L(0); PG8_MMA(0, 0, At, B0); PG8_BAR; PG8_SCHED;
            PG8_LDB(B1, 0, 1); PG8_STAGE(PG8_SB(0, 0), b2, voffB);
            PG8_BAR; PG8_WAIT_L(0); PG8_MMA(0, 1, At, B1); PG8_BAR;
            PG8_LDA(At, 0, 1); PG8_STAGE_A(PG8_SA(0, 0), a2, 0, last);
            PG8_BAR; PG8_WAIT_L(0); PG8_MMA(1, 0, At, B0); PG8_BAR; PG8_SCHED;
            PG8_STAGE(PG8_SB(0, 1), b2 + hstep, voffB);
            PG8_WAIT_V(6); PG8_BAR; PG8_MMA(1, 1, At, B1); PG8_BAR;
            PG8_LDB(B0, 1, 0); PG8_SCHED; PG8_LDA(At, 1, 0); PG8_STAGE_A(PG8_SA(0, 1), a2, 1, last);
            PG8_WAIT_L(8); PG8_BAR; PG8_WAIT_L(0); PG8_MMA(0, 0, At, B0); PG8_BAR; PG8_SCHED;
            PG8_LDB(B1, 1, 1); PG8_STAGE(PG8_SB(1, 0), b3, voffB);
            PG8_BAR; PG8_WAIT_L(0); PG8_MMA(0, 1, At, B1); PG8_BAR;
            PG8_LDA(At, 1, 1); PG8_STAGE_A(PG8_SA(1, 0), a3, 0, last);
            PG8_BAR; PG8_WAIT_L(0); PG8_MMA(1, 0, At, B0); PG8_BAR; PG8_SCHED;
            PG8_STAGE(PG8_SB(1, 1), b3 + hstep, voffB);
            PG8_WAIT_V(6); PG8_BAR; PG8_MMA(1, 1, At, B1); PG8_BAR;
            }
        }
        if constexpr (FP8) asm volatile("s_nop 15\n\ts_nop 7" ::: "memory");
        if constexpr (ALIGN_EPI) { if (wr == 0) PG8_BAR; }
        bool fin = true; if constexpr (Epi::CHAIN) fin = (cur.sel != 0);
        if constexpr (!Epi::AFTER_DRAIN) { if (fin) E(acc, cur, wr, wc, fr, fq); else { if constexpr (Epi::CHAIN) E.mid(acc, cur, wr, wc, fr, fq); } S.done(cur); }
        if (!has_next) break;
        if (fin)
#pragma unroll
        for (int a = 0; a < 2; ++a)
#pragma unroll
            for (int b = 0; b < 2; ++b)
#pragma unroll
                for (int m = 0; m < 4; ++m)
#pragma unroll
                    for (int n = 0; n < 2; ++n) acc[a][b][m][n] = (f32x4){0.f, 0.f, 0.f, 0.f};
        cur = nxt; cA = nA; cB = nB; ++ui;
        if constexpr (GATHER) { vA[0][0] = vN[0][0]; vA[0][1] = vN[0][1]; vA[1][0] = vN[1][0]; vA[1][1] = vN[1][1]; }
        if constexpr (ALIGN_EPI) { if (wr == 1) PG8_BAR; }
    }
    PG8_WAIT_V(0);
    if constexpr (!ALIGN_EPI) { if (wr == 0) PG8_BAR; }
    PG8_BAR;
    if constexpr (Epi::AFTER_DRAIN) { E.fused(acc, cur, wr, wc, fr, fq, lds, wid, lane); S.done(cur); }
#undef PG8_SA
#undef PG8_STAGE_A
#undef PG8_GOFF
#undef PG8_SB
#undef PG8_STAGE
#undef PG8_LDA
#undef PG8_LDB
#undef PG8_MMA
#undef PG8_WAIT_V
#undef PG8_WAIT_L
#undef PG8_BAR
#undef PG8_SCHED
}
}

#include <hip/hip_bf16.h>
#include <cmath>

namespace attn_body {
using bf16=__hip_bfloat16;
using bf16x8=__attribute__((ext_vector_type(8)))short;
using s16x4=__attribute__((ext_vector_type(4)))short;
using f32x16=__attribute__((ext_vector_type(16)))float;
using u32x4=__attribute__((ext_vector_type(4)))unsigned;
constexpr int NHEAD=8,SEQ=16384,D=64,DMQ=NHEAD*D,DMK=2*D;
constexpr int NW=8,QBLK=32,QB=QBLK*NW,KVBLK=64,NQB=SEQ/QB;
constexpr int ATTN_UNIT_ROWS=QB;
__device__ __forceinline__ int crow(int r,int hi){return (r&3)+8*(r>>2)+4*hi;}
#define SBAR() __builtin_amdgcn_sched_barrier(0)
__device__ __forceinline__ void cmask(f32x16&p0,f32x16&p1,int jb,int qrel,int hi){
  const float NEG=-INFINITY; int kb=64*jb+4*hi;
  #pragma unroll
  for(int r=0;r<16;++r){int kv=kb+(r&3)+8*(r>>2); if(kv>qrel)p0[r]=NEG; if(kv+32>qrel)p1[r]=NEG;}
}

constexpr int NSLOT=3, SLOTB=8192;
constexpr int LDS_K=0, LDS_V=NSLOT*SLOTB, LDS_WS=2*NSLOT*SLOTB, LDS_OST=LDS_WS+NW*64*4, LDS_BYTES=LDS_OST+NW*4096;
constexpr float C2=0.125f*1.4426950408889634f;
__device__ __forceinline__ void glds16(const void*gsrc,unsigned lds_dst){unsigned keep;
  asm volatile("s_mov_b32 %0, m0\n\ts_mov_b32 m0, %2\n\ts_nop 0\n\tglobal_load_lds_dwordx4 %1, off\n\ts_mov_b32 m0, %0":"=&s"(keep):"v"(gsrc),"s"(lds_dst):"memory");}
__device__ __forceinline__ float max3f(float a,float b,float c){float r;asm("v_max3_f32 %0, %1, %2, %3":"=v"(r):"v"(a),"v"(b),"v"(c));return r;}
__device__ __forceinline__ float max2f(float a,float b){float r;asm("v_max_f32_e32 %0, %1, %2":"=v"(r):"v"(a),"v"(b));return r;}
__device__ __forceinline__ float fadd_s(float a,float b){float r;asm("v_add_f32_e32 %0, %1, %2":"=v"(r):"v"(a),"v"(b));return r;}
__device__ __forceinline__ float fsub_s(float a,float b){float r;asm("v_sub_f32_e32 %0, %1, %2":"=v"(r):"v"(a),"v"(b));return r;}
typedef float f32x2_t __attribute__((ext_vector_type(2))); typedef __bf16 bf16x2_t __attribute__((ext_vector_type(2)));
__device__ __forceinline__ unsigned cvtpk_s(float lo,float hi){f32x2_t v={lo,hi};bf16x2_t b=__builtin_convertvector(v,bf16x2_t);return __builtin_bit_cast(unsigned,b);}
#define WAIT_BAR(N) asm volatile("s_waitcnt vmcnt(" #N ") lgkmcnt(0)\n\ts_barrier":::"memory")

__device__ __forceinline__ void qkt(f32x16&p0,f32x16&p1,const char*Kslot,const bf16x8*qr,const f32x16&negm,int r32,int hi){
  const char*kb=Kslot+hi*1024+r32*16;
  #pragma unroll
  for(int d0=0;d0<4;++d0){
    const bf16x8 b0=*reinterpret_cast<const bf16x8*>(kb+d0*2048);
    const bf16x8 b1=*reinterpret_cast<const bf16x8*>(kb+d0*2048+512);
    if(d0==0){p0=__builtin_amdgcn_mfma_f32_32x32x16_bf16(b0,qr[0],negm,0,0,0);p1=__builtin_amdgcn_mfma_f32_32x32x16_bf16(b1,qr[0],negm,0,0,0);}
    else{p0=__builtin_amdgcn_mfma_f32_32x32x16_bf16(b0,qr[d0],p0,0,0,0);p1=__builtin_amdgcn_mfma_f32_32x32x16_bf16(b1,qr[d0],p1,0,0,0);}}
}
typedef __attribute__((address_space(3))) const char* lds_cptr;
typedef short v4i16_t __attribute__((ext_vector_type(4)));
__device__ __forceinline__ void kload8(bf16x8*kf,lds_cptr kp){
  kf[0]=*(const __attribute__((address_space(3))) bf16x8*)(kp);      kf[1]=*(const __attribute__((address_space(3))) bf16x8*)(kp+512);
  kf[2]=*(const __attribute__((address_space(3))) bf16x8*)(kp+2048); kf[3]=*(const __attribute__((address_space(3))) bf16x8*)(kp+2560);
  kf[4]=*(const __attribute__((address_space(3))) bf16x8*)(kp+4096); kf[5]=*(const __attribute__((address_space(3))) bf16x8*)(kp+4608);
  kf[6]=*(const __attribute__((address_space(3))) bf16x8*)(kp+6144); kf[7]=*(const __attribute__((address_space(3))) bf16x8*)(kp+6656);
}
__device__ __forceinline__ void kload2(bf16x8*kf,lds_cptr kp,int j){ kf[2*j]=*(const __attribute__((address_space(3))) bf16x8*)(kp+j*2048); kf[2*j+1]=*(const __attribute__((address_space(3))) bf16x8*)(kp+j*2048+512); }
__device__ __forceinline__ s16x4 vtr(lds_cptr p){ return __builtin_bit_cast(s16x4,__builtin_amdgcn_ds_read_tr16_b64_v4i16((__attribute__((address_space(3))) v4i16_t*)p)); }
__device__ __forceinline__ float rowmax(const f32x16&p0,const f32x16&p1){
  float a=max3f(p0[0],p0[1],p1[0]),b=max3f(p0[2],p0[3],p1[1]);a=max3f(a,p1[2],p1[3]);
  #pragma unroll
  for(int r=4;r<16;r+=4){a=max3f(a,p0[r],p0[r+1]);b=max3f(b,p0[r+2],p0[r+3]);a=max3f(a,p1[r],p1[r+1]);b=max3f(b,p1[r+2],p1[r+3]);}
  const float m=max2f(a,b);
  auto rr=__builtin_amdgcn_permlane32_swap(__float_as_uint(m),__float_as_uint(m),false,false);
  return max2f(__uint_as_float(rr[0]),__uint_as_float(rr[1]));
}
__device__ __forceinline__ void pv(f32x16*o,int vb,bf16x8 pa0,bf16x8 pa1,bf16x8 pa2,bf16x8 pa3){
  #pragma unroll
  for(int d0=0;d0<2;++d0){s16x4 lo[4],hi[4];
    #pragma unroll
    for(int ks=0;ks<4;++ks){
      asm volatile("ds_read_b64_tr_b16 %0,%1 offset:%c2":"=&v"(lo[ks]):"v"(vb),"i"(d0*4096+ks*1024):"memory");
      asm volatile("ds_read_b64_tr_b16 %0,%1 offset:%c2":"=&v"(hi[ks]):"v"(vb),"i"(d0*4096+ks*1024+512):"memory");}
    asm volatile("s_waitcnt lgkmcnt(0)":::"memory");SBAR();
    #define PK(k) (bf16x8){lo[k][0],lo[k][1],lo[k][2],lo[k][3],hi[k][0],hi[k][1],hi[k][2],hi[k][3]}
    o[d0]=__builtin_amdgcn_mfma_f32_32x32x16_bf16(pa0,PK(0),o[d0],0,0,0);
    o[d0]=__builtin_amdgcn_mfma_f32_32x32x16_bf16(pa1,PK(1),o[d0],0,0,0);
    o[d0]=__builtin_amdgcn_mfma_f32_32x32x16_bf16(pa2,PK(2),o[d0],0,0,0);
    o[d0]=__builtin_amdgcn_mfma_f32_32x32x16_bf16(pa3,PK(3),o[d0],0,0,0);
    #undef PK
  }
}

#ifndef ATTN_STORE16
#define ATTN_STORE16(p,v) (*(u32x4*)(p)=(v))
#endif
template<int THRL> __device__ __forceinline__ void attn_unit(int b,int h,int qb,const bf16*Q,const bf16*__restrict__ K,const bf16*__restrict__ V,bf16*O,char*shm,int wave_,float negM){
  const int tid_=wave_*64+lane_id_opaque();
  const int tid=tid_,lane=tid&63,r32=lane&31,hi=lane>>5; const int wid=__builtin_amdgcn_readfirstlane(tid>>6);
  const long rowbase=0; const int q0=qb*QB; (void)b;
  const bf16*Qw=Q+(rowbase+q0+wid*QBLK)*DMQ+h*D;
  const bf16*Kh=K+(h>>2)*D,*Vh=V+(h>>2)*D;
  const unsigned lds0=(unsigned)(uintptr_t)shm;
  float*wsf=(float*)(shm+LDS_WS)+wid*64;
  const bf16*ksrc=Kh+(long)lane*DMK+wid*8;
  const bf16*vsrc=Vh+(long)(16*(wid&3)+(lane>>2))*DMK+(wid>>2)*32+(lane&3)*8;
  const unsigned kdst=lds0+LDS_K+wid*1024, vdst=lds0+LDS_V+wid*1024;
  #define DMA_K(t,slot) glds16(ksrc+(long)(t)*KVBLK*DMK,(unsigned)__builtin_amdgcn_readfirstlane(kdst+(slot)))
  #define DMA_V(t,slot) glds16(vsrc+(long)(t)*KVBLK*DMK,(unsigned)__builtin_amdgcn_readfirstlane(vdst+(slot)))
  const int vb0=(int)(lds0+LDS_V)+((lane>>4)&1)*32+(lane&3)*8+(4*hi+((lane&15)>>2))*64;
  const char*Kbase=shm+LDS_K; bf16x8 kf[8];
  const lds_cptr shm3=(lds_cptr)shm; const lds_cptr kp0=shm3+LDS_K+hi*1024+r32*16; const lds_cptr vp0=shm3+LDS_V+((lane>>4)&1)*32+(lane&3)*8+(4*hi+((lane&15)>>2))*64;
  const int NT=SEQ/KVBLK;
  DMA_K(0,0);DMA_V(0,0);DMA_K(1,SLOTB);
  bf16x8 qr[4];
  #pragma unroll
  for(int d0=0;d0<4;++d0)qr[d0]=*reinterpret_cast<const bf16x8*>(&Qw[(long)r32*DMQ+d0*16+hi*8]);
  float l_reg=0.f;f32x16 o[2];o[0]=f32x16{};o[1]=f32x16{};f32x16 negm;
  #pragma unroll
  for(int r=0;r<16;++r)negm[r]=negM;
  asm volatile("":"+v"(negm));
  const int qrel=wid*QBLK+r32; (void)qrel;
  #define CMASK(P0,P1,t) do{}while(0)
  #define START(P0,P1) do{ _Pragma("unroll") for(int r=0;r<16;++r)P0[r]=__builtin_amdgcn_exp2f(P0[r]); }while(0)
  #define RESC() do{}while(0)
  f32x16 pA0,pA1,pB0,pB1;
  int sl_prev=0,sl_cur=0,sl_next=SLOTB;
  #define ROT() do{sl_prev=sl_cur;sl_cur=sl_next;sl_next=(sl_next==(NSLOT-1)*SLOTB)?0:sl_next+SLOTB;}while(0)
  DMA_K(2,2*SLOTB);
  WAIT_BAR(3);
  qkt(pA0,pA1,Kbase,qr,negm,r32,hi);asm volatile("s_nop 15\n\ts_nop 7":"+v"(pA0),"+v"(pA1));CMASK(pA0,pA1,0);
  START(pA0,pA1);
  _Pragma("unroll") for(int r=0;r<16;++r)pA1[r]=__builtin_amdgcn_exp2f(pA1[r]);
  WAIT_BAR(0);
  DMA_K(3,0);DMA_V(1,SLOTB);
  ROT();
  kload8(kf,kp0+sl_cur);
  WAIT_BAR(2);
  s16x4 vlo[8],vhi[8]; u32x4 pw0,pw1,pw2,pw3;
  #define PKW(P,B) cvtpk_s(P[B],P[B+1])
  #define PAF(k) __builtin_bit_cast(bf16x8,pw##k)
  #define VFR(i) (bf16x8){vlo[i][0],vlo[i][1],vlo[i][2],vlo[i][3],vhi[i][0],vhi[i][1],vhi[i][2],vhi[i][3]}
  #define PIN(x) asm volatile("":"+v"(x))
  #define MX3(a,b,c) __builtin_fmaxf(__builtin_fmaxf((a),(b)),(c))
  #define GAPA(MF,A0,A1,A2,A3,W0,W1,PW) do{ MF; sacc+=A0; sacc+=A1; sacc+=A2; sacc+=A3; PIN(sacc); W0; W1; PIN(PW); SBAR(); }while(0)
  #define EX(v) __builtin_amdgcn_exp2f(v)
  #define GAPB(MF,X,B) do{ MF; X[B]=EX(X[B]); X[B+1]=EX(X[B+1]); X[B+2]=EX(X[B+2]); X[B+3]=EX(X[B+3]); PIN(X); SBAR(); }while(0)
  #define VRD(i) do{ vlo[i]=vtr(vp_+(((i)>>2)*4096+((i)&3)*1024)); vhi[i]=vtr(vp_+(((i)>>2)*4096+((i)&3)*1024+512)); }while(0)
  #define KRD(G,j) do{ if(G){ kload2(kf,kp0+sl_next,j); SBAR(); } }while(0)
  #define STEP(C0,C1,P0,P1,t,GK,GV,GL) do{ SBAR(); \
    const lds_cptr vp_=vp0+sl_prev; \
    VRD(0); SBAR(); float sacc=(P0[0]+P0[1]); \
    GAPA(C0=__builtin_amdgcn_mfma_f32_32x32x16_bf16(kf[0],qr[0],negm,0,0,0), P0[2],P0[3],P0[4],P0[5],     pw0[0]=PKW(P0,0), pw0[1]=PKW(P0,2), pw0); \
    VRD(4); SBAR(); GAPA(C1=__builtin_amdgcn_mfma_f32_32x32x16_bf16(kf[1],qr[0],negm,0,0,0), P0[6],P0[7],P0[8],P0[9],     pw0[2]=PKW(P0,4), pw0[3]=PKW(P0,6), pw0); \
    VRD(1); SBAR(); GAPA(C0=__builtin_amdgcn_mfma_f32_32x32x16_bf16(kf[2],qr[1],C0,0,0,0),   P0[10],P0[11],P0[12],P0[13], pw1[0]=PKW(P0,8), pw1[1]=PKW(P0,10), pw1); \
    VRD(5); SBAR(); GAPA(C1=__builtin_amdgcn_mfma_f32_32x32x16_bf16(kf[3],qr[1],C1,0,0,0),   P0[14],P0[15],P1[0],P1[1],   pw1[2]=PKW(P0,12),pw1[3]=PKW(P0,14), pw1); \
    VRD(2); SBAR(); GAPA(C0=__builtin_amdgcn_mfma_f32_32x32x16_bf16(kf[4],qr[2],C0,0,0,0),   P1[2],P1[3],P1[4],P1[5],     pw2[0]=PKW(P1,0), pw2[1]=PKW(P1,2), pw2); \
    VRD(6); SBAR(); GAPA(C1=__builtin_amdgcn_mfma_f32_32x32x16_bf16(kf[5],qr[2],C1,0,0,0),   P1[6],P1[7],P1[8],P1[9],     pw2[2]=PKW(P1,4), pw2[3]=PKW(P1,6), pw2); \
    VRD(3); SBAR(); GAPA(C0=__builtin_amdgcn_mfma_f32_32x32x16_bf16(kf[6],qr[3],C0,0,0,0),   P1[10],P1[11],P1[12],P1[13], pw3[0]=PKW(P1,8), pw3[1]=PKW(P1,10), pw3); \
    VRD(7); SBAR(); GAPA(C1=__builtin_amdgcn_mfma_f32_32x32x16_bf16(kf[7],qr[3],C1,0,0,0),   P1[14],P1[15],0.f,0.f,       pw3[2]=PKW(P1,12),pw3[3]=PKW(P1,14), pw3); \
    l_reg+=sacc; \
    if(GK){DMA_K((t)+3,sl_cur);} if(GV){DMA_V((t)+1,sl_next);} \
    CMASK(C0,C1,t); \
    SBAR(); \
    GAPB(o[0]=__builtin_amdgcn_mfma_f32_32x32x16_bf16(PAF(0),VFR(0),o[0],0,0,0), C0,0); \
    GAPB(o[1]=__builtin_amdgcn_mfma_f32_32x32x16_bf16(PAF(0),VFR(4),o[1],0,0,0), C0,4); \
    KRD(GL,0); GAPB(o[0]=__builtin_amdgcn_mfma_f32_32x32x16_bf16(PAF(1),VFR(1),o[0],0,0,0), C0,8); \
    KRD(GL,1); GAPB(o[1]=__builtin_amdgcn_mfma_f32_32x32x16_bf16(PAF(1),VFR(5),o[1],0,0,0), C0,12); \
    KRD(GL,2); GAPB(o[0]=__builtin_amdgcn_mfma_f32_32x32x16_bf16(PAF(2),VFR(2),o[0],0,0,0), C1,0); \
    KRD(GL,3); GAPB(o[1]=__builtin_amdgcn_mfma_f32_32x32x16_bf16(PAF(2),VFR(6),o[1],0,0,0), C1,4); \
    GAPB(o[0]=__builtin_amdgcn_mfma_f32_32x32x16_bf16(PAF(3),VFR(3),o[0],0,0,0), C1,8); \
    GAPB(o[1]=__builtin_amdgcn_mfma_f32_32x32x16_bf16(PAF(3),VFR(7),o[1],0,0,0), C1,12); \
    }while(0)
  int t=1;
  #undef CMASK
  #define CMASK(P0,P1,t) do{}while(0)
  for(;t+5<NT;t+=2){
    STEP(pB0,pB1,pA0,pA1,t,true,true,true);     WAIT_BAR(2); RESC(); ROT();
    STEP(pA0,pA1,pB0,pB1,t+1,true,true,true);   WAIT_BAR(2); RESC(); ROT();
  }
  #undef CMASK
  #define CMASK(P0,P1,t) do{}while(0)
  #define ENDW(tt) do{ if((tt)+3<NT){WAIT_BAR(2);} else if((tt)+2<NT){WAIT_BAR(1);} else {WAIT_BAR(0);} }while(0)
  for(;t+1<NT;t+=2){
    STEP(pB0,pB1,pA0,pA1,t,(t+3<NT),(t+1<NT),(t+1<NT));       ENDW(t);   RESC(); ROT();
    STEP(pA0,pA1,pB0,pB1,t+1,(t+4<NT),(t+2<NT),(t+2<NT));     ENDW(t+1); RESC(); ROT();
  }
  STEP(pB0,pB1,pA0,pA1,NT-1,false,false,false); RESC();
  { float sacc=pB0[0]+pB0[1]; _Pragma("unroll") for(int r=2;r<16;++r)sacc+=pB0[r]; _Pragma("unroll") for(int r=0;r<16;++r)sacc+=pB1[r]; l_reg+=sacc;
    pw0=(u32x4){PKW(pB0,0),PKW(pB0,2),PKW(pB0,4),PKW(pB0,6)};pw1=(u32x4){PKW(pB0,8),PKW(pB0,10),PKW(pB0,12),PKW(pB0,14)};pw2=(u32x4){PKW(pB1,0),PKW(pB1,2),PKW(pB1,4),PKW(pB1,6)};pw3=(u32x4){PKW(pB1,8),PKW(pB1,10),PKW(pB1,12),PKW(pB1,14)};
    SBAR(); pv(o,vb0+sl_cur,PAF(0),PAF(1),PAF(2),PAF(3)); }
  #undef PKW
  #undef PAF
  #undef VFR
  #undef PIN
  #undef MX3
  #undef GAPA
  #undef GAPB
  #undef EX
  #undef VRD
  #undef KRD
  #undef STEP
  #undef ENDW
  {auto rr=__builtin_amdgcn_permlane32_swap(__float_as_uint(l_reg),__float_as_uint(l_reg),false,false);l_reg=__uint_as_float(rr[0])+__uint_as_float(rr[1]);}
  if(hi==0)wsf[32+r32]=l_reg;asm volatile("s_waitcnt lgkmcnt(0)":::"memory");
  float rli[16];
  #pragma unroll
  for(int r=0;r<16;++r)rli[r]=__builtin_amdgcn_rcpf(wsf[32+crow(r,hi)]);
  bf16*Ow=O+(rowbase+q0+wid*QBLK)*DMQ+h*D;
  { bf16*stg=(bf16*)(shm+LDS_OST)+wid*2048;
    #pragma unroll
    for(int r=0;r<16;++r){const int orow=crow(r,hi);
      #pragma unroll
      for(int d0=0;d0<2;++d0)stg[orow*64+d0*32+r32]=__float2bfloat16(o[d0][r]*rli[r]);}
    asm volatile("s_waitcnt lgkmcnt(0)":::"memory");
    #pragma unroll
    for(int i=0;i<4;++i){const int row=i*8+(lane>>3),ch=lane&7; const u32x4 v=*(const u32x4*)(stg+row*64+ch*8); ATTN_STORE16(Ow+(long)row*DMQ+ch*8,v);} }
  asm volatile("s_waitcnt lgkmcnt(0)\n\ts_barrier":::"memory");
  #undef DMA_K
  #undef DMA_V
  #undef CMASK
  #undef START
  #undef RESC
  #undef ROT
}
constexpr int ATTN_LDS_BYTES=LDS_BYTES;
struct AttnTensors { const bf16* Q; const bf16* K; const bf16* V; bf16* O; };
struct AttnUnit { int bh; int qb; };
struct StaticOrder {
  int vcu, G;
  __device__ __forceinline__ explicit StaticOrder(int grid,int block):vcu((grid%8==0)?(block%8)*(grid/8)+block/8:block),G(grid){}
  __device__ __forceinline__ bool next(int i,AttnUnit&u)const{ constexpr int NU=NHEAD*NQB; int uu; if(NU%G==0){ const int per=NU/G; if(i>=per)return false; uu=vcu*per+i; } else { uu=i*G+vcu; if(uu>=NU)return false; } u.bh=uu/NQB; u.qb=uu%NQB; return true; }
  __device__ __forceinline__ void a_ready(const AttnUnit&)const{}
  __device__ __forceinline__ void done(const AttnUnit&)const{}
};
template<class Sched,int THRL=8> __device__ __forceinline__ void attn_phase(char*lds,const AttnTensors&T,const Sched&S,int wave_,float negM){
  AttnUnit u;
  for(int i=0;S.next(i,u);++i){ S.a_ready(u); attn_unit<THRL>(0,u.bh,u.qb,T.Q,T.K,T.V,T.O,lds,wave_,negM); S.done(u); }
}
#undef SBAR
#undef WAIT_BAR
}

namespace hg {
typedef short bf16x8 __attribute__((ext_vector_type(8)));
typedef short s16x4 __attribute__((ext_vector_type(4)));
constexpr int CH = 32, SEGT = 512, NSEG = S / SEGT, NCH = SEGT / CH;
constexpr int RS = 272, TS = 80;
constexpr int QOFF = 0, KOFF = 32 * RS, KTOFF = 2 * 32 * RS, VTOFF = KTOFF + 128 * TS, DOFF = VTOFF + 128 * TS, GOFF = DOFF + 512, BUFB = GOFF + 4096;
static_assert(2 * BUFB <= 131072, "hgrn LDS");
#define HG_MFMA(a, b, c) __builtin_amdgcn_mfma_f32_16x16x32_bf16((a), (b), (c), 0, 0, 0)
__device__ __forceinline__ unsigned pkbf(float lo, float hi) { typedef float f2 __attribute__((ext_vector_type(2))); typedef __bf16 b2 __attribute__((ext_vector_type(2))); f2 v = {lo, hi}; b2 b = __builtin_convertvector(v, b2); return __builtin_bit_cast(unsigned, b); }

typedef float f32x2h __attribute__((ext_vector_type(2)));
template <bool OUT>
__device__ __forceinline__ void chunk_matrix(LAS unsigned char* B, f32x4 (&Sacc)[8], int c16, int g, int e0, int dir, int h, int p0c, float* __restrict__ OF) {
    if (OUT) {
        f32x4 X00 = {0.f, 0.f, 0.f, 0.f}, X01 = X00, X11 = X00;
#pragma unroll
        for (int s = 0; s < 4; ++s) {
            const bf16x8 aK0 = *(const LAS bf16x8*)(B + KOFF + c16 * RS + (32 * s + 8 * g) * 2), aK1 = *(const LAS bf16x8*)(B + KOFF + (16 + c16) * RS + (32 * s + 8 * g) * 2);
            const bf16x8 bQ0 = *(const LAS bf16x8*)(B + QOFF + c16 * RS + (32 * s + 8 * g) * 2), bQ1 = *(const LAS bf16x8*)(B + QOFF + (16 + c16) * RS + (32 * s + 8 * g) * 2);
            X00 = HG_MFMA(aK0, bQ0, X00); X01 = HG_MFMA(aK0, bQ1, X01); X11 = HG_MFMA(aK1, bQ1, X11);
        }
#pragma unroll
        for (int r = 0; r < 4; ++r) { const bool keep = (4 * g + r) <= c16; X00[r] = keep ? X00[r] : 0.f; X11[r] = keep ? X11[r] : 0.f; }
        u32x4 a0w, a1w; a0w.x = pkbf(X00[0], X00[1]); a0w.y = pkbf(X00[2], X00[3]); a0w.z = 0u; a0w.w = 0u;
        a1w.x = pkbf(X01[0], X01[1]); a1w.y = pkbf(X01[2], X01[3]); a1w.z = pkbf(X11[0], X11[1]); a1w.w = pkbf(X11[2], X11[3]);
        const u32x2 vlo = *(const LAS u32x2*)(B + VTOFF + (e0 + c16) * TS + (4 * g) * 2), vhi = *(const LAS u32x2*)(B + VTOFF + (e0 + c16) * TS + (16 + 4 * g) * 2);
        u32x4 vbw; vbw.x = vlo.x; vbw.y = vlo.y; vbw.z = vhi.x; vbw.w = vhi.y;
        const bf16x8 vb = __builtin_bit_cast(bf16x8, vbw);
        f32x4 O0 = {0.f, 0.f, 0.f, 0.f}, O1 = O0;
        O0 = HG_MFMA(__builtin_bit_cast(bf16x8, a0w), vb, O0); O1 = HG_MFMA(__builtin_bit_cast(bf16x8, a1w), vb, O1);
#pragma unroll
        for (int s = 0; s < 4; ++s) {
            u32x4 sw; sw.x = pkbf(Sacc[2 * s][0], Sacc[2 * s][1]); sw.y = pkbf(Sacc[2 * s][2], Sacc[2 * s][3]); sw.z = pkbf(Sacc[2 * s + 1][0], Sacc[2 * s + 1][1]); sw.w = pkbf(Sacc[2 * s + 1][2], Sacc[2 * s + 1][3]);
            const bf16x8 sb = __builtin_bit_cast(bf16x8, sw);
            const u32x2 q0l = *(const LAS u32x2*)(B + QOFF + c16 * RS + (32 * s + 4 * g) * 2), q0h = *(const LAS u32x2*)(B + QOFF + c16 * RS + (32 * s + 16 + 4 * g) * 2);
            const u32x2 q1l = *(const LAS u32x2*)(B + QOFF + (16 + c16) * RS + (32 * s + 4 * g) * 2), q1h = *(const LAS u32x2*)(B + QOFF + (16 + c16) * RS + (32 * s + 16 + 4 * g) * 2);
            u32x4 q0w, q1w; q0w.x = q0l.x; q0w.y = q0l.y; q0w.z = q0h.x; q0w.w = q0h.y; q1w.x = q1l.x; q1w.y = q1l.y; q1w.z = q1h.x; q1w.w = q1h.y;
            O0 = HG_MFMA(__builtin_bit_cast(bf16x8, q0w), sb, O0); O1 = HG_MFMA(__builtin_bit_cast(bf16x8, q1w), sb, O1);
        }
#pragma unroll
        for (int r = 0; r < 4; ++r) {
            const int p0 = p0c + 4 * g + r, p1 = p0 + 16;
            const int t0 = dir ? (S - 1 - p0) : p0, t1 = dir ? (S - 1 - p1) : p1;
            OF[((size_t)dir * S + t0) * 512 + h * 128 + e0 + c16] = O0[r];
            OF[((size_t)dir * S + t1) * 512 + h * 128 + e0 + c16] = O1[r];
        }
    }
    {
        const bf16x8 vB = *(const LAS bf16x8*)(B + VTOFF + (e0 + c16) * TS + (8 * g) * 2);
#pragma unroll
        for (int dt = 0; dt < 8; ++dt) {
            const bf16x8 aT = *(const LAS bf16x8*)(B + KTOFF + (16 * dt + c16) * TS + (8 * g) * 2);
            Sacc[dt] = HG_MFMA(aT, vB, Sacc[dt]);
            const f32x4 dv = *(const LAS f32x4*)(B + DOFF + (16 * dt + 4 * g) * 4);
            Sacc[dt] = Sacc[dt] * dv;
        }
    }
}
template <bool OUT>
__device__ __forceinline__ void segment(LAS unsigned char* lds, int unit, const bf16_t* __restrict__ HQ, const float* __restrict__ LF, const bf16_t* __restrict__ KF,
                                        const bf16_t* __restrict__ HV, float* __restrict__ HST, float* __restrict__ HSD, float* __restrict__ OF, int wave_) {
    const int tid_ = wave_ * 64 + lane_id_opaque();
    const int tid = tid_, lane = tid & 63, w = __builtin_amdgcn_readfirstlane(tid >> 6), c16 = lane & 15, g = lane >> 4;
    const int dir = unit >> 7, h = (unit >> 5) & 3, seg = unit & 31;
    const int d0 = 2 * (tid & 63), tg = tid >> 6;
    const size_t cb = (size_t)h * 128 + d0;
    const float* lf = LF + (size_t)dir * S * 512 + cb;
    const bf16_t* kf = KF + (size_t)dir * S * 512 + cb;
    const bf16_t* hq = HQ + cb; const bf16_t* hv = HV + cb;
    f32x4 Sacc[8];
    float* hst = HST + (size_t)unit * 16384 + (size_t)w * 2048 + lane;
    if (OUT) {
#pragma unroll
        for (int dt = 0; dt < 8; ++dt) { Sacc[dt][0] = hst[(dt * 4 + 0) * 64]; Sacc[dt][1] = hst[(dt * 4 + 1) * 64]; Sacc[dt][2] = hst[(dt * 4 + 2) * 64]; Sacc[dt][3] = hst[(dt * 4 + 3) * 64]; }
    } else {
#pragma unroll
        for (int dt = 0; dt < 8; ++dt) Sacc[dt] = f32x4{0.f, 0.f, 0.f, 0.f};
    }
    f32x2h segsum = {0.f, 0.f};
    const int e0 = 16 * w;
    constexpr int RING = 2;
    f32x2h rl[RING][4]; unsigned rk[RING][4], rq[RING][4], rv[RING][4];
#define HG_LOAD(sl, cc) do { _Pragma("unroll") for (int jj = 0; jj < 4; ++jj) { \
        const int p_ = seg * SEGT + (cc) * CH + 4 * tg + jj, t_ = dir ? (S - 1 - p_) : p_; \
        rl[sl][jj] = *(const f32x2h*)(lf + (size_t)t_ * 512); rk[sl][jj] = *(const unsigned*)(kf + (size_t)t_ * 512); rv[sl][jj] = *(const unsigned*)(hv + (size_t)t_ * 512); \
        rq[sl][jj] = OUT ? *(const unsigned*)(hq + (size_t)t_ * 512) : 0u; } } while (0)
#pragma unroll
    for (int sl = 0; sl < RING; ++sl) HG_LOAD(sl, sl);
    for (int c4 = 0; c4 < NCH; c4 += RING) {
#pragma unroll
        for (int sl = 0; sl < RING; ++sl) {
            const int c = c4 + sl;
            LAS unsigned char* B = lds + (c & 1) * BUFB;
            f32x2h cs[4]; unsigned kk[4], qq[4], vv[4];
#pragma unroll
            for (int jj = 0; jj < 4; ++jj) { cs[jj] = rl[sl][jj]; kk[jj] = rk[sl][jj]; qq[jj] = rq[sl][jj]; vv[jj] = rv[sl][jj]; }
            if (c + RING < NCH) HG_LOAD(sl, c + RING);
#pragma unroll
            for (int jj = 1; jj < 4; ++jj) cs[jj] += cs[jj - 1];
            LAS float* gs = (LAS float*)(B + GOFF);
            *(LAS f32x2h*)(gs + tg * 128 + d0) = cs[3];
            __syncthreads();
            f32x2h off = {0.f, 0.f}, tot = {0.f, 0.f};
#pragma unroll
            for (int q = 0; q < 8; ++q) { const f32x2h gq = *(const LAS f32x2h*)(gs + q * 128 + d0); tot += gq; if (q < tg) off += gq; }
            float kt0[4], kt1[4];
#pragma unroll
            for (int jj = 0; jj < 4; ++jj) {
                const float b0 = fmaxf(off.x + cs[jj].x, -80.f), b1 = fmaxf(off.y + cs[jj].y, -80.f);
                kt0[jj] = bflo(kk[jj]) * __expf(-b0); kt1[jj] = bfhi(kk[jj]) * __expf(-b1);
                if (OUT) {
                    *(LAS unsigned*)(B + QOFF + (4 * tg + jj) * RS + d0 * 2) = pkbf(bflo(qq[jj]) * __expf(b0), bfhi(qq[jj]) * __expf(b1));
                    *(LAS unsigned*)(B + KOFF + (4 * tg + jj) * RS + d0 * 2) = pkbf(kt0[jj], kt1[jj]);
                }
            }
            { u32x2 o0, o1; o0.x = pkbf(kt0[0], kt0[1]); o0.y = pkbf(kt0[2], kt0[3]); o1.x = pkbf(kt1[0], kt1[1]); o1.y = pkbf(kt1[2], kt1[3]);
              *(LAS u32x2*)(B + KTOFF + d0 * TS + 8 * tg) = o0; *(LAS u32x2*)(B + KTOFF + (d0 + 1) * TS + 8 * tg) = o1;
              u32x2 v0, v1; v0.x = (vv[0] & 0xffffu) | (vv[1] << 16); v0.y = (vv[2] & 0xffffu) | (vv[3] << 16); v1.x = (vv[0] >> 16) | (vv[1] & 0xffff0000u); v1.y = (vv[2] >> 16) | (vv[3] & 0xffff0000u);
              *(LAS u32x2*)(B + VTOFF + d0 * TS + 8 * tg) = v0; *(LAS u32x2*)(B + VTOFF + (d0 + 1) * TS + 8 * tg) = v1; }
            if (tg == 0) { f32x2h dv; dv.x = __expf(fmaxf(tot.x, -80.f)); dv.y = __expf(fmaxf(tot.y, -80.f)); *(LAS f32x2h*)(B + DOFF + d0 * 4) = dv; }
            segsum += tot;
            __syncthreads();
            chunk_matrix<OUT>(B, Sacc, c16, g, e0, dir, h, seg * SEGT + c * CH, OF);
        }
    }
    if (!OUT) {
#pragma unroll
        for (int dt = 0; dt < 8; ++dt) { hst[(dt * 4 + 0) * 64] = Sacc[dt][0]; hst[(dt * 4 + 1) * 64] = Sacc[dt][1]; hst[(dt * 4 + 2) * 64] = Sacc[dt][2]; hst[(dt * 4 + 3) * 64] = Sacc[dt][3]; }
        if (tid < 64) { f32x2h dd; dd.x = __expf(fmaxf(segsum.x, -80.f)); dd.y = __expf(fmaxf(segsum.y, -80.f)); *(f32x2h*)(HSD + (size_t)unit * 128 + d0) = dd; }
    }
    __syncthreads();
}
__device__ __forceinline__ void carry(float* __restrict__ HST, const float* __restrict__ HSD, int gid) {
    const int chain = gid >> 14, el = gid & 16383, dt = (el >> 8) & 7, r = (el >> 6) & 3, ln = el & 63, d = 16 * dt + 4 * (ln >> 4) + r;
    float cy = 0.f;
    for (int sg = 0; sg < NSEG; ++sg) {
        const int u = chain * NSEG + sg;
        const float tmp = HST[(size_t)u * 16384 + el];
        HST[(size_t)u * 16384 + el] = cy;
        cy = HSD[(size_t)u * 128 + d] * cy + tmp;
    }
}
#undef HG_MFMA
#undef HG_LOAD
}

#define XB_TMO      128
#define XB_XCNT(j)  (256  + 64 * (j))
#define XB_XSUB(j)  (1280 + 64 * (j))
#define XB_XGEN(j)  (2304 + 64 * (j))
#define XB_TOP      3328
#define XB_TOPGEN   3392
#define XCD_BAR_WORDS 3456
#define XB_SPIN_CAP (1u << 18)

__device__ __forceinline__ unsigned xb_ld(unsigned* p)              { return __hip_atomic_load(p, __ATOMIC_RELAXED, __HIP_MEMORY_SCOPE_AGENT); }
__device__ __forceinline__ unsigned xb_add(unsigned* p, unsigned v) { return __hip_atomic_fetch_add(p, v, __ATOMIC_RELAXED, __HIP_MEMORY_SCOPE_AGENT); }
__device__ __forceinline__ unsigned xb_xcc_id() { return (unsigned)__builtin_amdgcn_s_getreg((3 << 11) | 20) & 0xFu; }
#define XB_SPIN(cond, bar) do { unsigned _sp = 0; while (cond) { __builtin_amdgcn_s_sleep(1); \
    if ((++_sp & 255u) == 0u) { if (xb_ld(&(bar)[XB_TMO])) break; if (_sp > XB_SPIN_CAP) { atomicAdd(&(bar)[XB_TMO], 1u); break; } } } } while (0)

struct XcdBarrier {
    int wv;
    unsigned* bar; unsigned x;
    volatile LAS unsigned* st;
};

__device__ __forceinline__ XcdBarrier xcd_barrier_post(unsigned* bar, volatile LAS unsigned* st) {
    XcdBarrier b; b.bar = bar; b.x = xb_xcc_id(); b.st = st; b.wv = __builtin_amdgcn_readfirstlane((int)threadIdx.x >> 6);
    if (threadIdx.x == 0) (void)xb_add(&bar[XB_XCNT(b.x)], 1u);
    return b;
}
__device__ __forceinline__ void xcd_barrier_complete(unsigned* bar, unsigned x, unsigned& nloc, unsigned& nx) {
    const unsigned G = gridDim.x * gridDim.y * gridDim.z;
    unsigned sum, cnt, mine, sp = 0u;
    for (;;) {
        sum = 0u; cnt = 0u; mine = 0u;
#pragma unroll
        for (unsigned j = 0; j < 16; ++j) { const unsigned c = xb_ld(&bar[XB_XCNT(j)]); sum += c; cnt += (c > 0u) ? 1u : 0u; mine = (j == x) ? c : mine; }
        if (sum == G) break;
        __builtin_amdgcn_s_sleep(1);
        if ((++sp & 255u) == 0u) { if (xb_ld(&bar[XB_TMO])) break; if (sp > XB_SPIN_CAP) { atomicAdd(&bar[XB_TMO], 1u); break; } }
    }
    nloc = mine > 0u ? mine : 1u; nx = cnt > 0u ? cnt : 1u;
}

__device__ __forceinline__ void xcd_barrier(const XcdBarrier& b) {
    asm volatile("s_waitcnt vmcnt(0)" ::: "memory");
    __syncthreads();
    if (b.wv == 0 && lane_id_opaque() == 0) {
        unsigned* bar = b.bar;
        __builtin_amdgcn_s_waitcnt(0);
        unsigned nloc = b.st[0], nx = b.st[1];
        if (nloc == 0u) { xcd_barrier_complete(bar, b.x, nloc, nx); b.st[0] = nloc; b.st[1] = nx; }
        const unsigned old = xb_add(&bar[XB_XSUB(b.x)], 1u);
        const unsigned gen = old / nloc;
        if (old + 1u == (gen + 1u) * nloc) {
            __builtin_amdgcn_fence(__ATOMIC_RELEASE, "agent");
            asm volatile("s_waitcnt vmcnt(0)" ::: "memory");
            const unsigned og = xb_add(&bar[XB_TOP], 1u);
            const unsigned tg = og / nx;
            if (og + 1u == (tg + 1u) * nx) xb_add(&bar[XB_TOPGEN], 1u);
            else XB_SPIN(xb_ld(&bar[XB_TOPGEN]) == tg, bar);
            __builtin_amdgcn_fence(__ATOMIC_ACQUIRE, "agent");
            xb_add(&bar[XB_XGEN(b.x)], 1u);
            asm volatile("s_waitcnt vmcnt(0)" ::: "memory");
        } else {
            XB_SPIN(xb_ld(&bar[XB_XGEN(b.x)]) == gen, bar);
            __builtin_amdgcn_fence(__ATOMIC_ACQUIRE, "agent");
            asm volatile("s_waitcnt vmcnt(0)" ::: "memory");
        }
    }
    __syncthreads();
}

constexpr int NWAVES = 8;
constexpr int RING_OFF = 0, RING_BYTES = 131072;
constexpr int LDSCTL_OFF = RING_BYTES, MISC_OFF = LDSCTL_OFF + 320;
constexpr int LDS_BYTES = 147456;
constexpr int CW_BAR = 4096;
constexpr int NPL = 12;
constexpr int PH_PRO = 0, PH_NORM1 = 1, PH_L0 = 2, PH_END = PH_L0 + NL * NPL;
enum { P_G1 = 0, P_QKP = 1, P_HGB = 2, P_HGC = 3, P_ATT = 4, P_G2 = 5, P_G3 = 6, P_N2R = 7, P_TOPK = 8, P_G4 = 9, P_G5 = 10, P_COMB = 11 };

#ifndef REP_HG
#define REP_HG 1
#endif
#ifndef REP_PRO
#define REP_PRO 1
#endif
#ifndef REP_ROW
#define REP_ROW 1
#endif
#ifndef REP_G
#define REP_G 1
#endif
#ifndef REP_TK
#define REP_TK 1
#endif
#ifndef REP_QK
#define REP_QK 1
#endif
#ifndef REP_ATT
#define REP_ATT 1
#endif
struct Params {
    const float *x, *c, *ada_w, *ada_b, *norm_mix_w, *norm_ffn_w, *w_in, *q_norm_w, *k_norm_w, *hlb, *hg_norm_w, *w_ba, *w_bh, *w_out, *w_router, *w_eg, *w_eu, *w_ed;
    float* out; unsigned char* ws;
    int ph_lo, ph_hi, li, pad;
};
struct Frame {
    LAS unsigned char* lds;
    int tid, lane, wave, vcu, G;
};

__device__ __forceinline__ void tr_tile(const float* __restrict__ src, int ldw, bf16_t* __restrict__ dst, int Kd, LAS float* scr, int lane) {
    f32x4 v[8];
#pragma unroll
    for (int i = 0; i < 8; ++i) v[i] = *(const f32x4*)(src + (size_t)(8 * i + (lane >> 3)) * ldw + 4 * (lane & 7));
#pragma unroll
    for (int i = 0; i < 8; ++i) { LAS float* s = scr + (8 * i + (lane >> 3)) * 33 + 4 * (lane & 7); s[0] = v[i].x; s[1] = v[i].y; s[2] = v[i].z; s[3] = v[i].w; }
    asm volatile("s_waitcnt lgkmcnt(0)" ::: "memory");
    const int cch = lane & 7;
#pragma unroll
    for (int j = 0; j < 4; ++j) { const int n = (lane >> 3) + 8 * j; const LAS float* s = scr + (8 * cch) * 33 + n;
        u32x4 o; o.x = pk2(s[0 * 33], s[1 * 33]); o.y = pk2(s[2 * 33], s[3 * 33]); o.z = pk2(s[4 * 33], s[5 * 33]); o.w = pk2(s[6 * 33], s[7 * 33]);
        *(u32x4*)(dst + (size_t)n * Kd + 8 * cch) = o; }
    asm volatile("s_waitcnt lgkmcnt(0)" ::: "memory");
}
struct ConvItem { const float* src; unsigned char* dst; int ldw, Kd; };
__device__ __forceinline__ ConvItem conv_item_f8(const Params& p, int l, int it) {
    ConvItem c;
    const int which = it / (NE * 1024), r0 = it % (NE * 1024), e = r0 >> 10, r = r0 & 1023;
    if (which < 2) {
        const int kb = r >> 6, nb = r & 63, n0 = 32 * nb;
        const float* W = (which == 0 ? p.w_eg : p.w_eu) + (size_t)(l * NE + e) * D * FF;
        const int rho = e * 4096 + (n0 >> 7) * 256 + which * 128 + (n0 & 127);
        c.src = W + (size_t)(64 * kb) * FF + n0; c.ldw = FF; c.dst = p.ws + WS_WGU + (size_t)l * 64 * MiB + (size_t)rho * D + 64 * kb; c.Kd = D;
    } else {
        const int kb = r >> 5, nb = r & 31, n0 = 32 * nb;
        const float* W = p.w_ed + (size_t)(l * NE + e) * FF * D;
        c.src = W + (size_t)(64 * kb) * D + n0; c.ldw = D; c.dst = p.ws + WS_WD + (size_t)l * 32 * MiB + (size_t)(e * 1024 + n0) * FF + 64 * kb; c.Kd = FF;
    }
    return c;
}
__device__ __forceinline__ void conv_load8(const ConvItem& c, int lane, f32x4 (&v)[8]) {
#pragma unroll
    for (int i = 0; i < 8; ++i) v[i] = *(const f32x4*)(c.src + (size_t)(8 * i + (lane >> 3)) * c.ldw + 4 * (lane & 7));
}
__device__ __forceinline__ void conv_store_f8(const ConvItem& c, int lane, const f32x4 (&v)[8], LAS float* scr, float scale) {
#pragma unroll
    for (int i = 0; i < 8; ++i) { LAS float* s = scr + (8 * i + (lane >> 3)) * 33 + 4 * (lane & 7); s[0] = v[i].x; s[1] = v[i].y; s[2] = v[i].z; s[3] = v[i].w; }
    asm volatile("s_waitcnt lgkmcnt(0)" ::: "memory");
    const int cch = lane & 7;
#pragma unroll
    for (int j = 0; j < 4; ++j) { const int n = (lane >> 3) + 8 * j; const LAS float* s = scr + (8 * cch) * 33 + n;
        const f32x4 a = {s[0 * 33] * scale, s[1 * 33] * scale, s[2 * 33] * scale, s[3 * 33] * scale}, b = {s[4 * 33] * scale, s[5 * 33] * scale, s[6 * 33] * scale, s[7 * 33] * scale};
        *(u32x2*)(c.dst + (size_t)n * c.Kd + 8 * cch) = pg8::pack8_fp8(a, b); }
    asm volatile("s_waitcnt lgkmcnt(0)" ::: "memory");
}
__device__ __forceinline__ void conv_experts_f8(Frame& F, const Params& p, int l, LAS float* scr) {
    const int gw = F.vcu * NWAVES + F.wave, NGW = F.G * NWAVES, NIT = 3 * NE * 1024;
    int it = gw; if (it >= NIT) return;
    ConvItem cur = conv_item_f8(p, l, it); f32x4 va[8], vb[8];
    conv_load8(cur, F.lane, va);
    for (;;) {
        const int it1 = it + NGW; const bool h1 = it1 < NIT; ConvItem c1 = conv_item_f8(p, l, h1 ? it1 : it);
        if (h1) conv_load8(c1, F.lane, vb);
        conv_store_f8(cur, F.lane, va, scr, 64.0f);
        if (!h1) break;
        const int it2 = it1 + NGW; const bool h2 = it2 < NIT; ConvItem c2 = conv_item_f8(p, l, h2 ? it2 : it1);
        if (h2) conv_load8(c2, F.lane, va);
        conv_store_f8(c1, F.lane, vb, scr, 64.0f);
        if (!h2) break;
        cur = c2; it = it2;
    }
}
__device__ __forceinline__ void conv_matrix(Frame& F, const float* W, int ldw, int K, int N, bf16_t* WT, LAS float* scr) {
    const int gw = F.vcu * NWAVES + F.wave, NGW = F.G * NWAVES, nblk = N / 32, nitems = (K / 64) * nblk;
    for (int it = gw; it < nitems; it += NGW) { const int kb = it / nblk, nb = it % nblk;
        tr_tile(W + (size_t)(64 * kb) * ldw + 32 * nb, ldw, WT + (size_t)(32 * nb) * K + 64 * kb, K, scr, F.lane); }
}
__device__ __forceinline__ void conv_matrix_f8(Frame& F, const float* W, int ldw, int K, int N, unsigned char* WT, LAS float* scr, float scale) {
    const int gw = F.vcu * NWAVES + F.wave, NGW = F.G * NWAVES, nblk = N / 32, nitems = (K / 64) * nblk;
    for (int it = gw; it < nitems; it += NGW) { const int kb = it / nblk, nb = it % nblk;
        ConvItem c; c.src = W + (size_t)(64 * kb) * ldw + 32 * nb; c.ldw = ldw; c.dst = WT + (size_t)(32 * nb) * K + 64 * kb; c.Kd = K;
        f32x4 v[8]; conv_load8(c, F.lane, v); conv_store_f8(c, F.lane, v, scr, scale); }
}
__device__ __forceinline__ void conv_experts(Frame& F, const Params& p, int l, LAS float* scr) {
    const int gw = F.vcu * NWAVES + F.wave, NGW = F.G * NWAVES;
    bf16_t* WGU = (bf16_t*)(p.ws + WS_WGU); bf16_t* WD = (bf16_t*)(p.ws + WS_WD);
    for (int it = gw; it < 3 * NE * 1024; it += NGW) {
        const int which = it / (NE * 1024), r0 = it % (NE * 1024), e = r0 >> 10, r = r0 & 1023;
        if (which < 2) {
            const int kb = r >> 6, nb = r & 63, n0 = 32 * nb;
            const float* W = (which == 0 ? p.w_eg : p.w_eu) + (size_t)(l * NE + e) * D * FF;
            const int rho = e * 4096 + (n0 >> 7) * 256 + which * 128 + (n0 & 127);
            tr_tile(W + (size_t)(64 * kb) * FF + n0, FF, WGU + (size_t)rho * D + 64 * kb, D, scr, F.lane);
        } else {
            const int kb = r >> 5, nb = r & 31, n0 = 32 * nb;
            const float* W = p.w_ed + (size_t)(l * NE + e) * FF * D;
            tr_tile(W + (size_t)(64 * kb) * D + n0, D, WD + (size_t)(e * 1024 + n0) * FF + 64 * kb, FF, scr, F.lane);
        }
    }
}
__device__ __forceinline__ void mod_units(Frame& F, const Params& p) {
    LAS float* sc = (LAS float*)(F.lds + 96 * 1024);
    LAS float* red = sc + 1024;
    float* MOD = (float*)(p.ws + WS_MOD); float* LBV = (float*)(p.ws + WS_LBV);
    for (int u = blockIdx.x; u < NL * 96; u += F.G) {
        for (int i = F.tid; i < D; i += 512) sc[i] = siluf_(p.c[i]);
        __syncthreads();
        const int l = u / 96, j = (u % 96) * 64 + (F.tid & 63), kp = F.tid >> 6;
        const float* w = p.ada_w + (size_t)l * D * 6 * D + (size_t)(kp * 128) * 6 * D + j;
        float acc = 0.f;
#pragma unroll 8
        for (int k = 0; k < 128; ++k) acc += sc[kp * 128 + k] * w[(size_t)k * 6 * D];
        red[kp * 64 + (F.tid & 63)] = acc;
        __syncthreads();
        if (F.tid < 64) { float s = 0.f;
#pragma unroll
            for (int q = 0; q < 8; ++q) s += red[q * 64 + F.tid];
            MOD[l * 6 * D + j] = s + p.ada_b[l * 6 * D + j]; }
        __syncthreads();
    }
    const int n = blockIdx.x * 512 + F.tid;
    if (n < NL * 1024) { const int l = n / 1024, r = n % 1024; float v = 0.f;
        if (l == 1) { const float b0 = p.hlb[r], b1 = p.hlb[1024 + r]; v = 1.0f / (1.0f + __expf(b0 - b1)); }
        LBV[n] = v; }
}

__device__ __forceinline__ void norm_mod_row(const f32x4 (&v)[4], float ss, const float* __restrict__ w, const float* __restrict__ scale,
                                             const float* __restrict__ shift, bf16_t* __restrict__ orow, int lane, f32x4 (&h)[4], unsigned char* __restrict__ orow8 = nullptr) {
    const float r = rsqrtf(ss * (1.0f / D) + EPS);
#pragma unroll
    for (int j = 0; j < 4; ++j) {
        const int c0 = 4 * lane + 256 * j;
        const f32x4 wv = *(const f32x4*)(w + c0), sv = *(const f32x4*)(scale + c0), bv = *(const f32x4*)(shift + c0);
        h[j] = (v[j] * r) * wv * (sv + 1.0f) + bv;
        u32x2 o; o.x = pk2(h[j].x, h[j].y); o.y = pk2(h[j].z, h[j].w);
        *(u32x2*)(orow + c0) = o;
        if (orow8) { int wd = 0; wd = __builtin_amdgcn_cvt_pk_fp8_f32(h[j].x, h[j].y, wd, false); wd = __builtin_amdgcn_cvt_pk_fp8_f32(h[j].z, h[j].w, wd, true); *(int*)(orow8 + c0) = wd; }
    }
}
__device__ __forceinline__ void norm_mod_row_f8(const f32x4 (&v)[4], float ss, const float* __restrict__ w, const float* __restrict__ scale,
                                                const float* __restrict__ shift, unsigned char* __restrict__ orow, int lane, f32x4 (&h)[4]) {
    const float r = rsqrtf(ss * (1.0f / D) + EPS);
#pragma unroll
    for (int j = 0; j < 4; ++j) {
        const int c0 = 4 * lane + 256 * j;
        const f32x4 wv = *(const f32x4*)(w + c0), sv = *(const f32x4*)(scale + c0), bv = *(const f32x4*)(shift + c0);
        h[j] = (v[j] * r) * wv * (sv + 1.0f) + bv;
        int wd = 0; wd = __builtin_amdgcn_cvt_pk_fp8_f32(h[j].x, h[j].y, wd, false); wd = __builtin_amdgcn_cvt_pk_fp8_f32(h[j].z, h[j].w, wd, true);
        *(int*)(orow + c0) = wd;
    }
}
__device__ __forceinline__ void ph_norm1(Frame& F, const float* x, const float* w, const float* scale, const float* shift, bf16_t* HB, unsigned char* HB8) {
    const int gw = F.vcu * NWAVES + F.wave, NGW = F.G * NWAVES;
    for (int row = gw; row < S; row += NGW) {
        const f32x4* xr = (const f32x4*)(x + (size_t)row * D) + F.lane;
        f32x4 v[4], h[4]; float ss = 0.f;
#pragma unroll
        for (int j = 0; j < 4; ++j) { v[j] = xr[64 * j]; ss += (v[j].x * v[j].x + v[j].y * v[j].y) + (v[j].z * v[j].z + v[j].w * v[j].w); }
        ss = wave_sum(ss);
        norm_mod_row(v, ss, w, scale, shift, HB + (size_t)row * D, F.lane, h);
    }
}
__device__ __forceinline__ void ph_gather(Frame& F, const unsigned char* HB8, const int* IDX, unsigned char* XE8) {
    const int gw = F.vcu * NWAVES + F.wave, NGW = F.G * NWAVES;
    constexpr int PER = NE * CAP / 2048;
    if (NGW * PER == NE * CAP) {
        const int r0 = gw * PER;
        const int mine = IDX[r0 + (F.lane & 15)];
#pragma unroll
        for (int q = 0; q < PER; q += 8) {
            u32x4 a[8];
#pragma unroll
            for (int k = 0; k < 8; ++k) { const int t = __builtin_amdgcn_readlane(mine, q + k); a[k] = ((const u32x4*)(HB8 + (size_t)t * D))[F.lane]; }
#pragma unroll
            for (int k = 0; k < 8; ++k) ((u32x4*)(XE8 + (size_t)(r0 + q + k) * D))[F.lane] = a[k];
        }
    } else {
        for (int r = gw; r < NE * CAP; r += NGW) { const int t = IDX[r]; ((u32x4*)(XE8 + (size_t)r * D))[F.lane] = ((const u32x4*)(HB8 + (size_t)t * D))[F.lane]; }
    }
}

#define OPAQUE_LANE() const int lane = lane_id_opaque(); const int t_ = F.wave * 64 + lane
__device__ __forceinline__ void ph_rope_table(Frame& F, float* ROPE) {
    OPAQUE_LANE();
    const int n = blockIdx.x * 512 + t_;
    if (n < 4096) { const int pos = n >> 4, i = n & 15; const float inv = exp2f(-(float)i * (13.287712379549449f / 16.0f)); float sn, cs; sincosf((float)pos * inv, &sn, &cs); ROPE[2 * n] = cs; ROPE[2 * n + 1] = sn; }
}
__device__ __forceinline__ void ph_qkprep(Frame& F, const bf16_t* __restrict__ QR, const bf16_t* __restrict__ KR, const float* __restrict__ qw, const float* __restrict__ kw,
                                          const float* __restrict__ ROPE, bf16_t* __restrict__ QN, bf16_t* __restrict__ KN, int rank, int nranks) {
    OPAQUE_LANE(); (void)lane;
    if (rank < 0) return;
    for (int gid = rank * 512 + t_; gid < S * 10; gid += nranks * 512) {
        const int t = gid / 10, hh = gid % 10;
        const bool isq = hh < 8;
        const bf16_t* src = isq ? QR + (size_t)t * 512 + hh * 64 : KR + (size_t)t * 128 + (hh - 8) * 64;
        bf16_t* dst = isq ? QN + (size_t)t * 512 + hh * 64 : KN + (size_t)t * 128 + (hh - 8) * 64;
        const float* w = isq ? qw : kw;
        float f[64]; float ss = 0.f;
#pragma unroll
        for (int i = 0; i < 8; ++i) { const u32x4 q = *(const u32x4*)(src + 8 * i);
#pragma unroll
            for (int j = 0; j < 4; ++j) { f[8 * i + 2 * j] = bflo(q[j]); f[8 * i + 2 * j + 1] = bfhi(q[j]); } }
#pragma unroll
        for (int i = 0; i < 64; ++i) ss += f[i] * f[i];
        const float rn = rsqrtf(ss * (1.0f / 64.0f) + EPS), sc = isq ? C2 : 1.0f;
#pragma unroll
        for (int i = 0; i < 16; ++i) { const f32x4 wv = *(const f32x4*)(w + 4 * i);
            f[4 * i] *= rn * wv.x; f[4 * i + 1] *= rn * wv.y; f[4 * i + 2] *= rn * wv.z; f[4 * i + 3] *= rn * wv.w; }
        float o[64];
#pragma unroll
        for (int ax = 0; ax < 2; ++ax) {
            const float* tb = ROPE + (size_t)(ax == 0 ? (t >> 6) : (t & 63)) * 32;
#pragma unroll
            for (int i2 = 0; i2 < 8; ++i2) { const f32x4 cs = *(const f32x4*)(tb + 4 * i2);
#pragma unroll
                for (int k = 0; k < 2; ++k) { const int i = 2 * i2 + k; const float c_ = k ? cs.z : cs.x, s_ = k ? cs.w : cs.y;
                    const float x1 = f[ax * 32 + i], x2 = f[ax * 32 + 16 + i];
                    o[ax * 32 + i] = (x1 * c_ - x2 * s_) * sc; o[ax * 32 + 16 + i] = (x2 * c_ + x1 * s_) * sc; } }
        }
#pragma unroll
        for (int i = 0; i < 8; ++i) { u32x4 q;
#pragma unroll
            for (int j = 0; j < 4; ++j) q[j] = pk2(o[8 * i + 2 * j], o[8 * i + 2 * j + 1]);
            *(u32x4*)(dst + 8 * i) = q; }
    }
}
__device__ __forceinline__ void ph_hgfin(Frame& F, const float* __restrict__ OF, const bf16_t* __restrict__ HG, const float* __restrict__ w, bf16_t* __restrict__ OHG) {
    OPAQUE_LANE();
    const int gw = F.vcu * NWAVES + F.wave, NGW = F.G * NWAVES;
    const int e0 = (lane & 15) * 8;
    const f32x4 w0 = *(const f32x4*)(w + e0), w1 = *(const f32x4*)(w + e0 + 4);
    for (int t = gw; t < S; t += NGW) {
        const size_t off = (size_t)t * 512 + lane * 8;
        const f32x4 a0 = *(const f32x4*)(OF + off), a1 = *(const f32x4*)(OF + off + 4), b0 = *(const f32x4*)(OF + (size_t)S * 512 + off), b1 = *(const f32x4*)(OF + (size_t)S * 512 + off + 4);
        const f32x4 s0 = a0 + b0, s1 = a1 + b1;
        float ss = (s0.x * s0.x + s0.y * s0.y) + (s0.z * s0.z + s0.w * s0.w) + (s1.x * s1.x + s1.y * s1.y) + (s1.z * s1.z + s1.w * s1.w);
        ss += __shfl_xor(ss, 1); ss += __shfl_xor(ss, 2); ss += __shfl_xor(ss, 4); ss += __shfl_xor(ss, 8);
        const float r = rsqrtf(ss * (1.0f / 128.0f) + EPS);
        const u32x4 g = *(const u32x4*)(HG + off);
        u32x4 o;
        o.x = pk2(s0.x * r * w0.x * bflo(g.x), s0.y * r * w0.y * bfhi(g.x));
        o.y = pk2(s0.z * r * w0.z * bflo(g.y), s0.w * r * w0.w * bfhi(g.y));
        o.z = pk2(s1.x * r * w1.x * bflo(g.z), s1.y * r * w1.y * bfhi(g.z));
        o.w = pk2(s1.z * r * w1.z * bflo(g.w), s1.w * r * w1.w * bfhi(g.w));
        *(u32x4*)(OHG + off) = o;
    }
}
__device__ __forceinline__ void ph_norm2_router(Frame& F, const float* __restrict__ X1, const float* __restrict__ w, const float* __restrict__ scale, const float* __restrict__ shift,
                                                const float* __restrict__ wr, unsigned char* __restrict__ HB, float* __restrict__ AFF) {
    OPAQUE_LANE();
    LAS float* WT = (LAS float*)F.lds;
    for (int dd = t_; dd < D; dd += NWAVES * 64) {
        const GAS f32x4* s = (const GAS f32x4*)((const GAS float*)wr + (size_t)dd * 16);
        const f32x4 a = s[0], b = s[1], c = s[2], e = s[3];
        WT[0 * D + dd] = a.x; WT[1 * D + dd] = a.y; WT[2 * D + dd] = a.z; WT[3 * D + dd] = a.w; WT[4 * D + dd] = b.x; WT[5 * D + dd] = b.y; WT[6 * D + dd] = b.z; WT[7 * D + dd] = b.w;
        WT[8 * D + dd] = c.x; WT[9 * D + dd] = c.y; WT[10 * D + dd] = c.z; WT[11 * D + dd] = c.w; WT[12 * D + dd] = e.x; WT[13 * D + dd] = e.y; WT[14 * D + dd] = e.z; WT[15 * D + dd] = e.w;
    }
    __syncthreads();
    const int gw = F.vcu * NWAVES + F.wave, NGW = F.G * NWAVES;
    for (int row = gw; row < S; row += 2 * NGW) {
        const int row1 = (row + NGW < S) ? row + NGW : row;
        const f32x4* xr0 = (const f32x4*)(X1 + (size_t)row * D) + lane; const f32x4* xr1 = (const f32x4*)(X1 + (size_t)row1 * D) + lane;
        f32x4 v0[4], v1[4], h0[4], h1[4]; float ss0 = 0.f, ss1 = 0.f;
#pragma unroll
        for (int j = 0; j < 4; ++j) { v0[j] = xr0[64 * j]; v1[j] = xr1[64 * j]; }
#pragma unroll
        for (int j = 0; j < 4; ++j) { ss0 += (v0[j].x * v0[j].x + v0[j].y * v0[j].y) + (v0[j].z * v0[j].z + v0[j].w * v0[j].w); ss1 += (v1[j].x * v1[j].x + v1[j].y * v1[j].y) + (v1[j].z * v1[j].z + v1[j].w * v1[j].w); }
        ss0 = wave_sum(ss0); ss1 = wave_sum(ss1);
        norm_mod_row_f8(v0, ss0, w, scale, shift, HB + (size_t)row * D, lane, h0);
        norm_mod_row_f8(v1, ss1, w, scale, shift, HB + (size_t)row1 * D, lane, h1);
        LAS float* wt = WT + 4 * lane; asm volatile("" : "+v"(wt));
        f32x4 lg0[4], lg1[4];
#pragma unroll
        for (int e = 0; e < 16; ++e) {
            float a0 = 0.f, a1 = 0.f;
#pragma unroll
            for (int j = 0; j < 4; ++j) { const f32x4 ww = *(const LAS f32x4*)(wt + e * D + 256 * j);
                a0 += (h0[j].x * ww.x + h0[j].y * ww.y) + (h0[j].z * ww.z + h0[j].w * ww.w); a1 += (h1[j].x * ww.x + h1[j].y * ww.y) + (h1[j].z * ww.z + h1[j].w * ww.w); }
            lg0[e >> 2][e & 3] = wave_sum(a0); lg1[e >> 2][e & 3] = wave_sum(a1);
        }
#pragma unroll
        for (int rr = 0; rr < 2; ++rr) {
            f32x4 (&lgv)[4] = rr ? lg1 : lg0;
            float mx = -1e30f;
#pragma unroll
            for (int e4 = 0; e4 < 4; ++e4) mx = fmaxf(mx, fmaxf(fmaxf(lgv[e4].x, lgv[e4].y), fmaxf(lgv[e4].z, lgv[e4].w)));
            float den = 0.f;
#pragma unroll
            for (int e4 = 0; e4 < 4; ++e4) { lgv[e4].x = __expf(lgv[e4].x - mx); lgv[e4].y = __expf(lgv[e4].y - mx); lgv[e4].z = __expf(lgv[e4].z - mx); lgv[e4].w = __expf(lgv[e4].w - mx);
                den += (lgv[e4].x + lgv[e4].y) + (lgv[e4].z + lgv[e4].w); }
            const float inv = 1.0f / den;
            const f32x4 s8a = (lane & 8) ? lgv[2] : lgv[0], s8b = (lane & 8) ? lgv[3] : lgv[1];
            const f32x4 s4 = (lane & 4) ? s8b : s8a;
            const float s2a = (lane & 2) ? s4.z : s4.x, s2b = (lane & 2) ? s4.w : s4.y;
            const float mine = ((lane & 1) ? s2b : s2a) * inv;
            const int rw = rr ? row1 : row;
            if (lane < 16 && (rr == 0 || row1 != row)) AFF[(size_t)lane * S + rw] = mine;
        }
    }
    __syncthreads();
}
__device__ __forceinline__ void ph_topk(Frame& F, LAS unsigned char* lds, int e, const float* __restrict__ AFF, int* __restrict__ IDX, float* __restrict__ TOPW, int* __restrict__ SLOT) {
    LAS unsigned* hist = (LAS unsigned*)lds;
    LAS unsigned* hsum = hist + 4096;
    LAS unsigned* shv = hsum + 256;
    LAS unsigned* scan = hsum + 512;
    OPAQUE_LANE(); const int tid = t_;
    const unsigned* vals = (const unsigned*)(AFF + (size_t)e * S);
    unsigned u[32];
#pragma unroll
    for (int i = 0; i < 8; ++i) { const u32x4 q = *(const u32x4*)(vals + tid * 32 + 4 * i); u[4 * i] = q.x; u[4 * i + 1] = q.y; u[4 * i + 2] = q.z; u[4 * i + 3] = q.w; }
    if (tid == 0) { shv[0] = 0u; shv[1] = CAP; }
    LAS unsigned* myh = hist + (lane & 15) * 256;
    __syncthreads();
    for (int pass = 3; pass >= 0; --pass) {
        const int shift = pass * 8;
        const unsigned mask = pass == 3 ? 0u : (0xFFFFFFFFu << (shift + 8));
#pragma unroll
        for (int i = 0; i < 8; ++i) hist[tid + 512 * i] = 0u;
        __syncthreads();
        const unsigned prefix = shv[0];
#pragma unroll
        for (int i = 0; i < 32; ++i) if ((u[i] & mask) == (prefix & mask)) __hip_atomic_fetch_add(&myh[(u[i] >> shift) & 255u], 1u, __ATOMIC_RELAXED, __HIP_MEMORY_SCOPE_WORKGROUP);
        __syncthreads();
        if (tid < 256) { unsigned s = 0u;
#pragma unroll
            for (int c = 0; c < 16; ++c) s += hist[c * 256 + tid];
            hsum[tid] = s; }
        __syncthreads();
        if (tid < 64) {
            const unsigned kk = shv[1];
            const unsigned h0 = hsum[4 * lane], h1 = hsum[4 * lane + 1], h2 = hsum[4 * lane + 2], h3 = hsum[4 * lane + 3];
            const unsigned tot = (h0 + h1) + (h2 + h3);
            unsigned inc = tot;
#pragma unroll
            for (int o = 1; o < 64; o <<= 1) { const unsigned v = __shfl_down(inc, o); if (lane + o < 64) inc += v; }
            unsigned c = inc - tot; int bin = -1; unsigned rem = 0u;
            if (c < kk && c + h3 >= kk) { bin = 4 * lane + 3; rem = kk - c; } c += h3;
            if (c < kk && c + h2 >= kk) { bin = 4 * lane + 2; rem = kk - c; } c += h2;
            if (c < kk && c + h1 >= kk) { bin = 4 * lane + 1; rem = kk - c; } c += h1;
            if (c < kk && c + h0 >= kk) { bin = 4 * lane; rem = kk - c; }
            if (bin >= 0) { shv[1] = rem; shv[0] = prefix | ((unsigned)bin << shift); }
        }
        __syncthreads();
    }
    const unsigned T = shv[0], need_eq = shv[1];
    unsigned ceq = 0u;
#pragma unroll
    for (int i = 0; i < 32; ++i) ceq += (u[i] == T) ? 1u : 0u;
    scan[tid] = ceq; __syncthreads();
    for (int off = 1; off < 512; off <<= 1) { const unsigned tv = tid >= off ? scan[tid - off] : 0u; __syncthreads(); scan[tid] += tv; __syncthreads(); }
    unsigned eq_rank = scan[tid] - ceq;
    __syncthreads();
    unsigned selmask = 0u, csel = 0u;
#pragma unroll
    for (int i = 0; i < 32; ++i) { bool sel = u[i] > T; if (u[i] == T) { sel = eq_rank < need_eq; ++eq_rank; } if (sel) { selmask |= 1u << i; ++csel; } }
    scan[tid] = csel; __syncthreads();
    for (int off = 1; off < 512; off <<= 1) { const unsigned tv = tid >= off ? scan[tid - off] : 0u; __syncthreads(); scan[tid] += tv; __syncthreads(); }
    unsigned slot = scan[tid] - csel;
#pragma unroll
    for (int i = 0; i < 32; ++i) {
        const int t = tid * 32 + i; int sl = -1;
        if (selmask & (1u << i)) { sl = (int)slot; ++slot; if (sl < CAP) { IDX[e * CAP + sl] = t; TOPW[e * CAP + sl] = __uint_as_float(u[i]); } }
        SLOT[(size_t)e * S + t] = sl < CAP ? sl : -1;
    }
    __syncthreads();
}
__device__ __forceinline__ void ph_combine(Frame& F, const float* __restrict__ X1, const bf16_t* __restrict__ YE, const int* __restrict__ SLOT, const float* __restrict__ gate,
                                           float* __restrict__ xout, const float* __restrict__ w, const float* __restrict__ scale, const float* __restrict__ shift, bf16_t* __restrict__ HB, unsigned char* __restrict__ HB8, bool do_norm) {
    OPAQUE_LANE();
    const int gw = F.vcu * NWAVES + F.wave, NGW = F.G * NWAVES;
    for (int row = gw; row < S; row += 2 * NGW) {
        const bool two = row + NGW < S; const int row1 = two ? row + NGW : row;
        const int sl0 = lane < NE ? SLOT[(size_t)lane * S + row] : -1, sl1 = lane < NE ? SLOT[(size_t)lane * S + row1] : -1;
        const f32x4* xr0 = (const f32x4*)(X1 + (size_t)row * D) + lane; const f32x4* xr1 = (const f32x4*)(X1 + (size_t)row1 * D) + lane;
        f32x4 v0[4], v1[4];
#pragma unroll
        for (int j = 0; j < 4; ++j) { v0[j] = xr0[64 * j]; v1[j] = xr1[64 * j]; }
        f32x4 acc0[4], acc1[4];
#pragma unroll
        for (int j = 0; j < 4; ++j) { acc0[j] = f32x4{0.f, 0.f, 0.f, 0.f}; acc1[j] = acc0[j]; }
        unsigned m0 = (unsigned)__ballot(sl0 >= 0) & 0xffffu, m1 = (unsigned)__ballot(sl1 >= 0) & 0xffffu;
        while (m0 | m1) {
            const int e0 = m0 ? __builtin_ctz(m0) : 0, e1 = m1 ? __builtin_ctz(m1) : 0;
            const float f0 = m0 ? 1.f : 0.f, f1 = m1 ? 1.f : 0.f;
            const int s0 = m0 ? __builtin_amdgcn_readlane(sl0, e0) : 0, s1 = m1 ? __builtin_amdgcn_readlane(sl1, e1) : 0;
            m0 &= m0 - 1u; m1 &= m1 - 1u;
            const bf16_t* y0 = YE + ((size_t)e0 * CAP + s0) * D + 4 * lane; const bf16_t* y1 = YE + ((size_t)e1 * CAP + s1) * D + 4 * lane;
            u32x2 q0[4], q1[4];
#pragma unroll
            for (int j = 0; j < 4; ++j) { q0[j] = *(const u32x2*)(y0 + 256 * j); q1[j] = *(const u32x2*)(y1 + 256 * j); }
#pragma unroll
            for (int j = 0; j < 4; ++j) { acc0[j].x += f0 * bflo(q0[j].x); acc0[j].y += f0 * bfhi(q0[j].x); acc0[j].z += f0 * bflo(q0[j].y); acc0[j].w += f0 * bfhi(q0[j].y);
                                          acc1[j].x += f1 * bflo(q1[j].x); acc1[j].y += f1 * bfhi(q1[j].x); acc1[j].z += f1 * bflo(q1[j].y); acc1[j].w += f1 * bfhi(q1[j].y); }
        }
        f32x4 h[4]; float ss0 = 0.f, ss1 = 0.f;
#pragma unroll
        for (int j = 0; j < 4; ++j) { const f32x4 gv = *(const f32x4*)(gate + 4 * lane + 256 * j); v0[j] = v0[j] + gv * acc0[j]; v1[j] = v1[j] + gv * acc1[j];
            ((f32x4*)(xout + (size_t)row * D) + lane)[64 * j] = v0[j]; if (two) ((f32x4*)(xout + (size_t)row1 * D) + lane)[64 * j] = v1[j];
            ss0 += (v0[j].x * v0[j].x + v0[j].y * v0[j].y) + (v0[j].z * v0[j].z + v0[j].w * v0[j].w); ss1 += (v1[j].x * v1[j].x + v1[j].y * v1[j].y) + (v1[j].z * v1[j].z + v1[j].w * v1[j].w); }
        if (do_norm) { ss0 = wave_sum(ss0); ss1 = wave_sum(ss1); norm_mod_row(v0, ss0, w, scale, shift, HB + (size_t)row * D, lane, h); if (two) norm_mod_row(v1, ss1, w, scale, shift, HB + (size_t)row1 * D, lane, h); }
    }
}

__global__ void __launch_bounds__(NWAVES * 64, 2) mega(Params p) {
    extern __shared__ __attribute__((aligned(16))) unsigned char lds[];
    Frame F;
    F.lds = (LAS unsigned char*)lds;
    volatile LAS unsigned* MISC = (volatile LAS unsigned*)(F.lds + MISC_OFF);
    F.tid = threadIdx.x; F.lane = F.tid & 63; F.wave = __builtin_amdgcn_readfirstlane(F.tid >> 6);
    F.G = gridDim.x; { const int bx = blockIdx.x; F.vcu = (F.G % 8 == 0) ? (bx % 8) * (F.G / 8) + bx / 8 : bx; }
    unsigned char* ws = p.ws;
    unsigned* ctl = (unsigned*)(ws + WS_CTL);
    for (int u = F.tid; u < (LDS_BYTES - LDSCTL_OFF) / 4; u += NWAVES * 64) ((LAS unsigned*)(F.lds + LDSCTL_OFF))[u] = 0u;
    __syncthreads();
    XcdBarrier bar = xcd_barrier_post(ctl + CW_BAR + p.li * XCD_BAR_WORDS, MISC + 8);
    const int lo = p.ph_lo, hi = p.ph_hi;
#define IN(k) (lo <= (k) && (k) < hi)
#define SEAM(k) do { if (IN(k) && IN((k) + 1)) xcd_barrier(bar); } while (0)
#define REFRESH() do { F.lane = lane_id_opaque(); F.tid = F.wave * 64 + F.lane; } while (0)

#define WSP(T, off) ((T*)(GAS T*)(wsl + (off)))
#define WSL() unsigned char* wsl = p.ws; asm volatile("" : "+s"(wsl))
    LAS float* scr = (LAS float*)(F.lds + RING_OFF + F.wave * 8704);

    if (IN(PH_PRO)) { REFRESH(); WSL();
        mod_units(F, p);
        for (int l = 0; l < NL; ++l) {
            conv_matrix(F, p.w_in + (size_t)l * D * INW, INW, D, INW, WSP(bf16_t, WS_WIN) + (size_t)l * INW * D, scr);
            conv_matrix(F, p.w_ba + (size_t)l * 512 * D, D, 512, D, WSP(bf16_t, WS_WBA) + (size_t)l * D * 512, scr);
            conv_matrix(F, p.w_bh + (size_t)l * 512 * D, D, 512, D, WSP(bf16_t, WS_WBH) + (size_t)l * D * 512, scr);
            conv_matrix(F, p.w_out + (size_t)l * D * D, D, D, D, WSP(bf16_t, WS_WOUT) + (size_t)l * D * D, scr);
        }
        for (int rep_ = 0; rep_ < REP_PRO; ++rep_) { conv_experts_f8(F, p, 0, scr); conv_experts_f8(F, p, 1, scr); }
        ph_rope_table(F, WSP(float, WS_ROPE));
    }
    SEAM(PH_PRO);
    if (IN(PH_NORM1)) { REFRESH(); WSL(); ph_norm1(F, p.x, p.norm_mix_w, WSP(float, WS_MOD) + 1 * D, WSP(float, WS_MOD) + 0 * D, WSP(bf16_t, WS_HB), WSP(unsigned char, WS_HBF8)); }
    SEAM(PH_NORM1);

    for (int l = 0; l < NL; ++l) {
        const int pb = PH_L0 + l * NPL;
        if (IN(pb + P_G1)) { WSL();
            pg8::Gemm g{WSP(bf16_t, WS_HB), WSP(bf16_t, WS_WIN) + (size_t)l * INW * D, S, 3072, D}; pg8::StaticOrder So; So.init(S, 3072, F.G, (int)blockIdx.x);
            pg8::EpiInproj E{WSP(bf16_t, WS_QR), WSP(bf16_t, WS_KR), WSP(bf16_t, WS_VV), WSP(bf16_t, WS_HQ), WSP(bf16_t, WS_KF), WSP(bf16_t, WS_HV), WSP(bf16_t, WS_HG), WSP(bf16_t, WS_GG), WSP(float, WS_LF), WSP(float, WS_LBV) + l * 1024, 1.0f};
            for (int rep_ = 0; rep_ < REP_G; ++rep_) pg8::gemm_phase<pg8::EpiInproj, pg8::StaticOrder, true, true>(F.lds + RING_OFF, g, So, E, F.wave);
        }
        SEAM(pb + P_G1);
        if (IN(pb + P_QKP)) { WSL();
            {
              pg8::Gemm g{WSP(bf16_t, WS_HB), WSP(bf16_t, WS_WIN) + (size_t)l * INW * D + (size_t)3072 * D, S, 2304, D}; pg8::OffOrder So; So.So.init(S, 2304, F.G, (int)blockIdx.x); So.off = 12;
              pg8::EpiInproj E{WSP(bf16_t, WS_QR), WSP(bf16_t, WS_KR), WSP(bf16_t, WS_VV), WSP(bf16_t, WS_HQ), WSP(bf16_t, WS_KF), WSP(bf16_t, WS_HV), WSP(bf16_t, WS_HG), WSP(bf16_t, WS_GG), WSP(float, WS_LF), WSP(float, WS_LBV) + l * 1024, 1.0f};
              for (int rep_ = 0; rep_ < REP_G; ++rep_) pg8::gemm_phase<pg8::EpiInproj, pg8::OffOrder, true, true>(F.lds + RING_OFF, g, So, E, F.wave); }
            { const bool even = (F.G == 256); const int rk = even ? (int)blockIdx.x - 64 : (int)blockIdx.x, nr = even ? 192 : F.G;
              for (int rep_ = 0; rep_ < REP_QK; ++rep_) ph_qkprep(F, WSP(bf16_t, WS_QR), WSP(bf16_t, WS_KR), p.q_norm_w + l * 64, p.k_norm_w + l * 64, WSP(float, WS_ROPE), WSP(bf16_t, WS_QN), WSP(bf16_t, WS_KN), rk, nr); }
            for (int rep_ = 0; rep_ < REP_HG; ++rep_) for (int u = blockIdx.x; u < 256; u += F.G) hg::segment<false>(F.lds, u, WSP(bf16_t, WS_HQ), WSP(float, WS_LF), WSP(bf16_t, WS_KF), WSP(bf16_t, WS_HV), WSP(float, WS_HST), WSP(float, WS_HST + 16 * MiB), nullptr, F.wave);
        }
        SEAM(pb + P_QKP);
        if (IN(pb + P_HGB)) { WSL(); OPAQUE_LANE(); (void)lane;
            for (int gid = blockIdx.x * 512 + t_; gid < 8 * 16384; gid += F.G * 512) hg::carry(WSP(float, WS_HST), WSP(float, WS_HST + 16 * MiB), gid);
        }
        SEAM(pb + P_HGB);
        if (IN(pb + P_HGC)) { WSL();
            for (int rep_ = 0; rep_ < REP_HG; ++rep_) for (int u = blockIdx.x; u < 256; u += F.G) hg::segment<true>(F.lds, u, WSP(bf16_t, WS_HQ), WSP(float, WS_LF), WSP(bf16_t, WS_KF), WSP(bf16_t, WS_HV), WSP(float, WS_HST), WSP(float, WS_HST + 16 * MiB), WSP(float, WS_OF), F.wave);
        }
        SEAM(pb + P_HGC);
        if (IN(pb + P_ATT)) { WSL();
            for (int rep_ = 0; rep_ < REP_QK; ++rep_) ph_hgfin(F, WSP(float, WS_OF), WSP(bf16_t, WS_HG), p.hg_norm_w + l * 128, WSP(bf16_t, WS_OHG));
            const attn_body::AttnTensors AT{(const attn_body::bf16*)WSP(bf16_t, WS_QN), (const attn_body::bf16*)WSP(bf16_t, WS_KN), (const attn_body::bf16*)WSP(bf16_t, WS_VV), (attn_body::bf16*)WSP(bf16_t, WS_OATT)};
            const attn_body::StaticOrder So((int)F.G, (int)blockIdx.x);
            float negM;
            { const int ln = lane_id_opaque(); float mq = fabsf(p.q_norm_w[l * 64 + ln]), mk = fabsf(p.k_norm_w[l * 64 + ln]);
#pragma unroll
              for (int o_ = 1; o_ < 64; o_ <<= 1) { mq = fmaxf(mq, __shfl_xor(mq, o_)); mk = fmaxf(mk, __shfl_xor(mk, o_)); }
              negM = -(64.0f * C2) * mq * mk * 1.0001f; }
            for (int rep_ = 0; rep_ < REP_ATT; ++rep_) attn_body::attn_phase<attn_body::StaticOrder>((char*)lds + RING_OFF, AT, So, F.wave, negM);
        }
        SEAM(pb + P_ATT);
        if (IN(pb + P_G2)) { WSL();
            pg8::Gemm g{WSP(bf16_t, WS_OATT), WSP(bf16_t, WS_WBA) + (size_t)l * D * 512, S, D, 512, WSP(bf16_t, WS_OHG), WSP(bf16_t, WS_WBH) + (size_t)l * D * 512};
            pg8::ChainOrder So; So.So.init(S, D, F.G, (int)blockIdx.x);
            pg8::EpiMerge E{WSP(bf16_t, WS_GG), WSP(bf16_t, WS_MG)};
            for (int rep_ = 0; rep_ < REP_G; ++rep_) pg8::gemm_phase<pg8::EpiMerge, pg8::ChainOrder, false, true>(F.lds + RING_OFF, g, So, E, F.wave);
        }
        SEAM(pb + P_G2);
        if (IN(pb + P_G3)) { WSL();
            pg8::Gemm g{WSP(bf16_t, WS_MG), WSP(bf16_t, WS_WOUT) + (size_t)l * D * D, S, D, D}; pg8::StaticOrder So; So.init(S, D, F.G, (int)blockIdx.x);
            pg8::EpiOut E{l == 0 ? p.x : WSP(float, WS_X2), WSP(float, WS_MOD) + l * 6 * D + 2 * D, WSP(float, WS_X1)};
            for (int rep_ = 0; rep_ < REP_G; ++rep_) pg8::gemm_phase<pg8::EpiOut, pg8::StaticOrder, false, true>(F.lds + RING_OFF, g, So, E, F.wave);
        }
        SEAM(pb + P_G3);
        if (IN(pb + P_N2R)) { WSL();
            for (int rep_ = 0; rep_ < REP_ROW; ++rep_) ph_norm2_router(F, WSP(float, WS_X1), p.norm_ffn_w + l * D, WSP(float, WS_MOD) + l * 6 * D + 4 * D, WSP(float, WS_MOD) + l * 6 * D + 3 * D, p.w_router + (size_t)l * D * NE, WSP(unsigned char, WS_HB8), WSP(float, WS_AFF));
        }
        SEAM(pb + P_N2R);
        if (IN(pb + P_TOPK)) { WSL();
            for (int rep_ = 0; rep_ < REP_TK; ++rep_) for (int e = blockIdx.x; e < NE; e += F.G) ph_topk(F, F.lds, e, WSP(float, WS_AFF), WSP(int, WS_IDX), WSP(float, WS_TOPW), WSP(int, WS_SLOT));
        }
        SEAM(pb + P_TOPK);
        if (IN(pb + P_G4)) { WSL();
            pg8::Gemm g{(const bf16_t*)WSP(unsigned char, WS_HB8), (const bf16_t*)(WSP(unsigned char, WS_WGU) + (size_t)l * 64 * MiB), NE * CAP, NE * 4096, D / 2, nullptr, nullptr, WSP(int, WS_IDX)}; pg8::GroupOrder So; So.init(16, F.G, (int)blockIdx.x);
            pg8::EpiGU8 E{WSP(unsigned char, WS_HID8)};
            for (int rep_ = 0; rep_ < REP_G; ++rep_) pg8::gemm_phase<pg8::EpiGU8, pg8::GroupOrder, true, true, true, true>(F.lds + RING_OFF, g, So, E, F.wave);
        }
        SEAM(pb + P_G4);
        if (IN(pb + P_G5)) { WSL();
            pg8::Gemm g{(const bf16_t*)WSP(unsigned char, WS_HID8), (const bf16_t*)(WSP(unsigned char, WS_WD) + (size_t)l * 32 * MiB), NE * CAP, NE * 1024, FF / 2}; pg8::GroupOrder So; So.init(4, F.G, (int)blockIdx.x);
            pg8::EpiDown E{WSP(bf16_t, WS_YE), WSP(float, WS_TOPW), 0.015625f};
            for (int rep_ = 0; rep_ < REP_G; ++rep_) pg8::gemm_phase<pg8::EpiDown, pg8::GroupOrder, true, true, true>(F.lds + RING_OFF, g, So, E, F.wave);
        }
        SEAM(pb + P_G5);
        if (IN(pb + P_COMB)) { WSL();
            const bool last = (l + 1 == NL); const int ln = last ? l : l + 1;
            for (int rep_ = 0; rep_ < REP_ROW; ++rep_) ph_combine(F, WSP(float, WS_X1), WSP(bf16_t, WS_YE), WSP(int, WS_SLOT), WSP(float, WS_MOD) + l * 6 * D + 5 * D, last ? p.out : WSP(float, WS_X2),
                       p.norm_mix_w + ln * D, WSP(float, WS_MOD) + ln * 6 * D + 1 * D, WSP(float, WS_MOD) + ln * 6 * D + 0 * D, WSP(bf16_t, WS_HB), WSP(unsigned char, WS_HBF8), !last);
        }
        SEAM(pb + P_COMB);
    }
#undef IN
#undef SEAM
}

#ifndef N_LAUNCH_MODE
#define N_LAUNCH_MODE 1
#endif
static int g_grid = 0;
extern "C" void kernel_launch(void* const* d_in, const int* in_sizes, int n_in, void* d_out, int out_size, void* d_ws, size_t ws_size, hipStream_t stream) {
    if (n_in != 18 || out_size != S * D || ws_size < WS_END) { fprintf(stderr, "kernel_launch: unexpected shapes (n_in %d out %d ws %zu)\n", n_in, out_size, ws_size); return; }
    if (g_grid == 0) {
        int dev = 0, cus = 0;
        if (hipGetDevice(&dev) != hipSuccess || hipDeviceGetAttribute(&cus, hipDeviceAttributeMultiprocessorCount, dev) != hipSuccess) { g_grid = -1; return; }
        if (hipFuncSetAttribute((const void*)mega, hipFuncAttributeMaxDynamicSharedMemorySize, LDS_BYTES) != hipSuccess) { g_grid = -1; return; }
        int per_cu = 0;
        if (hipOccupancyMaxActiveBlocksPerMultiprocessor(&per_cu, (const void*)mega, NWAVES * 64, LDS_BYTES) != hipSuccess || per_cu < 1) { fprintf(stderr, "occupancy query: %d\n", per_cu); }
        (void)hipGetLastError();
        g_grid = cus;
    }
    if (g_grid < 0) return;
    unsigned char* ws = (unsigned char*)d_ws;
    (void)hipMemsetAsync(ws + WS_CTL, 0, 1 * MiB, stream);
    Params p{};
    p.x = (const float*)d_in[0]; p.c = (const float*)d_in[1]; p.ada_w = (const float*)d_in[2]; p.ada_b = (const float*)d_in[3]; p.norm_mix_w = (const float*)d_in[4];
    p.norm_ffn_w = (const float*)d_in[5]; p.w_in = (const float*)d_in[6]; p.q_norm_w = (const float*)d_in[7]; p.k_norm_w = (const float*)d_in[8]; p.hlb = (const float*)d_in[9];
    p.hg_norm_w = (const float*)d_in[10]; p.w_ba = (const float*)d_in[11]; p.w_bh = (const float*)d_in[12]; p.w_out = (const float*)d_in[13]; p.w_router = (const float*)d_in[14];
    p.w_eg = (const float*)d_in[15]; p.w_eu = (const float*)d_in[16]; p.w_ed = (const float*)d_in[17];
    p.out = (float*)d_out; p.ws = ws;
#if defined(DBG_ATT)
    { const int cut = PH_L0 + P_ATT + 1;
      p.ph_lo = 0; p.ph_hi = cut; p.li = 0; p.pad = 0; hipLaunchKernelGGL(mega, dim3(g_grid), dim3(NWAVES * 64), LDS_BYTES, stream, p);
      hipMemcpyAsync(ws + 900 * MiB, ws + WS_OATT, 16 * MiB, hipMemcpyDeviceToDevice, stream);
      k_attn_naive<<<dim3(S / 64, 8), dim3(64), 0, stream>>>((const bf16_t*)(ws + WS_QN), (const bf16_t*)(ws + WS_KN), (const bf16_t*)(ws + WS_VV), (bf16_t*)(ws + WS_OATT));
      k_cmp_bf16<<<dim3(2048), dim3(256), 0, stream>>>((const bf16_t*)(ws + 900 * MiB), (const bf16_t*)(ws + WS_OATT), (size_t)8 * MiB, 512, 0, 512, (float*)(ws + 512 * 1024));
      p.ph_lo = cut; p.ph_hi = PH_END; p.li = 1; hipLaunchKernelGGL(mega, dim3(g_grid), dim3(NWAVES * 64), LDS_BYTES, stream, p);
      k_scale_out<<<dim3(2048), dim3(256), 0, stream>>>((float*)d_out, (size_t)S * D, (const float*)(ws + 512 * 1024)); }
#elif N_LAUNCH_MODE == 1
    p.ph_lo = 0; p.ph_hi = PH_END; p.li = 0; p.pad = 0;
    hipLaunchKernelGGL(mega, dim3(g_grid), dim3(NWAVES * 64), LDS_BYTES, stream, p);
#else
    for (int k = 0; k < PH_END; ++k) { p.ph_lo = k; p.ph_hi = k + 1; p.li = k; p.pad = 0; hipLaunchKernelGGL(mega, dim3(g_grid), dim3(NWAVES * 64), LDS_BYTES, stream, p); }
#endif
}
```

```cpp
#include <hip/hip_runtime.h>
#include <cstdio>
#include <cstdint>

typedef unsigned short bf16_t;
typedef float f32x4 __attribute__((ext_vector_type(4)));
typedef float f32x16 __attribute__((ext_vector_type(16)));
typedef unsigned u32x4 __attribute__((ext_vector_type(4)));
typedef unsigned u32x2 __attribute__((ext_vector_type(2)));

constexpr int S = 16384, D = 1024, NL = 2, INW = 5376;
constexpr int NE = 16, CAP = 2048, FF = 2048;
constexpr float EPS = 1e-6f;
constexpr float C2 = 0.125f * 1.4426950408889634f;
constexpr int C_AQ = 0, C_AK = 512, C_AV = 640, C_HQ = 768, C_ZF = 1280, C_ZB = 1792, C_HI = 2304, C_HGT = 2816, C_GL = 3328;

constexpr size_t MiB = 1u << 20;
constexpr size_t WS_CTL = 0;
constexpr size_t WS_MOD = 1 * MiB;
constexpr size_t WS_LBV = WS_MOD + 64 * 1024;
constexpr size_t WS_IDX = WS_MOD + 128 * 1024;
constexpr size_t WS_TOPW = WS_IDX + 128 * 1024;
constexpr size_t WS_ROPE = WS_MOD + 512 * 1024;
constexpr size_t WS_AFF = 2 * MiB;
constexpr size_t WS_SLOT = 3 * MiB;
constexpr size_t WS_HB = 4 * MiB;
constexpr size_t WS_QR = 36 * MiB;
constexpr size_t WS_KR = 52 * MiB;
constexpr size_t WS_VV = 56 * MiB;
constexpr size_t WS_QN = 60 * MiB;
constexpr size_t WS_KN = 76 * MiB;
constexpr size_t WS_HQ = 80 * MiB;
constexpr size_t WS_LF = 96 * MiB;
constexpr size_t WS_KF = 160 * MiB;
constexpr size_t WS_HV = 192 * MiB;
constexpr size_t WS_HG = 208 * MiB;
constexpr size_t WS_GG = 224 * MiB;
constexpr size_t WS_OATT = 288 * MiB;
constexpr size_t WS_OF = 304 * MiB;
constexpr size_t WS_OHG = 368 * MiB;
constexpr size_t WS_MP = 384 * MiB;
constexpr size_t WS_MG = 448 * MiB;
constexpr size_t WS_HB8 = 36 * MiB;
constexpr size_t WS_XE8 = 52 * MiB;
constexpr size_t WS_HID8 = 100 * MiB;
constexpr size_t WS_XE = 36 * MiB;
constexpr size_t WS_HID = 100 * MiB;
constexpr size_t WS_YE = 228 * MiB;
constexpr size_t WS_X1 = 480 * MiB;
constexpr size_t WS_X2 = 544 * MiB;
constexpr size_t WS_WIN = 608 * MiB;
constexpr size_t WS_WBA = 630 * MiB;
constexpr size_t WS_WBH = 632 * MiB;
constexpr size_t WS_WOUT = 634 * MiB;
constexpr size_t WS_WGU = 638 * MiB;
constexpr size_t WS_WD = 766 * MiB;
constexpr size_t WS_HST = 830 * MiB;
constexpr size_t WS_Q8 = 912 * MiB;
constexpr size_t WS_K8 = 920 * MiB;
constexpr size_t WS_V8T = 922 * MiB;
constexpr size_t WS_WIN8 = 900 * MiB;
constexpr size_t WS_HBF8 = 906 * MiB;
constexpr size_t WS_END = 924 * MiB;
static_assert(WS_END <= 1024 * MiB, "workspace");

__device__ __forceinline__ float bf2f(bf16_t v) { return __uint_as_float((unsigned)v << 16); }
__device__ __forceinline__ bf16_t f2bf(float f) { unsigned u = __float_as_uint(f); return (bf16_t)((u + 0x7fffu + ((u >> 16) & 1u)) >> 16); }
__device__ __forceinline__ unsigned pk2(float lo, float hi) { return (unsigned)f2bf(lo) | ((unsigned)f2bf(hi) << 16); }
__device__ __forceinline__ float bflo(unsigned w) { return __uint_as_float(w << 16); }
__device__ __forceinline__ float bfhi(unsigned w) { return __uint_as_float(w & 0xffff0000u); }
__device__ __forceinline__ float sigmoidf_(float v) { return __builtin_amdgcn_rcpf(1.0f + __expf(-v)); }
__device__ __forceinline__ float siluf_(float v) { return v * __builtin_amdgcn_rcpf(1.0f + __expf(-v)); }
__device__ __forceinline__ float wave_sum(float v) {
#pragma unroll
    for (int o = 1; o < 64; o <<= 1) v += __shfl_xor(v, o);
    return v;
}
__device__ __forceinline__ int crow(int r, int hi) { return (r & 3) + 8 * (r >> 2) + 4 * hi; }
__device__ __forceinline__ int lane_id_opaque() { int l; asm volatile("v_mbcnt_lo_u32_b32 %0, -1, 0\n\tv_mbcnt_hi_u32_b32 %0, -1, %0" : "=v"(l)); return l; }

#define GAS __attribute__((address_space(1)))
#define LAS __attribute__((address_space(3)))

namespace pg8 {
#define PG8_LAS __attribute__((address_space(3)))
typedef unsigned short bf16_t;
typedef short bf16x8 __attribute__((ext_vector_type(8)));
typedef float f32x4 __attribute__((ext_vector_type(4)));
typedef unsigned u32x4 __attribute__((ext_vector_type(4)));
constexpr int BM = 256, BK = 64, HALF = 128, HTB = HALF * BK * 2  , STAGE_BYTES = 8 * HTB, NXCD = 8, WGM = 8;

__host__ __device__ __forceinline__ int lds_byte(int r, int c) { const int st = (r >> 4) * 2 + (c >> 5), rr = r & 15, cc = c & 31, ob = rr * 64 + cc * 2; return st * 1024 + (ob ^ (((ob >> 9) & 1) << 5)); }
__host__ __device__ __forceinline__ void stage_rc(int b, int& R, int& C) { const int st = b / 1024, sb = b % 1024, swz = sb ^ (((sb >> 9) & 1) << 5); R = (st >> 1) * 16 + swz / 64; C = (st & 1) * 32 + (swz % 64) / 2; }
__host__ __device__ __forceinline__ int perm32(int rho) { const int n = rho >> 4, i = rho & 15; return 8 * (i >> 2) + 4 * n + (i & 3); }

struct Unit { int pm, pn, pb, sel; };
struct Gemm { const bf16_t* A; const bf16_t* Bt; int M, N, K; const bf16_t* A2 = nullptr; const bf16_t* Bt2 = nullptr; const int* rowidx = nullptr; };

struct StaticOrder {
    int nM, nN, nwg, G, c;
    __host__ __device__ void init(int M, int N, int G_, int c_) { nM = M / BM; nN = N / BM; nwg = nM * nN; G = G_; c = c_; }
    __host__ __device__ bool next(int i, Unit& u) const {
        const long L = (long)i * G + c; if (L >= nwg) return false;
        int wgid = (int)L; { const int q = nwg / NXCD, r = nwg % NXCD, xcd = wgid % NXCD, off = wgid / NXCD; wgid = (xcd < r ? xcd * (q + 1) : r * (q + 1) + (xcd - r) * q) + off; }
        const int nig = WGM * nN, gid = wgid / nig, fm = gid * WGM, gsz = (nM - fm) < WGM ? (nM - fm) : WGM;
        u.pm = fm + ((wgid % nig) % gsz); u.pn = (wgid % nig) / gsz; u.pb = u.pn; u.sel = 0; return true;
    }
    __device__ __forceinline__ void a_ready(const Unit&) const {}
    __device__ __forceinline__ void done(const Unit&) const {}
};

typedef float f32x2_c __attribute__((ext_vector_type(2))); typedef __bf16 bf16x2_c __attribute__((ext_vector_type(2)));
__device__ __forceinline__ unsigned cvt_pk_bf16(float lo, float hi) { f32x2_c v = {lo, hi}; bf16x2_c b = __builtin_convertvector(v, bf16x2_c); return __builtin_bit_cast(unsigned, b); }

typedef unsigned u32x2 __attribute__((ext_vector_type(2)));
__device__ __forceinline__ float e_bflo(unsigned w) { return __uint_as_float(w << 16); }
__device__ __forceinline__ float e_bfhi(unsigned w) { return __uint_as_float(w & 0xffff0000u); }
__device__ __forceinline__ float e_sig(float v) { return __builtin_amdgcn_rcpf(1.0f + __expf(-v)); }
__device__ __forceinline__ u32x4 pack8(const f32x4 a, const f32x4 b) { u32x4 w; w.x = cvt_pk_bf16(a[0], a[1]); w.y = cvt_pk_bf16(a[2], a[3]); w.z = cvt_pk_bf16(b[0], b[1]); w.w = cvt_pk_bf16(b[2], b[3]); return w; }

typedef int i32x4_ __attribute__((ext_vector_type(4))); typedef int i32x8_ __attribute__((ext_vector_type(8)));
__device__ __forceinline__ i32x8_ pg8_cat(const bf16x8 lo, const bf16x8 hi) { return __builtin_shufflevector(__builtin_bit_cast(i32x4_, lo), __builtin_bit_cast(i32x4_, hi), 0, 1, 2, 3, 4, 5, 6, 7); }
__device__ __forceinline__ u32x2 pack8_fp8(const f32x4 a, const f32x4 b) { int w0 = 0, w1 = 0;
    w0 = __builtin_amdgcn_cvt_pk_fp8_f32(a[0], a[1], w0, false); w0 = __builtin_amdgcn_cvt_pk_fp8_f32(a[2], a[3], w0, true);
    w1 = __builtin_amdgcn_cvt_pk_fp8_f32(b[0], b[1], w1, false); w1 = __builtin_amdgcn_cvt_pk_fp8_f32(b[2], b[3], w1, true);
    u32x2 r; r.x = (unsigned)w0; r.y = (unsigned)w1; return r; }
struct EpiInproj {
    static constexpr bool PERM = true, AFTER_DRAIN = false, CHAIN = false;
    bf16_t *QR, *KR, *VV, *HQ, *KF, *HV, *HG, *GG; float* LF; const float* lbv; float ascale;
    __device__ __forceinline__ void operator()(const f32x4 (&acc)[2][2][4][2], const Unit& u, int wr, int wc, int fr, int fq) const {
        const int row0 = u.pm * BM + wr * 64 + fr, cl = wc * 32 + 8 * fq;
#pragma unroll
        for (int bj = 0; bj < 2; ++bj) {
            const int colg = u.pn * BM + bj * HALF;
            int kind; bf16_t* dst; int pitch, c0; int dir = 0;
            if (colg < 512) { kind = 0; dst = QR; pitch = 512; c0 = colg; }
            else if (colg < 640) { kind = 0; dst = KR; pitch = 128; c0 = colg - 512; }
            else if (colg < 768) { kind = 0; dst = VV; pitch = 128; c0 = colg - 640; }
            else if (colg < 1280) { kind = 1; dst = HQ; pitch = 512; c0 = colg - 768; }
            else if (colg < 2304) { kind = 3; dir = colg >= 1792; dst = KF + (size_t)dir * 16384 * 512; pitch = 512; c0 = colg - (dir ? 1792 : 1280); }
            else if (colg < 2816) { kind = 0; dst = HV; pitch = 512; c0 = colg - 2304; }
            else if (colg < 3328) { kind = 1; dst = HG; pitch = 512; c0 = colg - 2816; }
            else { kind = 2; dst = GG; pitch = 2048; c0 = colg - 3328; }
            c0 += cl;
            if (kind == 0) {
#pragma unroll
                for (int ai = 0; ai < 2; ++ai)
#pragma unroll
                    for (int m = 0; m < 4; ++m) *(u32x4*)(dst + (size_t)(row0 + ai * HALF + m * 16) * pitch + c0) = pack8(acc[ai][bj][m][0] * ascale, acc[ai][bj][m][1] * ascale);
            } else if (kind == 1) {
#pragma unroll
                for (int ai = 0; ai < 2; ++ai)
#pragma unroll
                    for (int m = 0; m < 4; ++m) { f32x4 a = acc[ai][bj][m][0] * ascale, b = acc[ai][bj][m][1] * ascale;
#pragma unroll
                        for (int i = 0; i < 4; ++i) { a[i] = a[i] * e_sig(a[i]); b[i] = b[i] * e_sig(b[i]); }
                        *(u32x4*)(dst + (size_t)(row0 + ai * HALF + m * 16) * pitch + c0) = pack8(a, b); }
            } else if (kind == 2) {
#pragma unroll
                for (int ai = 0; ai < 2; ++ai)
#pragma unroll
                    for (int m = 0; m < 4; ++m) { f32x4 a = acc[ai][bj][m][0] * ascale, b = acc[ai][bj][m][1] * ascale;
#pragma unroll
                        for (int i = 0; i < 4; ++i) { a[i] = e_sig(a[i]); b[i] = e_sig(b[i]); }
                        *(u32x4*)(dst + (size_t)(row0 + ai * HALF + m * 16) * pitch + c0) = pack8(a, b); }
            } else {
                const f32x4 lb0 = *(const f32x4*)(lbv + dir * 512 + c0), lb1 = *(const f32x4*)(lbv + dir * 512 + c0 + 4);
                float* lf = LF + (size_t)dir * 16384 * 512;
#pragma unroll
                for (int ai = 0; ai < 2; ++ai)
#pragma unroll
                    for (int m = 0; m < 4; ++m) { const f32x4 a = acc[ai][bj][m][0] * ascale, b = acc[ai][bj][m][1] * ascale; f32x4 la, lb_, ka, kb;
#pragma unroll
                        for (int i = 0; i < 4; ++i) {
                            const float sa = e_sig(a[i]), sb = e_sig(b[i]);
                            la[i] = __logf(fmaxf(lb0[i] + (1.0f - lb0[i]) * sa, 1e-6f)); ka[i] = (1.0f - lb0[i]) * (1.0f - sa);
                            lb_[i] = __logf(fmaxf(lb1[i] + (1.0f - lb1[i]) * sb, 1e-6f)); kb[i] = (1.0f - lb1[i]) * (1.0f - sb); }
                        const size_t o = (size_t)(row0 + ai * HALF + m * 16) * 512 + c0;
                        *(f32x4*)(lf + o) = la; *(f32x4*)(lf + o + 4) = lb_;
                        *(u32x4*)(dst + o) = pack8(ka, kb); }
            }
        }
    }
};
struct EpiBrA {
    static constexpr bool PERM = true, AFTER_DRAIN = false, CHAIN = false;
    const bf16_t* GG; float* MP;
    __device__ __forceinline__ void operator()(const f32x4 (&acc)[2][2][4][2], const Unit& u, int wr, int wc, int fr, int fq) const {
        const int row0 = u.pm * BM + wr * 64 + fr, col0 = u.pn * BM + wc * 32 + 8 * fq;
#pragma unroll
        for (int ai = 0; ai < 2; ++ai)
#pragma unroll
            for (int m = 0; m < 4; ++m) { const size_t r = (size_t)(row0 + ai * HALF + m * 16);
#pragma unroll
                for (int bj = 0; bj < 2; ++bj) { const int c = col0 + bj * HALF; const u32x4 g = *(const u32x4*)(GG + r * 2048 + c);
                    f32x4 a = acc[ai][bj][m][0], b = acc[ai][bj][m][1];
                    a[0] *= e_bflo(g.x); a[1] *= e_bfhi(g.x); a[2] *= e_bflo(g.y); a[3] *= e_bfhi(g.y); b[0] *= e_bflo(g.z); b[1] *= e_bfhi(g.z); b[2] *= e_bflo(g.w); b[3] *= e_bfhi(g.w);
                    *(f32x4*)(MP + r * 1024 + c) = a; *(f32x4*)(MP + r * 1024 + c + 4) = b; } }
    }
};
struct EpiBrH {
    static constexpr bool PERM = true, AFTER_DRAIN = false, CHAIN = false;
    const bf16_t* GG; const float* MP; bf16_t* MG;
    __device__ __forceinline__ void operator()(const f32x4 (&acc)[2][2][4][2], const Unit& u, int wr, int wc, int fr, int fq) const {
        const int row0 = u.pm * BM + wr * 64 + fr, col0 = u.pn * BM + wc * 32 + 8 * fq;
#pragma unroll
        for (int ai = 0; ai < 2; ++ai)
#pragma unroll
            for (int m = 0; m < 4; ++m) { const size_t r = (size_t)(row0 + ai * HALF + m * 16);
#pragma unroll
                for (int bj = 0; bj < 2; ++bj) { const int c = col0 + bj * HALF; const u32x4 g = *(const u32x4*)(GG + r * 2048 + 1024 + c);
                    f32x4 a = acc[ai][bj][m][0], b = acc[ai][bj][m][1]; const f32x4 pa = *(const f32x4*)(MP + r * 1024 + c), pb = *(const f32x4*)(MP + r * 1024 + c + 4);
                    a[0] = pa[0] + a[0] * e_bflo(g.x); a[1] = pa[1] + a[1] * e_bfhi(g.x); a[2] = pa[2] + a[2] * e_bflo(g.y); a[3] = pa[3] + a[3] * e_bfhi(g.y);
                    b[0] = pb[0] + b[0] * e_bflo(g.z); b[1] = pb[1] + b[1] * e_bfhi(g.z); b[2] = pb[2] + b[2] * e_bflo(g.w); b[3] = pb[3] + b[3] * e_bfhi(g.w);
                    *(u32x4*)(MG + r * 1024 + c) = pack8(a, b); } }
    }
};
struct EpiMerge {
    static constexpr bool PERM = true, AFTER_DRAIN = false, CHAIN = true;
    const bf16_t* GG; bf16_t* MG;
    __device__ __forceinline__ void mid(f32x4 (&acc)[2][2][4][2], const Unit& u, int wr, int wc, int fr, int fq) const {
        const int row0 = u.pm * BM + wr * 64 + fr, col0 = u.pn * BM + wc * 32 + 8 * fq;
#pragma unroll
        for (int ai = 0; ai < 2; ++ai)
#pragma unroll
            for (int m = 0; m < 4; ++m) { const size_t r = (size_t)(row0 + ai * HALF + m * 16);
#pragma unroll
                for (int bj = 0; bj < 2; ++bj) { const int c = col0 + bj * HALF; const u32x4 g0 = *(const u32x4*)(GG + r * 2048 + c), g1 = *(const u32x4*)(GG + r * 2048 + 1024 + c);
                    f32x4& a = acc[ai][bj][m][0]; f32x4& b = acc[ai][bj][m][1];
                    a[0] *= e_bflo(g0.x) * __builtin_amdgcn_rcpf(e_bflo(g1.x)); a[1] *= e_bfhi(g0.x) * __builtin_amdgcn_rcpf(e_bfhi(g1.x));
                    a[2] *= e_bflo(g0.y) * __builtin_amdgcn_rcpf(e_bflo(g1.y)); a[3] *= e_bfhi(g0.y) * __builtin_amdgcn_rcpf(e_bfhi(g1.y));
                    b[0] *= e_bflo(g0.z) * __builtin_amdgcn_rcpf(e_bflo(g1.z)); b[1] *= e_bfhi(g0.z) * __builtin_amdgcn_rcpf(e_bfhi(g1.z));
                    b[2] *= e_bflo(g0.w) * __builtin_amdgcn_rcpf(e_bflo(g1.w)); b[3] *= e_bfhi(g0.w) * __builtin_amdgcn_rcpf(e_bfhi(g1.w)); } }
    }
    __device__ __forceinline__ void operator()(const f32x4 (&acc)[2][2][4][2], const Unit& u, int wr, int wc, int fr, int fq) const {
        const int row0 = u.pm * BM + wr * 64 + fr, col0 = u.pn * BM + wc * 32 + 8 * fq;
#pragma unroll
        for (int ai = 0; ai < 2; ++ai)
#pragma unroll
            for (int m = 0; m < 4; ++m) { const size_t r = (size_t)(row0 + ai * HALF + m * 16);
#pragma unroll
                for (int bj = 0; bj < 2; ++bj) { const int c = col0 + bj * HALF; const u32x4 g = *(const u32x4*)(GG + r * 2048 + 1024 + c);
                    f32x4 a = acc[ai][bj][m][0], b = acc[ai][bj][m][1];
                    a[0] *= e_bflo(g.x); a[1] *= e_bfhi(g.x); a[2] *= e_bflo(g.y); a[3] *= e_bfhi(g.y); b[0] *= e_bflo(g.z); b[1] *= e_bfhi(g.z); b[2] *= e_bflo(g.w); b[3] *= e_bfhi(g.w);
                    *(u32x4*)(MG + r * 1024 + c) = pack8(a, b); } }
    }
};
struct OffOrder {
    StaticOrder So; int off;
    __device__ bool next(int i, Unit& u) const { if (!So.next(i, u)) return false; u.pb = u.pn; u.pn += off; return true; }
    __device__ __forceinline__ void a_ready(const Unit&) const {}
    __device__ __forceinline__ void done(const Unit&) const {}
};
struct ChainOrder {
    StaticOrder So;
    __device__ bool next(int i, Unit& u) const { if (!So.next(i >> 1, u)) return false; u.sel = i & 1; return true; }
    __device__ __forceinline__ void a_ready(const Unit&) const {}
    __device__ __forceinline__ void done(const Unit&) const {}
};
struct EpiOut {
    static constexpr bool PERM = true, AFTER_DRAIN = false, CHAIN = false;
    const float* xin; const float* gate; float* X1;
    __device__ __forceinline__ void operator()(const f32x4 (&acc)[2][2][4][2], const Unit& u, int wr, int wc, int fr, int fq) const {
        const int row0 = u.pm * BM + wr * 64 + fr, col0 = u.pn * BM + wc * 32 + 8 * fq;
#pragma unroll
        for (int bj = 0; bj < 2; ++bj) { const int c = col0 + bj * HALF; const f32x4 g0 = *(const f32x4*)(gate + c), g1 = *(const f32x4*)(gate + c + 4);
#pragma unroll
            for (int ai = 0; ai < 2; ++ai)
#pragma unroll
                for (int m = 0; m < 4; ++m) { const size_t o = (size_t)(row0 + ai * HALF + m * 16) * 1024 + c;
                    *(f32x4*)(X1 + o) = *(const f32x4*)(xin + o) + g0 * acc[ai][bj][m][0]; *(f32x4*)(X1 + o + 4) = *(const f32x4*)(xin + o + 4) + g1 * acc[ai][bj][m][1]; } }
    }
};
struct EpiGU {
    static constexpr bool PERM = true, AFTER_DRAIN = false, CHAIN = false;
    bf16_t* HID;
    __device__ __forceinline__ void operator()(const f32x4 (&acc)[2][2][4][2], const Unit& u, int wr, int wc, int fr, int fq) const {
        const int row0 = u.pm * BM + wr * 64 + fr, col0 = u.pn * HALF + wc * 32 + 8 * fq;
#pragma unroll
        for (int ai = 0; ai < 2; ++ai)
#pragma unroll
            for (int m = 0; m < 4; ++m) { f32x4 a = acc[ai][0][m][0], b = acc[ai][0][m][1]; const f32x4 ua = acc[ai][1][m][0], ub = acc[ai][1][m][1];
#pragma unroll
                for (int i = 0; i < 4; ++i) { a[i] = a[i] * e_sig(a[i]) * ua[i]; b[i] = b[i] * e_sig(b[i]) * ub[i]; }
                *(u32x4*)(HID + (size_t)(row0 + ai * HALF + m * 16) * 2048 + col0) = pack8(a, b); }
    }
};
struct EpiGU8 {
    static constexpr bool PERM = true, AFTER_DRAIN = false, CHAIN = false;
    unsigned char* HID;
    __device__ __forceinline__ void operator()(const f32x4 (&acc)[2][2][4][2], const Unit& u, int wr, int wc, int fr, int fq) const {
        const int row0 = u.pm * BM + wr * 64 + fr, col0 = u.pn * HALF + wc * 32 + 8 * fq;
#pragma unroll
        for (int ai = 0; ai < 2; ++ai)
#pragma unroll
            for (int m = 0; m < 4; ++m) { f32x4 a = acc[ai][0][m][0], b = acc[ai][0][m][1]; const f32x4 ua = acc[ai][1][m][0], ub = acc[ai][1][m][1];
#pragma unroll
                for (int i = 0; i < 4; ++i) { const float ga = a[i] * 0.015625f, gb = b[i] * 0.015625f; a[i] = ga * e_sig(ga) * (ua[i] * 0.015625f); b[i] = gb * e_sig(gb) * (ub[i] * 0.015625f); }
                *(u32x2*)(HID + (size_t)(row0 + ai * HALF + m * 16) * 2048 + col0) = pack8_fp8(a, b); }
    }
};
struct EpiDown {
    static constexpr bool PERM = true, AFTER_DRAIN = false, CHAIN = false;
    bf16_t* YE; const float* topw; float wscale;
    __device__ __forceinline__ void operator()(const f32x4 (&acc)[2][2][4][2], const Unit& u, int wr, int wc, int fr, int fq) const {
        const int row0 = u.pm * BM + wr * 64 + fr, col0 = u.pn * BM + wc * 32 + 8 * fq;
#pragma unroll
        for (int ai = 0; ai < 2; ++ai)
#pragma unroll
            for (int m = 0; m < 4; ++m) { const int r = row0 + ai * HALF + m * 16; const float w = topw[r] * wscale;
#pragma unroll
                for (int bj = 0; bj < 2; ++bj) *(u32x4*)(YE + (size_t)r * 1024 + col0 + bj * HALF) = pack8(acc[ai][bj][m][0] * w, acc[ai][bj][m][1] * w); }
    }
};
struct GroupOrder {
    int nNe, nwg, G, c;
    __device__ void init(int nNe_, int G_, int c_) { nNe = nNe_; nwg = 16 * 8 * nNe_; G = G_; c = c_; }
    __device__ bool next(int i, Unit& u) const {
        const long L = (long)i * G + c; if (L >= nwg) return false;
        int wgid = (int)L; { const int q = nwg / NXCD, xcd = wgid % NXCD, off = wgid / NXCD; wgid = xcd * q + off; }
        const int per = 8 * nNe, e = wgid / per, w = wgid % per;
        u.pm = e * 8 + (w & 7); u.pn = w >> 3; u.pb = e * nNe + u.pn; u.sel = 0; return true;
    }
    __device__ __forceinline__ void a_ready(const Unit&) const {}
    __device__ __forceinline__ void done(const Unit&) const {}
};

template <class Epi, class Sched, bool ALIGN_EPI = false, bool SP2 = false, bool FP8 = false, bool GATHER = false>
__device__ __forceinline__ void gemm_phase(PG8_LAS unsigned char* lds, const Gemm g, const Sched& S, const Epi& E, int wave_) {
    const int tid_ = wave_ * 64 + lane_id_opaque();
    const int tid = tid_, wid = __builtin_amdgcn_readfirstlane(tid >> 6), lane = tid & 63, wr = wid >> 2, wc = wid & 3, fr = lane & 15, fq = lane >> 4;
    int K_ = g.K; asm volatile("" : "+s"(K_));
    const int K = K_, nt = K / BK;
    unsigned voffA[2], voffB[2];
#pragma unroll
    for (int i = 0; i < 2; ++i) { int R, C; stage_rc(tid * 16 + i * 8192, R, C); const int Rb = Epi::PERM ? ((R & ~31) + perm32(R & 31)) : R;
        voffA[i] = (unsigned)(R * K + C) * 2u; voffB[i] = (unsigned)(Rb * K + C) * 2u; }
    unsigned vA[2][2] = {{0u, 0u}, {0u, 0u}}, vN[2][2] = {{0u, 0u}, {0u, 0u}};
#define PG8_GOFF(dst, u_) do { if constexpr (GATHER) { _Pragma("unroll") for (int h_ = 0; h_ < 2; ++h_) _Pragma("unroll") for (int i_ = 0; i_ < 2; ++i_) \
        { int R_, C_; stage_rc(tid * 16 + i_ * 8192, R_, C_);     \
          dst[h_][i_] = (unsigned)((const __attribute__((address_space(1))) int*)g.rowidx)[(u_).pm * BM + h_ * HALF + R_] * (unsigned)(K * 2) + (unsigned)C_ * 2u; } } } while (0)
    const size_t kstep = (size_t)(BK * 2);
    const size_t hstep = (size_t)HALF * K * 2;
    const size_t tstep = 2 * hstep;
    const unsigned ldsw = (unsigned)wid * 1024u;
    const int aoff = lds_byte(wr * 64 + fr, fq * 8), boff = lds_byte(wc * 32 + fr, fq * 8);
#define PG8_SA(b, h) (((b) * 2 + (h)) * HTB)
#define PG8_SB(b, h) ((4 + (b) * 2 + (h)) * HTB)
#define PG8_STAGE(bufoff, gbase, voff) do { _Pragma("unroll") for (int _i = 0; _i < 2; ++_i) \
        __builtin_amdgcn_global_load_lds((const unsigned*)((const char*)(gbase) + (voff)[_i]), (PG8_LAS unsigned*)(lds + (bufoff) + ldsw + _i * 8192), 16, 0, 0); } while (0)
#define PG8_STAGE_A(bufoff, gptr, half, nsel) do { if constexpr (GATHER) { unsigned vs_[2]; vs_[0] = (nsel) ? vN[half][0] : vA[half][0]; vs_[1] = (nsel) ? vN[half][1] : vA[half][1]; PG8_STAGE(bufoff, gptr, vs_); } \
        else { PG8_STAGE(bufoff, (gptr) + (half) * hstep, voffA); } } while (0)
#define PG8_LDA(dst, b, h) do { if constexpr (FP8) { _Pragma("unroll") for (int m = 0; m < 4; ++m) dst##8[m] = pg8_cat(*(const PG8_LAS bf16x8*)(lds + PG8_SA(b, h) + aoff + m * 2048), *(const PG8_LAS bf16x8*)(lds + PG8_SA(b, h) + aoff + m * 2048 + 1024)); } else { \
        _Pragma("unroll") for (int m = 0; m < 4; ++m) _Pragma("unroll") for (int k = 0; k < 2; ++k) dst[m][k] = *(const PG8_LAS bf16x8*)(lds + PG8_SA(b, h) + aoff + m * 2048 + k * 1024); } } while (0)
#define PG8_LDB(dst, b, h) do { if constexpr (FP8) { _Pragma("unroll") for (int n = 0; n < 2; ++n) dst##8[n] = pg8_cat(*(const PG8_LAS bf16x8*)(lds + PG8_SB(b, h) + boff + n * 2048), *(const PG8_LAS bf16x8*)(lds + PG8_SB(b, h) + boff + n * 2048 + 1024)); } else { \
        _Pragma("unroll") for (int n = 0; n < 2; ++n) _Pragma("unroll") for (int k = 0; k < 2; ++k) dst[n][k] = *(const PG8_LAS bf16x8*)(lds + PG8_SB(b, h) + boff + n * 2048 + k * 1024); } } while (0)
#define PG8_MMA(ai, bj, At, Bt) do { __builtin_amdgcn_s_setprio(1); if constexpr (FP8) { \
        _Pragma("unroll") for (int m = 0; m < 4; ++m) _Pragma("unroll") for (int n = 0; n < 2; ++n) \
        asm volatile("v_mfma_f32_16x16x128_f8f6f4 %0, %1, %2, %0" : "+v"(acc[ai][bj][m][n]) : "v"(Bt##8[n]), "v"(At##8[m])); } else {     \
        _Pragma("unroll") for (int m = 0; m < 4; ++m) _Pragma("unroll") for (int n = 0; n < 2; ++n) _Pragma("unroll") for (int k = 0; k < 2; ++k) \
        acc[ai][bj][m][n] = __builtin_amdgcn_mfma_f32_16x16x32_bf16(Bt[n][k], At[m][k], acc[ai][bj][m][n], 0, 0, 0); } __builtin_amdgcn_s_setprio(0); } while (0)
#define PG8_WAIT_V(n) asm volatile("s_waitcnt vmcnt(" #n ")" ::: "memory")
#define PG8_WAIT_L(n) asm volatile("s_waitcnt lgkmcnt(" #n ")" ::: "memory")
#define PG8_BAR __builtin_amdgcn_s_barrier()
#define PG8_SCHED __builtin_amdgcn_sched_barrier(0)
    Unit cur, nxt; int ui = 0;
    if (!S.next(0, cur)) return;
    f32x4 acc[2][2][4][2];
#pragma unroll
    for (int a = 0; a < 2; ++a)
#pragma unroll
        for (int b = 0; b < 2; ++b)
#pragma unroll
            for (int m = 0; m < 4; ++m)
#pragma unroll
                for (int n = 0; n < 2; ++n) acc[a][b][m][n] = (f32x4){0.f, 0.f, 0.f, 0.f};
    bf16x8 At[4][2], B0[2][2], B1[2][2]; i32x8_ At8[4], B08[2], B18[2];
    const char* cA = GATHER ? (const char*)g.A : (const char*)(cur.sel ? g.A2 : g.A) + (size_t)cur.pm * tstep; PG8_GOFF(vA, cur); const char* cB = (const char*)(cur.sel ? g.Bt2 : g.Bt) + (size_t)cur.pb * tstep;
    S.a_ready(cur);
    if constexpr (SP2) {
        PG8_STAGE(PG8_SB(0, 0), cB, voffB); PG8_STAGE(PG8_SB(0, 1), cB + hstep, voffB); PG8_STAGE_A(PG8_SA(0, 0), cA, 0, false); PG8_STAGE_A(PG8_SA(0, 1), cA, 1, false);
        if (wr == 1) PG8_BAR;
        PG8_WAIT_V(2); PG8_BAR;
        PG8_STAGE(PG8_SB(1, 0), cB + kstep, voffB); PG8_STAGE_A(PG8_SA(1, 0), cA + kstep, 0, false); PG8_STAGE(PG8_SB(1, 1), cB + hstep + kstep, voffB);
        PG8_WAIT_V(6); PG8_BAR;
    } else {
        PG8_STAGE(PG8_SB(0, 0), cB, voffB); PG8_STAGE_A(PG8_SA(0, 0), cA, 0, false); PG8_STAGE(PG8_SB(0, 1), cB + hstep, voffB); PG8_STAGE_A(PG8_SA(0, 1), cA, 1, false);
        if (wr == 1) PG8_BAR;
        PG8_WAIT_V(4); PG8_BAR;
        PG8_STAGE(PG8_SB(1, 0), cB + kstep, voffB); PG8_STAGE_A(PG8_SA(1, 0), cA + kstep, 0, false); PG8_STAGE(PG8_SB(1, 1), cB + hstep + kstep, voffB);
        PG8_WAIT_V(6); PG8_BAR;
    }
    for (;;) {
        const bool has_next = S.next(ui + 1, nxt);
        if (has_next) PG8_GOFF(vN, nxt); else { if constexpr (GATHER) { vN[0][0] = vA[0][0]; vN[0][1] = vA[0][1]; vN[1][0] = vA[1][0]; vN[1][1] = vA[1][1]; } }
        const char* nA = GATHER ? (const char*)g.A : has_next ? (const char*)(nxt.sel ? g.A2 : g.A) + (size_t)nxt.pm * tstep : cA; const char* nB = has_next ? (const char*)(nxt.sel ? g.Bt2 : g.Bt) + (size_t)nxt.pb * tstep : cB;
#pragma unroll 1
        for (int t = 0; t < nt; t += 2) {
            const bool last = (t == nt - 2);
            const char* a1 = cA + (size_t)(t + 1) * kstep;
            const char* a2 = last ? nA : cA + (size_t)(t + 2) * kstep; const char* b2 = last ? nB : cB + (size_t)(t + 2) * kstep;
            const char* a3 = a2 + kstep; const char* b3 = b2 + kstep;
            if (last && has_next) S.a_ready(nxt);
            if constexpr (SP2) {
            PG8_LDB(B0, 0, 0); PG8_LDB(B1, 0, 1); PG8_SCHED; PG8_LDA(At, 0, 0); PG8_STAGE_A(PG8_SA(1, 1), a1, 1, false);
            PG8_WAIT_V(8); PG8_WAIT_L(0); PG8_BAR; PG8_MMA(0, 0, At, B0); PG8_MMA(0, 1, At, B1); PG8_BAR; PG8_SCHED;
            PG8_LDA(At, 0, 1); PG8_STAGE(PG8_SB(0, 0), b2, voffB); PG8_STAGE(PG8_SB(0, 1), b2 + hstep, voffB); PG8_STAGE_A(PG8_SA(0, 0), a2, 0, last);
            PG8_WAIT_V(8); PG8_WAIT_L(0); PG8_BAR; PG8_MMA(1, 0, At, B0); PG8_MMA(1, 1, At, B1); PG8_BAR; PG8_SCHED;
            PG8_LDB(B0, 1, 0); PG8_LDB(B1, 1, 1); PG8_SCHED; PG8_LDA(At, 1, 0); PG8_STAGE_A(PG8_SA(0, 1), a2, 1, last);
            PG8_WAIT_V(8); PG8_WAIT_L(0); PG8_BAR; PG8_MMA(0, 0, At, B0); PG8_MMA(0, 1, At, B1); PG8_BAR; PG8_SCHED;
            PG8_LDA(At, 1, 1); PG8_STAGE(PG8_SB(1, 0), b3, voffB); PG8_STAGE(PG8_SB(1, 1), b3 + hstep, voffB); PG8_STAGE_A(PG8_SA(1, 0), a3, 0, last);
            PG8_WAIT_V(8); PG8_WAIT_L(0); PG8_BAR; PG8_MMA(1, 0, At, B0); PG8_MMA(1, 1, At, B1); PG8_BAR; PG8_SCHED;
            } else {
            PG8_LDB(B0, 0, 0); PG8_SCHED; PG8_LDA(At, 0, 0); PG8_STAGE_A(PG8_SA(1, 1), a1, 1, false);
            PG8_WAIT_L(8); PG8_BAR; PG8_WAIT_L(0); PG8_MMA(0, 0, At, B0); PG8_BAR; PG8_SCHED;
            PG8_LDB(B1, 0, 1); PG8_STAGE(PG8_SB(0, 0), b2, voffB);
            PG8_BAR; PG8_WAIT_L(0); PG8_MMA(0, 1, At, B1); PG8_BAR;
            PG8_LDA(At, 0, 1); PG8_STAGE_A(PG8_SA(0, 0), a2, 0, last);
            PG8_BAR; PG8_WAIT_L(0); PG8_MMA(1, 0, At, B0); PG8_BAR; PG8_SCHED;
            PG8_STAGE(PG8_SB(0, 1), b2 + hstep, voffB);
            PG8_WAIT_V(6); PG8_BAR; PG8_MMA(1, 1, At, B1); PG8_BAR;
            PG8_LDB(B0, 1, 0); PG8_SCHED; PG8_LDA(At, 1, 0); PG8_STAGE_A(PG8_SA(0, 1), a2, 1, last);
            PG8_WAIT_L(8); PG8_BAR; PG8_WAIT_L(0); PG8_MMA(0, 0, At, B0); PG8_BAR; PG8_SCHED;
            PG8_LDB(B1, 1, 1); PG8_STAGE(PG8_SB(1, 0), b3, voffB);
            PG8_BAR; PG8_WAIT_L(0); PG8_MMA(0, 1, At, B1); PG8_BAR;
            PG8_LDA(At, 1, 1); PG8_STAGE_A(PG8_SA(1, 0), a3, 0, last);
            PG8_BAR; PG8_WAIT_L(0); PG8_MMA(1, 0, At, B0); PG8_BAR; PG8_SCHED;
            PG8_STAGE(PG8_SB(1, 1), b3 + hstep, voffB);
            PG8_WAIT_V(6); PG8_BAR; PG8_MMA(1, 1, At, B1); PG8_BAR;
            }
        }
        if constexpr (FP8) asm volatile("s_nop 15\n\ts_nop 7" ::: "memory");
        if constexpr (ALIGN_EPI) { if (wr == 0) PG8_BAR; }
        bool fin = true; if constexpr (Epi::CHAIN) fin = (cur.sel != 0);
        if constexpr (!Epi::AFTER_DRAIN) { const int le_ = lane_id_opaque(), fre = le_ & 15, fqe = le_ >> 4;
            if (fin) E(acc, cur, wr, wc, fre, fqe); else { if constexpr (Epi::CHAIN) E.mid(acc, cur, wr, wc, fre, fqe); } S.done(cur); }
        if (!has_next) break;
        if (fin)
#pragma unroll
        for (int a = 0; a < 2; ++a)
#pragma unroll
            for (int b = 0; b < 2; ++b)
#pragma unroll
                for (int m = 0; m < 4; ++m)
#pragma unroll
                    for (int n = 0; n < 2; ++n) acc[a][b][m][n] = (f32x4){0.f, 0.f, 0.f, 0.f};
        cur = nxt; cA = nA; cB = nB; ++ui;
        if constexpr (GATHER) { vA[0][0] = vN[0][0]; vA[0][1] = vN[0][1]; vA[1][0] = vN[1][0]; vA[1][1] = vN[1][1]; }
        if constexpr (ALIGN_EPI) { if (wr == 1) PG8_BAR; }
    }
    PG8_WAIT_V(0);
    if constexpr (!ALIGN_EPI) { if (wr == 0) PG8_BAR; }
    PG8_BAR;
    if constexpr (Epi::AFTER_DRAIN) { E.fused(acc, cur, wr, wc, fr, fq, lds, wid, lane); S.done(cur); }
#undef PG8_SA
#undef PG8_STAGE_A
#undef PG8_GOFF
#undef PG8_SB
#undef PG8_STAGE
#undef PG8_LDA
#undef PG8_LDB
#undef PG8_MMA
#undef PG8_WAIT_V
#undef PG8_WAIT_L
#undef PG8_BAR
#undef PG8_SCHED
}
}

#include <hip/hip_bf16.h>
#include <cmath>

namespace attn_body {
using bf16=__hip_bfloat16;
using bf16x8=__attribute__((ext_vector_type(8)))short;
using s16x4=__attribute__((ext_vector_type(4)))short;
using f32x16=__attribute__((ext_vector_type(16)))float;
using u32x4=__attribute__((ext_vector_type(4)))unsigned;
constexpr int NHEAD=8,SEQ=16384,D=64,DMQ=NHEAD*D,DMK=2*D;
constexpr int NW=8,QBLK=32,QB=QBLK*NW,KVBLK=64,NQB=SEQ/QB;
constexpr int ATTN_UNIT_ROWS=QB;
__device__ __forceinline__ int crow(int r,int hi){return (r&3)+8*(r>>2)+4*hi;}
#define SBAR() __builtin_amdgcn_sched_barrier(0)
__device__ __forceinline__ void cmask(f32x16&p0,f32x16&p1,int jb,int qrel,int hi){
  const float NEG=-INFINITY; int kb=64*jb+4*hi;
  #pragma unroll
  for(int r=0;r<16;++r){int kv=kb+(r&3)+8*(r>>2); if(kv>qrel)p0[r]=NEG; if(kv+32>qrel)p1[r]=NEG;}
}

constexpr int NSLOT=3, SLOTB=8192;
constexpr int LDS_K=0, LDS_V=NSLOT*SLOTB, LDS_WS=2*NSLOT*SLOTB, LDS_OST=LDS_WS+NW*64*4, LDS_BYTES=LDS_OST+NW*4096;
constexpr float C2=0.125f*1.4426950408889634f;
__device__ __forceinline__ void glds16(const void*gsrc,unsigned lds_dst){unsigned keep;
  asm volatile("s_mov_b32 %0, m0\n\ts_mov_b32 m0, %2\n\ts_nop 0\n\tglobal_load_lds_dwordx4 %1, off\n\ts_mov_b32 m0, %0":"=&s"(keep):"v"(gsrc),"s"(lds_dst):"memory");}
__device__ __forceinline__ float max3f(float a,float b,float c){float r;asm("v_max3_f32 %0, %1, %2, %3":"=v"(r):"v"(a),"v"(b),"v"(c));return r;}
__device__ __forceinline__ float max2f(float a,float b){float r;asm("v_max_f32_e32 %0, %1, %2":"=v"(r):"v"(a),"v"(b));return r;}
__device__ __forceinline__ float fadd_s(float a,float b){float r;asm("v_add_f32_e32 %0, %1, %2":"=v"(r):"v"(a),"v"(b));return r;}
__device__ __forceinline__ float fsub_s(float a,float b){float r;asm("v_sub_f32_e32 %0, %1, %2":"=v"(r):"v"(a),"v"(b));return r;}
typedef float f32x2_t __attribute__((ext_vector_type(2))); typedef __bf16 bf16x2_t __attribute__((ext_vector_type(2)));
__device__ __forceinline__ unsigned cvtpk_s(float lo,float hi){f32x2_t v={lo,hi};bf16x2_t b=__builtin_convertvector(v,bf16x2_t);return __builtin_bit_cast(unsigned,b);}
#define WAIT_BAR(N) asm volatile("s_waitcnt vmcnt(" #N ") lgkmcnt(0)\n\ts_barrier":::"memory")

__device__ __forceinline__ void qkt(f32x16&p0,f32x16&p1,const char*Kslot,const bf16x8*qr,const f32x16&negm,int r32,int hi){
  const char*kb=Kslot+hi*1024+r32*16;
  #pragma unroll
  for(int d0=0;d0<4;++d0){
    const bf16x8 b0=*reinterpret_cast<const bf16x8*>(kb+d0*2048);
    const bf16x8 b1=*reinterpret_cast<const bf16x8*>(kb+d0*2048+512);
    if(d0==0){p0=__builtin_amdgcn_mfma_f32_32x32x16_bf16(b0,qr[0],negm,0,0,0);p1=__builtin_amdgcn_mfma_f32_32x32x16_bf16(b1,qr[0],negm,0,0,0);}
    else{p0=__builtin_amdgcn_mfma_f32_32x32x16_bf16(b0,qr[d0],p0,0,0,0);p1=__builtin_amdgcn_mfma_f32_32x32x16_bf16(b1,qr[d0],p1,0,0,0);}}
}
typedef __attribute__((address_space(3))) const char* lds_cptr;
typedef short v4i16_t __attribute__((ext_vector_type(4)));
__device__ __forceinline__ void kload8(bf16x8*kf,lds_cptr kp){
  kf[0]=*(const __attribute__((address_space(3))) bf16x8*)(kp);      kf[1]=*(const __attribute__((address_space(3))) bf16x8*)(kp+512);
  kf[2]=*(const __attribute__((address_space(3))) bf16x8*)(kp+2048); kf[3]=*(const __attribute__((address_space(3))) bf16x8*)(kp+2560);
  kf[4]=*(const __attribute__((address_space(3))) bf16x8*)(kp+4096); kf[5]=*(const __attribute__((address_space(3))) bf16x8*)(kp+4608);
  kf[6]=*(const __attribute__((address_space(3))) bf16x8*)(kp+6144); kf[7]=*(const __attribute__((address_space(3))) bf16x8*)(kp+6656);
}
__device__ __forceinline__ void kload2(bf16x8*kf,lds_cptr kp,int j){ kf[2*j]=*(const __attribute__((address_space(3))) bf16x8*)(kp+j*2048); kf[2*j+1]=*(const __attribute__((address_space(3))) bf16x8*)(kp+j*2048+512); }
__device__ __forceinline__ s16x4 vtr(lds_cptr p){ return __builtin_bit_cast(s16x4,__builtin_amdgcn_ds_read_tr16_b64_v4i16((__attribute__((address_space(3))) v4i16_t*)p)); }
__device__ __forceinline__ float rowmax(const f32x16&p0,const f32x16&p1){
  float a=max3f(p0[0],p0[1],p1[0]),b=max3f(p0[2],p0[3],p1[1]);a=max3f(a,p1[2],p1[3]);
  #pragma unroll
  for(int r=4;r<16;r+=4){a=max3f(a,p0[r],p0[r+1]);b=max3f(b,p0[r+2],p0[r+3]);a=max3f(a,p1[r],p1[r+1]);b=max3f(b,p1[r+2],p1[r+3]);}
  const float m=max2f(a,b);
  auto rr=__builtin_amdgcn_permlane32_swap(__float_as_uint(m),__float_as_uint(m),false,false);
  return max2f(__uint_as_float(rr[0]),__uint_as_float(rr[1]));
}
__device__ __forceinline__ void pv(f32x16*o,int vb,bf16x8 pa0,bf16x8 pa1,bf16x8 pa2,bf16x8 pa3){
  #pragma unroll
  for(int d0=0;d0<2;++d0){s16x4 lo[4],hi[4];
    #pragma unroll
    for(int ks=0;ks<4;++ks){
      asm volatile("ds_read_b64_tr_b16 %0,%1 offset:%c2":"=&v"(lo[ks]):"v"(vb),"i"(d0*4096+ks*1024):"memory");
      asm volatile("ds_read_b64_tr_b16 %0,%1 offset:%c2":"=&v"(hi[ks]):"v"(vb),"i"(d0*4096+ks*1024+512):"memory");}
    asm volatile("s_waitcnt lgkmcnt(0)":::"memory");SBAR();
    #define PK(k) (bf16x8){lo[k][0],lo[k][1],lo[k][2],lo[k][3],hi[k][0],hi[k][1],hi[k][2],hi[k][3]}
    o[d0]=__builtin_amdgcn_mfma_f32_32x32x16_bf16(pa0,PK(0),o[d0],0,0,0);
    o[d0]=__builtin_amdgcn_mfma_f32_32x32x16_bf16(pa1,PK(1),o[d0],0,0,0);
    o[d0]=__builtin_amdgcn_mfma_f32_32x32x16_bf16(pa2,PK(2),o[d0],0,0,0);
    o[d0]=__builtin_amdgcn_mfma_f32_32x32x16_bf16(pa3,PK(3),o[d0],0,0,0);
    #undef PK
  }
}

#ifndef ATTN_STORE16
#define ATTN_STORE16(p,v) (*(u32x4*)(p)=(v))
#endif
template<int THRL> __device__ __forceinline__ void attn_unit(int b,int h,int qb,const bf16*Q,const bf16*__restrict__ K,const bf16*__restrict__ V,bf16*O,char*shm,int wave_,float negM){
  const int tid_=wave_*64+lane_id_opaque();
  const int tid=tid_,lane=tid&63,r32=lane&31,hi=lane>>5; const int wid=__builtin_amdgcn_readfirstlane(tid>>6);
  const long rowbase=0; const int q0=qb*QB; (void)b;
  const bf16*Qw=Q+(rowbase+q0+wid*QBLK)*DMQ+h*D;
  const bf16*Kh=K+(h>>2)*D,*Vh=V+(h>>2)*D;
  const unsigned lds0=(unsigned)(uintptr_t)shm;
  float*wsf=(float*)(shm+LDS_WS)+wid*64;
  const bf16*ksrc=Kh+(long)lane*DMK+wid*8;
  const bf16*vsrc=Vh+(long)(16*(wid&3)+(lane>>2))*DMK+(wid>>2)*32+(lane&3)*8;
  const unsigned kdst=lds0+LDS_K+wid*1024, vdst=lds0+LDS_V+wid*1024;
  #define DMA_K(t,slot) glds16(ksrc+(long)(t)*KVBLK*DMK,(unsigned)__builtin_amdgcn_readfirstlane(kdst+(slot)))
  #define DMA_V(t,slot) glds16(vsrc+(long)(t)*KVBLK*DMK,(unsigned)__builtin_amdgcn_readfirstlane(vdst+(slot)))
  const int vb0=(int)(lds0+LDS_V)+((lane>>4)&1)*32+(lane&3)*8+(4*hi+((lane&15)>>2))*64;
  const char*Kbase=shm+LDS_K; bf16x8 kf[8];
  const lds_cptr shm3=(lds_cptr)shm; const lds_cptr kp0=shm3+LDS_K+hi*1024+r32*16; const lds_cptr vp0=shm3+LDS_V+((lane>>4)&1)*32+(lane&3)*8+(4*hi+((lane&15)>>2))*64;
  const int NT=SEQ/KVBLK;
  DMA_K(0,0);DMA_V(0,0);DMA_K(1,SLOTB);
  bf16x8 qr[4];
  #pragma unroll
  for(int d0=0;d0<4;++d0)qr[d0]=*reinterpret_cast<const bf16x8*>(&Qw[(long)r32*DMQ+d0*16+hi*8]);
  float l_reg=0.f;f32x16 o[2];o[0]=f32x16{};o[1]=f32x16{};f32x16 negm;
  #pragma unroll
  for(int r=0;r<16;++r)negm[r]=negM;
  asm volatile("":"+v"(negm));
  const int qrel=wid*QBLK+r32; (void)qrel;
  #define CMASK(P0,P1,t) do{}while(0)
  #define START(P0,P1) do{ _Pragma("unroll") for(int r=0;r<16;++r)P0[r]=__builtin_amdgcn_exp2f(P0[r]); }while(0)
  #define RESC() do{}while(0)
  f32x16 pA0,pA1,pB0,pB1;
  int sl_prev=0,sl_cur=0,sl_next=SLOTB;
  #define ROT() do{sl_prev=sl_cur;sl_cur=sl_next;sl_next=(sl_next==(NSLOT-1)*SLOTB)?0:sl_next+SLOTB;}while(0)
  DMA_K(2,2*SLOTB);
  WAIT_BAR(3);
  qkt(pA0,pA1,Kbase,qr,negm,r32,hi);asm volatile("s_nop 15\n\ts_nop 7":"+v"(pA0),"+v"(pA1));CMASK(pA0,pA1,0);
  START(pA0,pA1);
  _Pragma("unroll") for(int r=0;r<16;++r)pA1[r]=__builtin_amdgcn_exp2f(pA1[r]);
  WAIT_BAR(0);
  DMA_K(3,0);DMA_V(1,SLOTB);
  ROT();
  kload8(kf,kp0+sl_cur);
  WAIT_BAR(2);
  s16x4 vlo[8],vhi[8]; u32x4 pw0,pw1,pw2,pw3;
  #define PKW(P,B) cvtpk_s(P[B],P[B+1])
  #define PAF(k) __builtin_bit_cast(bf16x8,pw##k)
  #define VFR(i) (bf16x8){vlo[i][0],vlo[i][1],vlo[i][2],vlo[i][3],vhi[i][0],vhi[i][1],vhi[i][2],vhi[i][3]}
  #define PIN(x) asm volatile("":"+v"(x))
  #define MX3(a,b,c) __builtin_fmaxf(__builtin_fmaxf((a),(b)),(c))
  #define GAPA(MF,A0,A1,A2,A3,W0,W1,PW) do{ MF; sacc+=A0; sacc+=A1; sacc+=A2; sacc+=A3; PIN(sacc); W0; W1; PIN(PW); SBAR(); }while(0)
  #define EX(v) __builtin_amdgcn_exp2f(v)
  #define GAPB(MF,X,B) do{ MF; X[B]=EX(X[B]); X[B+1]=EX(X[B+1]); X[B+2]=EX(X[B+2]); X[B+3]=EX(X[B+3]); PIN(X); SBAR(); }while(0)
  #define VRD(i) do{ vlo[i]=vtr(vp_+(((i)>>2)*4096+((i)&3)*1024)); vhi[i]=vtr(vp_+(((i)>>2)*4096+((i)&3)*1024+512)); }while(0)
  #define KRD(G,j) do{ if(G){ kload2(kf,kp0+sl_next,j); SBAR(); } }while(0)
  #define STEP(C0,C1,P0,P1,t,GK,GV,GL) do{ SBAR(); \
    const lds_cptr vp_=vp0+sl_prev; \
    VRD(0); SBAR(); float sacc=(P0[0]+P0[1]); \
    GAPA(C0=__builtin_amdgcn_mfma_f32_32x32x16_bf16(kf[0],qr[0],negm,0,0,0), P0[2],P0[3],P0[4],P0[5],     pw0[0]=PKW(P0,0), pw0[1]=PKW(P0,2), pw0); \
    VRD(4); SBAR(); GAPA(C1=__builtin_amdgcn_mfma_f32_32x32x16_bf16(kf[1],qr[0],negm,0,0,0), P0[6],P0[7],P0[8],P0[9],     pw0[2]=PKW(P0,4), pw0[3]=PKW(P0,6), pw0); \
    VRD(1); SBAR(); GAPA(C0=__builtin_amdgcn_mfma_f32_32x32x16_bf16(kf[2],qr[1],C0,0,0,0),   P0[10],P0[11],P0[12],P0[13], pw1[0]=PKW(P0,8), pw1[1]=PKW(P0,10), pw1); \
    VRD(5); SBAR(); GAPA(C1=__builtin_amdgcn_mfma_f32_32x32x16_bf16(kf[3],qr[1],C1,0,0,0),   P0[14],P0[15],P1[0],P1[1],   pw1[2]=PKW(P0,12),pw1[3]=PKW(P0,14), pw1); \
    VRD(2); SBAR(); GAPA(C0=__builtin_amdgcn_mfma_f32_32x32x16_bf16(kf[4],qr[2],C0,0,0,0),   P1[2],P1[3],P1[4],P1[5],     pw2[0]=PKW(P1,0), pw2[1]=PKW(P1,2), pw2); \
    VRD(6); SBAR(); GAPA(C1=__builtin_amdgcn_mfma_f32_32x32x16_bf16(kf[5],qr[2],C1,0,0,0),   P1[6],P1[7],P1[8],P1[9],     pw2[2]=PKW(P1,4), pw2[3]=PKW(P1,6), pw2); \
    VRD(3); SBAR(); GAPA(C0=__builtin_amdgcn_mfma_f32_32x32x16_bf16(kf[6],qr[3],C0,0,0,0),   P1[10],P1[11],P1[12],P1[13], pw3[0]=PKW(P1,8), pw3[1]=PKW(P1,10), pw3); \
    VRD(7); SBAR(); GAPA(C1=__builtin_amdgcn_mfma_f32_32x32x16_bf16(kf[7],qr[3],C1,0,0,0),   P1[14],P1[15],0.f,0.f,       pw3[2]=PKW(P1,12),pw3[3]=PKW(P1,14), pw3); \
    l_reg+=sacc; \
    if(GK){DMA_K((t)+3,sl_cur);} if(GV){DMA_V((t)+1,sl_next);} \
    CMASK(C0,C1,t); \
    SBAR(); \
    GAPB(o[0]=__builtin_amdgcn_mfma_f32_32x32x16_bf16(PAF(0),VFR(0),o[0],0,0,0), C0,0); \
    GAPB(o[1]=__builtin_amdgcn_mfma_f32_32x32x16_bf16(PAF(0),VFR(4),o[1],0,0,0), C0,4); \
    KRD(GL,0); GAPB(o[0]=__builtin_amdgcn_mfma_f32_32x32x16_bf16(PAF(1),VFR(1),o[0],0,0,0), C0,8); \
    KRD(GL,1); GAPB(o[1]=__builtin_amdgcn_mfma_f32_32x32x16_bf16(PAF(1),VFR(5),o[1],0,0,0), C0,12); \
    KRD(GL,2); GAPB(o[0]=__builtin_amdgcn_mfma_f32_32x32x16_bf16(PAF(2),VFR(2),o[0],0,0,0), C1,0); \
    KRD(GL,3); GAPB(o[1]=__builtin_amdgcn_mfma_f32_32x32x16_bf16(PAF(2),VFR(6),o[1],0,0,0), C1,4); \
    GAPB(o[0]=__builtin_amdgcn_mfma_f32_32x32x16_bf16(PAF(3),VFR(3),o[0],0,0,0), C1,8); \
    GAPB(o[1]=__builtin_amdgcn_mfma_f32_32x32x16_bf16(PAF(3),VFR(7),o[1],0,0,0), C1,12); \
    }while(0)
  int t=1;
  #undef CMASK
  #define CMASK(P0,P1,t) do{}while(0)
  for(;t+5<NT;t+=2){
    STEP(pB0,pB1,pA0,pA1,t,true,true,true);     WAIT_BAR(2); RESC(); ROT();
    STEP(pA0,pA1,pB0,pB1,t+1,true,true,true);   WAIT_BAR(2); RESC(); ROT();
  }
  #undef CMASK
  #define CMASK(P0,P1,t) do{}while(0)
  #define ENDW(tt) do{ if((tt)+3<NT){WAIT_BAR(2);} else if((tt)+2<NT){WAIT_BAR(1);} else {WAIT_BAR(0);} }while(0)
  for(;t+1<NT;t+=2){
    STEP(pB0,pB1,pA0,pA1,t,(t+3<NT),(t+1<NT),(t+1<NT));       ENDW(t);   RESC(); ROT();
    STEP(pA0,pA1,pB0,pB1,t+1,(t+4<NT),(t+2<NT),(t+2<NT));     ENDW(t+1); RESC(); ROT();
  }
  STEP(pB0,pB1,pA0,pA1,NT-1,false,false,false); RESC();
  { float sacc=pB0[0]+pB0[1]; _Pragma("unroll") for(int r=2;r<16;++r)sacc+=pB0[r]; _Pragma("unroll") for(int r=0;r<16;++r)sacc+=pB1[r]; l_reg+=sacc;
    pw0=(u32x4){PKW(pB0,0),PKW(pB0,2),PKW(pB0,4),PKW(pB0,6)};pw1=(u32x4){PKW(pB0,8),PKW(pB0,10),PKW(pB0,12),PKW(pB0,14)};pw2=(u32x4){PKW(pB1,0),PKW(pB1,2),PKW(pB1,4),PKW(pB1,6)};pw3=(u32x4){PKW(pB1,8),PKW(pB1,10),PKW(pB1,12),PKW(pB1,14)};
    SBAR(); pv(o,vb0+sl_cur,PAF(0),PAF(1),PAF(2),PAF(3)); }
  #undef PKW
  #undef PAF
  #undef VFR
  #undef PIN
  #undef MX3
  #undef GAPA
  #undef GAPB
  #undef EX
  #undef VRD
  #undef KRD
  #undef STEP
  #undef ENDW
  {auto rr=__builtin_amdgcn_permlane32_swap(__float_as_uint(l_reg),__float_as_uint(l_reg),false,false);l_reg=__uint_as_float(rr[0])+__uint_as_float(rr[1]);}
  if(hi==0)wsf[32+r32]=l_reg;asm volatile("s_waitcnt lgkmcnt(0)":::"memory");
  float rli[16];
  #pragma unroll
  for(int r=0;r<16;++r)rli[r]=__builtin_amdgcn_rcpf(wsf[32+crow(r,hi)]);
  bf16*Ow=O+(rowbase+q0+wid*QBLK)*DMQ+h*D;
  { bf16*stg=(bf16*)(shm+LDS_OST)+wid*2048;
    #pragma unroll
    for(int r=0;r<16;++r){const int orow=crow(r,hi);
      #pragma unroll
      for(int d0=0;d0<2;++d0)stg[orow*64+d0*32+r32]=__float2bfloat16(o[d0][r]*rli[r]);}
    asm volatile("s_waitcnt lgkmcnt(0)":::"memory");
    #pragma unroll
    for(int i=0;i<4;++i){const int row=i*8+(lane>>3),ch=lane&7; const u32x4 v=*(const u32x4*)(stg+row*64+ch*8); ATTN_STORE16(Ow+(long)row*DMQ+ch*8,v);} }
  asm volatile("s_waitcnt lgkmcnt(0)\n\ts_barrier":::"memory");
  #undef DMA_K
  #undef DMA_V
  #undef CMASK
  #undef START
  #undef RESC
  #undef ROT
}
constexpr int ATTN_LDS_BYTES=LDS_BYTES;
struct AttnTensors { const bf16* Q; const bf16* K; const bf16* V; bf16* O; };
struct AttnUnit { int bh; int qb; };
struct StaticOrder {
  int vcu, G;
  __device__ __forceinline__ explicit StaticOrder(int grid,int block):vcu((grid%8==0)?(block%8)*(grid/8)+block/8:block),G(grid){}
  __device__ __forceinline__ bool next(int i,AttnUnit&u)const{ constexpr int NU=NHEAD*NQB; int uu; if(NU%G==0){ const int per=NU/G; if(i>=per)return false; uu=vcu*per+i; } else { uu=i*G+vcu; if(uu>=NU)return false; } u.bh=uu/NQB; u.qb=uu%NQB; return true; }
  __device__ __forceinline__ void a_ready(const AttnUnit&)const{}
  __device__ __forceinline__ void done(const AttnUnit&)const{}
};
template<class Sched,int THRL=8> __device__ __forceinline__ void attn_phase(char*lds,const AttnTensors&T,const Sched&S,int wave_,float negM){
  AttnUnit u;
  for(int i=0;S.next(i,u);++i){ S.a_ready(u); attn_unit<THRL>(0,u.bh,u.qb,T.Q,T.K,T.V,T.O,lds,wave_,negM); S.done(u); }
}
#undef SBAR
#undef WAIT_BAR
}

namespace attn8 {
using bf16 = __hip_bfloat16;
typedef int i32x8 __attribute__((ext_vector_type(8)));
typedef int i32x4 __attribute__((ext_vector_type(4)));
typedef float f32x16 __attribute__((ext_vector_type(16)));
typedef unsigned u32x4 __attribute__((ext_vector_type(4)));
constexpr int NHEAD = 8, SEQ = 16384, QBLK = 32, NW = 8, QB = 256, KVBLK = 64, NQB = SEQ / QB, NT = SEQ / KVBLK;
constexpr int NS = 8, SLOT = 4096;
constexpr int LDS_K = 0, LDS_V = NS * SLOT, LDS_WS = 2 * NS * SLOT, LDS_OST = LDS_WS + NW * 256, LDS_BYTES = LDS_OST + NW * 4096;
__device__ __forceinline__ int crow(int r, int hi) { return (r & 3) + 8 * (r >> 2) + 4 * hi; }
__device__ __forceinline__ void glds16(const void* gsrc, unsigned lds_dst) { unsigned keep;
    asm volatile("s_mov_b32 %0, m0\n\ts_mov_b32 m0, %2\n\ts_nop 0\n\tglobal_load_lds_dwordx4 %1, off\n\ts_mov_b32 m0, %0" : "=&s"(keep) : "v"(gsrc), "s"(lds_dst) : "memory"); }
typedef __attribute__((address_space(3))) const char* lds_cptr;
__device__ __forceinline__ i32x8 frag(lds_cptr p) {
    const i32x4 lo = *(const __attribute__((address_space(3))) i32x4*)(p), hi = *(const __attribute__((address_space(3))) i32x4*)(p + 1024);
    return __builtin_shufflevector(lo, hi, 0, 1, 2, 3, 4, 5, 6, 7); }
#define A8_MFMA(a, b, c) __builtin_amdgcn_mfma_scale_f32_32x32x64_f8f6f4((a), (b), (c), 0, 0, 0, 0, 0, 0)
struct Tensors { const unsigned char* Q8; const unsigned char* K8; const unsigned char* V8T; bf16* O; };

__device__ __forceinline__ void unit(int h, int qb, const Tensors& T, char* shm, int wave_, float negM8) {
    const int tid = wave_ * 64 + lane_id_opaque(), lane = tid & 63, r32 = lane & 31, hi = lane >> 5; const int wid = __builtin_amdgcn_readfirstlane(tid >> 6);
    const int kvh = h >> 2, q0 = qb * QB;
    const unsigned lds0 = (unsigned)(uintptr_t)shm;
    float* wsf = (float*)(shm + LDS_WS) + wid * 64;
    const bool isk = wid < 4; const int c = wid & 3;
    const unsigned char* src0 = isk ? T.K8 + (size_t)lane * 128 + kvh * 64 + c * 16 : T.V8T + (size_t)kvh * NT * 4096 + (size_t)lane * 64 + c * 16;
    const size_t tstep = isk ? (size_t)KVBLK * 128 : (size_t)4096;
    const unsigned dst0 = lds0 + (isk ? LDS_K : LDS_V) + c * 1024;
#define A8_DMA(t) glds16(src0 + (size_t)(t) * tstep, (unsigned)__builtin_amdgcn_readfirstlane(dst0 + ((t) & (NS - 1)) * SLOT))
#pragma unroll
    for (int t = 0; t < 4; ++t) A8_DMA(t);
    if (isk) A8_DMA(4);
    const unsigned char* qp = T.Q8 + (size_t)(q0 + wid * QBLK + r32) * 512 + h * 64 + 32 * hi;
    const i32x4 qlo = *(const i32x4*)qp, qhi = *(const i32x4*)(qp + 16);
    const i32x8 qf = __builtin_shufflevector(qlo, qhi, 0, 1, 2, 3, 4, 5, 6, 7);
    f32x16 negm;
#pragma unroll
    for (int r = 0; r < 16; ++r) negm[r] = negM8;
    f32x16 o0 = f32x16{}, o1 = f32x16{}, lacc = f32x16{};
    i32x8 ones8;
#pragma unroll
    for (int k = 0; k < 8; ++k) ones8[k] = 0x38383838;
    const lds_cptr kbase = (lds_cptr)shm + LDS_K + (2 * hi) * 1024 + r32 * 16, vbase = (lds_cptr)shm + LDS_V + (2 * hi) * 1024 + r32 * 16;
    if (isk) asm volatile("s_waitcnt vmcnt(4)" ::: "memory"); else asm volatile("s_waitcnt vmcnt(3)" ::: "memory");
    asm volatile("s_waitcnt lgkmcnt(0)\n\ts_barrier" ::: "memory");
    asm volatile("" : "+v"(ones8));
    f32x16 sA0 = A8_MFMA(frag(kbase), qf, negm), sA1 = A8_MFMA(frag(kbase + 512), qf, negm), sB0, sB1;
#define A8_SB() __builtin_amdgcn_sched_barrier(0)
#define A8_TILE(C0, C1, N0, N1, kt, vt) do { \
        const lds_cptr kp_ = kbase + ((kt) & (NS - 1)) * SLOT, vp_ = vbase + ((vt) & (NS - 1)) * SLOT; \
        const i32x8 kf0_ = frag(kp_), kf1_ = frag(kp_ + 512), vf0_ = frag(vp_), vf1_ = frag(vp_ + 512); A8_SB(); \
        _Pragma("unroll") for (int r = 0; r < 16; ++r) C0[r] = __builtin_amdgcn_exp2f(C0[r]);            \
        A8_SB(); \
        N0 = A8_MFMA(kf0_, qf, negm); N1 = A8_MFMA(kf1_, qf, negm);                                     \
        A8_SB(); \
        _Pragma("unroll") for (int r = 0; r < 16; ++r) C1[r] = __builtin_amdgcn_exp2f(C1[r]); \
        i32x8 pa_; \
        _Pragma("unroll") for (int k = 0; k < 4; ++k) { int w_; asm volatile("" : "=v"(w_)); w_ = __builtin_amdgcn_cvt_pk_fp8_f32(C0[4 * k], C0[4 * k + 1], w_, false); w_ = __builtin_amdgcn_cvt_pk_fp8_f32(C0[4 * k + 2], C0[4 * k + 3], w_, true); pa_[k] = w_; \
            int v_; asm volatile("" : "=v"(v_)); v_ = __builtin_amdgcn_cvt_pk_fp8_f32(C1[4 * k], C1[4 * k + 1], v_, false); v_ = __builtin_amdgcn_cvt_pk_fp8_f32(C1[4 * k + 2], C1[4 * k + 3], v_, true); pa_[4 + k] = v_; } \
        A8_SB(); \
        o0 = A8_MFMA(pa_, vf0_, o0); o1 = A8_MFMA(pa_, vf1_, o1); lacc = A8_MFMA(pa_, ones8, lacc);      \
        A8_SB(); } while (0)
    for (int t = 0; t < NT; t += 2) {
        if (t + 6 < NT) asm volatile("s_waitcnt vmcnt(2)" ::: "memory"); else asm volatile("s_waitcnt vmcnt(0)" ::: "memory");
        asm volatile("s_waitcnt lgkmcnt(0)\n\ts_barrier" ::: "memory");
        if (isk) { if (t + 5 < NT) A8_DMA(t + 5); if (t + 6 < NT) A8_DMA(t + 6); } else { if (t + 4 < NT) A8_DMA(t + 4); if (t + 5 < NT) A8_DMA(t + 5); }
        A8_TILE(sA0, sA1, sB0, sB1, t + 1, t);
        A8_TILE(sB0, sB1, sA0, sA1, t + 2, t + 1);
    }
#undef A8_TILE
#undef A8_SB
    (void)wsf;
    float rli[16];
#pragma unroll
    for (int r = 0; r < 16; ++r) rli[r] = __builtin_amdgcn_rcpf(lacc[r]);
    bf16* Ow = T.O + (size_t)(q0 + wid * QBLK) * 512 + h * 64;
    { bf16* stg = (bf16*)(shm + LDS_OST) + wid * 2048;
#pragma unroll
      for (int r = 0; r < 16; ++r) { const int orow = crow(r, hi); stg[orow * 64 + r32] = __float2bfloat16(o0[r] * rli[r]); stg[orow * 64 + 32 + r32] = __float2bfloat16(o1[r] * rli[r]); }
      asm volatile("s_waitcnt lgkmcnt(0)" ::: "memory");
#pragma unroll
      for (int i = 0; i < 4; ++i) { const int row = i * 8 + (lane >> 3), ch = lane & 7; const u32x4 v = *(const u32x4*)(stg + row * 64 + ch * 8); *(u32x4*)(Ow + (size_t)row * 512 + ch * 8) = v; } }
    asm volatile("s_waitcnt vmcnt(0) lgkmcnt(0)\n\ts_barrier" ::: "memory");
#undef A8_DMA
}
__device__ __forceinline__ void phase(char* lds, const Tensors& T, int grid, int block, int wave_, float negM8) {
    const int vcu = (grid % 8 == 0) ? (block % 8) * (grid / 8) + block / 8 : block;
    constexpr int NU = NHEAD * NQB;
    if (NU % grid == 0) { const int per = NU / grid; for (int i = 0; i < per; ++i) { const int uu = vcu * per + i; unit(uu / NQB, uu % NQB, T, lds, wave_, negM8); } }
    else for (int uu = vcu; uu < NU; uu += grid) unit(uu / NQB, uu % NQB, T, lds, wave_, negM8);
}
#undef A8_MFMA
}

namespace hg {
typedef short bf16x8 __attribute__((ext_vector_type(8)));
typedef short s16x4 __attribute__((ext_vector_type(4)));
constexpr int CH = 32, SEGT = 512, NSEG = S / SEGT, NCH = SEGT / CH;
constexpr int RS = 272, TS = 80;
constexpr int QOFF = 0, KOFF = 32 * RS, KTOFF = 2 * 32 * RS, VTOFF = KTOFF + 128 * TS, DOFF = VTOFF + 128 * TS, GOFF = DOFF + 512, BUFB = GOFF + 4096;
static_assert(2 * BUFB <= 131072, "hgrn LDS");
#define HG_MFMA(a, b, c) __builtin_amdgcn_mfma_f32_16x16x32_bf16((a), (b), (c), 0, 0, 0)
__device__ __forceinline__ unsigned pkbf(float lo, float hi) { typedef float f2 __attribute__((ext_vector_type(2))); typedef __bf16 b2 __attribute__((ext_vector_type(2))); f2 v = {lo, hi}; b2 b = __builtin_convertvector(v, b2); return __builtin_bit_cast(unsigned, b); }

typedef float f32x2h __attribute__((ext_vector_type(2)));
template <bool OUT>
__device__ __forceinline__ void chunk_matrix(LAS unsigned char* B, f32x4 (&Sacc)[8], int c16, int g, int e0, int dir, int h, int p0c, float* __restrict__ OF) {
    if (OUT) {
        f32x4 X00 = {0.f, 0.f, 0.f, 0.f}, X01 = X00, X11 = X00;
#pragma unroll
        for (int s = 0; s < 4; ++s) {
            const bf16x8 aK0 = *(const LAS bf16x8*)(B + KOFF + c16 * RS + (32 * s + 8 * g) * 2), aK1 = *(const LAS bf16x8*)(B + KOFF + (16 + c16) * RS + (32 * s + 8 * g) * 2);
            const bf16x8 bQ0 = *(const LAS bf16x8*)(B + QOFF + c16 * RS + (32 * s + 8 * g) * 2), bQ1 = *(const LAS bf16x8*)(B + QOFF + (16 + c16) * RS + (32 * s + 8 * g) * 2);
            X00 = HG_MFMA(aK0, bQ0, X00); X01 = HG_MFMA(aK0, bQ1, X01); X11 = HG_MFMA(aK1, bQ1, X11);
        }
#pragma unroll
        for (int r = 0; r < 4; ++r) { const bool keep = (4 * g + r) <= c16; X00[r] = keep ? X00[r] : 0.f; X11[r] = keep ? X11[r] : 0.f; }
        u32x4 a0w, a1w; a0w.x = pkbf(X00[0], X00[1]); a0w.y = pkbf(X00[2], X00[3]); a0w.z = 0u; a0w.w = 0u;
        a1w.x = pkbf(X01[0], X01[1]); a1w.y = pkbf(X01[2], X01[3]); a1w.z = pkbf(X11[0], X11[1]); a1w.w = pkbf(X11[2], X11[3]);
        const u32x2 vlo = *(const LAS u32x2*)(B + VTOFF + (e0 + c16) * TS + (4 * g) * 2), vhi = *(const LAS u32x2*)(B + VTOFF + (e0 + c16) * TS + (16 + 4 * g) * 2);
        u32x4 vbw; vbw.x = vlo.x; vbw.y = vlo.y; vbw.z = vhi.x; vbw.w = vhi.y;
        const bf16x8 vb = __builtin_bit_cast(bf16x8, vbw);
        f32x4 O0 = {0.f, 0.f, 0.f, 0.f}, O1 = O0;
        O0 = HG_MFMA(__builtin_bit_cast(bf16x8, a0w), vb, O0); O1 = HG_MFMA(__builtin_bit_cast(bf16x8, a1w), vb, O1);
#pragma unroll
        for (int s = 0; s < 4; ++s) {
            u32x4 sw; sw.x = pkbf(Sacc[2 * s][0], Sacc[2 * s][1]); sw.y = pkbf(Sacc[2 * s][2], Sacc[2 * s][3]); sw.z = pkbf(Sacc[2 * s + 1][0], Sacc[2 * s + 1][1]); sw.w = pkbf(Sacc[2 * s + 1][2], Sacc[2 * s + 1][3]);
            const bf16x8 sb = __builtin_bit_cast(bf16x8, sw);
            const u32x2 q0l = *(const LAS u32x2*)(B + QOFF + c16 * RS + (32 * s + 4 * g) * 2), q0h = *(const LAS u32x2*)(B + QOFF + c16 * RS + (32 * s + 16 + 4 * g) * 2);
            const u32x2 q1l = *(const LAS u32x2*)(B + QOFF + (16 + c16) * RS + (32 * s + 4 * g) * 2), q1h = *(const LAS u32x2*)(B + QOFF + (16 + c16) * RS + (32 * s + 16 + 4 * g) * 2);
            u32x4 q0w, q1w; q0w.x = q0l.x; q0w.y = q0l.y; q0w.z = q0h.x; q0w.w = q0h.y; q1w.x = q1l.x; q1w.y = q1l.y; q1w.z = q1h.x; q1w.w = q1h.y;
            O0 = HG_MFMA(__builtin_bit_cast(bf16x8, q0w), sb, O0); O1 = HG_MFMA(__builtin_bit_cast(bf16x8, q1w), sb, O1);
        }
#pragma unroll
        for (int r = 0; r < 4; ++r) {
            const int p0 = p0c + 4 * g + r, p1 = p0 + 16;
            const int t0 = dir ? (S - 1 - p0) : p0, t1 = dir ? (S - 1 - p1) : p1;
            OF[((size_t)dir * S + t0) * 512 + h * 128 + e0 + c16] = O0[r];
            OF[((size_t)dir * S + t1) * 512 + h * 128 + e0 + c16] = O1[r];
        }
    }
    {
        const bf16x8 vB = *(const LAS bf16x8*)(B + VTOFF + (e0 + c16) * TS + (8 * g) * 2);
#pragma unroll
        for (int dt = 0; dt < 8; ++dt) {
            const bf16x8 aT = *(const LAS bf16x8*)(B + KTOFF + (16 * dt + c16) * TS + (8 * g) * 2);
            Sacc[dt] = HG_MFMA(aT, vB, Sacc[dt]);
            const f32x4 dv = *(const LAS f32x4*)(B + DOFF + (16 * dt + 4 * g) * 4);
            Sacc[dt] = Sacc[dt] * dv;
        }
    }
}
template <bool OUT>
__device__ __forceinline__ void segment(LAS unsigned char* lds, int unit, const bf16_t* __restrict__ HQ, const float* __restrict__ LF, const bf16_t* __restrict__ KF,
                                        const bf16_t* __restrict__ HV, float* __restrict__ HST, float* __restrict__ HSD, float* __restrict__ OF, int wave_) {
    const int tid_ = wave_ * 64 + lane_id_opaque();
    const int tid = tid_, lane = tid & 63, w = __builtin_amdgcn_readfirstlane(tid >> 6), c16 = lane & 15, g = lane >> 4;
    const int dir = unit >> 7, h = (unit >> 5) & 3, seg = unit & 31;
    const int d0 = 2 * (tid & 63), tg = tid >> 6;
    const size_t cb = (size_t)h * 128 + d0;
    const float* lf = LF + (size_t)dir * S * 512 + cb;
    const bf16_t* kf = KF + (size_t)dir * S * 512 + cb;
    const bf16_t* hq = HQ + cb; const bf16_t* hv = HV + cb;
    f32x4 Sacc[8];
    float* hst = HST + (size_t)unit * 16384 + (size_t)w * 2048 + lane;
    if (OUT) {
#pragma unroll
        for (int dt = 0; dt < 8; ++dt) { Sacc[dt][0] = hst[(dt * 4 + 0) * 64]; Sacc[dt][1] = hst[(dt * 4 + 1) * 64]; Sacc[dt][2] = hst[(dt * 4 + 2) * 64]; Sacc[dt][3] = hst[(dt * 4 + 3) * 64]; }
    } else {
#pragma unroll
        for (int dt = 0; dt < 8; ++dt) Sacc[dt] = f32x4{0.f, 0.f, 0.f, 0.f};
    }
    f32x2h segsum = {0.f, 0.f};
    const int e0 = 16 * w;
    constexpr int RING = 2;
    f32x2h rl[RING][4]; unsigned rk[RING][4], rq[RING][4], rv[RING][4];
#define HG_LOAD(sl, cc) do { _Pragma("unroll") for (int jj = 0; jj < 4; ++jj) { \
        const int p_ = seg * SEGT + (cc) * CH + 4 * tg + jj, t_ = dir ? (S - 1 - p_) : p_; \
        rl[sl][jj] = *(const f32x2h*)(lf + (size_t)t_ * 512); rk[sl][jj] = *(const unsigned*)(kf + (size_t)t_ * 512); rv[sl][jj] = *(const unsigned*)(hv + (size_t)t_ * 512); \
        rq[sl][jj] = OUT ? *(const unsigned*)(hq + (size_t)t_ * 512) : 0u; } } while (0)
#pragma unroll
    for (int sl = 0; sl < RING; ++sl) HG_LOAD(sl, sl);
    for (int c4 = 0; c4 < NCH; c4 += RING) {
#pragma unroll
        for (int sl = 0; sl < RING; ++sl) {
            const int c = c4 + sl;
            LAS unsigned char* B = lds + (c & 1) * BUFB;
            f32x2h cs[4]; unsigned kk[4], qq[4], vv[4];
#pragma unroll
            for (int jj = 0; jj < 4; ++jj) { cs[jj] = rl[sl][jj]; kk[jj] = rk[sl][jj]; qq[jj] = rq[sl][jj]; vv[jj] = rv[sl][jj]; }
            if (c + RING < NCH) HG_LOAD(sl, c + RING);
#pragma unroll
            for (int jj = 1; jj < 4; ++jj) cs[jj] += cs[jj - 1];
            LAS float* gs = (LAS float*)(B + GOFF);
            *(LAS f32x2h*)(gs + tg * 128 + d0) = cs[3];
            __syncthreads();
            f32x2h off = {0.f, 0.f}, tot = {0.f, 0.f};
#pragma unroll
            for (int q = 0; q < 8; ++q) { const f32x2h gq = *(const LAS f32x2h*)(gs + q * 128 + d0); tot += gq; if (q < tg) off += gq; }
            float kt0[4], kt1[4];
#pragma unroll
            for (int jj = 0; jj < 4; ++jj) {
                const float b0 = fmaxf(off.x + cs[jj].x, -80.f), b1 = fmaxf(off.y + cs[jj].y, -80.f);
                kt0[jj] = bflo(kk[jj]) * __expf(-b0); kt1[jj] = bfhi(kk[jj]) * __expf(-b1);
                if (OUT) {
                    *(LAS unsigned*)(B + QOFF + (4 * tg + jj) * RS + d0 * 2) = pkbf(bflo(qq[jj]) * __expf(b0), bfhi(qq[jj]) * __expf(b1));
                    *(LAS unsigned*)(B + KOFF + (4 * tg + jj) * RS + d0 * 2) = pkbf(kt0[jj], kt1[jj]);
                }
            }
            { u32x2 o0, o1; o0.x = pkbf(kt0[0], kt0[1]); o0.y = pkbf(kt0[2], kt0[3]); o1.x = pkbf(kt1[0], kt1[1]); o1.y = pkbf(kt1[2], kt1[3]);
              *(LAS u32x2*)(B + KTOFF + d0 * TS + 8 * tg) = o0; *(LAS u32x2*)(B + KTOFF + (d0 + 1) * TS + 8 * tg) = o1;
              u32x2 v0, v1; v0.x = (vv[0] & 0xffffu) | (vv[1] << 16); v0.y = (vv[2] & 0xffffu) | (vv[3] << 16); v1.x = (vv[0] >> 16) | (vv[1] & 0xffff0000u); v1.y = (vv[2] >> 16) | (vv[3] & 0xffff0000u);
              *(LAS u32x2*)(B + VTOFF + d0 * TS + 8 * tg) = v0; *(LAS u32x2*)(B + VTOFF + (d0 + 1) * TS + 8 * tg) = v1; }
            if (tg == 0) { f32x2h dv; dv.x = __expf(fmaxf(tot.x, -80.f)); dv.y = __expf(fmaxf(tot.y, -80.f)); *(LAS f32x2h*)(B + DOFF + d0 * 4) = dv; }
            segsum += tot;
            __syncthreads();
            chunk_matrix<OUT>(B, Sacc, c16, g, e0, dir, h, seg * SEGT + c * CH, OF);
        }
    }
    if (!OUT) {
#pragma unroll
        for (int dt = 0; dt < 8; ++dt) { hst[(dt * 4 + 0) * 64] = Sacc[dt][0]; hst[(dt * 4 + 1) * 64] = Sacc[dt][1]; hst[(dt * 4 + 2) * 64] = Sacc[dt][2]; hst[(dt * 4 + 3) * 64] = Sacc[dt][3]; }
        if (tid < 64) { f32x2h dd; dd.x = __expf(fmaxf(segsum.x, -80.f)); dd.y = __expf(fmaxf(segsum.y, -80.f)); *(f32x2h*)(HSD + (size_t)unit * 128 + d0) = dd; }
    }
    __syncthreads();
}
__device__ __forceinline__ void carry(float* __restrict__ HST, const float* __restrict__ HSD, int gid) {
    const int chain = gid >> 14, el = gid & 16383, dt = (el >> 8) & 7, r = (el >> 6) & 3, ln = el & 63, d = 16 * dt + 4 * (ln >> 4) + r;
    float cy = 0.f;
    for (int sg = 0; sg < NSEG; ++sg) {
        const int u = chain * NSEG + sg;
        const float tmp = HST[(size_t)u * 16384 + el];
        HST[(size_t)u * 16384 + el] = cy;
        cy = HSD[(size_t)u * 128 + d] * cy + tmp;
    }
}
#undef HG_MFMA
#undef HG_LOAD
}

#define XB_TMO      128
#define XB_XCNT(j)  (256  + 64 * (j))
#define XB_XSUB(j)  (1280 + 64 * (j))
#define XB_XGEN(j)  (2304 + 64 * (j))
#define XB_TOP      3328
#define XB_TOPGEN   3392
#define XCD_BAR_WORDS 3456
#define XB_SPIN_CAP (1u << 18)

__device__ __forceinline__ unsigned xb_ld(unsigned* p)              { return __hip_atomic_load(p, __ATOMIC_RELAXED, __HIP_MEMORY_SCOPE_AGENT); }
__device__ __forceinline__ unsigned xb_add(unsigned* p, unsigned v) { return __hip_atomic_fetch_add(p, v, __ATOMIC_RELAXED, __HIP_MEMORY_SCOPE_AGENT); }
__device__ __forceinline__ unsigned xb_xcc_id() { return (unsigned)__builtin_amdgcn_s_getreg((3 << 11) | 20) & 0xFu; }
#define XB_SPIN(cond, bar) do { unsigned _sp = 0; while (cond) { __builtin_amdgcn_s_sleep(1); \
    if ((++_sp & 255u) == 0u) { if (xb_ld(&(bar)[XB_TMO])) break; if (_sp > XB_SPIN_CAP) { atomicAdd(&(bar)[XB_TMO], 1u); break; } } } } while (0)

struct XcdBarrier {
    int wv;
    unsigned* bar; unsigned x;
    volatile LAS unsigned* st;
};

__device__ __forceinline__ XcdBarrier xcd_barrier_post(unsigned* bar, volatile LAS unsigned* st) {
    XcdBarrier b; b.bar = bar; b.x = xb_xcc_id(); b.st = st; b.wv = __builtin_amdgcn_readfirstlane((int)threadIdx.x >> 6);
    if (threadIdx.x == 0) (void)xb_add(&bar[XB_XCNT(b.x)], 1u);
    return b;
}
__device__ __forceinline__ void xcd_barrier_complete(unsigned* bar, unsigned x, unsigned& nloc, unsigned& nx) {
    const unsigned G = gridDim.x * gridDim.y * gridDim.z;
    unsigned sum, cnt, mine, sp = 0u;
    for (;;) {
        sum = 0u; cnt = 0u; mine = 0u;
#pragma unroll
        for (unsigned j = 0; j < 16; ++j) { const unsigned c = xb_ld(&bar[XB_XCNT(j)]); sum += c; cnt += (c > 0u) ? 1u : 0u; mine = (j == x) ? c : mine; }
        if (sum == G) break;
        __builtin_amdgcn_s_sleep(1);
        if ((++sp & 255u) == 0u) { if (xb_ld(&bar[XB_TMO])) break; if (sp > XB_SPIN_CAP) { atomicAdd(&bar[XB_TMO], 1u); break; } }
    }
    nloc = mine > 0u ? mine : 1u; nx = cnt > 0u ? cnt : 1u;
}

__device__ __forceinline__ void xcd_barrier(const XcdBarrier& b) {
    asm volatile("s_waitcnt vmcnt(0)" ::: "memory");
    __syncthreads();
    if (b.wv == 0 && lane_id_opaque() == 0) {
        unsigned* bar = b.bar;
        __builtin_amdgcn_s_waitcnt(0);
        unsigned nloc = b.st[0], nx = b.st[1];
        if (nloc == 0u) { xcd_barrier_complete(bar, b.x, nloc, nx); b.st[0] = nloc; b.st[1] = nx; }
        const unsigned old = xb_add(&bar[XB_XSUB(b.x)], 1u);
        const unsigned gen = old / nloc;
        if (old + 1u == (gen + 1u) * nloc) {
            __builtin_amdgcn_fence(__ATOMIC_RELEASE, "agent");
            asm volatile("s_waitcnt vmcnt(0)" ::: "memory");
            const unsigned og = xb_add(&bar[XB_TOP], 1u);
            const unsigned tg = og / nx;
            if (og + 1u == (tg + 1u) * nx) xb_add(&bar[XB_TOPGEN], 1u);
            else XB_SPIN(xb_ld(&bar[XB_TOPGEN]) == tg, bar);
            __builtin_amdgcn_fence(__ATOMIC_ACQUIRE, "agent");
            xb_add(&bar[XB_XGEN(b.x)], 1u);
            asm volatile("s_waitcnt vmcnt(0)" ::: "memory");
        } else {
            XB_SPIN(xb_ld(&bar[XB_XGEN(b.x)]) == gen, bar);
            __builtin_amdgcn_fence(__ATOMIC_ACQUIRE, "agent");
            asm volatile("s_waitcnt vmcnt(0)" ::: "memory");
        }
    }
    __syncthreads();
}

constexpr int NWAVES = 8;
constexpr int RING_OFF = 0, RING_BYTES = 131072;
constexpr int LDSCTL_OFF = RING_BYTES, MISC_OFF = LDSCTL_OFF + 320;
constexpr int LDS_BYTES = 147456;
constexpr int CW_BAR = 4096;
constexpr int NPL = 13;
constexpr int PH_PRO = 0, PH_NORM1 = 1, PH_L0 = 2, PH_END = PH_L0 + NL * NPL;
enum { P_G1 = 0, P_QKP = 1, P_HGB = 2, P_HGC = 3, P_ATT = 4, P_G2 = 5, P_G3 = 6, P_N2R = 7, P_TOPK = 8, P_GATH = 9, P_G4 = 10, P_G5 = 11, P_COMB = 12 };

#ifndef ATTN_FP8
#define ATTN_FP8 1
#endif
#ifndef KEEP_BF16_QK
#define KEEP_BF16_QK (!ATTN_FP8)
#endif
#ifndef REP_HG
#define REP_HG 1
#endif
#ifndef REP_PRO
#define REP_PRO 1
#endif
#ifndef REP_ROW
#define REP_ROW 1
#endif
#ifndef REP_G
#define REP_G 1
#endif
#ifndef REP_TK
#define REP_TK 1
#endif
#ifndef REP_QK
#define REP_QK 1
#endif
#ifndef REP_ATT
#define REP_ATT 1
#endif
struct Params {
    const float *x, *c, *ada_w, *ada_b, *norm_mix_w, *norm_ffn_w, *w_in, *q_norm_w, *k_norm_w, *hlb, *hg_norm_w, *w_ba, *w_bh, *w_out, *w_router, *w_eg, *w_eu, *w_ed;
    float* out; unsigned char* ws;
    int ph_lo, ph_hi, li, pad;
};
struct Frame {
    LAS unsigned char* lds;
    int tid, lane, wave, vcu, G;
};

__device__ __forceinline__ void tr_tile(const float* __restrict__ src, int ldw, bf16_t* __restrict__ dst, int Kd, LAS float* scr, int lane) {
    f32x4 v[8];
#pragma unroll
    for (int i = 0; i < 8; ++i) v[i] = *(const f32x4*)(src + (size_t)(8 * i + (lane >> 3)) * ldw + 4 * (lane & 7));
#pragma unroll
    for (int i = 0; i < 8; ++i) { LAS float* s = scr + (8 * i + (lane >> 3)) * 33 + 4 * (lane & 7); s[0] = v[i].x; s[1] = v[i].y; s[2] = v[i].z; s[3] = v[i].w; }
    asm volatile("s_waitcnt lgkmcnt(0)" ::: "memory");
    const int cch = lane & 7;
#pragma unroll
    for (int j = 0; j < 4; ++j) { const int n = (lane >> 3) + 8 * j; const LAS float* s = scr + (8 * cch) * 33 + n;
        u32x4 o; o.x = pk2(s[0 * 33], s[1 * 33]); o.y = pk2(s[2 * 33], s[3 * 33]); o.z = pk2(s[4 * 33], s[5 * 33]); o.w = pk2(s[6 * 33], s[7 * 33]);
        *(u32x4*)(dst + (size_t)n * Kd + 8 * cch) = o; }
    asm volatile("s_waitcnt lgkmcnt(0)" ::: "memory");
}
struct ConvItem { const float* src; unsigned char* dst; int ldw, Kd; };
__device__ __forceinline__ ConvItem conv_item_f8(const Params& p, int l, int it) {
    ConvItem c;
    const int which = it / (NE * 1024), r0 = it % (NE * 1024), e = r0 >> 10, r = r0 & 1023;
    if (which < 2) {
        const int kb = r >> 6, nb = r & 63, n0 = 32 * nb;
        const float* W = (which == 0 ? p.w_eg : p.w_eu) + (size_t)(l * NE + e) * D * FF;
        const int rho = e * 4096 + (n0 >> 7) * 256 + which * 128 + (n0 & 127);
        c.src = W + (size_t)(64 * kb) * FF + n0; c.ldw = FF; c.dst = p.ws + WS_WGU + (size_t)l * 64 * MiB + (size_t)rho * D + 64 * kb; c.Kd = D;
    } else {
        const int kb = r >> 5, nb = r & 31, n0 = 32 * nb;
        const float* W = p.w_ed + (size_t)(l * NE + e) * FF * D;
        c.src = W + (size_t)(64 * kb) * D + n0; c.ldw = D; c.dst = p.ws + WS_WD + (size_t)l * 32 * MiB + (size_t)(e * 1024 + n0) * FF + 64 * kb; c.Kd = FF;
    }
    return c;
}
__device__ __forceinline__ void conv_load8(const ConvItem& c, int lane, f32x4 (&v)[8]) {
#pragma unroll
    for (int i = 0; i < 8; ++i) v[i] = *(const f32x4*)(c.src + (size_t)(8 * i + (lane >> 3)) * c.ldw + 4 * (lane & 7));
}
__device__ __forceinline__ void conv_store_f8(const ConvItem& c, int lane, const f32x4 (&v)[8], LAS float* scr, float scale) {
#pragma unroll
    for (int i = 0; i < 8; ++i) { LAS float* s = scr + (8 * i + (lane >> 3)) * 33 + 4 * (lane & 7); s[0] = v[i].x; s[1] = v[i].y; s[2] = v[i].z; s[3] = v[i].w; }
    asm volatile("s_waitcnt lgkmcnt(0)" ::: "memory");
    const int cch = lane & 7;
#pragma unroll
    for (int j = 0; j < 4; ++j) { const int n = (lane >> 3) + 8 * j; const LAS float* s = scr + (8 * cch) * 33 + n;
        const f32x4 a = {s[0 * 33] * scale, s[1 * 33] * scale, s[2 * 33] * scale, s[3 * 33] * scale}, b = {s[4 * 33] * scale, s[5 * 33] * scale, s[6 * 33] * scale, s[7 * 33] * scale};
        *(u32x2*)(c.dst + (size_t)n * c.Kd + 8 * cch) = pg8::pack8_fp8(a, b); }
    asm volatile("s_waitcnt lgkmcnt(0)" ::: "memory");
}
__device__ __forceinline__ void conv_experts_f8(Frame& F, const Params& p, int l, LAS float* scr) {
    const int gw = F.vcu * NWAVES + F.wave, NGW = F.G * NWAVES, NIT = 3 * NE * 1024;
    int it = gw; if (it >= NIT) return;
    ConvItem cur = conv_item_f8(p, l, it); f32x4 va[8], vb[8];
    conv_load8(cur, F.lane, va);
    for (;;) {
        const int it1 = it + NGW; const bool h1 = it1 < NIT; ConvItem c1 = conv_item_f8(p, l, h1 ? it1 : it);
        if (h1) conv_load8(c1, F.lane, vb);
        conv_store_f8(cur, F.lane, va, scr, 64.0f);
        if (!h1) break;
        const int it2 = it1 + NGW; const bool h2 = it2 < NIT; ConvItem c2 = conv_item_f8(p, l, h2 ? it2 : it1);
        if (h2) conv_load8(c2, F.lane, va);
        conv_store_f8(c1, F.lane, vb, scr, 64.0f);
        if (!h2) break;
        cur = c2; it = it2;
    }
}
__device__ __forceinline__ void conv_matrix(Frame& F, const float* W, int ldw, int K, int N, bf16_t* WT, LAS float* scr) {
    const int gw = F.vcu * NWAVES + F.wave, NGW = F.G * NWAVES, nblk = N / 32, nitems = (K / 64) * nblk;
    for (int it = gw; it < nitems; it += NGW) { const int kb = it / nblk, nb = it % nblk;
        tr_tile(W + (size_t)(64 * kb) * ldw + 32 * nb, ldw, WT + (size_t)(32 * nb) * K + 64 * kb, K, scr, F.lane); }
}
__device__ __forceinline__ void conv_matrix_f8(Frame& F, const float* W, int ldw, int K, int N, unsigned char* WT, LAS float* scr, float scale) {
    const int gw = F.vcu * NWAVES + F.wave, NGW = F.G * NWAVES, nblk = N / 32, nitems = (K / 64) * nblk;
    for (int it = gw; it < nitems; it += NGW) { const int kb = it / nblk, nb = it % nblk;
        ConvItem c; c.src = W + (size_t)(64 * kb) * ldw + 32 * nb; c.ldw = ldw; c.dst = WT + (size_t)(32 * nb) * K + 64 * kb; c.Kd = K;
        f32x4 v[8]; conv_load8(c, F.lane, v); conv_store_f8(c, F.lane, v, scr, scale); }
}
__device__ __forceinline__ void conv_experts(Frame& F, const Params& p, int l, LAS float* scr) {
    const int gw = F.vcu * NWAVES + F.wave, NGW = F.G * NWAVES;
    bf16_t* WGU = (bf16_t*)(p.ws + WS_WGU); bf16_t* WD = (bf16_t*)(p.ws + WS_WD);
    for (int it = gw; it < 3 * NE * 1024; it += NGW) {
        const int which = it / (NE * 1024), r0 = it % (NE * 1024), e = r0 >> 10, r = r0 & 1023;
        if (which < 2) {
            const int kb = r >> 6, nb = r & 63, n0 = 32 * nb;
            const float* W = (which == 0 ? p.w_eg : p.w_eu) + (size_t)(l * NE + e) * D * FF;
            const int rho = e * 4096 + (n0 >> 7) * 256 + which * 128 + (n0 & 127);
            tr_tile(W + (size_t)(64 * kb) * FF + n0, FF, WGU + (size_t)rho * D + 64 * kb, D, scr, F.lane);
        } else {
            const int kb = r >> 5, nb = r & 31, n0 = 32 * nb;
            const float* W = p.w_ed + (size_t)(l * NE + e) * FF * D;
            tr_tile(W + (size_t)(64 * kb) * D + n0, D, WD + (size_t)(e * 1024 + n0) * FF + 64 * kb, FF, scr, F.lane);
        }
    }
}
__device__ __forceinline__ void mod_units(Frame& F, const Params& p) {
    LAS float* sc = (LAS float*)(F.lds + 96 * 1024);
    LAS float* red = sc + 1024;
    float* MOD = (float*)(p.ws + WS_MOD); float* LBV = (float*)(p.ws + WS_LBV);
    for (int u = blockIdx.x; u < NL * 96; u += F.G) {
        for (int i = F.tid; i < D; i += 512) sc[i] = siluf_(p.c[i]);
        __syncthreads();
        const int l = u / 96, j = (u % 96) * 64 + (F.tid & 63), kp = F.tid >> 6;
        const float* w = p.ada_w + (size_t)l * D * 6 * D + (size_t)(kp * 128) * 6 * D + j;
        float acc = 0.f;
#pragma unroll 8
        for (int k = 0; k < 128; ++k) acc += sc[kp * 128 + k] * w[(size_t)k * 6 * D];
        red[kp * 64 + (F.tid & 63)] = acc;
        __syncthreads();
        if (F.tid < 64) { float s = 0.f;
#pragma unroll
            for (int q = 0; q < 8; ++q) s += red[q * 64 + F.tid];
            MOD[l * 6 * D + j] = s + p.ada_b[l * 6 * D + j]; }
        __syncthreads();
    }
    const int n = blockIdx.x * 512 + F.tid;
    if (n < NL * 1024) { const int l = n / 1024, r = n % 1024; float v = 0.f;
        if (l == 1) { const float b0 = p.hlb[r], b1 = p.hlb[1024 + r]; v = 1.0f / (1.0f + __expf(b0 - b1)); }
        LBV[n] = v; }
}

__device__ __forceinline__ void norm_mod_row(const f32x4 (&v)[4], float ss, const float* __restrict__ w, const float* __restrict__ scale,
                                             const float* __restrict__ shift, bf16_t* __restrict__ orow, int lane, f32x4 (&h)[4], unsigned char* __restrict__ orow8 = nullptr) {
    const float r = rsqrtf(ss * (1.0f / D) + EPS);
#pragma unroll
    for (int j = 0; j < 4; ++j) {
        const int c0 = 4 * lane + 256 * j;
        const f32x4 wv = *(const f32x4*)(w + c0), sv = *(const f32x4*)(scale + c0), bv = *(const f32x4*)(shift + c0);
        h[j] = (v[j] * r) * wv * (sv + 1.0f) + bv;
        u32x2 o; o.x = pk2(h[j].x, h[j].y); o.y = pk2(h[j].z, h[j].w);
        *(u32x2*)(orow + c0) = o;
        if (orow8) { int wd = 0; wd = __builtin_amdgcn_cvt_pk_fp8_f32(h[j].x, h[j].y, wd, false); wd = __builtin_amdgcn_cvt_pk_fp8_f32(h[j].z, h[j].w, wd, true); *(int*)(orow8 + c0) = wd; }
    }
}
__device__ __forceinline__ void norm_mod_row_f8(const f32x4 (&v)[4], float ss, const float* __restrict__ w, const float* __restrict__ scale,
                                                const float* __restrict__ shift, unsigned char* __restrict__ orow, int lane, f32x4 (&h)[4]) {
    const float r = rsqrtf(ss * (1.0f / D) + EPS);
#pragma unroll
    for (int j = 0; j < 4; ++j) {
        const int c0 = 4 * lane + 256 * j;
        const f32x4 wv = *(const f32x4*)(w + c0), sv = *(const f32x4*)(scale + c0), bv = *(const f32x4*)(shift + c0);
        h[j] = (v[j] * r) * wv * (sv + 1.0f) + bv;
        int wd = 0; wd = __builtin_amdgcn_cvt_pk_fp8_f32(h[j].x, h[j].y, wd, false); wd = __builtin_amdgcn_cvt_pk_fp8_f32(h[j].z, h[j].w, wd, true);
        *(int*)(orow + c0) = wd;
    }
}
__device__ __forceinline__ void ph_norm1(Frame& F, const float* x, const float* w, const float* scale, const float* shift, bf16_t* HB, unsigned char* HB8) {
    const int gw = F.vcu * NWAVES + F.wave, NGW = F.G * NWAVES;
    for (int row = gw; row < S; row += NGW) {
        const f32x4* xr = (const f32x4*)(x + (size_t)row * D) + F.lane;
        f32x4 v[4], h[4]; float ss = 0.f;
#pragma unroll
        for (int j = 0; j < 4; ++j) { v[j] = xr[64 * j]; ss += (v[j].x * v[j].x + v[j].y * v[j].y) + (v[j].z * v[j].z + v[j].w * v[j].w); }
        ss = wave_sum(ss);
        norm_mod_row(v, ss, w, scale, shift, HB + (size_t)row * D, F.lane, h);
    }
}
__device__ __forceinline__ void ph_gather(Frame& F, const unsigned char* HB8, const int* IDX, unsigned char* XE8) {
    const int gw = F.vcu * NWAVES + F.wave, NGW = F.G * NWAVES;
    constexpr int PER = NE * CAP / 2048;
    if (NGW * PER == NE * CAP) {
        const int r0 = gw * PER;
        const int mine = IDX[r0 + (F.lane & 15)];
#pragma unroll
        for (int q = 0; q < PER; q += 8) {
            u32x4 a[8];
#pragma unroll
            for (int k = 0; k < 8; ++k) { const int t = __builtin_amdgcn_readlane(mine, q + k); a[k] = ((const u32x4*)(HB8 + (size_t)t * D))[F.lane]; }
#pragma unroll
            for (int k = 0; k < 8; ++k) ((u32x4*)(XE8 + (size_t)(r0 + q + k) * D))[F.lane] = a[k];
        }
    } else {
        for (int r = gw; r < NE * CAP; r += NGW) { const int t = IDX[r]; ((u32x4*)(XE8 + (size_t)r * D))[F.lane] = ((const u32x4*)(HB8 + (size_t)t * D))[F.lane]; }
    }
}

#define OPAQUE_LANE() const int lane = lane_id_opaque(); const int t_ = F.wave * 64 + lane
__device__ __forceinline__ void ph_rope_table(Frame& F, float* ROPE) {
    OPAQUE_LANE();
    const int n = blockIdx.x * 512 + t_;
    if (n < 4096) { const int pos = n >> 4, i = n & 15; const float inv = exp2f(-(float)i * (13.287712379549449f / 16.0f)); float sn, cs; sincosf((float)pos * inv, &sn, &cs); ROPE[2 * n] = cs; ROPE[2 * n + 1] = sn; }
}
__device__ __forceinline__ void ph_qkprep(Frame& F, const bf16_t* __restrict__ QR, const bf16_t* __restrict__ KR, const float* __restrict__ qw, const float* __restrict__ kw,
                                          const float* __restrict__ ROPE, bf16_t* __restrict__ QN, bf16_t* __restrict__ KN, unsigned char* __restrict__ Q8, unsigned char* __restrict__ K8, int rank, int nranks) {
    OPAQUE_LANE(); (void)lane;
    if (rank < 0) return;
    for (int gid = rank * 512 + t_; gid < S * 10; gid += nranks * 512) {
        const int t = gid / 10, hh = gid % 10;
        const bool isq = hh < 8;
        const bf16_t* src = isq ? QR + (size_t)t * 512 + hh * 64 : KR + (size_t)t * 128 + (hh - 8) * 64;
        bf16_t* dst = isq ? QN + (size_t)t * 512 + hh * 64 : KN + (size_t)t * 128 + (hh - 8) * 64;
        const float* w = isq ? qw : kw;
        float f[64]; float ss = 0.f;
#pragma unroll
        for (int i = 0; i < 8; ++i) { const u32x4 q = *(const u32x4*)(src + 8 * i);
#pragma unroll
            for (int j = 0; j < 4; ++j) { f[8 * i + 2 * j] = bflo(q[j]); f[8 * i + 2 * j + 1] = bfhi(q[j]); } }
#pragma unroll
        for (int i = 0; i < 64; ++i) ss += f[i] * f[i];
        const float rn = rsqrtf(ss * (1.0f / 64.0f) + EPS), sc = isq ? C2 : 1.0f;
#pragma unroll
        for (int i = 0; i < 16; ++i) { const f32x4 wv = *(const f32x4*)(w + 4 * i);
            f[4 * i] *= rn * wv.x; f[4 * i + 1] *= rn * wv.y; f[4 * i + 2] *= rn * wv.z; f[4 * i + 3] *= rn * wv.w; }
        float o[64];
#pragma unroll
        for (int ax = 0; ax < 2; ++ax) {
            const float* tb = ROPE + (size_t)(ax == 0 ? (t >> 6) : (t & 63)) * 32;
#pragma unroll
            for (int i2 = 0; i2 < 8; ++i2) { const f32x4 cs = *(const f32x4*)(tb + 4 * i2);
#pragma unroll
                for (int k = 0; k < 2; ++k) { const int i = 2 * i2 + k; const float c_ = k ? cs.z : cs.x, s_ = k ? cs.w : cs.y;
                    const float x1 = f[ax * 32 + i], x2 = f[ax * 32 + 16 + i];
                    o[ax * 32 + i] = (x1 * c_ - x2 * s_) * sc; o[ax * 32 + 16 + i] = (x2 * c_ + x1 * s_) * sc; } }
        }
#if KEEP_BF16_QK
#pragma unroll
        for (int i = 0; i < 8; ++i) { u32x4 q;
#pragma unroll
            for (int j = 0; j < 4; ++j) q[j] = pk2(o[8 * i + 2 * j], o[8 * i + 2 * j + 1]);
            *(u32x4*)(dst + 8 * i) = q; }
#else
        (void)dst;
#endif
        unsigned char* dst8 = isq ? Q8 + (size_t)t * 512 + hh * 64 : K8 + (size_t)t * 128 + (hh - 8) * 64;
#pragma unroll
        for (int i = 0; i < 4; ++i) { u32x4 q;
#pragma unroll
            for (int j = 0; j < 4; ++j) { int wd = 0; wd = __builtin_amdgcn_cvt_pk_fp8_f32(o[16 * i + 4 * j], o[16 * i + 4 * j + 1], wd, false); wd = __builtin_amdgcn_cvt_pk_fp8_f32(o[16 * i + 4 * j + 2], o[16 * i + 4 * j + 3], wd, true); q[j] = (unsigned)wd; }
            *(u32x4*)(dst8 + 16 * i) = q; }
    }
}
__device__ __forceinline__ void ph_v8t(Frame& F, const bf16_t* __restrict__ VV, unsigned char* __restrict__ V8T) {
    OPAQUE_LANE();
    const int gw = F.vcu * NWAVES + F.wave, NGW = F.G * NWAVES;
    for (int it = gw; it < 2 * (S / 64); it += NGW) {
        const int kvh = it / (S / 64), tile = it % (S / 64);
        const bf16_t* src = VV + (size_t)(64 * tile) * 128 + kvh * 64 + lane;
        u32x4 ov[4];
#pragma unroll
        for (int hi = 0; hi < 2; ++hi)
#pragma unroll
            for (int k = 0; k < 8; ++k) {
                float v[4];
#pragma unroll
                for (int b = 0; b < 4; ++b) { const int j = 4 * k + b; const int key = j < 16 ? ((j & 3) + 8 * (j >> 2) + 4 * hi) : 32 + (((j - 16) & 3) + 8 * ((j - 16) >> 2) + 4 * hi); v[b] = bf2f(src[(size_t)key * 128]); }
                int wd = 0; wd = __builtin_amdgcn_cvt_pk_fp8_f32(v[0], v[1], wd, false); wd = __builtin_amdgcn_cvt_pk_fp8_f32(v[2], v[3], wd, true);
                ov[hi * 2 + (k >> 2)][k & 3] = (unsigned)wd;
            }
        unsigned char* dst = V8T + ((size_t)it * 64 + lane) * 64;
#pragma unroll
        for (int q = 0; q < 4; ++q) *(u32x4*)(dst + 16 * q) = ov[q];
    }
}
__device__ __forceinline__ void ph_hgfin(Frame& F, const float* __restrict__ OF, const bf16_t* __restrict__ HG, const float* __restrict__ w, bf16_t* __restrict__ OHG) {
    OPAQUE_LANE();
    const int gw = F.vcu * NWAVES + F.wave, NGW = F.G * NWAVES;
    const int e0 = (lane & 15) * 8;
    const f32x4 w0 = *(const f32x4*)(w + e0), w1 = *(const f32x4*)(w + e0 + 4);
    for (int t = gw; t < S; t += NGW) {
        const size_t off = (size_t)t * 512 + lane * 8;
        const f32x4 a0 = *(const f32x4*)(OF + off), a1 = *(const f32x4*)(OF + off + 4), b0 = *(const f32x4*)(OF + (size_t)S * 512 + off), b1 = *(const f32x4*)(OF + (size_t)S * 512 + off + 4);
        const f32x4 s0 = a0 + b0, s1 = a1 + b1;
        float ss = (s0.x * s0.x + s0.y * s0.y) + (s0.z * s0.z + s0.w * s0.w) + (s1.x * s1.x + s1.y * s1.y) + (s1.z * s1.z + s1.w * s1.w);
        ss += __shfl_xor(ss, 1); ss += __shfl_xor(ss, 2); ss += __shfl_xor(ss, 4); ss += __shfl_xor(ss, 8);
        const float r = rsqrtf(ss * (1.0f / 128.0f) + EPS);
        const u32x4 g = *(const u32x4*)(HG + off);
        u32x4 o;
        o.x = pk2(s0.x * r * w0.x * bflo(g.x), s0.y * r * w0.y * bfhi(g.x));
        o.y = pk2(s0.z * r * w0.z * bflo(g.y), s0.w * r * w0.w * bfhi(g.y));
        o.z = pk2(s1.x * r * w1.x * bflo(g.z), s1.y * r * w1.y * bfhi(g.z));
        o.w = pk2(s1.z * r * w1.z * bflo(g.w), s1.w * r * w1.w * bfhi(g.w));
        *(u32x4*)(OHG + off) = o;
    }
}
__device__ __forceinline__ void ph_norm2_router(Frame& F, const float* __restrict__ X1, const float* __restrict__ w, const float* __restrict__ scale, const float* __restrict__ shift,
                                                const float* __restrict__ wr, unsigned char* __restrict__ HB, float* __restrict__ AFF) {
    OPAQUE_LANE();
    LAS float* WT = (LAS float*)F.lds;
    for (int dd = t_; dd < D; dd += NWAVES * 64) {
        const GAS f32x4* s = (const GAS f32x4*)((const GAS float*)wr + (size_t)dd * 16);
        const f32x4 a = s[0], b = s[1], c = s[2], e = s[3];
        WT[0 * D + dd] = a.x; WT[1 * D + dd] = a.y; WT[2 * D + dd] = a.z; WT[3 * D + dd] = a.w; WT[4 * D + dd] = b.x; WT[5 * D + dd] = b.y; WT[6 * D + dd] = b.z; WT[7 * D + dd] = b.w;
        WT[8 * D + dd] = c.x; WT[9 * D + dd] = c.y; WT[10 * D + dd] = c.z; WT[11 * D + dd] = c.w; WT[12 * D + dd] = e.x; WT[13 * D + dd] = e.y; WT[14 * D + dd] = e.z; WT[15 * D + dd] = e.w;
    }
    __syncthreads();
    const int gw = F.vcu * NWAVES + F.wave, NGW = F.G * NWAVES;
    for (int row = gw; row < S; row += 2 * NGW) {
        const int row1 = (row + NGW < S) ? row + NGW : row;
        const f32x4* xr0 = (const f32x4*)(X1 + (size_t)row * D) + lane; const f32x4* xr1 = (const f32x4*)(X1 + (size_t)row1 * D) + lane;
        f32x4 v0[4], v1[4], h0[4], h1[4]; float ss0 = 0.f, ss1 = 0.f;
#pragma unroll
        for (int j = 0; j < 4; ++j) { v0[j] = xr0[64 * j]; v1[j] = xr1[64 * j]; }
#pragma unroll
        for (int j = 0; j < 4; ++j) { ss0 += (v0[j].x * v0[j].x + v0[j].y * v0[j].y) + (v0[j].z * v0[j].z + v0[j].w * v0[j].w); ss1 += (v1[j].x * v1[j].x + v1[j].y * v1[j].y) + (v1[j].z * v1[j].z + v1[j].w * v1[j].w); }
        ss0 = wave_sum(ss0); ss1 = wave_sum(ss1);
        norm_mod_row_f8(v0, ss0, w, scale, shift, HB + (size_t)row * D, lane, h0);
        norm_mod_row_f8(v1, ss1, w, scale, shift, HB + (size_t)row1 * D, lane, h1);
        LAS float* wt = WT + 4 * lane; asm volatile("" : "+v"(wt));
        f32x4 lg0[4], lg1[4];
#pragma unroll
        for (int e = 0; e < 16; ++e) {
            float a0 = 0.f, a1 = 0.f;
#pragma unroll
            for (int j = 0; j < 4; ++j) { const f32x4 ww = *(const LAS f32x4*)(wt + e * D + 256 * j);
                a0 += (h0[j].x * ww.x + h0[j].y * ww.y) + (h0[j].z * ww.z + h0[j].w * ww.w); a1 += (h1[j].x * ww.x + h1[j].y * ww.y) + (h1[j].z * ww.z + h1[j].w * ww.w); }
            lg0[e >> 2][e & 3] = wave_sum(a0); lg1[e >> 2][e & 3] = wave_sum(a1);
        }
#pragma unroll
        for (int rr = 0; rr < 2; ++rr) {
            f32x4 (&lgv)[4] = rr ? lg1 : lg0;
            float mx = -1e30f;
#pragma unroll
            for (int e4 = 0; e4 < 4; ++e4) mx = fmaxf(mx, fmaxf(fmaxf(lgv[e4].x, lgv[e4].y), fmaxf(lgv[e4].z, lgv[e4].w)));
            float den = 0.f;
#pragma unroll
            for (int e4 = 0; e4 < 4; ++e4) { lgv[e4].x = __expf(lgv[e4].x - mx); lgv[e4].y = __expf(lgv[e4].y - mx); lgv[e4].z = __expf(lgv[e4].z - mx); lgv[e4].w = __expf(lgv[e4].w - mx);
                den += (lgv[e4].x + lgv[e4].y) + (lgv[e4].z + lgv[e4].w); }
            const float inv = 1.0f / den;
            const f32x4 s8a = (lane & 8) ? lgv[2] : lgv[0], s8b = (lane & 8) ? lgv[3] : lgv[1];
            const f32x4 s4 = (lane & 4) ? s8b : s8a;
            const float s2a = (lane & 2) ? s4.z : s4.x, s2b = (lane & 2) ? s4.w : s4.y;
            const float mine = ((lane & 1) ? s2b : s2a) * inv;
            const int rw = rr ? row1 : row;
            if (lane < 16 && (rr == 0 || row1 != row)) AFF[(size_t)lane * S + rw] = mine;
        }
    }
    __syncthreads();
}
__device__ __forceinline__ void ph_topk(Frame& F, LAS unsigned char* lds, int e, const float* __restrict__ AFF, int* __restrict__ IDX, float* __restrict__ TOPW, int* __restrict__ SLOT) {
    LAS unsigned* hist = (LAS unsigned*)lds;
    LAS unsigned* hsum = hist + 4096;
    LAS unsigned* shv = hsum + 256;
    LAS unsigned* scan = hsum + 512;
    OPAQUE_LANE(); const int tid = t_;
    const unsigned* vals = (const unsigned*)(AFF + (size_t)e * S);
    unsigned u[32];
#pragma unroll
    for (int i = 0; i < 8; ++i) { const u32x4 q = *(const u32x4*)(vals + tid * 32 + 4 * i); u[4 * i] = q.x; u[4 * i + 1] = q.y; u[4 * i + 2] = q.z; u[4 * i + 3] = q.w; }
    if (tid == 0) { shv[0] = 0u; shv[1] = CAP; }
    LAS unsigned* myh = hist + (lane & 15) * 256;
    __syncthreads();
    for (int pass = 3; pass >= 0; --pass) {
        const int shift = pass * 8;
        const unsigned mask = pass == 3 ? 0u : (0xFFFFFFFFu << (shift + 8));
#pragma unroll
        for (int i = 0; i < 8; ++i) hist[tid + 512 * i] = 0u;
        __syncthreads();
        const unsigned prefix = shv[0];
#pragma unroll
        for (int i = 0; i < 32; ++i) if ((u[i] & mask) == (prefix & mask)) __hip_atomic_fetch_add(&myh[(u[i] >> shift) & 255u], 1u, __ATOMIC_RELAXED, __HIP_MEMORY_SCOPE_WORKGROUP);
        __syncthreads();
        if (tid < 256) { unsigned s = 0u;
#pragma unroll
            for (int c = 0; c < 16; ++c) s += hist[c * 256 + tid];
            hsum[tid] = s; }
        __syncthreads();
        if (tid < 64) {
            const unsigned kk = shv[1];
            const unsigned h0 = hsum[4 * lane], h1 = hsum[4 * lane + 1], h2 = hsum[4 * lane + 2], h3 = hsum[4 * lane + 3];
            const unsigned tot = (h0 + h1) + (h2 + h3);
            unsigned inc = tot;
#pragma unroll
            for (int o = 1; o < 64; o <<= 1) { const unsigned v = __shfl_down(inc, o); if (lane + o < 64) inc += v; }
            unsigned c = inc - tot; int bin = -1; unsigned rem = 0u;
            if (c < kk && c + h3 >= kk) { bin = 4 * lane + 3; rem = kk - c; } c += h3;
            if (c < kk && c + h2 >= kk) { bin = 4 * lane + 2; rem = kk - c; } c += h2;
            if (c < kk && c + h1 >= kk) { bin = 4 * lane + 1; rem = kk - c; } c += h1;
            if (c < kk && c + h0 >= kk) { bin = 4 * lane; rem = kk - c; }
            if (bin >= 0) { shv[1] = rem; shv[0] = prefix | ((unsigned)bin << shift); }
        }
        __syncthreads();
    }
    const unsigned T = shv[0], need_eq = shv[1];
    unsigned ceq = 0u;
#pragma unroll
    for (int i = 0; i < 32; ++i) ceq += (u[i] == T) ? 1u : 0u;
    scan[tid] = ceq; __syncthreads();
    for (int off = 1; off < 512; off <<= 1) { const unsigned tv = tid >= off ? scan[tid - off] : 0u; __syncthreads(); scan[tid] += tv; __syncthreads(); }
    unsigned eq_rank = scan[tid] - ceq;
    __syncthreads();
    unsigned selmask = 0u, csel = 0u;
#pragma unroll
    for (int i = 0; i < 32; ++i) { bool sel = u[i] > T; if (u[i] == T) { sel = eq_rank < need_eq; ++eq_rank; } if (sel) { selmask |= 1u << i; ++csel; } }
    scan[tid] = csel; __syncthreads();
    for (int off = 1; off < 512; off <<= 1) { const unsigned tv = tid >= off ? scan[tid - off] : 0u; __syncthreads(); scan[tid] += tv; __syncthreads(); }
    unsigned slot = scan[tid] - csel;
#pragma unroll
    for (int i = 0; i < 32; ++i) {
        const int t = tid * 32 + i; int sl = -1;
        if (selmask & (1u << i)) { sl = (int)slot; ++slot; if (sl < CAP) { IDX[e * CAP + sl] = t; TOPW[e * CAP + sl] = __uint_as_float(u[i]); } }
        SLOT[(size_t)e * S + t] = sl < CAP ? sl : -1;
    }
    __syncthreads();
}
__device__ __forceinline__ void ph_combine(Frame& F, const float* __restrict__ X1, const bf16_t* __restrict__ YE, const int* __restrict__ SLOT, const float* __restrict__ gate,
                                           float* __restrict__ xout, const float* __restrict__ w, const float* __restrict__ scale, const float* __restrict__ shift, bf16_t* __restrict__ HB, unsigned char* __restrict__ HB8, bool do_norm) {
    OPAQUE_LANE();
    const int gw = F.vcu * NWAVES + F.wave, NGW = F.G * NWAVES;
    for (int row = gw; row < S; row += 2 * NGW) {
        const bool two = row + NGW < S; const int row1 = two ? row + NGW : row;
        const int sl0 = lane < NE ? SLOT[(size_t)lane * S + row] : -1, sl1 = lane < NE ? SLOT[(size_t)lane * S + row1] : -1;
        const f32x4* xr0 = (const f32x4*)(X1 + (size_t)row * D) + lane; const f32x4* xr1 = (const f32x4*)(X1 + (size_t)row1 * D) + lane;
        f32x4 v0[4], v1[4];
#pragma unroll
        for (int j = 0; j < 4; ++j) { v0[j] = xr0[64 * j]; v1[j] = xr1[64 * j]; }
        f32x4 acc0[4], acc1[4];
#pragma unroll
        for (int j = 0; j < 4; ++j) { acc0[j] = f32x4{0.f, 0.f, 0.f, 0.f}; acc1[j] = acc0[j]; }
        unsigned m0 = (unsigned)__ballot(sl0 >= 0) & 0xffffu, m1 = (unsigned)__ballot(sl1 >= 0) & 0xffffu;
        while (m0 | m1) {
            const int e0 = m0 ? __builtin_ctz(m0) : 0, e1 = m1 ? __builtin_ctz(m1) : 0;
            const float f0 = m0 ? 1.f : 0.f, f1 = m1 ? 1.f : 0.f;
            const int s0 = m0 ? __builtin_amdgcn_readlane(sl0, e0) : 0, s1 = m1 ? __builtin_amdgcn_readlane(sl1, e1) : 0;
            m0 &= m0 - 1u; m1 &= m1 - 1u;
            const bf16_t* y0 = YE + ((size_t)e0 * CAP + s0) * D + 4 * lane; const bf16_t* y1 = YE + ((size_t)e1 * CAP + s1) * D + 4 * lane;
            u32x2 q0[4], q1[4];
#pragma unroll
            for (int j = 0; j < 4; ++j) { q0[j] = *(const u32x2*)(y0 + 256 * j); q1[j] = *(const u32x2*)(y1 + 256 * j); }
#pragma unroll
            for (int j = 0; j < 4; ++j) { acc0[j].x += f0 * bflo(q0[j].x); acc0[j].y += f0 * bfhi(q0[j].x); acc0[j].z += f0 * bflo(q0[j].y); acc0[j].w += f0 * bfhi(q0[j].y);
                                          acc1[j].x += f1 * bflo(q1[j].x); acc1[j].y += f1 * bfhi(q1[j].x); acc1[j].z += f1 * bflo(q1[j].y); acc1[j].w += f1 * bfhi(q1[j].y); }
        }
        f32x4 h[4]; float ss0 = 0.f, ss1 = 0.f;
#pragma unroll
        for (int j = 0; j < 4; ++j) { const f32x4 gv = *(const f32x4*)(gate + 4 * lane + 256 * j); v0[j] = v0[j] + gv * acc0[j]; v1[j] = v1[j] + gv * acc1[j];
            ((f32x4*)(xout + (size_t)row * D) + lane)[64 * j] = v0[j]; if (two) ((f32x4*)(xout + (size_t)row1 * D) + lane)[64 * j] = v1[j];
            ss0 += (v0[j].x * v0[j].x + v0[j].y * v0[j].y) + (v0[j].z * v0[j].z + v0[j].w * v0[j].w); ss1 += (v1[j].x * v1[j].x + v1[j].y * v1[j].y) + (v1[j].z * v1[j].z + v1[j].w * v1[j].w); }
        if (do_norm) { ss0 = wave_sum(ss0); ss1 = wave_sum(ss1); norm_mod_row(v0, ss0, w, scale, shift, HB + (size_t)row * D, lane, h); if (two) norm_mod_row(v1, ss1, w, scale, shift, HB + (size_t)row1 * D, lane, h); }
    }
}

__global__ void __launch_bounds__(NWAVES * 64, 2) mega(Params p) {
    extern __shared__ __attribute__((aligned(16))) unsigned char lds[];
    Frame F;
    F.lds = (LAS unsigned char*)lds;
    volatile LAS unsigned* MISC = (volatile LAS unsigned*)(F.lds + MISC_OFF);
    F.tid = threadIdx.x; F.lane = F.tid & 63; F.wave = __builtin_amdgcn_readfirstlane(F.tid >> 6);
    F.G = gridDim.x; { const int bx = blockIdx.x; F.vcu = (F.G % 8 == 0) ? (bx % 8) * (F.G / 8) + bx / 8 : bx; }
    unsigned char* ws = p.ws;
    unsigned* ctl = (unsigned*)(ws + WS_CTL);
    for (int u = F.tid; u < (LDS_BYTES - LDSCTL_OFF) / 4; u += NWAVES * 64) ((LAS unsigned*)(F.lds + LDSCTL_OFF))[u] = 0u;
    __syncthreads();
    XcdBarrier bar = xcd_barrier_post(ctl + CW_BAR + p.li * XCD_BAR_WORDS, MISC + 8);
    const int lo = p.ph_lo, hi = p.ph_hi;
#define IN(k) (lo <= (k) && (k) < hi)
#define SEAM(k) do { if (IN(k) && IN((k) + 1)) xcd_barrier(bar); } while (0)
#define REFRESH() do { F.lane = lane_id_opaque(); F.tid = F.wave * 64 + F.lane; } while (0)

#define WSP(T, off) ((T*)(GAS T*)(wsl + (off)))
#define WSL() unsigned char* wsl = p.ws; asm volatile("" : "+s"(wsl))
    LAS float* scr = (LAS float*)(F.lds + RING_OFF + F.wave * 8704);

    if (IN(PH_PRO)) { REFRESH(); WSL();
        mod_units(F, p);
        for (int l = 0; l < NL; ++l) {
            conv_matrix(F, p.w_in + (size_t)l * D * INW, INW, D, INW, WSP(bf16_t, WS_WIN) + (size_t)l * INW * D, scr);
            conv_matrix(F, p.w_ba + (size_t)l * 512 * D, D, 512, D, WSP(bf16_t, WS_WBA) + (size_t)l * D * 512, scr);
            conv_matrix(F, p.w_bh + (size_t)l * 512 * D, D, 512, D, WSP(bf16_t, WS_WBH) + (size_t)l * D * 512, scr);
            conv_matrix(F, p.w_out + (size_t)l * D * D, D, D, D, WSP(bf16_t, WS_WOUT) + (size_t)l * D * D, scr);
        }
        for (int rep_ = 0; rep_ < REP_PRO; ++rep_) { conv_experts_f8(F, p, 0, scr); conv_experts_f8(F, p, 1, scr); }
        ph_rope_table(F, WSP(float, WS_ROPE));
    }
    SEAM(PH_PRO);
    if (IN(PH_NORM1)) { REFRESH(); WSL(); ph_norm1(F, p.x, p.norm_mix_w, WSP(float, WS_MOD) + 1 * D, WSP(float, WS_MOD) + 0 * D, WSP(bf16_t, WS_HB), WSP(unsigned char, WS_HBF8)); }
    SEAM(PH_NORM1);

    for (int l = 0; l < NL; ++l) {
        const int pb = PH_L0 + l * NPL;
        if (IN(pb + P_G1)) { WSL();
            pg8::Gemm g{WSP(bf16_t, WS_HB), WSP(bf16_t, WS_WIN) + (size_t)l * INW * D, S, 3072, D}; pg8::StaticOrder So; So.init(S, 3072, F.G, (int)blockIdx.x);
            pg8::EpiInproj E{WSP(bf16_t, WS_QR), WSP(bf16_t, WS_KR), WSP(bf16_t, WS_VV), WSP(bf16_t, WS_HQ), WSP(bf16_t, WS_KF), WSP(bf16_t, WS_HV), WSP(bf16_t, WS_HG), WSP(bf16_t, WS_GG), WSP(float, WS_LF), WSP(float, WS_LBV) + l * 1024, 1.0f};
            for (int rep_ = 0; rep_ < REP_G; ++rep_) pg8::gemm_phase<pg8::EpiInproj, pg8::StaticOrder, true, true>(F.lds + RING_OFF, g, So, E, F.wave);
        }
        SEAM(pb + P_G1);
        if (IN(pb + P_QKP)) { WSL();
            {
              pg8::Gemm g{WSP(bf16_t, WS_HB), WSP(bf16_t, WS_WIN) + (size_t)l * INW * D + (size_t)3072 * D, S, 2304, D}; pg8::OffOrder So; So.So.init(S, 2304, F.G, (int)blockIdx.x); So.off = 12;
              pg8::EpiInproj E{WSP(bf16_t, WS_QR), WSP(bf16_t, WS_KR), WSP(bf16_t, WS_VV), WSP(bf16_t, WS_HQ), WSP(bf16_t, WS_KF), WSP(bf16_t, WS_HV), WSP(bf16_t, WS_HG), WSP(bf16_t, WS_GG), WSP(float, WS_LF), WSP(float, WS_LBV) + l * 1024, 1.0f};
              for (int rep_ = 0; rep_ < REP_G; ++rep_) pg8::gemm_phase<pg8::EpiInproj, pg8::OffOrder, true, true>(F.lds + RING_OFF, g, So, E, F.wave); }
            { const bool even = (F.G == 256); const int rk = even ? (int)blockIdx.x - 64 : (int)blockIdx.x, nr = even ? 192 : F.G;
              for (int rep_ = 0; rep_ < REP_QK; ++rep_) ph_qkprep(F, WSP(bf16_t, WS_QR), WSP(bf16_t, WS_KR), p.q_norm_w + l * 64, p.k_norm_w + l * 64, WSP(float, WS_ROPE), WSP(bf16_t, WS_QN), WSP(bf16_t, WS_KN), WSP(unsigned char, WS_Q8), WSP(unsigned char, WS_K8), rk, nr);
              ph_v8t(F, WSP(bf16_t, WS_VV), WSP(unsigned char, WS_V8T)); }
            for (int rep_ = 0; rep_ < REP_HG; ++rep_) for (int u = blockIdx.x; u < 256; u += F.G) hg::segment<false>(F.lds, u, WSP(bf16_t, WS_HQ), WSP(float, WS_LF), WSP(bf16_t, WS_KF), WSP(bf16_t, WS_HV), WSP(float, WS_HST), WSP(float, WS_HST + 16 * MiB), nullptr, F.wave);
        }
        SEAM(pb + P_QKP);
        if (IN(pb + P_HGB)) { WSL(); OPAQUE_LANE(); (void)lane;
            for (int gid = blockIdx.x * 512 + t_; gid < 8 * 16384; gid += F.G * 512) hg::carry(WSP(float, WS_HST), WSP(float, WS_HST + 16 * MiB), gid);
        }
        SEAM(pb + P_HGB);
        if (IN(pb + P_HGC)) { WSL();
            for (int rep_ = 0; rep_ < REP_HG; ++rep_) for (int u = blockIdx.x; u < 256; u += F.G) hg::segment<true>(F.lds, u, WSP(bf16_t, WS_HQ), WSP(float, WS_LF), WSP(bf16_t, WS_KF), WSP(bf16_t, WS_HV), WSP(float, WS_HST), WSP(float, WS_HST + 16 * MiB), WSP(float, WS_OF), F.wave);
        }
        SEAM(pb + P_HGC);
        if (IN(pb + P_ATT)) { WSL();
            for (int rep_ = 0; rep_ < REP_QK; ++rep_) ph_hgfin(F, WSP(float, WS_OF), WSP(bf16_t, WS_HG), p.hg_norm_w + l * 128, WSP(bf16_t, WS_OHG));
            float negM;
            { const int ln = lane_id_opaque(); float mq = fabsf(p.q_norm_w[l * 64 + ln]), mk = fabsf(p.k_norm_w[l * 64 + ln]);
#pragma unroll
              for (int o_ = 1; o_ < 64; o_ <<= 1) { mq = fmaxf(mq, __shfl_xor(mq, o_)); mk = fmaxf(mk, __shfl_xor(mk, o_)); }
              negM = -(64.0f * C2) * mq * mk * 1.05f; }
#if ATTN_FP8
            const attn8::Tensors AT{WSP(unsigned char, WS_Q8), WSP(unsigned char, WS_K8), WSP(unsigned char, WS_V8T), (attn8::bf16*)WSP(bf16_t, WS_OATT)};
            for (int rep_ = 0; rep_ < REP_ATT; ++rep_) attn8::phase((char*)lds + RING_OFF, AT, (int)F.G, (int)blockIdx.x, F.wave, negM + 8.0f);
#else
            const attn_body::AttnTensors AT{(const attn_body::bf16*)WSP(bf16_t, WS_QN), (const attn_body::bf16*)WSP(bf16_t, WS_KN), (const attn_body::bf16*)WSP(bf16_t, WS_VV), (attn_body::bf16*)WSP(bf16_t, WS_OATT)};
            const attn_body::StaticOrder So((int)F.G, (int)blockIdx.x);
            for (int rep_ = 0; rep_ < REP_ATT; ++rep_) attn_body::attn_phase<attn_body::StaticOrder>((char*)lds + RING_OFF, AT, So, F.wave, negM);
#endif
        }
        SEAM(pb + P_ATT);
        if (IN(pb + P_G2)) { WSL();
            pg8::Gemm g{WSP(bf16_t, WS_OATT), WSP(bf16_t, WS_WBA) + (size_t)l * D * 512, S, D, 512, WSP(bf16_t, WS_OHG), WSP(bf16_t, WS_WBH) + (size_t)l * D * 512};
            pg8::ChainOrder So; So.So.init(S, D, F.G, (int)blockIdx.x);
            pg8::EpiMerge E{WSP(bf16_t, WS_GG), WSP(bf16_t, WS_MG)};
            for (int rep_ = 0; rep_ < REP_G; ++rep_) pg8::gemm_phase<pg8::EpiMerge, pg8::ChainOrder, false, true>(F.lds + RING_OFF, g, So, E, F.wave);
        }
        SEAM(pb + P_G2);
        if (IN(pb + P_G3)) { WSL();
            pg8::Gemm g{WSP(bf16_t, WS_MG), WSP(bf16_t, WS_WOUT) + (size_t)l * D * D, S, D, D}; pg8::StaticOrder So; So.init(S, D, F.G, (int)blockIdx.x);
            pg8::EpiOut E{l == 0 ? p.x : WSP(float, WS_X2), WSP(float, WS_MOD) + l * 6 * D + 2 * D, WSP(float, WS_X1)};
            for (int rep_ = 0; rep_ < REP_G; ++rep_) pg8::gemm_phase<pg8::EpiOut, pg8::StaticOrder, false, true>(F.lds + RING_OFF, g, So, E, F.wave);
        }
        SEAM(pb + P_G3);
        if (IN(pb + P_N2R)) { WSL();
            for (int rep_ = 0; rep_ < REP_ROW; ++rep_) ph_norm2_router(F, WSP(float, WS_X1), p.norm_ffn_w + l * D, WSP(float, WS_MOD) + l * 6 * D + 4 * D, WSP(float, WS_MOD) + l * 6 * D + 3 * D, p.w_router + (size_t)l * D * NE, WSP(unsigned char, WS_HB8), WSP(float, WS_AFF));
        }
        SEAM(pb + P_N2R);
        if (IN(pb + P_TOPK)) { WSL();
            for (int rep_ = 0; rep_ < REP_TK; ++rep_) for (int e = blockIdx.x; e < NE; e += F.G) ph_topk(F, F.lds, e, WSP(float, WS_AFF), WSP(int, WS_IDX), WSP(float, WS_TOPW), WSP(int, WS_SLOT));
        }
        SEAM(pb + P_TOPK);
        if (IN(pb + P_GATH)) { REFRESH(); WSL(); for (int rep_ = 0; rep_ < REP_ROW; ++rep_) ph_gather(F, WSP(unsigned char, WS_HB8), WSP(int, WS_IDX), WSP(unsigned char, WS_XE8)); }
        SEAM(pb + P_GATH);
        if (IN(pb + P_G4)) { WSL();
            pg8::Gemm g{(const bf16_t*)WSP(unsigned char, WS_XE8), (const bf16_t*)(WSP(unsigned char, WS_WGU) + (size_t)l * 64 * MiB), NE * CAP, NE * 4096, D / 2}; pg8::GroupOrder So; So.init(16, F.G, (int)blockIdx.x);
            pg8::EpiGU8 E{WSP(unsigned char, WS_HID8)};
            for (int rep_ = 0; rep_ < REP_G; ++rep_) pg8::gemm_phase<pg8::EpiGU8, pg8::GroupOrder, true, true, true>(F.lds + RING_OFF, g, So, E, F.wave);
        }
        SEAM(pb + P_G4);
        if (IN(pb + P_G5)) { WSL();
            pg8::Gemm g{(const bf16_t*)WSP(unsigned char, WS_HID8), (const bf16_t*)(WSP(unsigned char, WS_WD) + (size_t)l * 32 * MiB), NE * CAP, NE * 1024, FF / 2}; pg8::GroupOrder So; So.init(4, F.G, (int)blockIdx.x);
            pg8::EpiDown E{WSP(bf16_t, WS_YE), WSP(float, WS_TOPW), 0.015625f};
            for (int rep_ = 0; rep_ < REP_G; ++rep_) pg8::gemm_phase<pg8::EpiDown, pg8::GroupOrder, true, true, true>(F.lds + RING_OFF, g, So, E, F.wave);
        }
        SEAM(pb + P_G5);
        if (IN(pb + P_COMB)) { WSL();
            const bool last = (l + 1 == NL); const int ln = last ? l : l + 1;
            for (int rep_ = 0; rep_ < REP_ROW; ++rep_) ph_combine(F, WSP(float, WS_X1), WSP(bf16_t, WS_YE), WSP(int, WS_SLOT), WSP(float, WS_MOD) + l * 6 * D + 5 * D, last ? p.out : WSP(float, WS_X2),
                       p.norm_mix_w + ln * D, WSP(float, WS_MOD) + ln * 6 * D + 1 * D, WSP(float, WS_MOD) + ln * 6 * D + 0 * D, WSP(bf16_t, WS_HB), WSP(unsigned char, WS_HBF8), !last);
        }
        SEAM(pb + P_COMB);
    }
#undef IN
#undef SEAM
}

#ifndef N_LAUNCH_MODE
#define N_LAUNCH_MODE 1
#endif
static int g_grid = 0;
extern "C" void kernel_launch(void* const* d_in, const int* in_sizes, int n_in, void* d_out, int out_size, void* d_ws, size_t ws_size, hipStream_t stream) {
    if (n_in != 18 || out_size != S * D || ws_size < WS_END) { fprintf(stderr, "kernel_launch: unexpected shapes (n_in %d out %d ws %zu)\n", n_in, out_size, ws_size); return; }
    if (g_grid == 0) {
        int dev = 0, cus = 0;
        if (hipGetDevice(&dev) != hipSuccess || hipDeviceGetAttribute(&cus, hipDeviceAttributeMultiprocessorCount, dev) != hipSuccess) { g_grid = -1; return; }
        if (hipFuncSetAttribute((const void*)mega, hipFuncAttributeMaxDynamicSharedMemorySize, LDS_BYTES) != hipSuccess) { g_grid = -1; return; }
        int per_cu = 0;
        if (hipOccupancyMaxActiveBlocksPerMultiprocessor(&per_cu, (const void*)mega, NWAVES * 64, LDS_BYTES) != hipSuccess || per_cu < 1) { fprintf(stderr, "occupancy query: %d\n", per_cu); }
        (void)hipGetLastError();
        g_grid = cus;
    }
    if (g_grid < 0) return;
    unsigned char* ws = (unsigned char*)d_ws;
    (void)hipMemsetAsync(ws + WS_CTL, 0, 1 * MiB, stream);
    Params p{};
    p.x = (const float*)d_in[0]; p.c = (const float*)d_in[1]; p.ada_w = (const float*)d_in[2]; p.ada_b = (const float*)d_in[3]; p.norm_mix_w = (const float*)d_in[4];
    p.norm_ffn_w = (const float*)d_in[5]; p.w_in = (const float*)d_in[6]; p.q_norm_w = (const float*)d_in[7]; p.k_norm_w = (const float*)d_in[8]; p.hlb = (const float*)d_in[9];
    p.hg_norm_w = (const float*)d_in[10]; p.w_ba = (const float*)d_in[11]; p.w_bh = (const float*)d_in[12]; p.w_out = (const float*)d_in[13]; p.w_router = (const float*)d_in[14];
    p.w_eg = (const float*)d_in[15]; p.w_eu = (const float*)d_in[16]; p.w_ed = (const float*)d_in[17];
    p.out = (float*)d_out; p.ws = ws;
#if defined(DBG_ATT)
    { const int cut = PH_L0 + P_ATT + 1;
      p.ph_lo = 0; p.ph_hi = cut; p.li = 0; p.pad = 0; hipLaunchKernelGGL(mega, dim3(g_grid), dim3(NWAVES * 64), LDS_BYTES, stream, p);
      hipMemcpyAsync(ws + 900 * MiB, ws + WS_OATT, 16 * MiB, hipMemcpyDeviceToDevice, stream);
      k_attn_naive<<<dim3(S / 64, 8), dim3(64), 0, stream>>>((const bf16_t*)(ws + WS_QN), (const bf16_t*)(ws + WS_KN), (const bf16_t*)(ws + WS_VV), (bf16_t*)(ws + WS_OATT));
      k_cmp_bf16<<<dim3(2048), dim3(256), 0, stream>>>((const bf16_t*)(ws + 900 * MiB), (const bf16_t*)(ws + WS_OATT), (size_t)8 * MiB, 512, 0, 512, (float*)(ws + 512 * 1024));
      p.ph_lo = cut; p.ph_hi = PH_END; p.li = 1; hipLaunchKernelGGL(mega, dim3(g_grid), dim3(NWAVES * 64), LDS_BYTES, stream, p);
      k_scale_out<<<dim3(2048), dim3(256), 0, stream>>>((float*)d_out, (size_t)S * D, (const float*)(ws + 512 * 1024)); }
#elif N_LAUNCH_MODE == 1
    p.ph_lo = 0; p.ph_hi = PH_END; p.li = 0; p.pad = 0;
    hipLaunchKernelGGL(mega, dim3(g_grid), dim3(NWAVES * 64), LDS_BYTES, stream, p);
#else
    for (int k = 0; k < PH_END; ++k) { p.ph_lo = k; p.ph_hi = k + 1; p.li = k; p.pad = 0; hipLaunchKernelGGL(mega, dim3(g_grid), dim3(NWAVES * 64), LDS_BYTES, stream, p); }
#endif
}
```

```cpp
#include <hip/hip_runtime.h>
#include <cstdio>
#include <cstdint>

typedef unsigned short bf16_t;
typedef float f32x4 __attribute__((ext_vector_type(4)));
typedef float f32x16 __attribute__((ext_vector_type(16)));
typedef unsigned u32x4 __attribute__((ext_vector_type(4)));
typedef unsigned u32x2 __attribute__((ext_vector_type(2)));

constexpr int S = 16384, D = 1024, NL = 2, INW = 5376;
constexpr int NE = 16, CAP = 2048, FF = 2048;
constexpr float EPS = 1e-6f;
constexpr float C2 = 0.125f * 1.4426950408889634f;
constexpr int C_AQ = 0, C_AK = 512, C_AV = 640, C_HQ = 768, C_ZF = 1280, C_ZB = 1792, C_HI = 2304, C_HGT = 2816, C_GL = 3328;

constexpr size_t MiB = 1u << 20;
constexpr size_t WS_CTL = 0;
constexpr size_t WS_MOD = 1 * MiB;
constexpr size_t WS_LBV = WS_MOD + 64 * 1024;
constexpr size_t WS_IDX = WS_MOD + 128 * 1024;
constexpr size_t WS_TOPW = WS_IDX + 128 * 1024;
constexpr size_t WS_ROPE = WS_MOD + 512 * 1024;
constexpr size_t WS_AFF = 2 * MiB;
constexpr size_t WS_SLOT = 3 * MiB;
constexpr size_t WS_HB = 4 * MiB;
constexpr size_t WS_QR = 36 * MiB;
constexpr size_t WS_KR = 52 * MiB;
constexpr size_t WS_VV = 56 * MiB;
constexpr size_t WS_QN = 60 * MiB;
constexpr size_t WS_KN = 76 * MiB;
constexpr size_t WS_HQ = 80 * MiB;
constexpr size_t WS_LF = 96 * MiB;
constexpr size_t WS_KF = 160 * MiB;
constexpr size_t WS_HV = 192 * MiB;
constexpr size_t WS_HG = 208 * MiB;
constexpr size_t WS_GG = 224 * MiB;
constexpr size_t WS_OATT = 288 * MiB;
constexpr size_t WS_OF = 304 * MiB;
constexpr size_t WS_OHG = 368 * MiB;
constexpr size_t WS_MP = 384 * MiB;
constexpr size_t WS_MG = 448 * MiB;
constexpr size_t WS_HB8 = 36 * MiB;
constexpr size_t WS_XE8 = 52 * MiB;
constexpr size_t WS_HID8 = 100 * MiB;
constexpr size_t WS_XE = 36 * MiB;
constexpr size_t WS_HID = 100 * MiB;
constexpr size_t WS_YE = 228 * MiB;
constexpr size_t WS_X1 = 480 * MiB;
constexpr size_t WS_X2 = 544 * MiB;
constexpr size_t WS_WIN = 608 * MiB;
constexpr size_t WS_WBA = 630 * MiB;
constexpr size_t WS_WBH = 632 * MiB;
constexpr size_t WS_WOUT = 634 * MiB;
constexpr size_t WS_WGU = 638 * MiB;
constexpr size_t WS_WD = 766 * MiB;
constexpr size_t WS_HST = 830 * MiB;
constexpr size_t WS_Q8 = 912 * MiB;
constexpr size_t WS_K8 = 920 * MiB;
constexpr size_t WS_V8T = 922 * MiB;
constexpr size_t WS_WIN8 = 900 * MiB;
constexpr size_t WS_HBF8 = 906 * MiB;
constexpr size_t WS_END = 924 * MiB;
static_assert(WS_END <= 1024 * MiB, "workspace");

__device__ __forceinline__ float bf2f(bf16_t v) { return __uint_as_float((unsigned)v << 16); }
__device__ __forceinline__ bf16_t f2bf(float f) { unsigned u = __float_as_uint(f); return (bf16_t)((u + 0x7fffu + ((u >> 16) & 1u)) >> 16); }
__device__ __forceinline__ unsigned pk2(float lo, float hi) { return (unsigned)f2bf(lo) | ((unsigned)f2bf(hi) << 16); }
__device__ __forceinline__ float bflo(unsigned w) { return __uint_as_float(w << 16); }
__device__ __forceinline__ float bfhi(unsigned w) { return __uint_as_float(w & 0xffff0000u); }
__device__ __forceinline__ float sigmoidf_(float v) { return __builtin_amdgcn_rcpf(1.0f + __expf(-v)); }
__device__ __forceinline__ float siluf_(float v) { return v * __builtin_amdgcn_rcpf(1.0f + __expf(-v)); }
__device__ __forceinline__ float wave_sum(float v) {
#pragma unroll
    for (int o = 1; o < 64; o <<= 1) v += __shfl_xor(v, o);
    return v;
}
__device__ __forceinline__ int crow(int r, int hi) { return (r & 3) + 8 * (r >> 2) + 4 * hi; }
__device__ __forceinline__ int lane_id_opaque() { int l; asm volatile("v_mbcnt_lo_u32_b32 %0, -1, 0\n\tv_mbcnt_hi_u32_b32 %0, -1, %0" : "=v"(l)); return l; }

#define GAS __attribute__((address_space(1)))
#define LAS __attribute__((address_space(3)))

namespace pg8 {
#define PG8_LAS __attribute__((address_space(3)))
typedef unsigned short bf16_t;
typedef short bf16x8 __attribute__((ext_vector_type(8)));
typedef float f32x4 __attribute__((ext_vector_type(4)));
typedef unsigned u32x4 __attribute__((ext_vector_type(4)));
constexpr int BM = 256, BK = 64, HALF = 128, HTB = HALF * BK * 2  , STAGE_BYTES = 8 * HTB, NXCD = 8, WGM = 8;

__host__ __device__ __forceinline__ int lds_byte(int r, int c) { const int st = (r >> 4) * 2 + (c >> 5), rr = r & 15, cc = c & 31, ob = rr * 64 + cc * 2; return st * 1024 + (ob ^ (((ob >> 9) & 1) << 5)); }
__host__ __device__ __forceinline__ void stage_rc(int b, int& R, int& C) { const int st = b / 1024, sb = b % 1024, swz = sb ^ (((sb >> 9) & 1) << 5); R = (st >> 1) * 16 + swz / 64; C = (st & 1) * 32 + (swz % 64) / 2; }
__host__ __device__ __forceinline__ int perm32(int rho) { const int n = rho >> 4, i = rho & 15; return 8 * (i >> 2) + 4 * n + (i & 3); }

struct Unit { int pm, pn, pb, sel; };
struct Gemm { const bf16_t* A; const bf16_t* Bt; int M, N, K; const bf16_t* A2 = nullptr; const bf16_t* Bt2 = nullptr; const int* rowidx = nullptr; };

struct StaticOrder {
    int nM, nN, nwg, G, c;
    __host__ __device__ void init(int M, int N, int G_, int c_) { nM = M / BM; nN = N / BM; nwg = nM * nN; G = G_; c = c_; }
    __host__ __device__ bool next(int i, Unit& u) const {
        const long L = (long)i * G + c; if (L >= nwg) return false;
        int wgid = (int)L; { const int q = nwg / NXCD, r = nwg % NXCD, xcd = wgid % NXCD, off = wgid / NXCD; wgid = (xcd < r ? xcd * (q + 1) : r * (q + 1) + (xcd - r) * q) + off; }
        const int nig = WGM * nN, gid = wgid / nig, fm = gid * WGM, gsz = (nM - fm) < WGM ? (nM - fm) : WGM;
        u.pm = fm + ((wgid % nig) % gsz); u.pn = (wgid % nig) / gsz; u.pb = u.pn; u.sel = 0; return true;
    }
    __device__ __forceinline__ void a_ready(const Unit&) const {}
    __device__ __forceinline__ void done(const Unit&) const {}
};

typedef float f32x2_c __attribute__((ext_vector_type(2))); typedef __bf16 bf16x2_c __attribute__((ext_vector_type(2)));
__device__ __forceinline__ unsigned cvt_pk_bf16(float lo, float hi) { f32x2_c v = {lo, hi}; bf16x2_c b = __builtin_convertvector(v, bf16x2_c); return __builtin_bit_cast(unsigned, b); }

typedef unsigned u32x2 __attribute__((ext_vector_type(2)));
__device__ __forceinline__ float e_bflo(unsigned w) { return __uint_as_float(w << 16); }
__device__ __forceinline__ float e_bfhi(unsigned w) { return __uint_as_float(w & 0xffff0000u); }
__device__ __forceinline__ float e_sig(float v) { return __builtin_amdgcn_rcpf(1.0f + __expf(-v)); }
__device__ __forceinline__ u32x4 pack8(const f32x4 a, const f32x4 b) { u32x4 w; w.x = cvt_pk_bf16(a[0], a[1]); w.y = cvt_pk_bf16(a[2], a[3]); w.z = cvt_pk_bf16(b[0], b[1]); w.w = cvt_pk_bf16(b[2], b[3]); return w; }

typedef int i32x4_ __attribute__((ext_vector_type(4))); typedef int i32x8_ __attribute__((ext_vector_type(8)));
__device__ __forceinline__ i32x8_ pg8_cat(const bf16x8 lo, const bf16x8 hi) { return __builtin_shufflevector(__builtin_bit_cast(i32x4_, lo), __builtin_bit_cast(i32x4_, hi), 0, 1, 2, 3, 4, 5, 6, 7); }
__device__ __forceinline__ u32x2 pack8_fp8(const f32x4 a, const f32x4 b) { int w0 = 0, w1 = 0;
    w0 = __builtin_amdgcn_cvt_pk_fp8_f32(a[0], a[1], w0, false); w0 = __builtin_amdgcn_cvt_pk_fp8_f32(a[2], a[3], w0, true);
    w1 = __builtin_amdgcn_cvt_pk_fp8_f32(b[0], b[1], w1, false); w1 = __builtin_amdgcn_cvt_pk_fp8_f32(b[2], b[3], w1, true);
    u32x2 r; r.x = (unsigned)w0; r.y = (unsigned)w1; return r; }
struct EpiInproj {
    static constexpr bool PERM = true, AFTER_DRAIN = false, CHAIN = false;
    bf16_t *QR, *KR, *VV, *HQ, *KF, *HV, *HG, *GG; float* LF; const float* lbv; float ascale;
    __device__ __forceinline__ void operator()(const f32x4 (&acc)[2][2][4][2], const Unit& u, int wr, int wc, int fr, int fq) const {
        const int row0 = u.pm * BM + wr * 64 + fr, cl = wc * 32 + 8 * fq;
#pragma unroll
        for (int bj = 0; bj < 2; ++bj) {
            const int colg = u.pn * BM + bj * HALF;
            int kind; bf16_t* dst; int pitch, c0; int dir = 0;
            if (colg < 512) { kind = 0; dst = QR; pitch = 512; c0 = colg; }
            else if (colg < 640) { kind = 0; dst = KR; pitch = 128; c0 = colg - 512; }
            else if (colg < 768) { kind = 0; dst = VV; pitch = 128; c0 = colg - 640; }
            else if (colg < 1280) { kind = 1; dst = HQ; pitch = 512; c0 = colg - 768; }
            else if (colg < 2304) { kind = 3; dir = colg >= 1792; dst = KF + (size_t)dir * 16384 * 512; pitch = 512; c0 = colg - (dir ? 1792 : 1280); }
            else if (colg < 2816) { kind = 0; dst = HV; pitch = 512; c0 = colg - 2304; }
            else if (colg < 3328) { kind = 1; dst = HG; pitch = 512; c0 = colg - 2816; }
            else { kind = 2; dst = GG; pitch = 2048; c0 = colg - 3328; }
            c0 += cl;
            if (kind == 0) {
#pragma unroll
                for (int ai = 0; ai < 2; ++ai)
#pragma unroll
                    for (int m = 0; m < 4; ++m) *(u32x4*)(dst + (size_t)(row0 + ai * HALF + m * 16) * pitch + c0) = pack8(acc[ai][bj][m][0] * ascale, acc[ai][bj][m][1] * ascale);
            } else if (kind == 1) {
#pragma unroll
                for (int ai = 0; ai < 2; ++ai)
#pragma unroll
                    for (int m = 0; m < 4; ++m) { f32x4 a = acc[ai][bj][m][0] * ascale, b = acc[ai][bj][m][1] * ascale;
#pragma unroll
                        for (int i = 0; i < 4; ++i) { a[i] = a[i] * e_sig(a[i]); b[i] = b[i] * e_sig(b[i]); }
                        *(u32x4*)(dst + (size_t)(row0 + ai * HALF + m * 16) * pitch + c0) = pack8(a, b); }
            } else if (kind == 2) {
#pragma unroll
                for (int ai = 0; ai < 2; ++ai)
#pragma unroll
                    for (int m = 0; m < 4; ++m) { f32x4 a = acc[ai][bj][m][0] * ascale, b = acc[ai][bj][m][1] * ascale;
#pragma unroll
                        for (int i = 0; i < 4; ++i) { a[i] = e_sig(a[i]); b[i] = e_sig(b[i]); }
                        *(u32x4*)(dst + (size_t)(row0 + ai * HALF + m * 16) * pitch + c0) = pack8(a, b); }
            } else {
                const f32x4 lb0 = *(const f32x4*)(lbv + dir * 512 + c0), lb1 = *(const f32x4*)(lbv + dir * 512 + c0 + 4);
                float* lf = LF + (size_t)dir * 16384 * 512;
#pragma unroll
                for (int ai = 0; ai < 2; ++ai)
#pragma unroll
                    for (int m = 0; m < 4; ++m) { const f32x4 a = acc[ai][bj][m][0] * ascale, b = acc[ai][bj][m][1] * ascale; f32x4 la, lb_, ka, kb;
#pragma unroll
                        for (int i = 0; i < 4; ++i) {
                            const float sa = e_sig(a[i]), sb = e_sig(b[i]);
                            la[i] = __logf(fmaxf(lb0[i] + (1.0f - lb0[i]) * sa, 1e-6f)); ka[i] = (1.0f - lb0[i]) * (1.0f - sa);
                            lb_[i] = __logf(fmaxf(lb1[i] + (1.0f - lb1[i]) * sb, 1e-6f)); kb[i] = (1.0f - lb1[i]) * (1.0f - sb); }
                        const size_t o = (size_t)(row0 + ai * HALF + m * 16) * 512 + c0;
                        *(f32x4*)(lf + o) = la; *(f32x4*)(lf + o + 4) = lb_;
                        *(u32x4*)(dst + o) = pack8(ka, kb); }
            }
        }
    }
};
struct EpiBrA {
    static constexpr bool PERM = true, AFTER_DRAIN = false, CHAIN = false;
    const bf16_t* GG; float* MP;
    __device__ __forceinline__ void operator()(const f32x4 (&acc)[2][2][4][2], const Unit& u, int wr, int wc, int fr, int fq) const {
        const int row0 = u.pm * BM + wr * 64 + fr, col0 = u.pn * BM + wc * 32 + 8 * fq;
#pragma unroll
        for (int ai = 0; ai < 2; ++ai)
#pragma unroll
            for (int m = 0; m < 4; ++m) { const size_t r = (size_t)(row0 + ai * HALF + m * 16);
#pragma unroll
                for (int bj = 0; bj < 2; ++bj) { const int c = col0 + bj * HALF; const u32x4 g = *(const u32x4*)(GG + r * 2048 + c);
                    f32x4 a = acc[ai][bj][m][0], b = acc[ai][bj][m][1];
                    a[0] *= e_bflo(g.x); a[1] *= e_bfhi(g.x); a[2] *= e_bflo(g.y); a[3] *= e_bfhi(g.y); b[0] *= e_bflo(g.z); b[1] *= e_bfhi(g.z); b[2] *= e_bflo(g.w); b[3] *= e_bfhi(g.w);
                    *(f32x4*)(MP + r * 1024 + c) = a; *(f32x4*)(MP + r * 1024 + c + 4) = b; } }
    }
};
struct EpiBrH {
    static constexpr bool PERM = true, AFTER_DRAIN = false, CHAIN = false;
    const bf16_t* GG; const float* MP; bf16_t* MG;
    __device__ __forceinline__ void operator()(const f32x4 (&acc)[2][2][4][2], const Unit& u, int wr, int wc, int fr, int fq) const {
        const int row0 = u.pm * BM + wr * 64 + fr, col0 = u.pn * BM + wc * 32 + 8 * fq;
#pragma unroll
        for (int ai = 0; ai < 2; ++ai)
#pragma unroll
            for (int m = 0; m < 4; ++m) { const size_t r = (size_t)(row0 + ai * HALF + m * 16);
#pragma unroll
                for (int bj = 0; bj < 2; ++bj) { const int c = col0 + bj * HALF; const u32x4 g = *(const u32x4*)(GG + r * 2048 + 1024 + c);
                    f32x4 a = acc[ai][bj][m][0], b = acc[ai][bj][m][1]; const f32x4 pa = *(const f32x4*)(MP + r * 1024 + c), pb = *(const f32x4*)(MP + r * 1024 + c + 4);
                    a[0] = pa[0] + a[0] * e_bflo(g.x); a[1] = pa[1] + a[1] * e_bfhi(g.x); a[2] = pa[2] + a[2] * e_bflo(g.y); a[3] = pa[3] + a[3] * e_bfhi(g.y);
                    b[0] = pb[0] + b[0] * e_bflo(g.z); b[1] = pb[1] + b[1] * e_bfhi(g.z); b[2] = pb[2] + b[2] * e_bflo(g.w); b[3] = pb[3] + b[3] * e_bfhi(g.w);
                    *(u32x4*)(MG + r * 1024 + c) = pack8(a, b); } }
    }
};
struct EpiMerge {
    static constexpr bool PERM = true, AFTER_DRAIN = false, CHAIN = true;
    const bf16_t* GG; bf16_t* MG;
    __device__ __forceinline__ void mid(f32x4 (&acc)[2][2][4][2], const Unit& u, int wr, int wc, int fr, int fq) const {
        const int row0 = u.pm * BM + wr * 64 + fr, col0 = u.pn * BM + wc * 32 + 8 * fq;
#pragma unroll
        for (int ai = 0; ai < 2; ++ai)
#pragma unroll
            for (int m = 0; m < 4; ++m) { const size_t r = (size_t)(row0 + ai * HALF + m * 16);
#pragma unroll
                for (int bj = 0; bj < 2; ++bj) { const int c = col0 + bj * HALF; const u32x4 g0 = *(const u32x4*)(GG + r * 2048 + c), g1 = *(const u32x4*)(GG + r * 2048 + 1024 + c);
                    f32x4& a = acc[ai][bj][m][0]; f32x4& b = acc[ai][bj][m][1];
                    a[0] *= e_bflo(g0.x) * __builtin_amdgcn_rcpf(e_bflo(g1.x)); a[1] *= e_bfhi(g0.x) * __builtin_amdgcn_rcpf(e_bfhi(g1.x));
                    a[2] *= e_bflo(g0.y) * __builtin_amdgcn_rcpf(e_bflo(g1.y)); a[3] *= e_bfhi(g0.y) * __builtin_amdgcn_rcpf(e_bfhi(g1.y));
                    b[0] *= e_bflo(g0.z) * __builtin_amdgcn_rcpf(e_bflo(g1.z)); b[1] *= e_bfhi(g0.z) * __builtin_amdgcn_rcpf(e_bfhi(g1.z));
                    b[2] *= e_bflo(g0.w) * __builtin_amdgcn_rcpf(e_bflo(g1.w)); b[3] *= e_bfhi(g0.w) * __builtin_amdgcn_rcpf(e_bfhi(g1.w)); } }
    }
    __device__ __forceinline__ void operator()(const f32x4 (&acc)[2][2][4][2], const Unit& u, int wr, int wc, int fr, int fq) const {
        const int row0 = u.pm * BM + wr * 64 + fr, col0 = u.pn * BM + wc * 32 + 8 * fq;
#pragma unroll
        for (int ai = 0; ai < 2; ++ai)
#pragma unroll
            for (int m = 0; m < 4; ++m) { const size_t r = (size_t)(row0 + ai * HALF + m * 16);
#pragma unroll
                for (int bj = 0; bj < 2; ++bj) { const int c = col0 + bj * HALF; const u32x4 g = *(const u32x4*)(GG + r * 2048 + 1024 + c);
                    f32x4 a = acc[ai][bj][m][0], b = acc[ai][bj][m][1];
                    a[0] *= e_bflo(g.x); a[1] *= e_bfhi(g.x); a[2] *= e_bflo(g.y); a[3] *= e_bfhi(g.y); b[0] *= e_bflo(g.z); b[1] *= e_bfhi(g.z); b[2] *= e_bflo(g.w); b[3] *= e_bfhi(g.w);
                    *(u32x4*)(MG + r * 1024 + c) = pack8(a, b); } }
    }
};
struct OffOrder {
    StaticOrder So; int off;
    __device__ bool next(int i, Unit& u) const { if (!So.next(i, u)) return false; u.pb = u.pn; u.pn += off; return true; }
    __device__ __forceinline__ void a_ready(const Unit&) const {}
    __device__ __forceinline__ void done(const Unit&) const {}
};
struct ChainOrder {
    StaticOrder So;
    __device__ bool next(int i, Unit& u) const { if (!So.next(i >> 1, u)) return false; u.sel = i & 1; return true; }
    __device__ __forceinline__ void a_ready(const Unit&) const {}
    __device__ __forceinline__ void done(const Unit&) const {}
};
struct EpiOut {
    static constexpr bool PERM = true, AFTER_DRAIN = false, CHAIN = false;
    const float* xin; const float* gate; float* X1;
    __device__ __forceinline__ void operator()(const f32x4 (&acc)[2][2][4][2], const Unit& u, int wr, int wc, int fr, int fq) const {
        const int row0 = u.pm * BM + wr * 64 + fr, col0 = u.pn * BM + wc * 32 + 8 * fq;
#pragma unroll
        for (int bj = 0; bj < 2; ++bj) { const int c = col0 + bj * HALF; const f32x4 g0 = *(const f32x4*)(gate + c), g1 = *(const f32x4*)(gate + c + 4);
#pragma unroll
            for (int ai = 0; ai < 2; ++ai)
#pragma unroll
                for (int m = 0; m < 4; ++m) { const size_t o = (size_t)(row0 + ai * HALF + m * 16) * 1024 + c;
                    *(f32x4*)(X1 + o) = *(const f32x4*)(xin + o) + g0 * acc[ai][bj][m][0]; *(f32x4*)(X1 + o + 4) = *(const f32x4*)(xin + o + 4) + g1 * acc[ai][bj][m][1]; } }
    }
};
struct EpiGU {
    static constexpr bool PERM = true, AFTER_DRAIN = false, CHAIN = false;
    bf16_t* HID;
    __device__ __forceinline__ void operator()(const f32x4 (&acc)[2][2][4][2], const Unit& u, int wr, int wc, int fr, int fq) const {
        const int row0 = u.pm * BM + wr * 64 + fr, col0 = u.pn * HALF + wc * 32 + 8 * fq;
#pragma unroll
        for (int ai = 0; ai < 2; ++ai)
#pragma unroll
            for (int m = 0; m < 4; ++m) { f32x4 a = acc[ai][0][m][0], b = acc[ai][0][m][1]; const f32x4 ua = acc[ai][1][m][0], ub = acc[ai][1][m][1];
#pragma unroll
                for (int i = 0; i < 4; ++i) { a[i] = a[i] * e_sig(a[i]) * ua[i]; b[i] = b[i] * e_sig(b[i]) * ub[i]; }
                *(u32x4*)(HID + (size_t)(row0 + ai * HALF + m * 16) * 2048 + col0) = pack8(a, b); }
    }
};
struct EpiGU8 {
    static constexpr bool PERM = true, AFTER_DRAIN = false, CHAIN = false;
    unsigned char* HID;
    __device__ __forceinline__ void operator()(const f32x4 (&acc)[2][2][4][2], const Unit& u, int wr, int wc, int fr, int fq) const {
        const int row0 = u.pm * BM + wr * 64 + fr, col0 = u.pn * HALF + wc * 32 + 8 * fq;
#pragma unroll
        for (int ai = 0; ai < 2; ++ai)
#pragma unroll
            for (int m = 0; m < 4; ++m) { f32x4 a = acc[ai][0][m][0], b = acc[ai][0][m][1]; const f32x4 ua = acc[ai][1][m][0], ub = acc[ai][1][m][1];
#pragma unroll
                for (int i = 0; i < 4; ++i) { const float ga = a[i] * 0.015625f, gb = b[i] * 0.015625f; a[i] = ga * e_sig(ga) * (ua[i] * 0.015625f); b[i] = gb * e_sig(gb) * (ub[i] * 0.015625f); }
                *(u32x2*)(HID + (size_t)(row0 + ai * HALF + m * 16) * 2048 + col0) = pack8_fp8(a, b); }
    }
};
struct EpiDown {
    static constexpr bool PERM = true, AFTER_DRAIN = false, CHAIN = false;
    bf16_t* YE; const float* topw; float wscale;
    __device__ __forceinline__ void operator()(const f32x4 (&acc)[2][2][4][2], const Unit& u, int wr, int wc, int fr, int fq) const {
        const int row0 = u.pm * BM + wr * 64 + fr, col0 = u.pn * BM + wc * 32 + 8 * fq;
#pragma unroll
        for (int ai = 0; ai < 2; ++ai)
#pragma unroll
            for (int m = 0; m < 4; ++m) { const int r = row0 + ai * HALF + m * 16; const float w = topw[r] * wscale;
#pragma unroll
                for (int bj = 0; bj < 2; ++bj) *(u32x4*)(YE + (size_t)r * 1024 + col0 + bj * HALF) = pack8(acc[ai][bj][m][0] * w, acc[ai][bj][m][1] * w); }
    }
};
struct GroupOrder {
    int nNe, nwg, G, c;
    __device__ void init(int nNe_, int G_, int c_) { nNe = nNe_; nwg = 16 * 8 * nNe_; G = G_; c = c_; }
    __device__ bool next(int i, Unit& u) const {
        const long L = (long)i * G + c; if (L >= nwg) return false;
        int wgid = (int)L; { const int q = nwg / NXCD, xcd = wgid % NXCD, off = wgid / NXCD; wgid = xcd * q + off; }
        const int per = 8 * nNe, e = wgid / per, w = wgid % per;
        u.pm = e * 8 + (w & 7); u.pn = w >> 3; u.pb = e * nNe + u.pn; u.sel = 0; return true;
    }
    __device__ __forceinline__ void a_ready(const Unit&) const {}
    __device__ __forceinline__ void done(const Unit&) const {}
};

template <class Epi, class Sched, bool ALIGN_EPI = false, bool SP2 = false, bool FP8 = false, bool GATHER = false>
__device__ __forceinline__ void gemm_phase(PG8_LAS unsigned char* lds, const Gemm g, const Sched& S, const Epi& E, int wave_) {
    const int tid_ = wave_ * 64 + lane_id_opaque();
    const int tid = tid_, wid = __builtin_amdgcn_readfirstlane(tid >> 6), lane = tid & 63, wr = wid >> 2, wc = wid & 3, fr = lane & 15, fq = lane >> 4;
    int K_ = g.K; asm volatile("" : "+s"(K_));
    const int K = K_, nt = K / BK;
    unsigned voffA[2], voffB[2];
#pragma unroll
    for (int i = 0; i < 2; ++i) { int R, C; stage_rc(tid * 16 + i * 8192, R, C); const int Rb = Epi::PERM ? ((R & ~31) + perm32(R & 31)) : R;
        voffA[i] = (unsigned)(R * K + C) * 2u; voffB[i] = (unsigned)(Rb * K + C) * 2u; }
    unsigned vA[2][2] = {{0u, 0u}, {0u, 0u}}, vN[2][2] = {{0u, 0u}, {0u, 0u}};
#define PG8_GOFF(dst, u_) do { if constexpr (GATHER) { _Pragma("unroll") for (int h_ = 0; h_ < 2; ++h_) _Pragma("unroll") for (int i_ = 0; i_ < 2; ++i_) \
        { int R_, C_; stage_rc(tid * 16 + i_ * 8192, R_, C_);     \
          dst[h_][i_] = (unsigned)((const __attribute__((address_space(1))) int*)g.rowidx)[(u_).pm * BM + h_ * HALF + R_] * (unsigned)(K * 2) + (unsigned)C_ * 2u; } } } while (0)
    const size_t kstep = (size_t)(BK * 2);
    const size_t hstep = (size_t)HALF * K * 2;
    const size_t tstep = 2 * hstep;
    const unsigned ldsw = (unsigned)wid * 1024u;
    const int aoff = lds_byte(wr * 64 + fr, fq * 8), boff = lds_byte(wc * 32 + fr, fq * 8);
#define PG8_SA(b, h) (((b) * 2 + (h)) * HTB)
#define PG8_SB(b, h) ((4 + (b) * 2 + (h)) * HTB)
#define PG8_STAGE(bufoff, gbase, voff) do { _Pragma("unroll") for (int _i = 0; _i < 2; ++_i) \
        __builtin_amdgcn_global_load_lds((const unsigned*)((const char*)(gbase) + (voff)[_i]), (PG8_LAS unsigned*)(lds + (bufoff) + ldsw + _i * 8192), 16, 0, 0); } while (0)
#define PG8_STAGE_A(bufoff, gptr, half, nsel) do { if constexpr (GATHER) { unsigned vs_[2]; vs_[0] = (nsel) ? vN[half][0] : vA[half][0]; vs_[1] = (nsel) ? vN[half][1] : vA[half][1]; PG8_STAGE(bufoff, gptr, vs_); } \
        else { PG8_STAGE(bufoff, (gptr) + (half) * hstep, voffA); } } while (0)
#define PG8_LDA(dst, b, h) do { if constexpr (FP8) { _Pragma("unroll") for (int m = 0; m < 4; ++m) dst##8[m] = pg8_cat(*(const PG8_LAS bf16x8*)(lds + PG8_SA(b, h) + aoff + m * 2048), *(const PG8_LAS bf16x8*)(lds + PG8_SA(b, h) + aoff + m * 2048 + 1024)); } else { \
        _Pragma("unroll") for (int m = 0; m < 4; ++m) _Pragma("unroll") for (int k = 0; k < 2; ++k) dst[m][k] = *(const PG8_LAS bf16x8*)(lds + PG8_SA(b, h) + aoff + m * 2048 + k * 1024); } } while (0)
#define PG8_LDB(dst, b, h) do { if constexpr (FP8) { _Pragma("unroll") for (int n = 0; n < 2; ++n) dst##8[n] = pg8_cat(*(const PG8_LAS bf16x8*)(lds + PG8_SB(b, h) + boff + n * 2048), *(const PG8_LAS bf16x8*)(lds + PG8_SB(b, h) + boff + n * 2048 + 1024)); } else { \
        _Pragma("unroll") for (int n = 0; n < 2; ++n) _Pragma("unroll") for (int k = 0; k < 2; ++k) dst[n][k] = *(const PG8_LAS bf16x8*)(lds + PG8_SB(b, h) + boff + n * 2048 + k * 1024); } } while (0)
#define PG8_MMA(ai, bj, At, Bt) do { __builtin_amdgcn_s_setprio(1); if constexpr (FP8) { \
        _Pragma("unroll") for (int m = 0; m < 4; ++m) _Pragma("unroll") for (int n = 0; n < 2; ++n) \
        asm volatile("v_mfma_f32_16x16x128_f8f6f4 %0, %1, %2, %0" : "+v"(acc[ai][bj][m][n]) : "v"(Bt##8[n]), "v"(At##8[m])); } else {     \
        _Pragma("unroll") for (int m = 0; m < 4; ++m) _Pragma("unroll") for (int n = 0; n < 2; ++n) _Pragma("unroll") for (int k = 0; k < 2; ++k) \
        acc[ai][bj][m][n] = __builtin_amdgcn_mfma_f32_16x16x32_bf16(Bt[n][k], At[m][k], acc[ai][bj][m][n], 0, 0, 0); } __builtin_amdgcn_s_setprio(0); } while (0)
#define PG8_WAIT_V(n) asm volatile("s_waitcnt vmcnt(" #n ")" ::: "memory")
#define PG8_WAIT_L(n) asm volatile("s_waitcnt lgkmcnt(" #n ")" ::: "memory")
#define PG8_BAR __builtin_amdgcn_s_barrier()
#define PG8_SCHED __builtin_amdgcn_sched_barrier(0)
    Unit cur, nxt; int ui = 0;
    if (!S.next(0, cur)) return;
    f32x4 acc[2][2][4][2];
#pragma unroll
    for (int a = 0; a < 2; ++a)
#pragma unroll
        for (int b = 0; b < 2; ++b)
#pragma unroll
            for (int m = 0; m < 4; ++m)
#pragma unroll
                for (int n = 0; n < 2; ++n) acc[a][b][m][n] = (f32x4){0.f, 0.f, 0.f, 0.f};
    bf16x8 At[4][2], B0[2][2], B1[2][2]; i32x8_ At8[4], B08[2], B18[2];
    const char* cA = GATHER ? (const char*)g.A : (const char*)(cur.sel ? g.A2 : g.A) + (size_t)cur.pm * tstep; PG8_GOFF(vA, cur); const char* cB = (const char*)(cur.sel ? g.Bt2 : g.Bt) + (size_t)cur.pb * tstep;
    S.a_ready(cur);
    if constexpr (SP2) {
        PG8_STAGE(PG8_SB(0, 0), cB, voffB); PG8_STAGE(PG8_SB(0, 1), cB + hstep, voffB); PG8_STAGE_A(PG8_SA(0, 0), cA, 0, false); PG8_STAGE_A(PG8_SA(0, 1), cA, 1, false);
        if (wr == 1) PG8_BAR;
        PG8_WAIT_V(2); PG8_BAR;
        PG8_STAGE(PG8_SB(1, 0), cB + kstep, voffB); PG8_STAGE_A(PG8_SA(1, 0), cA + kstep, 0, false); PG8_STAGE(PG8_SB(1, 1), cB + hstep + kstep, voffB);
        PG8_WAIT_V(6); PG8_BAR;
    } else {
        PG8_STAGE(PG8_SB(0, 0), cB, voffB); PG8_STAGE_A(PG8_SA(0, 0), cA, 0, false); PG8_STAGE(PG8_SB(0, 1), cB + hstep, voffB); PG8_STAGE_A(PG8_SA(0, 1), cA, 1, false);
        if (wr == 1) PG8_BAR;
        PG8_WAIT_V(4); PG8_BAR;
        PG8_STAGE(PG8_SB(1, 0), cB + kstep, voffB); PG8_STAGE_A(PG8_SA(1, 0), cA + kstep, 0, false); PG8_STAGE(PG8_SB(1, 1), cB + hstep + kstep, voffB);
        PG8_WAIT_V(6); PG8_BAR;
    }
    for (;;) {
        const bool has_next = S.next(ui + 1, nxt);
        if (has_next) PG8_GOFF(vN, nxt); else { if constexpr (GATHER) { vN[0][0] = vA[0][0]; vN[0][1] = vA[0][1]; vN[1][0] = vA[1][0]; vN[1][1] = vA[1][1]; } }
        const char* nA = GATHER ? (const char*)g.A : has_next ? (const char*)(nxt.sel ? g.A2 : g.A) + (size_t)nxt.pm * tstep : cA; const char* nB = has_next ? (const char*)(nxt.sel ? g.Bt2 : g.Bt) + (size_t)nxt.pb * tstep : cB;
#pragma unroll 1
        for (int t = 0; t < nt; t += 2) {
            const bool last = (t == nt - 2);
            const char* a1 = cA + (size_t)(t + 1) * kstep;
            const char* a2 = last ? nA : cA + (size_t)(t + 2) * kstep; const char* b2 = last ? nB : cB + (size_t)(t + 2) * kstep;
            const char* a3 = a2 + kstep; const char* b3 = b2 + kstep;
            if (last && has_next) S.a_ready(nxt);
            if constexpr (SP2) {
            PG8_LDB(B0, 0, 0); PG8_LDB(B1, 0, 1); PG8_SCHED; PG8_LDA(At, 0, 0); PG8_STAGE_A(PG8_SA(1, 1), a1, 1, false);
            PG8_WAIT_V(8); PG8_WAIT_L(0); PG8_BAR; PG8_MMA(0, 0, At, B0); PG8_MMA(0, 1, At, B1); PG8_BAR; PG8_SCHED;
            PG8_LDA(At, 0, 1); PG8_STAGE(PG8_SB(0, 0), b2, voffB); PG8_STAGE(PG8_SB(0, 1), b2 + hstep, voffB); PG8_STAGE_A(PG8_SA(0, 0), a2, 0, last);
            PG8_WAIT_V(8); PG8_WAIT_L(0); PG8_BAR; PG8_MMA(1, 0, At, B0); PG8_MMA(1, 1, At, B1); PG8_BAR; PG8_SCHED;
            PG8_LDB(B0, 1, 0); PG8_LDB(B1, 1, 1); PG8_SCHED; PG8_LDA(At, 1, 0); PG8_STAGE_A(PG8_SA(0, 1), a2, 1, last);
            PG8_WAIT_V(8); PG8_WAIT_L(0); PG8_BAR; PG8_MMA(0, 0, At, B0); PG8_MMA(0, 1, At, B1); PG8_BAR; PG8_SCHED;
            PG8_LDA(At, 1, 1); PG8_STAGE(PG8_SB(1, 0), b3, voffB); PG8_STAGE(PG8_SB(1, 1), b3 + hstep, voffB); PG8_STAGE_A(PG8_SA(1, 0), a3, 0, last);
            PG8_WAIT_V(8); PG8_WAIT_L(0); PG8_BAR; PG8_MMA(1, 0, At, B0); PG8_MMA(1, 1, At, B1); PG8_BAR; PG8_SCHED;
            } else {
            PG8_LDB(B0, 0, 0); PG8_SCHED; PG8_LDA(At, 0, 0); PG8_STAGE_A(PG8_SA(1, 1), a1, 1, false);
            PG8_WAIT_L(8); PG8_BAR; PG8_WAIT_L(0); PG8_MMA(0, 0, At, B0); PG8_BAR; PG8_SCHED;
            PG8_LDB(B1, 0, 1); PG8_STAGE(PG8_SB(0, 0), b2, voffB);
            PG8_BAR; PG8_WAIT_L(0); PG8_MMA(0, 1, At, B1); PG8_BAR;
            PG8_LDA(At, 0, 1); PG8_STAGE_A(PG8_SA(0, 0), a2, 0, last);
            PG8_BAR; PG8_WAIT_L(0); PG8_MMA(1, 0, At, B0); PG8_BAR; PG8_SCHED;
            PG8_STAGE(PG8_SB(0, 1), b2 + hstep, voffB);
            PG8_WAIT_V(6); PG8_BAR; PG8_MMA(1, 1, At, B1); PG8_BAR;
            PG8_LDB(B0, 1, 0); PG8_SCHED; PG8_LDA(At, 1, 0); PG8_STAGE_A(PG8_SA(0, 1), a2, 1, last);
            PG8_WAIT_L(8); PG8_BAR; PG8_WAIT_L(0); PG8_MMA(0, 0, At, B0); PG8_BAR; PG8_SCHED;
            PG8_LDB(B1, 1, 1); PG8_STAGE(PG8_SB(1, 0), b3, voffB);
            PG8_BAR; PG8_WAIT_L(0); PG8_MMA(0, 1, At, B1); PG8_BAR;
            PG8_LDA(At, 1, 1); PG8_STAGE_A(PG8_SA(1, 0), a3, 0, last);
            PG8_BAR; PG8_WAIT_L(0); PG8_MMA(1, 0, At, B0); PG8_BAR; PG8_SCHED;
            PG8_STAGE(PG8_SB(1, 1), b3 + hstep, voffB);
            PG8_WAIT_V(6); PG8_BAR; PG8_MMA(1, 1, At, B1); PG8_BAR;
            }
        }
        if constexpr (FP8) asm volatile("s_nop 15\n\ts_nop 7" ::: "memory");
        if constexpr (ALIGN_EPI) { if (wr == 0) PG8_BAR; }
        bool fin = true; if constexpr (Epi::CHAIN) fin = (cur.sel != 0);
        if constexpr (!Epi::AFTER_DRAIN) { const int le_ = lane_id_opaque(), fre = le_ & 15, fqe = le_ >> 4;
            if (fin) E(acc, cur, wr, wc, fre, fqe); else { if constexpr (Epi::CHAIN) E.mid(acc, cur, wr, wc, fre, fqe); } S.done(cur); }
        if (!has_next) break;
        if (fin)
#pragma unroll
        for (int a = 0; a < 2; ++a)
#pragma unroll
            for (int b = 0; b < 2; ++b)
#pragma unroll
                for (int m = 0; m < 4; ++m)
#pragma unroll
                    for (int n = 0; n < 2; ++n) acc[a][b][m][n] = (f32x4){0.f, 0.f, 0.f, 0.f};
        cur = nxt; cA = nA; cB = nB; ++ui;
        if constexpr (GATHER) { vA[0][0] = vN[0][0]; vA[0][1] = vN[0][1]; vA[1][0] = vN[1][0]; vA[1][1] = vN[1][1]; }
        if constexpr (ALIGN_EPI) { if (wr == 1) PG8_BAR; }
    }
    PG8_WAIT_V(0);
    if constexpr (!ALIGN_EPI) { if (wr == 0) PG8_BAR; }
    PG8_BAR;
    if constexpr (Epi::AFTER_DRAIN) { E.fused(acc, cur, wr, wc, fr, fq, lds, wid, lane); S.done(cur); }
#undef PG8_SA
#undef PG8_STAGE_A
#undef PG8_GOFF
#undef PG8_SB
#undef PG8_STAGE
#undef PG8_LDA
#undef PG8_LDB
#undef PG8_MMA
#undef PG8_WAIT_V
#undef PG8_WAIT_L
#undef PG8_BAR
#undef PG8_SCHED
}
}

#include <hip/hip_bf16.h>
#include <cmath>

namespace attn_body {
using bf16=__hip_bfloat16;
using bf16x8=__attribute__((ext_vector_type(8)))short;
using s16x4=__attribute__((ext_vector_type(4)))short;
using f32x16=__attribute__((ext_vector_type(16)))float;
using u32x4=__attribute__((ext_vector_type(4)))unsigned;
constexpr int NHEAD=8,SEQ=16384,D=64,DMQ=NHEAD*D,DMK=2*D;
constexpr int NW=8,QBLK=32,QB=QBLK*NW,KVBLK=64,NQB=SEQ/QB;
constexpr int ATTN_UNIT_ROWS=QB;
__device__ __forceinline__ int crow(int r,int hi){return (r&3)+8*(r>>2)+4*hi;}
#define SBAR() __builtin_amdgcn_sched_barrier(0)
__device__ __forceinline__ void cmask(f32x16&p0,f32x16&p1,int jb,int qrel,int hi){
  const float NEG=-INFINITY; int kb=64*jb+4*hi;
  #pragma unroll
  for(int r=0;r<16;++r){int kv=kb+(r&3)+8*(r>>2); if(kv>qrel)p0[r]=NEG; if(kv+32>qrel)p1[r]=NEG;}
}

constexpr int NSLOT=3, SLOTB=8192;
constexpr int LDS_K=0, LDS_V=NSLOT*SLOTB, LDS_WS=2*NSLOT*SLOTB, LDS_OST=LDS_WS+NW*64*4, LDS_BYTES=LDS_OST+NW*4096;
constexpr float C2=0.125f*1.4426950408889634f;
__device__ __forceinline__ void glds16(const void*gsrc,unsigned lds_dst){unsigned keep;
  asm volatile("s_mov_b32 %0, m0\n\ts_mov_b32 m0, %2\n\ts_nop 0\n\tglobal_load_lds_dwordx4 %1, off\n\ts_mov_b32 m0, %0":"=&s"(keep):"v"(gsrc),"s"(lds_dst):"memory");}
__device__ __forceinline__ float max3f(float a,float b,float c){float r;asm("v_max3_f32 %0, %1, %2, %3":"=v"(r):"v"(a),"v"(b),"v"(c));return r;}
__device__ __forceinline__ float max2f(float a,float b){float r;asm("v_max_f32_e32 %0, %1, %2":"=v"(r):"v"(a),"v"(b));return r;}
__device__ __forceinline__ float fadd_s(float a,float b){float r;asm("v_add_f32_e32 %0, %1, %2":"=v"(r):"v"(a),"v"(b));return r;}
__device__ __forceinline__ float fsub_s(float a,float b){float r;asm("v_sub_f32_e32 %0, %1, %2":"=v"(r):"v"(a),"v"(b));return r;}
typedef float f32x2_t __attribute__((ext_vector_type(2))); typedef __bf16 bf16x2_t __attribute__((ext_vector_type(2)));
__device__ __forceinline__ unsigned cvtpk_s(float lo,float hi){f32x2_t v={lo,hi};bf16x2_t b=__builtin_convertvector(v,bf16x2_t);return __builtin_bit_cast(unsigned,b);}
#define WAIT_BAR(N) asm volatile("s_waitcnt vmcnt(" #N ") lgkmcnt(0)\n\ts_barrier":::"memory")

__device__ __forceinline__ void qkt(f32x16&p0,f32x16&p1,const char*Kslot,const bf16x8*qr,const f32x16&negm,int r32,int hi){
  const char*kb=Kslot+hi*1024+r32*16;
  #pragma unroll
  for(int d0=0;d0<4;++d0){
    const bf16x8 b0=*reinterpret_cast<const bf16x8*>(kb+d0*2048);
    const bf16x8 b1=*reinterpret_cast<const bf16x8*>(kb+d0*2048+512);
    if(d0==0){p0=__builtin_amdgcn_mfma_f32_32x32x16_bf16(b0,qr[0],negm,0,0,0);p1=__builtin_amdgcn_mfma_f32_32x32x16_bf16(b1,qr[0],negm,0,0,0);}
    else{p0=__builtin_amdgcn_mfma_f32_32x32x16_bf16(b0,qr[d0],p0,0,0,0);p1=__builtin_amdgcn_mfma_f32_32x32x16_bf16(b1,qr[d0],p1,0,0,0);}}
}
typedef __attribute__((address_space(3))) const char* lds_cptr;
typedef short v4i16_t __attribute__((ext_vector_type(4)));
__device__ __forceinline__ void kload8(bf16x8*kf,lds_cptr kp){
  kf[0]=*(const __attribute__((address_space(3))) bf16x8*)(kp);      kf[1]=*(const __attribute__((address_space(3))) bf16x8*)(kp+512);
  kf[2]=*(const __attribute__((address_space(3))) bf16x8*)(kp+2048); kf[3]=*(const __attribute__((address_space(3))) bf16x8*)(kp+2560);
  kf[4]=*(const __attribute__((address_space(3))) bf16x8*)(kp+4096); kf[5]=*(const __attribute__((address_space(3))) bf16x8*)(kp+4608);
  kf[6]=*(const __attribute__((address_space(3))) bf16x8*)(kp+6144); kf[7]=*(const __attribute__((address_space(3))) bf16x8*)(kp+6656);
}
__device__ __forceinline__ void kload2(bf16x8*kf,lds_cptr kp,int j){ kf[2*j]=*(const __attribute__((address_space(3))) bf16x8*)(kp+j*2048); kf[2*j+1]=*(const __attribute__((address_space(3))) bf16x8*)(kp+j*2048+512); }
__device__ __forceinline__ s16x4 vtr(lds_cptr p){ return __builtin_bit_cast(s16x4,__builtin_amdgcn_ds_read_tr16_b64_v4i16((__attribute__((address_space(3))) v4i16_t*)p)); }
__device__ __forceinline__ float rowmax(const f32x16&p0,const f32x16&p1){
  float a=max3f(p0[0],p0[1],p1[0]),b=max3f(p0[2],p0[3],p1[1]);a=max3f(a,p1[2],p1[3]);
  #pragma unroll
  for(int r=4;r<16;r+=4){a=max3f(a,p0[r],p0[r+1]);b=max3f(b,p0[r+2],p0[r+3]);a=max3f(a,p1[r],p1[r+1]);b=max3f(b,p1[r+2],p1[r+3]);}
  const float m=max2f(a,b);
  auto rr=__builtin_amdgcn_permlane32_swap(__float_as_uint(m),__float_as_uint(m),false,false);
  return max2f(__uint_as_float(rr[0]),__uint_as_float(rr[1]));
}
__device__ __forceinline__ void pv(f32x16*o,int vb,bf16x8 pa0,bf16x8 pa1,bf16x8 pa2,bf16x8 pa3){
  #pragma unroll
  for(int d0=0;d0<2;++d0){s16x4 lo[4],hi[4];
    #pragma unroll
    for(int ks=0;ks<4;++ks){
      asm volatile("ds_read_b64_tr_b16 %0,%1 offset:%c2":"=&v"(lo[ks]):"v"(vb),"i"(d0*4096+ks*1024):"memory");
      asm volatile("ds_read_b64_tr_b16 %0,%1 offset:%c2":"=&v"(hi[ks]):"v"(vb),"i"(d0*4096+ks*1024+512):"memory");}
    asm volatile("s_waitcnt lgkmcnt(0)":::"memory");SBAR();
    #define PK(k) (bf16x8){lo[k][0],lo[k][1],lo[k][2],lo[k][3],hi[k][0],hi[k][1],hi[k][2],hi[k][3]}
    o[d0]=__builtin_amdgcn_mfma_f32_32x32x16_bf16(pa0,PK(0),o[d0],0,0,0);
    o[d0]=__builtin_amdgcn_mfma_f32_32x32x16_bf16(pa1,PK(1),o[d0],0,0,0);
    o[d0]=__builtin_amdgcn_mfma_f32_32x32x16_bf16(pa2,PK(2),o[d0],0,0,0);
    o[d0]=__builtin_amdgcn_mfma_f32_32x32x16_bf16(pa3,PK(3),o[d0],0,0,0);
    #undef PK
  }
}

#ifndef ATTN_STORE16
#define ATTN_STORE16(p,v) (*(u32x4*)(p)=(v))
#endif
template<int THRL> __device__ __forceinline__ void attn_unit(int b,int h,int qb,const bf16*Q,const bf16*__restrict__ K,const bf16*__restrict__ V,bf16*O,char*shm,int wave_,float negM){
  const int tid_=wave_*64+lane_id_opaque();
  const int tid=tid_,lane=tid&63,r32=lane&31,hi=lane>>5; const int wid=__builtin_amdgcn_readfirstlane(tid>>6);
  const long rowbase=0; const int q0=qb*QB; (void)b;
  const bf16*Qw=Q+(rowbase+q0+wid*QBLK)*DMQ+h*D;
  const bf16*Kh=K+(h>>2)*D,*Vh=V+(h>>2)*D;
  const unsigned lds0=(unsigned)(uintptr_t)shm;
  float*wsf=(float*)(shm+LDS_WS)+wid*64;
  const bf16*ksrc=Kh+(long)lane*DMK+wid*8;
  const bf16*vsrc=Vh+(long)(16*(wid&3)+(lane>>2))*DMK+(wid>>2)*32+(lane&3)*8;
  const unsigned kdst=lds0+LDS_K+wid*1024, vdst=lds0+LDS_V+wid*1024;
  #define DMA_K(t,slot) glds16(ksrc+(long)(t)*KVBLK*DMK,(unsigned)__builtin_amdgcn_readfirstlane(kdst+(slot)))
  #define DMA_V(t,slot) glds16(vsrc+(long)(t)*KVBLK*DMK,(unsigned)__builtin_amdgcn_readfirstlane(vdst+(slot)))
  const int vb0=(int)(lds0+LDS_V)+((lane>>4)&1)*32+(lane&3)*8+(4*hi+((lane&15)>>2))*64;
  const char*Kbase=shm+LDS_K; bf16x8 kf[8];
  const lds_cptr shm3=(lds_cptr)shm; const lds_cptr kp0=shm3+LDS_K+hi*1024+r32*16; const lds_cptr vp0=shm3+LDS_V+((lane>>4)&1)*32+(lane&3)*8+(4*hi+((lane&15)>>2))*64;
  const int NT=SEQ/KVBLK;
  DMA_K(0,0);DMA_V(0,0);DMA_K(1,SLOTB);
  bf16x8 qr[4];
  #pragma unroll
  for(int d0=0;d0<4;++d0)qr[d0]=*reinterpret_cast<const bf16x8*>(&Qw[(long)r32*DMQ+d0*16+hi*8]);
  float l_reg=0.f;f32x16 o[2];o[0]=f32x16{};o[1]=f32x16{};f32x16 negm;
  #pragma unroll
  for(int r=0;r<16;++r)negm[r]=negM;
  asm volatile("":"+v"(negm));
  const int qrel=wid*QBLK+r32; (void)qrel;
  #define CMASK(P0,P1,t) do{}while(0)
  #define START(P0,P1) do{ _Pragma("unroll") for(int r=0;r<16;++r)P0[r]=__builtin_amdgcn_exp2f(P0[r]); }while(0)
  #define RESC() do{}while(0)
  f32x16 pA0,pA1,pB0,pB1;
  int sl_prev=0,sl_cur=0,sl_next=SLOTB;
  #define ROT() do{sl_prev=sl_cur;sl_cur=sl_next;sl_next=(sl_next==(NSLOT-1)*SLOTB)?0:sl_next+SLOTB;}while(0)
  DMA_K(2,2*SLOTB);
  WAIT_BAR(3);
  qkt(pA0,pA1,Kbase,qr,negm,r32,hi);asm volatile("s_nop 15\n\ts_nop 7":"+v"(pA0),"+v"(pA1));CMASK(pA0,pA1,0);
  START(pA0,pA1);
  _Pragma("unroll") for(int r=0;r<16;++r)pA1[r]=__builtin_amdgcn_exp2f(pA1[r]);
  WAIT_BAR(0);
  DMA_K(3,0);DMA_V(1,SLOTB);
  ROT();
  kload8(kf,kp0+sl_cur);
  WAIT_BAR(2);
  s16x4 vlo[8],vhi[8]; u32x4 pw0,pw1,pw2,pw3;
  #define PKW(P,B) cvtpk_s(P[B],P[B+1])
  #define PAF(k) __builtin_bit_cast(bf16x8,pw##k)
  #define VFR(i) (bf16x8){vlo[i][0],vlo[i][1],vlo[i][2],vlo[i][3],vhi[i][0],vhi[i][1],vhi[i][2],vhi[i][3]}
  #define PIN(x) asm volatile("":"+v"(x))
  #define MX3(a,b,c) __builtin_fmaxf(__builtin_fmaxf((a),(b)),(c))
  #define GAPA(MF,A0,A1,A2,A3,W0,W1,PW) do{ MF; sacc+=A0; sacc+=A1; sacc+=A2; sacc+=A3; PIN(sacc); W0; W1; PIN(PW); SBAR(); }while(0)
  #define EX(v) __builtin_amdgcn_exp2f(v)
  #define GAPB(MF,X,B) do{ MF; X[B]=EX(X[B]); X[B+1]=EX(X[B+1]); X[B+2]=EX(X[B+2]); X[B+3]=EX(X[B+3]); PIN(X); SBAR(); }while(0)
  #define VRD(i) do{ vlo[i]=vtr(vp_+(((i)>>2)*4096+((i)&3)*1024)); vhi[i]=vtr(vp_+(((i)>>2)*4096+((i)&3)*1024+512)); }while(0)
  #define KRD(G,j) do{ if(G){ kload2(kf,kp0+sl_next,j); SBAR(); } }while(0)
  #define STEP(C0,C1,P0,P1,t,GK,GV,GL) do{ SBAR(); \
    const lds_cptr vp_=vp0+sl_prev; \
    VRD(0); SBAR(); float sacc=(P0[0]+P0[1]); \
    GAPA(C0=__builtin_amdgcn_mfma_f32_32x32x16_bf16(kf[0],qr[0],negm,0,0,0), P0[2],P0[3],P0[4],P0[5],     pw0[0]=PKW(P0,0), pw0[1]=PKW(P0,2), pw0); \
    VRD(4); SBAR(); GAPA(C1=__builtin_amdgcn_mfma_f32_32x32x16_bf16(kf[1],qr[0],negm,0,0,0), P0[6],P0[7],P0[8],P0[9],     pw0[2]=PKW(P0,4), pw0[3]=PKW(P0,6), pw0); \
    VRD(1); SBAR(); GAPA(C0=__builtin_amdgcn_mfma_f32_32x32x16_bf16(kf[2],qr[1],C0,0,0,0),   P0[10],P0[11],P0[12],P0[13], pw1[0]=PKW(P0,8), pw1[1]=PKW(P0,10), pw1); \
    VRD(5); SBAR(); GAPA(C1=__builtin_amdgcn_mfma_f32_32x32x16_bf16(kf[3],qr[1],C1,0,0,0),   P0[14],P0[15],P1[0],P1[1],   pw1[2]=PKW(P0,12),pw1[3]=PKW(P0,14), pw1); \
    VRD(2); SBAR(); GAPA(C0=__builtin_amdgcn_mfma_f32_32x32x16_bf16(kf[4],qr[2],C0,0,0,0),   P1[2],P1[3],P1[4],P1[5],     pw2[0]=PKW(P1,0), pw2[1]=PKW(P1,2), pw2); \
    VRD(6); SBAR(); GAPA(C1=__builtin_amdgcn_mfma_f32_32x32x16_bf16(kf[5],qr[2],C1,0,0,0),   P1[6],P1[7],P1[8],P1[9],     pw2[2]=PKW(P1,4), pw2[3]=PKW(P1,6), pw2); \
    VRD(3); SBAR(); GAPA(C0=__builtin_amdgcn_mfma_f32_32x32x16_bf16(kf[6],qr[3],C0,0,0,0),   P1[10],P1[11],P1[12],P1[13], pw3[0]=PKW(P1,8), pw3[1]=PKW(P1,10), pw3); \
    VRD(7); SBAR(); GAPA(C1=__builtin_amdgcn_mfma_f32_32x32x16_bf16(kf[7],qr[3],C1,0,0,0),   P1[14],P1[15],0.f,0.f,       pw3[2]=PKW(P1,12),pw3[3]=PKW(P1,14), pw3); \
    l_reg+=sacc; \
    if(GK){DMA_K((t)+3,sl_cur);} if(GV){DMA_V((t)+1,sl_next);} \
    CMASK(C0,C1,t); \
    SBAR(); \
    GAPB(o[0]=__builtin_amdgcn_mfma_f32_32x32x16_bf16(PAF(0),VFR(0),o[0],0,0,0), C0,0); \
    GAPB(o[1]=__builtin_amdgcn_mfma_f32_32x32x16_bf16(PAF(0),VFR(4),o[1],0,0,0), C0,4); \
    KRD(GL,0); GAPB(o[0]=__builtin_amdgcn_mfma_f32_32x32x16_bf16(PAF(1),VFR(1),o[0],0,0,0), C0,8); \
    KRD(GL,1); GAPB(o[1]=__builtin_amdgcn_mfma_f32_32x32x16_bf16(PAF(1),VFR(5),o[1],0,0,0), C0,12); \
    KRD(GL,2); GAPB(o[0]=__builtin_amdgcn_mfma_f32_32x32x16_bf16(PAF(2),VFR(2),o[0],0,0,0), C1,0); \
    KRD(GL,3); GAPB(o[1]=__builtin_amdgcn_mfma_f32_32x32x16_bf16(PAF(2),VFR(6),o[1],0,0,0), C1,4); \
    GAPB(o[0]=__builtin_amdgcn_mfma_f32_32x32x16_bf16(PAF(3),VFR(3),o[0],0,0,0), C1,8); \
    GAPB(o[1]=__builtin_amdgcn_mfma_f32_32x32x16_bf16(PAF(3),VFR(7),o[1],0,0,0), C1,12); \
    }while(0)
  int t=1;
  #undef CMASK
  #define CMASK(P0,P1,t) do{}while(0)
  for(;t+5<NT;t+=2){
    STEP(pB0,pB1,pA0,pA1,t,true,true,true);     WAIT_BAR(2); RESC(); ROT();
    STEP(pA0,pA1,pB0,pB1,t+1,true,true,true);   WAIT_BAR(2); RESC(); ROT();
  }
  #undef CMASK
  #define CMASK(P0,P1,t) do{}while(0)
  #define ENDW(tt) do{ if((tt)+3<NT){WAIT_BAR(2);} else if((tt)+2<NT){WAIT_BAR(1);} else {WAIT_BAR(0);} }while(0)
  for(;t+1<NT;t+=2){
    STEP(pB0,pB1,pA0,pA1,t,(t+3<NT),(t+1<NT),(t+1<NT));       ENDW(t);   RESC(); ROT();
    STEP(pA0,pA1,pB0,pB1,t+1,(t+4<NT),(t+2<NT),(t+2<NT));     ENDW(t+1); RESC(); ROT();
  }
  STEP(pB0,pB1,pA0,pA1,NT-1,false,false,false); RESC();
  { float sacc=pB0[0]+pB0[1]; _Pragma("unroll") for(int r=2;r<16;++r)sacc+=pB0[r]; _Pragma("unroll") for(int r=0;r<16;++r)sacc+=pB1[r]; l_reg+=sacc;
    pw0=(u32x4){PKW(pB0,0),PKW(pB0,2),PKW(pB0,4),PKW(pB0,6)};pw1=(u32x4){PKW(pB0,8),PKW(pB0,10),PKW(pB0,12),PKW(pB0,14)};pw2=(u32x4){PKW(pB1,0),PKW(pB1,2),PKW(pB1,4),PKW(pB1,6)};pw3=(u32x4){PKW(pB1,8),PKW(pB1,10),PKW(pB1,12),PKW(pB1,14)};
    SBAR(); pv(o,vb0+sl_cur,PAF(0),PAF(1),PAF(2),PAF(3)); }
  #undef PKW
  #undef PAF
  #undef VFR
  #undef PIN
  #undef MX3
  #undef GAPA
  #undef GAPB
  #undef EX
  #undef VRD
  #undef KRD
  #undef STEP
  #undef ENDW
  {auto rr=__builtin_amdgcn_permlane32_swap(__float_as_uint(l_reg),__float_as_uint(l_reg),false,false);l_reg=__uint_as_float(rr[0])+__uint_as_float(rr[1]);}
  if(hi==0)wsf[32+r32]=l_reg;asm volatile("s_waitcnt lgkmcnt(0)":::"memory");
  float rli[16];
  #pragma unroll
  for(int r=0;r<16;++r)rli[r]=__builtin_amdgcn_rcpf(wsf[32+crow(r,hi)]);
  bf16*Ow=O+(rowbase+q0+wid*QBLK)*DMQ+h*D;
  { bf16*stg=(bf16*)(shm+LDS_OST)+wid*2048;
    #pragma unroll
    for(int r=0;r<16;++r){const int orow=crow(r,hi);
      #pragma unroll
      for(int d0=0;d0<2;++d0)stg[orow*64+d0*32+r32]=__float2bfloat16(o[d0][r]*rli[r]);}
    asm volatile("s_waitcnt lgkmcnt(0)":::"memory");
    #pragma unroll
    for(int i=0;i<4;++i){const int row=i*8+(lane>>3),ch=lane&7; const u32x4 v=*(const u32x4*)(stg+row*64+ch*8); ATTN_STORE16(Ow+(long)row*DMQ+ch*8,v);} }
  asm volatile("s_waitcnt lgkmcnt(0)\n\ts_barrier":::"memory");
  #undef DMA_K
  #undef DMA_V
  #undef CMASK
  #undef START
  #undef RESC
  #undef ROT
}
constexpr int ATTN_LDS_BYTES=LDS_BYTES;
struct AttnTensors { const bf16* Q; const bf16* K; const bf16* V; bf16* O; };
struct AttnUnit { int bh; int qb; };
struct StaticOrder {
  int vcu, G;
  __device__ __forceinline__ explicit StaticOrder(int grid,int block):vcu((grid%8==0)?(block%8)*(grid/8)+block/8:block),G(grid){}
  __device__ __forceinline__ bool next(int i,AttnUnit&u)const{ constexpr int NU=NHEAD*NQB; int uu; if(NU%G==0){ const int per=NU/G; if(i>=per)return false; uu=vcu*per+i; } else { uu=i*G+vcu; if(uu>=NU)return false; } u.bh=uu/NQB; u.qb=uu%NQB; return true; }
  __device__ __forceinline__ void a_ready(const AttnUnit&)const{}
  __device__ __forceinline__ void done(const AttnUnit&)const{}
};
template<class Sched,int THRL=8> __device__ __forceinline__ void attn_phase(char*lds,const AttnTensors&T,const Sched&S,int wave_,float negM){
  AttnUnit u;
  for(int i=0;S.next(i,u);++i){ S.a_ready(u); attn_unit<THRL>(0,u.bh,u.qb,T.Q,T.K,T.V,T.O,lds,wave_,negM); S.done(u); }
}
#undef SBAR
#undef WAIT_BAR
}

namespace attn8 {
using bf16 = __hip_bfloat16;
typedef int i32x8 __attribute__((ext_vector_type(8)));
typedef int i32x4 __attribute__((ext_vector_type(4)));
typedef float f32x16 __attribute__((ext_vector_type(16)));
typedef unsigned u32x4 __attribute__((ext_vector_type(4)));
constexpr int NHEAD = 8, SEQ = 16384, QBLK = 32, NW = 8, QB = 256, KVBLK = 64, NQB = SEQ / QB, NT = SEQ / KVBLK;
constexpr int NS = 8, SLOT = 4096;
constexpr int LDS_K = 0, LDS_V = NS * SLOT, LDS_WS = 2 * NS * SLOT, LDS_OST = LDS_WS + NW * 256, LDS_BYTES = LDS_OST + NW * 4096;
__device__ __forceinline__ int crow(int r, int hi) { return (r & 3) + 8 * (r >> 2) + 4 * hi; }
__device__ __forceinline__ void glds16(const void* gsrc, unsigned lds_dst) { unsigned keep;
    asm volatile("s_mov_b32 %0, m0\n\ts_mov_b32 m0, %2\n\ts_nop 0\n\tglobal_load_lds_dwordx4 %1, off\n\ts_mov_b32 m0, %0" : "=&s"(keep) : "v"(gsrc), "s"(lds_dst) : "memory"); }
typedef __attribute__((address_space(3))) const char* lds_cptr;
__device__ __forceinline__ i32x8 frag(lds_cptr p) {
    const i32x4 lo = *(const __attribute__((address_space(3))) i32x4*)(p), hi = *(const __attribute__((address_space(3))) i32x4*)(p + 1024);
    return __builtin_shufflevector(lo, hi, 0, 1, 2, 3, 4, 5, 6, 7); }
#define A8_MFMA(a, b, c) __builtin_amdgcn_mfma_scale_f32_32x32x64_f8f6f4((a), (b), (c), 0, 0, 0, 0, 0, 0)
struct Tensors { const unsigned char* Q8; const unsigned char* K8; const unsigned char* V8T; bf16* O; };

__device__ __forceinline__ void unit(int h, int qb, const Tensors& T, char* shm, int wave_, float negM8) {
    const int tid = wave_ * 64 + lane_id_opaque(), lane = tid & 63, r32 = lane & 31, hi = lane >> 5; const int wid = __builtin_amdgcn_readfirstlane(tid >> 6);
    const int kvh = h >> 2, q0 = qb * QB;
    const unsigned lds0 = (unsigned)(uintptr_t)shm;
    float* wsf = (float*)(shm + LDS_WS) + wid * 64;
    const bool isk = wid < 4; const int c = wid & 3;
    const unsigned char* src0 = isk ? T.K8 + (size_t)lane * 128 + kvh * 64 + c * 16 : T.V8T + (size_t)kvh * NT * 4096 + (size_t)lane * 64 + c * 16;
    const size_t tstep = isk ? (size_t)KVBLK * 128 : (size_t)4096;
    const unsigned dst0 = lds0 + (isk ? LDS_K : LDS_V) + c * 1024;
#define A8_DMA(t) glds16(src0 + (size_t)(t) * tstep, (unsigned)__builtin_amdgcn_readfirstlane(dst0 + ((t) & (NS - 1)) * SLOT))
#pragma unroll
    for (int t = 0; t < 4; ++t) A8_DMA(t);
    if (isk) A8_DMA(4);
    const unsigned char* qp = T.Q8 + (size_t)(q0 + wid * QBLK + r32) * 512 + h * 64 + 32 * hi;
    const i32x4 qlo = *(const i32x4*)qp, qhi = *(const i32x4*)(qp + 16);
    const i32x8 qf = __builtin_shufflevector(qlo, qhi, 0, 1, 2, 3, 4, 5, 6, 7);
    f32x16 negm;
#pragma unroll
    for (int r = 0; r < 16; ++r) negm[r] = negM8;
    f32x16 o0 = f32x16{}, o1 = f32x16{}, lacc = f32x16{};
    i32x8 ones8;
#pragma unroll
    for (int k = 0; k < 8; ++k) ones8[k] = 0x38383838;
    const lds_cptr kbase = (lds_cptr)shm + LDS_K + (2 * hi) * 1024 + r32 * 16, vbase = (lds_cptr)shm + LDS_V + (2 * hi) * 1024 + r32 * 16;
    if (isk) asm volatile("s_waitcnt vmcnt(4)" ::: "memory"); else asm volatile("s_waitcnt vmcnt(3)" ::: "memory");
    asm volatile("s_waitcnt lgkmcnt(0)\n\ts_barrier" ::: "memory");
    asm volatile("" : "+v"(ones8));
    f32x16 sA0 = A8_MFMA(frag(kbase), qf, negm), sA1 = A8_MFMA(frag(kbase + 512), qf, negm), sB0, sB1;
#define A8_SB() __builtin_amdgcn_sched_barrier(0)
#define A8_EX8(X, b) do { _Pragma("unroll") for (int r = 0; r < 8; ++r) X[(b) + r] = __builtin_amdgcn_exp2f(X[(b) + r]); } while (0)
#define A8_TILE(C0, C1, N0, N1, PP, PC, kt, vt) do { \
        const lds_cptr kp_ = kbase + ((kt) & (NS - 1)) * SLOT, vp_ = vbase + ((vt) & (NS - 1)) * SLOT; \
        const i32x8 kf0_ = frag(kp_), kf1_ = frag(kp_ + 512), vf0_ = frag(vp_), vf1_ = frag(vp_ + 512); A8_SB(); \
        N0 = A8_MFMA(kf0_, qf, negm); A8_SB(); A8_EX8(C0, 0); A8_SB(); \
        N1 = A8_MFMA(kf1_, qf, negm); A8_SB(); A8_EX8(C0, 8); A8_SB(); \
        o0 = A8_MFMA(PP, vf0_, o0); A8_SB(); A8_EX8(C1, 0); A8_SB(); \
        o1 = A8_MFMA(PP, vf1_, o1); A8_SB(); A8_EX8(C1, 8); A8_SB(); \
        lacc = A8_MFMA(PP, ones8, lacc); A8_SB(); \
        _Pragma("unroll") for (int k = 0; k < 4; ++k) { int w_; asm volatile("" : "=v"(w_)); w_ = __builtin_amdgcn_cvt_pk_fp8_f32(C0[4 * k], C0[4 * k + 1], w_, false); w_ = __builtin_amdgcn_cvt_pk_fp8_f32(C0[4 * k + 2], C0[4 * k + 3], w_, true); PC[k] = w_; \
            int v_; asm volatile("" : "=v"(v_)); v_ = __builtin_amdgcn_cvt_pk_fp8_f32(C1[4 * k], C1[4 * k + 1], v_, false); v_ = __builtin_amdgcn_cvt_pk_fp8_f32(C1[4 * k + 2], C1[4 * k + 3], v_, true); PC[4 + k] = v_; } \
        A8_SB(); } while (0)
    i32x8 pA, pB;
#pragma unroll
    for (int k = 0; k < 8; ++k) { pA[k] = 0; pB[k] = 0; }
    for (int t = 0; t < NT; t += 2) {
        if (t + 6 < NT) asm volatile("s_waitcnt vmcnt(2)" ::: "memory"); else asm volatile("s_waitcnt vmcnt(0)" ::: "memory");
        asm volatile("s_waitcnt lgkmcnt(0)\n\ts_barrier" ::: "memory");
        if (isk) { if (t + 5 < NT) A8_DMA(t + 5); if (t + 6 < NT) A8_DMA(t + 6); } else { if (t + 4 < NT) A8_DMA(t + 4); if (t + 5 < NT) A8_DMA(t + 5); }
        A8_TILE(sA0, sA1, sB0, sB1, pB, pA, t + 1, (t > 0 ? t - 1 : 0));
        A8_TILE(sB0, sB1, sA0, sA1, pA, pB, t + 2, t);
    }
    {
        const lds_cptr vp_ = vbase + ((NT - 1) & (NS - 1)) * SLOT; const i32x8 vf0_ = frag(vp_), vf1_ = frag(vp_ + 512);
        o0 = A8_MFMA(pB, vf0_, o0); o1 = A8_MFMA(pB, vf1_, o1); lacc = A8_MFMA(pB, ones8, lacc); }
#undef A8_EX8
#undef A8_TILE
#undef A8_SB
    (void)wsf;
    float rli[16];
#pragma unroll
    for (int r = 0; r < 16; ++r) rli[r] = __builtin_amdgcn_rcpf(lacc[r]);
    bf16* Ow = T.O + (size_t)(q0 + wid * QBLK) * 512 + h * 64;
    { bf16* stg = (bf16*)(shm + LDS_OST) + wid * 2048;
#pragma unroll
      for (int r = 0; r < 16; ++r) { const int orow = crow(r, hi); stg[orow * 64 + r32] = __float2bfloat16(o0[r] * rli[r]); stg[orow * 64 + 32 + r32] = __float2bfloat16(o1[r] * rli[r]); }
      asm volatile("s_waitcnt lgkmcnt(0)" ::: "memory");
#pragma unroll
      for (int i = 0; i < 4; ++i) { const int row = i * 8 + (lane >> 3), ch = lane & 7; const u32x4 v = *(const u32x4*)(stg + row * 64 + ch * 8); *(u32x4*)(Ow + (size_t)row * 512 + ch * 8) = v; } }
    asm volatile("s_waitcnt vmcnt(0) lgkmcnt(0)\n\ts_barrier" ::: "memory");
#undef A8_DMA
}
__device__ __forceinline__ void phase(char* lds, const Tensors& T, int grid, int block, int wave_, float negM8) {
    const int vcu = (grid % 8 == 0) ? (block % 8) * (grid / 8) + block / 8 : block;
    constexpr int NU = NHEAD * NQB;
    if (NU % grid == 0) { const int per = NU / grid; for (int i = 0; i < per; ++i) { const int uu = vcu * per + i; unit(uu / NQB, uu % NQB, T, lds, wave_, negM8); } }
    else for (int uu = vcu; uu < NU; uu += grid) unit(uu / NQB, uu % NQB, T, lds, wave_, negM8);
}
#undef A8_MFMA
}

namespace hg {
typedef short bf16x8 __attribute__((ext_vector_type(8)));
typedef short s16x4 __attribute__((ext_vector_type(4)));
constexpr int CH = 32, SEGT = 512, NSEG = S / SEGT, NCH = SEGT / CH;
constexpr int RS = 272, TS = 80;
constexpr int QOFF = 0, KOFF = 32 * RS, KTOFF = 2 * 32 * RS, VTOFF = KTOFF + 128 * TS, DOFF = VTOFF + 128 * TS, GOFF = DOFF + 512, BUFB = GOFF + 4096;
static_assert(2 * BUFB <= 131072, "hgrn LDS");
#define HG_MFMA(a, b, c) __builtin_amdgcn_mfma_f32_16x16x32_bf16((a), (b), (c), 0, 0, 0)
__device__ __forceinline__ unsigned pkbf(float lo, float hi) { typedef float f2 __attribute__((ext_vector_type(2))); typedef __bf16 b2 __attribute__((ext_vector_type(2))); f2 v = {lo, hi}; b2 b = __builtin_convertvector(v, b2); return __builtin_bit_cast(unsigned, b); }

typedef float f32x2h __attribute__((ext_vector_type(2)));
template <bool OUT>
__device__ __forceinline__ void chunk_matrix(LAS unsigned char* B, f32x4 (&Sacc)[8], int c16, int g, int e0, int dir, int h, int p0c, float* __restrict__ OF) {
    if (OUT) {
        f32x4 X00 = {0.f, 0.f, 0.f, 0.f}, X01 = X00, X11 = X00;
#pragma unroll
        for (int s = 0; s < 4; ++s) {
            const bf16x8 aK0 = *(const LAS bf16x8*)(B + KOFF + c16 * RS + (32 * s + 8 * g) * 2), aK1 = *(const LAS bf16x8*)(B + KOFF + (16 + c16) * RS + (32 * s + 8 * g) * 2);
            const bf16x8 bQ0 = *(const LAS bf16x8*)(B + QOFF + c16 * RS + (32 * s + 8 * g) * 2), bQ1 = *(const LAS bf16x8*)(B + QOFF + (16 + c16) * RS + (32 * s + 8 * g) * 2);
            X00 = HG_MFMA(aK0, bQ0, X00); X01 = HG_MFMA(aK0, bQ1, X01); X11 = HG_MFMA(aK1, bQ1, X11);
        }
#pragma unroll
        for (int r = 0; r < 4; ++r) { const bool keep = (4 * g + r) <= c16; X00[r] = keep ? X00[r] : 0.f; X11[r] = keep ? X11[r] : 0.f; }
        u32x4 a0w, a1w; a0w.x = pkbf(X00[0], X00[1]); a0w.y = pkbf(X00[2], X00[3]); a0w.z = 0u; a0w.w = 0u;
        a1w.x = pkbf(X01[0], X01[1]); a1w.y = pkbf(X01[2], X01[3]); a1w.z = pkbf(X11[0], X11[1]); a1w.w = pkbf(X11[2], X11[3]);
        const u32x2 vlo = *(const LAS u32x2*)(B + VTOFF + (e0 + c16) * TS + (4 * g) * 2), vhi = *(const LAS u32x2*)(B + VTOFF + (e0 + c16) * TS + (16 + 4 * g) * 2);
        u32x4 vbw; vbw.x = vlo.x; vbw.y = vlo.y; vbw.z = vhi.x; vbw.w = vhi.y;
        const bf16x8 vb = __builtin_bit_cast(bf16x8, vbw);
        f32x4 O0 = {0.f, 0.f, 0.f, 0.f}, O1 = O0;
        O0 = HG_MFMA(__builtin_bit_cast(bf16x8, a0w), vb, O0); O1 = HG_MFMA(__builtin_bit_cast(bf16x8, a1w), vb, O1);
#pragma unroll
        for (int s = 0; s < 4; ++s) {
            u32x4 sw; sw.x = pkbf(Sacc[2 * s][0], Sacc[2 * s][1]); sw.y = pkbf(Sacc[2 * s][2], Sacc[2 * s][3]); sw.z = pkbf(Sacc[2 * s + 1][0], Sacc[2 * s + 1][1]); sw.w = pkbf(Sacc[2 * s + 1][2], Sacc[2 * s + 1][3]);
            const bf16x8 sb = __builtin_bit_cast(bf16x8, sw);
            const u32x2 q0l = *(const LAS u32x2*)(B + QOFF + c16 * RS + (32 * s + 4 * g) * 2), q0h = *(const LAS u32x2*)(B + QOFF + c16 * RS + (32 * s + 16 + 4 * g) * 2);
            const u32x2 q1l = *(const LAS u32x2*)(B + QOFF + (16 + c16) * RS + (32 * s + 4 * g) * 2), q1h = *(const LAS u32x2*)(B + QOFF + (16 + c16) * RS + (32 * s + 16 + 4 * g) * 2);
            u32x4 q0w, q1w; q0w.x = q0l.x; q0w.y = q0l.y; q0w.z = q0h.x; q0w.w = q0h.y; q1w.x = q1l.x; q1w.y = q1l.y; q1w.z = q1h.x; q1w.w = q1h.y;
            O0 = HG_MFMA(__builtin_bit_cast(bf16x8, q0w), sb, O0); O1 = HG_MFMA(__builtin_bit_cast(bf16x8, q1w), sb, O1);
        }
#pragma unroll
        for (int r = 0; r < 4; ++r) {
            const int p0 = p0c + 4 * g + r, p1 = p0 + 16;
            const int t0 = dir ? (S - 1 - p0) : p0, t1 = dir ? (S - 1 - p1) : p1;
            OF[((size_t)dir * S + t0) * 512 + h * 128 + e0 + c16] = O0[r];
            OF[((size_t)dir * S + t1) * 512 + h * 128 + e0 + c16] = O1[r];
        }
    }
    {
        const bf16x8 vB = *(const LAS bf16x8*)(B + VTOFF + (e0 + c16) * TS + (8 * g) * 2);
#pragma unroll
        for (int dt = 0; dt < 8; ++dt) {
            const bf16x8 aT = *(const LAS bf16x8*)(B + KTOFF + (16 * dt + c16) * TS + (8 * g) * 2);
            Sacc[dt] = HG_MFMA(aT, vB, Sacc[dt]);
            const f32x4 dv = *(const LAS f32x4*)(B + DOFF + (16 * dt + 4 * g) * 4);
            Sacc[dt] = Sacc[dt] * dv;
        }
    }
}
template <bool OUT>
__device__ __forceinline__ void segment(LAS unsigned char* lds, int unit, const bf16_t* __restrict__ HQ, const float* __restrict__ LF, const bf16_t* __restrict__ KF,
                                        const bf16_t* __restrict__ HV, float* __restrict__ HST, float* __restrict__ HSD, float* __restrict__ OF, int wave_) {
    const int tid_ = wave_ * 64 + lane_id_opaque();
    const int tid = tid_, lane = tid & 63, w = __builtin_amdgcn_readfirstlane(tid >> 6), c16 = lane & 15, g = lane >> 4;
    const int dir = unit >> 7, h = (unit >> 5) & 3, seg = unit & 31;
    const int d0 = 2 * (tid & 63), tg = tid >> 6;
    const size_t cb = (size_t)h * 128 + d0;
    const float* lf = LF + (size_t)dir * S * 512 + cb;
    const bf16_t* kf = KF + (size_t)dir * S * 512 + cb;
    const bf16_t* hq = HQ + cb; const bf16_t* hv = HV + cb;
    f32x4 Sacc[8];
    float* hst = HST + (size_t)unit * 16384 + (size_t)w * 2048 + lane;
    if (OUT) {
#pragma unroll
        for (int dt = 0; dt < 8; ++dt) { Sacc[dt][0] = hst[(dt * 4 + 0) * 64]; Sacc[dt][1] = hst[(dt * 4 + 1) * 64]; Sacc[dt][2] = hst[(dt * 4 + 2) * 64]; Sacc[dt][3] = hst[(dt * 4 + 3) * 64]; }
    } else {
#pragma unroll
        for (int dt = 0; dt < 8; ++dt) Sacc[dt] = f32x4{0.f, 0.f, 0.f, 0.f};
    }
    f32x2h segsum = {0.f, 0.f};
    const int e0 = 16 * w;
    constexpr int RING = 2;
    f32x2h rl[RING][4]; unsigned rk[RING][4], rq[RING][4], rv[RING][4];
#define HG_LOAD(sl, cc) do { _Pragma("unroll") for (int jj = 0; jj < 4; ++jj) { \
        const int p_ = seg * SEGT + (cc) * CH + 4 * tg + jj, t_ = dir ? (S - 1 - p_) : p_; \
        rl[sl][jj] = *(const f32x2h*)(lf + (size_t)t_ * 512); rk[sl][jj] = *(const unsigned*)(kf + (size_t)t_ * 512); rv[sl][jj] = *(const unsigned*)(hv + (size_t)t_ * 512); \
        rq[sl][jj] = OUT ? *(const unsigned*)(hq + (size_t)t_ * 512) : 0u; } } while (0)
#pragma unroll
    for (int sl = 0; sl < RING; ++sl) HG_LOAD(sl, sl);
    for (int c4 = 0; c4 < NCH; c4 += RING) {
#pragma unroll
        for (int sl = 0; sl < RING; ++sl) {
            const int c = c4 + sl;
            LAS unsigned char* B = lds + (c & 1) * BUFB;
            f32x2h cs[4]; unsigned kk[4], qq[4], vv[4];
#pragma unroll
            for (int jj = 0; jj < 4; ++jj) { cs[jj] = rl[sl][jj]; kk[jj] = rk[sl][jj]; qq[jj] = rq[sl][jj]; vv[jj] = rv[sl][jj]; }
            if (c + RING < NCH) HG_LOAD(sl, c + RING);
#pragma unroll
            for (int jj = 1; jj < 4; ++jj) cs[jj] += cs[jj - 1];
            LAS float* gs = (LAS float*)(B + GOFF);
            *(LAS f32x2h*)(gs + tg * 128 + d0) = cs[3];
            __syncthreads();
            f32x2h off = {0.f, 0.f}, tot = {0.f, 0.f};
#pragma unroll
            for (int q = 0; q < 8; ++q) { const f32x2h gq = *(const LAS f32x2h*)(gs + q * 128 + d0); tot += gq; if (q < tg) off += gq; }
            float kt0[4], kt1[4];
#pragma unroll
            for (int jj = 0; jj < 4; ++jj) {
                const float b0 = fmaxf(off.x + cs[jj].x, -80.f), b1 = fmaxf(off.y + cs[jj].y, -80.f);
                kt0[jj] = bflo(kk[jj]) * __expf(-b0); kt1[jj] = bfhi(kk[jj]) * __expf(-b1);
                if (OUT) {
                    *(LAS unsigned*)(B + QOFF + (4 * tg + jj) * RS + d0 * 2) = pkbf(bflo(qq[jj]) * __expf(b0), bfhi(qq[jj]) * __expf(b1));
                    *(LAS unsigned*)(B + KOFF + (4 * tg + jj) * RS + d0 * 2) = pkbf(kt0[jj], kt1[jj]);
                }
            }
            { u32x2 o0, o1; o0.x = pkbf(kt0[0], kt0[1]); o0.y = pkbf(kt0[2], kt0[3]); o1.x = pkbf(kt1[0], kt1[1]); o1.y = pkbf(kt1[2], kt1[3]);
              *(LAS u32x2*)(B + KTOFF + d0 * TS + 8 * tg) = o0; *(LAS u32x2*)(B + KTOFF + (d0 + 1) * TS + 8 * tg) = o1;
              u32x2 v0, v1; v0.x = (vv[0] & 0xffffu) | (vv[1] << 16); v0.y = (vv[2] & 0xffffu) | (vv[3] << 16); v1.x = (vv[0] >> 16) | (vv[1] & 0xffff0000u); v1.y = (vv[2] >> 16) | (vv[3] & 0xffff0000u);
              *(LAS u32x2*)(B + VTOFF + d0 * TS + 8 * tg) = v0; *(LAS u32x2*)(B + VTOFF + (d0 + 1) * TS + 8 * tg) = v1; }
            if (tg == 0) { f32x2h dv; dv.x = __expf(fmaxf(tot.x, -80.f)); dv.y = __expf(fmaxf(tot.y, -80.f)); *(LAS f32x2h*)(B + DOFF + d0 * 4) = dv; }
            segsum += tot;
            __syncthreads();
            chunk_matrix<OUT>(B, Sacc, c16, g, e0, dir, h, seg * SEGT + c * CH, OF);
        }
    }
    if (!OUT) {
#pragma unroll
        for (int dt = 0; dt < 8; ++dt) { hst[(dt * 4 + 0) * 64] = Sacc[dt][0]; hst[(dt * 4 + 1) * 64] = Sacc[dt][1]; hst[(dt * 4 + 2) * 64] = Sacc[dt][2]; hst[(dt * 4 + 3) * 64] = Sacc[dt][3]; }
        if (tid < 64) { f32x2h dd; dd.x = __expf(fmaxf(segsum.x, -80.f)); dd.y = __expf(fmaxf(segsum.y, -80.f)); *(f32x2h*)(HSD + (size_t)unit * 128 + d0) = dd; }
    }
    __syncthreads();
}
__device__ __forceinline__ void carry(float* __restrict__ HST, const float* __restrict__ HSD, int gid) {
    const int chain = gid >> 14, el = gid & 16383, dt = (el >> 8) & 7, r = (el >> 6) & 3, ln = el & 63, d = 16 * dt + 4 * (ln >> 4) + r;
    float cy = 0.f;
    for (int sg = 0; sg < NSEG; ++sg) {
        const int u = chain * NSEG + sg;
        const float tmp = HST[(size_t)u * 16384 + el];
        HST[(size_t)u * 16384 + el] = cy;
        cy = HSD[(size_t)u * 128 + d] * cy + tmp;
    }
}
#undef HG_MFMA
#undef HG_LOAD
}

#define XB_TMO      128
#define XB_XCNT(j)  (256  + 64 * (j))
#define XB_XSUB(j)  (1280 + 64 * (j))
#define XB_XGEN(j)  (2304 + 64 * (j))
#define XB_TOP      3328
#define XB_TOPGEN   3392
#define XCD_BAR_WORDS 3456
#define XB_SPIN_CAP (1u << 18)

__device__ __forceinline__ unsigned xb_ld(unsigned* p)              { return __hip_atomic_load(p, __ATOMIC_RELAXED, __HIP_MEMORY_SCOPE_AGENT); }
__device__ __forceinline__ unsigned xb_add(unsigned* p, unsigned v) { return __hip_atomic_fetch_add(p, v, __ATOMIC_RELAXED, __HIP_MEMORY_SCOPE_AGENT); }
__device__ __forceinline__ unsigned xb_xcc_id() { return (unsigned)__builtin_amdgcn_s_getreg((3 << 11) | 20) & 0xFu; }
#define XB_SPIN(cond, bar) do { unsigned _sp = 0; while (cond) { __builtin_amdgcn_s_sleep(1); \
    if ((++_sp & 255u) == 0u) { if (xb_ld(&(bar)[XB_TMO])) break; if (_sp > XB_SPIN_CAP) { atomicAdd(&(bar)[XB_TMO], 1u); break; } } } } while (0)

struct XcdBarrier {
    int wv;
    unsigned* bar; unsigned x;
    volatile LAS unsigned* st;
};

__device__ __forceinline__ XcdBarrier xcd_barrier_post(unsigned* bar, volatile LAS unsigned* st) {
    XcdBarrier b; b.bar = bar; b.x = xb_xcc_id(); b.st = st; b.wv = __builtin_amdgcn_readfirstlane((int)threadIdx.x >> 6);
    if (threadIdx.x == 0) (void)xb_add(&bar[XB_XCNT(b.x)], 1u);
    return b;
}
__device__ __forceinline__ void xcd_barrier_complete(unsigned* bar, unsigned x, unsigned& nloc, unsigned& nx) {
    const unsigned G = gridDim.x * gridDim.y * gridDim.z;
    unsigned sum, cnt, mine, sp = 0u;
    for (;;) {
        sum = 0u; cnt = 0u; mine = 0u;
#pragma unroll
        for (unsigned j = 0; j < 16; ++j) { const unsigned c = xb_ld(&bar[XB_XCNT(j)]); sum += c; cnt += (c > 0u) ? 1u : 0u; mine = (j == x) ? c : mine; }
        if (sum == G) break;
        __builtin_amdgcn_s_sleep(1);
        if ((++sp & 255u) == 0u) { if (xb_ld(&bar[XB_TMO])) break; if (sp > XB_SPIN_CAP) { atomicAdd(&bar[XB_TMO], 1u); break; } }
    }
    nloc = mine > 0u ? mine : 1u; nx = cnt > 0u ? cnt : 1u;
}

__device__ __forceinline__ void xcd_barrier(const XcdBarrier& b) {
    asm volatile("s_waitcnt vmcnt(0)" ::: "memory");
    __syncthreads();
    if (b.wv == 0 && lane_id_opaque() == 0) {
        unsigned* bar = b.bar;
        __builtin_amdgcn_s_waitcnt(0);
        unsigned nloc = b.st[0], nx = b.st[1];
        if (nloc == 0u) { xcd_barrier_complete(bar, b.x, nloc, nx); b.st[0] = nloc; b.st[1] = nx; }
        const unsigned old = xb_add(&bar[XB_XSUB(b.x)], 1u);
        const unsigned gen = old / nloc;
        if (old + 1u == (gen + 1u) * nloc) {
            __builtin_amdgcn_fence(__ATOMIC_RELEASE, "agent");
            asm volatile("s_waitcnt vmcnt(0)" ::: "memory");
            const unsigned og = xb_add(&bar[XB_TOP], 1u);
            const unsigned tg = og / nx;
            if (og + 1u == (tg + 1u) * nx) xb_add(&bar[XB_TOPGEN], 1u);
            else XB_SPIN(xb_ld(&bar[XB_TOPGEN]) == tg, bar);
            __builtin_amdgcn_fence(__ATOMIC_ACQUIRE, "agent");
            xb_add(&bar[XB_XGEN(b.x)], 1u);
            asm volatile("s_waitcnt vmcnt(0)" ::: "memory");
        } else {
            XB_SPIN(xb_ld(&bar[XB_XGEN(b.x)]) == gen, bar);
            __builtin_amdgcn_fence(__ATOMIC_ACQUIRE, "agent");
            asm volatile("s_waitcnt vmcnt(0)" ::: "memory");
        }
    }
    __syncthreads();
}

constexpr int NWAVES = 8;
constexpr int RING_OFF = 0, RING_BYTES = 131072;
constexpr int LDSCTL_OFF = RING_BYTES, MISC_OFF = LDSCTL_OFF + 320;
constexpr int LDS_BYTES = 147456;
constexpr int CW_BAR = 4096;
constexpr int NPL = 13;
constexpr int PH_PRO = 0, PH_NORM1 = 1, PH_L0 = 2, PH_END = PH_L0 + NL * NPL;
enum { P_G1 = 0, P_QKP = 1, P_HGB = 2, P_HGC = 3, P_ATT = 4, P_G2 = 5, P_G3 = 6, P_N2R = 7, P_TOPK = 8, P_GATH = 9, P_G4 = 10, P_G5 = 11, P_COMB = 12 };

#ifndef ATTN_FP8
#define ATTN_FP8 1
#endif
#ifndef KEEP_BF16_QK
#define KEEP_BF16_QK (!ATTN_FP8)
#endif
#ifndef REP_HG
#define REP_HG 1
#endif
#ifndef REP_PRO
#define REP_PRO 1
#endif
#ifndef REP_ROW
#define REP_ROW 1
#endif
#ifndef REP_G
#define REP_G 1
#endif
#ifndef REP_TK
#define REP_TK 1
#endif
#ifndef REP_QK
#define REP_QK 1
#endif
#ifndef REP_ATT
#define REP_ATT 1
#endif
struct Params {
    const float *x, *c, *ada_w, *ada_b, *norm_mix_w, *norm_ffn_w, *w_in, *q_norm_w, *k_norm_w, *hlb, *hg_norm_w, *w_ba, *w_bh, *w_out, *w_router, *w_eg, *w_eu, *w_ed;
    float* out; unsigned char* ws;
    int ph_lo, ph_hi, li, pad;
};
struct Frame {
    LAS unsigned char* lds;
    int tid, lane, wave, vcu, G;
};

__device__ __forceinline__ void tr_tile(const float* __restrict__ src, int ldw, bf16_t* __restrict__ dst, int Kd, LAS float* scr, int lane) {
    f32x4 v[8];
#pragma unroll
    for (int i = 0; i < 8; ++i) v[i] = *(const f32x4*)(src + (size_t)(8 * i + (lane >> 3)) * ldw + 4 * (lane & 7));
#pragma unroll
    for (int i = 0; i < 8; ++i) { LAS float* s = scr + (8 * i + (lane >> 3)) * 33 + 4 * (lane & 7); s[0] = v[i].x; s[1] = v[i].y; s[2] = v[i].z; s[3] = v[i].w; }
    asm volatile("s_waitcnt lgkmcnt(0)" ::: "memory");
    const int cch = lane & 7;
#pragma unroll
    for (int j = 0; j < 4; ++j) { const int n = (lane >> 3) + 8 * j; const LAS float* s = scr + (8 * cch) * 33 + n;
        u32x4 o; o.x = pk2(s[0 * 33], s[1 * 33]); o.y = pk2(s[2 * 33], s[3 * 33]); o.z = pk2(s[4 * 33], s[5 * 33]); o.w = pk2(s[6 * 33], s[7 * 33]);
        *(u32x4*)(dst + (size_t)n * Kd + 8 * cch) = o; }
    asm volatile("s_waitcnt lgkmcnt(0)" ::: "memory");
}
struct ConvItem { const float* src; unsigned char* dst; int ldw, Kd; };
__device__ __forceinline__ ConvItem conv_item_f8(const Params& p, int l, int it) {
    ConvItem c;
    const int which = it / (NE * 1024), r0 = it % (NE * 1024), e = r0 >> 10, r = r0 & 1023;
    if (which < 2) {
        const int kb = r >> 6, nb = r & 63, n0 = 32 * nb;
        const float* W = (which == 0 ? p.w_eg : p.w_eu) + (size_t)(l * NE + e) * D * FF;
        const int rho = e * 4096 + (n0 >> 7) * 256 + which * 128 + (n0 & 127);
        c.src = W + (size_t)(64 * kb) * FF + n0; c.ldw = FF; c.dst = p.ws + WS_WGU + (size_t)l * 64 * MiB + (size_t)rho * D + 64 * kb; c.Kd = D;
    } else {
        const int kb = r >> 5, nb = r & 31, n0 = 32 * nb;
        const float* W = p.w_ed + (size_t)(l * NE + e) * FF * D;
        c.src = W + (size_t)(64 * kb) * D + n0; c.ldw = D; c.dst = p.ws + WS_WD + (size_t)l * 32 * MiB + (size_t)(e * 1024 + n0) * FF + 64 * kb; c.Kd = FF;
    }
    return c;
}
__device__ __forceinline__ void conv_load8(const ConvItem& c, int lane, f32x4 (&v)[8]) {
#pragma unroll
    for (int i = 0; i < 8; ++i) v[i] = *(const f32x4*)(c.src + (size_t)(8 * i + (lane >> 3)) * c.ldw + 4 * (lane & 7));
}
__device__ __forceinline__ void conv_store_f8(const ConvItem& c, int lane, const f32x4 (&v)[8], LAS float* scr, float scale) {
#pragma unroll
    for (int i = 0; i < 8; ++i) { LAS float* s = scr + (8 * i + (lane >> 3)) * 33 + 4 * (lane & 7); s[0] = v[i].x; s[1] = v[i].y; s[2] = v[i].z; s[3] = v[i].w; }
    asm volatile("s_waitcnt lgkmcnt(0)" ::: "memory");
    const int cch = lane & 7;
#pragma unroll
    for (int j = 0; j < 4; ++j) { const int n = (lane >> 3) + 8 * j; const LAS float* s = scr + (8 * cch) * 33 + n;
        const f32x4 a = {s[0 * 33] * scale, s[1 * 33] * scale, s[2 * 33] * scale, s[3 * 33] * scale}, b = {s[4 * 33] * scale, s[5 * 33] * scale, s[6 * 33] * scale, s[7 * 33] * scale};
        *(u32x2*)(c.dst + (size_t)n * c.Kd + 8 * cch) = pg8::pack8_fp8(a, b); }
    asm volatile("s_waitcnt lgkmcnt(0)" ::: "memory");
}
__device__ __forceinline__ void conv_experts_f8(Frame& F, const Params& p, int l, LAS float* scr) {
    const int gw = F.vcu * NWAVES + F.wave, NGW = F.G * NWAVES, NIT = 3 * NE * 1024;
    int it = gw; if (it >= NIT) return;
    ConvItem cur = conv_item_f8(p, l, it); f32x4 va[8], vb[8];
    conv_load8(cur, F.lane, va);
    for (;;) {
        const int it1 = it + NGW; const bool h1 = it1 < NIT; ConvItem c1 = conv_item_f8(p, l, h1 ? it1 : it);
        if (h1) conv_load8(c1, F.lane, vb);
        conv_store_f8(cur, F.lane, va, scr, 64.0f);
        if (!h1) break;
        const int it2 = it1 + NGW; const bool h2 = it2 < NIT; ConvItem c2 = conv_item_f8(p, l, h2 ? it2 : it1);
        if (h2) conv_load8(c2, F.lane, va);
        conv_store_f8(c1, F.lane, vb, scr, 64.0f);
        if (!h2) break;
        cur = c2; it = it2;
    }
}
__device__ __forceinline__ void conv_matrix(Frame& F, const float* W, int ldw, int K, int N, bf16_t* WT, LAS float* scr) {
    const int gw = F.vcu * NWAVES + F.wave, NGW = F.G * NWAVES, nblk = N / 32, nitems = (K / 64) * nblk;
    for (int it = gw; it < nitems; it += NGW) { const int kb = it / nblk, nb = it % nblk;
        tr_tile(W + (size_t)(64 * kb) * ldw + 32 * nb, ldw, WT + (size_t)(32 * nb) * K + 64 * kb, K, scr, F.lane); }
}
__device__ __forceinline__ void conv_matrix_f8(Frame& F, const float* W, int ldw, int K, int N, unsigned char* WT, LAS float* scr, float scale) {
    const int gw = F.vcu * NWAVES + F.wave, NGW = F.G * NWAVES, nblk = N / 32, nitems = (K / 64) * nblk;
    for (int it = gw; it < nitems; it += NGW) { const int kb = it / nblk, nb = it % nblk;
        ConvItem c; c.src = W + (size_t)(64 * kb) * ldw + 32 * nb; c.ldw = ldw; c.dst = WT + (size_t)(32 * nb) * K + 64 * kb; c.Kd = K;
        f32x4 v[8]; conv_load8(c, F.lane, v); conv_store_f8(c, F.lane, v, scr, scale); }
}
__device__ __forceinline__ void conv_experts(Frame& F, const Params& p, int l, LAS float* scr) {
    const int gw = F.vcu * NWAVES + F.wave, NGW = F.G * NWAVES;
    bf16_t* WGU = (bf16_t*)(p.ws + WS_WGU); bf16_t* WD = (bf16_t*)(p.ws + WS_WD);
    for (int it = gw; it < 3 * NE * 1024; it += NGW) {
        const int which = it / (NE * 1024), r0 = it % (NE * 1024), e = r0 >> 10, r = r0 & 1023;
        if (which < 2) {
            const int kb = r >> 6, nb = r & 63, n0 = 32 * nb;
            const float* W = (which == 0 ? p.w_eg : p.w_eu) + (size_t)(l * NE + e) * D * FF;
            const int rho = e * 4096 + (n0 >> 7) * 256 + which * 128 + (n0 & 127);
            tr_tile(W + (size_t)(64 * kb) * FF + n0, FF, WGU + (size_t)rho * D + 64 * kb, D, scr, F.lane);
        } else {
            const int kb = r >> 5, nb = r & 31, n0 = 32 * nb;
            const float* W = p.w_ed + (size_t)(l * NE + e) * FF * D;
            tr_tile(W + (size_t)(64 * kb) * D + n0, D, WD + (size_t)(e * 1024 + n0) * FF + 64 * kb, FF, scr, F.lane);
        }
    }
}
__device__ __forceinline__ void mod_units(Frame& F, const Params& p) {
    LAS float* sc = (LAS float*)(F.lds + 96 * 1024);
    LAS float* red = sc + 1024;
    float* MOD = (float*)(p.ws + WS_MOD); float* LBV = (float*)(p.ws + WS_LBV);
    for (int u = blockIdx.x; u < NL * 96; u += F.G) {
        for (int i = F.tid; i < D; i += 512) sc[i] = siluf_(p.c[i]);
        __syncthreads();
        const int l = u / 96, j = (u % 96) * 64 + (F.tid & 63), kp = F.tid >> 6;
        const float* w = p.ada_w + (size_t)l * D * 6 * D + (size_t)(kp * 128) * 6 * D + j;
        float acc = 0.f;
#pragma unroll 8
        for (int k = 0; k < 128; ++k) acc += sc[kp * 128 + k] * w[(size_t)k * 6 * D];
        red[kp * 64 + (F.tid & 63)] = acc;
        __syncthreads();
        if (F.tid < 64) { float s = 0.f;
#pragma unroll
            for (int q = 0; q < 8; ++q) s += red[q * 64 + F.tid];
            MOD[l * 6 * D + j] = s + p.ada_b[l * 6 * D + j]; }
        __syncthreads();
    }
    const int n = blockIdx.x * 512 + F.tid;
    if (n < NL * 1024) { const int l = n / 1024, r = n % 1024; float v = 0.f;
        if (l == 1) { const float b0 = p.hlb[r], b1 = p.hlb[1024 + r]; v = 1.0f / (1.0f + __expf(b0 - b1)); }
        LBV[n] = v; }
}

__device__ __forceinline__ void norm_mod_row(const f32x4 (&v)[4], float ss, const float* __restrict__ w, const float* __restrict__ scale,
                                             const float* __restrict__ shift, bf16_t* __restrict__ orow, int lane, f32x4 (&h)[4], unsigned char* __restrict__ orow8 = nullptr) {
    const float r = rsqrtf(ss * (1.0f / D) + EPS);
#pragma unroll
    for (int j = 0; j < 4; ++j) {
        const int c0 = 4 * lane + 256 * j;
        const f32x4 wv = *(const f32x4*)(w + c0), sv = *(const f32x4*)(scale + c0), bv = *(const f32x4*)(shift + c0);
        h[j] = (v[j] * r) * wv * (sv + 1.0f) + bv;
        u32x2 o; o.x = pk2(h[j].x, h[j].y); o.y = pk2(h[j].z, h[j].w);
        *(u32x2*)(orow + c0) = o;
        if (orow8) { int wd = 0; wd = __builtin_amdgcn_cvt_pk_fp8_f32(h[j].x, h[j].y, wd, false); wd = __builtin_amdgcn_cvt_pk_fp8_f32(h[j].z, h[j].w, wd, true); *(int*)(orow8 + c0) = wd; }
    }
}
__device__ __forceinline__ void norm_mod_row_f8(const f32x4 (&v)[4], float ss, const float* __restrict__ w, const float* __restrict__ scale,
                                                const float* __restrict__ shift, unsigned char* __restrict__ orow, int lane, f32x4 (&h)[4]) {
    const float r = rsqrtf(ss * (1.0f / D) + EPS);
#pragma unroll
    for (int j = 0; j < 4; ++j) {
        const int c0 = 4 * lane + 256 * j;
        const f32x4 wv = *(const f32x4*)(w + c0), sv = *(const f32x4*)(scale + c0), bv = *(const f32x4*)(shift + c0);
        h[j] = (v[j] * r) * wv * (sv + 1.0f) + bv;
        int wd = 0; wd = __builtin_amdgcn_cvt_pk_fp8_f32(h[j].x, h[j].y, wd, false); wd = __builtin_amdgcn_cvt_pk_fp8_f32(h[j].z, h[j].w, wd, true);
        *(int*)(orow + c0) = wd;
    }
}
__device__ __forceinline__ void ph_norm1(Frame& F, const float* x, const float* w, const float* scale, const float* shift, bf16_t* HB, unsigned char* HB8) {
    const int gw = F.vcu * NWAVES + F.wave, NGW = F.G * NWAVES;
    for (int row = gw; row < S; row += NGW) {
        const f32x4* xr = (const f32x4*)(x + (size_t)row * D) + F.lane;
        f32x4 v[4], h[4]; float ss = 0.f;
#pragma unroll
        for (int j = 0; j < 4; ++j) { v[j] = xr[64 * j]; ss += (v[j].x * v[j].x + v[j].y * v[j].y) + (v[j].z * v[j].z + v[j].w * v[j].w); }
        ss = wave_sum(ss);
        norm_mod_row(v, ss, w, scale, shift, HB + (size_t)row * D, F.lane, h);
    }
}
__device__ __forceinline__ void ph_gather(Frame& F, const unsigned char* HB8, const int* IDX, unsigned char* XE8) {
    const int gw = F.vcu * NWAVES + F.wave, NGW = F.G * NWAVES;
    constexpr int PER = NE * CAP / 2048;
    if (NGW * PER == NE * CAP) {
        const int r0 = gw * PER;
        const int mine = IDX[r0 + (F.lane & 15)];
#pragma unroll
        for (int q = 0; q < PER; q += 8) {
            u32x4 a[8];
#pragma unroll
            for (int k = 0; k < 8; ++k) { const int t = __builtin_amdgcn_readlane(mine, q + k); a[k] = ((const u32x4*)(HB8 + (size_t)t * D))[F.lane]; }
#pragma unroll
            for (int k = 0; k < 8; ++k) ((u32x4*)(XE8 + (size_t)(r0 + q + k) * D))[F.lane] = a[k];
        }
    } else {
        for (int r = gw; r < NE * CAP; r += NGW) { const int t = IDX[r]; ((u32x4*)(XE8 + (size_t)r * D))[F.lane] = ((const u32x4*)(HB8 + (size_t)t * D))[F.lane]; }
    }
}

#define OPAQUE_LANE() const int lane = lane_id_opaque(); const int t_ = F.wave * 64 + lane
__device__ __forceinline__ void ph_rope_table(Frame& F, float* ROPE) {
    OPAQUE_LANE();
    const int n = blockIdx.x * 512 + t_;
    if (n < 4096) { const int pos = n >> 4, i = n & 15; const float inv = exp2f(-(float)i * (13.287712379549449f / 16.0f)); float sn, cs; sincosf((float)pos * inv, &sn, &cs); ROPE[2 * n] = cs; ROPE[2 * n + 1] = sn; }
}
__device__ __forceinline__ void ph_qkprep(Frame& F, const bf16_t* __restrict__ QR, const bf16_t* __restrict__ KR, const float* __restrict__ qw, const float* __restrict__ kw,
                                          const float* __restrict__ ROPE, bf16_t* __restrict__ QN, bf16_t* __restrict__ KN, unsigned char* __restrict__ Q8, unsigned char* __restrict__ K8, int rank, int nranks) {
    OPAQUE_LANE(); (void)lane;
    if (rank < 0) return;
    for (int gid = rank * 512 + t_; gid < S * 10; gid += nranks * 512) {
        const int t = gid / 10, hh = gid % 10;
        const bool isq = hh < 8;
        const bf16_t* src = isq ? QR + (size_t)t * 512 + hh * 64 : KR + (size_t)t * 128 + (hh - 8) * 64;
        bf16_t* dst = isq ? QN + (size_t)t * 512 + hh * 64 : KN + (size_t)t * 128 + (hh - 8) * 64;
        const float* w = isq ? qw : kw;
        float f[64]; float ss = 0.f;
#pragma unroll
        for (int i = 0; i < 8; ++i) { const u32x4 q = *(const u32x4*)(src + 8 * i);
#pragma unroll
            for (int j = 0; j < 4; ++j) { f[8 * i + 2 * j] = bflo(q[j]); f[8 * i + 2 * j + 1] = bfhi(q[j]); } }
#pragma unroll
        for (int i = 0; i < 64; ++i) ss += f[i] * f[i];
        const float rn = rsqrtf(ss * (1.0f / 64.0f) + EPS), sc = isq ? C2 : 1.0f;
#pragma unroll
        for (int i = 0; i < 16; ++i) { const f32x4 wv = *(const f32x4*)(w + 4 * i);
            f[4 * i] *= rn * wv.x; f[4 * i + 1] *= rn * wv.y; f[4 * i + 2] *= rn * wv.z; f[4 * i + 3] *= rn * wv.w; }
        float o[64];
#pragma unroll
        for (int ax = 0; ax < 2; ++ax) {
            const float* tb = ROPE + (size_t)(ax == 0 ? (t >> 6) : (t & 63)) * 32;
#pragma unroll
            for (int i2 = 0; i2 < 8; ++i2) { const f32x4 cs = *(const f32x4*)(tb + 4 * i2);
#pragma unroll
                for (int k = 0; k < 2; ++k) { const int i = 2 * i2 + k; const float c_ = k ? cs.z : cs.x, s_ = k ? cs.w : cs.y;
                    const float x1 = f[ax * 32 + i], x2 = f[ax * 32 + 16 + i];
                    o[ax * 32 + i] = (x1 * c_ - x2 * s_) * sc; o[ax * 32 + 16 + i] = (x2 * c_ + x1 * s_) * sc; } }
        }
#if KEEP_BF16_QK
#pragma unroll
        for (int i = 0; i < 8; ++i) { u32x4 q;
#pragma unroll
            for (int j = 0; j < 4; ++j) q[j] = pk2(o[8 * i + 2 * j], o[8 * i + 2 * j + 1]);
            *(u32x4*)(dst + 8 * i) = q; }
#else
        (void)dst;
#endif
        unsigned char* dst8 = isq ? Q8 + (size_t)t * 512 + hh * 64 : K8 + (size_t)t * 128 + (hh - 8) * 64;
#pragma unroll
        for (int i = 0; i < 4; ++i) { u32x4 q;
#pragma unroll
            for (int j = 0; j < 4; ++j) { int wd = 0; wd = __builtin_amdgcn_cvt_pk_fp8_f32(o[16 * i + 4 * j], o[16 * i + 4 * j + 1], wd, false); wd = __builtin_amdgcn_cvt_pk_fp8_f32(o[16 * i + 4 * j + 2], o[16 * i + 4 * j + 3], wd, true); q[j] = (unsigned)wd; }
            *(u32x4*)(dst8 + 16 * i) = q; }
    }
}
__device__ __forceinline__ void ph_v8t(Frame& F, const bf16_t* __restrict__ VV, unsigned char* __restrict__ V8T) {
    OPAQUE_LANE();
    const int gw = F.vcu * NWAVES + F.wave, NGW = F.G * NWAVES;
    for (int it = gw; it < 2 * (S / 64); it += NGW) {
        const int kvh = it / (S / 64), tile = it % (S / 64);
        const bf16_t* src = VV + (size_t)(64 * tile) * 128 + kvh * 64 + lane;
        u32x4 ov[4];
#pragma unroll
        for (int hi = 0; hi < 2; ++hi)
#pragma unroll
            for (int k = 0; k < 8; ++k) {
                float v[4];
#pragma unroll
                for (int b = 0; b < 4; ++b) { const int j = 4 * k + b; const int key = j < 16 ? ((j & 3) + 8 * (j >> 2) + 4 * hi) : 32 + (((j - 16) & 3) + 8 * ((j - 16) >> 2) + 4 * hi); v[b] = bf2f(src[(size_t)key * 128]); }
                int wd = 0; wd = __builtin_amdgcn_cvt_pk_fp8_f32(v[0], v[1], wd, false); wd = __builtin_amdgcn_cvt_pk_fp8_f32(v[2], v[3], wd, true);
                ov[hi * 2 + (k >> 2)][k & 3] = (unsigned)wd;
            }
        unsigned char* dst = V8T + ((size_t)it * 64 + lane) * 64;
#pragma unroll
        for (int q = 0; q < 4; ++q) *(u32x4*)(dst + 16 * q) = ov[q];
    }
}
__device__ __forceinline__ void ph_hgfin(Frame& F, const float* __restrict__ OF, const bf16_t* __restrict__ HG, const float* __restrict__ w, bf16_t* __restrict__ OHG) {
    OPAQUE_LANE();
    const int gw = F.vcu * NWAVES + F.wave, NGW = F.G * NWAVES;
    const int e0 = (lane & 15) * 8;
    const f32x4 w0 = *(const f32x4*)(w + e0), w1 = *(const f32x4*)(w + e0 + 4);
    for (int t = gw; t < S; t += NGW) {
        const size_t off = (size_t)t * 512 + lane * 8;
        const f32x4 a0 = *(const f32x4*)(OF + off), a1 = *(const f32x4*)(OF + off + 4), b0 = *(const f32x4*)(OF + (size_t)S * 512 + off), b1 = *(const f32x4*)(OF + (size_t)S * 512 + off + 4);
        const f32x4 s0 = a0 + b0, s1 = a1 + b1;
        float ss = (s0.x * s0.x + s0.y * s0.y) + (s0.z * s0.z + s0.w * s0.w) + (s1.x * s1.x + s1.y * s1.y) + (s1.z * s1.z + s1.w * s1.w);
        ss += __shfl_xor(ss, 1); ss += __shfl_xor(ss, 2); ss += __shfl_xor(ss, 4); ss += __shfl_xor(ss, 8);
        const float r = rsqrtf(ss * (1.0f / 128.0f) + EPS);
        const u32x4 g = *(const u32x4*)(HG + off);
        u32x4 o;
        o.x = pk2(s0.x * r * w0.x * bflo(g.x), s0.y * r * w0.y * bfhi(g.x));
        o.y = pk2(s0.z * r * w0.z * bflo(g.y), s0.w * r * w0.w * bfhi(g.y));
        o.z = pk2(s1.x * r * w1.x * bflo(g.z), s1.y * r * w1.y * bfhi(g.z));
        o.w = pk2(s1.z * r * w1.z * bflo(g.w), s1.w * r * w1.w * bfhi(g.w));
        *(u32x4*)(OHG + off) = o;
    }
}
__device__ __forceinline__ void ph_norm2_router(Frame& F, const float* __restrict__ X1, const float* __restrict__ w, const float* __restrict__ scale, const float* __restrict__ shift,
                                                const float* __restrict__ wr, unsigned char* __restrict__ HB, float* __restrict__ AFF) {
    OPAQUE_LANE();
    LAS float* WT = (LAS float*)F.lds;
    for (int dd = t_; dd < D; dd += NWAVES * 64) {
        const GAS f32x4* s = (const GAS f32x4*)((const GAS float*)wr + (size_t)dd * 16);
        const f32x4 a = s[0], b = s[1], c = s[2], e = s[3];
        WT[0 * D + dd] = a.x; WT[1 * D + dd] = a.y; WT[2 * D + dd] = a.z; WT[3 * D + dd] = a.w; WT[4 * D + dd] = b.x; WT[5 * D + dd] = b.y; WT[6 * D + dd] = b.z; WT[7 * D + dd] = b.w;
        WT[8 * D + dd] = c.x; WT[9 * D + dd] = c.y; WT[10 * D + dd] = c.z; WT[11 * D + dd] = c.w; WT[12 * D + dd] = e.x; WT[13 * D + dd] = e.y; WT[14 * D + dd] = e.z; WT[15 * D + dd] = e.w;
    }
    __syncthreads();
    const int gw = F.vcu * NWAVES + F.wave, NGW = F.G * NWAVES;
    for (int row = gw; row < S; row += 2 * NGW) {
        const int row1 = (row + NGW < S) ? row + NGW : row;
        const f32x4* xr0 = (const f32x4*)(X1 + (size_t)row * D) + lane; const f32x4* xr1 = (const f32x4*)(X1 + (size_t)row1 * D) + lane;
        f32x4 v0[4], v1[4], h0[4], h1[4]; float ss0 = 0.f, ss1 = 0.f;
#pragma unroll
        for (int j = 0; j < 4; ++j) { v0[j] = xr0[64 * j]; v1[j] = xr1[64 * j]; }
#pragma unroll
        for (int j = 0; j < 4; ++j) { ss0 += (v0[j].x * v0[j].x + v0[j].y * v0[j].y) + (v0[j].z * v0[j].z + v0[j].w * v0[j].w); ss1 += (v1[j].x * v1[j].x + v1[j].y * v1[j].y) + (v1[j].z * v1[j].z + v1[j].w * v1[j].w); }
        ss0 = wave_sum(ss0); ss1 = wave_sum(ss1);
        norm_mod_row_f8(v0, ss0, w, scale, shift, HB + (size_t)row * D, lane, h0);
        norm_mod_row_f8(v1, ss1, w, scale, shift, HB + (size_t)row1 * D, lane, h1);
        LAS float* wt = WT + 4 * lane; asm volatile("" : "+v"(wt));
        f32x4 lg0[4], lg1[4];
#pragma unroll
        for (int e = 0; e < 16; ++e) {
            float a0 = 0.f, a1 = 0.f;
#pragma unroll
            for (int j = 0; j < 4; ++j) { const f32x4 ww = *(const LAS f32x4*)(wt + e * D + 256 * j);
                a0 += (h0[j].x * ww.x + h0[j].y * ww.y) + (h0[j].z * ww.z + h0[j].w * ww.w); a1 += (h1[j].x * ww.x + h1[j].y * ww.y) + (h1[j].z * ww.z + h1[j].w * ww.w); }
            lg0[e >> 2][e & 3] = wave_sum(a0); lg1[e >> 2][e & 3] = wave_sum(a1);
        }
#pragma unroll
        for (int rr = 0; rr < 2; ++rr) {
            f32x4 (&lgv)[4] = rr ? lg1 : lg0;
            float mx = -1e30f;
#pragma unroll
            for (int e4 = 0; e4 < 4; ++e4) mx = fmaxf(mx, fmaxf(fmaxf(lgv[e4].x, lgv[e4].y), fmaxf(lgv[e4].z, lgv[e4].w)));
            float den = 0.f;
#pragma unroll
            for (int e4 = 0; e4 < 4; ++e4) { lgv[e4].x = __expf(lgv[e4].x - mx); lgv[e4].y = __expf(lgv[e4].y - mx); lgv[e4].z = __expf(lgv[e4].z - mx); lgv[e4].w = __expf(lgv[e4].w - mx);
                den += (lgv[e4].x + lgv[e4].y) + (lgv[e4].z + lgv[e4].w); }
            const float inv = 1.0f / den;
            const f32x4 s8a = (lane & 8) ? lgv[2] : lgv[0], s8b = (lane & 8) ? lgv[3] : lgv[1];
            const f32x4 s4 = (lane & 4) ? s8b : s8a;
            const float s2a = (lane & 2) ? s4.z : s4.x, s2b = (lane & 2) ? s4.w : s4.y;
            const float mine = ((lane & 1) ? s2b : s2a) * inv;
            const int rw = rr ? row1 : row;
            if (lane < 16 && (rr == 0 || row1 != row)) AFF[(size_t)lane * S + rw] = mine;
        }
    }
    __syncthreads();
}
__device__ __forceinline__ void ph_topk(Frame& F, LAS unsigned char* lds, int e, const float* __restrict__ AFF, int* __restrict__ IDX, float* __restrict__ TOPW, int* __restrict__ SLOT) {
    LAS unsigned* hist = (LAS unsigned*)lds;
    LAS unsigned* hsum = hist + 4096;
    LAS unsigned* shv = hsum + 256;
    LAS unsigned* scan = hsum + 512;
    OPAQUE_LANE(); const int tid = t_;
    const unsigned* vals = (const unsigned*)(AFF + (size_t)e * S);
    unsigned u[32];
#pragma unroll
    for (int i = 0; i < 8; ++i) { const u32x4 q = *(const u32x4*)(vals + tid * 32 + 4 * i); u[4 * i] = q.x; u[4 * i + 1] = q.y; u[4 * i + 2] = q.z; u[4 * i + 3] = q.w; }
    if (tid == 0) { shv[0] = 0u; shv[1] = CAP; }
    LAS unsigned* myh = hist + (lane & 15) * 256;
    __syncthreads();
    for (int pass = 3; pass >= 0; --pass) {
        const int shift = pass * 8;
        const unsigned mask = pass == 3 ? 0u : (0xFFFFFFFFu << (shift + 8));
#pragma unroll
        for (int i = 0; i < 8; ++i) hist[tid + 512 * i] = 0u;
        __syncthreads();
        const unsigned prefix = shv[0];
#pragma unroll
        for (int i = 0; i < 32; ++i) if ((u[i] & mask) == (prefix & mask)) __hip_atomic_fetch_add(&myh[(u[i] >> shift) & 255u], 1u, __ATOMIC_RELAXED, __HIP_MEMORY_SCOPE_WORKGROUP);
        __syncthreads();
        if (tid < 256) { unsigned s = 0u;
#pragma unroll
            for (int c = 0; c < 16; ++c) s += hist[c * 256 + tid];
            hsum[tid] = s; }
        __syncthreads();
        if (tid < 64) {
            const unsigned kk = shv[1];
            const unsigned h0 = hsum[4 * lane], h1 = hsum[4 * lane + 1], h2 = hsum[4 * lane + 2], h3 = hsum[4 * lane + 3];
            const unsigned tot = (h0 + h1) + (h2 + h3);
            unsigned inc = tot;
#pragma unroll
            for (int o = 1; o < 64; o <<= 1) { const unsigned v = __shfl_down(inc, o); if (lane + o < 64) inc += v; }
            unsigned c = inc - tot; int bin = -1; unsigned rem = 0u;
            if (c < kk && c + h3 >= kk) { bin = 4 * lane + 3; rem = kk - c; } c += h3;
            if (c < kk && c + h2 >= kk) { bin = 4 * lane + 2; rem = kk - c; } c += h2;
            if (c < kk && c + h1 >= kk) { bin = 4 * lane + 1; rem = kk - c; } c += h1;
            if (c < kk && c + h0 >= kk) { bin = 4 * lane; rem = kk - c; }
            if (bin >= 0) { shv[1] = rem; shv[0] = prefix | ((unsigned)bin << shift); }
        }
        __syncthreads();
    }
    const unsigned T = shv[0], need_eq = shv[1];
    unsigned ceq = 0u;
#pragma unroll
    for (int i = 0; i < 32; ++i) ceq += (u[i] == T) ? 1u : 0u;
    scan[tid] = ceq; __syncthreads();
    for (int off = 1; off < 512; off <<= 1) { const unsigned tv = tid >= off ? scan[tid - off] : 0u; __syncthreads(); scan[tid] += tv; __syncthreads(); }
    unsigned eq_rank = scan[tid] - ceq;
    __syncthreads();
    unsigned selmask = 0u, csel = 0u;
#pragma unroll
    for (int i = 0; i < 32; ++i) { bool sel = u[i] > T; if (u[i] == T) { sel = eq_rank < need_eq; ++eq_rank; } if (sel) { selmask |= 1u << i; ++csel; } }
    scan[tid] = csel; __syncthreads();
    for (int off = 1; off < 512; off <<= 1) { const unsigned tv = tid >= off ? scan[tid - off] : 0u; __syncthreads(); scan[tid] += tv; __syncthreads(); }
    unsigned slot = scan[tid] - csel;
#pragma unroll
    for (int i = 0; i < 32; ++i) {
        const int t = tid * 32 + i; int sl = -1;
        if (selmask & (1u << i)) { sl = (int)slot; ++slot; if (sl < CAP) { IDX[e * CAP + sl] = t; TOPW[e * CAP + sl] = __uint_as_float(u[i]); } }
        SLOT[(size_t)e * S + t] = sl < CAP ? sl : -1;
    }
    __syncthreads();
}
__device__ __forceinline__ void ph_combine(Frame& F, const float* __restrict__ X1, const bf16_t* __restrict__ YE, const int* __restrict__ SLOT, const float* __restrict__ gate,
                                           float* __restrict__ xout, const float* __restrict__ w, const float* __restrict__ scale, const float* __restrict__ shift, bf16_t* __restrict__ HB, unsigned char* __restrict__ HB8, bool do_norm) {
    OPAQUE_LANE();
    const int gw = F.vcu * NWAVES + F.wave, NGW = F.G * NWAVES;
    for (int row = gw; row < S; row += 2 * NGW) {
        const bool two = row + NGW < S; const int row1 = two ? row + NGW : row;
        const int sl0 = lane < NE ? SLOT[(size_t)lane * S + row] : -1, sl1 = lane < NE ? SLOT[(size_t)lane * S + row1] : -1;
        const f32x4* xr0 = (const f32x4*)(X1 + (size_t)row * D) + lane; const f32x4* xr1 = (const f32x4*)(X1 + (size_t)row1 * D) + lane;
        f32x4 v0[4], v1[4];
#pragma unroll
        for (int j = 0; j < 4; ++j) { v0[j] = xr0[64 * j]; v1[j] = xr1[64 * j]; }
        f32x4 acc0[4], acc1[4];
#pragma unroll
        for (int j = 0; j < 4; ++j) { acc0[j] = f32x4{0.f, 0.f, 0.f, 0.f}; acc1[j] = acc0[j]; }
        unsigned m0 = (unsigned)__ballot(sl0 >= 0) & 0xffffu, m1 = (unsigned)__ballot(sl1 >= 0) & 0xffffu;
        while (m0 | m1) {
            const int e0 = m0 ? __builtin_ctz(m0) : 0, e1 = m1 ? __builtin_ctz(m1) : 0;
            const float f0 = m0 ? 1.f : 0.f, f1 = m1 ? 1.f : 0.f;
            const int s0 = m0 ? __builtin_amdgcn_readlane(sl0, e0) : 0, s1 = m1 ? __builtin_amdgcn_readlane(sl1, e1) : 0;
            m0 &= m0 - 1u; m1 &= m1 - 1u;
            const bf16_t* y0 = YE + ((size_t)e0 * CAP + s0) * D + 4 * lane; const bf16_t* y1 = YE + ((size_t)e1 * CAP + s1) * D + 4 * lane;
            u32x2 q0[4], q1[4];
#pragma unroll
            for (int j = 0; j < 4; ++j) { q0[j] = *(const u32x2*)(y0 + 256 * j); q1[j] = *(const u32x2*)(y1 + 256 * j); }
#pragma unroll
            for (int j = 0; j < 4; ++j) { acc0[j].x += f0 * bflo(q0[j].x); acc0[j].y += f0 * bfhi(q0[j].x); acc0[j].z += f0 * bflo(q0[j].y); acc0[j].w += f0 * bfhi(q0[j].y);
                                          acc1[j].x += f1 * bflo(q1[j].x); acc1[j].y += f1 * bfhi(q1[j].x); acc1[j].z += f1 * bflo(q1[j].y); acc1[j].w += f1 * bfhi(q1[j].y); }
        }
        f32x4 h[4]; float ss0 = 0.f, ss1 = 0.f;
#pragma unroll
        for (int j = 0; j < 4; ++j) { const f32x4 gv = *(const f32x4*)(gate + 4 * lane + 256 * j); v0[j] = v0[j] + gv * acc0[j]; v1[j] = v1[j] + gv * acc1[j];
            ((f32x4*)(xout + (size_t)row * D) + lane)[64 * j] = v0[j]; if (two) ((f32x4*)(xout + (size_t)row1 * D) + lane)[64 * j] = v1[j];
            ss0 += (v0[j].x * v0[j].x + v0[j].y * v0[j].y) + (v0[j].z * v0[j].z + v0[j].w * v0[j].w); ss1 += (v1[j].x * v1[j].x + v1[j].y * v1[j].y) + (v1[j].z * v1[j].z + v1[j].w * v1[j].w); }
        if (do_norm) { ss0 = wave_sum(ss0); ss1 = wave_sum(ss1); norm_mod_row(v0, ss0, w, scale, shift, HB + (size_t)row * D, lane, h); if (two) norm_mod_row(v1, ss1, w, scale, shift, HB + (size_t)row1 * D, lane, h); }
    }
}

__global__ void __launch_bounds__(NWAVES * 64, 2) mega(Params p) {
    extern __shared__ __attribute__((aligned(16))) unsigned char lds[];
    Frame F;
    F.lds = (LAS unsigned char*)lds;
    volatile LAS unsigned* MISC = (volatile LAS unsigned*)(F.lds + MISC_OFF);
    F.tid = threadIdx.x; F.lane = F.tid & 63; F.wave = __builtin_amdgcn_readfirstlane(F.tid >> 6);
    F.G = gridDim.x; { const int bx = blockIdx.x; F.vcu = (F.G % 8 == 0) ? (bx % 8) * (F.G / 8) + bx / 8 : bx; }
    unsigned char* ws = p.ws;
    unsigned* ctl = (unsigned*)(ws + WS_CTL);
    for (int u = F.tid; u < (LDS_BYTES - LDSCTL_OFF) / 4; u += NWAVES * 64) ((LAS unsigned*)(F.lds + LDSCTL_OFF))[u] = 0u;
    __syncthreads();
    XcdBarrier bar = xcd_barrier_post(ctl + CW_BAR + p.li * XCD_BAR_WORDS, MISC + 8);
    const int lo = p.ph_lo, hi = p.ph_hi;
#define IN(k) (lo <= (k) && (k) < hi)
#define SEAM(k) do { if (IN(k) && IN((k) + 1)) xcd_barrier(bar); } while (0)
#define REFRESH() do { F.lane = lane_id_opaque(); F.tid = F.wave * 64 + F.lane; } while (0)

#define WSP(T, off) ((T*)(GAS T*)(wsl + (off)))
#define WSL() unsigned char* wsl = p.ws; asm volatile("" : "+s"(wsl))
    LAS float* scr = (LAS float*)(F.lds + RING_OFF + F.wave * 8704);

    if (IN(PH_PRO)) { REFRESH(); WSL();
        mod_units(F, p);
        for (int l = 0; l < NL; ++l) {
            conv_matrix(F, p.w_in + (size_t)l * D * INW, INW, D, INW, WSP(bf16_t, WS_WIN) + (size_t)l * INW * D, scr);
            conv_matrix(F, p.w_ba + (size_t)l * 512 * D, D, 512, D, WSP(bf16_t, WS_WBA) + (size_t)l * D * 512, scr);
            conv_matrix(F, p.w_bh + (size_t)l * 512 * D, D, 512, D, WSP(bf16_t, WS_WBH) + (size_t)l * D * 512, scr);
            conv_matrix(F, p.w_out + (size_t)l * D * D, D, D, D, WSP(bf16_t, WS_WOUT) + (size_t)l * D * D, scr);
        }
        for (int rep_ = 0; rep_ < REP_PRO; ++rep_) { conv_experts_f8(F, p, 0, scr); conv_experts_f8(F, p, 1, scr); }
        ph_rope_table(F, WSP(float, WS_ROPE));
    }
    SEAM(PH_PRO);
    if (IN(PH_NORM1)) { REFRESH(); WSL(); ph_norm1(F, p.x, p.norm_mix_w, WSP(float, WS_MOD) + 1 * D, WSP(float, WS_MOD) + 0 * D, WSP(bf16_t, WS_HB), WSP(unsigned char, WS_HBF8)); }
    SEAM(PH_NORM1);

    for (int l = 0; l < NL; ++l) {
        const int pb = PH_L0 + l * NPL;
        if (IN(pb + P_G1)) { WSL();
            pg8::Gemm g{WSP(bf16_t, WS_HB), WSP(bf16_t, WS_WIN) + (size_t)l * INW * D, S, 3072, D}; pg8::StaticOrder So; So.init(S, 3072, F.G, (int)blockIdx.x);
            pg8::EpiInproj E{WSP(bf16_t, WS_QR), WSP(bf16_t, WS_KR), WSP(bf16_t, WS_VV), WSP(bf16_t, WS_HQ), WSP(bf16_t, WS_KF), WSP(bf16_t, WS_HV), WSP(bf16_t, WS_HG), WSP(bf16_t, WS_GG), WSP(float, WS_LF), WSP(float, WS_LBV) + l * 1024, 1.0f};
            for (int rep_ = 0; rep_ < REP_G; ++rep_) pg8::gemm_phase<pg8::EpiInproj, pg8::StaticOrder, true, true>(F.lds + RING_OFF, g, So, E, F.wave);
        }
        SEAM(pb + P_G1);
        if (IN(pb + P_QKP)) { WSL();
            {
              pg8::Gemm g{WSP(bf16_t, WS_HB), WSP(bf16_t, WS_WIN) + (size_t)l * INW * D + (size_t)3072 * D, S, 2304, D}; pg8::OffOrder So; So.So.init(S, 2304, F.G, (int)blockIdx.x); So.off = 12;
              pg8::EpiInproj E{WSP(bf16_t, WS_QR), WSP(bf16_t, WS_KR), WSP(bf16_t, WS_VV), WSP(bf16_t, WS_HQ), WSP(bf16_t, WS_KF), WSP(bf16_t, WS_HV), WSP(bf16_t, WS_HG), WSP(bf16_t, WS_GG), WSP(float, WS_LF), WSP(float, WS_LBV) + l * 1024, 1.0f};
              for (int rep_ = 0; rep_ < REP_G; ++rep_) pg8::gemm_phase<pg8::EpiInproj, pg8::OffOrder, true, true>(F.lds + RING_OFF, g, So, E, F.wave); }
            { const bool even = (F.G == 256); const int rk = even ? (int)blockIdx.x - 64 : (int)blockIdx.x, nr = even ? 192 : F.G;
              for (int rep_ = 0; rep_ < REP_QK; ++rep_) ph_qkprep(F, WSP(bf16_t, WS_QR), WSP(bf16_t, WS_KR), p.q_norm_w + l * 64, p.k_norm_w + l * 64, WSP(float, WS_ROPE), WSP(bf16_t, WS_QN), WSP(bf16_t, WS_KN), WSP(unsigned char, WS_Q8), WSP(unsigned char, WS_K8), rk, nr);
              ph_v8t(F, WSP(bf16_t, WS_VV), WSP(unsigned char, WS_V8T)); }
            for (int rep_ = 0; rep_ < REP_HG; ++rep_) for (int u = blockIdx.x; u < 256; u += F.G) hg::segment<false>(F.lds, u, WSP(bf16_t, WS_HQ), WSP(float, WS_LF), WSP(bf16_t, WS_KF), WSP(bf16_t, WS_HV), WSP(float, WS_HST), WSP(float, WS_HST + 16 * MiB), nullptr, F.wave);
        }
        SEAM(pb + P_QKP);
        if (IN(pb + P_HGB)) { WSL(); OPAQUE_LANE(); (void)lane;
            for (int gid = blockIdx.x * 512 + t_; gid < 8 * 16384; gid += F.G * 512) hg::carry(WSP(float, WS_HST), WSP(float, WS_HST + 16 * MiB), gid);
        }
        SEAM(pb + P_HGB);
        if (IN(pb + P_HGC)) { WSL();
            for (int rep_ = 0; rep_ < REP_HG; ++rep_) for (int u = blockIdx.x; u < 256; u += F.G) hg::segment<true>(F.lds, u, WSP(bf16_t, WS_HQ), WSP(float, WS_LF), WSP(bf16_t, WS_KF), WSP(bf16_t, WS_HV), WSP(float, WS_HST), WSP(float, WS_HST + 16 * MiB), WSP(float, WS_OF), F.wave);
        }
        SEAM(pb + P_HGC);
        if (IN(pb + P_ATT)) { WSL();
            for (int rep_ = 0; rep_ < REP_QK; ++rep_) ph_hgfin(F, WSP(float, WS_OF), WSP(bf16_t, WS_HG), p.hg_norm_w + l * 128, WSP(bf16_t, WS_OHG));
            float negM;
            { const int ln = lane_id_opaque(); float mq = fabsf(p.q_norm_w[l * 64 + ln]), mk = fabsf(p.k_norm_w[l * 64 + ln]);
#pragma unroll
              for (int o_ = 1; o_ < 64; o_ <<= 1) { mq = fmaxf(mq, __shfl_xor(mq, o_)); mk = fmaxf(mk, __shfl_xor(mk, o_)); }
              negM = -(64.0f * C2) * mq * mk * 1.05f; }
#if ATTN_FP8
            const attn8::Tensors AT{WSP(unsigned char, WS_Q8), WSP(unsigned char, WS_K8), WSP(unsigned char, WS_V8T), (attn8::bf16*)WSP(bf16_t, WS_OATT)};
            for (int rep_ = 0; rep_ < REP_ATT; ++rep_) attn8::phase((char*)lds + RING_OFF, AT, (int)F.G, (int)blockIdx.x, F.wave, negM + 8.0f);
#else
            const attn_body::AttnTensors AT{(const attn_body::bf16*)WSP(bf16_t, WS_QN), (const attn_body::bf16*)WSP(bf16_t, WS_KN), (const attn_body::bf16*)WSP(bf16_t, WS_VV), (attn_body::bf16*)WSP(bf16_t, WS_OATT)};
            const attn_body::StaticOrder So((int)F.G, (int)blockIdx.x);
            for (int rep_ = 0; rep_ < REP_ATT; ++rep_) attn_body::attn_phase<attn_body::StaticOrder>((char*)lds + RING_OFF, AT, So, F.wave, negM);
#endif
        }
        SEAM(pb + P_ATT);
        if (IN(pb + P_G2)) { WSL();
            pg8::Gemm g{WSP(bf16_t, WS_OATT), WSP(bf16_t, WS_WBA) + (size_t)l * D * 512, S, D, 512, WSP(bf16_t, WS_OHG), WSP(bf16_t, WS_WBH) + (size_t)l * D * 512};
            pg8::ChainOrder So; So.So.init(S, D, F.G, (int)blockIdx.x);
            pg8::EpiMerge E{WSP(bf16_t, WS_GG), WSP(bf16_t, WS_MG)};
            for (int rep_ = 0; rep_ < REP_G; ++rep_) pg8::gemm_phase<pg8::EpiMerge, pg8::ChainOrder, false, true>(F.lds + RING_OFF, g, So, E, F.wave);
        }
        SEAM(pb + P_G2);
        if (IN(pb + P_G3)) { WSL();
            pg8::Gemm g{WSP(bf16_t, WS_MG), WSP(bf16_t, WS_WOUT) + (size_t)l * D * D, S, D, D}; pg8::StaticOrder So; So.init(S, D, F.G, (int)blockIdx.x);
            pg8::EpiOut E{l == 0 ? p.x : WSP(float, WS_X2), WSP(float, WS_MOD) + l * 6 * D + 2 * D, WSP(float, WS_X1)};
            for (int rep_ = 0; rep_ < REP_G; ++rep_) pg8::gemm_phase<pg8::EpiOut, pg8::StaticOrder, false, true>(F.lds + RING_OFF, g, So, E, F.wave);
        }
        SEAM(pb + P_G3);
        if (IN(pb + P_N2R)) { WSL();
            for (int rep_ = 0; rep_ < REP_ROW; ++rep_) ph_norm2_router(F, WSP(float, WS_X1), p.norm_ffn_w + l * D, WSP(float, WS_MOD) + l * 6 * D + 4 * D, WSP(float, WS_MOD) + l * 6 * D + 3 * D, p.w_router + (size_t)l * D * NE, WSP(unsigned char, WS_HB8), WSP(float, WS_AFF));
        }
        SEAM(pb + P_N2R);
        if (IN(pb + P_TOPK)) { WSL();
            for (int rep_ = 0; rep_ < REP_TK; ++rep_) for (int e = blockIdx.x; e < NE; e += F.G) ph_topk(F, F.lds, e, WSP(float, WS_AFF), WSP(int, WS_IDX), WSP(float, WS_TOPW), WSP(int, WS_SLOT));
        }
        SEAM(pb + P_TOPK);
        if (IN(pb + P_GATH)) { REFRESH(); WSL(); for (int rep_ = 0; rep_ < REP_ROW; ++rep_) ph_gather(F, WSP(unsigned char, WS_HB8), WSP(int, WS_IDX), WSP(unsigned char, WS_XE8)); }
        SEAM(pb + P_GATH);
        if (IN(pb + P_G4)) { WSL();
            pg8::Gemm g{(const bf16_t*)WSP(unsigned char, WS_XE8), (const bf16_t*)(WSP(unsigned char, WS_WGU) + (size_t)l * 64 * MiB), NE * CAP, NE * 4096, D / 2}; pg8::GroupOrder So; So.init(16, F.G, (int)blockIdx.x);
            pg8::EpiGU8 E{WSP(unsigned char, WS_HID8)};
            for (int rep_ = 0; rep_ < REP_G; ++rep_) pg8::gemm_phase<pg8::EpiGU8, pg8::GroupOrder, true, true, true>(F.lds + RING_OFF, g, So, E, F.wave);
        }
        SEAM(pb + P_G4);
        if (IN(pb + P_G5)) { WSL();
            pg8::Gemm g{(const bf16_t*)WSP(unsigned char, WS_HID8), (const bf16_t*)(WSP(unsigned char, WS_WD) + (size_t)l * 32 * MiB), NE * CAP, NE * 1024, FF / 2}; pg8::GroupOrder So; So.init(4, F.G, (int)blockIdx.x);
            pg8::EpiDown E{WSP(bf16_t, WS_YE), WSP(float, WS_TOPW), 0.015625f};
            for (int rep_ = 0; rep_ < REP_G; ++rep_) pg8::gemm_phase<pg8::EpiDown, pg8::GroupOrder, true, true, true>(F.lds + RING_OFF, g, So, E, F.wave);
        }
        SEAM(pb + P_G5);
        if (IN(pb + P_COMB)) { WSL();
            const bool last = (l + 1 == NL); const int ln = last ? l : l + 1;
            for (int rep_ = 0; rep_ < REP_ROW; ++rep_) ph_combine(F, WSP(float, WS_X1), WSP(bf16_t, WS_YE), WSP(int, WS_SLOT), WSP(float, WS_MOD) + l * 6 * D + 5 * D, last ? p.out : WSP(float, WS_X2),
                       p.norm_mix_w + ln * D, WSP(float, WS_MOD) + ln * 6 * D + 1 * D, WSP(float, WS_MOD) + ln * 6 * D + 0 * D, WSP(bf16_t, WS_HB), WSP(unsigned char, WS_HBF8), !last);
        }
        SEAM(pb + P_COMB);
    }
#undef IN
#undef SEAM
}

#ifndef N_LAUNCH_MODE
#define N_LAUNCH_MODE 1
#endif
static int g_grid = 0;
extern "C" void kernel_launch(void* const* d_in, const int* in_sizes, int n_in, void* d_out, int out_size, void* d_ws, size_t ws_size, hipStream_t stream) {
    if (n_in != 18 || out_size != S * D || ws_size < WS_END) { fprintf(stderr, "kernel_launch: unexpected shapes (n_in %d out %d ws %zu)\n", n_in, out_size, ws_size); return; }
    if (g_grid == 0) {
        int dev = 0, cus = 0;
        if (hipGetDevice(&dev) != hipSuccess || hipDeviceGetAttribute(&cus, hipDeviceAttributeMultiprocessorCount, dev) != hipSuccess) { g_grid = -1; return; }
        if (hipFuncSetAttribute((const void*)mega, hipFuncAttributeMaxDynamicSharedMemorySize, LDS_BYTES) != hipSuccess) { g_grid = -1; return; }
        int per_cu = 0;
        if (hipOccupancyMaxActiveBlocksPerMultiprocessor(&per_cu, (const void*)mega, NWAVES * 64, LDS_BYTES) != hipSuccess || per_cu < 1) { fprintf(stderr, "occupancy query: %d\n", per_cu); }
        (void)hipGetLastError();
        g_grid = cus;
    }
    if (g_grid < 0) return;
    unsigned char* ws = (unsigned char*)d_ws;
    (void)hipMemsetAsync(ws + WS_CTL, 0, 1 * MiB, stream);
    Params p{};
    p.x = (const float*)d_in[0]; p.c = (const float*)d_in[1]; p.ada_w = (const float*)d_in[2]; p.ada_b = (const float*)d_in[3]; p.norm_mix_w = (const float*)d_in[4];
    p.norm_ffn_w = (const float*)d_in[5]; p.w_in = (const float*)d_in[6]; p.q_norm_w = (const float*)d_in[7]; p.k_norm_w = (const float*)d_in[8]; p.hlb = (const float*)d_in[9];
    p.hg_norm_w = (const float*)d_in[10]; p.w_ba = (const float*)d_in[11]; p.w_bh = (const float*)d_in[12]; p.w_out = (const float*)d_in[13]; p.w_router = (const float*)d_in[14];
    p.w_eg = (const float*)d_in[15]; p.w_eu = (const float*)d_in[16]; p.w_ed = (const float*)d_in[17];
    p.out = (float*)d_out; p.ws = ws;
#if defined(DBG_ATT)
    { const int cut = PH_L0 + P_ATT + 1;
      p.ph_lo = 0; p.ph_hi = cut; p.li = 0; p.pad = 0; hipLaunchKernelGGL(mega, dim3(g_grid), dim3(NWAVES * 64), LDS_BYTES, stream, p);
      hipMemcpyAsync(ws + 900 * MiB, ws + WS_OATT, 16 * MiB, hipMemcpyDeviceToDevice, stream);
      k_attn_naive<<<dim3(S / 64, 8), dim3(64), 0, stream>>>((const bf16_t*)(ws + WS_QN), (const bf16_t*)(ws + WS_KN), (const bf16_t*)(ws + WS_VV), (bf16_t*)(ws + WS_OATT));
      k_cmp_bf16<<<dim3(2048), dim3(256), 0, stream>>>((const bf16_t*)(ws + 900 * MiB), (const bf16_t*)(ws + WS_OATT), (size_t)8 * MiB, 512, 0, 512, (float*)(ws + 512 * 1024));
      p.ph_lo = cut; p.ph_hi = PH_END; p.li = 1; hipLaunchKernelGGL(mega, dim3(g_grid), dim3(NWAVES * 64), LDS_BYTES, stream, p);
      k_scale_out<<<dim3(2048), dim3(256), 0, stream>>>((float*)d_out, (size_t)S * D, (const float*)(ws + 512 * 1024)); }
#elif N_LAUNCH_MODE == 1
    p.ph_lo = 0; p.ph_hi = PH_END; p.li = 0; p.pad = 0;
    hipLaunchKernelGGL(mega, dim3(g_grid), dim3(NWAVES * 64), LDS_BYTES, stream, p);
#else
    for (int k = 0; k < PH_END; ++k) { p.ph_lo = k; p.ph_hi = k + 1; p.li = k; p.pad = 0; hipLaunchKernelGGL(mega, dim3(g_grid), dim3(NWAVES * 64), LDS_BYTES, stream, p); }
#endif
}
```

```cpp
#include <hip/hip_runtime.h>
#include <cstdio>
#include <cstdint>

typedef unsigned short bf16_t;
typedef float f32x4 __attribute__((ext_vector_type(4)));
typedef float f32x16 __attribute__((ext_vector_type(16)));
typedef unsigned u32x4 __attribute__((ext_vector_type(4)));
typedef unsigned u32x2 __attribute__((ext_vector_type(2)));

constexpr int S = 16384, D = 1024, NL = 2, INW = 5376;
constexpr int NE = 16, CAP = 2048, FF = 2048;
constexpr float EPS = 1e-6f;
constexpr float C2 = 0.125f * 1.4426950408889634f;
constexpr int C_AQ = 0, C_AK = 512, C_AV = 640, C_HQ = 768, C_ZF = 1280, C_ZB = 1792, C_HI = 2304, C_HGT = 2816, C_GL = 3328;

constexpr size_t MiB = 1u << 20;
constexpr size_t WS_CTL = 0;
constexpr size_t WS_MOD = 1 * MiB;
constexpr size_t WS_LBV = WS_MOD + 64 * 1024;
constexpr size_t WS_IDX = WS_MOD + 128 * 1024;
constexpr size_t WS_TOPW = WS_IDX + 128 * 1024;
constexpr size_t WS_ROPE = WS_MOD + 512 * 1024;
constexpr size_t WS_AFF = 2 * MiB;
constexpr size_t WS_SLOT = 3 * MiB;
constexpr size_t WS_HB = 4 * MiB;
constexpr size_t WS_QR = 36 * MiB;
constexpr size_t WS_KR = 52 * MiB;
constexpr size_t WS_VV = 56 * MiB;
constexpr size_t WS_QN = 60 * MiB;
constexpr size_t WS_KN = 76 * MiB;
constexpr size_t WS_HQ = 80 * MiB;
constexpr size_t WS_LF = 96 * MiB;
constexpr size_t WS_KF = 160 * MiB;
constexpr size_t WS_HV = 192 * MiB;
constexpr size_t WS_HG = 208 * MiB;
constexpr size_t WS_GG = 224 * MiB;
constexpr size_t WS_OATT = 288 * MiB;
constexpr size_t WS_OF = 304 * MiB;
constexpr size_t WS_OHG = 368 * MiB;
constexpr size_t WS_MP = 384 * MiB;
constexpr size_t WS_MG = 448 * MiB;
constexpr size_t WS_HB8 = 36 * MiB;
constexpr size_t WS_XE8 = 52 * MiB;
constexpr size_t WS_HID8 = 100 * MiB;
constexpr size_t WS_XE = 36 * MiB;
constexpr size_t WS_HID = 100 * MiB;
constexpr size_t WS_YE = 228 * MiB;
constexpr size_t WS_X1 = 480 * MiB;
constexpr size_t WS_X2 = 544 * MiB;
constexpr size_t WS_WIN = 608 * MiB;
constexpr size_t WS_WBA = 630 * MiB;
constexpr size_t WS_WBH = 632 * MiB;
constexpr size_t WS_WOUT = 634 * MiB;
constexpr size_t WS_WGU = 638 * MiB;
constexpr size_t WS_WD = 766 * MiB;
constexpr size_t WS_HST = 830 * MiB;
constexpr size_t WS_Q8 = 912 * MiB;
constexpr size_t WS_K8 = 920 * MiB;
constexpr size_t WS_V8T = 922 * MiB;
constexpr size_t WS_WIN8 = 900 * MiB;
constexpr size_t WS_HBF8 = 906 * MiB;
constexpr size_t WS_END = 924 * MiB;
static_assert(WS_END <= 1024 * MiB, "workspace");

__device__ __forceinline__ float bf2f(bf16_t v) { return __uint_as_float((unsigned)v << 16); }
__device__ __forceinline__ bf16_t f2bf(float f) { unsigned u = __float_as_uint(f); return (bf16_t)((u + 0x7fffu + ((u >> 16) & 1u)) >> 16); }
__device__ __forceinline__ unsigned pk2(float lo, float hi) { return (unsigned)f2bf(lo) | ((unsigned)f2bf(hi) << 16); }
__device__ __forceinline__ float bflo(unsigned w) { return __uint_as_float(w << 16); }
__device__ __forceinline__ float bfhi(unsigned w) { return __uint_as_float(w & 0xffff0000u); }
__device__ __forceinline__ float sigmoidf_(float v) { return __builtin_amdgcn_rcpf(1.0f + __expf(-v)); }
__device__ __forceinline__ float siluf_(float v) { return v * __builtin_amdgcn_rcpf(1.0f + __expf(-v)); }
__device__ __forceinline__ float wave_sum(float v) {
#pragma unroll
    for (int o = 1; o < 64; o <<= 1) v += __shfl_xor(v, o);
    return v;
}
__device__ __forceinline__ int crow(int r, int hi) { return (r & 3) + 8 * (r >> 2) + 4 * hi; }
__device__ __forceinline__ int lane_id_opaque() { int l; asm volatile("v_mbcnt_lo_u32_b32 %0, -1, 0\n\tv_mbcnt_hi_u32_b32 %0, -1, %0" : "=v"(l)); return l; }

#define GAS __attribute__((address_space(1)))
#define LAS __attribute__((address_space(3)))

namespace pg8 {
#define PG8_LAS __attribute__((address_space(3)))
typedef unsigned short bf16_t;
typedef short bf16x8 __attribute__((ext_vector_type(8)));
typedef float f32x4 __attribute__((ext_vector_type(4)));
typedef unsigned u32x4 __attribute__((ext_vector_type(4)));
constexpr int BM = 256, BK = 64, HALF = 128, HTB = HALF * BK * 2  , STAGE_BYTES = 8 * HTB, NXCD = 8, WGM = 8;

__host__ __device__ __forceinline__ int lds_byte(int r, int c) { const int st = (r >> 4) * 2 + (c >> 5), rr = r & 15, cc = c & 31, ob = rr * 64 + cc * 2; return st * 1024 + (ob ^ (((ob >> 9) & 1) << 5)); }
__host__ __device__ __forceinline__ void stage_rc(int b, int& R, int& C) { const int st = b / 1024, sb = b % 1024, swz = sb ^ (((sb >> 9) & 1) << 5); R = (st >> 1) * 16 + swz / 64; C = (st & 1) * 32 + (swz % 64) / 2; }
__host__ __device__ __forceinline__ int perm32(int rho) { const int n = rho >> 4, i = rho & 15; return 8 * (i >> 2) + 4 * n + (i & 3); }

struct Unit { int pm, pn, pb, sel; };
struct Gemm { const bf16_t* A; const bf16_t* Bt; int M, N, K; const bf16_t* A2 = nullptr; const bf16_t* Bt2 = nullptr; const int* rowidx = nullptr; };

struct StaticOrder {
    int nM, nN, nwg, G, c;
    __host__ __device__ void init(int M, int N, int G_, int c_) { nM = M / BM; nN = N / BM; nwg = nM * nN; G = G_; c = c_; }
    __host__ __device__ bool next(int i, Unit& u) const {
        const long L = (long)i * G + c; if (L >= nwg) return false;
        int wgid = (int)L; { const int q = nwg / NXCD, r = nwg % NXCD, xcd = wgid % NXCD, off = wgid / NXCD; wgid = (xcd < r ? xcd * (q + 1) : r * (q + 1) + (xcd - r) * q) + off; }
        const int nig = WGM * nN, gid = wgid / nig, fm = gid * WGM, gsz = (nM - fm) < WGM ? (nM - fm) : WGM;
        u.pm = fm + ((wgid % nig) % gsz); u.pn = (wgid % nig) / gsz; u.pb = u.pn; u.sel = 0; return true;
    }
    __device__ __forceinline__ void a_ready(const Unit&) const {}
    __device__ __forceinline__ void done(const Unit&) const {}
};

typedef float f32x2_c __attribute__((ext_vector_type(2))); typedef __bf16 bf16x2_c __attribute__((ext_vector_type(2)));
__device__ __forceinline__ unsigned cvt_pk_bf16(float lo, float hi) { f32x2_c v = {lo, hi}; bf16x2_c b = __builtin_convertvector(v, bf16x2_c); return __builtin_bit_cast(unsigned, b); }

typedef unsigned u32x2 __attribute__((ext_vector_type(2)));
__device__ __forceinline__ float e_bflo(unsigned w) { return __uint_as_float(w << 16); }
__device__ __forceinline__ float e_bfhi(unsigned w) { return __uint_as_float(w & 0xffff0000u); }
__device__ __forceinline__ float e_sig(float v) { return __builtin_amdgcn_rcpf(1.0f + __expf(-v)); }
__device__ __forceinline__ u32x4 pack8(const f32x4 a, const f32x4 b) { u32x4 w; w.x = cvt_pk_bf16(a[0], a[1]); w.y = cvt_pk_bf16(a[2], a[3]); w.z = cvt_pk_bf16(b[0], b[1]); w.w = cvt_pk_bf16(b[2], b[3]); return w; }

typedef int i32x4_ __attribute__((ext_vector_type(4))); typedef int i32x8_ __attribute__((ext_vector_type(8)));
__device__ __forceinline__ i32x8_ pg8_cat(const bf16x8 lo, const bf16x8 hi) { return __builtin_shufflevector(__builtin_bit_cast(i32x4_, lo), __builtin_bit_cast(i32x4_, hi), 0, 1, 2, 3, 4, 5, 6, 7); }
__device__ __forceinline__ u32x2 pack8_fp8(const f32x4 a, const f32x4 b) { int w0 = 0, w1 = 0;
    w0 = __builtin_amdgcn_cvt_pk_fp8_f32(a[0], a[1], w0, false); w0 = __builtin_amdgcn_cvt_pk_fp8_f32(a[2], a[3], w0, true);
    w1 = __builtin_amdgcn_cvt_pk_fp8_f32(b[0], b[1], w1, false); w1 = __builtin_amdgcn_cvt_pk_fp8_f32(b[2], b[3], w1, true);
    u32x2 r; r.x = (unsigned)w0; r.y = (unsigned)w1; return r; }
struct EpiInproj {
    static constexpr bool PERM = true, AFTER_DRAIN = false, CHAIN = false;
    bf16_t *QR, *KR, *VV, *HQ, *KF, *HV, *HG, *GG; float* LF; const float* lbv; float ascale;
    __device__ __forceinline__ void operator()(const f32x4 (&acc)[2][2][4][2], const Unit& u, int wr, int wc, int fr, int fq) const {
        const int row0 = u.pm * BM + wr * 64 + fr, cl = wc * 32 + 8 * fq;
#pragma unroll
        for (int bj = 0; bj < 2; ++bj) {
            const int colg = u.pn * BM + bj * HALF;
            int kind; bf16_t* dst; int pitch, c0; int dir = 0;
            if (colg < 512) { kind = 0; dst = QR; pitch = 512; c0 = colg; }
            else if (colg < 640) { kind = 0; dst = KR; pitch = 128; c0 = colg - 512; }
            else if (colg < 768) { kind = 0; dst = VV; pitch = 128; c0 = colg - 640; }
            else if (colg < 1280) { kind = 1; dst = HQ; pitch = 512; c0 = colg - 768; }
            else if (colg < 2304) { kind = 3; dir = colg >= 1792; dst = KF + (size_t)dir * 16384 * 512; pitch = 512; c0 = colg - (dir ? 1792 : 1280); }
            else if (colg < 2816) { kind = 0; dst = HV; pitch = 512; c0 = colg - 2304; }
            else if (colg < 3328) { kind = 1; dst = HG; pitch = 512; c0 = colg - 2816; }
            else { kind = 2; dst = GG; pitch = 2048; c0 = colg - 3328; }
            c0 += cl;
            if (kind == 0) {
#pragma unroll
                for (int ai = 0; ai < 2; ++ai)
#pragma unroll
                    for (int m = 0; m < 4; ++m) *(u32x4*)(dst + (size_t)(row0 + ai * HALF + m * 16) * pitch + c0) = pack8(acc[ai][bj][m][0] * ascale, acc[ai][bj][m][1] * ascale);
            } else if (kind == 1) {
#pragma unroll
                for (int ai = 0; ai < 2; ++ai)
#pragma unroll
                    for (int m = 0; m < 4; ++m) { f32x4 a = acc[ai][bj][m][0] * ascale, b = acc[ai][bj][m][1] * ascale;
#pragma unroll
                        for (int i = 0; i < 4; ++i) { a[i] = a[i] * e_sig(a[i]); b[i] = b[i] * e_sig(b[i]); }
                        *(u32x4*)(dst + (size_t)(row0 + ai * HALF + m * 16) * pitch + c0) = pack8(a, b); }
            } else if (kind == 2) {
#pragma unroll
                for (int ai = 0; ai < 2; ++ai)
#pragma unroll
                    for (int m = 0; m < 4; ++m) { f32x4 a = acc[ai][bj][m][0] * ascale, b = acc[ai][bj][m][1] * ascale;
#pragma unroll
                        for (int i = 0; i < 4; ++i) { a[i] = e_sig(a[i]); b[i] = e_sig(b[i]); }
                        *(u32x4*)(dst + (size_t)(row0 + ai * HALF + m * 16) * pitch + c0) = pack8(a, b); }
            } else {
                const f32x4 lb0 = *(const f32x4*)(lbv + dir * 512 + c0), lb1 = *(const f32x4*)(lbv + dir * 512 + c0 + 4);
                float* lf = LF + (size_t)dir * 16384 * 512;
#pragma unroll
                for (int ai = 0; ai < 2; ++ai)
#pragma unroll
                    for (int m = 0; m < 4; ++m) { const f32x4 a = acc[ai][bj][m][0] * ascale, b = acc[ai][bj][m][1] * ascale; f32x4 la, lb_, ka, kb;
#pragma unroll
                        for (int i = 0; i < 4; ++i) {
                            const float sa = e_sig(a[i]), sb = e_sig(b[i]);
                            la[i] = __logf(fmaxf(lb0[i] + (1.0f - lb0[i]) * sa, 1e-6f)); ka[i] = (1.0f - lb0[i]) * (1.0f - sa);
                            lb_[i] = __logf(fmaxf(lb1[i] + (1.0f - lb1[i]) * sb, 1e-6f)); kb[i] = (1.0f - lb1[i]) * (1.0f - sb); }
                        const size_t o = (size_t)(row0 + ai * HALF + m * 16) * 512 + c0;
                        *(f32x4*)(lf + o) = la; *(f32x4*)(lf + o + 4) = lb_;
                        *(u32x4*)(dst + o) = pack8(ka, kb); }
            }
        }
    }
};
struct EpiBrA {
    static constexpr bool PERM = true, AFTER_DRAIN = false, CHAIN = false;
    const bf16_t* GG; float* MP;
    __device__ __forceinline__ void operator()(const f32x4 (&acc)[2][2][4][2], const Unit& u, int wr, int wc, int fr, int fq) const {
        const int row0 = u.pm * BM + wr * 64 + fr, col0 = u.pn * BM + wc * 32 + 8 * fq;
#pragma unroll
        for (int ai = 0; ai < 2; ++ai)
#pragma unroll
            for (int m = 0; m < 4; ++m) { const size_t r = (size_t)(row0 + ai * HALF + m * 16);
#pragma unroll
                for (int bj = 0; bj < 2; ++bj) { const int c = col0 + bj * HALF; const u32x4 g = *(const u32x4*)(GG + r * 2048 + c);
                    f32x4 a = acc[ai][bj][m][0], b = acc[ai][bj][m][1];
                    a[0] *= e_bflo(g.x); a[1] *= e_bfhi(g.x); a[2] *= e_bflo(g.y); a[3] *= e_bfhi(g.y); b[0] *= e_bflo(g.z); b[1] *= e_bfhi(g.z); b[2] *= e_bflo(g.w); b[3] *= e_bfhi(g.w);
                    *(f32x4*)(MP + r * 1024 + c) = a; *(f32x4*)(MP + r * 1024 + c + 4) = b; } }
    }
};
struct EpiBrH {
    static constexpr bool PERM = true, AFTER_DRAIN = false, CHAIN = false;
    const bf16_t* GG; const float* MP; bf16_t* MG;
    __device__ __forceinline__ void operator()(const f32x4 (&acc)[2][2][4][2], const Unit& u, int wr, int wc, int fr, int fq) const {
        const int row0 = u.pm * BM + wr * 64 + fr, col0 = u.pn * BM + wc * 32 + 8 * fq;
#pragma unroll
        for (int ai = 0; ai < 2; ++ai)
#pragma unroll
            for (int m = 0; m < 4; ++m) { const size_t r = (size_t)(row0 + ai * HALF + m * 16);
#pragma unroll
                for (int bj = 0; bj < 2; ++bj) { const int c = col0 + bj * HALF; const u32x4 g = *(const u32x4*)(GG + r * 2048 + 1024 + c);
                    f32x4 a = acc[ai][bj][m][0], b = acc[ai][bj][m][1]; const f32x4 pa = *(const f32x4*)(MP + r * 1024 + c), pb = *(const f32x4*)(MP + r * 1024 + c + 4);
                    a[0] = pa[0] + a[0] * e_bflo(g.x); a[1] = pa[1] + a[1] * e_bfhi(g.x); a[2] = pa[2] + a[2] * e_bflo(g.y); a[3] = pa[3] + a[3] * e_bfhi(g.y);
                    b[0] = pb[0] + b[0] * e_bflo(g.z); b[1] = pb[1] + b[1] * e_bfhi(g.z); b[2] = pb[2] + b[2] * e_bflo(g.w); b[3] = pb[3] + b[3] * e_bfhi(g.w);
                    *(u32x4*)(MG + r * 1024 + c) = pack8(a, b); } }
    }
};
struct EpiMerge {
    static constexpr bool PERM = true, AFTER_DRAIN = false, CHAIN = true;
    const bf16_t* GG; bf16_t* MG;
    __device__ __forceinline__ void mid(f32x4 (&acc)[2][2][4][2], const Unit& u, int wr, int wc, int fr, int fq) const {
        const int row0 = u.pm * BM + wr * 64 + fr, col0 = u.pn * BM + wc * 32 + 8 * fq;
#pragma unroll
        for (int ai = 0; ai < 2; ++ai)
#pragma unroll
            for (int m = 0; m < 4; ++m) { const size_t r = (size_t)(row0 + ai * HALF + m * 16);
#pragma unroll
                for (int bj = 0; bj < 2; ++bj) { const int c = col0 + bj * HALF; const u32x4 g0 = *(const u32x4*)(GG + r * 2048 + c), g1 = *(const u32x4*)(GG + r * 2048 + 1024 + c);
                    f32x4& a = acc[ai][bj][m][0]; f32x4& b = acc[ai][bj][m][1];
                    a[0] *= e_bflo(g0.x) * __builtin_amdgcn_rcpf(e_bflo(g1.x)); a[1] *= e_bfhi(g0.x) * __builtin_amdgcn_rcpf(e_bfhi(g1.x));
                    a[2] *= e_bflo(g0.y) * __builtin_amdgcn_rcpf(e_bflo(g1.y)); a[3] *= e_bfhi(g0.y) * __builtin_amdgcn_rcpf(e_bfhi(g1.y));
                    b[0] *= e_bflo(g0.z) * __builtin_amdgcn_rcpf(e_bflo(g1.z)); b[1] *= e_bfhi(g0.z) * __builtin_amdgcn_rcpf(e_bfhi(g1.z));
                    b[2] *= e_bflo(g0.w) * __builtin_amdgcn_rcpf(e_bflo(g1.w)); b[3] *= e_bfhi(g0.w) * __builtin_amdgcn_rcpf(e_bfhi(g1.w)); } }
    }
    __device__ __forceinline__ void operator()(const f32x4 (&acc)[2][2][4][2], const Unit& u, int wr, int wc, int fr, int fq) const {
        const int row0 = u.pm * BM + wr * 64 + fr, col0 = u.pn * BM + wc * 32 + 8 * fq;
#pragma unroll
        for (int ai = 0; ai < 2; ++ai)
#pragma unroll
            for (int m = 0; m < 4; ++m) { const size_t r = (size_t)(row0 + ai * HALF + m * 16);
#pragma unroll
                for (int bj = 0; bj < 2; ++bj) { const int c = col0 + bj * HALF; const u32x4 g = *(const u32x4*)(GG + r * 2048 + 1024 + c);
                    f32x4 a = acc[ai][bj][m][0], b = acc[ai][bj][m][1];
                    a[0] *= e_bflo(g.x); a[1] *= e_bfhi(g.x); a[2] *= e_bflo(g.y); a[3] *= e_bfhi(g.y); b[0] *= e_bflo(g.z); b[1] *= e_bfhi(g.z); b[2] *= e_bflo(g.w); b[3] *= e_bfhi(g.w);
                    *(u32x4*)(MG + r * 1024 + c) = pack8(a, b); } }
    }
};
struct OffOrder {
    StaticOrder So; int off;
    __device__ bool next(int i, Unit& u) const { if (!So.next(i, u)) return false; u.pb = u.pn; u.pn += off; return true; }
    __device__ __forceinline__ void a_ready(const Unit&) const {}
    __device__ __forceinline__ void done(const Unit&) const {}
};
struct ChainOrder {
    StaticOrder So;
    __device__ bool next(int i, Unit& u) const { if (!So.next(i >> 1, u)) return false; u.sel = i & 1; return true; }
    __device__ __forceinline__ void a_ready(const Unit&) const {}
    __device__ __forceinline__ void done(const Unit&) const {}
};
struct EpiOut {
    static constexpr bool PERM = true, AFTER_DRAIN = false, CHAIN = false;
    const float* xin; const float* gate; float* X1;
    __device__ __forceinline__ void operator()(const f32x4 (&acc)[2][2][4][2], const Unit& u, int wr, int wc, int fr, int fq) const {
        const int row0 = u.pm * BM + wr * 64 + fr, col0 = u.pn * BM + wc * 32 + 8 * fq;
#pragma unroll
        for (int bj = 0; bj < 2; ++bj) { const int c = col0 + bj * HALF; const f32x4 g0 = *(const f32x4*)(gate + c), g1 = *(const f32x4*)(gate + c + 4);
#pragma unroll
            for (int ai = 0; ai < 2; ++ai)
#pragma unroll
                for (int m = 0; m < 4; ++m) { const size_t o = (size_t)(row0 + ai * HALF + m * 16) * 1024 + c;
                    *(f32x4*)(X1 + o) = *(const f32x4*)(xin + o) + g0 * acc[ai][bj][m][0]; *(f32x4*)(X1 + o + 4) = *(const f32x4*)(xin + o + 4) + g1 * acc[ai][bj][m][1]; } }
    }
};
struct EpiGU {
    static constexpr bool PERM = true, AFTER_DRAIN = false, CHAIN = false;
    bf16_t* HID;
    __device__ __forceinline__ void operator()(const f32x4 (&acc)[2][2][4][2], const Unit& u, int wr, int wc, int fr, int fq) const {
        const int row0 = u.pm * BM + wr * 64 + fr, col0 = u.pn * HALF + wc * 32 + 8 * fq;
#pragma unroll
        for (int ai = 0; ai < 2; ++ai)
#pragma unroll
            for (int m = 0; m < 4; ++m) { f32x4 a = acc[ai][0][m][0], b = acc[ai][0][m][1]; const f32x4 ua = acc[ai][1][m][0], ub = acc[ai][1][m][1];
#pragma unroll
                for (int i = 0; i < 4; ++i) { a[i] = a[i] * e_sig(a[i]) * ua[i]; b[i] = b[i] * e_sig(b[i]) * ub[i]; }
                *(u32x4*)(HID + (size_t)(row0 + ai * HALF + m * 16) * 2048 + col0) = pack8(a, b); }
    }
};
struct EpiGU8 {
    static constexpr bool PERM = true, AFTER_DRAIN = false, CHAIN = false;
    unsigned char* HID;
    __device__ __forceinline__ void operator()(const f32x4 (&acc)[2][2][4][2], const Unit& u, int wr, int wc, int fr, int fq) const {
        const int row0 = u.pm * BM + wr * 64 + fr, col0 = u.pn * HALF + wc * 32 + 8 * fq;
#pragma unroll
        for (int ai = 0; ai < 2; ++ai)
#pragma unroll
            for (int m = 0; m < 4; ++m) { f32x4 a = acc[ai][0][m][0], b = acc[ai][0][m][1]; const f32x4 ua = acc[ai][1][m][0], ub = acc[ai][1][m][1];
#pragma unroll
                for (int i = 0; i < 4; ++i) { const float ga = a[i] * 0.015625f, gb = b[i] * 0.015625f; a[i] = ga * e_sig(ga) * (ua[i] * 0.015625f); b[i] = gb * e_sig(gb) * (ub[i] * 0.015625f); }
                *(u32x2*)(HID + (size_t)(row0 + ai * HALF + m * 16) * 2048 + col0) = pack8_fp8(a, b); }
    }
};
struct EpiDown {
    static constexpr bool PERM = true, AFTER_DRAIN = false, CHAIN = false;
    bf16_t* YE; const float* topw; float wscale;
    __device__ __forceinline__ void operator()(const f32x4 (&acc)[2][2][4][2], const Unit& u, int wr, int wc, int fr, int fq) const {
        const int row0 = u.pm * BM + wr * 64 + fr, col0 = u.pn * BM + wc * 32 + 8 * fq;
#pragma unroll
        for (int ai = 0; ai < 2; ++ai)
#pragma unroll
            for (int m = 0; m < 4; ++m) { const int r = row0 + ai * HALF + m * 16; const float w = topw[r] * wscale;
#pragma unroll
                for (int bj = 0; bj < 2; ++bj) *(u32x4*)(YE + (size_t)r * 1024 + col0 + bj * HALF) = pack8(acc[ai][bj][m][0] * w, acc[ai][bj][m][1] * w); }
    }
};
struct GroupOrder {
    int nNe, nwg, G, c;
    __device__ void init(int nNe_, int G_, int c_) { nNe = nNe_; nwg = 16 * 8 * nNe_; G = G_; c = c_; }
    __device__ bool next(int i, Unit& u) const {
        const long L = (long)i * G + c; if (L >= nwg) return false;
        int wgid = (int)L; { const int q = nwg / NXCD, xcd = wgid % NXCD, off = wgid / NXCD; wgid = xcd * q + off; }
        const int per = 8 * nNe, e = wgid / per, w = wgid % per;
        u.pm = e * 8 + (w & 7); u.pn = w >> 3; u.pb = e * nNe + u.pn; u.sel = 0; return true;
    }
    __device__ __forceinline__ void a_ready(const Unit&) const {}
    __device__ __forceinline__ void done(const Unit&) const {}
};

template <class Epi, class Sched, bool ALIGN_EPI = false, bool SP2 = false, bool FP8 = false, bool GATHER = false>
__device__ __forceinline__ void gemm_phase(PG8_LAS unsigned char* lds, const Gemm g, const Sched& S, const Epi& E, int wave_) {
    const int tid_ = wave_ * 64 + lane_id_opaque();
    const int tid = tid_, wid = __builtin_amdgcn_readfirstlane(tid >> 6), lane = tid & 63, wr = wid >> 2, wc = wid & 3, fr = lane & 15, fq = lane >> 4;
    int K_ = g.K; asm volatile("" : "+s"(K_));
    const int K = K_, nt = K / BK;
    unsigned voffA[2], voffB[2];
#pragma unroll
    for (int i = 0; i < 2; ++i) { int R, C; stage_rc(tid * 16 + i * 8192, R, C); const int Rb = Epi::PERM ? ((R & ~31) + perm32(R & 31)) : R;
        voffA[i] = (unsigned)(R * K + C) * 2u; voffB[i] = (unsigned)(Rb * K + C) * 2u; }
    unsigned vA[2][2] = {{0u, 0u}, {0u, 0u}}, vN[2][2] = {{0u, 0u}, {0u, 0u}};
#define PG8_GOFF(dst, u_) do { if constexpr (GATHER) { _Pragma("unroll") for (int h_ = 0; h_ < 2; ++h_) _Pragma("unroll") for (int i_ = 0; i_ < 2; ++i_) \
        { int R_, C_; stage_rc(tid * 16 + i_ * 8192, R_, C_);     \
          dst[h_][i_] = (unsigned)((const __attribute__((address_space(1))) int*)g.rowidx)[(u_).pm * BM + h_ * HALF + R_] * (unsigned)(K * 2) + (unsigned)C_ * 2u; } } } while (0)
    const size_t kstep = (size_t)(BK * 2);
    const size_t hstep = (size_t)HALF * K * 2;
    const size_t tstep = 2 * hstep;
    const unsigned ldsw = (unsigned)wid * 1024u;
    const int aoff = lds_byte(wr * 64 + fr, fq * 8), boff = lds_byte(wc * 32 + fr, fq * 8);
#define PG8_SA(b, h) (((b) * 2 + (h)) * HTB)
#define PG8_SB(b, h) ((4 + (b) * 2 + (h)) * HTB)
#define PG8_STAGE(bufoff, gbase, voff) do { _Pragma("unroll") for (int _i = 0; _i < 2; ++_i) \
        __builtin_amdgcn_global_load_lds((const unsigned*)((const char*)(gbase) + (voff)[_i]), (PG8_LAS unsigned*)(lds + (bufoff) + ldsw + _i * 8192), 16, 0, 0); } while (0)
#define PG8_STAGE_A(bufoff, gptr, half, nsel) do { if constexpr (GATHER) { unsigned vs_[2]; vs_[0] = (nsel) ? vN[half][0] : vA[half][0]; vs_[1] = (nsel) ? vN[half][1] : vA[half][1]; PG8_STAGE(bufoff, gptr, vs_); } \
        else { PG8_STAGE(bufoff, (gptr) + (half) * hstep, voffA); } } while (0)
#define PG8_LDA(dst, b, h) do { if constexpr (FP8) { _Pragma("unroll") for (int m = 0; m < 4; ++m) dst##8[m] = pg8_cat(*(const PG8_LAS bf16x8*)(lds + PG8_SA(b, h) + aoff + m * 2048), *(const PG8_LAS bf16x8*)(lds + PG8_SA(b, h) + aoff + m * 2048 + 1024)); } else { \
        _Pragma("unroll") for (int m = 0; m < 4; ++m) _Pragma("unroll") for (int k = 0; k < 2; ++k) dst[m][k] = *(const PG8_LAS bf16x8*)(lds + PG8_SA(b, h) + aoff + m * 2048 + k * 1024); } } while (0)
#define PG8_LDB(dst, b, h) do { if constexpr (FP8) { _Pragma("unroll") for (int n = 0; n < 2; ++n) dst##8[n] = pg8_cat(*(const PG8_LAS bf16x8*)(lds + PG8_SB(b, h) + boff + n * 2048), *(const PG8_LAS bf16x8*)(lds + PG8_SB(b, h) + boff + n * 2048 + 1024)); } else { \
        _Pragma("unroll") for (int n = 0; n < 2; ++n) _Pragma("unroll") for (int k = 0; k < 2; ++k) dst[n][k] = *(const PG8_LAS bf16x8*)(lds + PG8_SB(b, h) + boff + n * 2048 + k * 1024); } } while (0)
#define PG8_MMA(ai, bj, At, Bt) do { __builtin_amdgcn_s_setprio(1); if constexpr (FP8) { \
        _Pragma("unroll") for (int m = 0; m < 4; ++m) _Pragma("unroll") for (int n = 0; n < 2; ++n) \
        asm volatile("v_mfma_f32_16x16x128_f8f6f4 %0, %1, %2, %0" : "+v"(acc[ai][bj][m][n]) : "v"(Bt##8[n]), "v"(At##8[m])); } else {     \
        _Pragma("unroll") for (int m = 0; m < 4; ++m) _Pragma("unroll") for (int n = 0; n < 2; ++n) _Pragma("unroll") for (int k = 0; k < 2; ++k) \
        acc[ai][bj][m][n] = __builtin_amdgcn_mfma_f32_16x16x32_bf16(Bt[n][k], At[m][k], acc[ai][bj][m][n], 0, 0, 0); } __builtin_amdgcn_s_setprio(0); } while (0)
#define PG8_WAIT_V(n) asm volatile("s_waitcnt vmcnt(" #n ")" ::: "memory")
#define PG8_WAIT_L(n) asm volatile("s_waitcnt lgkmcnt(" #n ")" ::: "memory")
#define PG8_BAR __builtin_amdgcn_s_barrier()
#define PG8_SCHED __builtin_amdgcn_sched_barrier(0)
    Unit cur, nxt; int ui = 0;
    if (!S.next(0, cur)) return;
    f32x4 acc[2][2][4][2];
#pragma unroll
    for (int a = 0; a < 2; ++a)
#pragma unroll
        for (int b = 0; b < 2; ++b)
#pragma unroll
            for (int m = 0; m < 4; ++m)
#pragma unroll
                for (int n = 0; n < 2; ++n) acc[a][b][m][n] = (f32x4){0.f, 0.f, 0.f, 0.f};
    bf16x8 At[4][2], B0[2][2], B1[2][2]; i32x8_ At8[4], B08[2], B18[2];
    const char* cA = GATHER ? (const char*)g.A : (const char*)(cur.sel ? g.A2 : g.A) + (size_t)cur.pm * tstep; PG8_GOFF(vA, cur); const char* cB = (const char*)(cur.sel ? g.Bt2 : g.Bt) + (size_t)cur.pb * tstep;
    S.a_ready(cur);
    if constexpr (SP2) {
        PG8_STAGE(PG8_SB(0, 0), cB, voffB); PG8_STAGE(PG8_SB(0, 1), cB + hstep, voffB); PG8_STAGE_A(PG8_SA(0, 0), cA, 0, false); PG8_STAGE_A(PG8_SA(0, 1), cA, 1, false);
        if (wr == 1) PG8_BAR;
        PG8_WAIT_V(2); PG8_BAR;
        PG8_STAGE(PG8_SB(1, 0), cB + kstep, voffB); PG8_STAGE_A(PG8_SA(1, 0), cA + kstep, 0, false); PG8_STAGE(PG8_SB(1, 1), cB + hstep + kstep, voffB);
        PG8_WAIT_V(6); PG8_BAR;
    } else {
        PG8_STAGE(PG8_SB(0, 0), cB, voffB); PG8_STAGE_A(PG8_SA(0, 0), cA, 0, false); PG8_STAGE(PG8_SB(0, 1), cB + hstep, voffB); PG8_STAGE_A(PG8_SA(0, 1), cA, 1, false);
        if (wr == 1) PG8_BAR;
        PG8_WAIT_V(4); PG8_BAR;
        PG8_STAGE(PG8_SB(1, 0), cB + kstep, voffB); PG8_STAGE_A(PG8_SA(1, 0), cA + kstep, 0, false); PG8_STAGE(PG8_SB(1, 1), cB + hstep + kstep, voffB);
        PG8_WAIT_V(6); PG8_BAR;
    }
    for (;;) {
        const bool has_next = S.next(ui + 1, nxt);
        if (has_next) PG8_GOFF(vN, nxt); else { if constexpr (GATHER) { vN[0][0] = vA[0][0]; vN[0][1] = vA[0][1]; vN[1][0] = vA[1][0]; vN[1][1] = vA[1][1]; } }
        const char* nA = GATHER ? (const char*)g.A : has_next ? (const char*)(nxt.sel ? g.A2 : g.A) + (size_t)nxt.pm * tstep : cA; const char* nB = has_next ? (const char*)(nxt.sel ? g.Bt2 : g.Bt) + (size_t)nxt.pb * tstep : cB;
#pragma unroll 1
        for (int t = 0; t < nt; t += 2) {
            const bool last = (t == nt - 2);
            const char* a1 = cA + (size_t)(t + 1) * kstep;
            const char* a2 = last ? nA : cA + (size_t)(t + 2) * kstep; const char* b2 = last ? nB : cB + (size_t)(t + 2) * kstep;
            const char* a3 = a2 + kstep; const char* b3 = b2 + kstep;
            if (last && has_next) S.a_ready(nxt);
            if constexpr (SP2) {
            PG8_LDB(B0, 0, 0); PG8_LDB(B1, 0, 1); PG8_SCHED; PG8_LDA(At, 0, 0); PG8_STAGE_A(PG8_SA(1, 1), a1, 1, false);
            PG8_WAIT_V(8); PG8_WAIT_L(0); PG8_BAR; PG8_MMA(0, 0, At, B0); PG8_MMA(0, 1, At, B1); PG8_BAR; PG8_SCHED;
            PG8_LDA(At, 0, 1); PG8_STAGE(PG8_SB(0, 0), b2, voffB); PG8_STAGE(PG8_SB(0, 1), b2 + hstep, voffB); PG8_STAGE_A(PG8_SA(0, 0), a2, 0, last);
            PG8_WAIT_V(8); PG8_WAIT_L(0); PG8_BAR; PG8_MMA(1, 0, At, B0); PG8_MMA(1, 1, At, B1); PG8_BAR; PG8_SCHED;
            PG8_LDB(B0, 1, 0); PG8_LDB(B1, 1, 1); PG8_SCHED; PG8_LDA(At, 1, 0); PG8_STAGE_A(PG8_SA(0, 1), a2, 1, last);
            PG8_WAIT_V(8); PG8_WAIT_L(0); PG8_BAR; PG8_MMA(0, 0, At, B0); PG8_MMA(0, 1, At, B1); PG8_BAR; PG8_SCHED;
            PG8_LDA(At, 1, 1); PG8_STAGE(PG8_SB(1, 0), b3, voffB); PG8_STAGE(PG8_SB(1, 1), b3 + hstep, voffB); PG8_STAGE_A(PG8_SA(1, 0), a3, 0, last);
            PG8_WAIT_V(8); PG8_WAIT_L(0); PG8_BAR; PG8_MMA(1, 0, At, B0); PG8_MMA(1, 1, At, B1); PG8_BAR; PG8_SCHED;
            } else {
            PG8_LDB(B0, 0, 0); PG8_SCHED; PG8_LDA(At, 0, 0); PG8_STAGE_A(PG8_SA(1, 1), a1, 1, false);
            PG8_WAIT_L(8); PG8_BAR; PG8_WAIT_L(0); PG8_MMA(0, 0, At, B0); PG8_BAR; PG8_SCHED;
            PG8_LDB(B1, 0, 1); PG8_STAGE(PG8_SB(0, 0), b2, voffB);
            PG8_BAR; PG8_WAIT_L(0); PG8_MMA(0, 1, At, B1); PG8_BAR;
            PG8_LDA(At, 0, 1); PG8_STAGE_A(PG8_SA(0, 0), a2, 0, last);
            PG8_BAR; PG8_WAIT_L(0); PG8_MMA(1, 0, At, B0); PG8_BAR; PG8_SCHED;
            PG8_STAGE(PG8_SB(0, 1), b2 + hstep, voffB);
            PG8_WAIT_V(6); PG8_BAR; PG8_MMA(1, 1, At, B1); PG8_BAR;
            PG8_LDB(B0, 1, 0); PG8_SCHED; PG8_LDA(At, 1, 0); PG8_STAGE_A(PG8_SA(0, 1), a2, 1, last);
            PG8_WAIT_L(8); PG8_BAR; PG8_WAIT_L(0); PG8_MMA(0, 0, At, B0); PG8_BAR; PG8_SCHED;
            PG8_LDB(B1, 1, 1); PG8_STAGE(PG8_SB(1, 0), b3, voffB);
            PG8_BAR; PG8_WAIT_L(0); PG8_MMA(0, 1, At, B1); PG8_BAR;
            PG8_LDA(At, 1, 1); PG8_STAGE_A(PG8_SA(1, 0), a3, 0, last);
            PG8_BAR; PG8_WAIT_L(0); PG8_MMA(1, 0, At, B0); PG8_BAR; PG8_SCHED;
            PG8_STAGE(PG8_SB(1, 1), b3 + hstep, voffB);
            PG8_WAIT_V(6); PG8_BAR; PG8_MMA(1, 1, At, B1); PG8_BAR;
            }
        }
        if constexpr (FP8) asm volatile("s_nop 15\n\ts_nop 7" ::: "memory");
        if constexpr (ALIGN_EPI) { if (wr == 0) PG8_BAR; }
        bool fin = true; if constexpr (Epi::CHAIN) fin = (cur.sel != 0);
        if constexpr (!Epi::AFTER_DRAIN) { const int le_ = lane_id_opaque(), fre = le_ & 15, fqe = le_ >> 4;
            if (fin) E(acc, cur, wr, wc, fre, fqe); else { if constexpr (Epi::CHAIN) E.mid(acc, cur, wr, wc, fre, fqe); } S.done(cur); }
        if (!has_next) break;
        if (fin)
#pragma unroll
        for (int a = 0; a < 2; ++a)
#pragma unroll
            for (int b = 0; b < 2; ++b)
#pragma unroll
                for (int m = 0; m < 4; ++m)
#pragma unroll
                    for (int n = 0; n < 2; ++n) acc[a][b][m][n] = (f32x4){0.f, 0.f, 0.f, 0.f};
        cur = nxt; cA = nA; cB = nB; ++ui;
        if constexpr (GATHER) { vA[0][0] = vN[0][0]; vA[0][1] = vN[0][1]; vA[1][0] = vN[1][0]; vA[1][1] = vN[1][1]; }
        if constexpr (ALIGN_EPI) { if (wr == 1) PG8_BAR; }
    }
    PG8_WAIT_V(0);
    if constexpr (!ALIGN_EPI) { if (wr == 0) PG8_BAR; }
    PG8_BAR;
    if constexpr (Epi::AFTER_DRAIN) { E.fused(acc, cur, wr, wc, fr, fq, lds, wid, lane); S.done(cur); }
#undef PG8_SA
#undef PG8_STAGE_A
#undef PG8_GOFF
#undef PG8_SB
#undef PG8_STAGE
#undef PG8_LDA
#undef PG8_LDB
#undef PG8_MMA
#undef PG8_WAIT_V
#undef PG8_WAIT_L
#undef PG8_BAR
#undef PG8_SCHED
}
}

#include <hip/hip_bf16.h>
#include <cmath>

namespace attn_body {
using bf16=__hip_bfloat16;
using bf16x8=__attribute__((ext_vector_type(8)))short;
using s16x4=__attribute__((ext_vector_type(4)))short;
using f32x16=__attribute__((ext_vector_type(16)))float;
using u32x4=__attribute__((ext_vector_type(4)))unsigned;
constexpr int NHEAD=8,SEQ=16384,D=64,DMQ=NHEAD*D,DMK=2*D;
constexpr int NW=8,QBLK=32,QB=QBLK*NW,KVBLK=64,NQB=SEQ/QB;
constexpr int ATTN_UNIT_ROWS=QB;
__device__ __forceinline__ int crow(int r,int hi){return (r&3)+8*(r>>2)+4*hi;}
#define SBAR() __builtin_amdgcn_sched_barrier(0)
__device__ __forceinline__ void cmask(f32x16&p0,f32x16&p1,int jb,int qrel,int hi){
  const float NEG=-INFINITY; int kb=64*jb+4*hi;
  #pragma unroll
  for(int r=0;r<16;++r){int kv=kb+(r&3)+8*(r>>2); if(kv>qrel)p0[r]=NEG; if(kv+32>qrel)p1[r]=NEG;}
}

constexpr int NSLOT=3, SLOTB=8192;
constexpr int LDS_K=0, LDS_V=NSLOT*SLOTB, LDS_WS=2*NSLOT*SLOTB, LDS_OST=LDS_WS+NW*64*4, LDS_BYTES=LDS_OST+NW*4096;
constexpr float C2=0.125f*1.4426950408889634f;
__device__ __forceinline__ void glds16(const void*gsrc,unsigned lds_dst){unsigned keep;
  asm volatile("s_mov_b32 %0, m0\n\ts_mov_b32 m0, %2\n\ts_nop 0\n\tglobal_load_lds_dwordx4 %1, off\n\ts_mov_b32 m0, %0":"=&s"(keep):"v"(gsrc),"s"(lds_dst):"memory");}
__device__ __forceinline__ float max3f(float a,float b,float c){float r;asm("v_max3_f32 %0, %1, %2, %3":"=v"(r):"v"(a),"v"(b),"v"(c));return r;}
__device__ __forceinline__ float max2f(float a,float b){float r;asm("v_max_f32_e32 %0, %1, %2":"=v"(r):"v"(a),"v"(b));return r;}
__device__ __forceinline__ float fadd_s(float a,float b){float r;asm("v_add_f32_e32 %0, %1, %2":"=v"(r):"v"(a),"v"(b));return r;}
__device__ __forceinline__ float fsub_s(float a,float b){float r;asm("v_sub_f32_e32 %0, %1, %2":"=v"(r):"v"(a),"v"(b));return r;}
typedef float f32x2_t __attribute__((ext_vector_type(2))); typedef __bf16 bf16x2_t __attribute__((ext_vector_type(2)));
__device__ __forceinline__ unsigned cvtpk_s(float lo,float hi){f32x2_t v={lo,hi};bf16x2_t b=__builtin_convertvector(v,bf16x2_t);return __builtin_bit_cast(unsigned,b);}
#define WAIT_BAR(N) asm volatile("s_waitcnt vmcnt(" #N ") lgkmcnt(0)\n\ts_barrier":::"memory")

__device__ __forceinline__ void qkt(f32x16&p0,f32x16&p1,const char*Kslot,const bf16x8*qr,const f32x16&negm,int r32,int hi){
  const char*kb=Kslot+hi*1024+r32*16;
  #pragma unroll
  for(int d0=0;d0<4;++d0){
    const bf16x8 b0=*reinterpret_cast<const bf16x8*>(kb+d0*2048);
    const bf16x8 b1=*reinterpret_cast<const bf16x8*>(kb+d0*2048+512);
    if(d0==0){p0=__builtin_amdgcn_mfma_f32_32x32x16_bf16(b0,qr[0],negm,0,0,0);p1=__builtin_amdgcn_mfma_f32_32x32x16_bf16(b1,qr[0],negm,0,0,0);}
    else{p0=__builtin_amdgcn_mfma_f32_32x32x16_bf16(b0,qr[d0],p0,0,0,0);p1=__builtin_amdgcn_mfma_f32_32x32x16_bf16(b1,qr[d0],p1,0,0,0);}}
}
typedef __attribute__((address_space(3))) const char* lds_cptr;
typedef short v4i16_t __attribute__((ext_vector_type(4)));
__device__ __forceinline__ void kload8(bf16x8*kf,lds_cptr kp){
  kf[0]=*(const __attribute__((address_space(3))) bf16x8*)(kp);      kf[1]=*(const __attribute__((address_space(3))) bf16x8*)(kp+512);
  kf[2]=*(const __attribute__((address_space(3))) bf16x8*)(kp+2048); kf[3]=*(const __attribute__((address_space(3))) bf16x8*)(kp+2560);
  kf[4]=*(const __attribute__((address_space(3))) bf16x8*)(kp+4096); kf[5]=*(const __attribute__((address_space(3))) bf16x8*)(kp+4608);
  kf[6]=*(const __attribute__((address_space(3))) bf16x8*)(kp+6144); kf[7]=*(const __attribute__((address_space(3))) bf16x8*)(kp+6656);
}
__device__ __forceinline__ void kload2(bf16x8*kf,lds_cptr kp,int j){ kf[2*j]=*(const __attribute__((address_space(3))) bf16x8*)(kp+j*2048); kf[2*j+1]=*(const __attribute__((address_space(3))) bf16x8*)(kp+j*2048+512); }
__device__ __forceinline__ s16x4 vtr(lds_cptr p){ return __builtin_bit_cast(s16x4,__builtin_amdgcn_ds_read_tr16_b64_v4i16((__attribute__((address_space(3))) v4i16_t*)p)); }
__device__ __forceinline__ float rowmax(const f32x16&p0,const f32x16&p1){
  float a=max3f(p0[0],p0[1],p1[0]),b=max3f(p0[2],p0[3],p1[1]);a=max3f(a,p1[2],p1[3]);
  #pragma unroll
  for(int r=4;r<16;r+=4){a=max3f(a,p0[r],p0[r+1]);b=max3f(b,p0[r+2],p0[r+3]);a=max3f(a,p1[r],p1[r+1]);b=max3f(b,p1[r+2],p1[r+3]);}
  const float m=max2f(a,b);
  auto rr=__builtin_amdgcn_permlane32_swap(__float_as_uint(m),__float_as_uint(m),false,false);
  return max2f(__uint_as_float(rr[0]),__uint_as_float(rr[1]));
}
__device__ __forceinline__ void pv(f32x16*o,int vb,bf16x8 pa0,bf16x8 pa1,bf16x8 pa2,bf16x8 pa3){
  #pragma unroll
  for(int d0=0;d0<2;++d0){s16x4 lo[4],hi[4];
    #pragma unroll
    for(int ks=0;ks<4;++ks){
      asm volatile("ds_read_b64_tr_b16 %0,%1 offset:%c2":"=&v"(lo[ks]):"v"(vb),"i"(d0*4096+ks*1024):"memory");
      asm volatile("ds_read_b64_tr_b16 %0,%1 offset:%c2":"=&v"(hi[ks]):"v"(vb),"i"(d0*4096+ks*1024+512):"memory");}
    asm volatile("s_waitcnt lgkmcnt(0)":::"memory");SBAR();
    #define PK(k) (bf16x8){lo[k][0],lo[k][1],lo[k][2],lo[k][3],hi[k][0],hi[k][1],hi[k][2],hi[k][3]}
    o[d0]=__builtin_amdgcn_mfma_f32_32x32x16_bf16(pa0,PK(0),o[d0],0,0,0);
    o[d0]=__builtin_amdgcn_mfma_f32_32x32x16_bf16(pa1,PK(1),o[d0],0,0,0);
    o[d0]=__builtin_amdgcn_mfma_f32_32x32x16_bf16(pa2,PK(2),o[d0],0,0,0);
    o[d0]=__builtin_amdgcn_mfma_f32_32x32x16_bf16(pa3,PK(3),o[d0],0,0,0);
    #undef PK
  }
}

#ifndef ATTN_STORE16
#define ATTN_STORE16(p,v) (*(u32x4*)(p)=(v))
#endif
template<int THRL> __device__ __forceinline__ void attn_unit(int b,int h,int qb,const bf16*Q,const bf16*__restrict__ K,const bf16*__restrict__ V,bf16*O,char*shm,int wave_,float negM){
  const int tid_=wave_*64+lane_id_opaque();
  const int tid=tid_,lane=tid&63,r32=lane&31,hi=lane>>5; const int wid=__builtin_amdgcn_readfirstlane(tid>>6);
  const long rowbase=0; const int q0=qb*QB; (void)b;
  const bf16*Qw=Q+(rowbase+q0+wid*QBLK)*DMQ+h*D;
  const bf16*Kh=K+(h>>2)*D,*Vh=V+(h>>2)*D;
  const unsigned lds0=(unsigned)(uintptr_t)shm;
  float*wsf=(float*)(shm+LDS_WS)+wid*64;
  const bf16*ksrc=Kh+(long)lane*DMK+wid*8;
  const bf16*vsrc=Vh+(long)(16*(wid&3)+(lane>>2))*DMK+(wid>>2)*32+(lane&3)*8;
  const unsigned kdst=lds0+LDS_K+wid*1024, vdst=lds0+LDS_V+wid*1024;
  #define DMA_K(t,slot) glds16(ksrc+(long)(t)*KVBLK*DMK,(unsigned)__builtin_amdgcn_readfirstlane(kdst+(slot)))
  #define DMA_V(t,slot) glds16(vsrc+(long)(t)*KVBLK*DMK,(unsigned)__builtin_amdgcn_readfirstlane(vdst+(slot)))
  const int vb0=(int)(lds0+LDS_V)+((lane>>4)&1)*32+(lane&3)*8+(4*hi+((lane&15)>>2))*64;
  const char*Kbase=shm+LDS_K; bf16x8 kf[8];
  const lds_cptr shm3=(lds_cptr)shm; const lds_cptr kp0=shm3+LDS_K+hi*1024+r32*16; const lds_cptr vp0=shm3+LDS_V+((lane>>4)&1)*32+(lane&3)*8+(4*hi+((lane&15)>>2))*64;
  const int NT=SEQ/KVBLK;
  DMA_K(0,0);DMA_V(0,0);DMA_K(1,SLOTB);
  bf16x8 qr[4];
  #pragma unroll
  for(int d0=0;d0<4;++d0)qr[d0]=*reinterpret_cast<const bf16x8*>(&Qw[(long)r32*DMQ+d0*16+hi*8]);
  float l_reg=0.f;f32x16 o[2];o[0]=f32x16{};o[1]=f32x16{};f32x16 negm;
  #pragma unroll
  for(int r=0;r<16;++r)negm[r]=negM;
  asm volatile("":"+v"(negm));
  const int qrel=wid*QBLK+r32; (void)qrel;
  #define CMASK(P0,P1,t) do{}while(0)
  #define START(P0,P1) do{ _Pragma("unroll") for(int r=0;r<16;++r)P0[r]=__builtin_amdgcn_exp2f(P0[r]); }while(0)
  #define RESC() do{}while(0)
  f32x16 pA0,pA1,pB0,pB1;
  int sl_prev=0,sl_cur=0,sl_next=SLOTB;
  #define ROT() do{sl_prev=sl_cur;sl_cur=sl_next;sl_next=(sl_next==(NSLOT-1)*SLOTB)?0:sl_next+SLOTB;}while(0)
  DMA_K(2,2*SLOTB);
  WAIT_BAR(3);
  qkt(pA0,pA1,Kbase,qr,negm,r32,hi);asm volatile("s_nop 15\n\ts_nop 7":"+v"(pA0),"+v"(pA1));CMASK(pA0,pA1,0);
  START(pA0,pA1);
  _Pragma("unroll") for(int r=0;r<16;++r)pA1[r]=__builtin_amdgcn_exp2f(pA1[r]);
  WAIT_BAR(0);
  DMA_K(3,0);DMA_V(1,SLOTB);
  ROT();
  kload8(kf,kp0+sl_cur);
  WAIT_BAR(2);
  s16x4 vlo[8],vhi[8]; u32x4 pw0,pw1,pw2,pw3;
  #define PKW(P,B) cvtpk_s(P[B],P[B+1])
  #define PAF(k) __builtin_bit_cast(bf16x8,pw##k)
  #define VFR(i) (bf16x8){vlo[i][0],vlo[i][1],vlo[i][2],vlo[i][3],vhi[i][0],vhi[i][1],vhi[i][2],vhi[i][3]}
  #define PIN(x) asm volatile("":"+v"(x))
  #define MX3(a,b,c) __builtin_fmaxf(__builtin_fmaxf((a),(b)),(c))
  #define GAPA(MF,A0,A1,A2,A3,W0,W1,PW) do{ MF; sacc+=A0; sacc+=A1; sacc+=A2; sacc+=A3; PIN(sacc); W0; W1; PIN(PW); SBAR(); }while(0)
  #define EX(v) __builtin_amdgcn_exp2f(v)
  #define GAPB(MF,X,B) do{ MF; X[B]=EX(X[B]); X[B+1]=EX(X[B+1]); X[B+2]=EX(X[B+2]); X[B+3]=EX(X[B+3]); PIN(X); SBAR(); }while(0)
  #define VRD(i) do{ vlo[i]=vtr(vp_+(((i)>>2)*4096+((i)&3)*1024)); vhi[i]=vtr(vp_+(((i)>>2)*4096+((i)&3)*1024+512)); }while(0)
  #define KRD(G,j) do{ if(G){ kload2(kf,kp0+sl_next,j); SBAR(); } }while(0)
  #define STEP(C0,C1,P0,P1,t,GK,GV,GL) do{ SBAR(); \
    const lds_cptr vp_=vp0+sl_prev; \
    VRD(0); SBAR(); float sacc=(P0[0]+P0[1]); \
    GAPA(C0=__builtin_amdgcn_mfma_f32_32x32x16_bf16(kf[0],qr[0],negm,0,0,0), P0[2],P0[3],P0[4],P0[5],     pw0[0]=PKW(P0,0), pw0[1]=PKW(P0,2), pw0); \
    VRD(4); SBAR(); GAPA(C1=__builtin_amdgcn_mfma_f32_32x32x16_bf16(kf[1],qr[0],negm,0,0,0), P0[6],P0[7],P0[8],P0[9],     pw0[2]=PKW(P0,4), pw0[3]=PKW(P0,6), pw0); \
    VRD(1); SBAR(); GAPA(C0=__builtin_amdgcn_mfma_f32_32x32x16_bf16(kf[2],qr[1],C0,0,0,0),   P0[10],P0[11],P0[12],P0[13], pw1[0]=PKW(P0,8), pw1[1]=PKW(P0,10), pw1); \
    VRD(5); SBAR(); GAPA(C1=__builtin_amdgcn_mfma_f32_32x32x16_bf16(kf[3],qr[1],C1,0,0,0),   P0[14],P0[15],P1[0],P1[1],   pw1[2]=PKW(P0,12),pw1[3]=PKW(P0,14), pw1); \
    VRD(2); SBAR(); GAPA(C0=__builtin_amdgcn_mfma_f32_32x32x16_bf16(kf[4],qr[2],C0,0,0,0),   P1[2],P1[3],P1[4],P1[5],     pw2[0]=PKW(P1,0), pw2[1]=PKW(P1,2), pw2); \
    VRD(6); SBAR(); GAPA(C1=__builtin_amdgcn_mfma_f32_32x32x16_bf16(kf[5],qr[2],C1,0,0,0),   P1[6],P1[7],P1[8],P1[9],     pw2[2]=PKW(P1,4), pw2[3]=PKW(P1,6), pw2); \
    VRD(3); SBAR(); GAPA(C0=__builtin_amdgcn_mfma_f32_32x32x16_bf16(kf[6],qr[3],C0,0,0,0),   P1[10],P1[11],P1[12],P1[13], pw3[0]=PKW(P1,8), pw3[1]=PKW(P1,10), pw3); \
    VRD(7); SBAR(); GAPA(C1=__builtin_amdgcn_mfma_f32_32x32x16_bf16(kf[7],qr[3],C1,0,0,0),   P1[14],P1[15],0.f,0.f,       pw3[2]=PKW(P1,12),pw3[3]=PKW(P1,14), pw3); \
    l_reg+=sacc; \
    if(GK){DMA_K((t)+3,sl_cur);} if(GV){DMA_V((t)+1,sl_next);} \
    CMASK(C0,C1,t); \
    SBAR(); \
    GAPB(o[0]=__builtin_amdgcn_mfma_f32_32x32x16_bf16(PAF(0),VFR(0),o[0],0,0,0), C0,0); \
    GAPB(o[1]=__builtin_amdgcn_mfma_f32_32x32x16_bf16(PAF(0),VFR(4),o[1],0,0,0), C0,4); \
    KRD(GL,0); GAPB(o[0]=__builtin_amdgcn_mfma_f32_32x32x16_bf16(PAF(1),VFR(1),o[0],0,0,0), C0,8); \
    KRD(GL,1); GAPB(o[1]=__builtin_amdgcn_mfma_f32_32x32x16_bf16(PAF(1),VFR(5),o[1],0,0,0), C0,12); \
    KRD(GL,2); GAPB(o[0]=__builtin_amdgcn_mfma_f32_32x32x16_bf16(PAF(2),VFR(2),o[0],0,0,0), C1,0); \
    KRD(GL,3); GAPB(o[1]=__builtin_amdgcn_mfma_f32_32x32x16_bf16(PAF(2),VFR(6),o[1],0,0,0), C1,4); \
    GAPB(o[0]=__builtin_amdgcn_mfma_f32_32x32x16_bf16(PAF(3),VFR(3),o[0],0,0,0), C1,8); \
    GAPB(o[1]=__builtin_amdgcn_mfma_f32_32x32x16_bf16(PAF(3),VFR(7),o[1],0,0,0), C1,12); \
    }while(0)
  int t=1;
  #undef CMASK
  #define CMASK(P0,P1,t) do{}while(0)
  for(;t+5<NT;t+=2){
    STEP(pB0,pB1,pA0,pA1,t,true,true,true);     WAIT_BAR(2); RESC(); ROT();
    STEP(pA0,pA1,pB0,pB1,t+1,true,true,true);   WAIT_BAR(2); RESC(); ROT();
  }
  #undef CMASK
  #define CMASK(P0,P1,t) do{}while(0)
  #define ENDW(tt) do{ if((tt)+3<NT){WAIT_BAR(2);} else if((tt)+2<NT){WAIT_BAR(1);} else {WAIT_BAR(0);} }while(0)
  for(;t+1<NT;t+=2){
    STEP(pB0,pB1,pA0,pA1,t,(t+3<NT),(t+1<NT),(t+1<NT));       ENDW(t);   RESC(); ROT();
    STEP(pA0,pA1,pB0,pB1,t+1,(t+4<NT),(t+2<NT),(t+2<NT));     ENDW(t+1); RESC(); ROT();
  }
  STEP(pB0,pB1,pA0,pA1,NT-1,false,false,false); RESC();
  { float sacc=pB0[0]+pB0[1]; _Pragma("unroll") for(int r=2;r<16;++r)sacc+=pB0[r]; _Pragma("unroll") for(int r=0;r<16;++r)sacc+=pB1[r]; l_reg+=sacc;
    pw0=(u32x4){PKW(pB0,0),PKW(pB0,2),PKW(pB0,4),PKW(pB0,6)};pw1=(u32x4){PKW(pB0,8),PKW(pB0,10),PKW(pB0,12),PKW(pB0,14)};pw2=(u32x4){PKW(pB1,0),PKW(pB1,2),PKW(pB1,4),PKW(pB1,6)};pw3=(u32x4){PKW(pB1,8),PKW(pB1,10),PKW(pB1,12),PKW(pB1,14)};
    SBAR(); pv(o,vb0+sl_cur,PAF(0),PAF(1),PAF(2),PAF(3)); }
  #undef PKW
  #undef PAF
  #undef VFR
  #undef PIN
  #undef MX3
  #undef GAPA
  #undef GAPB
  #undef EX
  #undef VRD
  #undef KRD
  #undef STEP
  #undef ENDW
  {auto rr=__builtin_amdgcn_permlane32_swap(__float_as_uint(l_reg),__float_as_uint(l_reg),false,false);l_reg=__uint_as_float(rr[0])+__uint_as_float(rr[1]);}
  if(hi==0)wsf[32+r32]=l_reg;asm volatile("s_waitcnt lgkmcnt(0)":::"memory");
  float rli[16];
  #pragma unroll
  for(int r=0;r<16;++r)rli[r]=__builtin_amdgcn_rcpf(wsf[32+crow(r,hi)]);
  bf16*Ow=O+(rowbase+q0+wid*QBLK)*DMQ+h*D;
  { bf16*stg=(bf16*)(shm+LDS_OST)+wid*2048;
    #pragma unroll
    for(int r=0;r<16;++r){const int orow=crow(r,hi);
      #pragma unroll
      for(int d0=0;d0<2;++d0)stg[orow*64+d0*32+r32]=__float2bfloat16(o[d0][r]*rli[r]);}
    asm volatile("s_waitcnt lgkmcnt(0)":::"memory");
    #pragma unroll
    for(int i=0;i<4;++i){const int row=i*8+(lane>>3),ch=lane&7; const u32x4 v=*(const u32x4*)(stg+row*64+ch*8); ATTN_STORE16(Ow+(long)row*DMQ+ch*8,v);} }
  asm volatile("s_waitcnt lgkmcnt(0)\n\ts_barrier":::"memory");
  #undef DMA_K
  #undef DMA_V
  #undef CMASK
  #undef START
  #undef RESC
  #undef ROT
}
constexpr int ATTN_LDS_BYTES=LDS_BYTES;
struct AttnTensors { const bf16* Q; const bf16* K; const bf16* V; bf16* O; };
struct AttnUnit { int bh; int qb; };
struct StaticOrder {
  int vcu, G;
  __device__ __forceinline__ explicit StaticOrder(int grid,int block):vcu((grid%8==0)?(block%8)*(grid/8)+block/8:block),G(grid){}
  __device__ __forceinline__ bool next(int i,AttnUnit&u)const{ constexpr int NU=NHEAD*NQB; int uu; if(NU%G==0){ const int per=NU/G; if(i>=per)return false; uu=vcu*per+i; } else { uu=i*G+vcu; if(uu>=NU)return false; } u.bh=uu/NQB; u.qb=uu%NQB; return true; }
  __device__ __forceinline__ void a_ready(const AttnUnit&)const{}
  __device__ __forceinline__ void done(const AttnUnit&)const{}
};
template<class Sched,int THRL=8> __device__ __forceinline__ void attn_phase(char*lds,const AttnTensors&T,const Sched&S,int wave_,float negM){
  AttnUnit u;
  for(int i=0;S.next(i,u);++i){ S.a_ready(u); attn_unit<THRL>(0,u.bh,u.qb,T.Q,T.K,T.V,T.O,lds,wave_,negM); S.done(u); }
}
#undef SBAR
#undef WAIT_BAR
}

namespace attn8 {
using bf16 = __hip_bfloat16;
typedef int i32x8 __attribute__((ext_vector_type(8)));
typedef int i32x4 __attribute__((ext_vector_type(4)));
typedef float f32x16 __attribute__((ext_vector_type(16)));
typedef unsigned u32x4 __attribute__((ext_vector_type(4)));
constexpr int NHEAD = 8, SEQ = 16384, QBLK = 32, NW = 8, QB = 256, KVBLK = 64, NQB = SEQ / QB, NT = SEQ / KVBLK;
constexpr int NS = 8, SLOT = 4096;
constexpr int LDS_K = 0, LDS_V = NS * SLOT, LDS_WS = 2 * NS * SLOT, LDS_OST = LDS_WS + NW * 256, LDS_BYTES = LDS_OST + NW * 4096;
__device__ __forceinline__ int crow(int r, int hi) { return (r & 3) + 8 * (r >> 2) + 4 * hi; }
__device__ __forceinline__ void glds16(const void* gsrc, unsigned lds_dst) { unsigned keep;
    asm volatile("s_mov_b32 %0, m0\n\ts_mov_b32 m0, %2\n\ts_nop 0\n\tglobal_load_lds_dwordx4 %1, off\n\ts_mov_b32 m0, %0" : "=&s"(keep) : "v"(gsrc), "s"(lds_dst) : "memory"); }
typedef __attribute__((address_space(3))) const char* lds_cptr;
__device__ __forceinline__ i32x8 frag(lds_cptr p) {
    const i32x4 lo = *(const __attribute__((address_space(3))) i32x4*)(p), hi = *(const __attribute__((address_space(3))) i32x4*)(p + 1024);
    return __builtin_shufflevector(lo, hi, 0, 1, 2, 3, 4, 5, 6, 7); }
#define A8_MFMA(a, b, c) __builtin_amdgcn_mfma_scale_f32_32x32x64_f8f6f4((a), (b), (c), 0, 0, 0, 0, 0, 0)
struct Tensors { const unsigned char* Q8; const unsigned char* K8; const unsigned char* V8T; bf16* O; };

__device__ __forceinline__ void unit(int h, int qb, const Tensors& T, char* shm, int wave_, float negM8) {
    const int tid = wave_ * 64 + lane_id_opaque(), lane = tid & 63, r32 = lane & 31, hi = lane >> 5; const int wid = __builtin_amdgcn_readfirstlane(tid >> 6);
    const int kvh = h >> 2, q0 = qb * QB;
    const unsigned lds0 = (unsigned)(uintptr_t)shm;
    float* wsf = (float*)(shm + LDS_WS) + wid * 64;
    const bool isk = wid < 4; const int c = wid & 3;
    const unsigned char* src0 = isk ? T.K8 + (size_t)lane * 128 + kvh * 64 + c * 16 : T.V8T + (size_t)kvh * NT * 4096 + (size_t)lane * 64 + c * 16;
    const size_t tstep = isk ? (size_t)KVBLK * 128 : (size_t)4096;
    const unsigned dst0 = lds0 + (isk ? LDS_K : LDS_V) + c * 1024;
#define A8_DMA(t) glds16(src0 + (size_t)(t) * tstep, (unsigned)__builtin_amdgcn_readfirstlane(dst0 + ((t) & (NS - 1)) * SLOT))
#pragma unroll
    for (int t = 0; t < 3; ++t) A8_DMA(t);
    if (isk) { A8_DMA(3); A8_DMA(4); }
    const unsigned char* qp = T.Q8 + (size_t)(q0 + wid * QBLK + r32) * 512 + h * 64 + 32 * hi;
    const i32x4 qlo = *(const i32x4*)qp, qhi = *(const i32x4*)(qp + 16);
    const i32x8 qf = __builtin_shufflevector(qlo, qhi, 0, 1, 2, 3, 4, 5, 6, 7);
    f32x16 negm;
#pragma unroll
    for (int r = 0; r < 16; ++r) negm[r] = negM8;
    f32x16 o0 = f32x16{}, o1 = f32x16{}, lacc = f32x16{};
    i32x8 ones8;
#pragma unroll
    for (int k = 0; k < 8; ++k) ones8[k] = 0x38383838;
    const lds_cptr kbase = (lds_cptr)shm + LDS_K + (2 * hi) * 1024 + r32 * 16, vbase = (lds_cptr)shm + LDS_V + (2 * hi) * 1024 + r32 * 16;
    if (isk) asm volatile("s_waitcnt vmcnt(4)" ::: "memory"); else asm volatile("s_waitcnt vmcnt(2)" ::: "memory");
    asm volatile("s_waitcnt lgkmcnt(0)\n\ts_barrier" ::: "memory");
    asm volatile("" : "+v"(ones8));
    f32x16 sA0 = A8_MFMA(frag(kbase), qf, negm), sA1 = A8_MFMA(frag(kbase + 512), qf, negm), sB0, sB1;
#define A8_SB() __builtin_amdgcn_sched_barrier(0)
#define A8_EX8(X, b) do { _Pragma("unroll") for (int r = 0; r < 8; ++r) X[(b) + r] = __builtin_amdgcn_exp2f(X[(b) + r]); } while (0)
#define A8_TILE(C0, C1, N0, N1, PP, PC, kt, vt) do { \
        const lds_cptr kp_ = kbase + ((kt) & (NS - 1)) * SLOT, vp_ = vbase + ((vt) & (NS - 1)) * SLOT; \
        const i32x8 kf0_ = frag(kp_), kf1_ = frag(kp_ + 512), vf0_ = frag(vp_), vf1_ = frag(vp_ + 512); A8_SB(); \
        N0 = A8_MFMA(kf0_, qf, negm); A8_SB(); A8_EX8(C0, 0); A8_SB(); \
        N1 = A8_MFMA(kf1_, qf, negm); A8_SB(); A8_EX8(C0, 8); A8_SB(); \
        o0 = A8_MFMA(PP, vf0_, o0); A8_SB(); A8_EX8(C1, 0); A8_SB(); \
        o1 = A8_MFMA(PP, vf1_, o1); A8_SB(); A8_EX8(C1, 8); A8_SB(); \
        lacc = A8_MFMA(PP, ones8, lacc); A8_SB(); \
        _Pragma("unroll") for (int k = 0; k < 4; ++k) { int w_; asm volatile("" : "=v"(w_)); w_ = __builtin_amdgcn_cvt_pk_fp8_f32(C0[4 * k], C0[4 * k + 1], w_, false); w_ = __builtin_amdgcn_cvt_pk_fp8_f32(C0[4 * k + 2], C0[4 * k + 3], w_, true); PC[k] = w_; \
            int v_; asm volatile("" : "=v"(v_)); v_ = __builtin_amdgcn_cvt_pk_fp8_f32(C1[4 * k], C1[4 * k + 1], v_, false); v_ = __builtin_amdgcn_cvt_pk_fp8_f32(C1[4 * k + 2], C1[4 * k + 3], v_, true); PC[4 + k] = v_; } \
        A8_SB(); } while (0)
    i32x8 pA, pB;
#pragma unroll
    for (int k = 0; k < 8; ++k) { pA[k] = 0; pB[k] = 0; }
    for (int t = 0; t < NT; t += 4) {
        asm volatile("s_waitcnt vmcnt(0) lgkmcnt(0)\n\ts_barrier" ::: "memory");
        if (isk) {
#pragma unroll
            for (int j = 5; j <= 8; ++j) if (t + j < NT) A8_DMA(t + j);
        } else {
#pragma unroll
            for (int j = 3; j <= 6; ++j) if (t + j < NT) A8_DMA(t + j);
        }
        A8_TILE(sA0, sA1, sB0, sB1, pB, pA, t + 1, (t > 0 ? t - 1 : 0));
        A8_TILE(sB0, sB1, sA0, sA1, pA, pB, t + 2, t);
        A8_TILE(sA0, sA1, sB0, sB1, pB, pA, t + 3, t + 1);
        A8_TILE(sB0, sB1, sA0, sA1, pA, pB, t + 4, t + 2);
    }
    asm volatile("s_waitcnt vmcnt(0) lgkmcnt(0)\n\ts_barrier" ::: "memory");
    {
        const lds_cptr vp_ = vbase + ((NT - 1) & (NS - 1)) * SLOT; const i32x8 vf0_ = frag(vp_), vf1_ = frag(vp_ + 512);
        o0 = A8_MFMA(pB, vf0_, o0); o1 = A8_MFMA(pB, vf1_, o1); lacc = A8_MFMA(pB, ones8, lacc); }
#undef A8_EX8
#undef A8_TILE
#undef A8_SB
    (void)wsf;
    float rli[16];
#pragma unroll
    for (int r = 0; r < 16; ++r) rli[r] = __builtin_amdgcn_rcpf(lacc[r]);
    bf16* Ow = T.O + (size_t)(q0 + wid * QBLK) * 512 + h * 64;
    { bf16* stg = (bf16*)(shm + LDS_OST) + wid * 2048;
#pragma unroll
      for (int r = 0; r < 16; ++r) { const int orow = crow(r, hi); stg[orow * 64 + r32] = __float2bfloat16(o0[r] * rli[r]); stg[orow * 64 + 32 + r32] = __float2bfloat16(o1[r] * rli[r]); }
      asm volatile("s_waitcnt lgkmcnt(0)" ::: "memory");
#pragma unroll
      for (int i = 0; i < 4; ++i) { const int row = i * 8 + (lane >> 3), ch = lane & 7; const u32x4 v = *(const u32x4*)(stg + row * 64 + ch * 8); *(u32x4*)(Ow + (size_t)row * 512 + ch * 8) = v; } }
    asm volatile("s_waitcnt vmcnt(0) lgkmcnt(0)\n\ts_barrier" ::: "memory");
#undef A8_DMA
}
__device__ __forceinline__ void phase(char* lds, const Tensors& T, int grid, int block, int wave_, float negM8) {
    const int vcu = (grid % 8 == 0) ? (block % 8) * (grid / 8) + block / 8 : block;
    constexpr int NU = NHEAD * NQB;
    if (NU % grid == 0) { const int per = NU / grid; for (int i = 0; i < per; ++i) { const int uu = vcu * per + i; unit(uu / NQB, uu % NQB, T, lds, wave_, negM8); } }
    else for (int uu = vcu; uu < NU; uu += grid) unit(uu / NQB, uu % NQB, T, lds, wave_, negM8);
}
#undef A8_MFMA
}

namespace hg {
typedef short bf16x8 __attribute__((ext_vector_type(8)));
typedef short s16x4 __attribute__((ext_vector_type(4)));
constexpr int CH = 32, SEGT = 512, NSEG = S / SEGT, NCH = SEGT / CH;
constexpr int RS = 272, TS = 80;
constexpr int QOFF = 0, KOFF = 32 * RS, KTOFF = 2 * 32 * RS, VTOFF = KTOFF + 128 * TS, DOFF = VTOFF + 128 * TS, GOFF = DOFF + 512, BUFB = GOFF + 4096;
static_assert(2 * BUFB <= 131072, "hgrn LDS");
#define HG_MFMA(a, b, c) __builtin_amdgcn_mfma_f32_16x16x32_bf16((a), (b), (c), 0, 0, 0)
__device__ __forceinline__ unsigned pkbf(float lo, float hi) { typedef float f2 __attribute__((ext_vector_type(2))); typedef __bf16 b2 __attribute__((ext_vector_type(2))); f2 v = {lo, hi}; b2 b = __builtin_convertvector(v, b2); return __builtin_bit_cast(unsigned, b); }

typedef float f32x2h __attribute__((ext_vector_type(2)));
template <bool OUT>
__device__ __forceinline__ void chunk_matrix(LAS unsigned char* B, f32x4 (&Sacc)[8], int c16, int g, int e0, int dir, int h, int p0c, float* __restrict__ OF) {
    if (OUT) {
        f32x4 X00 = {0.f, 0.f, 0.f, 0.f}, X01 = X00, X11 = X00;
#pragma unroll
        for (int s = 0; s < 4; ++s) {
            const bf16x8 aK0 = *(const LAS bf16x8*)(B + KOFF + c16 * RS + (32 * s + 8 * g) * 2), aK1 = *(const LAS bf16x8*)(B + KOFF + (16 + c16) * RS + (32 * s + 8 * g) * 2);
            const bf16x8 bQ0 = *(const LAS bf16x8*)(B + QOFF + c16 * RS + (32 * s + 8 * g) * 2), bQ1 = *(const LAS bf16x8*)(B + QOFF + (16 + c16) * RS + (32 * s + 8 * g) * 2);
            X00 = HG_MFMA(aK0, bQ0, X00); X01 = HG_MFMA(aK0, bQ1, X01); X11 = HG_MFMA(aK1, bQ1, X11);
        }
#pragma unroll
        for (int r = 0; r < 4; ++r) { const bool keep = (4 * g + r) <= c16; X00[r] = keep ? X00[r] : 0.f; X11[r] = keep ? X11[r] : 0.f; }
        u32x4 a0w, a1w; a0w.x = pkbf(X00[0], X00[1]); a0w.y = pkbf(X00[2], X00[3]); a0w.z = 0u; a0w.w = 0u;
        a1w.x = pkbf(X01[0], X01[1]); a1w.y = pkbf(X01[2], X01[3]); a1w.z = pkbf(X11[0], X11[1]); a1w.w = pkbf(X11[2], X11[3]);
        const u32x2 vlo = *(const LAS u32x2*)(B + VTOFF + (e0 + c16) * TS + (4 * g) * 2), vhi = *(const LAS u32x2*)(B + VTOFF + (e0 + c16) * TS + (16 + 4 * g) * 2);
        u32x4 vbw; vbw.x = vlo.x; vbw.y = vlo.y; vbw.z = vhi.x; vbw.w = vhi.y;
        const bf16x8 vb = __builtin_bit_cast(bf16x8, vbw);
        f32x4 O0 = {0.f, 0.f, 0.f, 0.f}, O1 = O0;
        O0 = HG_MFMA(__builtin_bit_cast(bf16x8, a0w), vb, O0); O1 = HG_MFMA(__builtin_bit_cast(bf16x8, a1w), vb, O1);
#pragma unroll
        for (int s = 0; s < 4; ++s) {
            u32x4 sw; sw.x = pkbf(Sacc[2 * s][0], Sacc[2 * s][1]); sw.y = pkbf(Sacc[2 * s][2], Sacc[2 * s][3]); sw.z = pkbf(Sacc[2 * s + 1][0], Sacc[2 * s + 1][1]); sw.w = pkbf(Sacc[2 * s + 1][2], Sacc[2 * s + 1][3]);
            const bf16x8 sb = __builtin_bit_cast(bf16x8, sw);
            const u32x2 q0l = *(const LAS u32x2*)(B + QOFF + c16 * RS + (32 * s + 4 * g) * 2), q0h = *(const LAS u32x2*)(B + QOFF + c16 * RS + (32 * s + 16 + 4 * g) * 2);
            const u32x2 q1l = *(const LAS u32x2*)(B + QOFF + (16 + c16) * RS + (32 * s + 4 * g) * 2), q1h = *(const LAS u32x2*)(B + QOFF + (16 + c16) * RS + (32 * s + 16 + 4 * g) * 2);
            u32x4 q0w, q1w; q0w.x = q0l.x; q0w.y = q0l.y; q0w.z = q0h.x; q0w.w = q0h.y; q1w.x = q1l.x; q1w.y = q1l.y; q1w.z = q1h.x; q1w.w = q1h.y;
            O0 = HG_MFMA(__builtin_bit_cast(bf16x8, q0w), sb, O0); O1 = HG_MFMA(__builtin_bit_cast(bf16x8, q1w), sb, O1);
        }
        { const int gm = dir ? 3 - g : g; const unsigned ooff = (unsigned)(4 * gm) * 512u + (unsigned)(e0 + c16);
          GAS float* ofu = (GAS float*)OF + (size_t)dir * S * 512 + h * 128;
          const int Tb = dir ? (S - 32 - p0c) : p0c;
#pragma unroll
          for (int r = 0; r < 4; ++r) {
              ofu[(size_t)(Tb + (dir ? 16 + 3 - r : r)) * 512 + ooff] = O0[r];
              ofu[(size_t)(Tb + (dir ? 3 - r : 16 + r)) * 512 + ooff] = O1[r];
          } }
    }
    {
        const bf16x8 vB = *(const LAS bf16x8*)(B + VTOFF + (e0 + c16) * TS + (8 * g) * 2);
#pragma unroll
        for (int dt = 0; dt < 8; ++dt) {
            const bf16x8 aT = *(const LAS bf16x8*)(B + KTOFF + (16 * dt + c16) * TS + (8 * g) * 2);
            Sacc[dt] = HG_MFMA(aT, vB, Sacc[dt]);
            const f32x4 dv = *(const LAS f32x4*)(B + DOFF + (16 * dt + 4 * g) * 4);
            Sacc[dt] = Sacc[dt] * dv;
        }
    }
}
template <bool OUT>
__device__ __forceinline__ void segment(LAS unsigned char* lds, int unit, const bf16_t* __restrict__ HQ, const float* __restrict__ LF, const bf16_t* __restrict__ KF,
                                        const bf16_t* __restrict__ HV, float* __restrict__ HST, float* __restrict__ HSD, float* __restrict__ OF, int wave_) {
    const int tid_ = wave_ * 64 + lane_id_opaque();
    const int tid = tid_, lane = tid & 63, w = __builtin_amdgcn_readfirstlane(tid >> 6), c16 = lane & 15, g = lane >> 4;
    const int dir = unit >> 7, h = (unit >> 5) & 3, seg = unit & 31;
    const int d0 = 2 * (tid & 63), tg = tid >> 6;
    f32x4 Sacc[8];
    float* hst = HST + (size_t)unit * 16384 + (size_t)w * 2048 + lane;
    if (OUT) {
#pragma unroll
        for (int dt = 0; dt < 8; ++dt) { Sacc[dt][0] = hst[(dt * 4 + 0) * 64]; Sacc[dt][1] = hst[(dt * 4 + 1) * 64]; Sacc[dt][2] = hst[(dt * 4 + 2) * 64]; Sacc[dt][3] = hst[(dt * 4 + 3) * 64]; }
    } else {
#pragma unroll
        for (int dt = 0; dt < 8; ++dt) Sacc[dt] = f32x4{0.f, 0.f, 0.f, 0.f};
    }
    f32x2h segsum = {0.f, 0.f};
    const int e0 = 16 * w;
    constexpr int RING = 2;
    f32x2h rl[RING][4]; unsigned rk[RING][4], rq[RING][4], rv[RING][4];
    const int tgm = dir ? 7 - tg : tg;
    const unsigned toff = (unsigned)(4 * tgm) * 512u + (unsigned)d0;
    const GAS float* lfu = (const GAS float*)LF + (size_t)dir * S * 512 + h * 128;
    const GAS bf16_t* kfu = (const GAS bf16_t*)KF + (size_t)dir * S * 512 + h * 128;
    const GAS bf16_t* hqu = (const GAS bf16_t*)HQ + h * 128; const GAS bf16_t* hvu = (const GAS bf16_t*)HV + h * 128;
#define HG_LOAD(sl, cc) do { const int Tb_ = dir ? (S - 32 - (seg * SEGT + (cc) * CH)) : (seg * SEGT + (cc) * CH); \
        _Pragma("unroll") for (int jj = 0; jj < 4; ++jj) { const size_t ub_ = (size_t)(Tb_ + (dir ? 3 - jj : jj)) * 512; \
        rl[sl][jj] = *(const GAS f32x2h*)(lfu + ub_ + toff); rk[sl][jj] = *(const GAS unsigned*)(kfu + ub_ + toff); rv[sl][jj] = *(const GAS unsigned*)(hvu + ub_ + toff); \
        rq[sl][jj] = OUT ? *(const GAS unsigned*)(hqu + ub_ + toff) : 0u; } } while (0)
#pragma unroll
    for (int sl = 0; sl < RING; ++sl) HG_LOAD(sl, sl);
    for (int c4 = 0; c4 < NCH; c4 += RING) {
#pragma unroll
        for (int sl = 0; sl < RING; ++sl) {
            const int c = c4 + sl;
            LAS unsigned char* B = lds + (c & 1) * BUFB;
            f32x2h cs[4]; unsigned kk[4], qq[4], vv[4];
#pragma unroll
            for (int jj = 0; jj < 4; ++jj) { cs[jj] = rl[sl][jj]; kk[jj] = rk[sl][jj]; qq[jj] = rq[sl][jj]; vv[jj] = rv[sl][jj]; }
            if (c + RING < NCH) HG_LOAD(sl, c + RING);
#pragma unroll
            for (int jj = 1; jj < 4; ++jj) cs[jj] += cs[jj - 1];
            LAS float* gs = (LAS float*)(B + GOFF);
            *(LAS f32x2h*)(gs + tg * 128 + d0) = cs[3];
            __syncthreads();
            f32x2h off = {0.f, 0.f}, tot = {0.f, 0.f};
#pragma unroll
            for (int q = 0; q < 8; ++q) { const f32x2h gq = *(const LAS f32x2h*)(gs + q * 128 + d0); tot += gq; if (q < tg) off += gq; }
            float kt0[4], kt1[4];
#pragma unroll
            for (int jj = 0; jj < 4; ++jj) {
                const float b0 = fmaxf(off.x + cs[jj].x, -80.f), b1 = fmaxf(off.y + cs[jj].y, -80.f);
                kt0[jj] = bflo(kk[jj]) * __expf(-b0); kt1[jj] = bfhi(kk[jj]) * __expf(-b1);
                if (OUT) {
                    *(LAS unsigned*)(B + QOFF + (4 * tg + jj) * RS + d0 * 2) = pkbf(bflo(qq[jj]) * __expf(b0), bfhi(qq[jj]) * __expf(b1));
                    *(LAS unsigned*)(B + KOFF + (4 * tg + jj) * RS + d0 * 2) = pkbf(kt0[jj], kt1[jj]);
                }
            }
            { u32x2 o0, o1; o0.x = pkbf(kt0[0], kt0[1]); o0.y = pkbf(kt0[2], kt0[3]); o1.x = pkbf(kt1[0], kt1[1]); o1.y = pkbf(kt1[2], kt1[3]);
              *(LAS u32x2*)(B + KTOFF + d0 * TS + 8 * tg) = o0; *(LAS u32x2*)(B + KTOFF + (d0 + 1) * TS + 8 * tg) = o1;
              u32x2 v0, v1; v0.x = (vv[0] & 0xffffu) | (vv[1] << 16); v0.y = (vv[2] & 0xffffu) | (vv[3] << 16); v1.x = (vv[0] >> 16) | (vv[1] & 0xffff0000u); v1.y = (vv[2] >> 16) | (vv[3] & 0xffff0000u);
              *(LAS u32x2*)(B + VTOFF + d0 * TS + 8 * tg) = v0; *(LAS u32x2*)(B + VTOFF + (d0 + 1) * TS + 8 * tg) = v1; }
            if (tg == 0) { f32x2h dv; dv.x = __expf(fmaxf(tot.x, -80.f)); dv.y = __expf(fmaxf(tot.y, -80.f)); *(LAS f32x2h*)(B + DOFF + d0 * 4) = dv; }
            segsum += tot;
            __syncthreads();
            chunk_matrix<OUT>(B, Sacc, c16, g, e0, dir, h, seg * SEGT + c * CH, OF);
        }
    }
    if (!OUT) {
#pragma unroll
        for (int dt = 0; dt < 8; ++dt) { hst[(dt * 4 + 0) * 64] = Sacc[dt][0]; hst[(dt * 4 + 1) * 64] = Sacc[dt][1]; hst[(dt * 4 + 2) * 64] = Sacc[dt][2]; hst[(dt * 4 + 3) * 64] = Sacc[dt][3]; }
        if (tid < 64) { f32x2h dd; dd.x = __expf(fmaxf(segsum.x, -80.f)); dd.y = __expf(fmaxf(segsum.y, -80.f)); *(f32x2h*)(HSD + (size_t)unit * 128 + d0) = dd; }
    }
    __syncthreads();
}
__device__ __forceinline__ void carry(float* __restrict__ HST, const float* __restrict__ HSD, int gid) {
    const int chain = gid >> 14, el = gid & 16383, dt = (el >> 8) & 7, r = (el >> 6) & 3, ln = el & 63, d = 16 * dt + 4 * (ln >> 4) + r;
    float cy = 0.f;
    for (int sg = 0; sg < NSEG; ++sg) {
        const int u = chain * NSEG + sg;
        const float tmp = HST[(size_t)u * 16384 + el];
        HST[(size_t)u * 16384 + el] = cy;
        cy = HSD[(size_t)u * 128 + d] * cy + tmp;
    }
}
#undef HG_MFMA
#undef HG_LOAD
}

#define XB_TMO      128
#define XB_XCNT(j)  (256  + 64 * (j))
#define XB_XSUB(j)  (1280 + 64 * (j))
#define XB_XGEN(j)  (2304 + 64 * (j))
#define XB_TOP      3328
#define XB_TOPGEN   3392
#define XCD_BAR_WORDS 3456
#define XB_SPIN_CAP (1u << 18)

__device__ __forceinline__ unsigned xb_ld(unsigned* p)              { return __hip_atomic_load(p, __ATOMIC_RELAXED, __HIP_MEMORY_SCOPE_AGENT); }
__device__ __forceinline__ unsigned xb_add(unsigned* p, unsigned v) { return __hip_atomic_fetch_add(p, v, __ATOMIC_RELAXED, __HIP_MEMORY_SCOPE_AGENT); }
__device__ __forceinline__ unsigned xb_xcc_id() { return (unsigned)__builtin_amdgcn_s_getreg((3 << 11) | 20) & 0xFu; }
#define XB_SPIN(cond, bar) do { unsigned _sp = 0; while (cond) { __builtin_amdgcn_s_sleep(1); \
    if ((++_sp & 255u) == 0u) { if (xb_ld(&(bar)[XB_TMO])) break; if (_sp > XB_SPIN_CAP) { atomicAdd(&(bar)[XB_TMO], 1u); break; } } } } while (0)

struct XcdBarrier {
    int wv;
    unsigned* bar; unsigned x;
    volatile LAS unsigned* st;
};

__device__ __forceinline__ XcdBarrier xcd_barrier_post(unsigned* bar, volatile LAS unsigned* st) {
    XcdBarrier b; b.bar = bar; b.x = xb_xcc_id(); b.st = st; b.wv = __builtin_amdgcn_readfirstlane((int)threadIdx.x >> 6);
    if (threadIdx.x == 0) (void)xb_add(&bar[XB_XCNT(b.x)], 1u);
    return b;
}
__device__ __forceinline__ void xcd_barrier_complete(unsigned* bar, unsigned x, unsigned& nloc, unsigned& nx) {
    const unsigned G = gridDim.x * gridDim.y * gridDim.z;
    unsigned sum, cnt, mine, sp = 0u;
    for (;;) {
        sum = 0u; cnt = 0u; mine = 0u;
#pragma unroll
        for (unsigned j = 0; j < 16; ++j) { const unsigned c = xb_ld(&bar[XB_XCNT(j)]); sum += c; cnt += (c > 0u) ? 1u : 0u; mine = (j == x) ? c : mine; }
        if (sum == G) break;
        __builtin_amdgcn_s_sleep(1);
        if ((++sp & 255u) == 0u) { if (xb_ld(&bar[XB_TMO])) break; if (sp > XB_SPIN_CAP) { atomicAdd(&bar[XB_TMO], 1u); break; } }
    }
    nloc = mine > 0u ? mine : 1u; nx = cnt > 0u ? cnt : 1u;
}

__device__ __forceinline__ void xcd_barrier(const XcdBarrier& b) {
    asm volatile("s_waitcnt vmcnt(0)" ::: "memory");
    __syncthreads();
    if (b.wv == 0 && lane_id_opaque() == 0) {
        unsigned* bar = b.bar;
        __builtin_amdgcn_s_waitcnt(0);
        unsigned nloc = b.st[0], nx = b.st[1];
        if (nloc == 0u) { xcd_barrier_complete(bar, b.x, nloc, nx); b.st[0] = nloc; b.st[1] = nx; }
        const unsigned old = xb_add(&bar[XB_XSUB(b.x)], 1u);
        const unsigned gen = old / nloc;
        if (old + 1u == (gen + 1u) * nloc) {
            __builtin_amdgcn_fence(__ATOMIC_RELEASE, "agent");
            asm volatile("s_waitcnt vmcnt(0)" ::: "memory");
            const unsigned og = xb_add(&bar[XB_TOP], 1u);
            const unsigned tg = og / nx;
            if (og + 1u == (tg + 1u) * nx) xb_add(&bar[XB_TOPGEN], 1u);
            else XB_SPIN(xb_ld(&bar[XB_TOPGEN]) == tg, bar);
            __builtin_amdgcn_fence(__ATOMIC_ACQUIRE, "agent");
            xb_add(&bar[XB_XGEN(b.x)], 1u);
            asm volatile("s_waitcnt vmcnt(0)" ::: "memory");
        } else {
            XB_SPIN(xb_ld(&bar[XB_XGEN(b.x)]) == gen, bar);
            __builtin_amdgcn_fence(__ATOMIC_ACQUIRE, "agent");
            asm volatile("s_waitcnt vmcnt(0)" ::: "memory");
        }
    }
    __syncthreads();
}

constexpr int NWAVES = 8;
constexpr int RING_OFF = 0, RING_BYTES = 131072;
constexpr int LDSCTL_OFF = RING_BYTES, MISC_OFF = LDSCTL_OFF + 320;
constexpr int LDS_BYTES = 147456;
constexpr int CW_BAR = 4096;
constexpr int NPL = 13;
constexpr int PH_PRO = 0, PH_NORM1 = 1, PH_L0 = 2, PH_END = PH_L0 + NL * NPL;
enum { P_G1 = 0, P_QKP = 1, P_HGB = 2, P_HGC = 3, P_ATT = 4, P_G2 = 5, P_G3 = 6, P_N2R = 7, P_TOPK = 8, P_GATH = 9, P_G4 = 10, P_G5 = 11, P_COMB = 12 };

#ifndef ATTN_FP8
#define ATTN_FP8 1
#endif
#ifndef KEEP_BF16_QK
#define KEEP_BF16_QK (!ATTN_FP8)
#endif
#ifndef REP_HG
#define REP_HG 1
#endif
#ifndef REP_PRO
#define REP_PRO 1
#endif
#ifndef REP_ROW
#define REP_ROW 1
#endif
#ifndef REP_G
#define REP_G 1
#endif
#ifndef REP_TK
#define REP_TK 1
#endif
#ifndef REP_QK
#define REP_QK 1
#endif
#ifndef REP_ATT
#define REP_ATT 1
#endif
struct Params {
    const float *x, *c, *ada_w, *ada_b, *norm_mix_w, *norm_ffn_w, *w_in, *q_norm_w, *k_norm_w, *hlb, *hg_norm_w, *w_ba, *w_bh, *w_out, *w_router, *w_eg, *w_eu, *w_ed;
    float* out; unsigned char* ws;
    int ph_lo, ph_hi, li, pad;
};
struct Frame {
    LAS unsigned char* lds;
    int tid, lane, wave, vcu, G;
};

__device__ __forceinline__ void tr_tile(const float* __restrict__ src, int ldw, bf16_t* __restrict__ dst, int Kd, LAS float* scr, int lane) {
    f32x4 v[8];
#pragma unroll
    for (int i = 0; i < 8; ++i) v[i] = *(const f32x4*)(src + (size_t)(8 * i + (lane >> 3)) * ldw + 4 * (lane & 7));
#pragma unroll
    for (int i = 0; i < 8; ++i) { LAS float* s = scr + (8 * i + (lane >> 3)) * 33 + 4 * (lane & 7); s[0] = v[i].x; s[1] = v[i].y; s[2] = v[i].z; s[3] = v[i].w; }
    asm volatile("s_waitcnt lgkmcnt(0)" ::: "memory");
    const int cch = lane & 7;
#pragma unroll
    for (int j = 0; j < 4; ++j) { const int n = (lane >> 3) + 8 * j; const LAS float* s = scr + (8 * cch) * 33 + n;
        u32x4 o; o.x = pk2(s[0 * 33], s[1 * 33]); o.y = pk2(s[2 * 33], s[3 * 33]); o.z = pk2(s[4 * 33], s[5 * 33]); o.w = pk2(s[6 * 33], s[7 * 33]);
        *(u32x4*)(dst + (size_t)n * Kd + 8 * cch) = o; }
    asm volatile("s_waitcnt lgkmcnt(0)" ::: "memory");
}
struct ConvItem { const float* src; unsigned char* dst; int ldw, Kd; };
__device__ __forceinline__ ConvItem conv_item_f8(const Params& p, int l, int it) {
    ConvItem c;
    const int which = it / (NE * 1024), r0 = it % (NE * 1024), e = r0 >> 10, r = r0 & 1023;
    if (which < 2) {
        const int kb = r >> 6, nb = r & 63, n0 = 32 * nb;
        const float* W = (which == 0 ? p.w_eg : p.w_eu) + (size_t)(l * NE + e) * D * FF;
        const int rho = e * 4096 + (n0 >> 7) * 256 + which * 128 + (n0 & 127);
        c.src = W + (size_t)(64 * kb) * FF + n0; c.ldw = FF; c.dst = p.ws + WS_WGU + (size_t)l * 64 * MiB + (size_t)rho * D + 64 * kb; c.Kd = D;
    } else {
        const int kb = r >> 5, nb = r & 31, n0 = 32 * nb;
        const float* W = p.w_ed + (size_t)(l * NE + e) * FF * D;
        c.src = W + (size_t)(64 * kb) * D + n0; c.ldw = D; c.dst = p.ws + WS_WD + (size_t)l * 32 * MiB + (size_t)(e * 1024 + n0) * FF + 64 * kb; c.Kd = FF;
    }
    return c;
}
__device__ __forceinline__ void conv_load8(const ConvItem& c, int lane, f32x4 (&v)[8]) {
#pragma unroll
    for (int i = 0; i < 8; ++i) v[i] = *(const f32x4*)(c.src + (size_t)(8 * i + (lane >> 3)) * c.ldw + 4 * (lane & 7));
}
__device__ __forceinline__ void conv_store_f8(const ConvItem& c, int lane, const f32x4 (&v)[8], LAS float* scr, float scale) {
#pragma unroll
    for (int i = 0; i < 8; ++i) { LAS float* s = scr + (8 * i + (lane >> 3)) * 33 + 4 * (lane & 7); s[0] = v[i].x; s[1] = v[i].y; s[2] = v[i].z; s[3] = v[i].w; }
    asm volatile("s_waitcnt lgkmcnt(0)" ::: "memory");
    const int cch = lane & 7;
#pragma unroll
    for (int j = 0; j < 4; ++j) { const int n = (lane >> 3) + 8 * j; const LAS float* s = scr + (8 * cch) * 33 + n;
        const f32x4 a = {s[0 * 33] * scale, s[1 * 33] * scale, s[2 * 33] * scale, s[3 * 33] * scale}, b = {s[4 * 33] * scale, s[5 * 33] * scale, s[6 * 33] * scale, s[7 * 33] * scale};
        *(u32x2*)(c.dst + (size_t)n * c.Kd + 8 * cch) = pg8::pack8_fp8(a, b); }
    asm volatile("s_waitcnt lgkmcnt(0)" ::: "memory");
}
__device__ __forceinline__ void conv_experts_f8(Frame& F, const Params& p, int l, LAS float* scr) {
    const int gw = F.vcu * NWAVES + F.wave, NGW = F.G * NWAVES, NIT = 3 * NE * 1024;
    int it = gw; if (it >= NIT) return;
    ConvItem cur = conv_item_f8(p, l, it); f32x4 va[8], vb[8];
    conv_load8(cur, F.lane, va);
    for (;;) {
        const int it1 = it + NGW; const bool h1 = it1 < NIT; ConvItem c1 = conv_item_f8(p, l, h1 ? it1 : it);
        if (h1) conv_load8(c1, F.lane, vb);
        conv_store_f8(cur, F.lane, va, scr, 64.0f);
        if (!h1) break;
        const int it2 = it1 + NGW; const bool h2 = it2 < NIT; ConvItem c2 = conv_item_f8(p, l, h2 ? it2 : it1);
        if (h2) conv_load8(c2, F.lane, va);
        conv_store_f8(c1, F.lane, vb, scr, 64.0f);
        if (!h2) break;
        cur = c2; it = it2;
    }
}
__device__ __forceinline__ void conv_matrix(Frame& F, const float* W, int ldw, int K, int N, bf16_t* WT, LAS float* scr) {
    const int gw = F.vcu * NWAVES + F.wave, NGW = F.G * NWAVES, nblk = N / 32, nitems = (K / 64) * nblk;
    for (int it = gw; it < nitems; it += NGW) { const int kb = it / nblk, nb = it % nblk;
        tr_tile(W + (size_t)(64 * kb) * ldw + 32 * nb, ldw, WT + (size_t)(32 * nb) * K + 64 * kb, K, scr, F.lane); }
}
__device__ __forceinline__ void conv_matrix_f8(Frame& F, const float* W, int ldw, int K, int N, unsigned char* WT, LAS float* scr, float scale) {
    const int gw = F.vcu * NWAVES + F.wave, NGW = F.G * NWAVES, nblk = N / 32, nitems = (K / 64) * nblk;
    for (int it = gw; it < nitems; it += NGW) { const int kb = it / nblk, nb = it % nblk;
        ConvItem c; c.src = W + (size_t)(64 * kb) * ldw + 32 * nb; c.ldw = ldw; c.dst = WT + (size_t)(32 * nb) * K + 64 * kb; c.Kd = K;
        f32x4 v[8]; conv_load8(c, F.lane, v); conv_store_f8(c, F.lane, v, scr, scale); }
}
__device__ __forceinline__ void conv_experts(Frame& F, const Params& p, int l, LAS float* scr) {
    const int gw = F.vcu * NWAVES + F.wave, NGW = F.G * NWAVES;
    bf16_t* WGU = (bf16_t*)(p.ws + WS_WGU); bf16_t* WD = (bf16_t*)(p.ws + WS_WD);
    for (int it = gw; it < 3 * NE * 1024; it += NGW) {
        const int which = it / (NE * 1024), r0 = it % (NE * 1024), e = r0 >> 10, r = r0 & 1023;
        if (which < 2) {
            const int kb = r >> 6, nb = r & 63, n0 = 32 * nb;
            const float* W = (which == 0 ? p.w_eg : p.w_eu) + (size_t)(l * NE + e) * D * FF;
            const int rho = e * 4096 + (n0 >> 7) * 256 + which * 128 + (n0 & 127);
            tr_tile(W + (size_t)(64 * kb) * FF + n0, FF, WGU + (size_t)rho * D + 64 * kb, D, scr, F.lane);
        } else {
            const int kb = r >> 5, nb = r & 31, n0 = 32 * nb;
            const float* W = p.w_ed + (size_t)(l * NE + e) * FF * D;
            tr_tile(W + (size_t)(64 * kb) * D + n0, D, WD + (size_t)(e * 1024 + n0) * FF + 64 * kb, FF, scr, F.lane);
        }
    }
}
__device__ __forceinline__ void mod_units(Frame& F, const Params& p) {
    LAS float* sc = (LAS float*)(F.lds + 96 * 1024);
    LAS float* red = sc + 1024;
    float* MOD = (float*)(p.ws + WS_MOD); float* LBV = (float*)(p.ws + WS_LBV);
    for (int u = blockIdx.x; u < NL * 96; u += F.G) {
        for (int i = F.tid; i < D; i += 512) sc[i] = siluf_(p.c[i]);
        __syncthreads();
        const int l = u / 96, j = (u % 96) * 64 + (F.tid & 63), kp = F.tid >> 6;
        const float* w = p.ada_w + (size_t)l * D * 6 * D + (size_t)(kp * 128) * 6 * D + j;
        float acc = 0.f;
#pragma unroll 8
        for (int k = 0; k < 128; ++k) acc += sc[kp * 128 + k] * w[(size_t)k * 6 * D];
        red[kp * 64 + (F.tid & 63)] = acc;
        __syncthreads();
        if (F.tid < 64) { float s = 0.f;
#pragma unroll
            for (int q = 0; q < 8; ++q) s += red[q * 64 + F.tid];
            MOD[l * 6 * D + j] = s + p.ada_b[l * 6 * D + j]; }
        __syncthreads();
    }
    const int n = blockIdx.x * 512 + F.tid;
    if (n < NL * 1024) { const int l = n / 1024, r = n % 1024; float v = 0.f;
        if (l == 1) { const float b0 = p.hlb[r], b1 = p.hlb[1024 + r]; v = 1.0f / (1.0f + __expf(b0 - b1)); }
        LBV[n] = v; }
}

__device__ __forceinline__ void norm_mod_row(const f32x4 (&v)[4], float ss, const float* __restrict__ w, const float* __restrict__ scale,
                                             const float* __restrict__ shift, bf16_t* __restrict__ orow, int lane, f32x4 (&h)[4], unsigned char* __restrict__ orow8 = nullptr) {
    const float r = rsqrtf(ss * (1.0f / D) + EPS);
#pragma unroll
    for (int j = 0; j < 4; ++j) {
        const int c0 = 4 * lane + 256 * j;
        const f32x4 wv = *(const f32x4*)(w + c0), sv = *(const f32x4*)(scale + c0), bv = *(const f32x4*)(shift + c0);
        h[j] = (v[j] * r) * wv * (sv + 1.0f) + bv;
        u32x2 o; o.x = pk2(h[j].x, h[j].y); o.y = pk2(h[j].z, h[j].w);
        *(u32x2*)(orow + c0) = o;
        if (orow8) { int wd = 0; wd = __builtin_amdgcn_cvt_pk_fp8_f32(h[j].x, h[j].y, wd, false); wd = __builtin_amdgcn_cvt_pk_fp8_f32(h[j].z, h[j].w, wd, true); *(int*)(orow8 + c0) = wd; }
    }
}
__device__ __forceinline__ void norm_mod_row_f8(const f32x4 (&v)[4], float ss, const float* __restrict__ w, const float* __restrict__ scale,
                                                const float* __restrict__ shift, unsigned char* __restrict__ orow, int lane, f32x4 (&h)[4]) {
    const float r = rsqrtf(ss * (1.0f / D) + EPS);
#pragma unroll
    for (int j = 0; j < 4; ++j) {
        const int c0 = 4 * lane + 256 * j;
        const f32x4 wv = *(const f32x4*)(w + c0), sv = *(const f32x4*)(scale + c0), bv = *(const f32x4*)(shift + c0);
        h[j] = (v[j] * r) * wv * (sv + 1.0f) + bv;
        int wd = 0; wd = __builtin_amdgcn_cvt_pk_fp8_f32(h[j].x, h[j].y, wd, false); wd = __builtin_amdgcn_cvt_pk_fp8_f32(h[j].z, h[j].w, wd, true);
        *(int*)(orow + c0) = wd;
    }
}
__device__ __forceinline__ void ph_norm1(Frame& F, const float* x, const float* w, const float* scale, const float* shift, bf16_t* HB, unsigned char* HB8) {
    const int gw = F.vcu * NWAVES + F.wave, NGW = F.G * NWAVES;
    for (int row = gw; row < S; row += NGW) {
        const f32x4* xr = (const f32x4*)(x + (size_t)row * D) + F.lane;
        f32x4 v[4], h[4]; float ss = 0.f;
#pragma unroll
        for (int j = 0; j < 4; ++j) { v[j] = xr[64 * j]; ss += (v[j].x * v[j].x + v[j].y * v[j].y) + (v[j].z * v[j].z + v[j].w * v[j].w); }
        ss = wave_sum(ss);
        norm_mod_row(v, ss, w, scale, shift, HB + (size_t)row * D, F.lane, h);
    }
}
__device__ __forceinline__ void ph_gather(Frame& F, const unsigned char* HB8, const int* IDX, unsigned char* XE8) {
    const int gw = F.vcu * NWAVES + F.wave, NGW = F.G * NWAVES;
    constexpr int PER = NE * CAP / 2048;
    if (NGW * PER == NE * CAP) {
        const int r0 = gw * PER;
        const int mine = IDX[r0 + (F.lane & 15)];
#pragma unroll
        for (int q = 0; q < PER; q += 8) {
            u32x4 a[8];
#pragma unroll
            for (int k = 0; k < 8; ++k) { const int t = __builtin_amdgcn_readlane(mine, q + k); a[k] = ((const u32x4*)(HB8 + (size_t)t * D))[F.lane]; }
#pragma unroll
            for (int k = 0; k < 8; ++k) ((u32x4*)(XE8 + (size_t)(r0 + q + k) * D))[F.lane] = a[k];
        }
    } else {
        for (int r = gw; r < NE * CAP; r += NGW) { const int t = IDX[r]; ((u32x4*)(XE8 + (size_t)r * D))[F.lane] = ((const u32x4*)(HB8 + (size_t)t * D))[F.lane]; }
    }
}

#define OPAQUE_LANE() const int lane = lane_id_opaque(); const int t_ = F.wave * 64 + lane
__device__ __forceinline__ void ph_rope_table(Frame& F, float* ROPE) {
    OPAQUE_LANE();
    const int n = blockIdx.x * 512 + t_;
    if (n < 4096) { const int pos = n >> 4, i = n & 15; const float inv = exp2f(-(float)i * (13.287712379549449f / 16.0f)); float sn, cs; sincosf((float)pos * inv, &sn, &cs); ROPE[2 * n] = cs; ROPE[2 * n + 1] = sn; }
}
__device__ __forceinline__ void ph_qkprep(Frame& F, const bf16_t* __restrict__ QR, const bf16_t* __restrict__ KR, const float* __restrict__ qw, const float* __restrict__ kw,
                                          const float* __restrict__ ROPE, bf16_t* __restrict__ QN, bf16_t* __restrict__ KN, unsigned char* __restrict__ Q8, unsigned char* __restrict__ K8, int rank, int nranks) {
    OPAQUE_LANE(); (void)lane;
    if (rank < 0) return;
    for (int gid = rank * 512 + t_; gid < S * 10; gid += nranks * 512) {
        const int t = gid / 10, hh = gid % 10;
        const bool isq = hh < 8;
        const bf16_t* src = isq ? QR + (size_t)t * 512 + hh * 64 : KR + (size_t)t * 128 + (hh - 8) * 64;
        bf16_t* dst = isq ? QN + (size_t)t * 512 + hh * 64 : KN + (size_t)t * 128 + (hh - 8) * 64;
        const float* w = isq ? qw : kw;
        float f[64]; float ss = 0.f;
#pragma unroll
        for (int i = 0; i < 8; ++i) { const u32x4 q = *(const u32x4*)(src + 8 * i);
#pragma unroll
            for (int j = 0; j < 4; ++j) { f[8 * i + 2 * j] = bflo(q[j]); f[8 * i + 2 * j + 1] = bfhi(q[j]); } }
#pragma unroll
        for (int i = 0; i < 64; ++i) ss += f[i] * f[i];
        const float rn = rsqrtf(ss * (1.0f / 64.0f) + EPS), sc = isq ? C2 : 1.0f;
#pragma unroll
        for (int i = 0; i < 16; ++i) { const f32x4 wv = *(const f32x4*)(w + 4 * i);
            f[4 * i] *= rn * wv.x; f[4 * i + 1] *= rn * wv.y; f[4 * i + 2] *= rn * wv.z; f[4 * i + 3] *= rn * wv.w; }
        float o[64];
#pragma unroll
        for (int ax = 0; ax < 2; ++ax) {
            const float* tb = ROPE + (size_t)(ax == 0 ? (t >> 6) : (t & 63)) * 32;
#pragma unroll
            for (int i2 = 0; i2 < 8; ++i2) { const f32x4 cs = *(const f32x4*)(tb + 4 * i2);
#pragma unroll
                for (int k = 0; k < 2; ++k) { const int i = 2 * i2 + k; const float c_ = k ? cs.z : cs.x, s_ = k ? cs.w : cs.y;
                    const float x1 = f[ax * 32 + i], x2 = f[ax * 32 + 16 + i];
                    o[ax * 32 + i] = (x1 * c_ - x2 * s_) * sc; o[ax * 32 + 16 + i] = (x2 * c_ + x1 * s_) * sc; } }
        }
#if KEEP_BF16_QK
#pragma unroll
        for (int i = 0; i < 8; ++i) { u32x4 q;
#pragma unroll
            for (int j = 0; j < 4; ++j) q[j] = pk2(o[8 * i + 2 * j], o[8 * i + 2 * j + 1]);
            *(u32x4*)(dst + 8 * i) = q; }
#else
        (void)dst;
#endif
        unsigned char* dst8 = isq ? Q8 + (size_t)t * 512 + hh * 64 : K8 + (size_t)t * 128 + (hh - 8) * 64;
#pragma unroll
        for (int i = 0; i < 4; ++i) { u32x4 q;
#pragma unroll
            for (int j = 0; j < 4; ++j) { int wd = 0; wd = __builtin_amdgcn_cvt_pk_fp8_f32(o[16 * i + 4 * j], o[16 * i + 4 * j + 1], wd, false); wd = __builtin_amdgcn_cvt_pk_fp8_f32(o[16 * i + 4 * j + 2], o[16 * i + 4 * j + 3], wd, true); q[j] = (unsigned)wd; }
            *(u32x4*)(dst8 + 16 * i) = q; }
    }
}
__device__ __forceinline__ void ph_v8t(Frame& F, const bf16_t* __restrict__ VV, unsigned char* __restrict__ V8T) {
    OPAQUE_LANE();
    const int gw = F.vcu * NWAVES + F.wave, NGW = F.G * NWAVES;
    for (int it = gw; it < 2 * (S / 64); it += NGW) {
        const int kvh = it / (S / 64), tile = it % (S / 64);
        const bf16_t* src = VV + (size_t)(64 * tile) * 128 + kvh * 64 + lane;
        u32x4 ov[4];
#pragma unroll
        for (int hi = 0; hi < 2; ++hi)
#pragma unroll
            for (int k = 0; k < 8; ++k) {
                float v[4];
#pragma unroll
                for (int b = 0; b < 4; ++b) { const int j = 4 * k + b; const int key = j < 16 ? ((j & 3) + 8 * (j >> 2) + 4 * hi) : 32 + (((j - 16) & 3) + 8 * ((j - 16) >> 2) + 4 * hi); v[b] = bf2f(src[(size_t)key * 128]); }
                int wd = 0; wd = __builtin_amdgcn_cvt_pk_fp8_f32(v[0], v[1], wd, false); wd = __builtin_amdgcn_cvt_pk_fp8_f32(v[2], v[3], wd, true);
                ov[hi * 2 + (k >> 2)][k & 3] = (unsigned)wd;
            }
        unsigned char* dst = V8T + ((size_t)it * 64 + lane) * 64;
#pragma unroll
        for (int q = 0; q < 4; ++q) *(u32x4*)(dst + 16 * q) = ov[q];
    }
}
__device__ __forceinline__ void ph_hgfin(Frame& F, const float* __restrict__ OF, const bf16_t* __restrict__ HG, const float* __restrict__ w, bf16_t* __restrict__ OHG) {
    OPAQUE_LANE();
    const int gw = F.vcu * NWAVES + F.wave, NGW = F.G * NWAVES;
    const int e0 = (lane & 15) * 8;
    const f32x4 w0 = *(const f32x4*)(w + e0), w1 = *(const f32x4*)(w + e0 + 4);
    for (int t = gw; t < S; t += NGW) {
        const size_t off = (size_t)t * 512 + lane * 8;
        const f32x4 a0 = *(const f32x4*)(OF + off), a1 = *(const f32x4*)(OF + off + 4), b0 = *(const f32x4*)(OF + (size_t)S * 512 + off), b1 = *(const f32x4*)(OF + (size_t)S * 512 + off + 4);
        const f32x4 s0 = a0 + b0, s1 = a1 + b1;
        float ss = (s0.x * s0.x + s0.y * s0.y) + (s0.z * s0.z + s0.w * s0.w) + (s1.x * s1.x + s1.y * s1.y) + (s1.z * s1.z + s1.w * s1.w);
        ss += __shfl_xor(ss, 1); ss += __shfl_xor(ss, 2); ss += __shfl_xor(ss, 4); ss += __shfl_xor(ss, 8);
        const float r = rsqrtf(ss * (1.0f / 128.0f) + EPS);
        const u32x4 g = *(const u32x4*)(HG + off);
        u32x4 o;
        o.x = pk2(s0.x * r * w0.x * bflo(g.x), s0.y * r * w0.y * bfhi(g.x));
        o.y = pk2(s0.z * r * w0.z * bflo(g.y), s0.w * r * w0.w * bfhi(g.y));
        o.z = pk2(s1.x * r * w1.x * bflo(g.z), s1.y * r * w1.y * bfhi(g.z));
        o.w = pk2(s1.z * r * w1.z * bflo(g.w), s1.w * r * w1.w * bfhi(g.w));
        *(u32x4*)(OHG + off) = o;
    }
}
__device__ __forceinline__ void ph_norm2_router(Frame& F, const float* __restrict__ X1, const float* __restrict__ w, const float* __restrict__ scale, const float* __restrict__ shift,
                                                const float* __restrict__ wr, unsigned char* __restrict__ HB, float* __restrict__ AFF) {
    OPAQUE_LANE();
    LAS float* WT = (LAS float*)F.lds;
    for (int dd = t_; dd < D; dd += NWAVES * 64) {
        const GAS f32x4* s = (const GAS f32x4*)((const GAS float*)wr + (size_t)dd * 16);
        const f32x4 a = s[0], b = s[1], c = s[2], e = s[3];
        WT[0 * D + dd] = a.x; WT[1 * D + dd] = a.y; WT[2 * D + dd] = a.z; WT[3 * D + dd] = a.w; WT[4 * D + dd] = b.x; WT[5 * D + dd] = b.y; WT[6 * D + dd] = b.z; WT[7 * D + dd] = b.w;
        WT[8 * D + dd] = c.x; WT[9 * D + dd] = c.y; WT[10 * D + dd] = c.z; WT[11 * D + dd] = c.w; WT[12 * D + dd] = e.x; WT[13 * D + dd] = e.y; WT[14 * D + dd] = e.z; WT[15 * D + dd] = e.w;
    }
    __syncthreads();
    const int gw = F.vcu * NWAVES + F.wave, NGW = F.G * NWAVES;
    for (int row = gw; row < S; row += 2 * NGW) {
        const int row1 = (row + NGW < S) ? row + NGW : row;
        const f32x4* xr0 = (const f32x4*)(X1 + (size_t)row * D) + lane; const f32x4* xr1 = (const f32x4*)(X1 + (size_t)row1 * D) + lane;
        f32x4 v0[4], v1[4], h0[4], h1[4]; float ss0 = 0.f, ss1 = 0.f;
#pragma unroll
        for (int j = 0; j < 4; ++j) { v0[j] = xr0[64 * j]; v1[j] = xr1[64 * j]; }
#pragma unroll
        for (int j = 0; j < 4; ++j) { ss0 += (v0[j].x * v0[j].x + v0[j].y * v0[j].y) + (v0[j].z * v0[j].z + v0[j].w * v0[j].w); ss1 += (v1[j].x * v1[j].x + v1[j].y * v1[j].y) + (v1[j].z * v1[j].z + v1[j].w * v1[j].w); }
        ss0 = wave_sum(ss0); ss1 = wave_sum(ss1);
        norm_mod_row_f8(v0, ss0, w, scale, shift, HB + (size_t)row * D, lane, h0);
        norm_mod_row_f8(v1, ss1, w, scale, shift, HB + (size_t)row1 * D, lane, h1);
        LAS float* wt = WT + 4 * lane; asm volatile("" : "+v"(wt));
        f32x4 lg0[4], lg1[4];
#pragma unroll
        for (int e = 0; e < 16; ++e) {
            float a0 = 0.f, a1 = 0.f;
#pragma unroll
            for (int j = 0; j < 4; ++j) { const f32x4 ww = *(const LAS f32x4*)(wt + e * D + 256 * j);
                a0 += (h0[j].x * ww.x + h0[j].y * ww.y) + (h0[j].z * ww.z + h0[j].w * ww.w); a1 += (h1[j].x * ww.x + h1[j].y * ww.y) + (h1[j].z * ww.z + h1[j].w * ww.w); }
            lg0[e >> 2][e & 3] = wave_sum(a0); lg1[e >> 2][e & 3] = wave_sum(a1);
        }
#pragma unroll
        for (int rr = 0; rr < 2; ++rr) {
            f32x4 (&lgv)[4] = rr ? lg1 : lg0;
            float mx = -1e30f;
#pragma unroll
            for (int e4 = 0; e4 < 4; ++e4) mx = fmaxf(mx, fmaxf(fmaxf(lgv[e4].x, lgv[e4].y), fmaxf(lgv[e4].z, lgv[e4].w)));
            float den = 0.f;
#pragma unroll
            for (int e4 = 0; e4 < 4; ++e4) { lgv[e4].x = __expf(lgv[e4].x - mx); lgv[e4].y = __expf(lgv[e4].y - mx); lgv[e4].z = __expf(lgv[e4].z - mx); lgv[e4].w = __expf(lgv[e4].w - mx);
                den += (lgv[e4].x + lgv[e4].y) + (lgv[e4].z + lgv[e4].w); }
            const float inv = 1.0f / den;
            const f32x4 s8a = (lane & 8) ? lgv[2] : lgv[0], s8b = (lane & 8) ? lgv[3] : lgv[1];
            const f32x4 s4 = (lane & 4) ? s8b : s8a;
            const float s2a = (lane & 2) ? s4.z : s4.x, s2b = (lane & 2) ? s4.w : s4.y;
            const float mine = ((lane & 1) ? s2b : s2a) * inv;
            const int rw = rr ? row1 : row;
            if (lane < 16 && (rr == 0 || row1 != row)) AFF[(size_t)lane * S + rw] = mine;
        }
    }
    __syncthreads();
}
__device__ __forceinline__ void ph_topk(Frame& F, LAS unsigned char* lds, int e, const float* __restrict__ AFF, int* __restrict__ IDX, float* __restrict__ TOPW, int* __restrict__ SLOT) {
    LAS unsigned* hist = (LAS unsigned*)lds;
    LAS unsigned* hsum = hist + 4096;
    LAS unsigned* shv = hsum + 256;
    LAS unsigned* scan = hsum + 512;
    OPAQUE_LANE(); const int tid = t_;
    const unsigned* vals = (const unsigned*)(AFF + (size_t)e * S);
    unsigned u[32];
#pragma unroll
    for (int i = 0; i < 8; ++i) { const u32x4 q = *(const u32x4*)(vals + tid * 32 + 4 * i); u[4 * i] = q.x; u[4 * i + 1] = q.y; u[4 * i + 2] = q.z; u[4 * i + 3] = q.w; }
    if (tid == 0) { shv[0] = 0u; shv[1] = CAP; }
    LAS unsigned* myh = hist + (lane & 15) * 256;
    __syncthreads();
    for (int pass = 3; pass >= 0; --pass) {
        const int shift = pass * 8;
        const unsigned mask = pass == 3 ? 0u : (0xFFFFFFFFu << (shift + 8));
#pragma unroll
        for (int i = 0; i < 8; ++i) hist[tid + 512 * i] = 0u;
        __syncthreads();
        const unsigned prefix = shv[0];
#pragma unroll
        for (int i = 0; i < 32; ++i) if ((u[i] & mask) == (prefix & mask)) __hip_atomic_fetch_add(&myh[(u[i] >> shift) & 255u], 1u, __ATOMIC_RELAXED, __HIP_MEMORY_SCOPE_WORKGROUP);
        __syncthreads();
        if (tid < 256) { unsigned s = 0u;
#pragma unroll
            for (int c = 0; c < 16; ++c) s += hist[c * 256 + tid];
            hsum[tid] = s; }
        __syncthreads();
        if (tid < 64) {
            const unsigned kk = shv[1];
            const unsigned h0 = hsum[4 * lane], h1 = hsum[4 * lane + 1], h2 = hsum[4 * lane + 2], h3 = hsum[4 * lane + 3];
            const unsigned tot = (h0 + h1) + (h2 + h3);
            unsigned inc = tot;
#pragma unroll
            for (int o = 1; o < 64; o <<= 1) { const unsigned v = __shfl_down(inc, o); if (lane + o < 64) inc += v; }
            unsigned c = inc - tot; int bin = -1; unsigned rem = 0u;
            if (c < kk && c + h3 >= kk) { bin = 4 * lane + 3; rem = kk - c; } c += h3;
            if (c < kk && c + h2 >= kk) { bin = 4 * lane + 2; rem = kk - c; } c += h2;
            if (c < kk && c + h1 >= kk) { bin = 4 * lane + 1; rem = kk - c; } c += h1;
            if (c < kk && c + h0 >= kk) { bin = 4 * lane; rem = kk - c; }
            if (bin >= 0) { shv[1] = rem; shv[0] = prefix | ((unsigned)bin << shift); }
        }
        __syncthreads();
    }
    const unsigned T = shv[0], need_eq = shv[1];
    unsigned ceq = 0u;
#pragma unroll
    for (int i = 0; i < 32; ++i) ceq += (u[i] == T) ? 1u : 0u;
    scan[tid] = ceq; __syncthreads();
    for (int off = 1; off < 512; off <<= 1) { const unsigned tv = tid >= off ? scan[tid - off] : 0u; __syncthreads(); scan[tid] += tv; __syncthreads(); }
    unsigned eq_rank = scan[tid] - ceq;
    __syncthreads();
    unsigned selmask = 0u, csel = 0u;
#pragma unroll
    for (int i = 0; i < 32; ++i) { bool sel = u[i] > T; if (u[i] == T) { sel = eq_rank < need_eq; ++eq_rank; } if (sel) { selmask |= 1u << i; ++csel; } }
    scan[tid] = csel; __syncthreads();
    for (int off = 1; off < 512; off <<= 1) { const unsigned tv = tid >= off ? scan[tid - off] : 0u; __syncthreads(); scan[tid] += tv; __syncthreads(); }
    unsigned slot = scan[tid] - csel;
#pragma unroll
    for (int i = 0; i < 32; ++i) {
        const int t = tid * 32 + i; int sl = -1;
        if (selmask & (1u << i)) { sl = (int)slot; ++slot; if (sl < CAP) { IDX[e * CAP + sl] = t; TOPW[e * CAP + sl] = __uint_as_float(u[i]); } }
        SLOT[(size_t)e * S + t] = sl < CAP ? sl : -1;
    }
    __syncthreads();
}
__device__ __forceinline__ void ph_combine(Frame& F, const float* __restrict__ X1, const bf16_t* __restrict__ YE, const int* __restrict__ SLOT, const float* __restrict__ gate,
                                           float* __restrict__ xout, const float* __restrict__ w, const float* __restrict__ scale, const float* __restrict__ shift, bf16_t* __restrict__ HB, unsigned char* __restrict__ HB8, bool do_norm) {
    OPAQUE_LANE();
    const int gw = F.vcu * NWAVES + F.wave, NGW = F.G * NWAVES;
    for (int row = gw; row < S; row += 2 * NGW) {
        const bool two = row + NGW < S; const int row1 = two ? row + NGW : row;
        const int sl0 = lane < NE ? SLOT[(size_t)lane * S + row] : -1, sl1 = lane < NE ? SLOT[(size_t)lane * S + row1] : -1;
        const f32x4* xr0 = (const f32x4*)(X1 + (size_t)row * D) + lane; const f32x4* xr1 = (const f32x4*)(X1 + (size_t)row1 * D) + lane;
        f32x4 v0[4], v1[4];
#pragma unroll
        for (int j = 0; j < 4; ++j) { v0[j] = xr0[64 * j]; v1[j] = xr1[64 * j]; }
        f32x4 acc0[4], acc1[4];
#pragma unroll
        for (int j = 0; j < 4; ++j) { acc0[j] = f32x4{0.f, 0.f, 0.f, 0.f}; acc1[j] = acc0[j]; }
        unsigned m0 = (unsigned)__ballot(sl0 >= 0) & 0xffffu, m1 = (unsigned)__ballot(sl1 >= 0) & 0xffffu;
        while (m0 | m1) {
            const int e0 = m0 ? __builtin_ctz(m0) : 0, e1 = m1 ? __builtin_ctz(m1) : 0;
            const float f0 = m0 ? 1.f : 0.f, f1 = m1 ? 1.f : 0.f;
            const int s0 = m0 ? __builtin_amdgcn_readlane(sl0, e0) : 0, s1 = m1 ? __builtin_amdgcn_readlane(sl1, e1) : 0;
            m0 &= m0 - 1u; m1 &= m1 - 1u;
            const bf16_t* y0 = YE + ((size_t)e0 * CAP + s0) * D + 4 * lane; const bf16_t* y1 = YE + ((size_t)e1 * CAP + s1) * D + 4 * lane;
            u32x2 q0[4], q1[4];
#pragma unroll
            for (int j = 0; j < 4; ++j) { q0[j] = *(const u32x2*)(y0 + 256 * j); q1[j] = *(const u32x2*)(y1 + 256 * j); }
#pragma unroll
            for (int j = 0; j < 4; ++j) { acc0[j].x += f0 * bflo(q0[j].x); acc0[j].y += f0 * bfhi(q0[j].x); acc0[j].z += f0 * bflo(q0[j].y); acc0[j].w += f0 * bfhi(q0[j].y);
                                          acc1[j].x += f1 * bflo(q1[j].x); acc1[j].y += f1 * bfhi(q1[j].x); acc1[j].z += f1 * bflo(q1[j].y); acc1[j].w += f1 * bfhi(q1[j].y); }
        }
        f32x4 h[4]; float ss0 = 0.f, ss1 = 0.f;
#pragma unroll
        for (int j = 0; j < 4; ++j) { const f32x4 gv = *(const f32x4*)(gate + 4 * lane + 256 * j); v0[j] = v0[j] + gv * acc0[j]; v1[j] = v1[j] + gv * acc1[j];
            ((f32x4*)(xout + (size_t)row * D) + lane)[64 * j] = v0[j]; if (two) ((f32x4*)(xout + (size_t)row1 * D) + lane)[64 * j] = v1[j];
            ss0 += (v0[j].x * v0[j].x + v0[j].y * v0[j].y) + (v0[j].z * v0[j].z + v0[j].w * v0[j].w); ss1 += (v1[j].x * v1[j].x + v1[j].y * v1[j].y) + (v1[j].z * v1[j].z + v1[j].w * v1[j].w); }
        if (do_norm) { ss0 = wave_sum(ss0); ss1 = wave_sum(ss1); norm_mod_row(v0, ss0, w, scale, shift, HB + (size_t)row * D, lane, h); if (two) norm_mod_row(v1, ss1, w, scale, shift, HB + (size_t)row1 * D, lane, h); }
    }
}

__global__ void __launch_bounds__(NWAVES * 64, 2) mega(Params p) {
    extern __shared__ __attribute__((aligned(16))) unsigned char lds[];
    Frame F;
    F.lds = (LAS unsigned char*)lds;
    volatile LAS unsigned* MISC = (volatile LAS unsigned*)(F.lds + MISC_OFF);
    F.tid = threadIdx.x; F.lane = F.tid & 63; F.wave = __builtin_amdgcn_readfirstlane(F.tid >> 6);
    F.G = gridDim.x; { const int bx = blockIdx.x; F.vcu = (F.G % 8 == 0) ? (bx % 8) * (F.G / 8) + bx / 8 : bx; }
    unsigned char* ws = p.ws;
    unsigned* ctl = (unsigned*)(ws + WS_CTL);
    for (int u = F.tid; u < (LDS_BYTES - LDSCTL_OFF) / 4; u += NWAVES * 64) ((LAS unsigned*)(F.lds + LDSCTL_OFF))[u] = 0u;
    __syncthreads();
    XcdBarrier bar = xcd_barrier_post(ctl + CW_BAR + p.li * XCD_BAR_WORDS, MISC + 8);
    const int lo = p.ph_lo, hi = p.ph_hi;
#define IN(k) (lo <= (k) && (k) < hi)
#define SEAM(k) do { if (IN(k) && IN((k) + 1)) xcd_barrier(bar); } while (0)
#define REFRESH() do { F.lane = lane_id_opaque(); F.tid = F.wave * 64 + F.lane; } while (0)

#define WSP(T, off) ((T*)(GAS T*)(wsl + (off)))
#define WSL() GAS unsigned char* wsl = (GAS unsigned char*)p.ws; asm volatile("" : "+s"(wsl))
    LAS float* scr = (LAS float*)(F.lds + RING_OFF + F.wave * 8704);

    if (IN(PH_PRO)) { REFRESH(); WSL();
        mod_units(F, p);
        for (int l = 0; l < NL; ++l) {
            conv_matrix(F, p.w_in + (size_t)l * D * INW, INW, D, INW, WSP(bf16_t, WS_WIN) + (size_t)l * INW * D, scr);
            conv_matrix(F, p.w_ba + (size_t)l * 512 * D, D, 512, D, WSP(bf16_t, WS_WBA) + (size_t)l * D * 512, scr);
            conv_matrix(F, p.w_bh + (size_t)l * 512 * D, D, 512, D, WSP(bf16_t, WS_WBH) + (size_t)l * D * 512, scr);
            conv_matrix(F, p.w_out + (size_t)l * D * D, D, D, D, WSP(bf16_t, WS_WOUT) + (size_t)l * D * D, scr);
        }
        for (int rep_ = 0; rep_ < REP_PRO; ++rep_) { conv_experts_f8(F, p, 0, scr); conv_experts_f8(F, p, 1, scr); }
        ph_rope_table(F, WSP(float, WS_ROPE));
    }
    SEAM(PH_PRO);
    if (IN(PH_NORM1)) { REFRESH(); WSL(); ph_norm1(F, p.x, p.norm_mix_w, WSP(float, WS_MOD) + 1 * D, WSP(float, WS_MOD) + 0 * D, WSP(bf16_t, WS_HB), WSP(unsigned char, WS_HBF8)); }
    SEAM(PH_NORM1);

    for (int l = 0; l < NL; ++l) {
        const int pb = PH_L0 + l * NPL;
        if (IN(pb + P_G1)) { WSL();
            pg8::Gemm g{WSP(bf16_t, WS_HB), WSP(bf16_t, WS_WIN) + (size_t)l * INW * D, S, 3072, D}; pg8::StaticOrder So; So.init(S, 3072, F.G, (int)blockIdx.x);
            pg8::EpiInproj E{WSP(bf16_t, WS_QR), WSP(bf16_t, WS_KR), WSP(bf16_t, WS_VV), WSP(bf16_t, WS_HQ), WSP(bf16_t, WS_KF), WSP(bf16_t, WS_HV), WSP(bf16_t, WS_HG), WSP(bf16_t, WS_GG), WSP(float, WS_LF), WSP(float, WS_LBV) + l * 1024, 1.0f};
            for (int rep_ = 0; rep_ < REP_G; ++rep_) pg8::gemm_phase<pg8::EpiInproj, pg8::StaticOrder, true, true>(F.lds + RING_OFF, g, So, E, F.wave);
        }
        SEAM(pb + P_G1);
        if (IN(pb + P_QKP)) { WSL();
            {
              pg8::Gemm g{WSP(bf16_t, WS_HB), WSP(bf16_t, WS_WIN) + (size_t)l * INW * D + (size_t)3072 * D, S, 2304, D}; pg8::OffOrder So; So.So.init(S, 2304, F.G, (int)blockIdx.x); So.off = 12;
              pg8::EpiInproj E{WSP(bf16_t, WS_QR), WSP(bf16_t, WS_KR), WSP(bf16_t, WS_VV), WSP(bf16_t, WS_HQ), WSP(bf16_t, WS_KF), WSP(bf16_t, WS_HV), WSP(bf16_t, WS_HG), WSP(bf16_t, WS_GG), WSP(float, WS_LF), WSP(float, WS_LBV) + l * 1024, 1.0f};
              for (int rep_ = 0; rep_ < REP_G; ++rep_) pg8::gemm_phase<pg8::EpiInproj, pg8::OffOrder, true, true>(F.lds + RING_OFF, g, So, E, F.wave); }
            { const bool even = (F.G == 256); const int rk = even ? (int)blockIdx.x - 64 : (int)blockIdx.x, nr = even ? 192 : F.G;
              for (int rep_ = 0; rep_ < REP_QK; ++rep_) ph_qkprep(F, WSP(bf16_t, WS_QR), WSP(bf16_t, WS_KR), p.q_norm_w + l * 64, p.k_norm_w + l * 64, WSP(float, WS_ROPE), WSP(bf16_t, WS_QN), WSP(bf16_t, WS_KN), WSP(unsigned char, WS_Q8), WSP(unsigned char, WS_K8), rk, nr);
              ph_v8t(F, WSP(bf16_t, WS_VV), WSP(unsigned char, WS_V8T)); }
            for (int rep_ = 0; rep_ < REP_HG; ++rep_) for (int u = blockIdx.x; u < 256; u += F.G) hg::segment<false>(F.lds, u, WSP(bf16_t, WS_HQ), WSP(float, WS_LF), WSP(bf16_t, WS_KF), WSP(bf16_t, WS_HV), WSP(float, WS_HST), WSP(float, WS_HST + 16 * MiB), nullptr, F.wave);
        }
        SEAM(pb + P_QKP);
        if (IN(pb + P_HGB)) { WSL(); OPAQUE_LANE(); (void)lane;
            for (int gid = blockIdx.x * 512 + t_; gid < 8 * 16384; gid += F.G * 512) hg::carry(WSP(float, WS_HST), WSP(float, WS_HST + 16 * MiB), gid);
        }
        SEAM(pb + P_HGB);
        if (IN(pb + P_HGC)) { WSL();
            for (int rep_ = 0; rep_ < REP_HG; ++rep_) for (int u = blockIdx.x; u < 256; u += F.G) hg::segment<true>(F.lds, u, WSP(bf16_t, WS_HQ), WSP(float, WS_LF), WSP(bf16_t, WS_KF), WSP(bf16_t, WS_HV), WSP(float, WS_HST), WSP(float, WS_HST + 16 * MiB), WSP(float, WS_OF), F.wave);
        }
        SEAM(pb + P_HGC);
        if (IN(pb + P_ATT)) { WSL();
            for (int rep_ = 0; rep_ < REP_QK; ++rep_) ph_hgfin(F, WSP(float, WS_OF), WSP(bf16_t, WS_HG), p.hg_norm_w + l * 128, WSP(bf16_t, WS_OHG));
            float negM;
            { const int ln = lane_id_opaque(); float mq = fabsf(p.q_norm_w[l * 64 + ln]), mk = fabsf(p.k_norm_w[l * 64 + ln]);
#pragma unroll
              for (int o_ = 1; o_ < 64; o_ <<= 1) { mq = fmaxf(mq, __shfl_xor(mq, o_)); mk = fmaxf(mk, __shfl_xor(mk, o_)); }
              negM = -(64.0f * C2) * mq * mk * 1.05f; }
#if ATTN_FP8
            const attn8::Tensors AT{WSP(unsigned char, WS_Q8), WSP(unsigned char, WS_K8), WSP(unsigned char, WS_V8T), (attn8::bf16*)WSP(bf16_t, WS_OATT)};
            for (int rep_ = 0; rep_ < REP_ATT; ++rep_) attn8::phase((char*)lds + RING_OFF, AT, (int)F.G, (int)blockIdx.x, F.wave, negM + 8.0f);
#else
            const attn_body::AttnTensors AT{(const attn_body::bf16*)WSP(bf16_t, WS_QN), (const attn_body::bf16*)WSP(bf16_t, WS_KN), (const attn_body::bf16*)WSP(bf16_t, WS_VV), (attn_body::bf16*)WSP(bf16_t, WS_OATT)};
            const attn_body::StaticOrder So((int)F.G, (int)blockIdx.x);
            for (int rep_ = 0; rep_ < REP_ATT; ++rep_) attn_body::attn_phase<attn_body::StaticOrder>((char*)lds + RING_OFF, AT, So, F.wave, negM);
#endif
        }
        SEAM(pb + P_ATT);
        if (IN(pb + P_G2)) { WSL();
            pg8::Gemm g{WSP(bf16_t, WS_OATT), WSP(bf16_t, WS_WBA) + (size_t)l * D * 512, S, D, 512, WSP(bf16_t, WS_OHG), WSP(bf16_t, WS_WBH) + (size_t)l * D * 512};
            pg8::ChainOrder So; So.So.init(S, D, F.G, (int)blockIdx.x);
            pg8::EpiMerge E{WSP(bf16_t, WS_GG), WSP(bf16_t, WS_MG)};
            for (int rep_ = 0; rep_ < REP_G; ++rep_) pg8::gemm_phase<pg8::EpiMerge, pg8::ChainOrder, false, true>(F.lds + RING_OFF, g, So, E, F.wave);
        }
        SEAM(pb + P_G2);
        if (IN(pb + P_G3)) { WSL();
            pg8::Gemm g{WSP(bf16_t, WS_MG), WSP(bf16_t, WS_WOUT) + (size_t)l * D * D, S, D, D}; pg8::StaticOrder So; So.init(S, D, F.G, (int)blockIdx.x);
            pg8::EpiOut E{l == 0 ? p.x : WSP(float, WS_X2), WSP(float, WS_MOD) + l * 6 * D + 2 * D, WSP(float, WS_X1)};
            for (int rep_ = 0; rep_ < REP_G; ++rep_) pg8::gemm_phase<pg8::EpiOut, pg8::StaticOrder, false, true>(F.lds + RING_OFF, g, So, E, F.wave);
        }
        SEAM(pb + P_G3);
        if (IN(pb + P_N2R)) { WSL();
            for (int rep_ = 0; rep_ < REP_ROW; ++rep_) ph_norm2_router(F, WSP(float, WS_X1), p.norm_ffn_w + l * D, WSP(float, WS_MOD) + l * 6 * D + 4 * D, WSP(float, WS_MOD) + l * 6 * D + 3 * D, p.w_router + (size_t)l * D * NE, WSP(unsigned char, WS_HB8), WSP(float, WS_AFF));
        }
        SEAM(pb + P_N2R);
        if (IN(pb + P_TOPK)) { WSL();
            for (int rep_ = 0; rep_ < REP_TK; ++rep_) for (int e = blockIdx.x; e < NE; e += F.G) ph_topk(F, F.lds, e, WSP(float, WS_AFF), WSP(int, WS_IDX), WSP(float, WS_TOPW), WSP(int, WS_SLOT));
        }
        SEAM(pb + P_TOPK);
        if (IN(pb + P_GATH)) { REFRESH(); WSL(); for (int rep_ = 0; rep_ < REP_ROW; ++rep_) ph_gather(F, WSP(unsigned char, WS_HB8), WSP(int, WS_IDX), WSP(unsigned char, WS_XE8)); }
        SEAM(pb + P_GATH);
        if (IN(pb + P_G4)) { WSL();
            pg8::Gemm g{(const bf16_t*)WSP(unsigned char, WS_XE8), (const bf16_t*)(WSP(unsigned char, WS_WGU) + (size_t)l * 64 * MiB), NE * CAP, NE * 4096, D / 2}; pg8::GroupOrder So; So.init(16, F.G, (int)blockIdx.x);
            pg8::EpiGU8 E{WSP(unsigned char, WS_HID8)};
            for (int rep_ = 0; rep_ < REP_G; ++rep_) pg8::gemm_phase<pg8::EpiGU8, pg8::GroupOrder, true, true, true>(F.lds + RING_OFF, g, So, E, F.wave);
        }
        SEAM(pb + P_G4);
        if (IN(pb + P_G5)) { WSL();
            pg8::Gemm g{(const bf16_t*)WSP(unsigned char, WS_HID8), (const bf16_t*)(WSP(unsigned char, WS_WD) + (size_t)l * 32 * MiB), NE * CAP, NE * 1024, FF / 2}; pg8::GroupOrder So; So.init(4, F.G, (int)blockIdx.x);
            pg8::EpiDown E{WSP(bf16_t, WS_YE), WSP(float, WS_TOPW), 0.015625f};
            for (int rep_ = 0; rep_ < REP_G; ++rep_) pg8::gemm_phase<pg8::EpiDown, pg8::GroupOrder, true, true, true>(F.lds + RING_OFF, g, So, E, F.wave);
        }
        SEAM(pb + P_G5);
        if (IN(pb + P_COMB)) { WSL();
            const bool last = (l + 1 == NL); const int ln = last ? l : l + 1;
            for (int rep_ = 0; rep_ < REP_ROW; ++rep_) ph_combine(F, WSP(float, WS_X1), WSP(bf16_t, WS_YE), WSP(int, WS_SLOT), WSP(float, WS_MOD) + l * 6 * D + 5 * D, last ? p.out : WSP(float, WS_X2),
                       p.norm_mix_w + ln * D, WSP(float, WS_MOD) + ln * 6 * D + 1 * D, WSP(float, WS_MOD) + ln * 6 * D + 0 * D, WSP(bf16_t, WS_HB), WSP(unsigned char, WS_HBF8), !last);
        }
        SEAM(pb + P_COMB);
    }
#undef IN
#undef SEAM
}

#ifndef N_LAUNCH_MODE
#define N_LAUNCH_MODE 1
#endif
static int g_grid = 0;
extern "C" void kernel_launch(void* const* d_in, const int* in_sizes, int n_in, void* d_out, int out_size, void* d_ws, size_t ws_size, hipStream_t stream) {
    if (n_in != 18 || out_size != S * D || ws_size < WS_END) { fprintf(stderr, "kernel_launch: unexpected shapes (n_in %d out %d ws %zu)\n", n_in, out_size, ws_size); return; }
    if (g_grid == 0) {
        int dev = 0, cus = 0;
        if (hipGetDevice(&dev) != hipSuccess || hipDeviceGetAttribute(&cus, hipDeviceAttributeMultiprocessorCount, dev) != hipSuccess) { g_grid = -1; return; }
        if (hipFuncSetAttribute((const void*)mega, hipFuncAttributeMaxDynamicSharedMemorySize, LDS_BYTES) != hipSuccess) { g_grid = -1; return; }
        int per_cu = 0;
        if (hipOccupancyMaxActiveBlocksPerMultiprocessor(&per_cu, (const void*)mega, NWAVES * 64, LDS_BYTES) != hipSuccess || per_cu < 1) { fprintf(stderr, "occupancy query: %d\n", per_cu); }
        (void)hipGetLastError();
        g_grid = cus;
    }
    if (g_grid < 0) return;
    unsigned char* ws = (unsigned char*)d_ws;
    (void)hipMemsetAsync(ws + WS_CTL, 0, 1 * MiB, stream);
    Params p{};
    p.x = (const float*)d_in[0]; p.c = (const float*)d_in[1]; p.ada_w = (const float*)d_in[2]; p.ada_b = (const float*)d_in[3]; p.norm_mix_w = (const float*)d_in[4];
    p.norm_ffn_w = (const float*)d_in[5]; p.w_in = (const float*)d_in[6]; p.q_norm_w = (const float*)d_in[7]; p.k_norm_w = (const float*)d_in[8]; p.hlb = (const float*)d_in[9];
    p.hg_norm_w = (const float*)d_in[10]; p.w_ba = (const float*)d_in[11]; p.w_bh = (const float*)d_in[12]; p.w_out = (const float*)d_in[13]; p.w_router = (const float*)d_in[14];
    p.w_eg = (const float*)d_in[15]; p.w_eu = (const float*)d_in[16]; p.w_ed = (const float*)d_in[17];
    p.out = (float*)d_out; p.ws = ws;
#if defined(DBG_ATT)
    { const int cut = PH_L0 + P_ATT + 1;
      p.ph_lo = 0; p.ph_hi = cut; p.li = 0; p.pad = 0; hipLaunchKernelGGL(mega, dim3(g_grid), dim3(NWAVES * 64), LDS_BYTES, stream, p);
      hipMemcpyAsync(ws + 900 * MiB, ws + WS_OATT, 16 * MiB, hipMemcpyDeviceToDevice, stream);
      k_attn_naive<<<dim3(S / 64, 8), dim3(64), 0, stream>>>((const bf16_t*)(ws + WS_QN), (const bf16_t*)(ws + WS_KN), (const bf16_t*)(ws + WS_VV), (bf16_t*)(ws + WS_OATT));
      k_cmp_bf16<<<dim3(2048), dim3(256), 0, stream>>>((const bf16_t*)(ws + 900 * MiB), (const bf16_t*)(ws + WS_OATT), (size_t)8 * MiB, 512, 0, 512, (float*)(ws + 512 * 1024));
      p.ph_lo = cut; p.ph_hi = PH_END; p.li = 1; hipLaunchKernelGGL(mega, dim3(g_grid), dim3(NWAVES * 64), LDS_BYTES, stream, p);
      k_scale_out<<<dim3(2048), dim3(256), 0, stream>>>((float*)d_out, (size_t)S * D, (const float*)(ws + 512 * 1024)); }
#elif N_LAUNCH_MODE == 1
    p.ph_lo = 0; p.ph_hi = PH_END; p.li = 0; p.pad = 0;
    hipLaunchKernelGGL(mega, dim3(g_grid), dim3(NWAVES * 64), LDS_BYTES, stream, p);
#else
    for (int k = 0; k < PH_END; ++k) { p.ph_lo = k; p.ph_hi = k + 1; p.li = k; p.pad = 0; hipLaunchKernelGGL(mega, dim3(g_grid), dim3(NWAVES * 64), LDS_BYTES, stream, p); }
#endif
}
```

```cpp
#include <hip/hip_runtime.h>
#include <cstdio>
#include <cstdint>

typedef unsigned short bf16_t;
typedef float f32x4 __attribute__((ext_vector_type(4)));
typedef float f32x16 __attribute__((ext_vector_type(16)));
typedef unsigned u32x4 __attribute__((ext_vector_type(4)));
typedef unsigned u32x2 __attribute__((ext_vector_type(2)));

constexpr int S = 16384, D = 1024, NL = 2, INW = 5376;
constexpr int NE = 16, CAP = 2048, FF = 2048;
constexpr float EPS = 1e-6f;
constexpr float C2 = 0.125f * 1.4426950408889634f;
constexpr int C_AQ = 0, C_AK = 512, C_AV = 640, C_HQ = 768, C_ZF = 1280, C_ZB = 1792, C_HI = 2304, C_HGT = 2816, C_GL = 3328;

constexpr size_t MiB = 1u << 20;
constexpr size_t WS_CTL = 0;
constexpr size_t WS_MOD = 1 * MiB;
constexpr size_t WS_LBV = WS_MOD + 64 * 1024;
constexpr size_t WS_IDX = WS_MOD + 128 * 1024;
constexpr size_t WS_TOPW = WS_IDX + 128 * 1024;
constexpr size_t WS_ROPE = WS_MOD + 512 * 1024;
constexpr size_t WS_AFF = 2 * MiB;
constexpr size_t WS_SLOT = 3 * MiB;
constexpr size_t WS_HB = 4 * MiB;
constexpr size_t WS_QR = 36 * MiB;
constexpr size_t WS_KR = 52 * MiB;
constexpr size_t WS_VV = 56 * MiB;
constexpr size_t WS_QN = 60 * MiB;
constexpr size_t WS_KN = 76 * MiB;
constexpr size_t WS_HQ = 80 * MiB;
constexpr size_t WS_LF = 96 * MiB;
constexpr size_t WS_KF = 160 * MiB;
constexpr size_t WS_HV = 192 * MiB;
constexpr size_t WS_HG = 208 * MiB;
constexpr size_t WS_GG = 224 * MiB;
constexpr size_t WS_OATT = 288 * MiB;
constexpr size_t WS_OF = 304 * MiB;
constexpr size_t WS_OHG = 368 * MiB;
constexpr size_t WS_MP = 384 * MiB;
constexpr size_t WS_MG = 448 * MiB;
constexpr size_t WS_HB8 = 36 * MiB;
constexpr size_t WS_XE8 = 52 * MiB;
constexpr size_t WS_HID8 = 100 * MiB;
constexpr size_t WS_XE = 36 * MiB;
constexpr size_t WS_HID = 100 * MiB;
constexpr size_t WS_YE = 228 * MiB;
constexpr size_t WS_X1 = 480 * MiB;
constexpr size_t WS_X2 = 544 * MiB;
constexpr size_t WS_WIN = 608 * MiB;
constexpr size_t WS_WBA = 630 * MiB;
constexpr size_t WS_WBH = 632 * MiB;
constexpr size_t WS_WOUT = 634 * MiB;
constexpr size_t WS_WGU = 638 * MiB;
constexpr size_t WS_WD = 766 * MiB;
constexpr size_t WS_HST = 830 * MiB;
constexpr size_t WS_Q8 = 912 * MiB;
constexpr size_t WS_K8 = 920 * MiB;
constexpr size_t WS_V8T = 922 * MiB;
constexpr size_t WS_WIN8 = 900 * MiB;
constexpr size_t WS_HBF8 = 906 * MiB;
constexpr size_t WS_END = 924 * MiB;
static_assert(WS_END <= 1024 * MiB, "workspace");

__device__ __forceinline__ float bf2f(bf16_t v) { return __uint_as_float((unsigned)v << 16); }
__device__ __forceinline__ bf16_t f2bf(float f) { unsigned u = __float_as_uint(f); return (bf16_t)((u + 0x7fffu + ((u >> 16) & 1u)) >> 16); }
__device__ __forceinline__ unsigned pk2(float lo, float hi) { return (unsigned)f2bf(lo) | ((unsigned)f2bf(hi) << 16); }
__device__ __forceinline__ float bflo(unsigned w) { return __uint_as_float(w << 16); }
__device__ __forceinline__ float bfhi(unsigned w) { return __uint_as_float(w & 0xffff0000u); }
__device__ __forceinline__ float sigmoidf_(float v) { return __builtin_amdgcn_rcpf(1.0f + __expf(-v)); }
__device__ __forceinline__ float siluf_(float v) { return v * __builtin_amdgcn_rcpf(1.0f + __expf(-v)); }
__device__ __forceinline__ float wave_sum(float v) {
#pragma unroll
    for (int o = 1; o < 64; o <<= 1) v += __shfl_xor(v, o);
    return v;
}
__device__ __forceinline__ int crow(int r, int hi) { return (r & 3) + 8 * (r >> 2) + 4 * hi; }
__device__ __forceinline__ int lane_id_opaque() { int l; asm volatile("v_mbcnt_lo_u32_b32 %0, -1, 0\n\tv_mbcnt_hi_u32_b32 %0, -1, %0" : "=v"(l)); return l; }

#define GAS __attribute__((address_space(1)))
#define LAS __attribute__((address_space(3)))

namespace pg8 {
#define PG8_LAS __attribute__((address_space(3)))
typedef unsigned short bf16_t;
typedef short bf16x8 __attribute__((ext_vector_type(8)));
typedef float f32x4 __attribute__((ext_vector_type(4)));
typedef unsigned u32x4 __attribute__((ext_vector_type(4)));
constexpr int BM = 256, BK = 64, HALF = 128, HTB = HALF * BK * 2  , STAGE_BYTES = 8 * HTB, NXCD = 8, WGM = 8;

__host__ __device__ __forceinline__ int lds_byte(int r, int c) { const int st = (r >> 4) * 2 + (c >> 5), rr = r & 15, cc = c & 31, ob = rr * 64 + cc * 2; return st * 1024 + (ob ^ (((ob >> 9) & 1) << 5)); }
__host__ __device__ __forceinline__ void stage_rc(int b, int& R, int& C) { const int st = b / 1024, sb = b % 1024, swz = sb ^ (((sb >> 9) & 1) << 5); R = (st >> 1) * 16 + swz / 64; C = (st & 1) * 32 + (swz % 64) / 2; }
__host__ __device__ __forceinline__ int perm32(int rho) { const int n = rho >> 4, i = rho & 15; return 8 * (i >> 2) + 4 * n + (i & 3); }

struct Unit { int pm, pn, pb, sel; };
struct Gemm { const bf16_t* A; const bf16_t* Bt; int M, N, K; const bf16_t* A2 = nullptr; const bf16_t* Bt2 = nullptr; const int* rowidx = nullptr; };

struct StaticOrder {
    int nM, nN, nwg, G, c;
    __host__ __device__ void init(int M, int N, int G_, int c_) { nM = M / BM; nN = N / BM; nwg = nM * nN; G = G_; c = c_; }
    __host__ __device__ bool next(int i, Unit& u) const {
        const long L = (long)i * G + c; if (L >= nwg) return false;
        int wgid = (int)L; { const int q = nwg / NXCD, r = nwg % NXCD, xcd = wgid % NXCD, off = wgid / NXCD; wgid = (xcd < r ? xcd * (q + 1) : r * (q + 1) + (xcd - r) * q) + off; }
        const int nig = WGM * nN, gid = wgid / nig, fm = gid * WGM, gsz = (nM - fm) < WGM ? (nM - fm) : WGM;
        u.pm = fm + ((wgid % nig) % gsz); u.pn = (wgid % nig) / gsz; u.pb = u.pn; u.sel = 0; return true;
    }
    __device__ __forceinline__ void a_ready(const Unit&) const {}
    __device__ __forceinline__ void done(const Unit&) const {}
};

typedef float f32x2_c __attribute__((ext_vector_type(2))); typedef __bf16 bf16x2_c __attribute__((ext_vector_type(2)));
__device__ __forceinline__ unsigned cvt_pk_bf16(float lo, float hi) { f32x2_c v = {lo, hi}; bf16x2_c b = __builtin_convertvector(v, bf16x2_c); return __builtin_bit_cast(unsigned, b); }

typedef unsigned u32x2 __attribute__((ext_vector_type(2)));
__device__ __forceinline__ float e_bflo(unsigned w) { return __uint_as_float(w << 16); }
__device__ __forceinline__ float e_bfhi(unsigned w) { return __uint_as_float(w & 0xffff0000u); }
__device__ __forceinline__ float e_sig(float v) { return __builtin_amdgcn_rcpf(1.0f + __expf(-v)); }
__device__ __forceinline__ u32x4 pack8(const f32x4 a, const f32x4 b) { u32x4 w; w.x = cvt_pk_bf16(a[0], a[1]); w.y = cvt_pk_bf16(a[2], a[3]); w.z = cvt_pk_bf16(b[0], b[1]); w.w = cvt_pk_bf16(b[2], b[3]); return w; }

typedef int i32x4_ __attribute__((ext_vector_type(4))); typedef int i32x8_ __attribute__((ext_vector_type(8)));
__device__ __forceinline__ i32x8_ pg8_cat(const bf16x8 lo, const bf16x8 hi) { return __builtin_shufflevector(__builtin_bit_cast(i32x4_, lo), __builtin_bit_cast(i32x4_, hi), 0, 1, 2, 3, 4, 5, 6, 7); }
__device__ __forceinline__ u32x2 pack8_fp8(const f32x4 a, const f32x4 b) { int w0 = 0, w1 = 0;
    w0 = __builtin_amdgcn_cvt_pk_fp8_f32(a[0], a[1], w0, false); w0 = __builtin_amdgcn_cvt_pk_fp8_f32(a[2], a[3], w0, true);
    w1 = __builtin_amdgcn_cvt_pk_fp8_f32(b[0], b[1], w1, false); w1 = __builtin_amdgcn_cvt_pk_fp8_f32(b[2], b[3], w1, true);
    u32x2 r; r.x = (unsigned)w0; r.y = (unsigned)w1; return r; }
struct EpiInproj {
    static constexpr bool PERM = true, AFTER_DRAIN = false, CHAIN = false;
    bf16_t *QR, *KR, *VV, *HQ, *KF, *HV, *HG, *GG; float* LF; const float* lbv; float ascale;
    __device__ __forceinline__ void operator()(const f32x4 (&acc)[2][2][4][2], const Unit& u, int wr, int wc, int fr, int fq) const {
        const int row0 = u.pm * BM + wr * 64 + fr, cl = wc * 32 + 8 * fq;
#pragma unroll
        for (int bj = 0; bj < 2; ++bj) {
            const int colg = u.pn * BM + bj * HALF;
            int kind; bf16_t* dst; int pitch, c0; int dir = 0;
            if (colg < 512) { kind = 0; dst = QR; pitch = 512; c0 = colg; }
            else if (colg < 640) { kind = 0; dst = KR; pitch = 128; c0 = colg - 512; }
            else if (colg < 768) { kind = 0; dst = VV; pitch = 128; c0 = colg - 640; }
            else if (colg < 1280) { kind = 1; dst = HQ; pitch = 512; c0 = colg - 768; }
            else if (colg < 2304) { kind = 3; dir = colg >= 1792; dst = KF + (size_t)dir * 16384 * 512; pitch = 512; c0 = colg - (dir ? 1792 : 1280); }
            else if (colg < 2816) { kind = 0; dst = HV; pitch = 512; c0 = colg - 2304; }
            else if (colg < 3328) { kind = 1; dst = HG; pitch = 512; c0 = colg - 2816; }
            else { kind = 2; dst = GG; pitch = 2048; c0 = colg - 3328; }
            c0 += cl;
            if (kind == 0) {
#pragma unroll
                for (int ai = 0; ai < 2; ++ai)
#pragma unroll
                    for (int m = 0; m < 4; ++m) *(u32x4*)(dst + (size_t)(row0 + ai * HALF + m * 16) * pitch + c0) = pack8(acc[ai][bj][m][0] * ascale, acc[ai][bj][m][1] * ascale);
            } else if (kind == 1) {
#pragma unroll
                for (int ai = 0; ai < 2; ++ai)
#pragma unroll
                    for (int m = 0; m < 4; ++m) { f32x4 a = acc[ai][bj][m][0] * ascale, b = acc[ai][bj][m][1] * ascale;
#pragma unroll
                        for (int i = 0; i < 4; ++i) { a[i] = a[i] * e_sig(a[i]); b[i] = b[i] * e_sig(b[i]); }
                        *(u32x4*)(dst + (size_t)(row0 + ai * HALF + m * 16) * pitch + c0) = pack8(a, b); }
            } else if (kind == 2) {
#pragma unroll
                for (int ai = 0; ai < 2; ++ai)
#pragma unroll
                    for (int m = 0; m < 4; ++m) { f32x4 a = acc[ai][bj][m][0] * ascale, b = acc[ai][bj][m][1] * ascale;
#pragma unroll
                        for (int i = 0; i < 4; ++i) { a[i] = e_sig(a[i]); b[i] = e_sig(b[i]); }
                        *(u32x4*)(dst + (size_t)(row0 + ai * HALF + m * 16) * pitch + c0) = pack8(a, b); }
            } else {
                const f32x4 lb0 = *(const f32x4*)(lbv + dir * 512 + c0), lb1 = *(const f32x4*)(lbv + dir * 512 + c0 + 4);
                float* lf = LF + (size_t)dir * 16384 * 512;
#pragma unroll
                for (int ai = 0; ai < 2; ++ai)
#pragma unroll
                    for (int m = 0; m < 4; ++m) { const f32x4 a = acc[ai][bj][m][0] * ascale, b = acc[ai][bj][m][1] * ascale; f32x4 la, lb_, ka, kb;
#pragma unroll
                        for (int i = 0; i < 4; ++i) {
                            const float sa = e_sig(a[i]), sb = e_sig(b[i]);
                            la[i] = __logf(fmaxf(lb0[i] + (1.0f - lb0[i]) * sa, 1e-6f)); ka[i] = (1.0f - lb0[i]) * (1.0f - sa);
                            lb_[i] = __logf(fmaxf(lb1[i] + (1.0f - lb1[i]) * sb, 1e-6f)); kb[i] = (1.0f - lb1[i]) * (1.0f - sb); }
                        const size_t o = (size_t)(row0 + ai * HALF + m * 16) * 512 + c0;
                        *(f32x4*)(lf + o) = la; *(f32x4*)(lf + o + 4) = lb_;
                        *(u32x4*)(dst + o) = pack8(ka, kb); }
            }
        }
    }
};
struct EpiBrA {
    static constexpr bool PERM = true, AFTER_DRAIN = false, CHAIN = false;
    const bf16_t* GG; float* MP;
    __device__ __forceinline__ void operator()(const f32x4 (&acc)[2][2][4][2], const Unit& u, int wr, int wc, int fr, int fq) const {
        const int row0 = u.pm * BM + wr * 64 + fr, col0 = u.pn * BM + wc * 32 + 8 * fq;
#pragma unroll
        for (int ai = 0; ai < 2; ++ai)
#pragma unroll
            for (int m = 0; m < 4; ++m) { const size_t r = (size_t)(row0 + ai * HALF + m * 16);
#pragma unroll
                for (int bj = 0; bj < 2; ++bj) { const int c = col0 + bj * HALF; const u32x4 g = *(const u32x4*)(GG + r * 2048 + c);
                    f32x4 a = acc[ai][bj][m][0], b = acc[ai][bj][m][1];
                    a[0] *= e_bflo(g.x); a[1] *= e_bfhi(g.x); a[2] *= e_bflo(g.y); a[3] *= e_bfhi(g.y); b[0] *= e_bflo(g.z); b[1] *= e_bfhi(g.z); b[2] *= e_bflo(g.w); b[3] *= e_bfhi(g.w);
                    *(f32x4*)(MP + r * 1024 + c) = a; *(f32x4*)(MP + r * 1024 + c + 4) = b; } }
    }
};
struct EpiBrH {
    static constexpr bool PERM = true, AFTER_DRAIN = false, CHAIN = false;
    const bf16_t* GG; const float* MP; bf16_t* MG;
    __device__ __forceinline__ void operator()(const f32x4 (&acc)[2][2][4][2], const Unit& u, int wr, int wc, int fr, int fq) const {
        const int row0 = u.pm * BM + wr * 64 + fr, col0 = u.pn * BM + wc * 32 + 8 * fq;
#pragma unroll
        for (int ai = 0; ai < 2; ++ai)
#pragma unroll
            for (int m = 0; m < 4; ++m) { const size_t r = (size_t)(row0 + ai * HALF + m * 16);
#pragma unroll
                for (int bj = 0; bj < 2; ++bj) { const int c = col0 + bj * HALF; const u32x4 g = *(const u32x4*)(GG + r * 2048 + 1024 + c);
                    f32x4 a = acc[ai][bj][m][0], b = acc[ai][bj][m][1]; const f32x4 pa = *(const f32x4*)(MP + r * 1024 + c), pb = *(const f32x4*)(MP + r * 1024 + c + 4);
                    a[0] = pa[0] + a[0] * e_bflo(g.x); a[1] = pa[1] + a[1] * e_bfhi(g.x); a[2] = pa[2] + a[2] * e_bflo(g.y); a[3] = pa[3] + a[3] * e_bfhi(g.y);
                    b[0] = pb[0] + b[0] * e_bflo(g.z); b[1] = pb[1] + b[1] * e_bfhi(g.z); b[2] = pb[2] + b[2] * e_bflo(g.w); b[3] = pb[3] + b[3] * e_bfhi(g.w);
                    *(u32x4*)(MG + r * 1024 + c) = pack8(a, b); } }
    }
};
struct EpiMerge {
    static constexpr bool PERM = true, AFTER_DRAIN = false, CHAIN = true;
    const bf16_t* GG; bf16_t* MG;
    __device__ __forceinline__ void mid(f32x4 (&acc)[2][2][4][2], const Unit& u, int wr, int wc, int fr, int fq) const {
        const int row0 = u.pm * BM + wr * 64 + fr, col0 = u.pn * BM + wc * 32 + 8 * fq;
#pragma unroll
        for (int ai = 0; ai < 2; ++ai)
#pragma unroll
            for (int m = 0; m < 4; ++m) { const size_t r = (size_t)(row0 + ai * HALF + m * 16);
#pragma unroll
                for (int bj = 0; bj < 2; ++bj) { const int c = col0 + bj * HALF; const u32x4 g0 = *(const u32x4*)(GG + r * 2048 + c), g1 = *(const u32x4*)(GG + r * 2048 + 1024 + c);
                    f32x4& a = acc[ai][bj][m][0]; f32x4& b = acc[ai][bj][m][1];
                    a[0] *= e_bflo(g0.x) * __builtin_amdgcn_rcpf(e_bflo(g1.x)); a[1] *= e_bfhi(g0.x) * __builtin_amdgcn_rcpf(e_bfhi(g1.x));
                    a[2] *= e_bflo(g0.y) * __builtin_amdgcn_rcpf(e_bflo(g1.y)); a[3] *= e_bfhi(g0.y) * __builtin_amdgcn_rcpf(e_bfhi(g1.y));
                    b[0] *= e_bflo(g0.z) * __builtin_amdgcn_rcpf(e_bflo(g1.z)); b[1] *= e_bfhi(g0.z) * __builtin_amdgcn_rcpf(e_bfhi(g1.z));
                    b[2] *= e_bflo(g0.w) * __builtin_amdgcn_rcpf(e_bflo(g1.w)); b[3] *= e_bfhi(g0.w) * __builtin_amdgcn_rcpf(e_bfhi(g1.w)); } }
    }
    __device__ __forceinline__ void operator()(const f32x4 (&acc)[2][2][4][2], const Unit& u, int wr, int wc, int fr, int fq) const {
        const int row0 = u.pm * BM + wr * 64 + fr, col0 = u.pn * BM + wc * 32 + 8 * fq;
#pragma unroll
        for (int ai = 0; ai < 2; ++ai)
#pragma unroll
            for (int m = 0; m < 4; ++m) { const size_t r = (size_t)(row0 + ai * HALF + m * 16);
#pragma unroll
                for (int bj = 0; bj < 2; ++bj) { const int c = col0 + bj * HALF; const u32x4 g = *(const u32x4*)(GG + r * 2048 + 1024 + c);
                    f32x4 a = acc[ai][bj][m][0], b = acc[ai][bj][m][1];
                    a[0] *= e_bflo(g.x); a[1] *= e_bfhi(g.x); a[2] *= e_bflo(g.y); a[3] *= e_bfhi(g.y); b[0] *= e_bflo(g.z); b[1] *= e_bfhi(g.z); b[2] *= e_bflo(g.w); b[3] *= e_bfhi(g.w);
                    *(u32x4*)(MG + r * 1024 + c) = pack8(a, b); } }
    }
};
struct OffOrder {
    StaticOrder So; int off;
    __device__ bool next(int i, Unit& u) const { if (!So.next(i, u)) return false; u.pb = u.pn; u.pn += off; return true; }
    __device__ __forceinline__ void a_ready(const Unit&) const {}
    __device__ __forceinline__ void done(const Unit&) const {}
};
struct ChainOrder {
    StaticOrder So;
    __device__ bool next(int i, Unit& u) const { if (!So.next(i >> 1, u)) return false; u.sel = i & 1; return true; }
    __device__ __forceinline__ void a_ready(const Unit&) const {}
    __device__ __forceinline__ void done(const Unit&) const {}
};
struct EpiOut {
    static constexpr bool PERM = true, AFTER_DRAIN = false, CHAIN = false;
    const float* xin; const float* gate; float* X1;
    __device__ __forceinline__ void operator()(const f32x4 (&acc)[2][2][4][2], const Unit& u, int wr, int wc, int fr, int fq) const {
        const int row0 = u.pm * BM + wr * 64 + fr, col0 = u.pn * BM + wc * 32 + 8 * fq;
#pragma unroll
        for (int bj = 0; bj < 2; ++bj) { const int c = col0 + bj * HALF; const f32x4 g0 = *(const f32x4*)(gate + c), g1 = *(const f32x4*)(gate + c + 4);
#pragma unroll
            for (int ai = 0; ai < 2; ++ai)
#pragma unroll
                for (int m = 0; m < 4; ++m) { const size_t o = (size_t)(row0 + ai * HALF + m * 16) * 1024 + c;
                    *(f32x4*)(X1 + o) = *(const f32x4*)(xin + o) + g0 * acc[ai][bj][m][0]; *(f32x4*)(X1 + o + 4) = *(const f32x4*)(xin + o + 4) + g1 * acc[ai][bj][m][1]; } }
    }
};
struct EpiGU {
    static constexpr bool PERM = true, AFTER_DRAIN = false, CHAIN = false;
    bf16_t* HID;
    __device__ __forceinline__ void operator()(const f32x4 (&acc)[2][2][4][2], const Unit& u, int wr, int wc, int fr, int fq) const {
        const int row0 = u.pm * BM + wr * 64 + fr, col0 = u.pn * HALF + wc * 32 + 8 * fq;
#pragma unroll
        for (int ai = 0; ai < 2; ++ai)
#pragma unroll
            for (int m = 0; m < 4; ++m) { f32x4 a = acc[ai][0][m][0], b = acc[ai][0][m][1]; const f32x4 ua = acc[ai][1][m][0], ub = acc[ai][1][m][1];
#pragma unroll
                for (int i = 0; i < 4; ++i) { a[i] = a[i] * e_sig(a[i]) * ua[i]; b[i] = b[i] * e_sig(b[i]) * ub[i]; }
                *(u32x4*)(HID + (size_t)(row0 + ai * HALF + m * 16) * 2048 + col0) = pack8(a, b); }
    }
};
struct EpiGU8 {
    static constexpr bool PERM = true, AFTER_DRAIN = false, CHAIN = false;
    unsigned char* HID;
    __device__ __forceinline__ void operator()(const f32x4 (&acc)[2][2][4][2], const Unit& u, int wr, int wc, int fr, int fq) const {
        const int row0 = u.pm * BM + wr * 64 + fr, col0 = u.pn * HALF + wc * 32 + 8 * fq;
#pragma unroll
        for (int ai = 0; ai < 2; ++ai)
#pragma unroll
            for (int m = 0; m < 4; ++m) { f32x4 a = acc[ai][0][m][0], b = acc[ai][0][m][1]; const f32x4 ua = acc[ai][1][m][0], ub = acc[ai][1][m][1];
#pragma unroll
                for (int i = 0; i < 4; ++i) { const float ga = a[i] * 0.015625f, gb = b[i] * 0.015625f; a[i] = ga * e_sig(ga) * (ua[i] * 0.015625f); b[i] = gb * e_sig(gb) * (ub[i] * 0.015625f); }
                *(u32x2*)(HID + (size_t)(row0 + ai * HALF + m * 16) * 2048 + col0) = pack8_fp8(a, b); }
    }
};
struct EpiDown {
    static constexpr bool PERM = true, AFTER_DRAIN = false, CHAIN = false;
    bf16_t* YE; const float* topw; float wscale;
    __device__ __forceinline__ void operator()(const f32x4 (&acc)[2][2][4][2], const Unit& u, int wr, int wc, int fr, int fq) const {
        const int row0 = u.pm * BM + wr * 64 + fr, col0 = u.pn * BM + wc * 32 + 8 * fq;
#pragma unroll
        for (int ai = 0; ai < 2; ++ai)
#pragma unroll
            for (int m = 0; m < 4; ++m) { const int r = row0 + ai * HALF + m * 16; const float w = topw[r] * wscale;
#pragma unroll
                for (int bj = 0; bj < 2; ++bj) *(u32x4*)(YE + (size_t)r * 1024 + col0 + bj * HALF) = pack8(acc[ai][bj][m][0] * w, acc[ai][bj][m][1] * w); }
    }
};
struct GroupOrder {
    int nNe, nwg, G, c;
    __device__ void init(int nNe_, int G_, int c_) { nNe = nNe_; nwg = 16 * 8 * nNe_; G = G_; c = c_; }
    __device__ bool next(int i, Unit& u) const {
        const long L = (long)i * G + c; if (L >= nwg) return false;
        int wgid = (int)L; { const int q = nwg / NXCD, xcd = wgid % NXCD, off = wgid / NXCD; wgid = xcd * q + off; }
        const int per = 8 * nNe, e = wgid / per, w = wgid % per;
        u.pm = e * 8 + (w & 7); u.pn = w >> 3; u.pb = e * nNe + u.pn; u.sel = 0; return true;
    }
    __device__ __forceinline__ void a_ready(const Unit&) const {}
    __device__ __forceinline__ void done(const Unit&) const {}
};

template <class Epi, class Sched, bool ALIGN_EPI = false, bool SP2 = false, bool FP8 = false, bool GATHER = false>
__device__ __forceinline__ void gemm_phase(PG8_LAS unsigned char* lds, const Gemm g, const Sched& S, const Epi& E, int wave_) {
    const int tid_ = wave_ * 64 + lane_id_opaque();
    const int tid = tid_, wid = __builtin_amdgcn_readfirstlane(tid >> 6), lane = tid & 63, wr = wid >> 2, wc = wid & 3, fr = lane & 15, fq = lane >> 4;
    int K_ = g.K; asm volatile("" : "+s"(K_));
    const int K = K_, nt = K / BK;
    unsigned voffA[2], voffB[2];
#pragma unroll
    for (int i = 0; i < 2; ++i) { int R, C; stage_rc(tid * 16 + i * 8192, R, C); const int Rb = Epi::PERM ? ((R & ~31) + perm32(R & 31)) : R;
        voffA[i] = (unsigned)(R * K + C) * 2u; voffB[i] = (unsigned)(Rb * K + C) * 2u; }
    unsigned vA[2][2] = {{0u, 0u}, {0u, 0u}}, vN[2][2] = {{0u, 0u}, {0u, 0u}};
#define PG8_GOFF(dst, u_) do { if constexpr (GATHER) { _Pragma("unroll") for (int h_ = 0; h_ < 2; ++h_) _Pragma("unroll") for (int i_ = 0; i_ < 2; ++i_) \
        { int R_, C_; stage_rc(tid * 16 + i_ * 8192, R_, C_);     \
          dst[h_][i_] = (unsigned)((const __attribute__((address_space(1))) int*)g.rowidx)[(u_).pm * BM + h_ * HALF + R_] * (unsigned)(K * 2) + (unsigned)C_ * 2u; } } } while (0)
    const size_t kstep = (size_t)(BK * 2);
    const size_t hstep = (size_t)HALF * K * 2;
    const size_t tstep = 2 * hstep;
    const unsigned ldsw = (unsigned)wid * 1024u;
    const int aoff = lds_byte(wr * 64 + fr, fq * 8), boff = lds_byte(wc * 32 + fr, fq * 8);
#define PG8_SA(b, h) (((b) * 2 + (h)) * HTB)
#define PG8_SB(b, h) ((4 + (b) * 2 + (h)) * HTB)
#define PG8_STAGE(bufoff, gbase, voff) do { _Pragma("unroll") for (int _i = 0; _i < 2; ++_i) \
        __builtin_amdgcn_global_load_lds((const unsigned*)((const char*)(gbase) + (voff)[_i]), (PG8_LAS unsigned*)(lds + (bufoff) + ldsw + _i * 8192), 16, 0, 0); } while (0)
#define PG8_STAGE_A(bufoff, gptr, half, nsel) do { if constexpr (GATHER) { unsigned vs_[2]; vs_[0] = (nsel) ? vN[half][0] : vA[half][0]; vs_[1] = (nsel) ? vN[half][1] : vA[half][1]; PG8_STAGE(bufoff, gptr, vs_); } \
        else { PG8_STAGE(bufoff, (gptr) + (half) * hstep, voffA); } } while (0)
#define PG8_LDA(dst, b, h) do { if constexpr (FP8) { _Pragma("unroll") for (int m = 0; m < 4; ++m) dst##8[m] = pg8_cat(*(const PG8_LAS bf16x8*)(lds + PG8_SA(b, h) + aoff + m * 2048), *(const PG8_LAS bf16x8*)(lds + PG8_SA(b, h) + aoff + m * 2048 + 1024)); } else { \
        _Pragma("unroll") for (int m = 0; m < 4; ++m) _Pragma("unroll") for (int k = 0; k < 2; ++k) dst[m][k] = *(const PG8_LAS bf16x8*)(lds + PG8_SA(b, h) + aoff + m * 2048 + k * 1024); } } while (0)
#define PG8_LDB(dst, b, h) do { if constexpr (FP8) { _Pragma("unroll") for (int n = 0; n < 2; ++n) dst##8[n] = pg8_cat(*(const PG8_LAS bf16x8*)(lds + PG8_SB(b, h) + boff + n * 2048), *(const PG8_LAS bf16x8*)(lds + PG8_SB(b, h) + boff + n * 2048 + 1024)); } else { \
        _Pragma("unroll") for (int n = 0; n < 2; ++n) _Pragma("unroll") for (int k = 0; k < 2; ++k) dst[n][k] = *(const PG8_LAS bf16x8*)(lds + PG8_SB(b, h) + boff + n * 2048 + k * 1024); } } while (0)
#define PG8_MMA(ai, bj, At, Bt) do { __builtin_amdgcn_s_setprio(1); if constexpr (FP8) { \
        _Pragma("unroll") for (int m = 0; m < 4; ++m) _Pragma("unroll") for (int n = 0; n < 2; ++n) \
        asm volatile("v_mfma_f32_16x16x128_f8f6f4 %0, %1, %2, %0" : "+v"(acc[ai][bj][m][n]) : "v"(Bt##8[n]), "v"(At##8[m])); } else {     \
        _Pragma("unroll") for (int m = 0; m < 4; ++m) _Pragma("unroll") for (int n = 0; n < 2; ++n) _Pragma("unroll") for (int k = 0; k < 2; ++k) \
        acc[ai][bj][m][n] = __builtin_amdgcn_mfma_f32_16x16x32_bf16(Bt[n][k], At[m][k], acc[ai][bj][m][n], 0, 0, 0); } __builtin_amdgcn_s_setprio(0); } while (0)
#define PG8_WAIT_V(n) asm volatile("s_waitcnt vmcnt(" #n ")" ::: "memory")
#define PG8_WAIT_L(n) asm volatile("s_waitcnt lgkmcnt(" #n ")" ::: "memory")
#define PG8_BAR __builtin_amdgcn_s_barrier()
#define PG8_SCHED __builtin_amdgcn_sched_barrier(0)
    Unit cur, nxt; int ui = 0;
    if (!S.next(0, cur)) return;
    f32x4 acc[2][2][4][2];
#pragma unroll
    for (int a = 0; a < 2; ++a)
#pragma unroll
        for (int b = 0; b < 2; ++b)
#pragma unroll
            for (int m = 0; m < 4; ++m)
#pragma unroll
                for (int n = 0; n < 2; ++n) acc[a][b][m][n] = (f32x4){0.f, 0.f, 0.f, 0.f};
    bf16x8 At[4][2], B0[2][2], B1[2][2]; i32x8_ At8[4], B08[2], B18[2];
    const char* cA = GATHER ? (const char*)g.A : (const char*)(cur.sel ? g.A2 : g.A) + (size_t)cur.pm * tstep; PG8_GOFF(vA, cur); const char* cB = (const char*)(cur.sel ? g.Bt2 : g.Bt) + (size_t)cur.pb * tstep;
    S.a_ready(cur);
    if constexpr (SP2) {
        PG8_STAGE(PG8_SB(0, 0), cB, voffB); PG8_STAGE(PG8_SB(0, 1), cB + hstep, voffB); PG8_STAGE_A(PG8_SA(0, 0), cA, 0, false); PG8_STAGE_A(PG8_SA(0, 1), cA, 1, false);
        if (wr == 1) PG8_BAR;
        PG8_WAIT_V(2); PG8_BAR;
        PG8_STAGE(PG8_SB(1, 0), cB + kstep, voffB); PG8_STAGE_A(PG8_SA(1, 0), cA + kstep, 0, false); PG8_STAGE(PG8_SB(1, 1), cB + hstep + kstep, voffB);
        PG8_WAIT_V(6); PG8_BAR;
    } else {
        PG8_STAGE(PG8_SB(0, 0), cB, voffB); PG8_STAGE_A(PG8_SA(0, 0), cA, 0, false); PG8_STAGE(PG8_SB(0, 1), cB + hstep, voffB); PG8_STAGE_A(PG8_SA(0, 1), cA, 1, false);
        if (wr == 1) PG8_BAR;
        PG8_WAIT_V(4); PG8_BAR;
        PG8_STAGE(PG8_SB(1, 0), cB + kstep, voffB); PG8_STAGE_A(PG8_SA(1, 0), cA + kstep, 0, false); PG8_STAGE(PG8_SB(1, 1), cB + hstep + kstep, voffB);
        PG8_WAIT_V(6); PG8_BAR;
    }
    for (;;) {
        const bool has_next = S.next(ui + 1, nxt);
        if (has_next) PG8_GOFF(vN, nxt); else { if constexpr (GATHER) { vN[0][0] = vA[0][0]; vN[0][1] = vA[0][1]; vN[1][0] = vA[1][0]; vN[1][1] = vA[1][1]; } }
        const char* nA = GATHER ? (const char*)g.A : has_next ? (const char*)(nxt.sel ? g.A2 : g.A) + (size_t)nxt.pm * tstep : cA; const char* nB = has_next ? (const char*)(nxt.sel ? g.Bt2 : g.Bt) + (size_t)nxt.pb * tstep : cB;
#pragma unroll 1
        for (int t = 0; t < nt; t += 2) {
            const bool last = (t == nt - 2);
            const char* a1 = cA + (size_t)(t + 1) * kstep;
            const char* a2 = last ? nA : cA + (size_t)(t + 2) * kstep; const char* b2 = last ? nB : cB + (size_t)(t + 2) * kstep;
            const char* a3 = a2 + kstep; const char* b3 = b2 + kstep;
            if (last && has_next) S.a_ready(nxt);
            if constexpr (SP2) {
            PG8_LDB(B0, 0, 0); PG8_LDB(B1, 0, 1); PG8_SCHED; PG8_LDA(At, 0, 0); PG8_STAGE_A(PG8_SA(1, 1), a1, 1, false);
            PG8_WAIT_V(8); PG8_WAIT_L(0); PG8_BAR; PG8_MMA(0, 0, At, B0); PG8_MMA(0, 1, At, B1); PG8_BAR; PG8_SCHED;
            PG8_LDA(At, 0, 1); PG8_STAGE(PG8_SB(0, 0), b2, voffB); PG8_STAGE(PG8_SB(0, 1), b2 + hstep, voffB); PG8_STAGE_A(PG8_SA(0, 0), a2, 0, last);
            PG8_WAIT_V(8); PG8_WAIT_L(0); PG8_BAR; PG8_MMA(1, 0, At, B0); PG8_MMA(1, 1, At, B1); PG8_BAR; PG8_SCHED;
            PG8_LDB(B0, 1, 0); PG8_LDB(B1, 1, 1); PG8_SCHED; PG8_LDA(At, 1, 0); PG8_STAGE_A(PG8_SA(0, 1), a2, 1, last);
            PG8_WAIT_V(8); PG8_WAIT_L(0); PG8_BAR; PG8_MMA(0, 0, At, B0); PG8_MMA(0, 1, At, B1); PG8_BAR; PG8_SCHED;
            PG8_LDA(At, 1, 1); PG8_STAGE(PG8_SB(1, 0), b3, voffB); PG8_STAGE(PG8_SB(1, 1), b3 + hstep, voffB); PG8_STAGE_A(PG8_SA(1, 0), a3, 0, last);
            PG8_WAIT_V(8); PG8_WAIT_L(0); PG8_BAR; PG8_MMA(1, 0, At, B0); PG8_MMA(1, 1, At, B1); PG8_BAR; PG8_SCHED;
            } else {
            PG8_LDB(B0, 0, 0); PG8_SCHED; PG8_LDA(At, 0, 0); PG8_STAGE_A(PG8_SA(1, 1), a1, 1, false);
            PG8_WAIT_L(8); PG8_BAR; PG8_WAIT_L(0); PG8_MMA(0, 0, At, B0); PG8_BAR; PG8_SCHED;
            PG8_LDB(B1, 0, 1); PG8_STAGE(PG8_SB(0, 0), b2, voffB);
            PG8_BAR; PG8_WAIT_L(0); PG8_MMA(0, 1, At, B1); PG8_BAR;
            PG8_LDA(At, 0, 1); PG8_STAGE_A(PG8_SA(0, 0), a2, 0, last);
            PG8_BAR; PG8_WAIT_L(0); PG8_MMA(1, 0, At, B0); PG8_BAR; PG8_SCHED;
            PG8_STAGE(PG8_SB(0, 1), b2 + hstep, voffB);
            PG8_WAIT_V(6); PG8_BAR; PG8_MMA(1, 1, At, B1); PG8_BAR;
            PG8_LDB(B0, 1, 0); PG8_SCHED; PG8_LDA(At, 1, 0); PG8_STAGE_A(PG8_SA(0, 1), a2, 1, last);
            PG8_WAIT_L(8); PG8_BAR; PG8_WAIT_L(0); PG8_MMA(0, 0, At, B0); PG8_BAR; PG8_SCHED;
            PG8_LDB(B1, 1, 1); PG8_STAGE(PG8_SB(1, 0), b3, voffB);
            PG8_BAR; PG8_WAIT_L(0); PG8_MMA(0, 1, At, B1); PG8_BAR;
            PG8_LDA(At, 1, 1); PG8_STAGE_A(PG8_SA(1, 0), a3, 0, last);
            PG8_BAR; PG8_WAIT_L(0); PG8_MMA(1, 0, At, B0); PG8_BAR; PG8_SCHED;
            PG8_STAGE(PG8_SB(1, 1), b3 + hstep, voffB);
            PG8_WAIT_V(6); PG8_BAR; PG8_MMA(1, 1, At, B1); PG8_BAR;
            }
        }
        if constexpr (FP8) asm volatile("s_nop 15\n\ts_nop 7" ::: "memory");
        if constexpr (ALIGN_EPI) { if (wr == 0) PG8_BAR; }
        bool fin = true; if constexpr (Epi::CHAIN) fin = (cur.sel != 0);
        if constexpr (!Epi::AFTER_DRAIN) { const int le_ = lane_id_opaque(), fre = le_ & 15, fqe = le_ >> 4;
            if (fin) E(acc, cur, wr, wc, fre, fqe); else { if constexpr (Epi::CHAIN) E.mid(acc, cur, wr, wc, fre, fqe); } S.done(cur); }
        if (!has_next) break;
        if (fin)
#pragma unroll
        for (int a = 0; a < 2; ++a)
#pragma unroll
            for (int b = 0; b < 2; ++b)
#pragma unroll
                for (int m = 0; m < 4; ++m)
#pragma unroll
                    for (int n = 0; n < 2; ++n) acc[a][b][m][n] = (f32x4){0.f, 0.f, 0.f, 0.f};
        cur = nxt; cA = nA; cB = nB; ++ui;
        if constexpr (GATHER) { vA[0][0] = vN[0][0]; vA[0][1] = vN[0][1]; vA[1][0] = vN[1][0]; vA[1][1] = vN[1][1]; }
        if constexpr (ALIGN_EPI) { if (wr == 1) PG8_BAR; }
    }
    PG8_WAIT_V(0);
    if constexpr (!ALIGN_EPI) { if (wr == 0) PG8_BAR; }
    PG8_BAR;
    if constexpr (Epi::AFTER_DRAIN) { E.fused(acc, cur, wr, wc, fr, fq, lds, wid, lane); S.done(cur); }
#undef PG8_SA
#undef PG8_STAGE_A
#undef PG8_GOFF
#undef PG8_SB
#undef PG8_STAGE
#undef PG8_LDA
#undef PG8_LDB
#undef PG8_MMA
#undef PG8_WAIT_V
#undef PG8_WAIT_L
#undef PG8_BAR
#undef PG8_SCHED
}
}

#include <hip/hip_bf16.h>
#include <cmath>

namespace attn_body {
using bf16=__hip_bfloat16;
using bf16x8=__attribute__((ext_vector_type(8)))short;
using s16x4=__attribute__((ext_vector_type(4)))short;
using f32x16=__attribute__((ext_vector_type(16)))float;
using u32x4=__attribute__((ext_vector_type(4)))unsigned;
constexpr int NHEAD=8,SEQ=16384,D=64,DMQ=NHEAD*D,DMK=2*D;
constexpr int NW=8,QBLK=32,QB=QBLK*NW,KVBLK=64,NQB=SEQ/QB;
constexpr int ATTN_UNIT_ROWS=QB;
__device__ __forceinline__ int crow(int r,int hi){return (r&3)+8*(r>>2)+4*hi;}
#define SBAR() __builtin_amdgcn_sched_barrier(0)
__device__ __forceinline__ void cmask(f32x16&p0,f32x16&p1,int jb,int qrel,int hi){
  const float NEG=-INFINITY; int kb=64*jb+4*hi;
  #pragma unroll
  for(int r=0;r<16;++r){int kv=kb+(r&3)+8*(r>>2); if(kv>qrel)p0[r]=NEG; if(kv+32>qrel)p1[r]=NEG;}
}

constexpr int NSLOT=3, SLOTB=8192;
constexpr int LDS_K=0, LDS_V=NSLOT*SLOTB, LDS_WS=2*NSLOT*SLOTB, LDS_OST=LDS_WS+NW*64*4, LDS_BYTES=LDS_OST+NW*4096;
constexpr float C2=0.125f*1.4426950408889634f;
__device__ __forceinline__ void glds16(const void*gsrc,unsigned lds_dst){unsigned keep;
  asm volatile("s_mov_b32 %0, m0\n\ts_mov_b32 m0, %2\n\ts_nop 0\n\tglobal_load_lds_dwordx4 %1, off\n\ts_mov_b32 m0, %0":"=&s"(keep):"v"(gsrc),"s"(lds_dst):"memory");}
__device__ __forceinline__ float max3f(float a,float b,float c){float r;asm("v_max3_f32 %0, %1, %2, %3":"=v"(r):"v"(a),"v"(b),"v"(c));return r;}
__device__ __forceinline__ float max2f(float a,float b){float r;asm("v_max_f32_e32 %0, %1, %2":"=v"(r):"v"(a),"v"(b));return r;}
__device__ __forceinline__ float fadd_s(float a,float b){float r;asm("v_add_f32_e32 %0, %1, %2":"=v"(r):"v"(a),"v"(b));return r;}
__device__ __forceinline__ float fsub_s(float a,float b){float r;asm("v_sub_f32_e32 %0, %1, %2":"=v"(r):"v"(a),"v"(b));return r;}
typedef float f32x2_t __attribute__((ext_vector_type(2))); typedef __bf16 bf16x2_t __attribute__((ext_vector_type(2)));
__device__ __forceinline__ unsigned cvtpk_s(float lo,float hi){f32x2_t v={lo,hi};bf16x2_t b=__builtin_convertvector(v,bf16x2_t);return __builtin_bit_cast(unsigned,b);}
#define WAIT_BAR(N) asm volatile("s_waitcnt vmcnt(" #N ") lgkmcnt(0)\n\ts_barrier":::"memory")

__device__ __forceinline__ void qkt(f32x16&p0,f32x16&p1,const char*Kslot,const bf16x8*qr,const f32x16&negm,int r32,int hi){
  const char*kb=Kslot+hi*1024+r32*16;
  #pragma unroll
  for(int d0=0;d0<4;++d0){
    const bf16x8 b0=*reinterpret_cast<const bf16x8*>(kb+d0*2048);
    const bf16x8 b1=*reinterpret_cast<const bf16x8*>(kb+d0*2048+512);
    if(d0==0){p0=__builtin_amdgcn_mfma_f32_32x32x16_bf16(b0,qr[0],negm,0,0,0);p1=__builtin_amdgcn_mfma_f32_32x32x16_bf16(b1,qr[0],negm,0,0,0);}
    else{p0=__builtin_amdgcn_mfma_f32_32x32x16_bf16(b0,qr[d0],p0,0,0,0);p1=__builtin_amdgcn_mfma_f32_32x32x16_bf16(b1,qr[d0],p1,0,0,0);}}
}
typedef __attribute__((address_space(3))) const char* lds_cptr;
typedef short v4i16_t __attribute__((ext_vector_type(4)));
__device__ __forceinline__ void kload8(bf16x8*kf,lds_cptr kp){
  kf[0]=*(const __attribute__((address_space(3))) bf16x8*)(kp);      kf[1]=*(const __attribute__((address_space(3))) bf16x8*)(kp+512);
  kf[2]=*(const __attribute__((address_space(3))) bf16x8*)(kp+2048); kf[3]=*(const __attribute__((address_space(3))) bf16x8*)(kp+2560);
  kf[4]=*(const __attribute__((address_space(3))) bf16x8*)(kp+4096); kf[5]=*(const __attribute__((address_space(3))) bf16x8*)(kp+4608);
  kf[6]=*(const __attribute__((address_space(3))) bf16x8*)(kp+6144); kf[7]=*(const __attribute__((address_space(3))) bf16x8*)(kp+6656);
}
__device__ __forceinline__ void kload2(bf16x8*kf,lds_cptr kp,int j){ kf[2*j]=*(const __attribute__((address_space(3))) bf16x8*)(kp+j*2048); kf[2*j+1]=*(const __attribute__((address_space(3))) bf16x8*)(kp+j*2048+512); }
__device__ __forceinline__ s16x4 vtr(lds_cptr p){ return __builtin_bit_cast(s16x4,__builtin_amdgcn_ds_read_tr16_b64_v4i16((__attribute__((address_space(3))) v4i16_t*)p)); }
__device__ __forceinline__ float rowmax(const f32x16&p0,const f32x16&p1){
  float a=max3f(p0[0],p0[1],p1[0]),b=max3f(p0[2],p0[3],p1[1]);a=max3f(a,p1[2],p1[3]);
  #pragma unroll
  for(int r=4;r<16;r+=4){a=max3f(a,p0[r],p0[r+1]);b=max3f(b,p0[r+2],p0[r+3]);a=max3f(a,p1[r],p1[r+1]);b=max3f(b,p1[r+2],p1[r+3]);}
  const float m=max2f(a,b);
  auto rr=__builtin_amdgcn_permlane32_swap(__float_as_uint(m),__float_as_uint(m),false,false);
  return max2f(__uint_as_float(rr[0]),__uint_as_float(rr[1]));
}
__device__ __forceinline__ void pv(f32x16*o,int vb,bf16x8 pa0,bf16x8 pa1,bf16x8 pa2,bf16x8 pa3){
  #pragma unroll
  for(int d0=0;d0<2;++d0){s16x4 lo[4],hi[4];
    #pragma unroll
    for(int ks=0;ks<4;++ks){
      asm volatile("ds_read_b64_tr_b16 %0,%1 offset:%c2":"=&v"(lo[ks]):"v"(vb),"i"(d0*4096+ks*1024):"memory");
      asm volatile("ds_read_b64_tr_b16 %0,%1 offset:%c2":"=&v"(hi[ks]):"v"(vb),"i"(d0*4096+ks*1024+512):"memory");}
    asm volatile("s_waitcnt lgkmcnt(0)":::"memory");SBAR();
    #define PK(k) (bf16x8){lo[k][0],lo[k][1],lo[k][2],lo[k][3],hi[k][0],hi[k][1],hi[k][2],hi[k][3]}
    o[d0]=__builtin_amdgcn_mfma_f32_32x32x16_bf16(pa0,PK(0),o[d0],0,0,0);
    o[d0]=__builtin_amdgcn_mfma_f32_32x32x16_bf16(pa1,PK(1),o[d0],0,0,0);
    o[d0]=__builtin_amdgcn_mfma_f32_32x32x16_bf16(pa2,PK(2),o[d0],0,0,0);
    o[d0]=__builtin_amdgcn_mfma_f32_32x32x16_bf16(pa3,PK(3),o[d0],0,0,0);
    #undef PK
  }
}

#ifndef ATTN_STORE16
#define ATTN_STORE16(p,v) (*(u32x4*)(p)=(v))
#endif
template<int THRL> __device__ __forceinline__ void attn_unit(int b,int h,int qb,const bf16*Q,const bf16*__restrict__ K,const bf16*__restrict__ V,bf16*O,char*shm,int wave_,float negM){
  const int tid_=wave_*64+lane_id_opaque();
  const int tid=tid_,lane=tid&63,r32=lane&31,hi=lane>>5; const int wid=__builtin_amdgcn_readfirstlane(tid>>6);
  const long rowbase=0; const int q0=qb*QB; (void)b;
  const bf16*Qw=Q+(rowbase+q0+wid*QBLK)*DMQ+h*D;
  const bf16*Kh=K+(h>>2)*D,*Vh=V+(h>>2)*D;
  const unsigned lds0=(unsigned)(uintptr_t)shm;
  float*wsf=(float*)(shm+LDS_WS)+wid*64;
  const bf16*ksrc=Kh+(long)lane*DMK+wid*8;
  const bf16*vsrc=Vh+(long)(16*(wid&3)+(lane>>2))*DMK+(wid>>2)*32+(lane&3)*8;
  const unsigned kdst=lds0+LDS_K+wid*1024, vdst=lds0+LDS_V+wid*1024;
  #define DMA_K(t,slot) glds16(ksrc+(long)(t)*KVBLK*DMK,(unsigned)__builtin_amdgcn_readfirstlane(kdst+(slot)))
  #define DMA_V(t,slot) glds16(vsrc+(long)(t)*KVBLK*DMK,(unsigned)__builtin_amdgcn_readfirstlane(vdst+(slot)))
  const int vb0=(int)(lds0+LDS_V)+((lane>>4)&1)*32+(lane&3)*8+(4*hi+((lane&15)>>2))*64;
  const char*Kbase=shm+LDS_K; bf16x8 kf[8];
  const lds_cptr shm3=(lds_cptr)shm; const lds_cptr kp0=shm3+LDS_K+hi*1024+r32*16; const lds_cptr vp0=shm3+LDS_V+((lane>>4)&1)*32+(lane&3)*8+(4*hi+((lane&15)>>2))*64;
  const int NT=SEQ/KVBLK;
  DMA_K(0,0);DMA_V(0,0);DMA_K(1,SLOTB);
  bf16x8 qr[4];
  #pragma unroll
  for(int d0=0;d0<4;++d0)qr[d0]=*reinterpret_cast<const bf16x8*>(&Qw[(long)r32*DMQ+d0*16+hi*8]);
  float l_reg=0.f;f32x16 o[2];o[0]=f32x16{};o[1]=f32x16{};f32x16 negm;
  #pragma unroll
  for(int r=0;r<16;++r)negm[r]=negM;
  asm volatile("":"+v"(negm));
  const int qrel=wid*QBLK+r32; (void)qrel;
  #define CMASK(P0,P1,t) do{}while(0)
  #define START(P0,P1) do{ _Pragma("unroll") for(int r=0;r<16;++r)P0[r]=__builtin_amdgcn_exp2f(P0[r]); }while(0)
  #define RESC() do{}while(0)
  f32x16 pA0,pA1,pB0,pB1;
  int sl_prev=0,sl_cur=0,sl_next=SLOTB;
  #define ROT() do{sl_prev=sl_cur;sl_cur=sl_next;sl_next=(sl_next==(NSLOT-1)*SLOTB)?0:sl_next+SLOTB;}while(0)
  DMA_K(2,2*SLOTB);
  WAIT_BAR(3);
  qkt(pA0,pA1,Kbase,qr,negm,r32,hi);asm volatile("s_nop 15\n\ts_nop 7":"+v"(pA0),"+v"(pA1));CMASK(pA0,pA1,0);
  START(pA0,pA1);
  _Pragma("unroll") for(int r=0;r<16;++r)pA1[r]=__builtin_amdgcn_exp2f(pA1[r]);
  WAIT_BAR(0);
  DMA_K(3,0);DMA_V(1,SLOTB);
  ROT();
  kload8(kf,kp0+sl_cur);
  WAIT_BAR(2);
  s16x4 vlo[8],vhi[8]; u32x4 pw0,pw1,pw2,pw3;
  #define PKW(P,B) cvtpk_s(P[B],P[B+1])
  #define PAF(k) __builtin_bit_cast(bf16x8,pw##k)
  #define VFR(i) (bf16x8){vlo[i][0],vlo[i][1],vlo[i][2],vlo[i][3],vhi[i][0],vhi[i][1],vhi[i][2],vhi[i][3]}
  #define PIN(x) asm volatile("":"+v"(x))
  #define MX3(a,b,c) __builtin_fmaxf(__builtin_fmaxf((a),(b)),(c))
  #define GAPA(MF,A0,A1,A2,A3,W0,W1,PW) do{ MF; sacc+=A0; sacc+=A1; sacc+=A2; sacc+=A3; PIN(sacc); W0; W1; PIN(PW); SBAR(); }while(0)
  #define EX(v) __builtin_amdgcn_exp2f(v)
  #define GAPB(MF,X,B) do{ MF; X[B]=EX(X[B]); X[B+1]=EX(X[B+1]); X[B+2]=EX(X[B+2]); X[B+3]=EX(X[B+3]); PIN(X); SBAR(); }while(0)
  #define VRD(i) do{ vlo[i]=vtr(vp_+(((i)>>2)*4096+((i)&3)*1024)); vhi[i]=vtr(vp_+(((i)>>2)*4096+((i)&3)*1024+512)); }while(0)
  #define KRD(G,j) do{ if(G){ kload2(kf,kp0+sl_next,j); SBAR(); } }while(0)
  #define STEP(C0,C1,P0,P1,t,GK,GV,GL) do{ SBAR(); \
    const lds_cptr vp_=vp0+sl_prev; \
    VRD(0); SBAR(); float sacc=(P0[0]+P0[1]); \
    GAPA(C0=__builtin_amdgcn_mfma_f32_32x32x16_bf16(kf[0],qr[0],negm,0,0,0), P0[2],P0[3],P0[4],P0[5],     pw0[0]=PKW(P0,0), pw0[1]=PKW(P0,2), pw0); \
    VRD(4); SBAR(); GAPA(C1=__builtin_amdgcn_mfma_f32_32x32x16_bf16(kf[1],qr[0],negm,0,0,0), P0[6],P0[7],P0[8],P0[9],     pw0[2]=PKW(P0,4), pw0[3]=PKW(P0,6), pw0); \
    VRD(1); SBAR(); GAPA(C0=__builtin_amdgcn_mfma_f32_32x32x16_bf16(kf[2],qr[1],C0,0,0,0),   P0[10],P0[11],P0[12],P0[13], pw1[0]=PKW(P0,8), pw1[1]=PKW(P0,10), pw1); \
    VRD(5); SBAR(); GAPA(C1=__builtin_amdgcn_mfma_f32_32x32x16_bf16(kf[3],qr[1],C1,0,0,0),   P0[14],P0[15],P1[0],P1[1],   pw1[2]=PKW(P0,12),pw1[3]=PKW(P0,14), pw1); \
    VRD(2); SBAR(); GAPA(C0=__builtin_amdgcn_mfma_f32_32x32x16_bf16(kf[4],qr[2],C0,0,0,0),   P1[2],P1[3],P1[4],P1[5],     pw2[0]=PKW(P1,0), pw2[1]=PKW(P1,2), pw2); \
    VRD(6); SBAR(); GAPA(C1=__builtin_amdgcn_mfma_f32_32x32x16_bf16(kf[5],qr[2],C1,0,0,0),   P1[6],P1[7],P1[8],P1[9],     pw2[2]=PKW(P1,4), pw2[3]=PKW(P1,6), pw2); \
    VRD(3); SBAR(); GAPA(C0=__builtin_amdgcn_mfma_f32_32x32x16_bf16(kf[6],qr[3],C0,0,0,0),   P1[10],P1[11],P1[12],P1[13], pw3[0]=PKW(P1,8), pw3[1]=PKW(P1,10), pw3); \
    VRD(7); SBAR(); GAPA(C1=__builtin_amdgcn_mfma_f32_32x32x16_bf16(kf[7],qr[3],C1,0,0,0),   P1[14],P1[15],0.f,0.f,       pw3[2]=PKW(P1,12),pw3[3]=PKW(P1,14), pw3); \
    l_reg+=sacc; \
    if(GK){DMA_K((t)+3,sl_cur);} if(GV){DMA_V((t)+1,sl_next);} \
    CMASK(C0,C1,t); \
    SBAR(); \
    GAPB(o[0]=__builtin_amdgcn_mfma_f32_32x32x16_bf16(PAF(0),VFR(0),o[0],0,0,0), C0,0); \
    GAPB(o[1]=__builtin_amdgcn_mfma_f32_32x32x16_bf16(PAF(0),VFR(4),o[1],0,0,0), C0,4); \
    KRD(GL,0); GAPB(o[0]=__builtin_amdgcn_mfma_f32_32x32x16_bf16(PAF(1),VFR(1),o[0],0,0,0), C0,8); \
    KRD(GL,1); GAPB(o[1]=__builtin_amdgcn_mfma_f32_32x32x16_bf16(PAF(1),VFR(5),o[1],0,0,0), C0,12); \
    KRD(GL,2); GAPB(o[0]=__builtin_amdgcn_mfma_f32_32x32x16_bf16(PAF(2),VFR(2),o[0],0,0,0), C1,0); \
    KRD(GL,3); GAPB(o[1]=__builtin_amdgcn_mfma_f32_32x32x16_bf16(PAF(2),VFR(6),o[1],0,0,0), C1,4); \
    GAPB(o[0]=__builtin_amdgcn_mfma_f32_32x32x16_bf16(PAF(3),VFR(3),o[0],0,0,0), C1,8); \
    GAPB(o[1]=__builtin_amdgcn_mfma_f32_32x32x16_bf16(PAF(3),VFR(7),o[1],0,0,0), C1,12); \
    }while(0)
  int t=1;
  #undef CMASK
  #define CMASK(P0,P1,t) do{}while(0)
  for(;t+5<NT;t+=2){
    STEP(pB0,pB1,pA0,pA1,t,true,true,true);     WAIT_BAR(2); RESC(); ROT();
    STEP(pA0,pA1,pB0,pB1,t+1,true,true,true);   WAIT_BAR(2); RESC(); ROT();
  }
  #undef CMASK
  #define CMASK(P0,P1,t) do{}while(0)
  #define ENDW(tt) do{ if((tt)+3<NT){WAIT_BAR(2);} else if((tt)+2<NT){WAIT_BAR(1);} else {WAIT_BAR(0);} }while(0)
  for(;t+1<NT;t+=2){
    STEP(pB0,pB1,pA0,pA1,t,(t+3<NT),(t+1<NT),(t+1<NT));       ENDW(t);   RESC(); ROT();
    STEP(pA0,pA1,pB0,pB1,t+1,(t+4<NT),(t+2<NT),(t+2<NT));     ENDW(t+1); RESC(); ROT();
  }
  STEP(pB0,pB1,pA0,pA1,NT-1,false,false,false); RESC();
  { float sacc=pB0[0]+pB0[1]; _Pragma("unroll") for(int r=2;r<16;++r)sacc+=pB0[r]; _Pragma("unroll") for(int r=0;r<16;++r)sacc+=pB1[r]; l_reg+=sacc;
    pw0=(u32x4){PKW(pB0,0),PKW(pB0,2),PKW(pB0,4),PKW(pB0,6)};pw1=(u32x4){PKW(pB0,8),PKW(pB0,10),PKW(pB0,12),PKW(pB0,14)};pw2=(u32x4){PKW(pB1,0),PKW(pB1,2),PKW(pB1,4),PKW(pB1,6)};pw3=(u32x4){PKW(pB1,8),PKW(pB1,10),PKW(pB1,12),PKW(pB1,14)};
    SBAR(); pv(o,vb0+sl_cur,PAF(0),PAF(1),PAF(2),PAF(3)); }
  #undef PKW
  #undef PAF
  #undef VFR
  #undef PIN
  #undef MX3
  #undef GAPA
  #undef GAPB
  #undef EX
  #undef VRD
  #undef KRD
  #undef STEP
  #undef ENDW
  {auto rr=__builtin_amdgcn_permlane32_swap(__float_as_uint(l_reg),__float_as_uint(l_reg),false,false);l_reg=__uint_as_float(rr[0])+__uint_as_float(rr[1]);}
  if(hi==0)wsf[32+r32]=l_reg;asm volatile("s_waitcnt lgkmcnt(0)":::"memory");
  float rli[16];
  #pragma unroll
  for(int r=0;r<16;++r)rli[r]=__builtin_amdgcn_rcpf(wsf[32+crow(r,hi)]);
  bf16*Ow=O+(rowbase+q0+wid*QBLK)*DMQ+h*D;
  { bf16*stg=(bf16*)(shm+LDS_OST)+wid*2048;
    #pragma unroll
    for(int r=0;r<16;++r){const int orow=crow(r,hi);
      #pragma unroll
      for(int d0=0;d0<2;++d0)stg[orow*64+d0*32+r32]=__float2bfloat16(o[d0][r]*rli[r]);}
    asm volatile("s_waitcnt lgkmcnt(0)":::"memory");
    #pragma unroll
    for(int i=0;i<4;++i){const int row=i*8+(lane>>3),ch=lane&7; const u32x4 v=*(const u32x4*)(stg+row*64+ch*8); ATTN_STORE16(Ow+(long)row*DMQ+ch*8,v);} }
  asm volatile("s_waitcnt lgkmcnt(0)\n\ts_barrier":::"memory");
  #undef DMA_K
  #undef DMA_V
  #undef CMASK
  #undef START
  #undef RESC
  #undef ROT
}
constexpr int ATTN_LDS_BYTES=LDS_BYTES;
struct AttnTensors { const bf16* Q; const bf16* K; const bf16* V; bf16* O; };
struct AttnUnit { int bh; int qb; };
struct StaticOrder {
  int vcu, G;
  __device__ __forceinline__ explicit StaticOrder(int grid,int block):vcu((grid%8==0)?(block%8)*(grid/8)+block/8:block),G(grid){}
  __device__ __forceinline__ bool next(int i,AttnUnit&u)const{ constexpr int NU=NHEAD*NQB; int uu; if(NU%G==0){ const int per=NU/G; if(i>=per)return false; uu=vcu*per+i; } else { uu=i*G+vcu; if(uu>=NU)return false; } u.bh=uu/NQB; u.qb=uu%NQB; return true; }
  __device__ __forceinline__ void a_ready(const AttnUnit&)const{}
  __device__ __forceinline__ void done(const AttnUnit&)const{}
};
template<class Sched,int THRL=8> __device__ __forceinline__ void attn_phase(char*lds,const AttnTensors&T,const Sched&S,int wave_,float negM){
  AttnUnit u;
  for(int i=0;S.next(i,u);++i){ S.a_ready(u); attn_unit<THRL>(0,u.bh,u.qb,T.Q,T.K,T.V,T.O,lds,wave_,negM); S.done(u); }
}
#undef SBAR
#undef WAIT_BAR
}

namespace attn8 {
using bf16 = __hip_bfloat16;
typedef int i32x8 __attribute__((ext_vector_type(8)));
typedef int i32x4 __attribute__((ext_vector_type(4)));
typedef float f32x16 __attribute__((ext_vector_type(16)));
typedef unsigned u32x4 __attribute__((ext_vector_type(4)));
constexpr int NHEAD = 8, SEQ = 16384, QBLK = 32, NW = 8, QB = 256, KVBLK = 64, NQB = SEQ / QB, NT = SEQ / KVBLK;
constexpr int NS = 8, SLOT = 4096;
constexpr int LDS_K = 0, LDS_V = NS * SLOT, LDS_WS = 2 * NS * SLOT, LDS_OST = LDS_WS + NW * 256, LDS_BYTES = LDS_OST + NW * 4096;
__device__ __forceinline__ int crow(int r, int hi) { return (r & 3) + 8 * (r >> 2) + 4 * hi; }
__device__ __forceinline__ void glds16(const void* gsrc, unsigned lds_dst) { unsigned keep;
    asm volatile("s_mov_b32 %0, m0\n\ts_mov_b32 m0, %2\n\ts_nop 0\n\tglobal_load_lds_dwordx4 %1, off\n\ts_mov_b32 m0, %0" : "=&s"(keep) : "v"(gsrc), "s"(lds_dst) : "memory"); }
typedef __attribute__((address_space(3))) const char* lds_cptr;
__device__ __forceinline__ i32x8 frag(lds_cptr p) {
    const i32x4 lo = *(const __attribute__((address_space(3))) i32x4*)(p), hi = *(const __attribute__((address_space(3))) i32x4*)(p + 1024);
    return __builtin_shufflevector(lo, hi, 0, 1, 2, 3, 4, 5, 6, 7); }
#define A8_MFMA(a, b, c) __builtin_amdgcn_mfma_scale_f32_32x32x64_f8f6f4((a), (b), (c), 0, 0, 0, 0, 0, 0)
struct Tensors { const unsigned char* Q8; const unsigned char* K8; const unsigned char* V8T; bf16* O; };

template <class Bg>
__device__ __forceinline__ void unit(int h, int qb, const Tensors& T, char* shm, int wave_, float negM8, Bg& bg) {
    const int tid = wave_ * 64 + lane_id_opaque(), lane = tid & 63, r32 = lane & 31, hi = lane >> 5; const int wid = __builtin_amdgcn_readfirstlane(tid >> 6);
    const int kvh = h >> 2, q0 = qb * QB;
    const unsigned lds0 = (unsigned)(uintptr_t)shm;
    float* wsf = (float*)(shm + LDS_WS) + wid * 64;
    const bool isk = wid < 4; const int c = wid & 3;
    const unsigned char* src0 = isk ? T.K8 + (size_t)lane * 128 + kvh * 64 + c * 16 : T.V8T + (size_t)kvh * NT * 4096 + (size_t)lane * 64 + c * 16;
    const size_t tstep = isk ? (size_t)KVBLK * 128 : (size_t)4096;
    const unsigned dst0 = lds0 + (isk ? LDS_K : LDS_V) + c * 1024;
#define A8_DMA(t) glds16(src0 + (size_t)(t) * tstep, (unsigned)__builtin_amdgcn_readfirstlane(dst0 + ((t) & (NS - 1)) * SLOT))
#pragma unroll
    for (int t = 0; t < 3; ++t) A8_DMA(t);
    if (isk) { A8_DMA(3); A8_DMA(4); }
    const unsigned char* qp = T.Q8 + (size_t)(q0 + wid * QBLK + r32) * 512 + h * 64 + 32 * hi;
    const i32x4 qlo = *(const i32x4*)qp, qhi = *(const i32x4*)(qp + 16);
    const i32x8 qf = __builtin_shufflevector(qlo, qhi, 0, 1, 2, 3, 4, 5, 6, 7);
    f32x16 negm;
#pragma unroll
    for (int r = 0; r < 16; ++r) negm[r] = negM8;
    f32x16 o0 = f32x16{}, o1 = f32x16{}, lacc = f32x16{};
    i32x8 ones8;
#pragma unroll
    for (int k = 0; k < 8; ++k) ones8[k] = 0x38383838;
    const lds_cptr kbase = (lds_cptr)shm + LDS_K + (2 * hi) * 1024 + r32 * 16, vbase = (lds_cptr)shm + LDS_V + (2 * hi) * 1024 + r32 * 16;
    if (isk) asm volatile("s_waitcnt vmcnt(4)" ::: "memory"); else asm volatile("s_waitcnt vmcnt(2)" ::: "memory");
    asm volatile("s_waitcnt lgkmcnt(0)\n\ts_barrier" ::: "memory");
    asm volatile("" : "+v"(ones8));
    f32x16 sA0 = A8_MFMA(frag(kbase), qf, negm), sA1 = A8_MFMA(frag(kbase + 512), qf, negm), sB0, sB1;
#define A8_SB() __builtin_amdgcn_sched_barrier(0)
#define A8_EX8(X, b) do { _Pragma("unroll") for (int r = 0; r < 8; ++r) X[(b) + r] = __builtin_amdgcn_exp2f(X[(b) + r]); } while (0)
#define A8_TILE(C0, C1, N0, N1, PP, PC, kt, vt) do { \
        const lds_cptr kp_ = kbase + ((kt) & (NS - 1)) * SLOT, vp_ = vbase + ((vt) & (NS - 1)) * SLOT; \
        const i32x8 kf0_ = frag(kp_), kf1_ = frag(kp_ + 512), vf0_ = frag(vp_), vf1_ = frag(vp_ + 512); A8_SB(); \
        N0 = A8_MFMA(kf0_, qf, negm); A8_SB(); A8_EX8(C0, 0); A8_SB(); \
        N1 = A8_MFMA(kf1_, qf, negm); A8_SB(); A8_EX8(C0, 8); A8_SB(); \
        o0 = A8_MFMA(PP, vf0_, o0); A8_SB(); A8_EX8(C1, 0); A8_SB(); \
        o1 = A8_MFMA(PP, vf1_, o1); A8_SB(); A8_EX8(C1, 8); A8_SB(); \
        lacc = A8_MFMA(PP, ones8, lacc); A8_SB(); \
        _Pragma("unroll") for (int k = 0; k < 4; ++k) { int w_; asm volatile("" : "=v"(w_)); w_ = __builtin_amdgcn_cvt_pk_fp8_f32(C0[4 * k], C0[4 * k + 1], w_, false); w_ = __builtin_amdgcn_cvt_pk_fp8_f32(C0[4 * k + 2], C0[4 * k + 3], w_, true); PC[k] = w_; \
            int v_; asm volatile("" : "=v"(v_)); v_ = __builtin_amdgcn_cvt_pk_fp8_f32(C1[4 * k], C1[4 * k + 1], v_, false); v_ = __builtin_amdgcn_cvt_pk_fp8_f32(C1[4 * k + 2], C1[4 * k + 3], v_, true); PC[4 + k] = v_; } \
        A8_SB(); } while (0)
    i32x8 pA, pB;
#pragma unroll
    for (int k = 0; k < 8; ++k) { pA[k] = 0; pB[k] = 0; }
    for (int t = 0; t < NT; t += 4) {
        asm volatile("s_waitcnt vmcnt(0) lgkmcnt(0)\n\ts_barrier" ::: "memory");
        if (isk) {
#pragma unroll
            for (int j = 5; j <= 8; ++j) if (t + j < NT) A8_DMA(t + j);
        } else {
#pragma unroll
            for (int j = 3; j <= 6; ++j) if (t + j < NT) A8_DMA(t + j);
        }
        bg.step();
        A8_TILE(sA0, sA1, sB0, sB1, pB, pA, t + 1, (t > 0 ? t - 1 : 0));
        A8_TILE(sB0, sB1, sA0, sA1, pA, pB, t + 2, t);
        A8_TILE(sA0, sA1, sB0, sB1, pB, pA, t + 3, t + 1);
        A8_TILE(sB0, sB1, sA0, sA1, pA, pB, t + 4, t + 2);
    }
    asm volatile("s_waitcnt vmcnt(0) lgkmcnt(0)\n\ts_barrier" ::: "memory");
    {
        const lds_cptr vp_ = vbase + ((NT - 1) & (NS - 1)) * SLOT; const i32x8 vf0_ = frag(vp_), vf1_ = frag(vp_ + 512);
        o0 = A8_MFMA(pB, vf0_, o0); o1 = A8_MFMA(pB, vf1_, o1); lacc = A8_MFMA(pB, ones8, lacc); }
#undef A8_EX8
#undef A8_TILE
#undef A8_SB
    (void)wsf;
    float rli[16];
#pragma unroll
    for (int r = 0; r < 16; ++r) rli[r] = __builtin_amdgcn_rcpf(lacc[r]);
    bf16* Ow = T.O + (size_t)(q0 + wid * QBLK) * 512 + h * 64;
    { bf16* stg = (bf16*)(shm + LDS_OST) + wid * 2048;
#pragma unroll
      for (int r = 0; r < 16; ++r) { const int orow = crow(r, hi); stg[orow * 64 + r32] = __float2bfloat16(o0[r] * rli[r]); stg[orow * 64 + 32 + r32] = __float2bfloat16(o1[r] * rli[r]); }
      asm volatile("s_waitcnt lgkmcnt(0)" ::: "memory");
#pragma unroll
      for (int i = 0; i < 4; ++i) { const int row = i * 8 + (lane >> 3), ch = lane & 7; const u32x4 v = *(const u32x4*)(stg + row * 64 + ch * 8); *(u32x4*)(Ow + (size_t)row * 512 + ch * 8) = v; } }
    asm volatile("s_waitcnt vmcnt(0) lgkmcnt(0)\n\ts_barrier" ::: "memory");
#undef A8_DMA
}
template <class Bg>
__device__ __forceinline__ void phase(char* lds, const Tensors& T, int grid, int block, int wave_, float negM8, Bg& bg) {
    const int vcu = (grid % 8 == 0) ? (block % 8) * (grid / 8) + block / 8 : block;
    constexpr int NU = NHEAD * NQB;
    if (NU % grid == 0) { const int per = NU / grid; for (int i = 0; i < per; ++i) { const int uu = vcu * per + i; unit(uu / NQB, uu % NQB, T, lds, wave_, negM8, bg); } }
    else for (int uu = vcu; uu < NU; uu += grid) unit(uu / NQB, uu % NQB, T, lds, wave_, negM8, bg);
}
#undef A8_MFMA
}

namespace hg {
typedef short bf16x8 __attribute__((ext_vector_type(8)));
typedef short s16x4 __attribute__((ext_vector_type(4)));
constexpr int CH = 32, SEGT = 512, NSEG = S / SEGT, NCH = SEGT / CH;
constexpr int RS = 272, TS = 80;
constexpr int QOFF = 0, KOFF = 32 * RS, KTOFF = 2 * 32 * RS, VTOFF = KTOFF + 128 * TS, DOFF = VTOFF + 128 * TS, GOFF = DOFF + 512, BUFB = GOFF + 4096;
static_assert(2 * BUFB <= 131072, "hgrn LDS");
#define HG_MFMA(a, b, c) __builtin_amdgcn_mfma_f32_16x16x32_bf16((a), (b), (c), 0, 0, 0)
__device__ __forceinline__ unsigned pkbf(float lo, float hi) { typedef float f2 __attribute__((ext_vector_type(2))); typedef __bf16 b2 __attribute__((ext_vector_type(2))); f2 v = {lo, hi}; b2 b = __builtin_convertvector(v, b2); return __builtin_bit_cast(unsigned, b); }

typedef float f32x2h __attribute__((ext_vector_type(2)));
template <bool OUT>
__device__ __forceinline__ void chunk_matrix(LAS unsigned char* B, f32x4 (&Sacc)[8], int c16, int g, int e0, int dir, int h, int p0c, float* __restrict__ OF) {
    if (OUT) {
        f32x4 X00 = {0.f, 0.f, 0.f, 0.f}, X01 = X00, X11 = X00;
#pragma unroll
        for (int s = 0; s < 4; ++s) {
            const bf16x8 aK0 = *(const LAS bf16x8*)(B + KOFF + c16 * RS + (32 * s + 8 * g) * 2), aK1 = *(const LAS bf16x8*)(B + KOFF + (16 + c16) * RS + (32 * s + 8 * g) * 2);
            const bf16x8 bQ0 = *(const LAS bf16x8*)(B + QOFF + c16 * RS + (32 * s + 8 * g) * 2), bQ1 = *(const LAS bf16x8*)(B + QOFF + (16 + c16) * RS + (32 * s + 8 * g) * 2);
            X00 = HG_MFMA(aK0, bQ0, X00); X01 = HG_MFMA(aK0, bQ1, X01); X11 = HG_MFMA(aK1, bQ1, X11);
        }
#pragma unroll
        for (int r = 0; r < 4; ++r) { const bool keep = (4 * g + r) <= c16; X00[r] = keep ? X00[r] : 0.f; X11[r] = keep ? X11[r] : 0.f; }
        u32x4 a0w, a1w; a0w.x = pkbf(X00[0], X00[1]); a0w.y = pkbf(X00[2], X00[3]); a0w.z = 0u; a0w.w = 0u;
        a1w.x = pkbf(X01[0], X01[1]); a1w.y = pkbf(X01[2], X01[3]); a1w.z = pkbf(X11[0], X11[1]); a1w.w = pkbf(X11[2], X11[3]);
        const u32x2 vlo = *(const LAS u32x2*)(B + VTOFF + (e0 + c16) * TS + (4 * g) * 2), vhi = *(const LAS u32x2*)(B + VTOFF + (e0 + c16) * TS + (16 + 4 * g) * 2);
        u32x4 vbw; vbw.x = vlo.x; vbw.y = vlo.y; vbw.z = vhi.x; vbw.w = vhi.y;
        const bf16x8 vb = __builtin_bit_cast(bf16x8, vbw);
        f32x4 O0 = {0.f, 0.f, 0.f, 0.f}, O1 = O0;
        O0 = HG_MFMA(__builtin_bit_cast(bf16x8, a0w), vb, O0); O1 = HG_MFMA(__builtin_bit_cast(bf16x8, a1w), vb, O1);
#pragma unroll
        for (int s = 0; s < 4; ++s) {
            u32x4 sw; sw.x = pkbf(Sacc[2 * s][0], Sacc[2 * s][1]); sw.y = pkbf(Sacc[2 * s][2], Sacc[2 * s][3]); sw.z = pkbf(Sacc[2 * s + 1][0], Sacc[2 * s + 1][1]); sw.w = pkbf(Sacc[2 * s + 1][2], Sacc[2 * s + 1][3]);
            const bf16x8 sb = __builtin_bit_cast(bf16x8, sw);
            const u32x2 q0l = *(const LAS u32x2*)(B + QOFF + c16 * RS + (32 * s + 4 * g) * 2), q0h = *(const LAS u32x2*)(B + QOFF + c16 * RS + (32 * s + 16 + 4 * g) * 2);
            const u32x2 q1l = *(const LAS u32x2*)(B + QOFF + (16 + c16) * RS + (32 * s + 4 * g) * 2), q1h = *(const LAS u32x2*)(B + QOFF + (16 + c16) * RS + (32 * s + 16 + 4 * g) * 2);
            u32x4 q0w, q1w; q0w.x = q0l.x; q0w.y = q0l.y; q0w.z = q0h.x; q0w.w = q0h.y; q1w.x = q1l.x; q1w.y = q1l.y; q1w.z = q1h.x; q1w.w = q1h.y;
            O0 = HG_MFMA(__builtin_bit_cast(bf16x8, q0w), sb, O0); O1 = HG_MFMA(__builtin_bit_cast(bf16x8, q1w), sb, O1);
        }
        { const int gm = dir ? 3 - g : g; const unsigned ooff = (unsigned)(4 * gm) * 512u + (unsigned)(e0 + c16);
          GAS float* ofu = (GAS float*)OF + (size_t)dir * S * 512 + h * 128;
          const int Tb = dir ? (S - 32 - p0c) : p0c;
#pragma unroll
          for (int r = 0; r < 4; ++r) {
              ofu[(size_t)(Tb + (dir ? 16 + 3 - r : r)) * 512 + ooff] = O0[r];
              ofu[(size_t)(Tb + (dir ? 3 - r : 16 + r)) * 512 + ooff] = O1[r];
          } }
    }
    {
        const bf16x8 vB = *(const LAS bf16x8*)(B + VTOFF + (e0 + c16) * TS + (8 * g) * 2);
#pragma unroll
        for (int dt = 0; dt < 8; ++dt) {
            const bf16x8 aT = *(const LAS bf16x8*)(B + KTOFF + (16 * dt + c16) * TS + (8 * g) * 2);
            Sacc[dt] = HG_MFMA(aT, vB, Sacc[dt]);
            const f32x4 dv = *(const LAS f32x4*)(B + DOFF + (16 * dt + 4 * g) * 4);
            Sacc[dt] = Sacc[dt] * dv;
        }
    }
}
template <bool OUT>
__device__ __forceinline__ void segment(LAS unsigned char* lds, int unit, const bf16_t* __restrict__ HQ, const float* __restrict__ LF, const bf16_t* __restrict__ KF,
                                        const bf16_t* __restrict__ HV, float* __restrict__ HST, float* __restrict__ HSD, float* __restrict__ OF, int wave_) {
    const int tid_ = wave_ * 64 + lane_id_opaque();
    const int tid = tid_, lane = tid & 63, w = __builtin_amdgcn_readfirstlane(tid >> 6), c16 = lane & 15, g = lane >> 4;
    const int dir = unit >> 7, h = (unit >> 5) & 3, seg = unit & 31;
    const int d0 = 2 * (tid & 63), tg = tid >> 6;
    f32x4 Sacc[8];
    float* hst = HST + (size_t)unit * 16384 + (size_t)w * 2048 + lane;
    if (OUT) {
#pragma unroll
        for (int dt = 0; dt < 8; ++dt) { Sacc[dt][0] = hst[(dt * 4 + 0) * 64]; Sacc[dt][1] = hst[(dt * 4 + 1) * 64]; Sacc[dt][2] = hst[(dt * 4 + 2) * 64]; Sacc[dt][3] = hst[(dt * 4 + 3) * 64]; }
    } else {
#pragma unroll
        for (int dt = 0; dt < 8; ++dt) Sacc[dt] = f32x4{0.f, 0.f, 0.f, 0.f};
    }
    f32x2h segsum = {0.f, 0.f};
    const int e0 = 16 * w;
    constexpr int RING = 2;
    f32x2h rl[RING][4]; unsigned rk[RING][4], rq[RING][4], rv[RING][4];
    const int tgm = dir ? 7 - tg : tg;
    const unsigned toff = (unsigned)(4 * tgm) * 512u + (unsigned)d0;
    const GAS float* lfu = (const GAS float*)LF + (size_t)dir * S * 512 + h * 128;
    const GAS bf16_t* kfu = (const GAS bf16_t*)KF + (size_t)dir * S * 512 + h * 128;
    const GAS bf16_t* hqu = (const GAS bf16_t*)HQ + h * 128; const GAS bf16_t* hvu = (const GAS bf16_t*)HV + h * 128;
#define HG_LOAD(sl, cc) do { const int Tb_ = dir ? (S - 32 - (seg * SEGT + (cc) * CH)) : (seg * SEGT + (cc) * CH); \
        _Pragma("unroll") for (int jj = 0; jj < 4; ++jj) { const size_t ub_ = (size_t)(Tb_ + (dir ? 3 - jj : jj)) * 512; \
        rl[sl][jj] = *(const GAS f32x2h*)(lfu + ub_ + toff); rk[sl][jj] = *(const GAS unsigned*)(kfu + ub_ + toff); rv[sl][jj] = *(const GAS unsigned*)(hvu + ub_ + toff); \
        rq[sl][jj] = OUT ? *(const GAS unsigned*)(hqu + ub_ + toff) : 0u; } } while (0)
#pragma unroll
    for (int sl = 0; sl < RING; ++sl) HG_LOAD(sl, sl);
    for (int c4 = 0; c4 < NCH; c4 += RING) {
#pragma unroll
        for (int sl = 0; sl < RING; ++sl) {
            const int c = c4 + sl;
            LAS unsigned char* B = lds + (c & 1) * BUFB;
            f32x2h cs[4]; unsigned kk[4], qq[4], vv[4];
#pragma unroll
            for (int jj = 0; jj < 4; ++jj) { cs[jj] = rl[sl][jj]; kk[jj] = rk[sl][jj]; qq[jj] = rq[sl][jj]; vv[jj] = rv[sl][jj]; }
            if (c + RING < NCH) HG_LOAD(sl, c + RING);
#pragma unroll
            for (int jj = 1; jj < 4; ++jj) cs[jj] += cs[jj - 1];
            LAS float* gs = (LAS float*)(B + GOFF);
            *(LAS f32x2h*)(gs + tg * 128 + d0) = cs[3];
            __syncthreads();
            f32x2h off = {0.f, 0.f}, tot = {0.f, 0.f};
#pragma unroll
            for (int q = 0; q < 8; ++q) { const f32x2h gq = *(const LAS f32x2h*)(gs + q * 128 + d0); tot += gq; if (q < tg) off += gq; }
            float kt0[4], kt1[4];
#pragma unroll
            for (int jj = 0; jj < 4; ++jj) {
                const float b0 = fmaxf(off.x + cs[jj].x, -80.f), b1 = fmaxf(off.y + cs[jj].y, -80.f);
                kt0[jj] = bflo(kk[jj]) * __expf(-b0); kt1[jj] = bfhi(kk[jj]) * __expf(-b1);
                if (OUT) {
                    *(LAS unsigned*)(B + QOFF + (4 * tg + jj) * RS + d0 * 2) = pkbf(bflo(qq[jj]) * __expf(b0), bfhi(qq[jj]) * __expf(b1));
                    *(LAS unsigned*)(B + KOFF + (4 * tg + jj) * RS + d0 * 2) = pkbf(kt0[jj], kt1[jj]);
                }
            }
            { u32x2 o0, o1; o0.x = pkbf(kt0[0], kt0[1]); o0.y = pkbf(kt0[2], kt0[3]); o1.x = pkbf(kt1[0], kt1[1]); o1.y = pkbf(kt1[2], kt1[3]);
              *(LAS u32x2*)(B + KTOFF + d0 * TS + 8 * tg) = o0; *(LAS u32x2*)(B + KTOFF + (d0 + 1) * TS + 8 * tg) = o1;
              u32x2 v0, v1; v0.x = (vv[0] & 0xffffu) | (vv[1] << 16); v0.y = (vv[2] & 0xffffu) | (vv[3] << 16); v1.x = (vv[0] >> 16) | (vv[1] & 0xffff0000u); v1.y = (vv[2] >> 16) | (vv[3] & 0xffff0000u);
              *(LAS u32x2*)(B + VTOFF + d0 * TS + 8 * tg) = v0; *(LAS u32x2*)(B + VTOFF + (d0 + 1) * TS + 8 * tg) = v1; }
            if (tg == 0) { f32x2h dv; dv.x = __expf(fmaxf(tot.x, -80.f)); dv.y = __expf(fmaxf(tot.y, -80.f)); *(LAS f32x2h*)(B + DOFF + d0 * 4) = dv; }
            segsum += tot;
            __syncthreads();
            chunk_matrix<OUT>(B, Sacc, c16, g, e0, dir, h, seg * SEGT + c * CH, OF);
        }
    }
    if (!OUT) {
#pragma unroll
        for (int dt = 0; dt < 8; ++dt) { hst[(dt * 4 + 0) * 64] = Sacc[dt][0]; hst[(dt * 4 + 1) * 64] = Sacc[dt][1]; hst[(dt * 4 + 2) * 64] = Sacc[dt][2]; hst[(dt * 4 + 3) * 64] = Sacc[dt][3]; }
        if (tid < 64) { f32x2h dd; dd.x = __expf(fmaxf(segsum.x, -80.f)); dd.y = __expf(fmaxf(segsum.y, -80.f)); *(f32x2h*)(HSD + (size_t)unit * 128 + d0) = dd; }
    }
    __syncthreads();
}
__device__ __forceinline__ void carry(float* __restrict__ HST, const float* __restrict__ HSD, int gid) {
    const int chain = gid >> 14, el = gid & 16383, dt = (el >> 8) & 7, r = (el >> 6) & 3, ln = el & 63, d = 16 * dt + 4 * (ln >> 4) + r;
    float cy = 0.f;
    for (int sg = 0; sg < NSEG; ++sg) {
        const int u = chain * NSEG + sg;
        const float tmp = HST[(size_t)u * 16384 + el];
        HST[(size_t)u * 16384 + el] = cy;
        cy = HSD[(size_t)u * 128 + d] * cy + tmp;
    }
}
#undef HG_MFMA
#undef HG_LOAD
}

#define XB_TMO      128
#define XB_XCNT(j)  (256  + 64 * (j))
#define XB_XSUB(j)  (1280 + 64 * (j))
#define XB_XGEN(j)  (2304 + 64 * (j))
#define XB_TOP      3328
#define XB_TOPGEN   3392
#define XCD_BAR_WORDS 3456
#define XB_SPIN_CAP (1u << 18)

__device__ __forceinline__ unsigned xb_ld(unsigned* p)              { return __hip_atomic_load(p, __ATOMIC_RELAXED, __HIP_MEMORY_SCOPE_AGENT); }
__device__ __forceinline__ unsigned xb_add(unsigned* p, unsigned v) { return __hip_atomic_fetch_add(p, v, __ATOMIC_RELAXED, __HIP_MEMORY_SCOPE_AGENT); }
__device__ __forceinline__ unsigned xb_xcc_id() { return (unsigned)__builtin_amdgcn_s_getreg((3 << 11) | 20) & 0xFu; }
#define XB_SPIN(cond, bar) do { unsigned _sp = 0; while (cond) { __builtin_amdgcn_s_sleep(1); \
    if ((++_sp & 255u) == 0u) { if (xb_ld(&(bar)[XB_TMO])) break; if (_sp > XB_SPIN_CAP) { atomicAdd(&(bar)[XB_TMO], 1u); break; } } } } while (0)

struct XcdBarrier {
    int wv;
    unsigned* bar; unsigned x;
    volatile LAS unsigned* st;
};

__device__ __forceinline__ XcdBarrier xcd_barrier_post(unsigned* bar, volatile LAS unsigned* st) {
    XcdBarrier b; b.bar = bar; b.x = xb_xcc_id(); b.st = st; b.wv = __builtin_amdgcn_readfirstlane((int)threadIdx.x >> 6);
    if (threadIdx.x == 0) (void)xb_add(&bar[XB_XCNT(b.x)], 1u);
    return b;
}
__device__ __forceinline__ void xcd_barrier_complete(unsigned* bar, unsigned x, unsigned& nloc, unsigned& nx) {
    const unsigned G = gridDim.x * gridDim.y * gridDim.z;
    unsigned sum, cnt, mine, sp = 0u;
    for (;;) {
        sum = 0u; cnt = 0u; mine = 0u;
#pragma unroll
        for (unsigned j = 0; j < 16; ++j) { const unsigned c = xb_ld(&bar[XB_XCNT(j)]); sum += c; cnt += (c > 0u) ? 1u : 0u; mine = (j == x) ? c : mine; }
        if (sum == G) break;
        __builtin_amdgcn_s_sleep(1);
        if ((++sp & 255u) == 0u) { if (xb_ld(&bar[XB_TMO])) break; if (sp > XB_SPIN_CAP) { atomicAdd(&bar[XB_TMO], 1u); break; } }
    }
    nloc = mine > 0u ? mine : 1u; nx = cnt > 0u ? cnt : 1u;
}

__device__ __forceinline__ void xcd_barrier(const XcdBarrier& b) {
    asm volatile("s_waitcnt vmcnt(0)" ::: "memory");
    __syncthreads();
    if (b.wv == 0 && lane_id_opaque() == 0) {
        unsigned* bar = b.bar;
        __builtin_amdgcn_s_waitcnt(0);
        unsigned nloc = b.st[0], nx = b.st[1];
        if (nloc == 0u) { xcd_barrier_complete(bar, b.x, nloc, nx); b.st[0] = nloc; b.st[1] = nx; }
        const unsigned old = xb_add(&bar[XB_XSUB(b.x)], 1u);
        const unsigned gen = old / nloc;
        if (old + 1u == (gen + 1u) * nloc) {
            __builtin_amdgcn_fence(__ATOMIC_RELEASE, "agent");
            asm volatile("s_waitcnt vmcnt(0)" ::: "memory");
            const unsigned og = xb_add(&bar[XB_TOP], 1u);
            const unsigned tg = og / nx;
            if (og + 1u == (tg + 1u) * nx) xb_add(&bar[XB_TOPGEN], 1u);
            else XB_SPIN(xb_ld(&bar[XB_TOPGEN]) == tg, bar);
            __builtin_amdgcn_fence(__ATOMIC_ACQUIRE, "agent");
            xb_add(&bar[XB_XGEN(b.x)], 1u);
            asm volatile("s_waitcnt vmcnt(0)" ::: "memory");
        } else {
            XB_SPIN(xb_ld(&bar[XB_XGEN(b.x)]) == gen, bar);
            __builtin_amdgcn_fence(__ATOMIC_ACQUIRE, "agent");
            asm volatile("s_waitcnt vmcnt(0)" ::: "memory");
        }
    }
    __syncthreads();
}

constexpr int NWAVES = 8;
constexpr int RING_OFF = 0, RING_BYTES = 131072;
constexpr int LDSCTL_OFF = RING_BYTES, MISC_OFF = LDSCTL_OFF + 320;
constexpr int LDS_BYTES = 147456;
constexpr int CW_BAR = 4096;
constexpr int NPL = 12;
constexpr int PH_PRO = 0, PH_NORM1 = 1, PH_L0 = 2, PH_END = PH_L0 + NL * NPL;
enum { P_G1 = 0, P_QKP = 1, P_HGB = 2, P_HGC = 3, P_ATT = 4, P_G2 = 5, P_G3 = 6, P_N2R = 7, P_TOPK = 8, P_G4 = 9, P_G5 = 10, P_COMB = 11 };

#ifndef ATTN_FP8
#define ATTN_FP8 1
#endif
#ifndef KEEP_BF16_QK
#define KEEP_BF16_QK (!ATTN_FP8)
#endif
#ifndef REP_HG
#define REP_HG 1
#endif
#ifndef REP_PRO
#define REP_PRO 1
#endif
#ifndef REP_ROW
#define REP_ROW 1
#endif
#ifndef REP_G
#define REP_G 1
#endif
#ifndef REP_TK
#define REP_TK 1
#endif
#ifndef REP_QK
#define REP_QK 1
#endif
#ifndef REP_ATT
#define REP_ATT 1
#endif
struct Params {
    const float *x, *c, *ada_w, *ada_b, *norm_mix_w, *norm_ffn_w, *w_in, *q_norm_w, *k_norm_w, *hlb, *hg_norm_w, *w_ba, *w_bh, *w_out, *w_router, *w_eg, *w_eu, *w_ed;
    float* out; unsigned char* ws;
    int ph_lo, ph_hi, li, pad;
};
struct Frame {
    LAS unsigned char* lds;
    int tid, lane, wave, vcu, G;
};

__device__ __forceinline__ void tr_tile(const float* __restrict__ src, int ldw, bf16_t* __restrict__ dst, int Kd, LAS float* scr, int lane) {
    f32x4 v[8];
#pragma unroll
    for (int i = 0; i < 8; ++i) v[i] = *(const f32x4*)(src + (size_t)(8 * i + (lane >> 3)) * ldw + 4 * (lane & 7));
#pragma unroll
    for (int i = 0; i < 8; ++i) { LAS float* s = scr + (8 * i + (lane >> 3)) * 33 + 4 * (lane & 7); s[0] = v[i].x; s[1] = v[i].y; s[2] = v[i].z; s[3] = v[i].w; }
    asm volatile("s_waitcnt lgkmcnt(0)" ::: "memory");
    const int cch = lane & 7;
#pragma unroll
    for (int j = 0; j < 4; ++j) { const int n = (lane >> 3) + 8 * j; const LAS float* s = scr + (8 * cch) * 33 + n;
        u32x4 o; o.x = pk2(s[0 * 33], s[1 * 33]); o.y = pk2(s[2 * 33], s[3 * 33]); o.z = pk2(s[4 * 33], s[5 * 33]); o.w = pk2(s[6 * 33], s[7 * 33]);
        *(u32x4*)(dst + (size_t)n * Kd + 8 * cch) = o; }
    asm volatile("s_waitcnt lgkmcnt(0)" ::: "memory");
}
struct ConvItem { const float* src; unsigned char* dst; int ldw, Kd; };
__device__ __forceinline__ ConvItem conv_item_f8(const Params& p, int l, int it) {
    ConvItem c;
    const int which = it / (NE * 1024), r0 = it % (NE * 1024), e = r0 >> 10, r = r0 & 1023;
    if (which < 2) {
        const int kb = r >> 6, nb = r & 63, n0 = 32 * nb;
        const float* W = (which == 0 ? p.w_eg : p.w_eu) + (size_t)(l * NE + e) * D * FF;
        const int rho = e * 4096 + (n0 >> 7) * 256 + which * 128 + (n0 & 127);
        c.src = W + (size_t)(64 * kb) * FF + n0; c.ldw = FF; c.dst = p.ws + WS_WGU + (size_t)l * 64 * MiB + (size_t)rho * D + 64 * kb; c.Kd = D;
    } else {
        const int kb = r >> 5, nb = r & 31, n0 = 32 * nb;
        const float* W = p.w_ed + (size_t)(l * NE + e) * FF * D;
        c.src = W + (size_t)(64 * kb) * D + n0; c.ldw = D; c.dst = p.ws + WS_WD + (size_t)l * 32 * MiB + (size_t)(e * 1024 + n0) * FF + 64 * kb; c.Kd = FF;
    }
    return c;
}
__device__ __forceinline__ void conv_load8(const ConvItem& c, int lane, f32x4 (&v)[8]) {
#pragma unroll
    for (int i = 0; i < 8; ++i) v[i] = *(const f32x4*)(c.src + (size_t)(8 * i + (lane >> 3)) * c.ldw + 4 * (lane & 7));
}
__device__ __forceinline__ void conv_store_f8(const ConvItem& c, int lane, const f32x4 (&v)[8], LAS float* scr, float scale) {
#pragma unroll
    for (int i = 0; i < 8; ++i) { LAS float* s = scr + (8 * i + (lane >> 3)) * 33 + 4 * (lane & 7); s[0] = v[i].x; s[1] = v[i].y; s[2] = v[i].z; s[3] = v[i].w; }
    asm volatile("s_waitcnt lgkmcnt(0)" ::: "memory");
    const int cch = lane & 7;
#pragma unroll
    for (int j = 0; j < 4; ++j) { const int n = (lane >> 3) + 8 * j; const LAS float* s = scr + (8 * cch) * 33 + n;
        const f32x4 a = {s[0 * 33] * scale, s[1 * 33] * scale, s[2 * 33] * scale, s[3 * 33] * scale}, b = {s[4 * 33] * scale, s[5 * 33] * scale, s[6 * 33] * scale, s[7 * 33] * scale};
        *(u32x2*)(c.dst + (size_t)n * c.Kd + 8 * cch) = pg8::pack8_fp8(a, b); }
    asm volatile("s_waitcnt lgkmcnt(0)" ::: "memory");
}
struct BgNone { __device__ __forceinline__ void step() {} };
struct BgConv {
    const float *eg, *eu, *ed; unsigned char* ws; LAS unsigned char* scr; int lane, it, stride, nit, l; bool have; ConvItem cur; f32x4 v[4];
    __device__ __forceinline__ ConvItem item(int i) const {
        ConvItem c; const int it_ = i;
        const int which = it_ / (NE * 2048), r0 = it_ % (NE * 2048), e = r0 >> 11, r = r0 & 2047;
        if (which < 2) { const int kb = r >> 6, nb = r & 63, n0 = 32 * nb; const float* W = (which == 0 ? eg : eu) + (size_t)(l * NE + e) * D * FF;
            const int rho = e * 4096 + (n0 >> 7) * 256 + which * 128 + (n0 & 127);
            c.src = W + (size_t)(32 * kb) * FF + n0; c.ldw = FF; c.dst = ws + WS_WGU + (size_t)l * 64 * MiB + (size_t)rho * D + 32 * kb; c.Kd = D; }
        else { const int kb = r >> 5, nb = r & 31, n0 = 32 * nb; const float* W = ed + (size_t)(l * NE + e) * FF * D;
            c.src = W + (size_t)(32 * kb) * D + n0; c.ldw = D; c.dst = ws + WS_WD + (size_t)l * 32 * MiB + (size_t)(e * 1024 + n0) * FF + 32 * kb; c.Kd = FF; }
        return c; }
    __device__ __forceinline__ void load(const ConvItem& c) {
#pragma unroll
        for (int i = 0; i < 4; ++i) v[i] = *(const GAS f32x4*)((const GAS float*)c.src + (size_t)(8 * i + (lane >> 3)) * c.ldw + 4 * (lane & 7));
    }
    __device__ __forceinline__ void init(const Params& p, int layer, LAS unsigned char* scr_, int lane_, int gw, int ngw) {
        eg = p.w_eg; eu = p.w_eu; ed = p.w_ed; ws = p.ws; l = layer; scr = scr_; lane = lane_; it = gw; stride = ngw; nit = 3 * NE * 2048; have = it < nit;
        if (have) { cur = item(it); load(cur); }
    }
    __device__ __forceinline__ void process(const ConvItem& c, const f32x4 (&w)[4]) {
        LAS unsigned* s32 = (LAS unsigned*)scr;
#pragma unroll
        for (int i = 0; i < 4; ++i) { int wd; asm volatile("" : "=v"(wd)); wd = __builtin_amdgcn_cvt_pk_fp8_f32(w[i].x * 64.0f, w[i].y * 64.0f, wd, false); wd = __builtin_amdgcn_cvt_pk_fp8_f32(w[i].z * 64.0f, w[i].w * 64.0f, wd, true);
            s32[(8 * i + (lane >> 3)) * 9 + (lane & 7)] = (unsigned)wd; }
        asm volatile("s_waitcnt lgkmcnt(0)" ::: "memory");
        const int cch = lane & 3;
#pragma unroll
        for (int j = 0; j < 2; ++j) { const int n = (lane >> 2) + 16 * j; const LAS unsigned char* s = scr + (8 * cch) * 36 + n;
            u32x2 o; o.x = (unsigned)s[0] | ((unsigned)s[36] << 8) | ((unsigned)s[72] << 16) | ((unsigned)s[108] << 24);
            o.y = (unsigned)s[144] | ((unsigned)s[180] << 8) | ((unsigned)s[216] << 16) | ((unsigned)s[252] << 24);
            *(GAS u32x2*)((GAS unsigned char*)c.dst + (size_t)n * c.Kd + 8 * cch) = o; }
        asm volatile("s_waitcnt lgkmcnt(0)" ::: "memory");
    }
    __device__ __forceinline__ void step() {
        if (!have) return;
        const ConvItem c = cur; f32x4 w[4];
#pragma unroll
        for (int i = 0; i < 4; ++i) w[i] = v[i];
        it += stride; have = it < nit;
        if (have) { cur = item(it); load(cur); }
        process(c, w);
    }
    __device__ __forceinline__ void finish() { while (have) step(); }
};
__device__ __forceinline__ void conv_experts_f8(Frame& F, const Params& p, int l, LAS float* scr) {
    const int gw = F.vcu * NWAVES + F.wave, NGW = F.G * NWAVES, NIT = 3 * NE * 1024;
    int it = gw; if (it >= NIT) return;
    ConvItem cur = conv_item_f8(p, l, it); f32x4 va[8], vb[8];
    conv_load8(cur, F.lane, va);
    for (;;) {
        const int it1 = it + NGW; const bool h1 = it1 < NIT; ConvItem c1 = conv_item_f8(p, l, h1 ? it1 : it);
        if (h1) conv_load8(c1, F.lane, vb);
        conv_store_f8(cur, F.lane, va, scr, 64.0f);
        if (!h1) break;
        const int it2 = it1 + NGW; const bool h2 = it2 < NIT; ConvItem c2 = conv_item_f8(p, l, h2 ? it2 : it1);
        if (h2) conv_load8(c2, F.lane, va);
        conv_store_f8(c1, F.lane, vb, scr, 64.0f);
        if (!h2) break;
        cur = c2; it = it2;
    }
}
__device__ __forceinline__ void conv_matrix(Frame& F, const float* W, int ldw, int K, int N, bf16_t* WT, LAS float* scr) {
    const int gw = F.vcu * NWAVES + F.wave, NGW = F.G * NWAVES, nblk = N / 32, nitems = (K / 64) * nblk;
    for (int it = gw; it < nitems; it += NGW) { const int kb = it / nblk, nb = it % nblk;
        tr_tile(W + (size_t)(64 * kb) * ldw + 32 * nb, ldw, WT + (size_t)(32 * nb) * K + 64 * kb, K, scr, F.lane); }
}
__device__ __forceinline__ void conv_matrix_f8(Frame& F, const float* W, int ldw, int K, int N, unsigned char* WT, LAS float* scr, float scale) {
    const int gw = F.vcu * NWAVES + F.wave, NGW = F.G * NWAVES, nblk = N / 32, nitems = (K / 64) * nblk;
    for (int it = gw; it < nitems; it += NGW) { const int kb = it / nblk, nb = it % nblk;
        ConvItem c; c.src = W + (size_t)(64 * kb) * ldw + 32 * nb; c.ldw = ldw; c.dst = WT + (size_t)(32 * nb) * K + 64 * kb; c.Kd = K;
        f32x4 v[8]; conv_load8(c, F.lane, v); conv_store_f8(c, F.lane, v, scr, scale); }
}
__device__ __forceinline__ void conv_experts(Frame& F, const Params& p, int l, LAS float* scr) {
    const int gw = F.vcu * NWAVES + F.wave, NGW = F.G * NWAVES;
    bf16_t* WGU = (bf16_t*)(p.ws + WS_WGU); bf16_t* WD = (bf16_t*)(p.ws + WS_WD);
    for (int it = gw; it < 3 * NE * 1024; it += NGW) {
        const int which = it / (NE * 1024), r0 = it % (NE * 1024), e = r0 >> 10, r = r0 & 1023;
        if (which < 2) {
            const int kb = r >> 6, nb = r & 63, n0 = 32 * nb;
            const float* W = (which == 0 ? p.w_eg : p.w_eu) + (size_t)(l * NE + e) * D * FF;
            const int rho = e * 4096 + (n0 >> 7) * 256 + which * 128 + (n0 & 127);
            tr_tile(W + (size_t)(64 * kb) * FF + n0, FF, WGU + (size_t)rho * D + 64 * kb, D, scr, F.lane);
        } else {
            const int kb = r >> 5, nb = r & 31, n0 = 32 * nb;
            const float* W = p.w_ed + (size_t)(l * NE + e) * FF * D;
            tr_tile(W + (size_t)(64 * kb) * D + n0, D, WD + (size_t)(e * 1024 + n0) * FF + 64 * kb, FF, scr, F.lane);
        }
    }
}
__device__ __forceinline__ void mod_units(Frame& F, const Params& p) {
    LAS float* sc = (LAS float*)(F.lds + 96 * 1024);
    LAS float* red = sc + 1024;
    float* MOD = (float*)(p.ws + WS_MOD); float* LBV = (float*)(p.ws + WS_LBV);
    for (int u = blockIdx.x; u < NL * 96; u += F.G) {
        for (int i = F.tid; i < D; i += 512) sc[i] = siluf_(p.c[i]);
        __syncthreads();
        const int l = u / 96, j = (u % 96) * 64 + (F.tid & 63), kp = F.tid >> 6;
        const float* w = p.ada_w + (size_t)l * D * 6 * D + (size_t)(kp * 128) * 6 * D + j;
        float acc = 0.f;
#pragma unroll 8
        for (int k = 0; k < 128; ++k) acc += sc[kp * 128 + k] * w[(size_t)k * 6 * D];
        red[kp * 64 + (F.tid & 63)] = acc;
        __syncthreads();
        if (F.tid < 64) { float s = 0.f;
#pragma unroll
            for (int q = 0; q < 8; ++q) s += red[q * 64 + F.tid];
            MOD[l * 6 * D + j] = s + p.ada_b[l * 6 * D + j]; }
        __syncthreads();
    }
    const int n = blockIdx.x * 512 + F.tid;
    if (n < NL * 1024) { const int l = n / 1024, r = n % 1024; float v = 0.f;
        if (l == 1) { const float b0 = p.hlb[r], b1 = p.hlb[1024 + r]; v = 1.0f / (1.0f + __expf(b0 - b1)); }
        LBV[n] = v; }
}

__device__ __forceinline__ void norm_mod_row(const f32x4 (&v)[4], float ss, const float* __restrict__ w, const float* __restrict__ scale,
                                             const float* __restrict__ shift, bf16_t* __restrict__ orow, int lane, f32x4 (&h)[4], unsigned char* __restrict__ orow8 = nullptr) {
    const float r = rsqrtf(ss * (1.0f / D) + EPS);
#pragma unroll
    for (int j = 0; j < 4; ++j) {
        const int c0 = 4 * lane + 256 * j;
        const f32x4 wv = *(const f32x4*)(w + c0), sv = *(const f32x4*)(scale + c0), bv = *(const f32x4*)(shift + c0);
        h[j] = (v[j] * r) * wv * (sv + 1.0f) + bv;
        u32x2 o; o.x = pk2(h[j].x, h[j].y); o.y = pk2(h[j].z, h[j].w);
        *(u32x2*)(orow + c0) = o;
        if (orow8) { int wd = 0; wd = __builtin_amdgcn_cvt_pk_fp8_f32(h[j].x, h[j].y, wd, false); wd = __builtin_amdgcn_cvt_pk_fp8_f32(h[j].z, h[j].w, wd, true); *(int*)(orow8 + c0) = wd; }
    }
}
__device__ __forceinline__ void norm_mod_row_f8(const f32x4 (&v)[4], float ss, const float* __restrict__ w, const float* __restrict__ scale,
                                                const float* __restrict__ shift, unsigned char* __restrict__ orow, int lane, f32x4 (&h)[4]) {
    const float r = rsqrtf(ss * (1.0f / D) + EPS);
#pragma unroll
    for (int j = 0; j < 4; ++j) {
        const int c0 = 4 * lane + 256 * j;
        const f32x4 wv = *(const f32x4*)(w + c0), sv = *(const f32x4*)(scale + c0), bv = *(const f32x4*)(shift + c0);
        h[j] = (v[j] * r) * wv * (sv + 1.0f) + bv;
        int wd = 0; wd = __builtin_amdgcn_cvt_pk_fp8_f32(h[j].x, h[j].y, wd, false); wd = __builtin_amdgcn_cvt_pk_fp8_f32(h[j].z, h[j].w, wd, true);
        *(int*)(orow + c0) = wd;
    }
}
__device__ __forceinline__ void ph_norm1(Frame& F, const float* x, const float* w, const float* scale, const float* shift, bf16_t* HB, unsigned char* HB8) {
    const int gw = F.vcu * NWAVES + F.wave, NGW = F.G * NWAVES;
    for (int row = gw; row < S; row += NGW) {
        const f32x4* xr = (const f32x4*)(x + (size_t)row * D) + F.lane;
        f32x4 v[4], h[4]; float ss = 0.f;
#pragma unroll
        for (int j = 0; j < 4; ++j) { v[j] = xr[64 * j]; ss += (v[j].x * v[j].x + v[j].y * v[j].y) + (v[j].z * v[j].z + v[j].w * v[j].w); }
        ss = wave_sum(ss);
        norm_mod_row(v, ss, w, scale, shift, HB + (size_t)row * D, F.lane, h);
    }
}
__device__ __forceinline__ void ph_gather(Frame& F, const unsigned char* HB8, const int* IDX, unsigned char* XE8) {
    const int gw = F.vcu * NWAVES + F.wave, NGW = F.G * NWAVES;
    constexpr int PER = NE * CAP / 2048;
    if (NGW * PER == NE * CAP) {
        const int r0 = gw * PER;
        const int mine = IDX[r0 + (F.lane & 15)];
#pragma unroll
        for (int q = 0; q < PER; q += 8) {
            u32x4 a[8];
#pragma unroll
            for (int k = 0; k < 8; ++k) { const int t = __builtin_amdgcn_readlane(mine, q + k); a[k] = ((const u32x4*)(HB8 + (size_t)t * D))[F.lane]; }
#pragma unroll
            for (int k = 0; k < 8; ++k) ((u32x4*)(XE8 + (size_t)(r0 + q + k) * D))[F.lane] = a[k];
        }
    } else {
        for (int r = gw; r < NE * CAP; r += NGW) { const int t = IDX[r]; ((u32x4*)(XE8 + (size_t)r * D))[F.lane] = ((const u32x4*)(HB8 + (size_t)t * D))[F.lane]; }
    }
}

#define OPAQUE_LANE() const int lane = lane_id_opaque(); const int t_ = F.wave * 64 + lane
__device__ __forceinline__ void ph_rope_table(Frame& F, float* ROPE) {
    OPAQUE_LANE();
    const int n = blockIdx.x * 512 + t_;
    if (n < 4096) { const int pos = n >> 4, i = n & 15; const float inv = exp2f(-(float)i * (13.287712379549449f / 16.0f)); float sn, cs; sincosf((float)pos * inv, &sn, &cs); ROPE[2 * n] = cs; ROPE[2 * n + 1] = sn; }
}
__device__ __forceinline__ void ph_qkprep(Frame& F, const bf16_t* __restrict__ QR, const bf16_t* __restrict__ KR, const float* __restrict__ qw, const float* __restrict__ kw,
                                          const float* __restrict__ ROPE, bf16_t* __restrict__ QN, bf16_t* __restrict__ KN, unsigned char* __restrict__ Q8, unsigned char* __restrict__ K8, int rank, int nranks) {
    OPAQUE_LANE(); (void)lane;
    if (rank < 0) return;
    for (int gid = rank * 512 + t_; gid < S * 10; gid += nranks * 512) {
        const int t = gid / 10, hh = gid % 10;
        const bool isq = hh < 8;
        const bf16_t* src = isq ? QR + (size_t)t * 512 + hh * 64 : KR + (size_t)t * 128 + (hh - 8) * 64;
        bf16_t* dst = isq ? QN + (size_t)t * 512 + hh * 64 : KN + (size_t)t * 128 + (hh - 8) * 64;
        const float* w = isq ? qw : kw;
        float f[64]; float ss = 0.f;
#pragma unroll
        for (int i = 0; i < 8; ++i) { const u32x4 q = *(const u32x4*)(src + 8 * i);
#pragma unroll
            for (int j = 0; j < 4; ++j) { f[8 * i + 2 * j] = bflo(q[j]); f[8 * i + 2 * j + 1] = bfhi(q[j]); } }
#pragma unroll
        for (int i = 0; i < 64; ++i) ss += f[i] * f[i];
        const float rn = rsqrtf(ss * (1.0f / 64.0f) + EPS), sc = isq ? C2 : 1.0f;
#pragma unroll
        for (int i = 0; i < 16; ++i) { const f32x4 wv = *(const f32x4*)(w + 4 * i);
            f[4 * i] *= rn * wv.x; f[4 * i + 1] *= rn * wv.y; f[4 * i + 2] *= rn * wv.z; f[4 * i + 3] *= rn * wv.w; }
        float o[64];
#pragma unroll
        for (int ax = 0; ax < 2; ++ax) {
            const float* tb = ROPE + (size_t)(ax == 0 ? (t >> 6) : (t & 63)) * 32;
#pragma unroll
            for (int i2 = 0; i2 < 8; ++i2) { const f32x4 cs = *(const f32x4*)(tb + 4 * i2);
#pragma unroll
                for (int k = 0; k < 2; ++k) { const int i = 2 * i2 + k; const float c_ = k ? cs.z : cs.x, s_ = k ? cs.w : cs.y;
                    const float x1 = f[ax * 32 + i], x2 = f[ax * 32 + 16 + i];
                    o[ax * 32 + i] = (x1 * c_ - x2 * s_) * sc; o[ax * 32 + 16 + i] = (x2 * c_ + x1 * s_) * sc; } }
        }
#if KEEP_BF16_QK
#pragma unroll
        for (int i = 0; i < 8; ++i) { u32x4 q;
#pragma unroll
            for (int j = 0; j < 4; ++j) q[j] = pk2(o[8 * i + 2 * j], o[8 * i + 2 * j + 1]);
            *(u32x4*)(dst + 8 * i) = q; }
#else
        (void)dst;
#endif
        unsigned char* dst8 = isq ? Q8 + (size_t)t * 512 + hh * 64 : K8 + (size_t)t * 128 + (hh - 8) * 64;
#pragma unroll
        for (int i = 0; i < 4; ++i) { u32x4 q;
#pragma unroll
            for (int j = 0; j < 4; ++j) { int wd = 0; wd = __builtin_amdgcn_cvt_pk_fp8_f32(o[16 * i + 4 * j], o[16 * i + 4 * j + 1], wd, false); wd = __builtin_amdgcn_cvt_pk_fp8_f32(o[16 * i + 4 * j + 2], o[16 * i + 4 * j + 3], wd, true); q[j] = (unsigned)wd; }
            *(u32x4*)(dst8 + 16 * i) = q; }
    }
}
__device__ __forceinline__ void ph_v8t(Frame& F, const bf16_t* __restrict__ VV, unsigned char* __restrict__ V8T) {
    OPAQUE_LANE();
    const int gw = F.vcu * NWAVES + F.wave, NGW = F.G * NWAVES;
    for (int it = gw; it < 2 * (S / 64); it += NGW) {
        const int kvh = it / (S / 64), tile = it % (S / 64);
        const bf16_t* src = VV + (size_t)(64 * tile) * 128 + kvh * 64 + lane;
        u32x4 ov[4];
#pragma unroll
        for (int hi = 0; hi < 2; ++hi)
#pragma unroll
            for (int k = 0; k < 8; ++k) {
                float v[4];
#pragma unroll
                for (int b = 0; b < 4; ++b) { const int j = 4 * k + b; const int key = j < 16 ? ((j & 3) + 8 * (j >> 2) + 4 * hi) : 32 + (((j - 16) & 3) + 8 * ((j - 16) >> 2) + 4 * hi); v[b] = bf2f(src[(size_t)key * 128]); }
                int wd = 0; wd = __builtin_amdgcn_cvt_pk_fp8_f32(v[0], v[1], wd, false); wd = __builtin_amdgcn_cvt_pk_fp8_f32(v[2], v[3], wd, true);
                ov[hi * 2 + (k >> 2)][k & 3] = (unsigned)wd;
            }
        unsigned char* dst = V8T + ((size_t)it * 64 + lane) * 64;
#pragma unroll
        for (int q = 0; q < 4; ++q) *(u32x4*)(dst + 16 * q) = ov[q];
    }
}
__device__ __forceinline__ void ph_hgfin(Frame& F, const float* __restrict__ OF, const bf16_t* __restrict__ HG, const float* __restrict__ w, bf16_t* __restrict__ OHG) {
    OPAQUE_LANE();
    const int gw = F.vcu * NWAVES + F.wave, NGW = F.G * NWAVES;
    const int e0 = (lane & 15) * 8;
    const f32x4 w0 = *(const f32x4*)(w + e0), w1 = *(const f32x4*)(w + e0 + 4);
    for (int t = gw; t < S; t += NGW) {
        const size_t off = (size_t)t * 512 + lane * 8;
        const f32x4 a0 = *(const f32x4*)(OF + off), a1 = *(const f32x4*)(OF + off + 4), b0 = *(const f32x4*)(OF + (size_t)S * 512 + off), b1 = *(const f32x4*)(OF + (size_t)S * 512 + off + 4);
        const f32x4 s0 = a0 + b0, s1 = a1 + b1;
        float ss = (s0.x * s0.x + s0.y * s0.y) + (s0.z * s0.z + s0.w * s0.w) + (s1.x * s1.x + s1.y * s1.y) + (s1.z * s1.z + s1.w * s1.w);
        ss += __shfl_xor(ss, 1); ss += __shfl_xor(ss, 2); ss += __shfl_xor(ss, 4); ss += __shfl_xor(ss, 8);
        const float r = rsqrtf(ss * (1.0f / 128.0f) + EPS);
        const u32x4 g = *(const u32x4*)(HG + off);
        u32x4 o;
        o.x = pk2(s0.x * r * w0.x * bflo(g.x), s0.y * r * w0.y * bfhi(g.x));
        o.y = pk2(s0.z * r * w0.z * bflo(g.y), s0.w * r * w0.w * bfhi(g.y));
        o.z = pk2(s1.x * r * w1.x * bflo(g.z), s1.y * r * w1.y * bfhi(g.z));
        o.w = pk2(s1.z * r * w1.z * bflo(g.w), s1.w * r * w1.w * bfhi(g.w));
        *(u32x4*)(OHG + off) = o;
    }
}
__device__ __forceinline__ void ph_norm2_router(Frame& F, const float* __restrict__ X1, const float* __restrict__ w, const float* __restrict__ scale, const float* __restrict__ shift,
                                                const float* __restrict__ wr, unsigned char* __restrict__ HB, float* __restrict__ AFF) {
    OPAQUE_LANE();
    LAS float* WT = (LAS float*)F.lds;
    for (int dd = t_; dd < D; dd += NWAVES * 64) {
        const GAS f32x4* s = (const GAS f32x4*)((const GAS float*)wr + (size_t)dd * 16);
        const f32x4 a = s[0], b = s[1], c = s[2], e = s[3];
        WT[0 * D + dd] = a.x; WT[1 * D + dd] = a.y; WT[2 * D + dd] = a.z; WT[3 * D + dd] = a.w; WT[4 * D + dd] = b.x; WT[5 * D + dd] = b.y; WT[6 * D + dd] = b.z; WT[7 * D + dd] = b.w;
        WT[8 * D + dd] = c.x; WT[9 * D + dd] = c.y; WT[10 * D + dd] = c.z; WT[11 * D + dd] = c.w; WT[12 * D + dd] = e.x; WT[13 * D + dd] = e.y; WT[14 * D + dd] = e.z; WT[15 * D + dd] = e.w;
    }
    __syncthreads();
    const int gw = F.vcu * NWAVES + F.wave, NGW = F.G * NWAVES;
    for (int row = gw; row < S; row += 2 * NGW) {
        const int row1 = (row + NGW < S) ? row + NGW : row;
        const f32x4* xr0 = (const f32x4*)(X1 + (size_t)row * D) + lane; const f32x4* xr1 = (const f32x4*)(X1 + (size_t)row1 * D) + lane;
        f32x4 v0[4], v1[4], h0[4], h1[4]; float ss0 = 0.f, ss1 = 0.f;
#pragma unroll
        for (int j = 0; j < 4; ++j) { v0[j] = xr0[64 * j]; v1[j] = xr1[64 * j]; }
#pragma unroll
        for (int j = 0; j < 4; ++j) { ss0 += (v0[j].x * v0[j].x + v0[j].y * v0[j].y) + (v0[j].z * v0[j].z + v0[j].w * v0[j].w); ss1 += (v1[j].x * v1[j].x + v1[j].y * v1[j].y) + (v1[j].z * v1[j].z + v1[j].w * v1[j].w); }
        ss0 = wave_sum(ss0); ss1 = wave_sum(ss1);
        norm_mod_row_f8(v0, ss0, w, scale, shift, HB + (size_t)row * D, lane, h0);
        norm_mod_row_f8(v1, ss1, w, scale, shift, HB + (size_t)row1 * D, lane, h1);
        LAS float* wt = WT + 4 * lane; asm volatile("" : "+v"(wt));
        f32x4 lg0[4], lg1[4];
#pragma unroll
        for (int e = 0; e < 16; ++e) {
            float a0 = 0.f, a1 = 0.f;
#pragma unroll
            for (int j = 0; j < 4; ++j) { const f32x4 ww = *(const LAS f32x4*)(wt + e * D + 256 * j);
                a0 += (h0[j].x * ww.x + h0[j].y * ww.y) + (h0[j].z * ww.z + h0[j].w * ww.w); a1 += (h1[j].x * ww.x + h1[j].y * ww.y) + (h1[j].z * ww.z + h1[j].w * ww.w); }
            lg0[e >> 2][e & 3] = wave_sum(a0); lg1[e >> 2][e & 3] = wave_sum(a1);
        }
#pragma unroll
        for (int rr = 0; rr < 2; ++rr) {
            f32x4 (&lgv)[4] = rr ? lg1 : lg0;
            float mx = -1e30f;
#pragma unroll
            for (int e4 = 0; e4 < 4; ++e4) mx = fmaxf(mx, fmaxf(fmaxf(lgv[e4].x, lgv[e4].y), fmaxf(lgv[e4].z, lgv[e4].w)));
            float den = 0.f;
#pragma unroll
            for (int e4 = 0; e4 < 4; ++e4) { lgv[e4].x = __expf(lgv[e4].x - mx); lgv[e4].y = __expf(lgv[e4].y - mx); lgv[e4].z = __expf(lgv[e4].z - mx); lgv[e4].w = __expf(lgv[e4].w - mx);
                den += (lgv[e4].x + lgv[e4].y) + (lgv[e4].z + lgv[e4].w); }
            const float inv = 1.0f / den;
            const f32x4 s8a = (lane & 8) ? lgv[2] : lgv[0], s8b = (lane & 8) ? lgv[3] : lgv[1];
            const f32x4 s4 = (lane & 4) ? s8b : s8a;
            const float s2a = (lane & 2) ? s4.z : s4.x, s2b = (lane & 2) ? s4.w : s4.y;
            const float mine = ((lane & 1) ? s2b : s2a) * inv;
            const int rw = rr ? row1 : row;
            if (lane < 16 && (rr == 0 || row1 != row)) AFF[(size_t)lane * S + rw] = mine;
        }
    }
    __syncthreads();
}
__device__ __forceinline__ void ph_topk(Frame& F, LAS unsigned char* lds, int e, const float* __restrict__ AFF, int* __restrict__ IDX, float* __restrict__ TOPW, int* __restrict__ SLOT) {
    LAS unsigned* hist = (LAS unsigned*)lds;
    LAS unsigned* hsum = hist + 4096;
    LAS unsigned* shv = hsum + 256;
    LAS unsigned* scan = hsum + 512;
    OPAQUE_LANE(); const int tid = t_;
    const unsigned* vals = (const unsigned*)(AFF + (size_t)e * S);
    unsigned u[32];
#pragma unroll
    for (int i = 0; i < 8; ++i) { const u32x4 q = *(const u32x4*)(vals + tid * 32 + 4 * i); u[4 * i] = q.x; u[4 * i + 1] = q.y; u[4 * i + 2] = q.z; u[4 * i + 3] = q.w; }
    if (tid == 0) { shv[0] = 0u; shv[1] = CAP; }
    LAS unsigned* myh = hist + (lane & 15) * 256;
    __syncthreads();
    for (int pass = 3; pass >= 0; --pass) {
        const int shift = pass * 8;
        const unsigned mask = pass == 3 ? 0u : (0xFFFFFFFFu << (shift + 8));
#pragma unroll
        for (int i = 0; i < 8; ++i) hist[tid + 512 * i] = 0u;
        __syncthreads();
        const unsigned prefix = shv[0];
#pragma unroll
        for (int i = 0; i < 32; ++i) if ((u[i] & mask) == (prefix & mask)) __hip_atomic_fetch_add(&myh[(u[i] >> shift) & 255u], 1u, __ATOMIC_RELAXED, __HIP_MEMORY_SCOPE_WORKGROUP);
        __syncthreads();
        if (tid < 256) { unsigned s = 0u;
#pragma unroll
            for (int c = 0; c < 16; ++c) s += hist[c * 256 + tid];
            hsum[tid] = s; }
        __syncthreads();
        if (tid < 64) {
            const unsigned kk = shv[1];
            const unsigned h0 = hsum[4 * lane], h1 = hsum[4 * lane + 1], h2 = hsum[4 * lane + 2], h3 = hsum[4 * lane + 3];
            const unsigned tot = (h0 + h1) + (h2 + h3);
            unsigned inc = tot;
#pragma unroll
            for (int o = 1; o < 64; o <<= 1) { const unsigned v = __shfl_down(inc, o); if (lane + o < 64) inc += v; }
            unsigned c = inc - tot; int bin = -1; unsigned rem = 0u;
            if (c < kk && c + h3 >= kk) { bin = 4 * lane + 3; rem = kk - c; } c += h3;
            if (c < kk && c + h2 >= kk) { bin = 4 * lane + 2; rem = kk - c; } c += h2;
            if (c < kk && c + h1 >= kk) { bin = 4 * lane + 1; rem = kk - c; } c += h1;
            if (c < kk && c + h0 >= kk) { bin = 4 * lane; rem = kk - c; }
            if (bin >= 0) { shv[1] = rem; shv[0] = prefix | ((unsigned)bin << shift); }
        }
        __syncthreads();
    }
    const unsigned T = shv[0], need_eq = shv[1];
    unsigned ceq = 0u;
#pragma unroll
    for (int i = 0; i < 32; ++i) ceq += (u[i] == T) ? 1u : 0u;
    scan[tid] = ceq; __syncthreads();
    for (int off = 1; off < 512; off <<= 1) { const unsigned tv = tid >= off ? scan[tid - off] : 0u; __syncthreads(); scan[tid] += tv; __syncthreads(); }
    unsigned eq_rank = scan[tid] - ceq;
    __syncthreads();
    unsigned selmask = 0u, csel = 0u;
#pragma unroll
    for (int i = 0; i < 32; ++i) { bool sel = u[i] > T; if (u[i] == T) { sel = eq_rank < need_eq; ++eq_rank; } if (sel) { selmask |= 1u << i; ++csel; } }
    scan[tid] = csel; __syncthreads();
    for (int off = 1; off < 512; off <<= 1) { const unsigned tv = tid >= off ? scan[tid - off] : 0u; __syncthreads(); scan[tid] += tv; __syncthreads(); }
    unsigned slot = scan[tid] - csel;
#pragma unroll
    for (int i = 0; i < 32; ++i) {
        const int t = tid * 32 + i; int sl = -1;
        if (selmask & (1u << i)) { sl = (int)slot; ++slot; if (sl < CAP) { IDX[e * CAP + sl] = t; TOPW[e * CAP + sl] = __uint_as_float(u[i]); } }
        SLOT[(size_t)e * S + t] = sl < CAP ? sl : -1;
    }
    __syncthreads();
}
__device__ __forceinline__ void ph_combine(Frame& F, const float* __restrict__ X1, const bf16_t* __restrict__ YE, const int* __restrict__ SLOT, const float* __restrict__ gate,
                                           float* __restrict__ xout, const float* __restrict__ w, const float* __restrict__ scale, const float* __restrict__ shift, bf16_t* __restrict__ HB, unsigned char* __restrict__ HB8, bool do_norm) {
    OPAQUE_LANE();
    const int gw = F.vcu * NWAVES + F.wave, NGW = F.G * NWAVES;
    for (int row = gw; row < S; row += 2 * NGW) {
        const bool two = row + NGW < S; const int row1 = two ? row + NGW : row;
        const int sl0 = lane < NE ? SLOT[(size_t)lane * S + row] : -1, sl1 = lane < NE ? SLOT[(size_t)lane * S + row1] : -1;
        const f32x4* xr0 = (const f32x4*)(X1 + (size_t)row * D) + lane; const f32x4* xr1 = (const f32x4*)(X1 + (size_t)row1 * D) + lane;
        f32x4 v0[4], v1[4];
#pragma unroll
        for (int j = 0; j < 4; ++j) { v0[j] = xr0[64 * j]; v1[j] = xr1[64 * j]; }
        f32x4 acc0[4], acc1[4];
#pragma unroll
        for (int j = 0; j < 4; ++j) { acc0[j] = f32x4{0.f, 0.f, 0.f, 0.f}; acc1[j] = acc0[j]; }
        unsigned m0 = (unsigned)__ballot(sl0 >= 0) & 0xffffu, m1 = (unsigned)__ballot(sl1 >= 0) & 0xffffu;
        while (m0 | m1) {
            const int e0 = m0 ? __builtin_ctz(m0) : 0, e1 = m1 ? __builtin_ctz(m1) : 0;
            const float f0 = m0 ? 1.f : 0.f, f1 = m1 ? 1.f : 0.f;
            const int s0 = m0 ? __builtin_amdgcn_readlane(sl0, e0) : 0, s1 = m1 ? __builtin_amdgcn_readlane(sl1, e1) : 0;
            m0 &= m0 - 1u; m1 &= m1 - 1u;
            const bf16_t* y0 = YE + ((size_t)e0 * CAP + s0) * D + 4 * lane; const bf16_t* y1 = YE + ((size_t)e1 * CAP + s1) * D + 4 * lane;
            u32x2 q0[4], q1[4];
#pragma unroll
            for (int j = 0; j < 4; ++j) { q0[j] = *(const u32x2*)(y0 + 256 * j); q1[j] = *(const u32x2*)(y1 + 256 * j); }
#pragma unroll
            for (int j = 0; j < 4; ++j) { acc0[j].x += f0 * bflo(q0[j].x); acc0[j].y += f0 * bfhi(q0[j].x); acc0[j].z += f0 * bflo(q0[j].y); acc0[j].w += f0 * bfhi(q0[j].y);
                                          acc1[j].x += f1 * bflo(q1[j].x); acc1[j].y += f1 * bfhi(q1[j].x); acc1[j].z += f1 * bflo(q1[j].y); acc1[j].w += f1 * bfhi(q1[j].y); }
        }
        f32x4 h[4]; float ss0 = 0.f, ss1 = 0.f;
#pragma unroll
        for (int j = 0; j < 4; ++j) { const f32x4 gv = *(const f32x4*)(gate + 4 * lane + 256 * j); v0[j] = v0[j] + gv * acc0[j]; v1[j] = v1[j] + gv * acc1[j];
            ((f32x4*)(xout + (size_t)row * D) + lane)[64 * j] = v0[j]; if (two) ((f32x4*)(xout + (size_t)row1 * D) + lane)[64 * j] = v1[j];
            ss0 += (v0[j].x * v0[j].x + v0[j].y * v0[j].y) + (v0[j].z * v0[j].z + v0[j].w * v0[j].w); ss1 += (v1[j].x * v1[j].x + v1[j].y * v1[j].y) + (v1[j].z * v1[j].z + v1[j].w * v1[j].w); }
        if (do_norm) { ss0 = wave_sum(ss0); ss1 = wave_sum(ss1); norm_mod_row(v0, ss0, w, scale, shift, HB + (size_t)row * D, lane, h); if (two) norm_mod_row(v1, ss1, w, scale, shift, HB + (size_t)row1 * D, lane, h); }
    }
}

__global__ void __launch_bounds__(NWAVES * 64, 2) mega(Params p) {
    extern __shared__ __attribute__((aligned(16))) unsigned char lds[];
    Frame F;
    F.lds = (LAS unsigned char*)lds;
    volatile LAS unsigned* MISC = (volatile LAS unsigned*)(F.lds + MISC_OFF);
    F.tid = threadIdx.x; F.lane = F.tid & 63; F.wave = __builtin_amdgcn_readfirstlane(F.tid >> 6);
    F.G = gridDim.x; { const int bx = blockIdx.x; F.vcu = (F.G % 8 == 0) ? (bx % 8) * (F.G / 8) + bx / 8 : bx; }
    unsigned char* ws = p.ws;
    unsigned* ctl = (unsigned*)(ws + WS_CTL);
    for (int u = F.tid; u < (LDS_BYTES - LDSCTL_OFF) / 4; u += NWAVES * 64) ((LAS unsigned*)(F.lds + LDSCTL_OFF))[u] = 0u;
    __syncthreads();
    XcdBarrier bar = xcd_barrier_post(ctl + CW_BAR + p.li * XCD_BAR_WORDS, MISC + 8);
    const int lo = p.ph_lo, hi = p.ph_hi;
#define IN(k) (lo <= (k) && (k) < hi)
#define SEAM(k) do { if (IN(k) && IN((k) + 1)) xcd_barrier(bar); } while (0)
#define REFRESH() do { F.lane = lane_id_opaque(); F.tid = F.wave * 64 + F.lane; } while (0)

#define WSP(T, off) ((T*)(GAS T*)(wsl + (off)))
#define WSL() GAS unsigned char* wsl = (GAS unsigned char*)p.ws; asm volatile("" : "+s"(wsl))
    LAS float* scr = (LAS float*)(F.lds + RING_OFF + F.wave * 8704);

    if (IN(PH_PRO)) { REFRESH(); WSL();
        mod_units(F, p);
        for (int l = 0; l < NL; ++l) {
            conv_matrix(F, p.w_in + (size_t)l * D * INW, INW, D, INW, WSP(bf16_t, WS_WIN) + (size_t)l * INW * D, scr);
            conv_matrix(F, p.w_ba + (size_t)l * 512 * D, D, 512, D, WSP(bf16_t, WS_WBA) + (size_t)l * D * 512, scr);
            conv_matrix(F, p.w_bh + (size_t)l * 512 * D, D, 512, D, WSP(bf16_t, WS_WBH) + (size_t)l * D * 512, scr);
            conv_matrix(F, p.w_out + (size_t)l * D * D, D, D, D, WSP(bf16_t, WS_WOUT) + (size_t)l * D * D, scr);
        }
        ph_rope_table(F, WSP(float, WS_ROPE));
    }
    SEAM(PH_PRO);
    if (IN(PH_NORM1)) { REFRESH(); WSL(); ph_norm1(F, p.x, p.norm_mix_w, WSP(float, WS_MOD) + 1 * D, WSP(float, WS_MOD) + 0 * D, WSP(bf16_t, WS_HB), WSP(unsigned char, WS_HBF8)); }
    SEAM(PH_NORM1);

    for (int l = 0; l < NL; ++l) {
        const int pb = PH_L0 + l * NPL;
        if (IN(pb + P_G1)) { WSL();
            pg8::Gemm g{WSP(bf16_t, WS_HB), WSP(bf16_t, WS_WIN) + (size_t)l * INW * D, S, 3072, D}; pg8::StaticOrder So; So.init(S, 3072, F.G, (int)blockIdx.x);
            pg8::EpiInproj E{WSP(bf16_t, WS_QR), WSP(bf16_t, WS_KR), WSP(bf16_t, WS_VV), WSP(bf16_t, WS_HQ), WSP(bf16_t, WS_KF), WSP(bf16_t, WS_HV), WSP(bf16_t, WS_HG), WSP(bf16_t, WS_GG), WSP(float, WS_LF), WSP(float, WS_LBV) + l * 1024, 1.0f};
            for (int rep_ = 0; rep_ < REP_G; ++rep_) pg8::gemm_phase<pg8::EpiInproj, pg8::StaticOrder, true, true>(F.lds + RING_OFF, g, So, E, F.wave);
        }
        SEAM(pb + P_G1);
        if (IN(pb + P_QKP)) { WSL();
            {
              pg8::Gemm g{WSP(bf16_t, WS_HB), WSP(bf16_t, WS_WIN) + (size_t)l * INW * D + (size_t)3072 * D, S, 2304, D}; pg8::OffOrder So; So.So.init(S, 2304, F.G, (int)blockIdx.x); So.off = 12;
              pg8::EpiInproj E{WSP(bf16_t, WS_QR), WSP(bf16_t, WS_KR), WSP(bf16_t, WS_VV), WSP(bf16_t, WS_HQ), WSP(bf16_t, WS_KF), WSP(bf16_t, WS_HV), WSP(bf16_t, WS_HG), WSP(bf16_t, WS_GG), WSP(float, WS_LF), WSP(float, WS_LBV) + l * 1024, 1.0f};
              for (int rep_ = 0; rep_ < REP_G; ++rep_) pg8::gemm_phase<pg8::EpiInproj, pg8::OffOrder, true, true>(F.lds + RING_OFF, g, So, E, F.wave); }
            { const bool even = (F.G == 256); const int rk = even ? (int)blockIdx.x - 64 : (int)blockIdx.x, nr = even ? 192 : F.G;
              for (int rep_ = 0; rep_ < REP_QK; ++rep_) ph_qkprep(F, WSP(bf16_t, WS_QR), WSP(bf16_t, WS_KR), p.q_norm_w + l * 64, p.k_norm_w + l * 64, WSP(float, WS_ROPE), WSP(bf16_t, WS_QN), WSP(bf16_t, WS_KN), WSP(unsigned char, WS_Q8), WSP(unsigned char, WS_K8), rk, nr);
              ph_v8t(F, WSP(bf16_t, WS_VV), WSP(unsigned char, WS_V8T)); }
            for (int rep_ = 0; rep_ < REP_HG; ++rep_) for (int u = blockIdx.x; u < 256; u += F.G) hg::segment<false>(F.lds, u, WSP(bf16_t, WS_HQ), WSP(float, WS_LF), WSP(bf16_t, WS_KF), WSP(bf16_t, WS_HV), WSP(float, WS_HST), WSP(float, WS_HST + 16 * MiB), nullptr, F.wave);
        }
        SEAM(pb + P_QKP);
        if (IN(pb + P_HGB)) { WSL(); OPAQUE_LANE(); (void)lane;
            for (int gid = blockIdx.x * 512 + t_; gid < 8 * 16384; gid += F.G * 512) hg::carry(WSP(float, WS_HST), WSP(float, WS_HST + 16 * MiB), gid);
        }
        SEAM(pb + P_HGB);
        if (IN(pb + P_HGC)) { WSL();
            for (int rep_ = 0; rep_ < REP_HG; ++rep_) for (int u = blockIdx.x; u < 256; u += F.G) hg::segment<true>(F.lds, u, WSP(bf16_t, WS_HQ), WSP(float, WS_LF), WSP(bf16_t, WS_KF), WSP(bf16_t, WS_HV), WSP(float, WS_HST), WSP(float, WS_HST + 16 * MiB), WSP(float, WS_OF), F.wave);
        }
        SEAM(pb + P_HGC);
        if (IN(pb + P_ATT)) { WSL();
            for (int rep_ = 0; rep_ < REP_QK; ++rep_) ph_hgfin(F, WSP(float, WS_OF), WSP(bf16_t, WS_HG), p.hg_norm_w + l * 128, WSP(bf16_t, WS_OHG));
            float negM;
            { const int ln = lane_id_opaque(); float mq = fabsf(p.q_norm_w[l * 64 + ln]), mk = fabsf(p.k_norm_w[l * 64 + ln]);
#pragma unroll
              for (int o_ = 1; o_ < 64; o_ <<= 1) { mq = fmaxf(mq, __shfl_xor(mq, o_)); mk = fmaxf(mk, __shfl_xor(mk, o_)); }
              negM = -(64.0f * C2) * mq * mk * 1.05f; }
#if ATTN_FP8
            const attn8::Tensors AT{WSP(unsigned char, WS_Q8), WSP(unsigned char, WS_K8), WSP(unsigned char, WS_V8T), (attn8::bf16*)WSP(bf16_t, WS_OATT)};
            { BgConv bg; bg.init(p, l, F.lds + attn8::LDS_BYTES + F.wave * 1152, lane_id_opaque(), F.vcu * NWAVES + F.wave, F.G * NWAVES);
              attn8::phase((char*)lds + RING_OFF, AT, (int)F.G, (int)blockIdx.x, F.wave, negM + 8.0f, bg); bg.finish(); }
#else
            const attn_body::AttnTensors AT{(const attn_body::bf16*)WSP(bf16_t, WS_QN), (const attn_body::bf16*)WSP(bf16_t, WS_KN), (const attn_body::bf16*)WSP(bf16_t, WS_VV), (attn_body::bf16*)WSP(bf16_t, WS_OATT)};
            const attn_body::StaticOrder So((int)F.G, (int)blockIdx.x);
            for (int rep_ = 0; rep_ < REP_ATT; ++rep_) attn_body::attn_phase<attn_body::StaticOrder>((char*)lds + RING_OFF, AT, So, F.wave, negM);
#endif
        }
        SEAM(pb + P_ATT);
        if (IN(pb + P_G2)) { WSL();
            pg8::Gemm g{WSP(bf16_t, WS_OATT), WSP(bf16_t, WS_WBA) + (size_t)l * D * 512, S, D, 512, WSP(bf16_t, WS_OHG), WSP(bf16_t, WS_WBH) + (size_t)l * D * 512};
            pg8::ChainOrder So; So.So.init(S, D, F.G, (int)blockIdx.x);
            pg8::EpiMerge E{WSP(bf16_t, WS_GG), WSP(bf16_t, WS_MG)};
            for (int rep_ = 0; rep_ < REP_G; ++rep_) pg8::gemm_phase<pg8::EpiMerge, pg8::ChainOrder, false, true>(F.lds + RING_OFF, g, So, E, F.wave);
        }
        SEAM(pb + P_G2);
        if (IN(pb + P_G3)) { WSL();
            pg8::Gemm g{WSP(bf16_t, WS_MG), WSP(bf16_t, WS_WOUT) + (size_t)l * D * D, S, D, D}; pg8::StaticOrder So; So.init(S, D, F.G, (int)blockIdx.x);
            pg8::EpiOut E{l == 0 ? p.x : WSP(float, WS_X2), WSP(float, WS_MOD) + l * 6 * D + 2 * D, WSP(float, WS_X1)};
            for (int rep_ = 0; rep_ < REP_G; ++rep_) pg8::gemm_phase<pg8::EpiOut, pg8::StaticOrder, false, true>(F.lds + RING_OFF, g, So, E, F.wave);
        }
        SEAM(pb + P_G3);
        if (IN(pb + P_N2R)) { WSL();
            for (int rep_ = 0; rep_ < REP_ROW; ++rep_) ph_norm2_router(F, WSP(float, WS_X1), p.norm_ffn_w + l * D, WSP(float, WS_MOD) + l * 6 * D + 4 * D, WSP(float, WS_MOD) + l * 6 * D + 3 * D, p.w_router + (size_t)l * D * NE, WSP(unsigned char, WS_HB8), WSP(float, WS_AFF));
        }
        SEAM(pb + P_N2R);
        if (IN(pb + P_TOPK)) { WSL();
            for (int rep_ = 0; rep_ < REP_TK; ++rep_) for (int e = blockIdx.x; e < NE; e += F.G) ph_topk(F, F.lds, e, WSP(float, WS_AFF), WSP(int, WS_IDX), WSP(float, WS_TOPW), WSP(int, WS_SLOT));
        }
        SEAM(pb + P_TOPK);
        if (IN(pb + P_G4)) { WSL();
            pg8::Gemm g{(const bf16_t*)WSP(unsigned char, WS_HB8), (const bf16_t*)(WSP(unsigned char, WS_WGU) + (size_t)l * 64 * MiB), NE * CAP, NE * 4096, D / 2, nullptr, nullptr, WSP(int, WS_IDX)}; pg8::GroupOrder So; So.init(16, F.G, (int)blockIdx.x);
            pg8::EpiGU8 E{WSP(unsigned char, WS_HID8)};
            for (int rep_ = 0; rep_ < REP_G; ++rep_) pg8::gemm_phase<pg8::EpiGU8, pg8::GroupOrder, true, true, true, true>(F.lds + RING_OFF, g, So, E, F.wave);
        }
        SEAM(pb + P_G4);
        if (IN(pb + P_G5)) { WSL();
            pg8::Gemm g{(const bf16_t*)WSP(unsigned char, WS_HID8), (const bf16_t*)(WSP(unsigned char, WS_WD) + (size_t)l * 32 * MiB), NE * CAP, NE * 1024, FF / 2}; pg8::GroupOrder So; So.init(4, F.G, (int)blockIdx.x);
            pg8::EpiDown E{WSP(bf16_t, WS_YE), WSP(float, WS_TOPW), 0.015625f};
            for (int rep_ = 0; rep_ < REP_G; ++rep_) pg8::gemm_phase<pg8::EpiDown, pg8::GroupOrder, true, true, true>(F.lds + RING_OFF, g, So, E, F.wave);
        }
        SEAM(pb + P_G5);
        if (IN(pb + P_COMB)) { WSL();
            const bool last = (l + 1 == NL); const int ln = last ? l : l + 1;
            for (int rep_ = 0; rep_ < REP_ROW; ++rep_) ph_combine(F, WSP(float, WS_X1), WSP(bf16_t, WS_YE), WSP(int, WS_SLOT), WSP(float, WS_MOD) + l * 6 * D + 5 * D, last ? p.out : WSP(float, WS_X2),
                       p.norm_mix_w + ln * D, WSP(float, WS_MOD) + ln * 6 * D + 1 * D, WSP(float, WS_MOD) + ln * 6 * D + 0 * D, WSP(bf16_t, WS_HB), WSP(unsigned char, WS_HBF8), !last);
        }
        SEAM(pb + P_COMB);
    }
#undef IN
#undef SEAM
}

#ifndef N_LAUNCH_MODE
#define N_LAUNCH_MODE 1
#endif
static int g_grid = 0;
extern "C" void kernel_launch(void* const* d_in, const int* in_sizes, int n_in, void* d_out, int out_size, void* d_ws, size_t ws_size, hipStream_t stream) {
    if (n_in != 18 || out_size != S * D || ws_size < WS_END) { fprintf(stderr, "kernel_launch: unexpected shapes (n_in %d out %d ws %zu)\n", n_in, out_size, ws_size); return; }
    if (g_grid == 0) {
        int dev = 0, cus = 0;
        if (hipGetDevice(&dev) != hipSuccess || hipDeviceGetAttribute(&cus, hipDeviceAttributeMultiprocessorCount, dev) != hipSuccess) { g_grid = -1; return; }
        if (hipFuncSetAttribute((const void*)mega, hipFuncAttributeMaxDynamicSharedMemorySize, LDS_BYTES) != hipSuccess) { g_grid = -1; return; }
        int per_cu = 0;
        if (hipOccupancyMaxActiveBlocksPerMultiprocessor(&per_cu, (const void*)mega, NWAVES * 64, LDS_BYTES) != hipSuccess || per_cu < 1) { fprintf(stderr, "occupancy query: %d\n", per_cu); }
        (void)hipGetLastError();
        g_grid = cus;
    }
    if (g_grid < 0) return;
    unsigned char* ws = (unsigned char*)d_ws;
    (void)hipMemsetAsync(ws + WS_CTL, 0, 1 * MiB, stream);
    Params p{};
    p.x = (const float*)d_in[0]; p.c = (const float*)d_in[1]; p.ada_w = (const float*)d_in[2]; p.ada_b = (const float*)d_in[3]; p.norm_mix_w = (const float*)d_in[4];
    p.norm_ffn_w = (const float*)d_in[5]; p.w_in = (const float*)d_in[6]; p.q_norm_w = (const float*)d_in[7]; p.k_norm_w = (const float*)d_in[8]; p.hlb = (const float*)d_in[9];
    p.hg_norm_w = (const float*)d_in[10]; p.w_ba = (const float*)d_in[11]; p.w_bh = (const float*)d_in[12]; p.w_out = (const float*)d_in[13]; p.w_router = (const float*)d_in[14];
    p.w_eg = (const float*)d_in[15]; p.w_eu = (const float*)d_in[16]; p.w_ed = (const float*)d_in[17];
    p.out = (float*)d_out; p.ws = ws;
#if defined(DBG_ATT)
    { const int cut = PH_L0 + P_ATT + 1;
      p.ph_lo = 0; p.ph_hi = cut; p.li = 0; p.pad = 0; hipLaunchKernelGGL(mega, dim3(g_grid), dim3(NWAVES * 64), LDS_BYTES, stream, p);
      hipMemcpyAsync(ws + 900 * MiB, ws + WS_OATT, 16 * MiB, hipMemcpyDeviceToDevice, stream);
      k_attn_naive<<<dim3(S / 64, 8), dim3(64), 0, stream>>>((const bf16_t*)(ws + WS_QN), (const bf16_t*)(ws + WS_KN), (const bf16_t*)(ws + WS_VV), (bf16_t*)(ws + WS_OATT));
      k_cmp_bf16<<<dim3(2048), dim3(256), 0, stream>>>((const bf16_t*)(ws + 900 * MiB), (const bf16_t*)(ws + WS_OATT), (size_t)8 * MiB, 512, 0, 512, (float*)(ws + 512 * 1024));
      p.ph_lo = cut; p.ph_hi = PH_END; p.li = 1; hipLaunchKernelGGL(mega, dim3(g_grid), dim3(NWAVES * 64), LDS_BYTES, stream, p);
      k_scale_out<<<dim3(2048), dim3(256), 0, stream>>>((float*)d_out, (size_t)S * D, (const float*)(ws + 512 * 1024)); }
#elif N_LAUNCH_MODE == 1
    p.ph_lo = 0; p.ph_hi = PH_END; p.li = 0; p.pad = 0;
    hipLaunchKernelGGL(mega, dim3(g_grid), dim3(NWAVES * 64), LDS_BYTES, stream, p);
#else
    for (int k = 0; k < PH_END; ++k) { p.ph_lo = k; p.ph_hi = k + 1; p.li = k; p.pad = 0; hipLaunchKernelGGL(mega, dim3(g_grid), dim3(NWAVES * 64), LDS_BYTES, stream, p); }
#endif
}
```

```cpp
#include <hip/hip_runtime.h>
#include <cstdio>
#include <cstdint>

typedef unsigned short bf16_t;
typedef float f32x4 __attribute__((ext_vector_type(4)));
typedef float f32x16 __attribute__((ext_vector_type(16)));
typedef unsigned u32x4 __attribute__((ext_vector_type(4)));
typedef unsigned u32x2 __attribute__((ext_vector_type(2)));

constexpr int S = 16384, D = 1024, NL = 2, INW = 5376;
constexpr int NE = 16, CAP = 2048, FF = 2048;
constexpr float EPS = 1e-6f;
constexpr float C2 = 0.125f * 1.4426950408889634f;
constexpr int C_AQ = 0, C_AK = 512, C_AV = 640, C_HQ = 768, C_ZF = 1280, C_ZB = 1792, C_HI = 2304, C_HGT = 2816, C_GL = 3328;

constexpr size_t MiB = 1u << 20;
constexpr size_t WS_CTL = 0;
constexpr size_t WS_MOD = 1 * MiB;
constexpr size_t WS_LBV = WS_MOD + 64 * 1024;
constexpr size_t WS_IDX = WS_MOD + 128 * 1024;
constexpr size_t WS_TOPW = WS_IDX + 128 * 1024;
constexpr size_t WS_ROPE = WS_MOD + 512 * 1024;
constexpr size_t WS_AFF = 2 * MiB;
constexpr size_t WS_SLOT = 3 * MiB;
constexpr size_t WS_HB = 4 * MiB;
constexpr size_t WS_QR = 36 * MiB;
constexpr size_t WS_KR = 52 * MiB;
constexpr size_t WS_VV = 56 * MiB;
constexpr size_t WS_QN = 60 * MiB;
constexpr size_t WS_KN = 76 * MiB;
constexpr size_t WS_HQ = 80 * MiB;
constexpr size_t WS_LF = 96 * MiB;
constexpr size_t WS_KF = 160 * MiB;
constexpr size_t WS_HV = 192 * MiB;
constexpr size_t WS_HG = 208 * MiB;
constexpr size_t WS_GG = 224 * MiB;
constexpr size_t WS_OATT = 288 * MiB;
constexpr size_t WS_OF = 304 * MiB;
constexpr size_t WS_OHG = 368 * MiB;
constexpr size_t WS_MP = 384 * MiB;
constexpr size_t WS_MG = 448 * MiB;
constexpr size_t WS_HB8 = 36 * MiB;
constexpr size_t WS_XE8 = 52 * MiB;
constexpr size_t WS_HID8 = 100 * MiB;
constexpr size_t WS_XE = 36 * MiB;
constexpr size_t WS_HID = 100 * MiB;
constexpr size_t WS_YE = 228 * MiB;
constexpr size_t WS_X1 = 480 * MiB;
constexpr size_t WS_X2 = 544 * MiB;
constexpr size_t WS_WIN = 608 * MiB;
constexpr size_t WS_WBA = 630 * MiB;
constexpr size_t WS_WBH = 632 * MiB;
constexpr size_t WS_WOUT = 634 * MiB;
constexpr size_t WS_WGU = 638 * MiB;
constexpr size_t WS_WD = 766 * MiB;
constexpr size_t WS_HST = 830 * MiB;
constexpr size_t WS_Q8 = 912 * MiB;
constexpr size_t WS_K8 = 920 * MiB;
constexpr size_t WS_V8T = 922 * MiB;
constexpr size_t WS_WIN8 = 900 * MiB;
constexpr size_t WS_HBF8 = 906 * MiB;
constexpr size_t WS_END = 924 * MiB;
static_assert(WS_END <= 1024 * MiB, "workspace");

__device__ __forceinline__ float bf2f(bf16_t v) { return __uint_as_float((unsigned)v << 16); }
__device__ __forceinline__ bf16_t f2bf(float f) { unsigned u = __float_as_uint(f); return (bf16_t)((u + 0x7fffu + ((u >> 16) & 1u)) >> 16); }
__device__ __forceinline__ unsigned pk2(float lo, float hi) { return (unsigned)f2bf(lo) | ((unsigned)f2bf(hi) << 16); }
__device__ __forceinline__ float bflo(unsigned w) { return __uint_as_float(w << 16); }
__device__ __forceinline__ float bfhi(unsigned w) { return __uint_as_float(w & 0xffff0000u); }
__device__ __forceinline__ float sigmoidf_(float v) { return __builtin_amdgcn_rcpf(1.0f + __expf(-v)); }
__device__ __forceinline__ float siluf_(float v) { return v * __builtin_amdgcn_rcpf(1.0f + __expf(-v)); }
__device__ __forceinline__ float wave_sum(float v) {
#pragma unroll
    for (int o = 1; o < 64; o <<= 1) v += __shfl_xor(v, o);
    return v;
}
__device__ __forceinline__ int crow(int r, int hi) { return (r & 3) + 8 * (r >> 2) + 4 * hi; }
__device__ __forceinline__ int lane_id_opaque() { int l; asm volatile("v_mbcnt_lo_u32_b32 %0, -1, 0\n\tv_mbcnt_hi_u32_b32 %0, -1, %0" : "=v"(l)); return l; }

#define GAS __attribute__((address_space(1)))
#define LAS __attribute__((address_space(3)))

namespace pg8 {
#define PG8_LAS __attribute__((address_space(3)))
typedef unsigned short bf16_t;
typedef short bf16x8 __attribute__((ext_vector_type(8)));
typedef float f32x4 __attribute__((ext_vector_type(4)));
typedef unsigned u32x4 __attribute__((ext_vector_type(4)));
constexpr int BM = 256, BK = 64, HALF = 128, HTB = HALF * BK * 2  , STAGE_BYTES = 8 * HTB, NXCD = 8, WGM = 8;

__host__ __device__ __forceinline__ int lds_byte(int r, int c) { const int st = (r >> 4) * 2 + (c >> 5), rr = r & 15, cc = c & 31, ob = rr * 64 + cc * 2; return st * 1024 + (ob ^ (((ob >> 9) & 1) << 5)); }
__host__ __device__ __forceinline__ void stage_rc(int b, int& R, int& C) { const int st = b / 1024, sb = b % 1024, swz = sb ^ (((sb >> 9) & 1) << 5); R = (st >> 1) * 16 + swz / 64; C = (st & 1) * 32 + (swz % 64) / 2; }
__host__ __device__ __forceinline__ int perm32(int rho) { const int n = rho >> 4, i = rho & 15; return 8 * (i >> 2) + 4 * n + (i & 3); }

struct Unit { int pm, pn, pb, sel; };
struct Gemm { const bf16_t* A; const bf16_t* Bt; int M, N, K; const bf16_t* A2 = nullptr; const bf16_t* Bt2 = nullptr; const int* rowidx = nullptr; };

struct StaticOrder {
    int nM, nN, nwg, G, c;
    __host__ __device__ void init(int M, int N, int G_, int c_) { nM = M / BM; nN = N / BM; nwg = nM * nN; G = G_; c = c_; }
    __host__ __device__ bool next(int i, Unit& u) const {
        const long L = (long)i * G + c; if (L >= nwg) return false;
        int wgid = (int)L; { const int q = nwg / NXCD, r = nwg % NXCD, xcd = wgid % NXCD, off = wgid / NXCD; wgid = (xcd < r ? xcd * (q + 1) : r * (q + 1) + (xcd - r) * q) + off; }
        const int nig = WGM * nN, gid = wgid / nig, fm = gid * WGM, gsz = (nM - fm) < WGM ? (nM - fm) : WGM;
        u.pm = fm + ((wgid % nig) % gsz); u.pn = (wgid % nig) / gsz; u.pb = u.pn; u.sel = 0; return true;
    }
    __device__ __forceinline__ void a_ready(const Unit&) const {}
    __device__ __forceinline__ void done(const Unit&) const {}
};

typedef float f32x2_c __attribute__((ext_vector_type(2))); typedef __bf16 bf16x2_c __attribute__((ext_vector_type(2)));
__device__ __forceinline__ unsigned cvt_pk_bf16(float lo, float hi) { f32x2_c v = {lo, hi}; bf16x2_c b = __builtin_convertvector(v, bf16x2_c); return __builtin_bit_cast(unsigned, b); }

typedef unsigned u32x2 __attribute__((ext_vector_type(2)));
__device__ __forceinline__ float e_bflo(unsigned w) { return __uint_as_float(w << 16); }
__device__ __forceinline__ float e_bfhi(unsigned w) { return __uint_as_float(w & 0xffff0000u); }
__device__ __forceinline__ float e_sig(float v) { return __builtin_amdgcn_rcpf(1.0f + __expf(-v)); }
__device__ __forceinline__ u32x4 pack8(const f32x4 a, const f32x4 b) { u32x4 w; w.x = cvt_pk_bf16(a[0], a[1]); w.y = cvt_pk_bf16(a[2], a[3]); w.z = cvt_pk_bf16(b[0], b[1]); w.w = cvt_pk_bf16(b[2], b[3]); return w; }

typedef int i32x4_ __attribute__((ext_vector_type(4))); typedef int i32x8_ __attribute__((ext_vector_type(8)));
__device__ __forceinline__ i32x8_ pg8_cat(const bf16x8 lo, const bf16x8 hi) { return __builtin_shufflevector(__builtin_bit_cast(i32x4_, lo), __builtin_bit_cast(i32x4_, hi), 0, 1, 2, 3, 4, 5, 6, 7); }
__device__ __forceinline__ u32x2 pack8_fp8(const f32x4 a, const f32x4 b) { int w0 = 0, w1 = 0;
    w0 = __builtin_amdgcn_cvt_pk_fp8_f32(a[0], a[1], w0, false); w0 = __builtin_amdgcn_cvt_pk_fp8_f32(a[2], a[3], w0, true);
    w1 = __builtin_amdgcn_cvt_pk_fp8_f32(b[0], b[1], w1, false); w1 = __builtin_amdgcn_cvt_pk_fp8_f32(b[2], b[3], w1, true);
    u32x2 r; r.x = (unsigned)w0; r.y = (unsigned)w1; return r; }
struct EpiInproj {
    static constexpr bool PERM = true, AFTER_DRAIN = false, CHAIN = false;
    bf16_t *QR, *KR, *VV, *HQ, *KF, *HV, *HG, *GG; float* LF; const float* lbv; float ascale;
    __device__ __forceinline__ void operator()(const f32x4 (&acc)[2][2][4][2], const Unit& u, int wr, int wc, int fr, int fq) const {
        const int row0 = u.pm * BM + wr * 64 + fr, cl = wc * 32 + 8 * fq;
#pragma unroll
        for (int bj = 0; bj < 2; ++bj) {
            const int colg = u.pn * BM + bj * HALF;
            int kind; bf16_t* dst; int pitch, c0; int dir = 0;
            if (colg < 512) { kind = 0; dst = QR; pitch = 512; c0 = colg; }
            else if (colg < 640) { kind = 0; dst = KR; pitch = 128; c0 = colg - 512; }
            else if (colg < 768) { kind = 0; dst = VV; pitch = 128; c0 = colg - 640; }
            else if (colg < 1280) { kind = 1; dst = HQ; pitch = 512; c0 = colg - 768; }
            else if (colg < 2304) { kind = 3; dir = colg >= 1792; dst = KF + (size_t)dir * 16384 * 512; pitch = 512; c0 = colg - (dir ? 1792 : 1280); }
            else if (colg < 2816) { kind = 0; dst = HV; pitch = 512; c0 = colg - 2304; }
            else if (colg < 3328) { kind = 1; dst = HG; pitch = 512; c0 = colg - 2816; }
            else { kind = 2; dst = GG; pitch = 2048; c0 = colg - 3328; }
            c0 += cl;
            if (kind == 0) {
#pragma unroll
                for (int ai = 0; ai < 2; ++ai)
#pragma unroll
                    for (int m = 0; m < 4; ++m) *(u32x4*)(dst + (size_t)(row0 + ai * HALF + m * 16) * pitch + c0) = pack8(acc[ai][bj][m][0] * ascale, acc[ai][bj][m][1] * ascale);
            } else if (kind == 1) {
#pragma unroll
                for (int ai = 0; ai < 2; ++ai)
#pragma unroll
                    for (int m = 0; m < 4; ++m) { f32x4 a = acc[ai][bj][m][0] * ascale, b = acc[ai][bj][m][1] * ascale;
#pragma unroll
                        for (int i = 0; i < 4; ++i) { a[i] = a[i] * e_sig(a[i]); b[i] = b[i] * e_sig(b[i]); }
                        *(u32x4*)(dst + (size_t)(row0 + ai * HALF + m * 16) * pitch + c0) = pack8(a, b); }
            } else if (kind == 2) {
#pragma unroll
                for (int ai = 0; ai < 2; ++ai)
#pragma unroll
                    for (int m = 0; m < 4; ++m) { f32x4 a = acc[ai][bj][m][0] * ascale, b = acc[ai][bj][m][1] * ascale;
#pragma unroll
                        for (int i = 0; i < 4; ++i) { a[i] = e_sig(a[i]); b[i] = e_sig(b[i]); }
                        *(u32x4*)(dst + (size_t)(row0 + ai * HALF + m * 16) * pitch + c0) = pack8(a, b); }
            } else {
                const f32x4 lb0 = *(const f32x4*)(lbv + dir * 512 + c0), lb1 = *(const f32x4*)(lbv + dir * 512 + c0 + 4);
                float* lf = LF + (size_t)dir * 16384 * 512;
#pragma unroll
                for (int ai = 0; ai < 2; ++ai)
#pragma unroll
                    for (int m = 0; m < 4; ++m) { const f32x4 a = acc[ai][bj][m][0] * ascale, b = acc[ai][bj][m][1] * ascale; f32x4 la, lb_, ka, kb;
#pragma unroll
                        for (int i = 0; i < 4; ++i) {
                            const float sa = e_sig(a[i]), sb = e_sig(b[i]);
                            la[i] = __logf(fmaxf(lb0[i] + (1.0f - lb0[i]) * sa, 1e-6f)); ka[i] = (1.0f - lb0[i]) * (1.0f - sa);
                            lb_[i] = __logf(fmaxf(lb1[i] + (1.0f - lb1[i]) * sb, 1e-6f)); kb[i] = (1.0f - lb1[i]) * (1.0f - sb); }
                        const size_t o = (size_t)(row0 + ai * HALF + m * 16) * 512 + c0;
                        *(f32x4*)(lf + o) = la; *(f32x4*)(lf + o + 4) = lb_;
                        *(u32x4*)(dst + o) = pack8(ka, kb); }
            }
        }
    }
};
struct EpiBrA {
    static constexpr bool PERM = true, AFTER_DRAIN = false, CHAIN = false;
    const bf16_t* GG; float* MP;
    __device__ __forceinline__ void operator()(const f32x4 (&acc)[2][2][4][2], const Unit& u, int wr, int wc, int fr, int fq) const {
        const int row0 = u.pm * BM + wr * 64 + fr, col0 = u.pn * BM + wc * 32 + 8 * fq;
#pragma unroll
        for (int ai = 0; ai < 2; ++ai)
#pragma unroll
            for (int m = 0; m < 4; ++m) { const size_t r = (size_t)(row0 + ai * HALF + m * 16);
#pragma unroll
                for (int bj = 0; bj < 2; ++bj) { const int c = col0 + bj * HALF; const u32x4 g = *(const u32x4*)(GG + r * 2048 + c);
                    f32x4 a = acc[ai][bj][m][0], b = acc[ai][bj][m][1];
                    a[0] *= e_bflo(g.x); a[1] *= e_bfhi(g.x); a[2] *= e_bflo(g.y); a[3] *= e_bfhi(g.y); b[0] *= e_bflo(g.z); b[1] *= e_bfhi(g.z); b[2] *= e_bflo(g.w); b[3] *= e_bfhi(g.w);
                    *(f32x4*)(MP + r * 1024 + c) = a; *(f32x4*)(MP + r * 1024 + c + 4) = b; } }
    }
};
struct EpiBrH {
    static constexpr bool PERM = true, AFTER_DRAIN = false, CHAIN = false;
    const bf16_t* GG; const float* MP; bf16_t* MG;
    __device__ __forceinline__ void operator()(const f32x4 (&acc)[2][2][4][2], const Unit& u, int wr, int wc, int fr, int fq) const {
        const int row0 = u.pm * BM + wr * 64 + fr, col0 = u.pn * BM + wc * 32 + 8 * fq;
#pragma unroll
        for (int ai = 0; ai < 2; ++ai)
#pragma unroll
            for (int m = 0; m < 4; ++m) { const size_t r = (size_t)(row0 + ai * HALF + m * 16);
#pragma unroll
                for (int bj = 0; bj < 2; ++bj) { const int c = col0 + bj * HALF; const u32x4 g = *(const u32x4*)(GG + r * 2048 + 1024 + c);
                    f32x4 a = acc[ai][bj][m][0], b = acc[ai][bj][m][1]; const f32x4 pa = *(const f32x4*)(MP + r * 1024 + c), pb = *(const f32x4*)(MP + r * 1024 + c + 4);
                    a[0] = pa[0] + a[0] * e_bflo(g.x); a[1] = pa[1] + a[1] * e_bfhi(g.x); a[2] = pa[2] + a[2] * e_bflo(g.y); a[3] = pa[3] + a[3] * e_bfhi(g.y);
                    b[0] = pb[0] + b[0] * e_bflo(g.z); b[1] = pb[1] + b[1] * e_bfhi(g.z); b[2] = pb[2] + b[2] * e_bflo(g.w); b[3] = pb[3] + b[3] * e_bfhi(g.w);
                    *(u32x4*)(MG + r * 1024 + c) = pack8(a, b); } }
    }
};
struct EpiMerge {
    static constexpr bool PERM = true, AFTER_DRAIN = false, CHAIN = true;
    const bf16_t* GG; bf16_t* MG;
    __device__ __forceinline__ void mid(f32x4 (&acc)[2][2][4][2], const Unit& u, int wr, int wc, int fr, int fq) const {
        const int row0 = u.pm * BM + wr * 64 + fr, col0 = u.pn * BM + wc * 32 + 8 * fq;
#pragma unroll
        for (int ai = 0; ai < 2; ++ai)
#pragma unroll
            for (int m = 0; m < 4; ++m) { const size_t r = (size_t)(row0 + ai * HALF + m * 16);
#pragma unroll
                for (int bj = 0; bj < 2; ++bj) { const int c = col0 + bj * HALF; const u32x4 g0 = *(const u32x4*)(GG + r * 2048 + c), g1 = *(const u32x4*)(GG + r * 2048 + 1024 + c);
                    f32x4& a = acc[ai][bj][m][0]; f32x4& b = acc[ai][bj][m][1];
                    a[0] *= e_bflo(g0.x) * __builtin_amdgcn_rcpf(e_bflo(g1.x)); a[1] *= e_bfhi(g0.x) * __builtin_amdgcn_rcpf(e_bfhi(g1.x));
                    a[2] *= e_bflo(g0.y) * __builtin_amdgcn_rcpf(e_bflo(g1.y)); a[3] *= e_bfhi(g0.y) * __builtin_amdgcn_rcpf(e_bfhi(g1.y));
                    b[0] *= e_bflo(g0.z) * __builtin_amdgcn_rcpf(e_bflo(g1.z)); b[1] *= e_bfhi(g0.z) * __builtin_amdgcn_rcpf(e_bfhi(g1.z));
                    b[2] *= e_bflo(g0.w) * __builtin_amdgcn_rcpf(e_bflo(g1.w)); b[3] *= e_bfhi(g0.w) * __builtin_amdgcn_rcpf(e_bfhi(g1.w)); } }
    }
    __device__ __forceinline__ void operator()(const f32x4 (&acc)[2][2][4][2], const Unit& u, int wr, int wc, int fr, int fq) const {
        const int row0 = u.pm * BM + wr * 64 + fr, col0 = u.pn * BM + wc * 32 + 8 * fq;
#pragma unroll
        for (int ai = 0; ai < 2; ++ai)
#pragma unroll
            for (int m = 0; m < 4; ++m) { const size_t r = (size_t)(row0 + ai * HALF + m * 16);
#pragma unroll
                for (int bj = 0; bj < 2; ++bj) { const int c = col0 + bj * HALF; const u32x4 g = *(const u32x4*)(GG + r * 2048 + 1024 + c);
                    f32x4 a = acc[ai][bj][m][0], b = acc[ai][bj][m][1];
                    a[0] *= e_bflo(g.x); a[1] *= e_bfhi(g.x); a[2] *= e_bflo(g.y); a[3] *= e_bfhi(g.y); b[0] *= e_bflo(g.z); b[1] *= e_bfhi(g.z); b[2] *= e_bflo(g.w); b[3] *= e_bfhi(g.w);
                    *(u32x4*)(MG + r * 1024 + c) = pack8(a, b); } }
    }
};
struct OffOrder {
    StaticOrder So; int off;
    __device__ bool next(int i, Unit& u) const { if (!So.next(i, u)) return false; u.pb = u.pn; u.pn += off; return true; }
    __device__ __forceinline__ void a_ready(const Unit&) const {}
    __device__ __forceinline__ void done(const Unit&) const {}
};
struct ChainOrder {
    StaticOrder So;
    __device__ bool next(int i, Unit& u) const { if (!So.next(i >> 1, u)) return false; u.sel = i & 1; return true; }
    __device__ __forceinline__ void a_ready(const Unit&) const {}
    __device__ __forceinline__ void done(const Unit&) const {}
};
struct EpiOut {
    static constexpr bool PERM = true, AFTER_DRAIN = false, CHAIN = false;
    const float* xin; const float* gate; float* X1;
    __device__ __forceinline__ void operator()(const f32x4 (&acc)[2][2][4][2], const Unit& u, int wr, int wc, int fr, int fq) const {
        const int row0 = u.pm * BM + wr * 64 + fr, col0 = u.pn * BM + wc * 32 + 8 * fq;
#pragma unroll
        for (int bj = 0; bj < 2; ++bj) { const int c = col0 + bj * HALF; const f32x4 g0 = *(const f32x4*)(gate + c), g1 = *(const f32x4*)(gate + c + 4);
#pragma unroll
            for (int ai = 0; ai < 2; ++ai)
#pragma unroll
                for (int m = 0; m < 4; ++m) { const size_t o = (size_t)(row0 + ai * HALF + m * 16) * 1024 + c;
                    *(f32x4*)(X1 + o) = *(const f32x4*)(xin + o) + g0 * acc[ai][bj][m][0]; *(f32x4*)(X1 + o + 4) = *(const f32x4*)(xin + o + 4) + g1 * acc[ai][bj][m][1]; } }
    }
};
struct EpiGU {
    static constexpr bool PERM = true, AFTER_DRAIN = false, CHAIN = false;
    bf16_t* HID;
    __device__ __forceinline__ void operator()(const f32x4 (&acc)[2][2][4][2], const Unit& u, int wr, int wc, int fr, int fq) const {
        const int row0 = u.pm * BM + wr * 64 + fr, col0 = u.pn * HALF + wc * 32 + 8 * fq;
#pragma unroll
        for (int ai = 0; ai < 2; ++ai)
#pragma unroll
            for (int m = 0; m < 4; ++m) { f32x4 a = acc[ai][0][m][0], b = acc[ai][0][m][1]; const f32x4 ua = acc[ai][1][m][0], ub = acc[ai][1][m][1];
#pragma unroll
                for (int i = 0; i < 4; ++i) { a[i] = a[i] * e_sig(a[i]) * ua[i]; b[i] = b[i] * e_sig(b[i]) * ub[i]; }
                *(u32x4*)(HID + (size_t)(row0 + ai * HALF + m * 16) * 2048 + col0) = pack8(a, b); }
    }
};
struct EpiGU8 {
    static constexpr bool PERM = true, AFTER_DRAIN = false, CHAIN = false;
    unsigned char* HID;
    __device__ __forceinline__ void operator()(const f32x4 (&acc)[2][2][4][2], const Unit& u, int wr, int wc, int fr, int fq) const {
        const int row0 = u.pm * BM + wr * 64 + fr, col0 = u.pn * HALF + wc * 32 + 8 * fq;
#pragma unroll
        for (int ai = 0; ai < 2; ++ai)
#pragma unroll
            for (int m = 0; m < 4; ++m) { f32x4 a = acc[ai][0][m][0], b = acc[ai][0][m][1]; const f32x4 ua = acc[ai][1][m][0], ub = acc[ai][1][m][1];
#pragma unroll
                for (int i = 0; i < 4; ++i) { const float ga = a[i] * 0.015625f, gb = b[i] * 0.015625f; a[i] = ga * e_sig(ga) * (ua[i] * 0.015625f); b[i] = gb * e_sig(gb) * (ub[i] * 0.015625f); }
                *(u32x2*)(HID + (size_t)(row0 + ai * HALF + m * 16) * 2048 + col0) = pack8_fp8(a, b); }
    }
};
struct EpiDown {
    static constexpr bool PERM = true, AFTER_DRAIN = false, CHAIN = false;
    bf16_t* YE; const float* topw; float wscale;
    __device__ __forceinline__ void operator()(const f32x4 (&acc)[2][2][4][2], const Unit& u, int wr, int wc, int fr, int fq) const {
        const int row0 = u.pm * BM + wr * 64 + fr, col0 = u.pn * BM + wc * 32 + 8 * fq;
#pragma unroll
        for (int ai = 0; ai < 2; ++ai)
#pragma unroll
            for (int m = 0; m < 4; ++m) { const int r = row0 + ai * HALF + m * 16; const float w = topw[r] * wscale;
#pragma unroll
                for (int bj = 0; bj < 2; ++bj) *(u32x4*)(YE + (size_t)r * 1024 + col0 + bj * HALF) = pack8(acc[ai][bj][m][0] * w, acc[ai][bj][m][1] * w); }
    }
};
struct GroupOrder {
    int nNe, nwg, G, c;
    __device__ void init(int nNe_, int G_, int c_) { nNe = nNe_; nwg = 16 * 8 * nNe_; G = G_; c = c_; }
    __device__ bool next(int i, Unit& u) const {
        const long L = (long)i * G + c; if (L >= nwg) return false;
        int wgid = (int)L; { const int q = nwg / NXCD, xcd = wgid % NXCD, off = wgid / NXCD; wgid = xcd * q + off; }
        const int per = 8 * nNe, e = wgid / per, w = wgid % per;
        u.pm = e * 8 + (w & 7); u.pn = w >> 3; u.pb = e * nNe + u.pn; u.sel = 0; return true;
    }
    __device__ __forceinline__ void a_ready(const Unit&) const {}
    __device__ __forceinline__ void done(const Unit&) const {}
};

template <class Epi, class Sched, bool ALIGN_EPI = false, bool SP2 = false, bool FP8 = false, bool GATHER = false>
__device__ __forceinline__ void gemm_phase(PG8_LAS unsigned char* lds, const Gemm g, const Sched& S, const Epi& E, int wave_) {
    const int tid_ = wave_ * 64 + lane_id_opaque();
    const int tid = tid_, wid = __builtin_amdgcn_readfirstlane(tid >> 6), lane = tid & 63, wr = wid >> 2, wc = wid & 3, fr = lane & 15, fq = lane >> 4;
    int K_ = g.K; asm volatile("" : "+s"(K_));
    const int K = K_, nt = K / BK;
    unsigned voffA[2], voffB[2];
#pragma unroll
    for (int i = 0; i < 2; ++i) { int R, C; stage_rc(tid * 16 + i * 8192, R, C); const int Rb = Epi::PERM ? ((R & ~31) + perm32(R & 31)) : R;
        voffA[i] = (unsigned)(R * K + C) * 2u; voffB[i] = (unsigned)(Rb * K + C) * 2u; }
    unsigned vA[2][2] = {{0u, 0u}, {0u, 0u}}, vN[2][2] = {{0u, 0u}, {0u, 0u}};
#define PG8_GOFF(dst, u_) do { if constexpr (GATHER) { _Pragma("unroll") for (int h_ = 0; h_ < 2; ++h_) _Pragma("unroll") for (int i_ = 0; i_ < 2; ++i_) \
        { int R_, C_; stage_rc(tid * 16 + i_ * 8192, R_, C_);     \
          dst[h_][i_] = (unsigned)((const __attribute__((address_space(1))) int*)g.rowidx)[(u_).pm * BM + h_ * HALF + R_] * (unsigned)(K * 2) + (unsigned)C_ * 2u; } } } while (0)
    const size_t kstep = (size_t)(BK * 2);
    const size_t hstep = (size_t)HALF * K * 2;
    const size_t tstep = 2 * hstep;
    const unsigned ldsw = (unsigned)wid * 1024u;
    const int aoff = lds_byte(wr * 64 + fr, fq * 8), boff = lds_byte(wc * 32 + fr, fq * 8);
#define PG8_SA(b, h) (((b) * 2 + (h)) * HTB)
#define PG8_SB(b, h) ((4 + (b) * 2 + (h)) * HTB)
#define PG8_STAGE(bufoff, gbase, voff) do { _Pragma("unroll") for (int _i = 0; _i < 2; ++_i) \
        __builtin_amdgcn_global_load_lds((const unsigned*)((const char*)(gbase) + (voff)[_i]), (PG8_LAS unsigned*)(lds + (bufoff) + ldsw + _i * 8192), 16, 0, 0); } while (0)
#define PG8_STAGE_A(bufoff, gptr, half, nsel) do { if constexpr (GATHER) { unsigned vs_[2]; vs_[0] = (nsel) ? vN[half][0] : vA[half][0]; vs_[1] = (nsel) ? vN[half][1] : vA[half][1]; PG8_STAGE(bufoff, gptr, vs_); } \
        else { PG8_STAGE(bufoff, (gptr) + (half) * hstep, voffA); } } while (0)
#define PG8_LDA(dst, b, h) do { if constexpr (FP8) { _Pragma("unroll") for (int m = 0; m < 4; ++m) dst##8[m] = pg8_cat(*(const PG8_LAS bf16x8*)(lds + PG8_SA(b, h) + aoff + m * 2048), *(const PG8_LAS bf16x8*)(lds + PG8_SA(b, h) + aoff + m * 2048 + 1024)); } else { \
        _Pragma("unroll") for (int m = 0; m < 4; ++m) _Pragma("unroll") for (int k = 0; k < 2; ++k) dst[m][k] = *(const PG8_LAS bf16x8*)(lds + PG8_SA(b, h) + aoff + m * 2048 + k * 1024); } } while (0)
#define PG8_LDB(dst, b, h) do { if constexpr (FP8) { _Pragma("unroll") for (int n = 0; n < 2; ++n) dst##8[n] = pg8_cat(*(const PG8_LAS bf16x8*)(lds + PG8_SB(b, h) + boff + n * 2048), *(const PG8_LAS bf16x8*)(lds + PG8_SB(b, h) + boff + n * 2048 + 1024)); } else { \
        _Pragma("unroll") for (int n = 0; n < 2; ++n) _Pragma("unroll") for (int k = 0; k < 2; ++k) dst[n][k] = *(const PG8_LAS bf16x8*)(lds + PG8_SB(b, h) + boff + n * 2048 + k * 1024); } } while (0)
#define PG8_MMA(ai, bj, At, Bt) do { __builtin_amdgcn_s_setprio(1); if constexpr (FP8) { \
        _Pragma("unroll") for (int m = 0; m < 4; ++m) _Pragma("unroll") for (int n = 0; n < 2; ++n) \
        asm volatile("v_mfma_f32_16x16x128_f8f6f4 %0, %1, %2, %0" : "+v"(acc[ai][bj][m][n]) : "v"(Bt##8[n]), "v"(At##8[m])); } else {     \
        _Pragma("unroll") for (int m = 0; m < 4; ++m) _Pragma("unroll") for (int n = 0; n < 2; ++n) _Pragma("unroll") for (int k = 0; k < 2; ++k) \
        acc[ai][bj][m][n] = __builtin_amdgcn_mfma_f32_16x16x32_bf16(Bt[n][k], At[m][k], acc[ai][bj][m][n], 0, 0, 0); } __builtin_amdgcn_s_setprio(0); } while (0)
#define PG8_WAIT_V(n) asm volatile("s_waitcnt vmcnt(" #n ")" ::: "memory")
#define PG8_WAIT_L(n) asm volatile("s_waitcnt lgkmcnt(" #n ")" ::: "memory")
#define PG8_BAR __builtin_amdgcn_s_barrier()
#define PG8_SCHED __builtin_amdgcn_sched_barrier(0)
    Unit cur, nxt; int ui = 0;
    if (!S.next(0, cur)) return;
    f32x4 acc[2][2][4][2];
#pragma unroll
    for (int a = 0; a < 2; ++a)
#pragma unroll
        for (int b = 0; b < 2; ++b)
#pragma unroll
            for (int m = 0; m < 4; ++m)
#pragma unroll
                for (int n = 0; n < 2; ++n) acc[a][b][m][n] = (f32x4){0.f, 0.f, 0.f, 0.f};
    bf16x8 At[4][2], B0[2][2], B1[2][2]; i32x8_ At8[4], B08[2], B18[2];
    const char* cA = GATHER ? (const char*)g.A : (const char*)(cur.sel ? g.A2 : g.A) + (size_t)cur.pm * tstep; PG8_GOFF(vA, cur); const char* cB = (const char*)(cur.sel ? g.Bt2 : g.Bt) + (size_t)cur.pb * tstep;
    S.a_ready(cur);
    if constexpr (SP2) {
        PG8_STAGE(PG8_SB(0, 0), cB, voffB); PG8_STAGE(PG8_SB(0, 1), cB + hstep, voffB); PG8_STAGE_A(PG8_SA(0, 0), cA, 0, false); PG8_STAGE_A(PG8_SA(0, 1), cA, 1, false);
        if (wr == 1) PG8_BAR;
        PG8_WAIT_V(2); PG8_BAR;
        PG8_STAGE(PG8_SB(1, 0), cB + kstep, voffB); PG8_STAGE_A(PG8_SA(1, 0), cA + kstep, 0, false); PG8_STAGE(PG8_SB(1, 1), cB + hstep + kstep, voffB);
        PG8_WAIT_V(6); PG8_BAR;
    } else {
        PG8_STAGE(PG8_SB(0, 0), cB, voffB); PG8_STAGE_A(PG8_SA(0, 0), cA, 0, false); PG8_STAGE(PG8_SB(0, 1), cB + hstep, voffB); PG8_STAGE_A(PG8_SA(0, 1), cA, 1, false);
        if (wr == 1) PG8_BAR;
        PG8_WAIT_V(4); PG8_BAR;
        PG8_STAGE(PG8_SB(1, 0), cB + kstep, voffB); PG8_STAGE_A(PG8_SA(1, 0), cA + kstep, 0, false); PG8_STAGE(PG8_SB(1, 1), cB + hstep + kstep, voffB);
        PG8_WAIT_V(6); PG8_BAR;
    }
    for (;;) {
        const bool has_next = S.next(ui + 1, nxt);
        if (has_next) PG8_GOFF(vN, nxt); else { if constexpr (GATHER) { vN[0][0] = vA[0][0]; vN[0][1] = vA[0][1]; vN[1][0] = vA[1][0]; vN[1][1] = vA[1][1]; } }
        const char* nA = GATHER ? (const char*)g.A : has_next ? (const char*)(nxt.sel ? g.A2 : g.A) + (size_t)nxt.pm * tstep : cA; const char* nB = has_next ? (const char*)(nxt.sel ? g.Bt2 : g.Bt) + (size_t)nxt.pb * tstep : cB;
#pragma unroll 1
        for (int t = 0; t < nt; t += 2) {
            const bool last = (t == nt - 2);
            const char* a1 = cA + (size_t)(t + 1) * kstep;
            const char* a2 = last ? nA : cA + (size_t)(t + 2) * kstep; const char* b2 = last ? nB : cB + (size_t)(t + 2) * kstep;
            const char* a3 = a2 + kstep; const char* b3 = b2 + kstep;
            if (last && has_next) S.a_ready(nxt);
            if constexpr (SP2) {
            PG8_LDB(B0, 0, 0); PG8_LDB(B1, 0, 1); PG8_SCHED; PG8_LDA(At, 0, 0); PG8_STAGE_A(PG8_SA(1, 1), a1, 1, false);
            PG8_WAIT_V(8); PG8_WAIT_L(0); PG8_BAR; PG8_MMA(0, 0, At, B0); PG8_MMA(0, 1, At, B1); PG8_BAR; PG8_SCHED;
            PG8_LDA(At, 0, 1); PG8_STAGE(PG8_SB(0, 0), b2, voffB); PG8_STAGE(PG8_SB(0, 1), b2 + hstep, voffB); PG8_STAGE_A(PG8_SA(0, 0), a2, 0, last);
            PG8_WAIT_V(8); PG8_WAIT_L(0); PG8_BAR; PG8_MMA(1, 0, At, B0); PG8_MMA(1, 1, At, B1); PG8_BAR; PG8_SCHED;
            PG8_LDB(B0, 1, 0); PG8_LDB(B1, 1, 1); PG8_SCHED; PG8_LDA(At, 1, 0); PG8_STAGE_A(PG8_SA(0, 1), a2, 1, last);
            PG8_WAIT_V(8); PG8_WAIT_L(0); PG8_BAR; PG8_MMA(0, 0, At, B0); PG8_MMA(0, 1, At, B1); PG8_BAR; PG8_SCHED;
            PG8_LDA(At, 1, 1); PG8_STAGE(PG8_SB(1, 0), b3, voffB); PG8_STAGE(PG8_SB(1, 1), b3 + hstep, voffB); PG8_STAGE_A(PG8_SA(1, 0), a3, 0, last);
            PG8_WAIT_V(8); PG8_WAIT_L(0); PG8_BAR; PG8_MMA(1, 0, At, B0); PG8_MMA(1, 1, At, B1); PG8_BAR; PG8_SCHED;
            } else {
            PG8_LDB(B0, 0, 0); PG8_SCHED; PG8_LDA(At, 0, 0); PG8_STAGE_A(PG8_SA(1, 1), a1, 1, false);
            PG8_WAIT_L(8); PG8_BAR; PG8_WAIT_L(0); PG8_MMA(0, 0, At, B0); PG8_BAR; PG8_SCHED;
            PG8_LDB(B1, 0, 1); PG8_STAGE(PG8_SB(0, 0), b2, voffB);
            PG8_BAR; PG8_WAIT_L(0); PG8_MMA(0, 1, At, B1); PG8_BAR;
            PG8_LDA(At, 0, 1); PG8_STAGE_A(PG8_SA(0, 0), a2, 0, last);
            PG8_BAR; PG8_WAIT_L(0); PG8_MMA(1, 0, At, B0); PG8_BAR; PG8_SCHED;
            PG8_STAGE(PG8_SB(0, 1), b2 + hstep, voffB);
            PG8_WAIT_V(6); PG8_BAR; PG8_MMA(1, 1, At, B1); PG8_BAR;
            PG8_LDB(B0, 1, 0); PG8_SCHED; PG8_LDA(At, 1, 0); PG8_STAGE_A(PG8_SA(0, 1), a2, 1, last);
            PG8_WAIT_L(8); PG8_BAR; PG8_WAIT_L(0); PG8_MMA(0, 0, At, B0); PG8_BAR; PG8_SCHED;
            PG8_LDB(B1, 1, 1); PG8_STAGE(PG8_SB(1, 0), b3, voffB);
            PG8_BAR; PG8_WAIT_L(0); PG8_MMA(0, 1, At, B1); PG8_BAR;
            PG8_LDA(At, 1, 1); PG8_STAGE_A(PG8_SA(1, 0), a3, 0, last);
            PG8_BAR; PG8_WAIT_L(0); PG8_MMA(1, 0, At, B0); PG8_BAR; PG8_SCHED;
            PG8_STAGE(PG8_SB(1, 1), b3 + hstep, voffB);
            PG8_WAIT_V(6); PG8_BAR; PG8_MMA(1, 1, At, B1); PG8_BAR;
            }
        }
        if constexpr (FP8) asm volatile("s_nop 15\n\ts_nop 7" ::: "memory");
        if constexpr (ALIGN_EPI) { if (wr == 0) PG8_BAR; }
        bool fin = true; if constexpr (Epi::CHAIN) fin = (cur.sel != 0);
        if constexpr (!Epi::AFTER_DRAIN) { const int le_ = lane_id_opaque(), fre = le_ & 15, fqe = le_ >> 4;
            if (fin) E(acc, cur, wr, wc, fre, fqe); else { if constexpr (Epi::CHAIN) E.mid(acc, cur, wr, wc, fre, fqe); } S.done(cur); }
        if (!has_next) break;
        if (fin)
#pragma unroll
        for (int a = 0; a < 2; ++a)
#pragma unroll
            for (int b = 0; b < 2; ++b)
#pragma unroll
                for (int m = 0; m < 4; ++m)
#pragma unroll
                    for (int n = 0; n < 2; ++n) acc[a][b][m][n] = (f32x4){0.f, 0.f, 0.f, 0.f};
        cur = nxt; cA = nA; cB = nB; ++ui;
        if constexpr (GATHER) { vA[0][0] = vN[0][0]; vA[0][1] = vN[0][1]; vA[1][0] = vN[1][0]; vA[1][1] = vN[1][1]; }
        if constexpr (ALIGN_EPI) { if (wr == 1) PG8_BAR; }
    }
    PG8_WAIT_V(0);
    if constexpr (!ALIGN_EPI) { if (wr == 0) PG8_BAR; }
    PG8_BAR;
    if constexpr (Epi::AFTER_DRAIN) { E.fused(acc, cur, wr, wc, fr, fq, lds, wid, lane); S.done(cur); }
#undef PG8_SA
#undef PG8_STAGE_A
#undef PG8_GOFF
#undef PG8_SB
#undef PG8_STAGE
#undef PG8_LDA
#undef PG8_LDB
#undef PG8_MMA
#undef PG8_WAIT_V
#undef PG8_WAIT_L
#undef PG8_BAR
#undef PG8_SCHED
}
}

#include <hip/hip_bf16.h>
#include <cmath>

namespace attn8 {
using bf16 = __hip_bfloat16;
typedef int i32x8 __attribute__((ext_vector_type(8)));
typedef int i32x4 __attribute__((ext_vector_type(4)));
typedef float f32x16 __attribute__((ext_vector_type(16)));
typedef unsigned u32x4 __attribute__((ext_vector_type(4)));
constexpr int NHEAD = 8, SEQ = 16384, QBLK = 32, NW = 8, QB = 256, KVBLK = 64, NQB = SEQ / QB, NT = SEQ / KVBLK;
constexpr int NS = 8, SLOT = 4096;
constexpr int LDS_K = 0, LDS_V = NS * SLOT, LDS_WS = 2 * NS * SLOT, LDS_OST = LDS_WS + NW * 256, LDS_BYTES = LDS_OST + NW * 4096;
__device__ __forceinline__ int crow(int r, int hi) { return (r & 3) + 8 * (r >> 2) + 4 * hi; }
__device__ __forceinline__ void glds16(const void* gsrc, unsigned lds_dst) { unsigned keep;
    asm volatile("s_mov_b32 %0, m0\n\ts_mov_b32 m0, %2\n\ts_nop 0\n\tglobal_load_lds_dwordx4 %1, off\n\ts_mov_b32 m0, %0" : "=&s"(keep) : "v"(gsrc), "s"(lds_dst) : "memory"); }
typedef __attribute__((address_space(3))) const char* lds_cptr;
__device__ __forceinline__ i32x8 frag(lds_cptr p) {
    const i32x4 lo = *(const __attribute__((address_space(3))) i32x4*)(p), hi = *(const __attribute__((address_space(3))) i32x4*)(p + 1024);
    return __builtin_shufflevector(lo, hi, 0, 1, 2, 3, 4, 5, 6, 7); }
#define A8_MFMA(a, b, c) __builtin_amdgcn_mfma_scale_f32_32x32x64_f8f6f4((a), (b), (c), 0, 0, 0, 0, 0, 0)
struct Tensors { const unsigned char* Q8; const unsigned char* K8; const unsigned char* V8T; bf16* O; };

template <class Bg>
__device__ __forceinline__ void unit(int h, int qb, const Tensors& T, char* shm, int wave_, float negM8, Bg& bg) {
    const int tid = wave_ * 64 + lane_id_opaque(), lane = tid & 63, r32 = lane & 31, hi = lane >> 5; const int wid = __builtin_amdgcn_readfirstlane(tid >> 6);
    const int kvh = h >> 2, q0 = qb * QB;
    const unsigned lds0 = (unsigned)(uintptr_t)shm;
    float* wsf = (float*)(shm + LDS_WS) + wid * 64;
    const bool isk = wid < 4; const int c = wid & 3;
    const unsigned char* src0 = isk ? T.K8 + (size_t)lane * 128 + kvh * 64 + c * 16 : T.V8T + (size_t)kvh * NT * 4096 + (size_t)lane * 64 + c * 16;
    const size_t tstep = isk ? (size_t)KVBLK * 128 : (size_t)4096;
    const unsigned dst0 = lds0 + (isk ? LDS_K : LDS_V) + c * 1024;
#define A8_DMA(t) glds16(src0 + (size_t)(t) * tstep, (unsigned)__builtin_amdgcn_readfirstlane(dst0 + ((t) & (NS - 1)) * SLOT))
#pragma unroll
    for (int t = 0; t < 3; ++t) A8_DMA(t);
    if (isk) { A8_DMA(3); A8_DMA(4); }
    const unsigned char* qp = T.Q8 + (size_t)(q0 + wid * QBLK + r32) * 512 + h * 64 + 32 * hi;
    const i32x4 qlo = *(const i32x4*)qp, qhi = *(const i32x4*)(qp + 16);
    const i32x8 qf = __builtin_shufflevector(qlo, qhi, 0, 1, 2, 3, 4, 5, 6, 7);
    f32x16 negm;
#pragma unroll
    for (int r = 0; r < 16; ++r) negm[r] = negM8;
    f32x16 o0 = f32x16{}, o1 = f32x16{}, lacc = f32x16{};
    i32x8 ones8;
#pragma unroll
    for (int k = 0; k < 8; ++k) ones8[k] = 0x38383838;
    const lds_cptr kbase = (lds_cptr)shm + LDS_K + (2 * hi) * 1024 + r32 * 16, vbase = (lds_cptr)shm + LDS_V + (2 * hi) * 1024 + r32 * 16;
    if (isk) asm volatile("s_waitcnt vmcnt(4)" ::: "memory"); else asm volatile("s_waitcnt vmcnt(2)" ::: "memory");
    asm volatile("s_waitcnt lgkmcnt(0)\n\ts_barrier" ::: "memory");
    asm volatile("" : "+v"(ones8));
    f32x16 sA0 = A8_MFMA(frag(kbase), qf, negm), sA1 = A8_MFMA(frag(kbase + 512), qf, negm), sB0, sB1;
#define A8_SB() __builtin_amdgcn_sched_barrier(0)
#define A8_EX8(X, b) do { _Pragma("unroll") for (int r = 0; r < 8; ++r) X[(b) + r] = __builtin_amdgcn_exp2f(X[(b) + r]); } while (0)
#define A8_TILE(C0, C1, N0, N1, PP, PC, kt, vt) do { \
        const lds_cptr kp_ = kbase + ((kt) & (NS - 1)) * SLOT, vp_ = vbase + ((vt) & (NS - 1)) * SLOT; \
        const i32x8 kf0_ = frag(kp_), kf1_ = frag(kp_ + 512), vf0_ = frag(vp_), vf1_ = frag(vp_ + 512); A8_SB(); \
        N0 = A8_MFMA(kf0_, qf, negm); A8_SB(); A8_EX8(C0, 0); A8_SB(); \
        N1 = A8_MFMA(kf1_, qf, negm); A8_SB(); A8_EX8(C0, 8); A8_SB(); \
        o0 = A8_MFMA(PP, vf0_, o0); A8_SB(); A8_EX8(C1, 0); A8_SB(); \
        o1 = A8_MFMA(PP, vf1_, o1); A8_SB(); A8_EX8(C1, 8); A8_SB(); \
        lacc = A8_MFMA(PP, ones8, lacc); A8_SB(); \
        _Pragma("unroll") for (int k = 0; k < 4; ++k) { int w_; asm volatile("" : "=v"(w_)); w_ = __builtin_amdgcn_cvt_pk_fp8_f32(C0[4 * k], C0[4 * k + 1], w_, false); w_ = __builtin_amdgcn_cvt_pk_fp8_f32(C0[4 * k + 2], C0[4 * k + 3], w_, true); PC[k] = w_; \
            int v_; asm volatile("" : "=v"(v_)); v_ = __builtin_amdgcn_cvt_pk_fp8_f32(C1[4 * k], C1[4 * k + 1], v_, false); v_ = __builtin_amdgcn_cvt_pk_fp8_f32(C1[4 * k + 2], C1[4 * k + 3], v_, true); PC[4 + k] = v_; } \
        A8_SB(); } while (0)
    i32x8 pA, pB;
#pragma unroll
    for (int k = 0; k < 8; ++k) { pA[k] = 0; pB[k] = 0; }
    for (int t = 0; t < NT; t += 4) {
        asm volatile("s_waitcnt vmcnt(0) lgkmcnt(0)\n\ts_barrier" ::: "memory");
        if (isk) {
#pragma unroll
            for (int j = 5; j <= 8; ++j) if (t + j < NT) A8_DMA(t + j);
        } else {
#pragma unroll
            for (int j = 3; j <= 6; ++j) if (t + j < NT) A8_DMA(t + j);
        }
        bg.step();
        A8_TILE(sA0, sA1, sB0, sB1, pB, pA, t + 1, (t > 0 ? t - 1 : 0));
        A8_TILE(sB0, sB1, sA0, sA1, pA, pB, t + 2, t);
        A8_TILE(sA0, sA1, sB0, sB1, pB, pA, t + 3, t + 1);
        A8_TILE(sB0, sB1, sA0, sA1, pA, pB, t + 4, t + 2);
    }
    asm volatile("s_waitcnt vmcnt(0) lgkmcnt(0)\n\ts_barrier" ::: "memory");
    {
        const lds_cptr vp_ = vbase + ((NT - 1) & (NS - 1)) * SLOT; const i32x8 vf0_ = frag(vp_), vf1_ = frag(vp_ + 512);
        o0 = A8_MFMA(pB, vf0_, o0); o1 = A8_MFMA(pB, vf1_, o1); lacc = A8_MFMA(pB, ones8, lacc); }
#undef A8_EX8
#undef A8_TILE
#undef A8_SB
    (void)wsf;
    float rli[16];
#pragma unroll
    for (int r = 0; r < 16; ++r) rli[r] = __builtin_amdgcn_rcpf(lacc[r]);
    bf16* Ow = T.O + (size_t)(q0 + wid * QBLK) * 512 + h * 64;
    { bf16* stg = (bf16*)(shm + LDS_OST) + wid * 2048;
#pragma unroll
      for (int r = 0; r < 16; ++r) { const int orow = crow(r, hi); stg[orow * 64 + r32] = __float2bfloat16(o0[r] * rli[r]); stg[orow * 64 + 32 + r32] = __float2bfloat16(o1[r] * rli[r]); }
      asm volatile("s_waitcnt lgkmcnt(0)" ::: "memory");
#pragma unroll
      for (int i = 0; i < 4; ++i) { const int row = i * 8 + (lane >> 3), ch = lane & 7; const u32x4 v = *(const u32x4*)(stg + row * 64 + ch * 8); *(u32x4*)(Ow + (size_t)row * 512 + ch * 8) = v; } }
    asm volatile("s_waitcnt vmcnt(0) lgkmcnt(0)\n\ts_barrier" ::: "memory");
#undef A8_DMA
}
template <class Bg>
__device__ __forceinline__ void phase(char* lds, const Tensors& T, int grid, int block, int wave_, float negM8, Bg& bg) {
    const int vcu = (grid % 8 == 0) ? (block % 8) * (grid / 8) + block / 8 : block;
    constexpr int NU = NHEAD * NQB;
    if (NU % grid == 0) { const int per = NU / grid; for (int i = 0; i < per; ++i) { const int uu = vcu * per + i; unit(uu / NQB, uu % NQB, T, lds, wave_, negM8, bg); } }
    else for (int uu = vcu; uu < NU; uu += grid) unit(uu / NQB, uu % NQB, T, lds, wave_, negM8, bg);
}
#undef A8_MFMA
}

namespace hg {
typedef short bf16x8 __attribute__((ext_vector_type(8)));
typedef short s16x4 __attribute__((ext_vector_type(4)));
constexpr int CH = 32, SEGT = 512, NSEG = S / SEGT, NCH = SEGT / CH;
constexpr int RS = 272, TS = 80;
constexpr int QOFF = 0, KOFF = 32 * RS, KTOFF = 2 * 32 * RS, VTOFF = KTOFF + 128 * TS, DOFF = VTOFF + 128 * TS, GOFF = DOFF + 512, BUFB = GOFF + 4096;
static_assert(2 * BUFB <= 131072, "hgrn LDS");
#define HG_MFMA(a, b, c) __builtin_amdgcn_mfma_f32_16x16x32_bf16((a), (b), (c), 0, 0, 0)
__device__ __forceinline__ unsigned pkbf(float lo, float hi) { typedef float f2 __attribute__((ext_vector_type(2))); typedef __bf16 b2 __attribute__((ext_vector_type(2))); f2 v = {lo, hi}; b2 b = __builtin_convertvector(v, b2); return __builtin_bit_cast(unsigned, b); }

typedef float f32x2h __attribute__((ext_vector_type(2)));
template <bool OUT>
__device__ __forceinline__ void chunk_matrix(LAS unsigned char* B, f32x4 (&Sacc)[8], int c16, int g, int e0, int dir, int h, int p0c, float* __restrict__ OF) {
    if (OUT) {
        f32x4 X00 = {0.f, 0.f, 0.f, 0.f}, X01 = X00, X11 = X00;
#pragma unroll
        for (int s = 0; s < 4; ++s) {
            const bf16x8 aK0 = *(const LAS bf16x8*)(B + KOFF + c16 * RS + (32 * s + 8 * g) * 2), aK1 = *(const LAS bf16x8*)(B + KOFF + (16 + c16) * RS + (32 * s + 8 * g) * 2);
            const bf16x8 bQ0 = *(const LAS bf16x8*)(B + QOFF + c16 * RS + (32 * s + 8 * g) * 2), bQ1 = *(const LAS bf16x8*)(B + QOFF + (16 + c16) * RS + (32 * s + 8 * g) * 2);
            X00 = HG_MFMA(aK0, bQ0, X00); X01 = HG_MFMA(aK0, bQ1, X01); X11 = HG_MFMA(aK1, bQ1, X11);
        }
#pragma unroll
        for (int r = 0; r < 4; ++r) { const bool keep = (4 * g + r) <= c16; X00[r] = keep ? X00[r] : 0.f; X11[r] = keep ? X11[r] : 0.f; }
        u32x4 a0w, a1w; a0w.x = pkbf(X00[0], X00[1]); a0w.y = pkbf(X00[2], X00[3]); a0w.z = 0u; a0w.w = 0u;
        a1w.x = pkbf(X01[0], X01[1]); a1w.y = pkbf(X01[2], X01[3]); a1w.z = pkbf(X11[0], X11[1]); a1w.w = pkbf(X11[2], X11[3]);
        const u32x2 vlo = *(const LAS u32x2*)(B + VTOFF + (e0 + c16) * TS + (4 * g) * 2), vhi = *(const LAS u32x2*)(B + VTOFF + (e0 + c16) * TS + (16 + 4 * g) * 2);
        u32x4 vbw; vbw.x = vlo.x; vbw.y = vlo.y; vbw.z = vhi.x; vbw.w = vhi.y;
        const bf16x8 vb = __builtin_bit_cast(bf16x8, vbw);
        f32x4 O0 = {0.f, 0.f, 0.f, 0.f}, O1 = O0;
        O0 = HG_MFMA(__builtin_bit_cast(bf16x8, a0w), vb, O0); O1 = HG_MFMA(__builtin_bit_cast(bf16x8, a1w), vb, O1);
#pragma unroll
        for (int s = 0; s < 4; ++s) {
            u32x4 sw; sw.x = pkbf(Sacc[2 * s][0], Sacc[2 * s][1]); sw.y = pkbf(Sacc[2 * s][2], Sacc[2 * s][3]); sw.z = pkbf(Sacc[2 * s + 1][0], Sacc[2 * s + 1][1]); sw.w = pkbf(Sacc[2 * s + 1][2], Sacc[2 * s + 1][3]);
            const bf16x8 sb = __builtin_bit_cast(bf16x8, sw);
            const u32x2 q0l = *(const LAS u32x2*)(B + QOFF + c16 * RS + (32 * s + 4 * g) * 2), q0h = *(const LAS u32x2*)(B + QOFF + c16 * RS + (32 * s + 16 + 4 * g) * 2);
            const u32x2 q1l = *(const LAS u32x2*)(B + QOFF + (16 + c16) * RS + (32 * s + 4 * g) * 2), q1h = *(const LAS u32x2*)(B + QOFF + (16 + c16) * RS + (32 * s + 16 + 4 * g) * 2);
            u32x4 q0w, q1w; q0w.x = q0l.x; q0w.y = q0l.y; q0w.z = q0h.x; q0w.w = q0h.y; q1w.x = q1l.x; q1w.y = q1l.y; q1w.z = q1h.x; q1w.w = q1h.y;
            O0 = HG_MFMA(__builtin_bit_cast(bf16x8, q0w), sb, O0); O1 = HG_MFMA(__builtin_bit_cast(bf16x8, q1w), sb, O1);
        }
        { const int gm = dir ? 3 - g : g; const unsigned ooff = (unsigned)(4 * gm) * 512u + (unsigned)(e0 + c16);
          GAS float* ofu = (GAS float*)OF + (size_t)dir * S * 512 + h * 128;
          const int Tb = dir ? (S - 32 - p0c) : p0c;
#pragma unroll
          for (int r = 0; r < 4; ++r) {
              ofu[(size_t)(Tb + (dir ? 16 + 3 - r : r)) * 512 + ooff] = O0[r];
              ofu[(size_t)(Tb + (dir ? 3 - r : 16 + r)) * 512 + ooff] = O1[r];
          } }
    }
    {
        const bf16x8 vB = *(const LAS bf16x8*)(B + VTOFF + (e0 + c16) * TS + (8 * g) * 2);
#pragma unroll
        for (int dt = 0; dt < 8; ++dt) {
            const bf16x8 aT = *(const LAS bf16x8*)(B + KTOFF + (16 * dt + c16) * TS + (8 * g) * 2);
            Sacc[dt] = HG_MFMA(aT, vB, Sacc[dt]);
            const f32x4 dv = *(const LAS f32x4*)(B + DOFF + (16 * dt + 4 * g) * 4);
            Sacc[dt] = Sacc[dt] * dv;
        }
    }
}
template <bool OUT>
__device__ __forceinline__ void segment(LAS unsigned char* lds, int unit, const bf16_t* __restrict__ HQ, const float* __restrict__ LF, const bf16_t* __restrict__ KF,
                                        const bf16_t* __restrict__ HV, float* __restrict__ HST, float* __restrict__ HSD, float* __restrict__ OF, int wave_) {
    const int tid_ = wave_ * 64 + lane_id_opaque();
    const int tid = tid_, lane = tid & 63, w = __builtin_amdgcn_readfirstlane(tid >> 6), c16 = lane & 15, g = lane >> 4;
    const int dir = unit >> 7, h = (unit >> 5) & 3, seg = unit & 31;
    const int d0 = 2 * (tid & 63), tg = tid >> 6;
    f32x4 Sacc[8];
    float* hst = HST + (size_t)unit * 16384 + (size_t)w * 2048 + lane;
    if (OUT) {
#pragma unroll
        for (int dt = 0; dt < 8; ++dt) { Sacc[dt][0] = hst[(dt * 4 + 0) * 64]; Sacc[dt][1] = hst[(dt * 4 + 1) * 64]; Sacc[dt][2] = hst[(dt * 4 + 2) * 64]; Sacc[dt][3] = hst[(dt * 4 + 3) * 64]; }
    } else {
#pragma unroll
        for (int dt = 0; dt < 8; ++dt) Sacc[dt] = f32x4{0.f, 0.f, 0.f, 0.f};
    }
    f32x2h segsum = {0.f, 0.f};
    const int e0 = 16 * w;
    constexpr int RING = 2;
    f32x2h rl[RING][4]; unsigned rk[RING][4], rq[RING][4], rv[RING][4];
    const int tgm = dir ? 7 - tg : tg;
    const unsigned toff = (unsigned)(4 * tgm) * 512u + (unsigned)d0;
    const GAS float* lfu = (const GAS float*)LF + (size_t)dir * S * 512 + h * 128;
    const GAS bf16_t* kfu = (const GAS bf16_t*)KF + (size_t)dir * S * 512 + h * 128;
    const GAS bf16_t* hqu = (const GAS bf16_t*)HQ + h * 128; const GAS bf16_t* hvu = (const GAS bf16_t*)HV + h * 128;
#define HG_LOAD(sl, cc) do { const int Tb_ = dir ? (S - 32 - (seg * SEGT + (cc) * CH)) : (seg * SEGT + (cc) * CH); \
        _Pragma("unroll") for (int jj = 0; jj < 4; ++jj) { const size_t ub_ = (size_t)(Tb_ + (dir ? 3 - jj : jj)) * 512; \
        rl[sl][jj] = *(const GAS f32x2h*)(lfu + ub_ + toff); rk[sl][jj] = *(const GAS unsigned*)(kfu + ub_ + toff); rv[sl][jj] = *(const GAS unsigned*)(hvu + ub_ + toff); \
        rq[sl][jj] = OUT ? *(const GAS unsigned*)(hqu + ub_ + toff) : 0u; } } while (0)
#pragma unroll
    for (int sl = 0; sl < RING; ++sl) HG_LOAD(sl, sl);
    for (int c4 = 0; c4 < NCH; c4 += RING) {
#pragma unroll
        for (int sl = 0; sl < RING; ++sl) {
            const int c = c4 + sl;
            LAS unsigned char* B = lds + (c & 1) * BUFB;
            f32x2h cs[4]; unsigned kk[4], qq[4], vv[4];
#pragma unroll
            for (int jj = 0; jj < 4; ++jj) { cs[jj] = rl[sl][jj]; kk[jj] = rk[sl][jj]; qq[jj] = rq[sl][jj]; vv[jj] = rv[sl][jj]; }
            if (c + RING < NCH) HG_LOAD(sl, c + RING);
#pragma unroll
            for (int jj = 1; jj < 4; ++jj) cs[jj] += cs[jj - 1];
            LAS float* gs = (LAS float*)(B + GOFF);
            *(LAS f32x2h*)(gs + tg * 128 + d0) = cs[3];
            __syncthreads();
            f32x2h off = {0.f, 0.f}, tot = {0.f, 0.f};
#pragma unroll
            for (int q = 0; q < 8; ++q) { const f32x2h gq = *(const LAS f32x2h*)(gs + q * 128 + d0); tot += gq; if (q < tg) off += gq; }
            float kt0[4], kt1[4];
#pragma unroll
            for (int jj = 0; jj < 4; ++jj) {
                const float b0 = fmaxf(off.x + cs[jj].x, -80.f), b1 = fmaxf(off.y + cs[jj].y, -80.f);
                kt0[jj] = bflo(kk[jj]) * __expf(-b0); kt1[jj] = bfhi(kk[jj]) * __expf(-b1);
                if (OUT) {
                    *(LAS unsigned*)(B + QOFF + (4 * tg + jj) * RS + d0 * 2) = pkbf(bflo(qq[jj]) * __expf(b0), bfhi(qq[jj]) * __expf(b1));
                    *(LAS unsigned*)(B + KOFF + (4 * tg + jj) * RS + d0 * 2) = pkbf(kt0[jj], kt1[jj]);
                }
            }
            { u32x2 o0, o1; o0.x = pkbf(kt0[0], kt0[1]); o0.y = pkbf(kt0[2], kt0[3]); o1.x = pkbf(kt1[0], kt1[1]); o1.y = pkbf(kt1[2], kt1[3]);
              *(LAS u32x2*)(B + KTOFF + d0 * TS + 8 * tg) = o0; *(LAS u32x2*)(B + KTOFF + (d0 + 1) * TS + 8 * tg) = o1;
              u32x2 v0, v1; v0.x = (vv[0] & 0xffffu) | (vv[1] << 16); v0.y = (vv[2] & 0xffffu) | (vv[3] << 16); v1.x = (vv[0] >> 16) | (vv[1] & 0xffff0000u); v1.y = (vv[2] >> 16) | (vv[3] & 0xffff0000u);
              *(LAS u32x2*)(B + VTOFF + d0 * TS + 8 * tg) = v0; *(LAS u32x2*)(B + VTOFF + (d0 + 1) * TS + 8 * tg) = v1; }
            if (tg == 0) { f32x2h dv; dv.x = __expf(fmaxf(tot.x, -80.f)); dv.y = __expf(fmaxf(tot.y, -80.f)); *(LAS f32x2h*)(B + DOFF + d0 * 4) = dv; }
            segsum += tot;
            __syncthreads();
            chunk_matrix<OUT>(B, Sacc, c16, g, e0, dir, h, seg * SEGT + c * CH, OF);
        }
    }
    if (!OUT) {
#pragma unroll
        for (int dt = 0; dt < 8; ++dt) { hst[(dt * 4 + 0) * 64] = Sacc[dt][0]; hst[(dt * 4 + 1) * 64] = Sacc[dt][1]; hst[(dt * 4 + 2) * 64] = Sacc[dt][2]; hst[(dt * 4 + 3) * 64] = Sacc[dt][3]; }
        if (tid < 64) { f32x2h dd; dd.x = __expf(fmaxf(segsum.x, -80.f)); dd.y = __expf(fmaxf(segsum.y, -80.f)); *(f32x2h*)(HSD + (size_t)unit * 128 + d0) = dd; }
    }
    __syncthreads();
}
__device__ __forceinline__ void carry(float* __restrict__ HST, const float* __restrict__ HSD, int gid) {
    const int chain = gid >> 14, el = gid & 16383, dt = (el >> 8) & 7, r = (el >> 6) & 3, ln = el & 63, d = 16 * dt + 4 * (ln >> 4) + r;
    float cy = 0.f;
    for (int sg = 0; sg < NSEG; ++sg) {
        const int u = chain * NSEG + sg;
        const float tmp = HST[(size_t)u * 16384 + el];
        HST[(size_t)u * 16384 + el] = cy;
        cy = HSD[(size_t)u * 128 + d] * cy + tmp;
    }
}
#undef HG_MFMA
#undef HG_LOAD
}

#define XB_TMO      128
#define XB_XCNT(j)  (256  + 64 * (j))
#define XB_XSUB(j)  (1280 + 64 * (j))
#define XB_XGEN(j)  (2304 + 64 * (j))
#define XB_TOP      3328
#define XB_TOPGEN   3392
#define XCD_BAR_WORDS 3456
#define XB_SPIN_CAP (1u << 18)

__device__ __forceinline__ unsigned xb_ld(unsigned* p)              { return __hip_atomic_load(p, __ATOMIC_RELAXED, __HIP_MEMORY_SCOPE_AGENT); }
__device__ __forceinline__ unsigned xb_add(unsigned* p, unsigned v) { return __hip_atomic_fetch_add(p, v, __ATOMIC_RELAXED, __HIP_MEMORY_SCOPE_AGENT); }
__device__ __forceinline__ unsigned xb_xcc_id() { return (unsigned)__builtin_amdgcn_s_getreg((3 << 11) | 20) & 0xFu; }
#define XB_SPIN(cond, bar) do { unsigned _sp = 0; while (cond) { __builtin_amdgcn_s_sleep(1); \
    if ((++_sp & 255u) == 0u) { if (xb_ld(&(bar)[XB_TMO])) break; if (_sp > XB_SPIN_CAP) { atomicAdd(&(bar)[XB_TMO], 1u); break; } } } } while (0)

struct XcdBarrier {
    int wv;
    unsigned* bar; unsigned x;
    volatile LAS unsigned* st;
};

__device__ __forceinline__ XcdBarrier xcd_barrier_post(unsigned* bar, volatile LAS unsigned* st) {
    XcdBarrier b; b.bar = bar; b.x = xb_xcc_id(); b.st = st; b.wv = __builtin_amdgcn_readfirstlane((int)threadIdx.x >> 6);
    if (threadIdx.x == 0) (void)xb_add(&bar[XB_XCNT(b.x)], 1u);
    return b;
}
__device__ __forceinline__ void xcd_barrier_complete(unsigned* bar, unsigned x, unsigned& nloc, unsigned& nx) {
    const unsigned G = gridDim.x * gridDim.y * gridDim.z;
    unsigned sum, cnt, mine, sp = 0u;
    for (;;) {
        sum = 0u; cnt = 0u; mine = 0u;
#pragma unroll
        for (unsigned j = 0; j < 16; ++j) { const unsigned c = xb_ld(&bar[XB_XCNT(j)]); sum += c; cnt += (c > 0u) ? 1u : 0u; mine = (j == x) ? c : mine; }
        if (sum == G) break;
        __builtin_amdgcn_s_sleep(1);
        if ((++sp & 255u) == 0u) { if (xb_ld(&bar[XB_TMO])) break; if (sp > XB_SPIN_CAP) { atomicAdd(&bar[XB_TMO], 1u); break; } }
    }
    nloc = mine > 0u ? mine : 1u; nx = cnt > 0u ? cnt : 1u;
}

__device__ __forceinline__ void xcd_barrier(const XcdBarrier& b) {
    asm volatile("s_waitcnt vmcnt(0)" ::: "memory");
    __syncthreads();
    if (b.wv == 0 && lane_id_opaque() == 0) {
        unsigned* bar = b.bar;
        __builtin_amdgcn_s_waitcnt(0);
        unsigned nloc = b.st[0], nx = b.st[1];
        if (nloc == 0u) { xcd_barrier_complete(bar, b.x, nloc, nx); b.st[0] = nloc; b.st[1] = nx; }
        const unsigned old = xb_add(&bar[XB_XSUB(b.x)], 1u);
        const unsigned gen = old / nloc;
        if (old + 1u == (gen + 1u) * nloc) {
            __builtin_amdgcn_fence(__ATOMIC_RELEASE, "agent");
            asm volatile("s_waitcnt vmcnt(0)" ::: "memory");
            const unsigned og = xb_add(&bar[XB_TOP], 1u);
            const unsigned tg = og / nx;
            if (og + 1u == (tg + 1u) * nx) xb_add(&bar[XB_TOPGEN], 1u);
            else XB_SPIN(xb_ld(&bar[XB_TOPGEN]) == tg, bar);
            __builtin_amdgcn_fence(__ATOMIC_ACQUIRE, "agent");
            xb_add(&bar[XB_XGEN(b.x)], 1u);
            asm volatile("s_waitcnt vmcnt(0)" ::: "memory");
        } else {
            XB_SPIN(xb_ld(&bar[XB_XGEN(b.x)]) == gen, bar);
            __builtin_amdgcn_fence(__ATOMIC_ACQUIRE, "agent");
            asm volatile("s_waitcnt vmcnt(0)" ::: "memory");
        }
    }
    __syncthreads();
}

constexpr int NWAVES = 8;
constexpr int RING_OFF = 0, RING_BYTES = 131072;
constexpr int LDSCTL_OFF = RING_BYTES, MISC_OFF = LDSCTL_OFF + 320;
constexpr int LDS_BYTES = 147456;
constexpr int CW_BAR = 4096;
constexpr int NPL = 12;
constexpr int PH_PRO = 0, PH_NORM1 = 1, PH_L0 = 2, PH_END = PH_L0 + NL * NPL;
enum { P_G1 = 0, P_QKP = 1, P_HGB = 2, P_HGC = 3, P_ATT = 4, P_G2 = 5, P_G3 = 6, P_N2R = 7, P_TOPK = 8, P_G4 = 9, P_G5 = 10, P_COMB = 11 };

#ifndef KEEP_BF16_QK
#define KEEP_BF16_QK 0
#endif
#ifndef REP_HG
#define REP_HG 1
#endif
#ifndef REP_PRO
#define REP_PRO 1
#endif
#ifndef REP_ROW
#define REP_ROW 1
#endif
#ifndef REP_G
#define REP_G 1
#endif
#ifndef REP_TK
#define REP_TK 1
#endif
#ifndef REP_QK
#define REP_QK 1
#endif
#ifndef REP_ATT
#define REP_ATT 1
#endif
struct Params {
    const float *x, *c, *ada_w, *ada_b, *norm_mix_w, *norm_ffn_w, *w_in, *q_norm_w, *k_norm_w, *hlb, *hg_norm_w, *w_ba, *w_bh, *w_out, *w_router, *w_eg, *w_eu, *w_ed;
    float* out; unsigned char* ws;
    int ph_lo, ph_hi, li, pad;
};
struct Frame {
    LAS unsigned char* lds;
    int tid, lane, wave, vcu, G;
};

__device__ __forceinline__ void tr_tile(const float* __restrict__ src, int ldw, bf16_t* __restrict__ dst, int Kd, LAS float* scr, int lane) {
    f32x4 v[8];
#pragma unroll
    for (int i = 0; i < 8; ++i) v[i] = *(const f32x4*)(src + (size_t)(8 * i + (lane >> 3)) * ldw + 4 * (lane & 7));
#pragma unroll
    for (int i = 0; i < 8; ++i) { LAS float* s = scr + (8 * i + (lane >> 3)) * 33 + 4 * (lane & 7); s[0] = v[i].x; s[1] = v[i].y; s[2] = v[i].z; s[3] = v[i].w; }
    asm volatile("s_waitcnt lgkmcnt(0)" ::: "memory");
    const int cch = lane & 7;
#pragma unroll
    for (int j = 0; j < 4; ++j) { const int n = (lane >> 3) + 8 * j; const LAS float* s = scr + (8 * cch) * 33 + n;
        u32x4 o; o.x = pk2(s[0 * 33], s[1 * 33]); o.y = pk2(s[2 * 33], s[3 * 33]); o.z = pk2(s[4 * 33], s[5 * 33]); o.w = pk2(s[6 * 33], s[7 * 33]);
        *(u32x4*)(dst + (size_t)n * Kd + 8 * cch) = o; }
    asm volatile("s_waitcnt lgkmcnt(0)" ::: "memory");
}
struct ConvItem { const float* src; unsigned char* dst; int ldw, Kd; };
__device__ __forceinline__ ConvItem conv_item_f8(const Params& p, int l, int it) {
    ConvItem c;
    const int which = it / (NE * 1024), r0 = it % (NE * 1024), e = r0 >> 10, r = r0 & 1023;
    if (which < 2) {
        const int kb = r >> 6, nb = r & 63, n0 = 32 * nb;
        const float* W = (which == 0 ? p.w_eg : p.w_eu) + (size_t)(l * NE + e) * D * FF;
        const int rho = e * 4096 + (n0 >> 7) * 256 + which * 128 + (n0 & 127);
        c.src = W + (size_t)(64 * kb) * FF + n0; c.ldw = FF; c.dst = p.ws + WS_WGU + (size_t)l * 64 * MiB + (size_t)rho * D + 64 * kb; c.Kd = D;
    } else {
        const int kb = r >> 5, nb = r & 31, n0 = 32 * nb;
        const float* W = p.w_ed + (size_t)(l * NE + e) * FF * D;
        c.src = W + (size_t)(64 * kb) * D + n0; c.ldw = D; c.dst = p.ws + WS_WD + (size_t)l * 32 * MiB + (size_t)(e * 1024 + n0) * FF + 64 * kb; c.Kd = FF;
    }
    return c;
}
__device__ __forceinline__ void conv_load8(const ConvItem& c, int lane, f32x4 (&v)[8]) {
#pragma unroll
    for (int i = 0; i < 8; ++i) v[i] = *(const f32x4*)(c.src + (size_t)(8 * i + (lane >> 3)) * c.ldw + 4 * (lane & 7));
}
__device__ __forceinline__ void conv_store_f8(const ConvItem& c, int lane, const f32x4 (&v)[8], LAS float* scr, float scale) {
#pragma unroll
    for (int i = 0; i < 8; ++i) { LAS float* s = scr + (8 * i + (lane >> 3)) * 33 + 4 * (lane & 7); s[0] = v[i].x; s[1] = v[i].y; s[2] = v[i].z; s[3] = v[i].w; }
    asm volatile("s_waitcnt lgkmcnt(0)" ::: "memory");
    const int cch = lane & 7;
#pragma unroll
    for (int j = 0; j < 4; ++j) { const int n = (lane >> 3) + 8 * j; const LAS float* s = scr + (8 * cch) * 33 + n;
        const f32x4 a = {s[0 * 33] * scale, s[1 * 33] * scale, s[2 * 33] * scale, s[3 * 33] * scale}, b = {s[4 * 33] * scale, s[5 * 33] * scale, s[6 * 33] * scale, s[7 * 33] * scale};
        *(u32x2*)(c.dst + (size_t)n * c.Kd + 8 * cch) = pg8::pack8_fp8(a, b); }
    asm volatile("s_waitcnt lgkmcnt(0)" ::: "memory");
}
struct BgNone { __device__ __forceinline__ void step() {} };
struct BgConv {
    const float *eg, *eu, *ed; unsigned char* ws; LAS unsigned char* scr; int lane, it, stride, nit, l; bool have; ConvItem cur; f32x4 v[4];
    __device__ __forceinline__ ConvItem item(int i) const {
        ConvItem c; const int it_ = i;
        const int which = it_ / (NE * 2048), r0 = it_ % (NE * 2048), e = r0 >> 11, r = r0 & 2047;
        if (which < 2) { const int kb = r >> 6, nb = r & 63, n0 = 32 * nb; const float* W = (which == 0 ? eg : eu) + (size_t)(l * NE + e) * D * FF;
            const int rho = e * 4096 + (n0 >> 7) * 256 + which * 128 + (n0 & 127);
            c.src = W + (size_t)(32 * kb) * FF + n0; c.ldw = FF; c.dst = ws + WS_WGU + (size_t)l * 64 * MiB + (size_t)rho * D + 32 * kb; c.Kd = D; }
        else { const int kb = r >> 5, nb = r & 31, n0 = 32 * nb; const float* W = ed + (size_t)(l * NE + e) * FF * D;
            c.src = W + (size_t)(32 * kb) * D + n0; c.ldw = D; c.dst = ws + WS_WD + (size_t)l * 32 * MiB + (size_t)(e * 1024 + n0) * FF + 32 * kb; c.Kd = FF; }
        return c; }
    __device__ __forceinline__ void load(const ConvItem& c) {
#pragma unroll
        for (int i = 0; i < 4; ++i) v[i] = *(const GAS f32x4*)((const GAS float*)c.src + (size_t)(8 * i + (lane >> 3)) * c.ldw + 4 * (lane & 7));
    }
    __device__ __forceinline__ void init(const Params& p, int layer, LAS unsigned char* scr_, int lane_, int gw, int ngw) {
        eg = p.w_eg; eu = p.w_eu; ed = p.w_ed; ws = p.ws; l = layer; scr = scr_; lane = lane_; it = gw; stride = ngw; nit = 3 * NE * 2048; have = it < nit;
        if (have) { cur = item(it); load(cur); }
    }
    __device__ __forceinline__ void process(const ConvItem& c, const f32x4 (&w)[4]) {
        LAS unsigned* s32 = (LAS unsigned*)scr;
#pragma unroll
        for (int i = 0; i < 4; ++i) { int wd; asm volatile("" : "=v"(wd)); wd = __builtin_amdgcn_cvt_pk_fp8_f32(w[i].x * 64.0f, w[i].y * 64.0f, wd, false); wd = __builtin_amdgcn_cvt_pk_fp8_f32(w[i].z * 64.0f, w[i].w * 64.0f, wd, true);
            s32[(8 * i + (lane >> 3)) * 10 + (lane & 7)] = (unsigned)wd; }
        asm volatile("s_waitcnt lgkmcnt(0)" ::: "memory");
        typedef int v2i_ __attribute__((ext_vector_type(2)));
        const int gq = lane >> 4, i16 = lane & 15;
#pragma unroll
        for (int nh = 0; nh < 2; ++nh) {
            const v2i_ r = __builtin_amdgcn_ds_read_tr8_b64_v2i32((LAS v2i_*)(scr + (8 * gq + (i16 >> 1)) * 40 + 16 * nh + 8 * (i16 & 1)));
            u32x2 o; o.x = (unsigned)r.x; o.y = (unsigned)r.y;
            *(GAS u32x2*)((GAS unsigned char*)c.dst + (size_t)(16 * nh + i16) * c.Kd + 8 * gq) = o; }
        asm volatile("s_waitcnt lgkmcnt(0)" ::: "memory");
    }
    __device__ __forceinline__ void step() {
        if (!have) return;
        const ConvItem c = cur; f32x4 w[4];
#pragma unroll
        for (int i = 0; i < 4; ++i) w[i] = v[i];
        it += stride; have = it < nit;
        if (have) { cur = item(it); load(cur); }
        process(c, w);
    }
    __device__ __forceinline__ void finish() { while (have) step(); }
};
__device__ __forceinline__ void conv_experts_f8(Frame& F, const Params& p, int l, LAS float* scr) {
    const int gw = F.vcu * NWAVES + F.wave, NGW = F.G * NWAVES, NIT = 3 * NE * 1024;
    int it = gw; if (it >= NIT) return;
    ConvItem cur = conv_item_f8(p, l, it); f32x4 va[8], vb[8];
    conv_load8(cur, F.lane, va);
    for (;;) {
        const int it1 = it + NGW; const bool h1 = it1 < NIT; ConvItem c1 = conv_item_f8(p, l, h1 ? it1 : it);
        if (h1) conv_load8(c1, F.lane, vb);
        conv_store_f8(cur, F.lane, va, scr, 64.0f);
        if (!h1) break;
        const int it2 = it1 + NGW; const bool h2 = it2 < NIT; ConvItem c2 = conv_item_f8(p, l, h2 ? it2 : it1);
        if (h2) conv_load8(c2, F.lane, va);
        conv_store_f8(c1, F.lane, vb, scr, 64.0f);
        if (!h2) break;
        cur = c2; it = it2;
    }
}
__device__ __forceinline__ void conv_matrix(Frame& F, const float* W, int ldw, int K, int N, bf16_t* WT, LAS float* scr) {
    const int gw = F.vcu * NWAVES + F.wave, NGW = F.G * NWAVES, nblk = N / 32, nitems = (K / 64) * nblk;
    for (int it = gw; it < nitems; it += NGW) { const int kb = it / nblk, nb = it % nblk;
        tr_tile(W + (size_t)(64 * kb) * ldw + 32 * nb, ldw, WT + (size_t)(32 * nb) * K + 64 * kb, K, scr, F.lane); }
}
__device__ __forceinline__ void conv_matrix_f8(Frame& F, const float* W, int ldw, int K, int N, unsigned char* WT, LAS float* scr, float scale) {
    const int gw = F.vcu * NWAVES + F.wave, NGW = F.G * NWAVES, nblk = N / 32, nitems = (K / 64) * nblk;
    for (int it = gw; it < nitems; it += NGW) { const int kb = it / nblk, nb = it % nblk;
        ConvItem c; c.src = W + (size_t)(64 * kb) * ldw + 32 * nb; c.ldw = ldw; c.dst = WT + (size_t)(32 * nb) * K + 64 * kb; c.Kd = K;
        f32x4 v[8]; conv_load8(c, F.lane, v); conv_store_f8(c, F.lane, v, scr, scale); }
}
__device__ __forceinline__ void conv_experts(Frame& F, const Params& p, int l, LAS float* scr) {
    const int gw = F.vcu * NWAVES + F.wave, NGW = F.G * NWAVES;
    bf16_t* WGU = (bf16_t*)(p.ws + WS_WGU); bf16_t* WD = (bf16_t*)(p.ws + WS_WD);
    for (int it = gw; it < 3 * NE * 1024; it += NGW) {
        const int which = it / (NE * 1024), r0 = it % (NE * 1024), e = r0 >> 10, r = r0 & 1023;
        if (which < 2) {
            const int kb = r >> 6, nb = r & 63, n0 = 32 * nb;
            const float* W = (which == 0 ? p.w_eg : p.w_eu) + (size_t)(l * NE + e) * D * FF;
            const int rho = e * 4096 + (n0 >> 7) * 256 + which * 128 + (n0 & 127);
            tr_tile(W + (size_t)(64 * kb) * FF + n0, FF, WGU + (size_t)rho * D + 64 * kb, D, scr, F.lane);
        } else {
            const int kb = r >> 5, nb = r & 31, n0 = 32 * nb;
            const float* W = p.w_ed + (size_t)(l * NE + e) * FF * D;
            tr_tile(W + (size_t)(64 * kb) * D + n0, D, WD + (size_t)(e * 1024 + n0) * FF + 64 * kb, FF, scr, F.lane);
        }
    }
}
__device__ __forceinline__ void mod_units(Frame& F, const Params& p) {
    LAS float* sc = (LAS float*)(F.lds + 96 * 1024);
    LAS float* red = sc + 1024;
    float* MOD = (float*)(p.ws + WS_MOD); float* LBV = (float*)(p.ws + WS_LBV);
    for (int u = blockIdx.x; u < NL * 96; u += F.G) {
        for (int i = F.tid; i < D; i += 512) sc[i] = siluf_(p.c[i]);
        __syncthreads();
        const int l = u / 96, j = (u % 96) * 64 + (F.tid & 63), kp = F.tid >> 6;
        const float* w = p.ada_w + (size_t)l * D * 6 * D + (size_t)(kp * 128) * 6 * D + j;
        float acc = 0.f;
#pragma unroll 8
        for (int k = 0; k < 128; ++k) acc += sc[kp * 128 + k] * w[(size_t)k * 6 * D];
        red[kp * 64 + (F.tid & 63)] = acc;
        __syncthreads();
        if (F.tid < 64) { float s = 0.f;
#pragma unroll
            for (int q = 0; q < 8; ++q) s += red[q * 64 + F.tid];
            MOD[l * 6 * D + j] = s + p.ada_b[l * 6 * D + j]; }
        __syncthreads();
    }
    const int n = blockIdx.x * 512 + F.tid;
    if (n < NL * 1024) { const int l = n / 1024, r = n % 1024; float v = 0.f;
        if (l == 1) { const float b0 = p.hlb[r], b1 = p.hlb[1024 + r]; v = 1.0f / (1.0f + __expf(b0 - b1)); }
        LBV[n] = v; }
}

__device__ __forceinline__ void norm_mod_row(const f32x4 (&v)[4], float ss, const float* __restrict__ w, const float* __restrict__ scale,
                                             const float* __restrict__ shift, bf16_t* __restrict__ orow, int lane, f32x4 (&h)[4], unsigned char* __restrict__ orow8 = nullptr) {
    const float r = rsqrtf(ss * (1.0f / D) + EPS);
#pragma unroll
    for (int j = 0; j < 4; ++j) {
        const int c0 = 4 * lane + 256 * j;
        const f32x4 wv = *(const f32x4*)(w + c0), sv = *(const f32x4*)(scale + c0), bv = *(const f32x4*)(shift + c0);
        h[j] = (v[j] * r) * wv * (sv + 1.0f) + bv;
        u32x2 o; o.x = pk2(h[j].x, h[j].y); o.y = pk2(h[j].z, h[j].w);
        *(u32x2*)(orow + c0) = o;
        if (orow8) { int wd = 0; wd = __builtin_amdgcn_cvt_pk_fp8_f32(h[j].x, h[j].y, wd, false); wd = __builtin_amdgcn_cvt_pk_fp8_f32(h[j].z, h[j].w, wd, true); *(int*)(orow8 + c0) = wd; }
    }
}
__device__ __forceinline__ void norm_mod_row_f8(const f32x4 (&v)[4], float ss, const float* __restrict__ w, const float* __restrict__ scale,
                                                const float* __restrict__ shift, unsigned char* __restrict__ orow, int lane, f32x4 (&h)[4]) {
    const float r = rsqrtf(ss * (1.0f / D) + EPS);
#pragma unroll
    for (int j = 0; j < 4; ++j) {
        const int c0 = 4 * lane + 256 * j;
        const f32x4 wv = *(const f32x4*)(w + c0), sv = *(const f32x4*)(scale + c0), bv = *(const f32x4*)(shift + c0);
        h[j] = (v[j] * r) * wv * (sv + 1.0f) + bv;
        int wd = 0; wd = __builtin_amdgcn_cvt_pk_fp8_f32(h[j].x, h[j].y, wd, false); wd = __builtin_amdgcn_cvt_pk_fp8_f32(h[j].z, h[j].w, wd, true);
        *(int*)(orow + c0) = wd;
    }
}
__device__ __forceinline__ void ph_norm1(Frame& F, const float* x, const float* w, const float* scale, const float* shift, bf16_t* HB, unsigned char* HB8) {
    const int gw = F.vcu * NWAVES + F.wave, NGW = F.G * NWAVES;
    for (int row = gw; row < S; row += NGW) {
        const f32x4* xr = (const f32x4*)(x + (size_t)row * D) + F.lane;
        f32x4 v[4], h[4]; float ss = 0.f;
#pragma unroll
        for (int j = 0; j < 4; ++j) { v[j] = xr[64 * j]; ss += (v[j].x * v[j].x + v[j].y * v[j].y) + (v[j].z * v[j].z + v[j].w * v[j].w); }
        ss = wave_sum(ss);
        norm_mod_row(v, ss, w, scale, shift, HB + (size_t)row * D, F.lane, h);
    }
}
__device__ __forceinline__ void ph_gather(Frame& F, const unsigned char* HB8, const int* IDX, unsigned char* XE8) {
    const int gw = F.vcu * NWAVES + F.wave, NGW = F.G * NWAVES;
    constexpr int PER = NE * CAP / 2048;
    if (NGW * PER == NE * CAP) {
        const int r0 = gw * PER;
        const int mine = IDX[r0 + (F.lane & 15)];
#pragma unroll
        for (int q = 0; q < PER; q += 8) {
            u32x4 a[8];
#pragma unroll
            for (int k = 0; k < 8; ++k) { const int t = __builtin_amdgcn_readlane(mine, q + k); a[k] = ((const u32x4*)(HB8 + (size_t)t * D))[F.lane]; }
#pragma unroll
            for (int k = 0; k < 8; ++k) ((u32x4*)(XE8 + (size_t)(r0 + q + k) * D))[F.lane] = a[k];
        }
    } else {
        for (int r = gw; r < NE * CAP; r += NGW) { const int t = IDX[r]; ((u32x4*)(XE8 + (size_t)r * D))[F.lane] = ((const u32x4*)(HB8 + (size_t)t * D))[F.lane]; }
    }
}

#define OPAQUE_LANE() const int lane = lane_id_opaque(); const int t_ = F.wave * 64 + lane
__device__ __forceinline__ void ph_rope_table(Frame& F, float* ROPE) {
    OPAQUE_LANE();
    const int n = blockIdx.x * 512 + t_;
    if (n < 4096) { const int pos = n >> 4, i = n & 15; const float inv = exp2f(-(float)i * (13.287712379549449f / 16.0f)); float sn, cs; sincosf((float)pos * inv, &sn, &cs); ROPE[2 * n] = cs; ROPE[2 * n + 1] = sn; }
}
__device__ __forceinline__ void ph_qkprep(Frame& F, const bf16_t* __restrict__ QR, const bf16_t* __restrict__ KR, const float* __restrict__ qw, const float* __restrict__ kw,
                                          const float* __restrict__ ROPE, bf16_t* __restrict__ QN, bf16_t* __restrict__ KN, unsigned char* __restrict__ Q8, unsigned char* __restrict__ K8, int rank, int nranks) {
    OPAQUE_LANE(); (void)lane;
    if (rank < 0) return;
    for (int gid = rank * 512 + t_; gid < S * 10; gid += nranks * 512) {
        const int t = gid / 10, hh = gid % 10;
        const bool isq = hh < 8;
        const bf16_t* src = isq ? QR + (size_t)t * 512 + hh * 64 : KR + (size_t)t * 128 + (hh - 8) * 64;
        bf16_t* dst = isq ? QN + (size_t)t * 512 + hh * 64 : KN + (size_t)t * 128 + (hh - 8) * 64;
        const float* w = isq ? qw : kw;
        float f[64]; float ss = 0.f;
#pragma unroll
        for (int i = 0; i < 8; ++i) { const u32x4 q = *(const u32x4*)(src + 8 * i);
#pragma unroll
            for (int j = 0; j < 4; ++j) { f[8 * i + 2 * j] = bflo(q[j]); f[8 * i + 2 * j + 1] = bfhi(q[j]); } }
#pragma unroll
        for (int i = 0; i < 64; ++i) ss += f[i] * f[i];
        const float rn = rsqrtf(ss * (1.0f / 64.0f) + EPS), sc = isq ? C2 : 1.0f;
#pragma unroll
        for (int i = 0; i < 16; ++i) { const f32x4 wv = *(const f32x4*)(w + 4 * i);
            f[4 * i] *= rn * wv.x; f[4 * i + 1] *= rn * wv.y; f[4 * i + 2] *= rn * wv.z; f[4 * i + 3] *= rn * wv.w; }
        float o[64];
#pragma unroll
        for (int ax = 0; ax < 2; ++ax) {
            const float* tb = ROPE + (size_t)(ax == 0 ? (t >> 6) : (t & 63)) * 32;
#pragma unroll
            for (int i2 = 0; i2 < 8; ++i2) { const f32x4 cs = *(const f32x4*)(tb + 4 * i2);
#pragma unroll
                for (int k = 0; k < 2; ++k) { const int i = 2 * i2 + k; const float c_ = k ? cs.z : cs.x, s_ = k ? cs.w : cs.y;
                    const float x1 = f[ax * 32 + i], x2 = f[ax * 32 + 16 + i];
                    o[ax * 32 + i] = (x1 * c_ - x2 * s_) * sc; o[ax * 32 + 16 + i] = (x2 * c_ + x1 * s_) * sc; } }
        }
#if KEEP_BF16_QK
#pragma unroll
        for (int i = 0; i < 8; ++i) { u32x4 q;
#pragma unroll
            for (int j = 0; j < 4; ++j) q[j] = pk2(o[8 * i + 2 * j], o[8 * i + 2 * j + 1]);
            *(u32x4*)(dst + 8 * i) = q; }
#else
        (void)dst;
#endif
        unsigned char* dst8 = isq ? Q8 + (size_t)t * 512 + hh * 64 : K8 + (size_t)t * 128 + (hh - 8) * 64;
#pragma unroll
        for (int i = 0; i < 4; ++i) { u32x4 q;
#pragma unroll
            for (int j = 0; j < 4; ++j) { int wd = 0; wd = __builtin_amdgcn_cvt_pk_fp8_f32(o[16 * i + 4 * j], o[16 * i + 4 * j + 1], wd, false); wd = __builtin_amdgcn_cvt_pk_fp8_f32(o[16 * i + 4 * j + 2], o[16 * i + 4 * j + 3], wd, true); q[j] = (unsigned)wd; }
            *(u32x4*)(dst8 + 16 * i) = q; }
    }
}
__device__ __forceinline__ void ph_v8t(Frame& F, const bf16_t* __restrict__ VV, unsigned char* __restrict__ V8T) {
    OPAQUE_LANE();
    const int gw = F.vcu * NWAVES + F.wave, NGW = F.G * NWAVES;
    for (int it = gw; it < 2 * (S / 64); it += NGW) {
        const int kvh = it / (S / 64), tile = it % (S / 64);
        const bf16_t* src = VV + (size_t)(64 * tile) * 128 + kvh * 64 + lane;
        u32x4 ov[4];
#pragma unroll
        for (int hi = 0; hi < 2; ++hi)
#pragma unroll
            for (int k = 0; k < 8; ++k) {
                float v[4];
#pragma unroll
                for (int b = 0; b < 4; ++b) { const int j = 4 * k + b; const int key = j < 16 ? ((j & 3) + 8 * (j >> 2) + 4 * hi) : 32 + (((j - 16) & 3) + 8 * ((j - 16) >> 2) + 4 * hi); v[b] = bf2f(src[(size_t)key * 128]); }
                int wd = 0; wd = __builtin_amdgcn_cvt_pk_fp8_f32(v[0], v[1], wd, false); wd = __builtin_amdgcn_cvt_pk_fp8_f32(v[2], v[3], wd, true);
                ov[hi * 2 + (k >> 2)][k & 3] = (unsigned)wd;
            }
        unsigned char* dst = V8T + ((size_t)it * 64 + lane) * 64;
#pragma unroll
        for (int q = 0; q < 4; ++q) *(u32x4*)(dst + 16 * q) = ov[q];
    }
}
__device__ __forceinline__ void ph_hgfin(Frame& F, const float* __restrict__ OF, const bf16_t* __restrict__ HG, const float* __restrict__ w, bf16_t* __restrict__ OHG) {
    OPAQUE_LANE();
    const int gw = F.vcu * NWAVES + F.wave, NGW = F.G * NWAVES;
    const int e0 = (lane & 15) * 8;
    const f32x4 w0 = *(const f32x4*)(w + e0), w1 = *(const f32x4*)(w + e0 + 4);
    for (int t = gw; t < S; t += NGW) {
        const size_t off = (size_t)t * 512 + lane * 8;
        const f32x4 a0 = *(const f32x4*)(OF + off), a1 = *(const f32x4*)(OF + off + 4), b0 = *(const f32x4*)(OF + (size_t)S * 512 + off), b1 = *(const f32x4*)(OF + (size_t)S * 512 + off + 4);
        const f32x4 s0 = a0 + b0, s1 = a1 + b1;
        float ss = (s0.x * s0.x + s0.y * s0.y) + (s0.z * s0.z + s0.w * s0.w) + (s1.x * s1.x + s1.y * s1.y) + (s1.z * s1.z + s1.w * s1.w);
        ss += __shfl_xor(ss, 1); ss += __shfl_xor(ss, 2); ss += __shfl_xor(ss, 4); ss += __shfl_xor(ss, 8);
        const float r = rsqrtf(ss * (1.0f / 128.0f) + EPS);
        const u32x4 g = *(const u32x4*)(HG + off);
        u32x4 o;
        o.x = pk2(s0.x * r * w0.x * bflo(g.x), s0.y * r * w0.y * bfhi(g.x));
        o.y = pk2(s0.z * r * w0.z * bflo(g.y), s0.w * r * w0.w * bfhi(g.y));
        o.z = pk2(s1.x * r * w1.x * bflo(g.z), s1.y * r * w1.y * bfhi(g.z));
        o.w = pk2(s1.z * r * w1.z * bflo(g.w), s1.w * r * w1.w * bfhi(g.w));
        *(u32x4*)(OHG + off) = o;
    }
}
__device__ __forceinline__ void ph_norm2_router(Frame& F, const float* __restrict__ X1, const float* __restrict__ w, const float* __restrict__ scale, const float* __restrict__ shift,
                                                const float* __restrict__ wr, unsigned char* __restrict__ HB, float* __restrict__ AFF) {
    OPAQUE_LANE();
    LAS float* WT = (LAS float*)F.lds;
    for (int dd = t_; dd < D; dd += NWAVES * 64) {
        const GAS f32x4* s = (const GAS f32x4*)((const GAS float*)wr + (size_t)dd * 16);
        const f32x4 a = s[0], b = s[1], c = s[2], e = s[3];
        WT[0 * D + dd] = a.x; WT[1 * D + dd] = a.y; WT[2 * D + dd] = a.z; WT[3 * D + dd] = a.w; WT[4 * D + dd] = b.x; WT[5 * D + dd] = b.y; WT[6 * D + dd] = b.z; WT[7 * D + dd] = b.w;
        WT[8 * D + dd] = c.x; WT[9 * D + dd] = c.y; WT[10 * D + dd] = c.z; WT[11 * D + dd] = c.w; WT[12 * D + dd] = e.x; WT[13 * D + dd] = e.y; WT[14 * D + dd] = e.z; WT[15 * D + dd] = e.w;
    }
    __syncthreads();
    const int gw = F.vcu * NWAVES + F.wave, NGW = F.G * NWAVES;
    for (int row = gw; row < S; row += 2 * NGW) {
        const int row1 = (row + NGW < S) ? row + NGW : row;
        const f32x4* xr0 = (const f32x4*)(X1 + (size_t)row * D) + lane; const f32x4* xr1 = (const f32x4*)(X1 + (size_t)row1 * D) + lane;
        f32x4 v0[4], v1[4], h0[4], h1[4]; float ss0 = 0.f, ss1 = 0.f;
#pragma unroll
        for (int j = 0; j < 4; ++j) { v0[j] = xr0[64 * j]; v1[j] = xr1[64 * j]; }
#pragma unroll
        for (int j = 0; j < 4; ++j) { ss0 += (v0[j].x * v0[j].x + v0[j].y * v0[j].y) + (v0[j].z * v0[j].z + v0[j].w * v0[j].w); ss1 += (v1[j].x * v1[j].x + v1[j].y * v1[j].y) + (v1[j].z * v1[j].z + v1[j].w * v1[j].w); }
        ss0 = wave_sum(ss0); ss1 = wave_sum(ss1);
        norm_mod_row_f8(v0, ss0, w, scale, shift, HB + (size_t)row * D, lane, h0);
        norm_mod_row_f8(v1, ss1, w, scale, shift, HB + (size_t)row1 * D, lane, h1);
        LAS float* wt = WT + 4 * lane; asm volatile("" : "+v"(wt));
        f32x4 lg0[4], lg1[4];
#pragma unroll
        for (int e = 0; e < 16; ++e) {
            float a0 = 0.f, a1 = 0.f;
#pragma unroll
            for (int j = 0; j < 4; ++j) { const f32x4 ww = *(const LAS f32x4*)(wt + e * D + 256 * j);
                a0 += (h0[j].x * ww.x + h0[j].y * ww.y) + (h0[j].z * ww.z + h0[j].w * ww.w); a1 += (h1[j].x * ww.x + h1[j].y * ww.y) + (h1[j].z * ww.z + h1[j].w * ww.w); }
            lg0[e >> 2][e & 3] = wave_sum(a0); lg1[e >> 2][e & 3] = wave_sum(a1);
        }
#pragma unroll
        for (int rr = 0; rr < 2; ++rr) {
            f32x4 (&lgv)[4] = rr ? lg1 : lg0;
            float mx = -1e30f;
#pragma unroll
            for (int e4 = 0; e4 < 4; ++e4) mx = fmaxf(mx, fmaxf(fmaxf(lgv[e4].x, lgv[e4].y), fmaxf(lgv[e4].z, lgv[e4].w)));
            float den = 0.f;
#pragma unroll
            for (int e4 = 0; e4 < 4; ++e4) { lgv[e4].x = __expf(lgv[e4].x - mx); lgv[e4].y = __expf(lgv[e4].y - mx); lgv[e4].z = __expf(lgv[e4].z - mx); lgv[e4].w = __expf(lgv[e4].w - mx);
                den += (lgv[e4].x + lgv[e4].y) + (lgv[e4].z + lgv[e4].w); }
            const float inv = 1.0f / den;
            const f32x4 s8a = (lane & 8) ? lgv[2] : lgv[0], s8b = (lane & 8) ? lgv[3] : lgv[1];
            const f32x4 s4 = (lane & 4) ? s8b : s8a;
            const float s2a = (lane & 2) ? s4.z : s4.x, s2b = (lane & 2) ? s4.w : s4.y;
            const float mine = ((lane & 1) ? s2b : s2a) * inv;
            const int rw = rr ? row1 : row;
            if (lane < 16 && (rr == 0 || row1 != row)) AFF[(size_t)lane * S + rw] = mine;
        }
    }
    __syncthreads();
}
__device__ __forceinline__ void ph_topk(Frame& F, LAS unsigned char* lds, int e, const float* __restrict__ AFF, int* __restrict__ IDX, float* __restrict__ TOPW, int* __restrict__ SLOT) {
    LAS unsigned* hist = (LAS unsigned*)lds;
    LAS unsigned* hsum = hist + 4096;
    LAS unsigned* shv = hsum + 256;
    LAS unsigned* scan = hsum + 512;
    OPAQUE_LANE(); const int tid = t_;
    const unsigned* vals = (const unsigned*)(AFF + (size_t)e * S);
    unsigned u[32];
#pragma unroll
    for (int i = 0; i < 8; ++i) { const u32x4 q = *(const u32x4*)(vals + tid * 32 + 4 * i); u[4 * i] = q.x; u[4 * i + 1] = q.y; u[4 * i + 2] = q.z; u[4 * i + 3] = q.w; }
    if (tid == 0) { shv[0] = 0u; shv[1] = CAP; }
    LAS unsigned* myh = hist + (lane & 15) * 256;
    __syncthreads();
    for (int pass = 3; pass >= 0; --pass) {
        const int shift = pass * 8;
        const unsigned mask = pass == 3 ? 0u : (0xFFFFFFFFu << (shift + 8));
#pragma unroll
        for (int i = 0; i < 8; ++i) hist[tid + 512 * i] = 0u;
        __syncthreads();
        const unsigned prefix = shv[0];
#pragma unroll
        for (int i = 0; i < 32; ++i) if ((u[i] & mask) == (prefix & mask)) __hip_atomic_fetch_add(&myh[(u[i] >> shift) & 255u], 1u, __ATOMIC_RELAXED, __HIP_MEMORY_SCOPE_WORKGROUP);
        __syncthreads();
        if (tid < 256) { unsigned s = 0u;
#pragma unroll
            for (int c = 0; c < 16; ++c) s += hist[c * 256 + tid];
            hsum[tid] = s; }
        __syncthreads();
        if (tid < 64) {
            const unsigned kk = shv[1];
            const unsigned h0 = hsum[4 * lane], h1 = hsum[4 * lane + 1], h2 = hsum[4 * lane + 2], h3 = hsum[4 * lane + 3];
            const unsigned tot = (h0 + h1) + (h2 + h3);
            unsigned inc = tot;
#pragma unroll
            for (int o = 1; o < 64; o <<= 1) { const unsigned v = __shfl_down(inc, o); if (lane + o < 64) inc += v; }
            unsigned c = inc - tot; int bin = -1; unsigned rem = 0u;
            if (c < kk && c + h3 >= kk) { bin = 4 * lane + 3; rem = kk - c; } c += h3;
            if (c < kk && c + h2 >= kk) { bin = 4 * lane + 2; rem = kk - c; } c += h2;
            if (c < kk && c + h1 >= kk) { bin = 4 * lane + 1; rem = kk - c; } c += h1;
            if (c < kk && c + h0 >= kk) { bin = 4 * lane; rem = kk - c; }
            if (bin >= 0) { shv[1] = rem; shv[0] = prefix | ((unsigned)bin << shift); }
        }
        __syncthreads();
    }
    const unsigned T = shv[0], need_eq = shv[1];
    unsigned ceq = 0u;
#pragma unroll
    for (int i = 0; i < 32; ++i) ceq += (u[i] == T) ? 1u : 0u;
    scan[tid] = ceq; __syncthreads();
    for (int off = 1; off < 512; off <<= 1) { const unsigned tv = tid >= off ? scan[tid - off] : 0u; __syncthreads(); scan[tid] += tv; __syncthreads(); }
    unsigned eq_rank = scan[tid] - ceq;
    __syncthreads();
    unsigned selmask = 0u, csel = 0u;
#pragma unroll
    for (int i = 0; i < 32; ++i) { bool sel = u[i] > T; if (u[i] == T) { sel = eq_rank < need_eq; ++eq_rank; } if (sel) { selmask |= 1u << i; ++csel; } }
    scan[tid] = csel; __syncthreads();
    for (int off = 1; off < 512; off <<= 1) { const unsigned tv = tid >= off ? scan[tid - off] : 0u; __syncthreads(); scan[tid] += tv; __syncthreads(); }
    unsigned slot = scan[tid] - csel;
#pragma unroll
    for (int i = 0; i < 32; ++i) {
        const int t = tid * 32 + i; int sl = -1;
        if (selmask & (1u << i)) { sl = (int)slot; ++slot; if (sl < CAP) { IDX[e * CAP + sl] = t; TOPW[e * CAP + sl] = __uint_as_float(u[i]); } }
        SLOT[(size_t)e * S + t] = sl < CAP ? sl : -1;
    }
    __syncthreads();
}
__device__ __forceinline__ void ph_combine(Frame& F, const float* __restrict__ X1, const bf16_t* __restrict__ YE, const int* __restrict__ SLOT, const float* __restrict__ gate,
                                           float* __restrict__ xout, const float* __restrict__ w, const float* __restrict__ scale, const float* __restrict__ shift, bf16_t* __restrict__ HB, unsigned char* __restrict__ HB8, bool do_norm) {
    OPAQUE_LANE();
    const int gw = F.vcu * NWAVES + F.wave, NGW = F.G * NWAVES;
    for (int row = gw; row < S; row += 2 * NGW) {
        const bool two = row + NGW < S; const int row1 = two ? row + NGW : row;
        const int sl0 = lane < NE ? SLOT[(size_t)lane * S + row] : -1, sl1 = lane < NE ? SLOT[(size_t)lane * S + row1] : -1;
        const f32x4* xr0 = (const f32x4*)(X1 + (size_t)row * D) + lane; const f32x4* xr1 = (const f32x4*)(X1 + (size_t)row1 * D) + lane;
        f32x4 v0[4], v1[4];
#pragma unroll
        for (int j = 0; j < 4; ++j) { v0[j] = xr0[64 * j]; v1[j] = xr1[64 * j]; }
        f32x4 acc0[4], acc1[4];
#pragma unroll
        for (int j = 0; j < 4; ++j) { acc0[j] = f32x4{0.f, 0.f, 0.f, 0.f}; acc1[j] = acc0[j]; }
        unsigned m0 = (unsigned)__ballot(sl0 >= 0) & 0xffffu, m1 = (unsigned)__ballot(sl1 >= 0) & 0xffffu;
        while (m0 | m1) {
            const int e0 = m0 ? __builtin_ctz(m0) : 0, e1 = m1 ? __builtin_ctz(m1) : 0;
            const float f0 = m0 ? 1.f : 0.f, f1 = m1 ? 1.f : 0.f;
            const int s0 = m0 ? __builtin_amdgcn_readlane(sl0, e0) : 0, s1 = m1 ? __builtin_amdgcn_readlane(sl1, e1) : 0;
            m0 &= m0 - 1u; m1 &= m1 - 1u;
            const bf16_t* y0 = YE + ((size_t)e0 * CAP + s0) * D + 4 * lane; const bf16_t* y1 = YE + ((size_t)e1 * CAP + s1) * D + 4 * lane;
            u32x2 q0[4], q1[4];
#pragma unroll
            for (int j = 0; j < 4; ++j) { q0[j] = *(const u32x2*)(y0 + 256 * j); q1[j] = *(const u32x2*)(y1 + 256 * j); }
#pragma unroll
            for (int j = 0; j < 4; ++j) { acc0[j].x += f0 * bflo(q0[j].x); acc0[j].y += f0 * bfhi(q0[j].x); acc0[j].z += f0 * bflo(q0[j].y); acc0[j].w += f0 * bfhi(q0[j].y);
                                          acc1[j].x += f1 * bflo(q1[j].x); acc1[j].y += f1 * bfhi(q1[j].x); acc1[j].z += f1 * bflo(q1[j].y); acc1[j].w += f1 * bfhi(q1[j].y); }
        }
        f32x4 h[4]; float ss0 = 0.f, ss1 = 0.f;
#pragma unroll
        for (int j = 0; j < 4; ++j) { const f32x4 gv = *(const f32x4*)(gate + 4 * lane + 256 * j); v0[j] = v0[j] + gv * acc0[j]; v1[j] = v1[j] + gv * acc1[j];
            ((f32x4*)(xout + (size_t)row * D) + lane)[64 * j] = v0[j]; if (two) ((f32x4*)(xout + (size_t)row1 * D) + lane)[64 * j] = v1[j];
            ss0 += (v0[j].x * v0[j].x + v0[j].y * v0[j].y) + (v0[j].z * v0[j].z + v0[j].w * v0[j].w); ss1 += (v1[j].x * v1[j].x + v1[j].y * v1[j].y) + (v1[j].z * v1[j].z + v1[j].w * v1[j].w); }
        if (do_norm) { ss0 = wave_sum(ss0); ss1 = wave_sum(ss1); norm_mod_row(v0, ss0, w, scale, shift, HB + (size_t)row * D, lane, h); if (two) norm_mod_row(v1, ss1, w, scale, shift, HB + (size_t)row1 * D, lane, h); }
    }
}

__global__ void __launch_bounds__(NWAVES * 64, 2) mega(Params p) {
    extern __shared__ __attribute__((aligned(16))) unsigned char lds[];
    Frame F;
    F.lds = (LAS unsigned char*)lds;
    volatile LAS unsigned* MISC = (volatile LAS unsigned*)(F.lds + MISC_OFF);
    F.tid = threadIdx.x; F.lane = F.tid & 63; F.wave = __builtin_amdgcn_readfirstlane(F.tid >> 6);
    F.G = gridDim.x; { const int bx = blockIdx.x; F.vcu = (F.G % 8 == 0) ? (bx % 8) * (F.G / 8) + bx / 8 : bx; }
    unsigned char* ws = p.ws;
    unsigned* ctl = (unsigned*)(ws + WS_CTL);
    for (int u = F.tid; u < (LDS_BYTES - LDSCTL_OFF) / 4; u += NWAVES * 64) ((LAS unsigned*)(F.lds + LDSCTL_OFF))[u] = 0u;
    __syncthreads();
    XcdBarrier bar = xcd_barrier_post(ctl + CW_BAR + p.li * XCD_BAR_WORDS, MISC + 8);
    const int lo = p.ph_lo, hi = p.ph_hi;
#define IN(k) (lo <= (k) && (k) < hi)
#define SEAM(k) do { if (IN(k) && IN((k) + 1)) xcd_barrier(bar); } while (0)
#define REFRESH() do { F.lane = lane_id_opaque(); F.tid = F.wave * 64 + F.lane; } while (0)

#define WSP(T, off) ((T*)(GAS T*)(wsl + (off)))
#define WSL() GAS unsigned char* wsl = (GAS unsigned char*)p.ws; asm volatile("" : "+s"(wsl))
    LAS float* scr = (LAS float*)(F.lds + RING_OFF + F.wave * 8704);

    if (IN(PH_PRO)) { REFRESH(); WSL();
        mod_units(F, p);
        for (int l = 0; l < NL; ++l) {
            conv_matrix(F, p.w_in + (size_t)l * D * INW, INW, D, INW, WSP(bf16_t, WS_WIN) + (size_t)l * INW * D, scr);
            conv_matrix(F, p.w_ba + (size_t)l * 512 * D, D, 512, D, WSP(bf16_t, WS_WBA) + (size_t)l * D * 512, scr);
            conv_matrix(F, p.w_bh + (size_t)l * 512 * D, D, 512, D, WSP(bf16_t, WS_WBH) + (size_t)l * D * 512, scr);
            conv_matrix(F, p.w_out + (size_t)l * D * D, D, D, D, WSP(bf16_t, WS_WOUT) + (size_t)l * D * D, scr);
        }
        ph_rope_table(F, WSP(float, WS_ROPE));
    }
    SEAM(PH_PRO);
    if (IN(PH_NORM1)) { REFRESH(); WSL(); ph_norm1(F, p.x, p.norm_mix_w, WSP(float, WS_MOD) + 1 * D, WSP(float, WS_MOD) + 0 * D, WSP(bf16_t, WS_HB), WSP(unsigned char, WS_HBF8)); }
    SEAM(PH_NORM1);

    for (int l = 0; l < NL; ++l) {
        const int pb = PH_L0 + l * NPL;
        if (IN(pb + P_G1)) { WSL();
            pg8::Gemm g{WSP(bf16_t, WS_HB), WSP(bf16_t, WS_WIN) + (size_t)l * INW * D, S, 3072, D}; pg8::StaticOrder So; So.init(S, 3072, F.G, (int)blockIdx.x);
            pg8::EpiInproj E{WSP(bf16_t, WS_QR), WSP(bf16_t, WS_KR), WSP(bf16_t, WS_VV), WSP(bf16_t, WS_HQ), WSP(bf16_t, WS_KF), WSP(bf16_t, WS_HV), WSP(bf16_t, WS_HG), WSP(bf16_t, WS_GG), WSP(float, WS_LF), WSP(float, WS_LBV) + l * 1024, 1.0f};
            for (int rep_ = 0; rep_ < REP_G; ++rep_) pg8::gemm_phase<pg8::EpiInproj, pg8::StaticOrder, true, true>(F.lds + RING_OFF, g, So, E, F.wave);
        }
        SEAM(pb + P_G1);
        if (IN(pb + P_QKP)) { WSL();
            {
              pg8::Gemm g{WSP(bf16_t, WS_HB), WSP(bf16_t, WS_WIN) + (size_t)l * INW * D + (size_t)3072 * D, S, 2304, D}; pg8::OffOrder So; So.So.init(S, 2304, F.G, (int)blockIdx.x); So.off = 12;
              pg8::EpiInproj E{WSP(bf16_t, WS_QR), WSP(bf16_t, WS_KR), WSP(bf16_t, WS_VV), WSP(bf16_t, WS_HQ), WSP(bf16_t, WS_KF), WSP(bf16_t, WS_HV), WSP(bf16_t, WS_HG), WSP(bf16_t, WS_GG), WSP(float, WS_LF), WSP(float, WS_LBV) + l * 1024, 1.0f};
              for (int rep_ = 0; rep_ < REP_G; ++rep_) pg8::gemm_phase<pg8::EpiInproj, pg8::OffOrder, true, true>(F.lds + RING_OFF, g, So, E, F.wave); }
            { const bool even = (F.G == 256); const int rk = even ? (int)blockIdx.x - 64 : (int)blockIdx.x, nr = even ? 192 : F.G;
              for (int rep_ = 0; rep_ < REP_QK; ++rep_) ph_qkprep(F, WSP(bf16_t, WS_QR), WSP(bf16_t, WS_KR), p.q_norm_w + l * 64, p.k_norm_w + l * 64, WSP(float, WS_ROPE), WSP(bf16_t, WS_QN), WSP(bf16_t, WS_KN), WSP(unsigned char, WS_Q8), WSP(unsigned char, WS_K8), rk, nr);
              ph_v8t(F, WSP(bf16_t, WS_VV), WSP(unsigned char, WS_V8T)); }
            for (int rep_ = 0; rep_ < REP_HG; ++rep_) for (int u = blockIdx.x; u < 256; u += F.G) hg::segment<false>(F.lds, u, WSP(bf16_t, WS_HQ), WSP(float, WS_LF), WSP(bf16_t, WS_KF), WSP(bf16_t, WS_HV), WSP(float, WS_HST), WSP(float, WS_HST + 16 * MiB), nullptr, F.wave);
        }
        SEAM(pb + P_QKP);
        if (IN(pb + P_HGB)) { WSL(); OPAQUE_LANE(); (void)lane;
            for (int gid = blockIdx.x * 512 + t_; gid < 8 * 16384; gid += F.G * 512) hg::carry(WSP(float, WS_HST), WSP(float, WS_HST + 16 * MiB), gid);
        }
        SEAM(pb + P_HGB);
        if (IN(pb + P_HGC)) { WSL();
            for (int rep_ = 0; rep_ < REP_HG; ++rep_) for (int u = blockIdx.x; u < 256; u += F.G) hg::segment<true>(F.lds, u, WSP(bf16_t, WS_HQ), WSP(float, WS_LF), WSP(bf16_t, WS_KF), WSP(bf16_t, WS_HV), WSP(float, WS_HST), WSP(float, WS_HST + 16 * MiB), WSP(float, WS_OF), F.wave);
        }
        SEAM(pb + P_HGC);
        if (IN(pb + P_ATT)) { WSL();
            for (int rep_ = 0; rep_ < REP_QK; ++rep_) ph_hgfin(F, WSP(float, WS_OF), WSP(bf16_t, WS_HG), p.hg_norm_w + l * 128, WSP(bf16_t, WS_OHG));
            float negM;
            { const int ln = lane_id_opaque(); float mq = fabsf(p.q_norm_w[l * 64 + ln]), mk = fabsf(p.k_norm_w[l * 64 + ln]);
#pragma unroll
              for (int o_ = 1; o_ < 64; o_ <<= 1) { mq = fmaxf(mq, __shfl_xor(mq, o_)); mk = fmaxf(mk, __shfl_xor(mk, o_)); }
              negM = -(64.0f * C2) * mq * mk * 1.05f; }
            const attn8::Tensors AT{WSP(unsigned char, WS_Q8), WSP(unsigned char, WS_K8), WSP(unsigned char, WS_V8T), (attn8::bf16*)WSP(bf16_t, WS_OATT)};
            { BgConv bg; bg.init(p, l, F.lds + attn8::LDS_BYTES + F.wave * 1280, lane_id_opaque(), F.vcu * NWAVES + F.wave, F.G * NWAVES);
              attn8::phase((char*)lds + RING_OFF, AT, (int)F.G, (int)blockIdx.x, F.wave, negM + 8.0f, bg); bg.finish(); }
        }
        SEAM(pb + P_ATT);
        if (IN(pb + P_G2)) { WSL();
            pg8::Gemm g{WSP(bf16_t, WS_OATT), WSP(bf16_t, WS_WBA) + (size_t)l * D * 512, S, D, 512, WSP(bf16_t, WS_OHG), WSP(bf16_t, WS_WBH) + (size_t)l * D * 512};
            pg8::ChainOrder So; So.So.init(S, D, F.G, (int)blockIdx.x);
            pg8::EpiMerge E{WSP(bf16_t, WS_GG), WSP(bf16_t, WS_MG)};
            for (int rep_ = 0; rep_ < REP_G; ++rep_) pg8::gemm_phase<pg8::EpiMerge, pg8::ChainOrder, false, true>(F.lds + RING_OFF, g, So, E, F.wave);
        }
        SEAM(pb + P_G2);
        if (IN(pb + P_G3)) { WSL();
            pg8::Gemm g{WSP(bf16_t, WS_MG), WSP(bf16_t, WS_WOUT) + (size_t)l * D * D, S, D, D}; pg8::StaticOrder So; So.init(S, D, F.G, (int)blockIdx.x);
            pg8::EpiOut E{l == 0 ? p.x : WSP(float, WS_X2), WSP(float, WS_MOD) + l * 6 * D + 2 * D, WSP(float, WS_X1)};
            for (int rep_ = 0; rep_ < REP_G; ++rep_) pg8::gemm_phase<pg8::EpiOut, pg8::StaticOrder, false, true>(F.lds + RING_OFF, g, So, E, F.wave);
        }
        SEAM(pb + P_G3);
        if (IN(pb + P_N2R)) { WSL();
            for (int rep_ = 0; rep_ < REP_ROW; ++rep_) ph_norm2_router(F, WSP(float, WS_X1), p.norm_ffn_w + l * D, WSP(float, WS_MOD) + l * 6 * D + 4 * D, WSP(float, WS_MOD) + l * 6 * D + 3 * D, p.w_router + (size_t)l * D * NE, WSP(unsigned char, WS_HB8), WSP(float, WS_AFF));
        }
        SEAM(pb + P_N2R);
        if (IN(pb + P_TOPK)) { WSL();
            for (int rep_ = 0; rep_ < REP_TK; ++rep_) for (int e = blockIdx.x; e < NE; e += F.G) ph_topk(F, F.lds, e, WSP(float, WS_AFF), WSP(int, WS_IDX), WSP(float, WS_TOPW), WSP(int, WS_SLOT));
        }
        SEAM(pb + P_TOPK);
        if (IN(pb + P_G4)) { WSL();
            pg8::Gemm g{(const bf16_t*)WSP(unsigned char, WS_HB8), (const bf16_t*)(WSP(unsigned char, WS_WGU) + (size_t)l * 64 * MiB), NE * CAP, NE * 4096, D / 2, nullptr, nullptr, WSP(int, WS_IDX)}; pg8::GroupOrder So; So.init(16, F.G, (int)blockIdx.x);
            pg8::EpiGU8 E{WSP(unsigned char, WS_HID8)};
            for (int rep_ = 0; rep_ < REP_G; ++rep_) pg8::gemm_phase<pg8::EpiGU8, pg8::GroupOrder, true, true, true, true>(F.lds + RING_OFF, g, So, E, F.wave);
        }
        SEAM(pb + P_G4);
        if (IN(pb + P_G5)) { WSL();
            pg8::Gemm g{(const bf16_t*)WSP(unsigned char, WS_HID8), (const bf16_t*)(WSP(unsigned char, WS_WD) + (size_t)l * 32 * MiB), NE * CAP, NE * 1024, FF / 2}; pg8::GroupOrder So; So.init(4, F.G, (int)blockIdx.x);
            pg8::EpiDown E{WSP(bf16_t, WS_YE), WSP(float, WS_TOPW), 0.015625f};
            for (int rep_ = 0; rep_ < REP_G; ++rep_) pg8::gemm_phase<pg8::EpiDown, pg8::GroupOrder, true, true, true>(F.lds + RING_OFF, g, So, E, F.wave);
        }
        SEAM(pb + P_G5);
        if (IN(pb + P_COMB)) { WSL();
            const bool last = (l + 1 == NL); const int ln = last ? l : l + 1;
            for (int rep_ = 0; rep_ < REP_ROW; ++rep_) ph_combine(F, WSP(float, WS_X1), WSP(bf16_t, WS_YE), WSP(int, WS_SLOT), WSP(float, WS_MOD) + l * 6 * D + 5 * D, last ? p.out : WSP(float, WS_X2),
                       p.norm_mix_w + ln * D, WSP(float, WS_MOD) + ln * 6 * D + 1 * D, WSP(float, WS_MOD) + ln * 6 * D + 0 * D, WSP(bf16_t, WS_HB), WSP(unsigned char, WS_HBF8), !last);
        }
        SEAM(pb + P_COMB);
    }
#undef IN
#undef SEAM
}

#ifndef N_LAUNCH_MODE
#define N_LAUNCH_MODE 1
#endif
static int g_grid = 0;
extern "C" void kernel_launch(void* const* d_in, const int* in_sizes, int n_in, void* d_out, int out_size, void* d_ws, size_t ws_size, hipStream_t stream) {
    if (n_in != 18 || out_size != S * D || ws_size < WS_END) { fprintf(stderr, "kernel_launch: unexpected shapes (n_in %d out %d ws %zu)\n", n_in, out_size, ws_size); return; }
    if (g_grid == 0) {
        int dev = 0, cus = 0;
        if (hipGetDevice(&dev) != hipSuccess || hipDeviceGetAttribute(&cus, hipDeviceAttributeMultiprocessorCount, dev) != hipSuccess) { g_grid = -1; return; }
        if (hipFuncSetAttribute((const void*)mega, hipFuncAttributeMaxDynamicSharedMemorySize, LDS_BYTES) != hipSuccess) { g_grid = -1; return; }
        int per_cu = 0;
        if (hipOccupancyMaxActiveBlocksPerMultiprocessor(&per_cu, (const void*)mega, NWAVES * 64, LDS_BYTES) != hipSuccess || per_cu < 1) { fprintf(stderr, "occupancy query: %d\n", per_cu); }
        (void)hipGetLastError();
        g_grid = cus;
    }
    if (g_grid < 0) return;
    unsigned char* ws = (unsigned char*)d_ws;
    (void)hipMemsetAsync(ws + WS_CTL, 0, 1 * MiB, stream);
    Params p{};
    p.x = (const float*)d_in[0]; p.c = (const float*)d_in[1]; p.ada_w = (const float*)d_in[2]; p.ada_b = (const float*)d_in[3]; p.norm_mix_w = (const float*)d_in[4];
    p.norm_ffn_w = (const float*)d_in[5]; p.w_in = (const float*)d_in[6]; p.q_norm_w = (const float*)d_in[7]; p.k_norm_w = (const float*)d_in[8]; p.hlb = (const float*)d_in[9];
    p.hg_norm_w = (const float*)d_in[10]; p.w_ba = (const float*)d_in[11]; p.w_bh = (const float*)d_in[12]; p.w_out = (const float*)d_in[13]; p.w_router = (const float*)d_in[14];
    p.w_eg = (const float*)d_in[15]; p.w_eu = (const float*)d_in[16]; p.w_ed = (const float*)d_in[17];
    p.out = (float*)d_out; p.ws = ws;
#if defined(DBG_ATT)
    { const int cut = PH_L0 + P_ATT + 1;
      p.ph_lo = 0; p.ph_hi = cut; p.li = 0; p.pad = 0; hipLaunchKernelGGL(mega, dim3(g_grid), dim3(NWAVES * 64), LDS_BYTES, stream, p);
      hipMemcpyAsync(ws + 900 * MiB, ws + WS_OATT, 16 * MiB, hipMemcpyDeviceToDevice, stream);
      k_attn_naive<<<dim3(S / 64, 8), dim3(64), 0, stream>>>((const bf16_t*)(ws + WS_QN), (const bf16_t*)(ws + WS_KN), (const bf16_t*)(ws + WS_VV), (bf16_t*)(ws + WS_OATT));
      k_cmp_bf16<<<dim3(2048), dim3(256), 0, stream>>>((const bf16_t*)(ws + 900 * MiB), (const bf16_t*)(ws + WS_OATT), (size_t)8 * MiB, 512, 0, 512, (float*)(ws + 512 * 1024));
      p.ph_lo = cut; p.ph_hi = PH_END; p.li = 1; hipLaunchKernelGGL(mega, dim3(g_grid), dim3(NWAVES * 64), LDS_BYTES, stream, p);
      k_scale_out<<<dim3(2048), dim3(256), 0, stream>>>((float*)d_out, (size_t)S * D, (const float*)(ws + 512 * 1024)); }
#elif N_LAUNCH_MODE == 1
    p.ph_lo = 0; p.ph_hi = PH_END; p.li = 0; p.pad = 0;
    hipLaunchKernelGGL(mega, dim3(g_grid), dim3(NWAVES * 64), LDS_BYTES, stream, p);
#else
    for (int k = 0; k < PH_END; ++k) { p.ph_lo = k; p.ph_hi = k + 1; p.li = k; p.pad = 0; hipLaunchKernelGGL(mega, dim3(g_grid), dim3(NWAVES * 64), LDS_BYTES, stream, p); }
#endif
}
```

```cpp
#include <hip/hip_runtime.h>
#include <cstdio>
#include <cstdint>

typedef unsigned short bf16_t;
typedef float f32x4 __attribute__((ext_vector_type(4)));
typedef float f32x16 __attribute__((ext_vector_type(16)));
typedef unsigned u32x4 __attribute__((ext_vector_type(4)));
typedef unsigned u32x2 __attribute__((ext_vector_type(2)));

constexpr int S = 16384, D = 1024, NL = 2, INW = 5376;
constexpr int NE = 16, CAP = 2048, FF = 2048;
constexpr float EPS = 1e-6f;
constexpr float C2 = 0.125f * 1.4426950408889634f;
constexpr int C_AQ = 0, C_AK = 512, C_AV = 640, C_HQ = 768, C_ZF = 1280, C_ZB = 1792, C_HI = 2304, C_HGT = 2816, C_GL = 3328;

constexpr size_t MiB = 1u << 20;
constexpr size_t WS_CTL = 0;
constexpr size_t WS_MOD = 1 * MiB;
constexpr size_t WS_LBV = WS_MOD + 64 * 1024;
constexpr size_t WS_IDX = WS_MOD + 128 * 1024;
constexpr size_t WS_TOPW = WS_IDX + 128 * 1024;
constexpr size_t WS_ROPE = WS_MOD + 512 * 1024;
constexpr size_t WS_AFF = 2 * MiB;
constexpr size_t WS_SLOT = 3 * MiB;
constexpr size_t WS_HB = 4 * MiB;
constexpr size_t WS_QR = 36 * MiB;
constexpr size_t WS_KR = 52 * MiB;
constexpr size_t WS_VV = 56 * MiB;
constexpr size_t WS_QN = 60 * MiB;
constexpr size_t WS_KN = 76 * MiB;
constexpr size_t WS_HQ = 80 * MiB;
constexpr size_t WS_LF = 96 * MiB;
constexpr size_t WS_KF = 160 * MiB;
constexpr size_t WS_HV = 192 * MiB;
constexpr size_t WS_HG = 208 * MiB;
constexpr size_t WS_GG = 224 * MiB;
constexpr size_t WS_OATT = 288 * MiB;
constexpr size_t WS_OF = 304 * MiB;
constexpr size_t WS_OHG = 368 * MiB;
constexpr size_t WS_MP = 384 * MiB;
constexpr size_t WS_MG = 448 * MiB;
constexpr size_t WS_HB8 = 36 * MiB;
constexpr size_t WS_XE8 = 52 * MiB;
constexpr size_t WS_HID8 = 100 * MiB;
constexpr size_t WS_XE = 36 * MiB;
constexpr size_t WS_HID = 100 * MiB;
constexpr size_t WS_YE = 228 * MiB;
constexpr size_t WS_X1 = 480 * MiB;
constexpr size_t WS_X2 = 544 * MiB;
constexpr size_t WS_WIN = 608 * MiB;
constexpr size_t WS_WBA = 630 * MiB;
constexpr size_t WS_WBH = 632 * MiB;
constexpr size_t WS_WOUT = 634 * MiB;
constexpr size_t WS_WGU = 638 * MiB;
constexpr size_t WS_WD = 766 * MiB;
constexpr size_t WS_HST = 830 * MiB;
constexpr size_t WS_Q8 = 912 * MiB;
constexpr size_t WS_K8 = 920 * MiB;
constexpr size_t WS_V8T = 922 * MiB;
constexpr size_t WS_WIN8 = 900 * MiB;
constexpr size_t WS_HBF8 = 906 * MiB;
constexpr size_t WS_END = 924 * MiB;
static_assert(WS_END <= 1024 * MiB, "workspace");

__device__ __forceinline__ float bf2f(bf16_t v) { return __uint_as_float((unsigned)v << 16); }
__device__ __forceinline__ bf16_t f2bf(float f) { unsigned u = __float_as_uint(f); return (bf16_t)((u + 0x7fffu + ((u >> 16) & 1u)) >> 16); }
__device__ __forceinline__ unsigned pk2(float lo, float hi) { return (unsigned)f2bf(lo) | ((unsigned)f2bf(hi) << 16); }
__device__ __forceinline__ float bflo(unsigned w) { return __uint_as_float(w << 16); }
__device__ __forceinline__ float bfhi(unsigned w) { return __uint_as_float(w & 0xffff0000u); }
__device__ __forceinline__ float sigmoidf_(float v) { return __builtin_amdgcn_rcpf(1.0f + __expf(-v)); }
__device__ __forceinline__ float siluf_(float v) { return v * __builtin_amdgcn_rcpf(1.0f + __expf(-v)); }
__device__ __forceinline__ float wave_sum(float v) {
#pragma unroll
    for (int o = 1; o < 64; o <<= 1) v += __shfl_xor(v, o);
    return v;
}
__device__ __forceinline__ int crow(int r, int hi) { return (r & 3) + 8 * (r >> 2) + 4 * hi; }
__device__ __forceinline__ int lane_id_opaque() { int l; asm volatile("v_mbcnt_lo_u32_b32 %0, -1, 0\n\tv_mbcnt_hi_u32_b32 %0, -1, %0" : "=v"(l)); return l; }

#define GAS __attribute__((address_space(1)))
#define LAS __attribute__((address_space(3)))

namespace pg8 {
#define PG8_LAS __attribute__((address_space(3)))
typedef unsigned short bf16_t;
typedef short bf16x8 __attribute__((ext_vector_type(8)));
typedef float f32x4 __attribute__((ext_vector_type(4)));
typedef unsigned u32x4 __attribute__((ext_vector_type(4)));
constexpr int BM = 256, BK = 64, HALF = 128, HTB = HALF * BK * 2  , STAGE_BYTES = 8 * HTB, NXCD = 8, WGM = 8;

__host__ __device__ __forceinline__ int lds_byte(int r, int c) { const int st = (r >> 4) * 2 + (c >> 5), rr = r & 15, cc = c & 31, ob = rr * 64 + cc * 2; return st * 1024 + (ob ^ (((ob >> 9) & 1) << 5)); }
__host__ __device__ __forceinline__ void stage_rc(int b, int& R, int& C) { const int st = b / 1024, sb = b % 1024, swz = sb ^ (((sb >> 9) & 1) << 5); R = (st >> 1) * 16 + swz / 64; C = (st & 1) * 32 + (swz % 64) / 2; }
__host__ __device__ __forceinline__ int perm32(int rho) { const int n = rho >> 4, i = rho & 15; return 8 * (i >> 2) + 4 * n + (i & 3); }

struct Unit { int pm, pn, pb, sel; };
struct Gemm { const bf16_t* A; const bf16_t* Bt; int M, N, K; const bf16_t* A2 = nullptr; const bf16_t* Bt2 = nullptr; const int* rowidx = nullptr; };

struct StaticOrder {
    int nM, nN, nwg, G, c;
    __host__ __device__ void init(int M, int N, int G_, int c_) { nM = M / BM; nN = N / BM; nwg = nM * nN; G = G_; c = c_; }
    __host__ __device__ bool next(int i, Unit& u) const {
        const long L = (long)i * G + c; if (L >= nwg) return false;
        int wgid = (int)L; { const int q = nwg / NXCD, r = nwg % NXCD, xcd = wgid % NXCD, off = wgid / NXCD; wgid = (xcd < r ? xcd * (q + 1) : r * (q + 1) + (xcd - r) * q) + off; }
        const int nig = WGM * nN, gid = wgid / nig, fm = gid * WGM, gsz = (nM - fm) < WGM ? (nM - fm) : WGM;
        u.pm = fm + ((wgid % nig) % gsz); u.pn = (wgid % nig) / gsz; u.pb = u.pn; u.sel = 0; return true;
    }
    __device__ __forceinline__ void a_ready(const Unit&) const {}
    __device__ __forceinline__ void done(const Unit&) const {}
};

typedef float f32x2_c __attribute__((ext_vector_type(2))); typedef __bf16 bf16x2_c __attribute__((ext_vector_type(2)));
__device__ __forceinline__ unsigned cvt_pk_bf16(float lo, float hi) { f32x2_c v = {lo, hi}; bf16x2_c b = __builtin_convertvector(v, bf16x2_c); return __builtin_bit_cast(unsigned, b); }

typedef unsigned u32x2 __attribute__((ext_vector_type(2)));
__device__ __forceinline__ float e_bflo(unsigned w) { return __uint_as_float(w << 16); }
__device__ __forceinline__ float e_bfhi(unsigned w) { return __uint_as_float(w & 0xffff0000u); }
__device__ __forceinline__ float e_sig(float v) { return __builtin_amdgcn_rcpf(1.0f + __expf(-v)); }
__device__ __forceinline__ u32x4 pack8(const f32x4 a, const f32x4 b) { u32x4 w; w.x = cvt_pk_bf16(a[0], a[1]); w.y = cvt_pk_bf16(a[2], a[3]); w.z = cvt_pk_bf16(b[0], b[1]); w.w = cvt_pk_bf16(b[2], b[3]); return w; }

typedef int i32x4_ __attribute__((ext_vector_type(4))); typedef int i32x8_ __attribute__((ext_vector_type(8)));
__device__ __forceinline__ i32x8_ pg8_cat(const bf16x8 lo, const bf16x8 hi) { return __builtin_shufflevector(__builtin_bit_cast(i32x4_, lo), __builtin_bit_cast(i32x4_, hi), 0, 1, 2, 3, 4, 5, 6, 7); }
__device__ __forceinline__ u32x2 pack8_fp8(const f32x4 a, const f32x4 b) { int w0 = 0, w1 = 0;
    w0 = __builtin_amdgcn_cvt_pk_fp8_f32(a[0], a[1], w0, false); w0 = __builtin_amdgcn_cvt_pk_fp8_f32(a[2], a[3], w0, true);
    w1 = __builtin_amdgcn_cvt_pk_fp8_f32(b[0], b[1], w1, false); w1 = __builtin_amdgcn_cvt_pk_fp8_f32(b[2], b[3], w1, true);
    u32x2 r; r.x = (unsigned)w0; r.y = (unsigned)w1; return r; }
struct EpiInproj {
    static constexpr bool PERM = true, AFTER_DRAIN = false, CHAIN = false;
    bf16_t *QR, *KR, *VV, *HQ, *KF, *HV, *HG, *GG; float* LF; const float* lbv; float ascale;
    __device__ __forceinline__ void operator()(const f32x4 (&acc)[2][2][4][2], const Unit& u, int wr, int wc, int fr, int fq) const {
        const int row0 = u.pm * BM + wr * 64 + fr, cl = wc * 32 + 8 * fq;
#pragma unroll
        for (int bj = 0; bj < 2; ++bj) {
            const int colg = u.pn * BM + bj * HALF;
            int kind; bf16_t* dst; int pitch, c0; int dir = 0;
            if (colg < 512) { kind = 0; dst = QR; pitch = 512; c0 = colg; }
            else if (colg < 640) { kind = 0; dst = KR; pitch = 128; c0 = colg - 512; }
            else if (colg < 768) { kind = 0; dst = VV; pitch = 128; c0 = colg - 640; }
            else if (colg < 1280) { kind = 1; dst = HQ; pitch = 512; c0 = colg - 768; }
            else if (colg < 2304) { kind = 3; dir = colg >= 1792; dst = KF + (size_t)dir * 16384 * 512; pitch = 512; c0 = colg - (dir ? 1792 : 1280); }
            else if (colg < 2816) { kind = 0; dst = HV; pitch = 512; c0 = colg - 2304; }
            else if (colg < 3328) { kind = 1; dst = HG; pitch = 512; c0 = colg - 2816; }
            else { kind = 2; dst = GG; pitch = 2048; c0 = colg - 3328; }
            c0 += cl;
            if (kind == 0) {
#pragma unroll
                for (int ai = 0; ai < 2; ++ai)
#pragma unroll
                    for (int m = 0; m < 4; ++m) *(u32x4*)(dst + (size_t)(row0 + ai * HALF + m * 16) * pitch + c0) = pack8(acc[ai][bj][m][0] * ascale, acc[ai][bj][m][1] * ascale);
            } else if (kind == 1) {
#pragma unroll
                for (int ai = 0; ai < 2; ++ai)
#pragma unroll
                    for (int m = 0; m < 4; ++m) { f32x4 a = acc[ai][bj][m][0] * ascale, b = acc[ai][bj][m][1] * ascale;
#pragma unroll
                        for (int i = 0; i < 4; ++i) { a[i] = a[i] * e_sig(a[i]); b[i] = b[i] * e_sig(b[i]); }
                        *(u32x4*)(dst + (size_t)(row0 + ai * HALF + m * 16) * pitch + c0) = pack8(a, b); }
            } else if (kind == 2) {
#pragma unroll
                for (int ai = 0; ai < 2; ++ai)
#pragma unroll
                    for (int m = 0; m < 4; ++m) { f32x4 a = acc[ai][bj][m][0] * ascale, b = acc[ai][bj][m][1] * ascale;
#pragma unroll
                        for (int i = 0; i < 4; ++i) { a[i] = e_sig(a[i]); b[i] = e_sig(b[i]); }
                        *(u32x4*)(dst + (size_t)(row0 + ai * HALF + m * 16) * pitch + c0) = pack8(a, b); }
            } else {
                const f32x4 lb0 = *(const f32x4*)(lbv + dir * 512 + c0), lb1 = *(const f32x4*)(lbv + dir * 512 + c0 + 4);
                float* lf = LF + (size_t)dir * 16384 * 512;
#pragma unroll
                for (int ai = 0; ai < 2; ++ai)
#pragma unroll
                    for (int m = 0; m < 4; ++m) { const f32x4 a = acc[ai][bj][m][0] * ascale, b = acc[ai][bj][m][1] * ascale; f32x4 la, lb_, ka, kb;
#pragma unroll
                        for (int i = 0; i < 4; ++i) {
                            const float sa = e_sig(a[i]), sb = e_sig(b[i]);
                            la[i] = __logf(fmaxf(lb0[i] + (1.0f - lb0[i]) * sa, 1e-6f)); ka[i] = (1.0f - lb0[i]) * (1.0f - sa);
                            lb_[i] = __logf(fmaxf(lb1[i] + (1.0f - lb1[i]) * sb, 1e-6f)); kb[i] = (1.0f - lb1[i]) * (1.0f - sb); }
                        const size_t o = (size_t)(row0 + ai * HALF + m * 16) * 512 + c0;
                        *(f32x4*)(lf + o) = la; *(f32x4*)(lf + o + 4) = lb_;
                        *(u32x4*)(dst + o) = pack8(ka, kb); }
            }
        }
    }
};
struct EpiBrA {
    static constexpr bool PERM = true, AFTER_DRAIN = false, CHAIN = false;
    const bf16_t* GG; float* MP;
    __device__ __forceinline__ void operator()(const f32x4 (&acc)[2][2][4][2], const Unit& u, int wr, int wc, int fr, int fq) const {
        const int row0 = u.pm * BM + wr * 64 + fr, col0 = u.pn * BM + wc * 32 + 8 * fq;
#pragma unroll
        for (int ai = 0; ai < 2; ++ai)
#pragma unroll
            for (int m = 0; m < 4; ++m) { const size_t r = (size_t)(row0 + ai * HALF + m * 16);
#pragma unroll
                for (int bj = 0; bj < 2; ++bj) { const int c = col0 + bj * HALF; const u32x4 g = *(const u32x4*)(GG + r * 2048 + c);
                    f32x4 a = acc[ai][bj][m][0], b = acc[ai][bj][m][1];
                    a[0] *= e_bflo(g.x); a[1] *= e_bfhi(g.x); a[2] *= e_bflo(g.y); a[3] *= e_bfhi(g.y); b[0] *= e_bflo(g.z); b[1] *= e_bfhi(g.z); b[2] *= e_bflo(g.w); b[3] *= e_bfhi(g.w);
                    *(f32x4*)(MP + r * 1024 + c) = a; *(f32x4*)(MP + r * 1024 + c + 4) = b; } }
    }
};
struct EpiBrH {
    static constexpr bool PERM = true, AFTER_DRAIN = false, CHAIN = false;
    const bf16_t* GG; const float* MP; bf16_t* MG;
    __device__ __forceinline__ void operator()(const f32x4 (&acc)[2][2][4][2], const Unit& u, int wr, int wc, int fr, int fq) const {
        const int row0 = u.pm * BM + wr * 64 + fr, col0 = u.pn * BM + wc * 32 + 8 * fq;
#pragma unroll
        for (int ai = 0; ai < 2; ++ai)
#pragma unroll
            for (int m = 0; m < 4; ++m) { const size_t r = (size_t)(row0 + ai * HALF + m * 16);
#pragma unroll
                for (int bj = 0; bj < 2; ++bj) { const int c = col0 + bj * HALF; const u32x4 g = *(const u32x4*)(GG + r * 2048 + 1024 + c);
                    f32x4 a = acc[ai][bj][m][0], b = acc[ai][bj][m][1]; const f32x4 pa = *(const f32x4*)(MP + r * 1024 + c), pb = *(const f32x4*)(MP + r * 1024 + c + 4);
                    a[0] = pa[0] + a[0] * e_bflo(g.x); a[1] = pa[1] + a[1] * e_bfhi(g.x); a[2] = pa[2] + a[2] * e_bflo(g.y); a[3] = pa[3] + a[3] * e_bfhi(g.y);
                    b[0] = pb[0] + b[0] * e_bflo(g.z); b[1] = pb[1] + b[1] * e_bfhi(g.z); b[2] = pb[2] + b[2] * e_bflo(g.w); b[3] = pb[3] + b[3] * e_bfhi(g.w);
                    *(u32x4*)(MG + r * 1024 + c) = pack8(a, b); } }
    }
};
struct EpiMerge {
    static constexpr bool PERM = true, AFTER_DRAIN = false, CHAIN = true;
    const bf16_t* GG; bf16_t* MG;
    __device__ __forceinline__ void mid(f32x4 (&acc)[2][2][4][2], const Unit& u, int wr, int wc, int fr, int fq) const {
        const int row0 = u.pm * BM + wr * 64 + fr, col0 = u.pn * BM + wc * 32 + 8 * fq;
#pragma unroll
        for (int ai = 0; ai < 2; ++ai)
#pragma unroll
            for (int m = 0; m < 4; ++m) { const size_t r = (size_t)(row0 + ai * HALF + m * 16);
#pragma unroll
                for (int bj = 0; bj < 2; ++bj) { const int c = col0 + bj * HALF; const u32x4 g0 = *(const u32x4*)(GG + r * 2048 + c), g1 = *(const u32x4*)(GG + r * 2048 + 1024 + c);
                    f32x4& a = acc[ai][bj][m][0]; f32x4& b = acc[ai][bj][m][1];
                    a[0] *= e_bflo(g0.x) * __builtin_amdgcn_rcpf(e_bflo(g1.x)); a[1] *= e_bfhi(g0.x) * __builtin_amdgcn_rcpf(e_bfhi(g1.x));
                    a[2] *= e_bflo(g0.y) * __builtin_amdgcn_rcpf(e_bflo(g1.y)); a[3] *= e_bfhi(g0.y) * __builtin_amdgcn_rcpf(e_bfhi(g1.y));
                    b[0] *= e_bflo(g0.z) * __builtin_amdgcn_rcpf(e_bflo(g1.z)); b[1] *= e_bfhi(g0.z) * __builtin_amdgcn_rcpf(e_bfhi(g1.z));
                    b[2] *= e_bflo(g0.w) * __builtin_amdgcn_rcpf(e_bflo(g1.w)); b[3] *= e_bfhi(g0.w) * __builtin_amdgcn_rcpf(e_bfhi(g1.w)); } }
    }
    __device__ __forceinline__ void operator()(const f32x4 (&acc)[2][2][4][2], const Unit& u, int wr, int wc, int fr, int fq) const {
        const int row0 = u.pm * BM + wr * 64 + fr, col0 = u.pn * BM + wc * 32 + 8 * fq;
#pragma unroll
        for (int ai = 0; ai < 2; ++ai)
#pragma unroll
            for (int m = 0; m < 4; ++m) { const size_t r = (size_t)(row0 + ai * HALF + m * 16);
#pragma unroll
                for (int bj = 0; bj < 2; ++bj) { const int c = col0 + bj * HALF; const u32x4 g = *(const u32x4*)(GG + r * 2048 + 1024 + c);
                    f32x4 a = acc[ai][bj][m][0], b = acc[ai][bj][m][1];
                    a[0] *= e_bflo(g.x); a[1] *= e_bfhi(g.x); a[2] *= e_bflo(g.y); a[3] *= e_bfhi(g.y); b[0] *= e_bflo(g.z); b[1] *= e_bfhi(g.z); b[2] *= e_bflo(g.w); b[3] *= e_bfhi(g.w);
                    *(u32x4*)(MG + r * 1024 + c) = pack8(a, b); } }
    }
};
struct OffOrder {
    StaticOrder So; int off;
    __device__ bool next(int i, Unit& u) const { if (!So.next(i, u)) return false; u.pb = u.pn; u.pn += off; return true; }
    __device__ __forceinline__ void a_ready(const Unit&) const {}
    __device__ __forceinline__ void done(const Unit&) const {}
};
struct ChainOrder {
    StaticOrder So;
    __device__ bool next(int i, Unit& u) const { if (!So.next(i >> 1, u)) return false; u.sel = i & 1; return true; }
    __device__ __forceinline__ void a_ready(const Unit&) const {}
    __device__ __forceinline__ void done(const Unit&) const {}
};
struct EpiOut {
    static constexpr bool PERM = true, AFTER_DRAIN = false, CHAIN = false;
    const void* xin; const float* gate; bf16_t* X1; int xin_bf16;
    __device__ __forceinline__ void operator()(const f32x4 (&acc)[2][2][4][2], const Unit& u, int wr, int wc, int fr, int fq) const {
        const int row0 = u.pm * BM + wr * 64 + fr, col0 = u.pn * BM + wc * 32 + 8 * fq;
#pragma unroll
        for (int bj = 0; bj < 2; ++bj) { const int c = col0 + bj * HALF; const f32x4 g0 = *(const f32x4*)(gate + c), g1 = *(const f32x4*)(gate + c + 4);
#pragma unroll
            for (int ai = 0; ai < 2; ++ai)
#pragma unroll
                for (int m = 0; m < 4; ++m) { const size_t o = (size_t)(row0 + ai * HALF + m * 16) * 1024 + c; f32x4 ra, rb;
                    if (xin_bf16) { const u32x4 q = *(const u32x4*)((const bf16_t*)xin + o); ra = f32x4{__uint_as_float(q.x << 16), __uint_as_float(q.x & 0xffff0000u), __uint_as_float(q.y << 16), __uint_as_float(q.y & 0xffff0000u)};
                        rb = f32x4{__uint_as_float(q.z << 16), __uint_as_float(q.z & 0xffff0000u), __uint_as_float(q.w << 16), __uint_as_float(q.w & 0xffff0000u)}; }
                    else { ra = *(const f32x4*)((const float*)xin + o); rb = *(const f32x4*)((const float*)xin + o + 4); }
                    *(u32x4*)(X1 + o) = pack8(ra + g0 * acc[ai][bj][m][0], rb + g1 * acc[ai][bj][m][1]); } }
    }
};
struct EpiGU {
    static constexpr bool PERM = true, AFTER_DRAIN = false, CHAIN = false;
    bf16_t* HID;
    __device__ __forceinline__ void operator()(const f32x4 (&acc)[2][2][4][2], const Unit& u, int wr, int wc, int fr, int fq) const {
        const int row0 = u.pm * BM + wr * 64 + fr, col0 = u.pn * HALF + wc * 32 + 8 * fq;
#pragma unroll
        for (int ai = 0; ai < 2; ++ai)
#pragma unroll
            for (int m = 0; m < 4; ++m) { f32x4 a = acc[ai][0][m][0], b = acc[ai][0][m][1]; const f32x4 ua = acc[ai][1][m][0], ub = acc[ai][1][m][1];
#pragma unroll
                for (int i = 0; i < 4; ++i) { a[i] = a[i] * e_sig(a[i]) * ua[i]; b[i] = b[i] * e_sig(b[i]) * ub[i]; }
                *(u32x4*)(HID + (size_t)(row0 + ai * HALF + m * 16) * 2048 + col0) = pack8(a, b); }
    }
};
struct EpiGU8 {
    static constexpr bool PERM = true, AFTER_DRAIN = false, CHAIN = false;
    unsigned char* HID;
    __device__ __forceinline__ void operator()(const f32x4 (&acc)[2][2][4][2], const Unit& u, int wr, int wc, int fr, int fq) const {
        const int row0 = u.pm * BM + wr * 64 + fr, col0 = u.pn * HALF + wc * 32 + 8 * fq;
#pragma unroll
        for (int ai = 0; ai < 2; ++ai)
#pragma unroll
            for (int m = 0; m < 4; ++m) { f32x4 a = acc[ai][0][m][0], b = acc[ai][0][m][1]; const f32x4 ua = acc[ai][1][m][0], ub = acc[ai][1][m][1];
#pragma unroll
                for (int i = 0; i < 4; ++i) { const float ga = a[i] * 0.015625f, gb = b[i] * 0.015625f; a[i] = ga * e_sig(ga) * (ua[i] * 0.015625f); b[i] = gb * e_sig(gb) * (ub[i] * 0.015625f); }
                *(u32x2*)(HID + (size_t)(row0 + ai * HALF + m * 16) * 2048 + col0) = pack8_fp8(a, b); }
    }
};
struct EpiDown {
    static constexpr bool PERM = true, AFTER_DRAIN = false, CHAIN = false;
    bf16_t* YE; const float* topw; float wscale;
    __device__ __forceinline__ void operator()(const f32x4 (&acc)[2][2][4][2], const Unit& u, int wr, int wc, int fr, int fq) const {
        const int row0 = u.pm * BM + wr * 64 + fr, col0 = u.pn * BM + wc * 32 + 8 * fq;
#pragma unroll
        for (int ai = 0; ai < 2; ++ai)
#pragma unroll
            for (int m = 0; m < 4; ++m) { const int r = row0 + ai * HALF + m * 16; const float w = topw[r] * wscale;
#pragma unroll
                for (int bj = 0; bj < 2; ++bj) *(u32x4*)(YE + (size_t)r * 1024 + col0 + bj * HALF) = pack8(acc[ai][bj][m][0] * w, acc[ai][bj][m][1] * w); }
    }
};
struct GroupOrder {
    int nNe, nwg, G, c;
    __device__ void init(int nNe_, int G_, int c_) { nNe = nNe_; nwg = 16 * 8 * nNe_; G = G_; c = c_; }
    __device__ bool next(int i, Unit& u) const {
        const long L = (long)i * G + c; if (L >= nwg) return false;
        int wgid = (int)L; { const int q = nwg / NXCD, xcd = wgid % NXCD, off = wgid / NXCD; wgid = xcd * q + off; }
        const int per = 8 * nNe, e = wgid / per, w = wgid % per;
        u.pm = e * 8 + (w & 7); u.pn = w >> 3; u.pb = e * nNe + u.pn; u.sel = 0; return true;
    }
    __device__ __forceinline__ void a_ready(const Unit&) const {}
    __device__ __forceinline__ void done(const Unit&) const {}
};

template <class Epi, class Sched, bool ALIGN_EPI = false, bool SP2 = false, bool FP8 = false, bool GATHER = false>
__device__ __forceinline__ void gemm_phase(PG8_LAS unsigned char* lds, const Gemm g, const Sched& S, const Epi& E, int wave_) {
    const int tid_ = wave_ * 64 + lane_id_opaque();
    const int tid = tid_, wid = __builtin_amdgcn_readfirstlane(tid >> 6), lane = tid & 63, wr = wid >> 2, wc = wid & 3, fr = lane & 15, fq = lane >> 4;
    int K_ = g.K; asm volatile("" : "+s"(K_));
    const int K = K_, nt = K / BK;
    unsigned voffA[2], voffB[2];
#pragma unroll
    for (int i = 0; i < 2; ++i) { int R, C; stage_rc(tid * 16 + i * 8192, R, C); const int Rb = Epi::PERM ? ((R & ~31) + perm32(R & 31)) : R;
        voffA[i] = (unsigned)(R * K + C) * 2u; voffB[i] = (unsigned)(Rb * K + C) * 2u; }
    unsigned vA[2][2] = {{0u, 0u}, {0u, 0u}}, vN[2][2] = {{0u, 0u}, {0u, 0u}};
#define PG8_GOFF(dst, u_) do { if constexpr (GATHER) { _Pragma("unroll") for (int h_ = 0; h_ < 2; ++h_) _Pragma("unroll") for (int i_ = 0; i_ < 2; ++i_) \
        { int R_, C_; stage_rc(tid * 16 + i_ * 8192, R_, C_);     \
          dst[h_][i_] = (unsigned)((const __attribute__((address_space(1))) int*)g.rowidx)[(u_).pm * BM + h_ * HALF + R_] * (unsigned)(K * 2) + (unsigned)C_ * 2u; } } } while (0)
    const size_t kstep = (size_t)(BK * 2);
    const size_t hstep = (size_t)HALF * K * 2;
    const size_t tstep = 2 * hstep;
    const unsigned ldsbase = (unsigned)__builtin_amdgcn_readfirstlane((int)(unsigned)(size_t)lds + wid * 1024);
    const int aoff = lds_byte(wr * 64 + fr, fq * 8), boff = lds_byte(wc * 32 + fr, fq * 8);
#define PG8_SA(b, h) (((b) * 2 + (h)) * HTB)
#define PG8_SB(b, h) ((4 + (b) * 2 + (h)) * HTB)
#define PG8_STAGE(bufoff, gbase, voff) do { _Pragma("unroll") for (int _i = 0; _i < 2; ++_i) { unsigned keep_; \
        asm volatile("s_mov_b32 %0, m0\n\ts_mov_b32 m0, %3\n\ts_nop 0\n\tglobal_load_lds_dwordx4 %1, %2\n\ts_mov_b32 m0, %0" : "=&s"(keep_) : "v"((voff)[_i]), "s"((const char*)(gbase)), "s"(ldsbase + (unsigned)((bufoff) + _i * 8192)) : "memory"); } } while (0)
#define PG8_STAGE_A(bufoff, gptr, half, nsel) do { if constexpr (GATHER) { unsigned vs_[2]; vs_[0] = (nsel) ? vN[half][0] : vA[half][0]; vs_[1] = (nsel) ? vN[half][1] : vA[half][1]; PG8_STAGE(bufoff, gptr, vs_); } \
        else { PG8_STAGE(bufoff, (gptr) + (half) * hstep, voffA); } } while (0)
#define PG8_LDA(dst, b, h) do { if constexpr (FP8) { _Pragma("unroll") for (int m = 0; m < 4; ++m) dst##8[m] = pg8_cat(*(const PG8_LAS bf16x8*)(lds + PG8_SA(b, h) + aoff + m * 2048), *(const PG8_LAS bf16x8*)(lds + PG8_SA(b, h) + aoff + m * 2048 + 1024)); } else { \
        _Pragma("unroll") for (int m = 0; m < 4; ++m) _Pragma("unroll") for (int k = 0; k < 2; ++k) dst[m][k] = *(const PG8_LAS bf16x8*)(lds + PG8_SA(b, h) + aoff + m * 2048 + k * 1024); } } while (0)
#define PG8_LDB(dst, b, h) do { if constexpr (FP8) { _Pragma("unroll") for (int n = 0; n < 2; ++n) dst##8[n] = pg8_cat(*(const PG8_LAS bf16x8*)(lds + PG8_SB(b, h) + boff + n * 2048), *(const PG8_LAS bf16x8*)(lds + PG8_SB(b, h) + boff + n * 2048 + 1024)); } else { \
        _Pragma("unroll") for (int n = 0; n < 2; ++n) _Pragma("unroll") for (int k = 0; k < 2; ++k) dst[n][k] = *(const PG8_LAS bf16x8*)(lds + PG8_SB(b, h) + boff + n * 2048 + k * 1024); } } while (0)
#define PG8_MMA(ai, bj, At, Bt) do { __builtin_amdgcn_s_setprio(1); if constexpr (FP8) { \
        _Pragma("unroll") for (int m = 0; m < 4; ++m) _Pragma("unroll") for (int n = 0; n < 2; ++n) \
        asm volatile("v_mfma_f32_16x16x128_f8f6f4 %0, %1, %2, %0" : "+v"(acc[ai][bj][m][n]) : "v"(Bt##8[n]), "v"(At##8[m])); } else {     \
        _Pragma("unroll") for (int m = 0; m < 4; ++m) _Pragma("unroll") for (int n = 0; n < 2; ++n) _Pragma("unroll") for (int k = 0; k < 2; ++k) \
        acc[ai][bj][m][n] = __builtin_amdgcn_mfma_f32_16x16x32_bf16(Bt[n][k], At[m][k], acc[ai][bj][m][n], 0, 0, 0); } __builtin_amdgcn_s_setprio(0); } while (0)
#define PG8_WAIT_V(n) asm volatile("s_waitcnt vmcnt(" #n ")" ::: "memory")
#define PG8_WAIT_L(n) asm volatile("s_waitcnt lgkmcnt(" #n ")" ::: "memory")
#define PG8_BAR __builtin_amdgcn_s_barrier()
#define PG8_SCHED __builtin_amdgcn_sched_barrier(0)
    Unit cur, nxt; int ui = 0;
    if (!S.next(0, cur)) return;
    f32x4 acc[2][2][4][2];
#pragma unroll
    for (int a = 0; a < 2; ++a)
#pragma unroll
        for (int b = 0; b < 2; ++b)
#pragma unroll
            for (int m = 0; m < 4; ++m)
#pragma unroll
                for (int n = 0; n < 2; ++n) acc[a][b][m][n] = (f32x4){0.f, 0.f, 0.f, 0.f};
    bf16x8 At[4][2], B0[2][2], B1[2][2]; i32x8_ At8[4], B08[2], B18[2];
    const char* cA = GATHER ? (const char*)g.A : (const char*)(cur.sel ? g.A2 : g.A) + (size_t)cur.pm * tstep; PG8_GOFF(vA, cur); const char* cB = (const char*)(cur.sel ? g.Bt2 : g.Bt) + (size_t)cur.pb * tstep;
    S.a_ready(cur);
    if constexpr (SP2) {
        PG8_STAGE(PG8_SB(0, 0), cB, voffB); PG8_STAGE(PG8_SB(0, 1), cB + hstep, voffB); PG8_STAGE_A(PG8_SA(0, 0), cA, 0, false); PG8_STAGE_A(PG8_SA(0, 1), cA, 1, false);
        if (wr == 1) PG8_BAR;
        PG8_WAIT_V(2); PG8_BAR;
        PG8_STAGE(PG8_SB(1, 0), cB + kstep, voffB); PG8_STAGE_A(PG8_SA(1, 0), cA + kstep, 0, false); PG8_STAGE(PG8_SB(1, 1), cB + hstep + kstep, voffB);
        PG8_WAIT_V(6); PG8_BAR;
    } else {
        PG8_STAGE(PG8_SB(0, 0), cB, voffB); PG8_STAGE_A(PG8_SA(0, 0), cA, 0, false); PG8_STAGE(PG8_SB(0, 1), cB + hstep, voffB); PG8_STAGE_A(PG8_SA(0, 1), cA, 1, false);
        if (wr == 1) PG8_BAR;
        PG8_WAIT_V(4); PG8_BAR;
        PG8_STAGE(PG8_SB(1, 0), cB + kstep, voffB); PG8_STAGE_A(PG8_SA(1, 0), cA + kstep, 0, false); PG8_STAGE(PG8_SB(1, 1), cB + hstep + kstep, voffB);
        PG8_WAIT_V(6); PG8_BAR;
    }
    for (;;) {
        const bool has_next = S.next(ui + 1, nxt);
        if (has_next) PG8_GOFF(vN, nxt); else { if constexpr (GATHER) { vN[0][0] = vA[0][0]; vN[0][1] = vA[0][1]; vN[1][0] = vA[1][0]; vN[1][1] = vA[1][1]; } }
        const char* nA = GATHER ? (const char*)g.A : has_next ? (const char*)(nxt.sel ? g.A2 : g.A) + (size_t)nxt.pm * tstep : cA; const char* nB = has_next ? (const char*)(nxt.sel ? g.Bt2 : g.Bt) + (size_t)nxt.pb * tstep : cB;
#pragma unroll 1
        for (int t = 0; t < nt; t += 2) {
            const bool last = (t == nt - 2);
            const char* a1 = cA + (size_t)(t + 1) * kstep;
            const char* a2 = last ? nA : cA + (size_t)(t + 2) * kstep; const char* b2 = last ? nB : cB + (size_t)(t + 2) * kstep;
            const char* a3 = a2 + kstep; const char* b3 = b2 + kstep;
            if (last && has_next) S.a_ready(nxt);
            if constexpr (SP2) {
            PG8_LDB(B0, 0, 0); PG8_LDB(B1, 0, 1); PG8_SCHED; PG8_LDA(At, 0, 0); PG8_STAGE_A(PG8_SA(1, 1), a1, 1, false);
            PG8_WAIT_V(8); PG8_WAIT_L(0); PG8_BAR; PG8_MMA(0, 0, At, B0); PG8_MMA(0, 1, At, B1); PG8_BAR; PG8_SCHED;
            PG8_LDA(At, 0, 1); PG8_STAGE(PG8_SB(0, 0), b2, voffB); PG8_STAGE(PG8_SB(0, 1), b2 + hstep, voffB); PG8_STAGE_A(PG8_SA(0, 0), a2, 0, last);
            PG8_WAIT_V(8); PG8_WAIT_L(0); PG8_BAR; PG8_MMA(1, 0, At, B0); PG8_MMA(1, 1, At, B1); PG8_BAR; PG8_SCHED;
            PG8_LDB(B0, 1, 0); PG8_LDB(B1, 1, 1); PG8_SCHED; PG8_LDA(At, 1, 0); PG8_STAGE_A(PG8_SA(0, 1), a2, 1, last);
            PG8_WAIT_V(8); PG8_WAIT_L(0); PG8_BAR; PG8_MMA(0, 0, At, B0); PG8_MMA(0, 1, At, B1); PG8_BAR; PG8_SCHED;
            PG8_LDA(At, 1, 1); PG8_STAGE(PG8_SB(1, 0), b3, voffB); PG8_STAGE(PG8_SB(1, 1), b3 + hstep, voffB); PG8_STAGE_A(PG8_SA(1, 0), a3, 0, last);
            PG8_WAIT_V(8); PG8_WAIT_L(0); PG8_BAR; PG8_MMA(1, 0, At, B0); PG8_MMA(1, 1, At, B1); PG8_BAR; PG8_SCHED;
            } else {
            PG8_LDB(B0, 0, 0); PG8_SCHED; PG8_LDA(At, 0, 0); PG8_STAGE_A(PG8_SA(1, 1), a1, 1, false);
            PG8_WAIT_L(8); PG8_BAR; PG8_WAIT_L(0); PG8_MMA(0, 0, At, B0); PG8_BAR; PG8_SCHED;
            PG8_LDB(B1, 0, 1); PG8_STAGE(PG8_SB(0, 0), b2, voffB);
            PG8_BAR; PG8_WAIT_L(0); PG8_MMA(0, 1, At, B1); PG8_BAR;
            PG8_LDA(At, 0, 1); PG8_STAGE_A(PG8_SA(0, 0), a2, 0, last);
            PG8_BAR; PG8_WAIT_L(0); PG8_MMA(1, 0, At, B0); PG8_BAR; PG8_SCHED;
            PG8_STAGE(PG8_SB(0, 1), b2 + hstep, voffB);
            PG8_WAIT_V(6); PG8_BAR; PG8_MMA(1, 1, At, B1); PG8_BAR;
            PG8_LDB(B0, 1, 0); PG8_SCHED; PG8_LDA(At, 1, 0); PG8_STAGE_A(PG8_SA(0, 1), a2, 1, last);
            PG8_WAIT_L(8); PG8_BAR; PG8_WAIT_L(0); PG8_MMA(0, 0, At, B0); PG8_BAR; PG8_SCHED;
            PG8_LDB(B1, 1, 1); PG8_STAGE(PG8_SB(1, 0), b3, voffB);
            PG8_BAR; PG8_WAIT_L(0); PG8_MMA(0, 1, At, B1); PG8_BAR;
            PG8_LDA(At, 1, 1); PG8_STAGE_A(PG8_SA(1, 0), a3, 0, last);
            PG8_BAR; PG8_WAIT_L(0); PG8_MMA(1, 0, At, B0); PG8_BAR; PG8_SCHED;
            PG8_STAGE(PG8_SB(1, 1), b3 + hstep, voffB);
            PG8_WAIT_V(6); PG8_BAR; PG8_MMA(1, 1, At, B1); PG8_BAR;
            }
        }
        if constexpr (FP8) asm volatile("s_nop 15\n\ts_nop 7" ::: "memory");
        if constexpr (ALIGN_EPI) { if (wr == 0) PG8_BAR; }
        bool fin = true; if constexpr (Epi::CHAIN) fin = (cur.sel != 0);
        if constexpr (!Epi::AFTER_DRAIN) { const int le_ = lane_id_opaque(), fre = le_ & 15, fqe = le_ >> 4;
            if (fin) E(acc, cur, wr, wc, fre, fqe); else { if constexpr (Epi::CHAIN) E.mid(acc, cur, wr, wc, fre, fqe); } S.done(cur); }
        if (!has_next) break;
        if (fin)
#pragma unroll
        for (int a = 0; a < 2; ++a)
#pragma unroll
            for (int b = 0; b < 2; ++b)
#pragma unroll
                for (int m = 0; m < 4; ++m)
#pragma unroll
                    for (int n = 0; n < 2; ++n) acc[a][b][m][n] = (f32x4){0.f, 0.f, 0.f, 0.f};
        cur = nxt; cA = nA; cB = nB; ++ui;
        if constexpr (GATHER) { vA[0][0] = vN[0][0]; vA[0][1] = vN[0][1]; vA[1][0] = vN[1][0]; vA[1][1] = vN[1][1]; }
        if constexpr (ALIGN_EPI) { if (wr == 1) PG8_BAR; }
    }
    PG8_WAIT_V(0);
    if constexpr (!ALIGN_EPI) { if (wr == 0) PG8_BAR; }
    PG8_BAR;
    if constexpr (Epi::AFTER_DRAIN) { E.fused(acc, cur, wr, wc, fr, fq, lds, wid, lane); S.done(cur); }
#undef PG8_SA
#undef PG8_STAGE_A
#undef PG8_GOFF
#undef PG8_SB
#undef PG8_STAGE
#undef PG8_LDA
#undef PG8_LDB
#undef PG8_MMA
#undef PG8_WAIT_V
#undef PG8_WAIT_L
#undef PG8_BAR
#undef PG8_SCHED
}
}

#include <hip/hip_bf16.h>
#include <cmath>

namespace attn8 {
using bf16 = __hip_bfloat16;
typedef int i32x8 __attribute__((ext_vector_type(8)));
typedef int i32x4 __attribute__((ext_vector_type(4)));
typedef float f32x16 __attribute__((ext_vector_type(16)));
typedef unsigned u32x4 __attribute__((ext_vector_type(4)));
constexpr int NHEAD = 8, SEQ = 16384, QBLK = 32, NW = 8, QB = 256, KVBLK = 64, NQB = SEQ / QB, NT = SEQ / KVBLK;
constexpr int NS = 8, SLOT = 4096;
constexpr int LDS_K = 0, LDS_V = NS * SLOT, LDS_WS = 2 * NS * SLOT, LDS_OST = LDS_WS + NW * 256, LDS_BYTES = LDS_OST + NW * 4096;
__device__ __forceinline__ int crow(int r, int hi) { return (r & 3) + 8 * (r >> 2) + 4 * hi; }
__device__ __forceinline__ void glds16(const void* gsrc, unsigned lds_dst) { unsigned keep;
    asm volatile("s_mov_b32 %0, m0\n\ts_mov_b32 m0, %2\n\ts_nop 0\n\tglobal_load_lds_dwordx4 %1, off\n\ts_mov_b32 m0, %0" : "=&s"(keep) : "v"(gsrc), "s"(lds_dst) : "memory"); }
typedef __attribute__((address_space(3))) const char* lds_cptr;
__device__ __forceinline__ i32x8 frag(lds_cptr p) {
    const i32x4 lo = *(const __attribute__((address_space(3))) i32x4*)(p), hi = *(const __attribute__((address_space(3))) i32x4*)(p + 1024);
    return __builtin_shufflevector(lo, hi, 0, 1, 2, 3, 4, 5, 6, 7); }
#define A8_MFMA(a, b, c) __builtin_amdgcn_mfma_scale_f32_32x32x64_f8f6f4((a), (b), (c), 0, 0, 0, 0, 0, 0)
struct Tensors { const unsigned char* Q8; const unsigned char* K8; const unsigned char* V8T; bf16* O; };

template <class Bg>
__device__ __forceinline__ void unit(int h, int qb, const Tensors& T, char* shm, int wave_, float negM8, Bg& bg) {
    const int tid = wave_ * 64 + lane_id_opaque(), lane = tid & 63, r32 = lane & 31, hi = lane >> 5; const int wid = __builtin_amdgcn_readfirstlane(tid >> 6);
    const int kvh = h >> 2, q0 = qb * QB;
    const unsigned lds0 = (unsigned)(uintptr_t)shm;
    float* wsf = (float*)(shm + LDS_WS) + wid * 64;
    const bool isk = wid < 4; const int c = wid & 3;
    const unsigned char* src0 = isk ? T.K8 + (size_t)lane * 128 + kvh * 64 + c * 16 : T.V8T + (size_t)kvh * NT * 4096 + (size_t)lane * 64 + c * 16;
    const size_t tstep = isk ? (size_t)KVBLK * 128 : (size_t)4096;
    const unsigned dst0 = lds0 + (isk ? LDS_K : LDS_V) + c * 1024;
#define A8_DMA(t) glds16(src0 + (size_t)(t) * tstep, (unsigned)__builtin_amdgcn_readfirstlane(dst0 + ((t) & (NS - 1)) * SLOT))
#pragma unroll
    for (int t = 0; t < 3; ++t) A8_DMA(t);
    if (isk) { A8_DMA(3); A8_DMA(4); }
    const unsigned char* qp = T.Q8 + (size_t)(q0 + wid * QBLK + r32) * 512 + h * 64 + 32 * hi;
    const i32x4 qlo = *(const i32x4*)qp, qhi = *(const i32x4*)(qp + 16);
    const i32x8 qf = __builtin_shufflevector(qlo, qhi, 0, 1, 2, 3, 4, 5, 6, 7);
    f32x16 negm;
#pragma unroll
    for (int r = 0; r < 16; ++r) negm[r] = negM8;
    f32x16 o0 = f32x16{}, o1 = f32x16{}, lacc = f32x16{};
    i32x8 ones8;
#pragma unroll
    for (int k = 0; k < 8; ++k) ones8[k] = 0x38383838;
    const lds_cptr kbase = (lds_cptr)shm + LDS_K + (2 * hi) * 1024 + r32 * 16, vbase = (lds_cptr)shm + LDS_V + (2 * hi) * 1024 + r32 * 16;
    if (isk) asm volatile("s_waitcnt vmcnt(4)" ::: "memory"); else asm volatile("s_waitcnt vmcnt(2)" ::: "memory");
    asm volatile("s_waitcnt lgkmcnt(0)\n\ts_barrier" ::: "memory");
    asm volatile("" : "+v"(ones8));
    f32x16 sA0 = A8_MFMA(frag(kbase), qf, negm), sA1 = A8_MFMA(frag(kbase + 512), qf, negm), sB0, sB1;
#define A8_SB() __builtin_amdgcn_sched_barrier(0)
#define A8_EX8(X, b) do { _Pragma("unroll") for (int r = 0; r < 8; ++r) X[(b) + r] = __builtin_amdgcn_exp2f(X[(b) + r]); } while (0)
#define A8_TILE(C0, C1, N0, N1, PP, PC, kt, vt) do { \
        const lds_cptr kp_ = kbase + ((kt) & (NS - 1)) * SLOT, vp_ = vbase + ((vt) & (NS - 1)) * SLOT; \
        const i32x8 kf0_ = frag(kp_), kf1_ = frag(kp_ + 512), vf0_ = frag(vp_), vf1_ = frag(vp_ + 512); A8_SB(); \
        N0 = A8_MFMA(kf0_, qf, negm); A8_SB(); A8_EX8(C0, 0); A8_SB(); \
        N1 = A8_MFMA(kf1_, qf, negm); A8_SB(); A8_EX8(C0, 8); A8_SB(); \
        o0 = A8_MFMA(PP, vf0_, o0); A8_SB(); A8_EX8(C1, 0); A8_SB(); \
        o1 = A8_MFMA(PP, vf1_, o1); A8_SB(); A8_EX8(C1, 8); A8_SB(); \
        lacc = A8_MFMA(PP, ones8, lacc); A8_SB(); \
        _Pragma("unroll") for (int k = 0; k < 4; ++k) { int w_; asm volatile("" : "=v"(w_)); w_ = __builtin_amdgcn_cvt_pk_fp8_f32(C0[4 * k], C0[4 * k + 1], w_, false); w_ = __builtin_amdgcn_cvt_pk_fp8_f32(C0[4 * k + 2], C0[4 * k + 3], w_, true); PC[k] = w_; \
            int v_; asm volatile("" : "=v"(v_)); v_ = __builtin_amdgcn_cvt_pk_fp8_f32(C1[4 * k], C1[4 * k + 1], v_, false); v_ = __builtin_amdgcn_cvt_pk_fp8_f32(C1[4 * k + 2], C1[4 * k + 3], v_, true); PC[4 + k] = v_; } \
        A8_SB(); } while (0)
    i32x8 pA, pB;
#pragma unroll
    for (int k = 0; k < 8; ++k) { pA[k] = 0; pB[k] = 0; }
    for (int t = 0; t < NT; t += 4) {
        asm volatile("s_waitcnt vmcnt(0) lgkmcnt(0)\n\ts_barrier" ::: "memory");
        if (isk) {
#pragma unroll
            for (int j = 5; j <= 8; ++j) if (t + j < NT) A8_DMA(t + j);
        } else {
#pragma unroll
            for (int j = 3; j <= 6; ++j) if (t + j < NT) A8_DMA(t + j);
        }
        bg.step();
        A8_TILE(sA0, sA1, sB0, sB1, pB, pA, t + 1, (t > 0 ? t - 1 : 0));
        A8_TILE(sB0, sB1, sA0, sA1, pA, pB, t + 2, t);
        A8_TILE(sA0, sA1, sB0, sB1, pB, pA, t + 3, t + 1);
        A8_TILE(sB0, sB1, sA0, sA1, pA, pB, t + 4, t + 2);
    }
    asm volatile("s_waitcnt vmcnt(0) lgkmcnt(0)\n\ts_barrier" ::: "memory");
    {
        const lds_cptr vp_ = vbase + ((NT - 1) & (NS - 1)) * SLOT; const i32x8 vf0_ = frag(vp_), vf1_ = frag(vp_ + 512);
        o0 = A8_MFMA(pB, vf0_, o0); o1 = A8_MFMA(pB, vf1_, o1); lacc = A8_MFMA(pB, ones8, lacc); }
#undef A8_EX8
#undef A8_TILE
#undef A8_SB
    (void)wsf;
    float rli[16];
#pragma unroll
    for (int r = 0; r < 16; ++r) rli[r] = __builtin_amdgcn_rcpf(lacc[r]);
    bf16* Ow = T.O + (size_t)(q0 + wid * QBLK) * 512 + h * 64;
    { bf16* stg = (bf16*)(shm + LDS_OST) + wid * 2048;
#pragma unroll
      for (int r = 0; r < 16; ++r) { const int orow = crow(r, hi); stg[orow * 64 + r32] = __float2bfloat16(o0[r] * rli[r]); stg[orow * 64 + 32 + r32] = __float2bfloat16(o1[r] * rli[r]); }
      asm volatile("s_waitcnt lgkmcnt(0)" ::: "memory");
#pragma unroll
      for (int i = 0; i < 4; ++i) { const int row = i * 8 + (lane >> 3), ch = lane & 7; const u32x4 v = *(const u32x4*)(stg + row * 64 + ch * 8); *(u32x4*)(Ow + (size_t)row * 512 + ch * 8) = v; } }
    asm volatile("s_waitcnt vmcnt(0) lgkmcnt(0)\n\ts_barrier" ::: "memory");
#undef A8_DMA
}
template <class Bg>
__device__ __forceinline__ void phase(char* lds, const Tensors& T, int grid, int block, int wave_, float negM8, Bg& bg) {
    const int vcu = (grid % 8 == 0) ? (block % 8) * (grid / 8) + block / 8 : block;
    constexpr int NU = NHEAD * NQB;
    if (NU % grid == 0) { const int per = NU / grid; for (int i = 0; i < per; ++i) { const int uu = vcu * per + i; unit(uu / NQB, uu % NQB, T, lds, wave_, negM8, bg); } }
    else for (int uu = vcu; uu < NU; uu += grid) unit(uu / NQB, uu % NQB, T, lds, wave_, negM8, bg);
}
#undef A8_MFMA
}

namespace hg {
typedef short bf16x8 __attribute__((ext_vector_type(8)));
typedef short s16x4 __attribute__((ext_vector_type(4)));
constexpr int CH = 32, SEGT = 512, NSEG = S / SEGT, NCH = SEGT / CH;
constexpr int RS = 272, TS = 80;
constexpr int QOFF = 0, KOFF = 32 * RS, KTOFF = 2 * 32 * RS, VTOFF = KTOFF + 128 * TS, DOFF = VTOFF + 128 * TS, GOFF = DOFF + 512, BUFB = GOFF + 4096;
static_assert(2 * BUFB <= 131072, "hgrn LDS");
#define HG_MFMA(a, b, c) __builtin_amdgcn_mfma_f32_16x16x32_bf16((a), (b), (c), 0, 0, 0)
__device__ __forceinline__ unsigned pkbf(float lo, float hi) { typedef float f2 __attribute__((ext_vector_type(2))); typedef __bf16 b2 __attribute__((ext_vector_type(2))); f2 v = {lo, hi}; b2 b = __builtin_convertvector(v, b2); return __builtin_bit_cast(unsigned, b); }

typedef float f32x2h __attribute__((ext_vector_type(2)));
template <bool OUT>
__device__ __forceinline__ void chunk_matrix(LAS unsigned char* B, f32x4 (&Sacc)[8], int c16, int g, int e0, int dir, int h, int p0c, float* __restrict__ OF) {
    if (OUT) {
        f32x4 X00 = {0.f, 0.f, 0.f, 0.f}, X01 = X00, X11 = X00;
#pragma unroll
        for (int s = 0; s < 4; ++s) {
            const bf16x8 aK0 = *(const LAS bf16x8*)(B + KOFF + c16 * RS + (32 * s + 8 * g) * 2), aK1 = *(const LAS bf16x8*)(B + KOFF + (16 + c16) * RS + (32 * s + 8 * g) * 2);
            const bf16x8 bQ0 = *(const LAS bf16x8*)(B + QOFF + c16 * RS + (32 * s + 8 * g) * 2), bQ1 = *(const LAS bf16x8*)(B + QOFF + (16 + c16) * RS + (32 * s + 8 * g) * 2);
            X00 = HG_MFMA(aK0, bQ0, X00); X01 = HG_MFMA(aK0, bQ1, X01); X11 = HG_MFMA(aK1, bQ1, X11);
        }
#pragma unroll
        for (int r = 0; r < 4; ++r) { const bool keep = (4 * g + r) <= c16; X00[r] = keep ? X00[r] : 0.f; X11[r] = keep ? X11[r] : 0.f; }
        u32x4 a0w, a1w; a0w.x = pkbf(X00[0], X00[1]); a0w.y = pkbf(X00[2], X00[3]); a0w.z = 0u; a0w.w = 0u;
        a1w.x = pkbf(X01[0], X01[1]); a1w.y = pkbf(X01[2], X01[3]); a1w.z = pkbf(X11[0], X11[1]); a1w.w = pkbf(X11[2], X11[3]);
        const u32x2 vlo = *(const LAS u32x2*)(B + VTOFF + (e0 + c16) * TS + (4 * g) * 2), vhi = *(const LAS u32x2*)(B + VTOFF + (e0 + c16) * TS + (16 + 4 * g) * 2);
        u32x4 vbw; vbw.x = vlo.x; vbw.y = vlo.y; vbw.z = vhi.x; vbw.w = vhi.y;
        const bf16x8 vb = __builtin_bit_cast(bf16x8, vbw);
        f32x4 O0 = {0.f, 0.f, 0.f, 0.f}, O1 = O0;
        O0 = HG_MFMA(__builtin_bit_cast(bf16x8, a0w), vb, O0); O1 = HG_MFMA(__builtin_bit_cast(bf16x8, a1w), vb, O1);
#pragma unroll
        for (int s = 0; s < 4; ++s) {
            u32x4 sw; sw.x = pkbf(Sacc[2 * s][0], Sacc[2 * s][1]); sw.y = pkbf(Sacc[2 * s][2], Sacc[2 * s][3]); sw.z = pkbf(Sacc[2 * s + 1][0], Sacc[2 * s + 1][1]); sw.w = pkbf(Sacc[2 * s + 1][2], Sacc[2 * s + 1][3]);
            const bf16x8 sb = __builtin_bit_cast(bf16x8, sw);
            const u32x2 q0l = *(const LAS u32x2*)(B + QOFF + c16 * RS + (32 * s + 4 * g) * 2), q0h = *(const LAS u32x2*)(B + QOFF + c16 * RS + (32 * s + 16 + 4 * g) * 2);
            const u32x2 q1l = *(const LAS u32x2*)(B + QOFF + (16 + c16) * RS + (32 * s + 4 * g) * 2), q1h = *(const LAS u32x2*)(B + QOFF + (16 + c16) * RS + (32 * s + 16 + 4 * g) * 2);
            u32x4 q0w, q1w; q0w.x = q0l.x; q0w.y = q0l.y; q0w.z = q0h.x; q0w.w = q0h.y; q1w.x = q1l.x; q1w.y = q1l.y; q1w.z = q1h.x; q1w.w = q1h.y;
            O0 = HG_MFMA(__builtin_bit_cast(bf16x8, q0w), sb, O0); O1 = HG_MFMA(__builtin_bit_cast(bf16x8, q1w), sb, O1);
        }
        { const int gm = dir ? 3 - g : g; const unsigned ooff = (unsigned)(4 * gm) * 512u + (unsigned)(e0 + c16);
          GAS float* ofu = (GAS float*)OF + (size_t)dir * S * 512 + h * 128;
          const int Tb = dir ? (S - 32 - p0c) : p0c;
#pragma unroll
          for (int r = 0; r < 4; ++r) {
              ofu[(size_t)(Tb + (dir ? 16 + 3 - r : r)) * 512 + ooff] = O0[r];
              ofu[(size_t)(Tb + (dir ? 3 - r : 16 + r)) * 512 + ooff] = O1[r];
          } }
    }
    {
        const bf16x8 vB = *(const LAS bf16x8*)(B + VTOFF + (e0 + c16) * TS + (8 * g) * 2);
#pragma unroll
        for (int dt = 0; dt < 8; ++dt) {
            const bf16x8 aT = *(const LAS bf16x8*)(B + KTOFF + (16 * dt + c16) * TS + (8 * g) * 2);
            Sacc[dt] = HG_MFMA(aT, vB, Sacc[dt]);
            const f32x4 dv = *(const LAS f32x4*)(B + DOFF + (16 * dt + 4 * g) * 4);
            Sacc[dt] = Sacc[dt] * dv;
        }
    }
}
template <bool OUT>
__device__ __forceinline__ void segment(LAS unsigned char* lds, int unit, const bf16_t* __restrict__ HQ, const float* __restrict__ LF, const bf16_t* __restrict__ KF,
                                        const bf16_t* __restrict__ HV, float* __restrict__ HST, float* __restrict__ HSD, float* __restrict__ OF, int wave_) {
    const int tid_ = wave_ * 64 + lane_id_opaque();
    const int tid = tid_, lane = tid & 63, w = __builtin_amdgcn_readfirstlane(tid >> 6), c16 = lane & 15, g = lane >> 4;
    const int dir = unit >> 7, h = (unit >> 5) & 3, seg = unit & 31;
    const int d0 = 2 * (tid & 63), tg = tid >> 6;
    f32x4 Sacc[8];
    float* hst = HST + (size_t)unit * 16384 + (size_t)w * 2048 + lane;
    if (OUT) {
#pragma unroll
        for (int dt = 0; dt < 8; ++dt) { Sacc[dt][0] = hst[(dt * 4 + 0) * 64]; Sacc[dt][1] = hst[(dt * 4 + 1) * 64]; Sacc[dt][2] = hst[(dt * 4 + 2) * 64]; Sacc[dt][3] = hst[(dt * 4 + 3) * 64]; }
    } else {
#pragma unroll
        for (int dt = 0; dt < 8; ++dt) Sacc[dt] = f32x4{0.f, 0.f, 0.f, 0.f};
    }
    f32x2h segsum = {0.f, 0.f};
    const int e0 = 16 * w;
    constexpr int RING = 2;
    f32x2h rl[RING][4]; unsigned rk[RING][4], rq[RING][4], rv[RING][4];
    const int tgm = dir ? 7 - tg : tg;
    const unsigned toff = (unsigned)(4 * tgm) * 512u + (unsigned)d0;
    const GAS float* lfu = (const GAS float*)LF + (size_t)dir * S * 512 + h * 128;
    const GAS bf16_t* kfu = (const GAS bf16_t*)KF + (size_t)dir * S * 512 + h * 128;
    const GAS bf16_t* hqu = (const GAS bf16_t*)HQ + h * 128; const GAS bf16_t* hvu = (const GAS bf16_t*)HV + h * 128;
#define HG_LOAD(sl, cc) do { const int Tb_ = dir ? (S - 32 - (seg * SEGT + (cc) * CH)) : (seg * SEGT + (cc) * CH); \
        _Pragma("unroll") for (int jj = 0; jj < 4; ++jj) { const size_t ub_ = (size_t)(Tb_ + (dir ? 3 - jj : jj)) * 512; \
        rl[sl][jj] = *(const GAS f32x2h*)(lfu + ub_ + toff); rk[sl][jj] = *(const GAS unsigned*)(kfu + ub_ + toff); rv[sl][jj] = *(const GAS unsigned*)(hvu + ub_ + toff); \
        rq[sl][jj] = OUT ? *(const GAS unsigned*)(hqu + ub_ + toff) : 0u; } } while (0)
#pragma unroll
    for (int sl = 0; sl < RING; ++sl) HG_LOAD(sl, sl);
    for (int c4 = 0; c4 < NCH; c4 += RING) {
#pragma unroll
        for (int sl = 0; sl < RING; ++sl) {
            const int c = c4 + sl;
            LAS unsigned char* B = lds + (c & 1) * BUFB;
            f32x2h cs[4]; unsigned kk[4], qq[4], vv[4];
#pragma unroll
            for (int jj = 0; jj < 4; ++jj) { cs[jj] = rl[sl][jj]; kk[jj] = rk[sl][jj]; qq[jj] = rq[sl][jj]; vv[jj] = rv[sl][jj]; }
            if (c + RING < NCH) HG_LOAD(sl, c + RING);
#pragma unroll
            for (int jj = 1; jj < 4; ++jj) cs[jj] += cs[jj - 1];
            LAS float* gs = (LAS float*)(B + GOFF);
            *(LAS f32x2h*)(gs + tg * 128 + d0) = cs[3];
            __syncthreads();
            f32x2h off = {0.f, 0.f}, tot = {0.f, 0.f};
#pragma unroll
            for (int q = 0; q < 8; ++q) { const f32x2h gq = *(const LAS f32x2h*)(gs + q * 128 + d0); tot += gq; if (q < tg) off += gq; }
            float kt0[4], kt1[4];
#pragma unroll
            for (int jj = 0; jj < 4; ++jj) {
                const float b0 = fmaxf(off.x + cs[jj].x, -80.f), b1 = fmaxf(off.y + cs[jj].y, -80.f);
                kt0[jj] = bflo(kk[jj]) * __expf(-b0); kt1[jj] = bfhi(kk[jj]) * __expf(-b1);
                if (OUT) {
                    *(LAS unsigned*)(B + QOFF + (4 * tg + jj) * RS + d0 * 2) = pkbf(bflo(qq[jj]) * __expf(b0), bfhi(qq[jj]) * __expf(b1));
                    *(LAS unsigned*)(B + KOFF + (4 * tg + jj) * RS + d0 * 2) = pkbf(kt0[jj], kt1[jj]);
                }
            }
            { u32x2 o0, o1; o0.x = pkbf(kt0[0], kt0[1]); o0.y = pkbf(kt0[2], kt0[3]); o1.x = pkbf(kt1[0], kt1[1]); o1.y = pkbf(kt1[2], kt1[3]);
              *(LAS u32x2*)(B + KTOFF + d0 * TS + 8 * tg) = o0; *(LAS u32x2*)(B + KTOFF + (d0 + 1) * TS + 8 * tg) = o1;
              u32x2 v0, v1; v0.x = (vv[0] & 0xffffu) | (vv[1] << 16); v0.y = (vv[2] & 0xffffu) | (vv[3] << 16); v1.x = (vv[0] >> 16) | (vv[1] & 0xffff0000u); v1.y = (vv[2] >> 16) | (vv[3] & 0xffff0000u);
              *(LAS u32x2*)(B + VTOFF + d0 * TS + 8 * tg) = v0; *(LAS u32x2*)(B + VTOFF + (d0 + 1) * TS + 8 * tg) = v1; }
            if (tg == 0) { f32x2h dv; dv.x = __expf(fmaxf(tot.x, -80.f)); dv.y = __expf(fmaxf(tot.y, -80.f)); *(LAS f32x2h*)(B + DOFF + d0 * 4) = dv; }
            segsum += tot;
            __syncthreads();
            chunk_matrix<OUT>(B, Sacc, c16, g, e0, dir, h, seg * SEGT + c * CH, OF);
        }
    }
    if (!OUT) {
#pragma unroll
        for (int dt = 0; dt < 8; ++dt) { hst[(dt * 4 + 0) * 64] = Sacc[dt][0]; hst[(dt * 4 + 1) * 64] = Sacc[dt][1]; hst[(dt * 4 + 2) * 64] = Sacc[dt][2]; hst[(dt * 4 + 3) * 64] = Sacc[dt][3]; }
        if (tid < 64) { f32x2h dd; dd.x = __expf(fmaxf(segsum.x, -80.f)); dd.y = __expf(fmaxf(segsum.y, -80.f)); *(f32x2h*)(HSD + (size_t)unit * 128 + d0) = dd; }
    }
    __syncthreads();
}
__device__ __forceinline__ void carry(float* __restrict__ HST, const float* __restrict__ HSD, int gid) {
    const int chain = gid >> 14, el = gid & 16383, dt = (el >> 8) & 7, r = (el >> 6) & 3, ln = el & 63, d = 16 * dt + 4 * (ln >> 4) + r;
    float cy = 0.f;
    for (int sg = 0; sg < NSEG; ++sg) {
        const int u = chain * NSEG + sg;
        const float tmp = HST[(size_t)u * 16384 + el];
        HST[(size_t)u * 16384 + el] = cy;
        cy = HSD[(size_t)u * 128 + d] * cy + tmp;
    }
}
#undef HG_MFMA
#undef HG_LOAD
}

#define XB_TMO      128
#define XB_XCNT(j)  (256  + 64 * (j))
#define XB_XSUB(j)  (1280 + 64 * (j))
#define XB_XGEN(j)  (2304 + 64 * (j))
#define XB_TOP      3328
#define XB_TOPGEN   3392
#define XCD_BAR_WORDS 3456
#define XB_SPIN_CAP (1u << 18)

__device__ __forceinline__ unsigned xb_ld(unsigned* p)              { return __hip_atomic_load(p, __ATOMIC_RELAXED, __HIP_MEMORY_SCOPE_AGENT); }
__device__ __forceinline__ unsigned xb_add(unsigned* p, unsigned v) { return __hip_atomic_fetch_add(p, v, __ATOMIC_RELAXED, __HIP_MEMORY_SCOPE_AGENT); }
__device__ __forceinline__ unsigned xb_xcc_id() { return (unsigned)__builtin_amdgcn_s_getreg((3 << 11) | 20) & 0xFu; }
#define XB_SPIN(cond, bar) do { unsigned _sp = 0; while (cond) { __builtin_amdgcn_s_sleep(1); \
    if ((++_sp & 255u) == 0u) { if (xb_ld(&(bar)[XB_TMO])) break; if (_sp > XB_SPIN_CAP) { atomicAdd(&(bar)[XB_TMO], 1u); break; } } } } while (0)

struct XcdBarrier {
    int wv;
    unsigned* bar; unsigned x;
    volatile LAS unsigned* st;
};

__device__ __forceinline__ XcdBarrier xcd_barrier_post(unsigned* bar, volatile LAS unsigned* st) {
    XcdBarrier b; b.bar = bar; b.x = xb_xcc_id(); b.st = st; b.wv = __builtin_amdgcn_readfirstlane((int)threadIdx.x >> 6);
    if (threadIdx.x == 0) (void)xb_add(&bar[XB_XCNT(b.x)], 1u);
    return b;
}
__device__ __forceinline__ void xcd_barrier_complete(unsigned* bar, unsigned x, unsigned& nloc, unsigned& nx) {
    const unsigned G = gridDim.x * gridDim.y * gridDim.z;
    unsigned sum, cnt, mine, sp = 0u;
    for (;;) {
        sum = 0u; cnt = 0u; mine = 0u;
#pragma unroll
        for (unsigned j = 0; j < 16; ++j) { const unsigned c = xb_ld(&bar[XB_XCNT(j)]); sum += c; cnt += (c > 0u) ? 1u : 0u; mine = (j == x) ? c : mine; }
        if (sum == G) break;
        __builtin_amdgcn_s_sleep(1);
        if ((++sp & 255u) == 0u) { if (xb_ld(&bar[XB_TMO])) break; if (sp > XB_SPIN_CAP) { atomicAdd(&bar[XB_TMO], 1u); break; } }
    }
    nloc = mine > 0u ? mine : 1u; nx = cnt > 0u ? cnt : 1u;
}

__device__ __forceinline__ void xcd_barrier(const XcdBarrier& b) {
    asm volatile("s_waitcnt vmcnt(0)" ::: "memory");
    __syncthreads();
    if (b.wv == 0 && lane_id_opaque() == 0) {
        unsigned* bar = b.bar;
        __builtin_amdgcn_s_waitcnt(0);
        unsigned nloc = b.st[0], nx = b.st[1];
        if (nloc == 0u) { xcd_barrier_complete(bar, b.x, nloc, nx); b.st[0] = nloc; b.st[1] = nx; }
        const unsigned old = xb_add(&bar[XB_XSUB(b.x)], 1u);
        const unsigned gen = old / nloc;
        if (old + 1u == (gen + 1u) * nloc) {
            __builtin_amdgcn_fence(__ATOMIC_RELEASE, "agent");
            asm volatile("s_waitcnt vmcnt(0)" ::: "memory");
            const unsigned og = xb_add(&bar[XB_TOP], 1u);
            const unsigned tg = og / nx;
            if (og + 1u == (tg + 1u) * nx) xb_add(&bar[XB_TOPGEN], 1u);
            else XB_SPIN(xb_ld(&bar[XB_TOPGEN]) == tg, bar);
            __builtin_amdgcn_fence(__ATOMIC_ACQUIRE, "agent");
            xb_add(&bar[XB_XGEN(b.x)], 1u);
            asm volatile("s_waitcnt vmcnt(0)" ::: "memory");
        } else {
            XB_SPIN(xb_ld(&bar[XB_XGEN(b.x)]) == gen, bar);
            __builtin_amdgcn_fence(__ATOMIC_ACQUIRE, "agent");
            asm volatile("s_waitcnt vmcnt(0)" ::: "memory");
        }
    }
    __syncthreads();
}

constexpr int NWAVES = 8;
constexpr int RING_OFF = 0, RING_BYTES = 131072;
constexpr int LDSCTL_OFF = RING_BYTES, MISC_OFF = LDSCTL_OFF + 320;
constexpr int LDS_BYTES = 147456;
constexpr int CW_BAR = 4096;
constexpr int NPL = 12;
constexpr int PH_PRO = 0, PH_NORM1 = 1, PH_L0 = 2, PH_END = PH_L0 + NL * NPL;
enum { P_G1 = 0, P_QKP = 1, P_HGB = 2, P_HGC = 3, P_ATT = 4, P_G2 = 5, P_G3 = 6, P_N2R = 7, P_TOPK = 8, P_G4 = 9, P_G5 = 10, P_COMB = 11 };

#ifndef KEEP_BF16_QK
#define KEEP_BF16_QK 0
#endif
#ifndef REP_HG
#define REP_HG 1
#endif
#ifndef REP_PRO
#define REP_PRO 1
#endif
#ifndef REP_ROW
#define REP_ROW 1
#endif
#ifndef REP_G
#define REP_G 1
#endif
#ifndef REP_TK
#define REP_TK 1
#endif
#ifndef REP_QK
#define REP_QK 1
#endif
#ifndef REP_ATT
#define REP_ATT 1
#endif
struct Params {
    const float *x, *c, *ada_w, *ada_b, *norm_mix_w, *norm_ffn_w, *w_in, *q_norm_w, *k_norm_w, *hlb, *hg_norm_w, *w_ba, *w_bh, *w_out, *w_router, *w_eg, *w_eu, *w_ed;
    float* out; unsigned char* ws;
    int ph_lo, ph_hi, li, pad;
};
struct Frame {
    LAS unsigned char* lds;
    int tid, lane, wave, vcu, G;
};

__device__ __forceinline__ void tr_tile(const float* __restrict__ src, int ldw, bf16_t* __restrict__ dst, int Kd, LAS float* scr, int lane) {
    f32x4 v[8];
#pragma unroll
    for (int i = 0; i < 8; ++i) v[i] = *(const f32x4*)(src + (size_t)(8 * i + (lane >> 3)) * ldw + 4 * (lane & 7));
#pragma unroll
    for (int i = 0; i < 8; ++i) { LAS float* s = scr + (8 * i + (lane >> 3)) * 33 + 4 * (lane & 7); s[0] = v[i].x; s[1] = v[i].y; s[2] = v[i].z; s[3] = v[i].w; }
    asm volatile("s_waitcnt lgkmcnt(0)" ::: "memory");
    const int cch = lane & 7;
#pragma unroll
    for (int j = 0; j < 4; ++j) { const int n = (lane >> 3) + 8 * j; const LAS float* s = scr + (8 * cch) * 33 + n;
        u32x4 o; o.x = pk2(s[0 * 33], s[1 * 33]); o.y = pk2(s[2 * 33], s[3 * 33]); o.z = pk2(s[4 * 33], s[5 * 33]); o.w = pk2(s[6 * 33], s[7 * 33]);
        *(u32x4*)(dst + (size_t)n * Kd + 8 * cch) = o; }
    asm volatile("s_waitcnt lgkmcnt(0)" ::: "memory");
}
struct ConvItem { const float* src; unsigned char* dst; int ldw, Kd; };
__device__ __forceinline__ ConvItem conv_item_f8(const Params& p, int l, int it) {
    ConvItem c;
    const int which = it / (NE * 1024), r0 = it % (NE * 1024), e = r0 >> 10, r = r0 & 1023;
    if (which < 2) {
        const int kb = r >> 6, nb = r & 63, n0 = 32 * nb;
        const float* W = (which == 0 ? p.w_eg : p.w_eu) + (size_t)(l * NE + e) * D * FF;
        const int rho = e * 4096 + (n0 >> 7) * 256 + which * 128 + (n0 & 127);
        c.src = W + (size_t)(64 * kb) * FF + n0; c.ldw = FF; c.dst = p.ws + WS_WGU + (size_t)l * 64 * MiB + (size_t)rho * D + 64 * kb; c.Kd = D;
    } else {
        const int kb = r >> 5, nb = r & 31, n0 = 32 * nb;
        const float* W = p.w_ed + (size_t)(l * NE + e) * FF * D;
        c.src = W + (size_t)(64 * kb) * D + n0; c.ldw = D; c.dst = p.ws + WS_WD + (size_t)l * 32 * MiB + (size_t)(e * 1024 + n0) * FF + 64 * kb; c.Kd = FF;
    }
    return c;
}
__device__ __forceinline__ void conv_load8(const ConvItem& c, int lane, f32x4 (&v)[8]) {
#pragma unroll
    for (int i = 0; i < 8; ++i) v[i] = *(const f32x4*)(c.src + (size_t)(8 * i + (lane >> 3)) * c.ldw + 4 * (lane & 7));
}
__device__ __forceinline__ void conv_store_f8(const ConvItem& c, int lane, const f32x4 (&v)[8], LAS float* scr, float scale) {
#pragma unroll
    for (int i = 0; i < 8; ++i) { LAS float* s = scr + (8 * i + (lane >> 3)) * 33 + 4 * (lane & 7); s[0] = v[i].x; s[1] = v[i].y; s[2] = v[i].z; s[3] = v[i].w; }
    asm volatile("s_waitcnt lgkmcnt(0)" ::: "memory");
    const int cch = lane & 7;
#pragma unroll
    for (int j = 0; j < 4; ++j) { const int n = (lane >> 3) + 8 * j; const LAS float* s = scr + (8 * cch) * 33 + n;
        const f32x4 a = {s[0 * 33] * scale, s[1 * 33] * scale, s[2 * 33] * scale, s[3 * 33] * scale}, b = {s[4 * 33] * scale, s[5 * 33] * scale, s[6 * 33] * scale, s[7 * 33] * scale};
        *(u32x2*)(c.dst + (size_t)n * c.Kd + 8 * cch) = pg8::pack8_fp8(a, b); }
    asm volatile("s_waitcnt lgkmcnt(0)" ::: "memory");
}
struct BgNone { __device__ __forceinline__ void step() {} };
struct BgConv {
    const float *eg, *eu, *ed; unsigned char* ws; LAS unsigned char* scr; int lane, it, stride, nit, l; bool have; ConvItem cur; f32x4 v[4];
    __device__ __forceinline__ ConvItem item(int i) const {
        ConvItem c; const int it_ = i;
        const int which = it_ / (NE * 2048), r0 = it_ % (NE * 2048), e = r0 >> 11, r = r0 & 2047;
        if (which < 2) { const int kb = r >> 6, nb = r & 63, n0 = 32 * nb; const float* W = (which == 0 ? eg : eu) + (size_t)(l * NE + e) * D * FF;
            const int rho = e * 4096 + (n0 >> 7) * 256 + which * 128 + (n0 & 127);
            c.src = W + (size_t)(32 * kb) * FF + n0; c.ldw = FF; c.dst = ws + WS_WGU + (size_t)l * 64 * MiB + (size_t)rho * D + 32 * kb; c.Kd = D; }
        else { const int kb = r >> 5, nb = r & 31, n0 = 32 * nb; const float* W = ed + (size_t)(l * NE + e) * FF * D;
            c.src = W + (size_t)(32 * kb) * D + n0; c.ldw = D; c.dst = ws + WS_WD + (size_t)l * 32 * MiB + (size_t)(e * 1024 + n0) * FF + 32 * kb; c.Kd = FF; }
        return c; }
    __device__ __forceinline__ void load(const ConvItem& c) {
#pragma unroll
        for (int i = 0; i < 4; ++i) v[i] = *(const GAS f32x4*)((const GAS float*)c.src + (size_t)(8 * i + (lane >> 3)) * c.ldw + 4 * (lane & 7));
    }
    __device__ __forceinline__ void init(const Params& p, int layer, LAS unsigned char* scr_, int lane_, int gw, int ngw) {
        eg = p.w_eg; eu = p.w_eu; ed = p.w_ed; ws = p.ws; l = layer; scr = scr_; lane = lane_; it = gw; stride = ngw; nit = 3 * NE * 2048; have = it < nit;
        if (have) { cur = item(it); load(cur); }
    }
    __device__ __forceinline__ void process(const ConvItem& c, const f32x4 (&w)[4]) {
        LAS unsigned* s32 = (LAS unsigned*)scr;
#pragma unroll
        for (int i = 0; i < 4; ++i) { int wd; asm volatile("" : "=v"(wd)); wd = __builtin_amdgcn_cvt_pk_fp8_f32(w[i].x * 64.0f, w[i].y * 64.0f, wd, false); wd = __builtin_amdgcn_cvt_pk_fp8_f32(w[i].z * 64.0f, w[i].w * 64.0f, wd, true);
            s32[(8 * i + (lane >> 3)) * 10 + (lane & 7)] = (unsigned)wd; }
        asm volatile("s_waitcnt lgkmcnt(0)" ::: "memory");
        typedef int v2i_ __attribute__((ext_vector_type(2)));
        const int gq = lane >> 4, i16 = lane & 15;
#pragma unroll
        for (int nh = 0; nh < 2; ++nh) {
            const v2i_ r = __builtin_amdgcn_ds_read_tr8_b64_v2i32((LAS v2i_*)(scr + (8 * gq + (i16 >> 1)) * 40 + 16 * nh + 8 * (i16 & 1)));
            u32x2 o; o.x = (unsigned)r.x; o.y = (unsigned)r.y;
            *(GAS u32x2*)((GAS unsigned char*)c.dst + (size_t)(16 * nh + i16) * c.Kd + 8 * gq) = o; }
        asm volatile("s_waitcnt lgkmcnt(0)" ::: "memory");
    }
    __device__ __forceinline__ void step() {
        if (!have) return;
        const ConvItem c = cur; f32x4 w[4];
#pragma unroll
        for (int i = 0; i < 4; ++i) w[i] = v[i];
        it += stride; have = it < nit;
        if (have) { cur = item(it); load(cur); }
        process(c, w);
    }
    __device__ __forceinline__ void finish() { while (have) step(); }
};
__device__ __forceinline__ void conv_experts_f8(Frame& F, const Params& p, int l, LAS float* scr) {
    const int gw = F.vcu * NWAVES + F.wave, NGW = F.G * NWAVES, NIT = 3 * NE * 1024;
    int it = gw; if (it >= NIT) return;
    ConvItem cur = conv_item_f8(p, l, it); f32x4 va[8], vb[8];
    conv_load8(cur, F.lane, va);
    for (;;) {
        const int it1 = it + NGW; const bool h1 = it1 < NIT; ConvItem c1 = conv_item_f8(p, l, h1 ? it1 : it);
        if (h1) conv_load8(c1, F.lane, vb);
        conv_store_f8(cur, F.lane, va, scr, 64.0f);
        if (!h1) break;
        const int it2 = it1 + NGW; const bool h2 = it2 < NIT; ConvItem c2 = conv_item_f8(p, l, h2 ? it2 : it1);
        if (h2) conv_load8(c2, F.lane, va);
        conv_store_f8(c1, F.lane, vb, scr, 64.0f);
        if (!h2) break;
        cur = c2; it = it2;
    }
}
__device__ __forceinline__ void conv_matrix(Frame& F, const float* W, int ldw, int K, int N, bf16_t* WT, LAS float* scr) {
    const int gw = F.vcu * NWAVES + F.wave, NGW = F.G * NWAVES, nblk = N / 32, nitems = (K / 64) * nblk;
    for (int it = gw; it < nitems; it += NGW) { const int kb = it / nblk, nb = it % nblk;
        tr_tile(W + (size_t)(64 * kb) * ldw + 32 * nb, ldw, WT + (size_t)(32 * nb) * K + 64 * kb, K, scr, F.lane); }
}
__device__ __forceinline__ void conv_matrix_f8(Frame& F, const float* W, int ldw, int K, int N, unsigned char* WT, LAS float* scr, float scale) {
    const int gw = F.vcu * NWAVES + F.wave, NGW = F.G * NWAVES, nblk = N / 32, nitems = (K / 64) * nblk;
    for (int it = gw; it < nitems; it += NGW) { const int kb = it / nblk, nb = it % nblk;
        ConvItem c; c.src = W + (size_t)(64 * kb) * ldw + 32 * nb; c.ldw = ldw; c.dst = WT + (size_t)(32 * nb) * K + 64 * kb; c.Kd = K;
        f32x4 v[8]; conv_load8(c, F.lane, v); conv_store_f8(c, F.lane, v, scr, scale); }
}
__device__ __forceinline__ void conv_experts(Frame& F, const Params& p, int l, LAS float* scr) {
    const int gw = F.vcu * NWAVES + F.wave, NGW = F.G * NWAVES;
    bf16_t* WGU = (bf16_t*)(p.ws + WS_WGU); bf16_t* WD = (bf16_t*)(p.ws + WS_WD);
    for (int it = gw; it < 3 * NE * 1024; it += NGW) {
        const int which = it / (NE * 1024), r0 = it % (NE * 1024), e = r0 >> 10, r = r0 & 1023;
        if (which < 2) {
            const int kb = r >> 6, nb = r & 63, n0 = 32 * nb;
            const float* W = (which == 0 ? p.w_eg : p.w_eu) + (size_t)(l * NE + e) * D * FF;
            const int rho = e * 4096 + (n0 >> 7) * 256 + which * 128 + (n0 & 127);
            tr_tile(W + (size_t)(64 * kb) * FF + n0, FF, WGU + (size_t)rho * D + 64 * kb, D, scr, F.lane);
        } else {
            const int kb = r >> 5, nb = r & 31, n0 = 32 * nb;
            const float* W = p.w_ed + (size_t)(l * NE + e) * FF * D;
            tr_tile(W + (size_t)(64 * kb) * D + n0, D, WD + (size_t)(e * 1024 + n0) * FF + 64 * kb, FF, scr, F.lane);
        }
    }
}
__device__ __forceinline__ void mod_units(Frame& F, const Params& p) {
    LAS float* sc = (LAS float*)(F.lds + 96 * 1024);
    LAS float* red = sc + 1024;
    float* MOD = (float*)(p.ws + WS_MOD); float* LBV = (float*)(p.ws + WS_LBV);
    for (int u = blockIdx.x; u < NL * 96; u += F.G) {
        for (int i = F.tid; i < D; i += 512) sc[i] = siluf_(p.c[i]);
        __syncthreads();
        const int l = u / 96, j = (u % 96) * 64 + (F.tid & 63), kp = F.tid >> 6;
        const float* w = p.ada_w + (size_t)l * D * 6 * D + (size_t)(kp * 128) * 6 * D + j;
        float acc = 0.f;
#pragma unroll 8
        for (int k = 0; k < 128; ++k) acc += sc[kp * 128 + k] * w[(size_t)k * 6 * D];
        red[kp * 64 + (F.tid & 63)] = acc;
        __syncthreads();
        if (F.tid < 64) { float s = 0.f;
#pragma unroll
            for (int q = 0; q < 8; ++q) s += red[q * 64 + F.tid];
            MOD[l * 6 * D + j] = s + p.ada_b[l * 6 * D + j]; }
        __syncthreads();
    }
    const int n = blockIdx.x * 512 + F.tid;
    if (n < NL * 1024) { const int l = n / 1024, r = n % 1024; float v = 0.f;
        if (l == 1) { const float b0 = p.hlb[r], b1 = p.hlb[1024 + r]; v = 1.0f / (1.0f + __expf(b0 - b1)); }
        LBV[n] = v; }
}

__device__ __forceinline__ f32x4 unpk4(const u32x2 q) { return f32x4{bflo(q.x), bfhi(q.x), bflo(q.y), bfhi(q.y)}; }
__device__ __forceinline__ void norm_mod_row(const f32x4 (&v)[4], float ss, const float* __restrict__ w, const float* __restrict__ scale,
                                             const float* __restrict__ shift, bf16_t* __restrict__ orow, int lane, f32x4 (&h)[4], unsigned char* __restrict__ orow8 = nullptr) {
    const float r = rsqrtf(ss * (1.0f / D) + EPS);
#pragma unroll
    for (int j = 0; j < 4; ++j) {
        const int c0 = 4 * lane + 256 * j;
        const f32x4 wv = *(const f32x4*)(w + c0), sv = *(const f32x4*)(scale + c0), bv = *(const f32x4*)(shift + c0);
        h[j] = (v[j] * r) * wv * (sv + 1.0f) + bv;
        u32x2 o; o.x = pk2(h[j].x, h[j].y); o.y = pk2(h[j].z, h[j].w);
        *(u32x2*)(orow + c0) = o;
        if (orow8) { int wd = 0; wd = __builtin_amdgcn_cvt_pk_fp8_f32(h[j].x, h[j].y, wd, false); wd = __builtin_amdgcn_cvt_pk_fp8_f32(h[j].z, h[j].w, wd, true); *(int*)(orow8 + c0) = wd; }
    }
}
__device__ __forceinline__ void norm_mod_row_f8(const f32x4 (&v)[4], float ss, const float* __restrict__ w, const float* __restrict__ scale,
                                                const float* __restrict__ shift, unsigned char* __restrict__ orow, int lane, f32x4 (&h)[4]) {
    const float r = rsqrtf(ss * (1.0f / D) + EPS);
#pragma unroll
    for (int j = 0; j < 4; ++j) {
        const int c0 = 4 * lane + 256 * j;
        const f32x4 wv = *(const f32x4*)(w + c0), sv = *(const f32x4*)(scale + c0), bv = *(const f32x4*)(shift + c0);
        h[j] = (v[j] * r) * wv * (sv + 1.0f) + bv;
        int wd = 0; wd = __builtin_amdgcn_cvt_pk_fp8_f32(h[j].x, h[j].y, wd, false); wd = __builtin_amdgcn_cvt_pk_fp8_f32(h[j].z, h[j].w, wd, true);
        *(int*)(orow + c0) = wd;
    }
}
__device__ __forceinline__ void ph_norm1(Frame& F, const float* x, const float* w, const float* scale, const float* shift, bf16_t* HB, unsigned char* HB8) {
    const int gw = F.vcu * NWAVES + F.wave, NGW = F.G * NWAVES;
    for (int row = gw; row < S; row += NGW) {
        const f32x4* xr = (const f32x4*)(x + (size_t)row * D) + F.lane;
        f32x4 v[4], h[4]; float ss = 0.f;
#pragma unroll
        for (int j = 0; j < 4; ++j) { v[j] = xr[64 * j]; ss += (v[j].x * v[j].x + v[j].y * v[j].y) + (v[j].z * v[j].z + v[j].w * v[j].w); }
        ss = wave_sum(ss);
        norm_mod_row(v, ss, w, scale, shift, HB + (size_t)row * D, F.lane, h);
    }
}
__device__ __forceinline__ void ph_gather(Frame& F, const unsigned char* HB8, const int* IDX, unsigned char* XE8) {
    const int gw = F.vcu * NWAVES + F.wave, NGW = F.G * NWAVES;
    constexpr int PER = NE * CAP / 2048;
    if (NGW * PER == NE * CAP) {
        const int r0 = gw * PER;
        const int mine = IDX[r0 + (F.lane & 15)];
#pragma unroll
        for (int q = 0; q < PER; q += 8) {
            u32x4 a[8];
#pragma unroll
            for (int k = 0; k < 8; ++k) { const int t = __builtin_amdgcn_readlane(mine, q + k); a[k] = ((const u32x4*)(HB8 + (size_t)t * D))[F.lane]; }
#pragma unroll
            for (int k = 0; k < 8; ++k) ((u32x4*)(XE8 + (size_t)(r0 + q + k) * D))[F.lane] = a[k];
        }
    } else {
        for (int r = gw; r < NE * CAP; r += NGW) { const int t = IDX[r]; ((u32x4*)(XE8 + (size_t)r * D))[F.lane] = ((const u32x4*)(HB8 + (size_t)t * D))[F.lane]; }
    }
}

#define OPAQUE_LANE() const int lane = lane_id_opaque(); const int t_ = F.wave * 64 + lane
__device__ __forceinline__ void ph_rope_table(Frame& F, float* ROPE) {
    OPAQUE_LANE();
    const int n = blockIdx.x * 512 + t_;
    if (n < 4096) { const int pos = n >> 4, i = n & 15; const float inv = exp2f(-(float)i * (13.287712379549449f / 16.0f)); float sn, cs; sincosf((float)pos * inv, &sn, &cs); ROPE[2 * n] = cs; ROPE[2 * n + 1] = sn; }
}
__device__ __forceinline__ void ph_qkprep(Frame& F, const bf16_t* __restrict__ QR, const bf16_t* __restrict__ KR, const float* __restrict__ qw, const float* __restrict__ kw,
                                          const float* __restrict__ ROPE, bf16_t* __restrict__ QN, bf16_t* __restrict__ KN, unsigned char* __restrict__ Q8, unsigned char* __restrict__ K8, int rank, int nranks) {
    OPAQUE_LANE(); (void)lane;
    if (rank < 0) return;
    for (int gid = rank * 512 + t_; gid < S * 10; gid += nranks * 512) {
        const int t = gid / 10, hh = gid % 10;
        const bool isq = hh < 8;
        const bf16_t* src = isq ? QR + (size_t)t * 512 + hh * 64 : KR + (size_t)t * 128 + (hh - 8) * 64;
        bf16_t* dst = isq ? QN + (size_t)t * 512 + hh * 64 : KN + (size_t)t * 128 + (hh - 8) * 64;
        const float* w = isq ? qw : kw;
        float f[64]; float ss = 0.f;
#pragma unroll
        for (int i = 0; i < 8; ++i) { const u32x4 q = *(const u32x4*)(src + 8 * i);
#pragma unroll
            for (int j = 0; j < 4; ++j) { f[8 * i + 2 * j] = bflo(q[j]); f[8 * i + 2 * j + 1] = bfhi(q[j]); } }
#pragma unroll
        for (int i = 0; i < 64; ++i) ss += f[i] * f[i];
        const float rn = rsqrtf(ss * (1.0f / 64.0f) + EPS), sc = isq ? C2 : 1.0f;
#pragma unroll
        for (int i = 0; i < 16; ++i) { const f32x4 wv = *(const f32x4*)(w + 4 * i);
            f[4 * i] *= rn * wv.x; f[4 * i + 1] *= rn * wv.y; f[4 * i + 2] *= rn * wv.z; f[4 * i + 3] *= rn * wv.w; }
        float o[64];
#pragma unroll
        for (int ax = 0; ax < 2; ++ax) {
            const float* tb = ROPE + (size_t)(ax == 0 ? (t >> 6) : (t & 63)) * 32;
#pragma unroll
            for (int i2 = 0; i2 < 8; ++i2) { const f32x4 cs = *(const f32x4*)(tb + 4 * i2);
#pragma unroll
                for (int k = 0; k < 2; ++k) { const int i = 2 * i2 + k; const float c_ = k ? cs.z : cs.x, s_ = k ? cs.w : cs.y;
                    const float x1 = f[ax * 32 + i], x2 = f[ax * 32 + 16 + i];
                    o[ax * 32 + i] = (x1 * c_ - x2 * s_) * sc; o[ax * 32 + 16 + i] = (x2 * c_ + x1 * s_) * sc; } }
        }
#if KEEP_BF16_QK
#pragma unroll
        for (int i = 0; i < 8; ++i) { u32x4 q;
#pragma unroll
            for (int j = 0; j < 4; ++j) q[j] = pk2(o[8 * i + 2 * j], o[8 * i + 2 * j + 1]);
            *(u32x4*)(dst + 8 * i) = q; }
#else
        (void)dst;
#endif
        unsigned char* dst8 = isq ? Q8 + (size_t)t * 512 + hh * 64 : K8 + (size_t)t * 128 + (hh - 8) * 64;
#pragma unroll
        for (int i = 0; i < 4; ++i) { u32x4 q;
#pragma unroll
            for (int j = 0; j < 4; ++j) { int wd = 0; wd = __builtin_amdgcn_cvt_pk_fp8_f32(o[16 * i + 4 * j], o[16 * i + 4 * j + 1], wd, false); wd = __builtin_amdgcn_cvt_pk_fp8_f32(o[16 * i + 4 * j + 2], o[16 * i + 4 * j + 3], wd, true); q[j] = (unsigned)wd; }
            *(u32x4*)(dst8 + 16 * i) = q; }
    }
}
__device__ __forceinline__ void ph_v8t(Frame& F, const bf16_t* __restrict__ VV, unsigned char* __restrict__ V8T) {
    OPAQUE_LANE();
    const int gw = F.vcu * NWAVES + F.wave, NGW = F.G * NWAVES;
    for (int it = gw; it < 2 * (S / 64); it += NGW) {
        const int kvh = it / (S / 64), tile = it % (S / 64);
        const bf16_t* src = VV + (size_t)(64 * tile) * 128 + kvh * 64 + lane;
        u32x4 ov[4];
#pragma unroll
        for (int hi = 0; hi < 2; ++hi)
#pragma unroll
            for (int k = 0; k < 8; ++k) {
                float v[4];
#pragma unroll
                for (int b = 0; b < 4; ++b) { const int j = 4 * k + b; const int key = j < 16 ? ((j & 3) + 8 * (j >> 2) + 4 * hi) : 32 + (((j - 16) & 3) + 8 * ((j - 16) >> 2) + 4 * hi); v[b] = bf2f(src[(size_t)key * 128]); }
                int wd = 0; wd = __builtin_amdgcn_cvt_pk_fp8_f32(v[0], v[1], wd, false); wd = __builtin_amdgcn_cvt_pk_fp8_f32(v[2], v[3], wd, true);
                ov[hi * 2 + (k >> 2)][k & 3] = (unsigned)wd;
            }
        unsigned char* dst = V8T + ((size_t)it * 64 + lane) * 64;
#pragma unroll
        for (int q = 0; q < 4; ++q) *(u32x4*)(dst + 16 * q) = ov[q];
    }
}
__device__ __forceinline__ void ph_hgfin(Frame& F, const float* __restrict__ OF, const bf16_t* __restrict__ HG, const float* __restrict__ w, bf16_t* __restrict__ OHG) {
    OPAQUE_LANE();
    const int gw = F.vcu * NWAVES + F.wave, NGW = F.G * NWAVES;
    const int e0 = (lane & 15) * 8;
    const f32x4 w0 = *(const f32x4*)(w + e0), w1 = *(const f32x4*)(w + e0 + 4);
    for (int t = gw; t < S; t += NGW) {
        const size_t off = (size_t)t * 512 + lane * 8;
        const f32x4 a0 = *(const f32x4*)(OF + off), a1 = *(const f32x4*)(OF + off + 4), b0 = *(const f32x4*)(OF + (size_t)S * 512 + off), b1 = *(const f32x4*)(OF + (size_t)S * 512 + off + 4);
        const f32x4 s0 = a0 + b0, s1 = a1 + b1;
        float ss = (s0.x * s0.x + s0.y * s0.y) + (s0.z * s0.z + s0.w * s0.w) + (s1.x * s1.x + s1.y * s1.y) + (s1.z * s1.z + s1.w * s1.w);
        ss += __shfl_xor(ss, 1); ss += __shfl_xor(ss, 2); ss += __shfl_xor(ss, 4); ss += __shfl_xor(ss, 8);
        const float r = rsqrtf(ss * (1.0f / 128.0f) + EPS);
        const u32x4 g = *(const u32x4*)(HG + off);
        u32x4 o;
        o.x = pk2(s0.x * r * w0.x * bflo(g.x), s0.y * r * w0.y * bfhi(g.x));
        o.y = pk2(s0.z * r * w0.z * bflo(g.y), s0.w * r * w0.w * bfhi(g.y));
        o.z = pk2(s1.x * r * w1.x * bflo(g.z), s1.y * r * w1.y * bfhi(g.z));
        o.w = pk2(s1.z * r * w1.z * bflo(g.w), s1.w * r * w1.w * bfhi(g.w));
        *(u32x4*)(OHG + off) = o;
    }
}
__device__ __forceinline__ void ph_norm2_router(Frame& F, const bf16_t* __restrict__ X1, const float* __restrict__ w, const float* __restrict__ scale, const float* __restrict__ shift,
                                                const float* __restrict__ wr, unsigned char* __restrict__ HB, float* __restrict__ AFF) {
    OPAQUE_LANE();
    LAS float* WT = (LAS float*)F.lds;
    for (int dd = t_; dd < D; dd += NWAVES * 64) {
        const GAS f32x4* s = (const GAS f32x4*)((const GAS float*)wr + (size_t)dd * 16);
        const f32x4 a = s[0], b = s[1], c = s[2], e = s[3];
        WT[0 * D + dd] = a.x; WT[1 * D + dd] = a.y; WT[2 * D + dd] = a.z; WT[3 * D + dd] = a.w; WT[4 * D + dd] = b.x; WT[5 * D + dd] = b.y; WT[6 * D + dd] = b.z; WT[7 * D + dd] = b.w;
        WT[8 * D + dd] = c.x; WT[9 * D + dd] = c.y; WT[10 * D + dd] = c.z; WT[11 * D + dd] = c.w; WT[12 * D + dd] = e.x; WT[13 * D + dd] = e.y; WT[14 * D + dd] = e.z; WT[15 * D + dd] = e.w;
    }
    __syncthreads();
    const int gw = F.vcu * NWAVES + F.wave, NGW = F.G * NWAVES;
    for (int row = gw; row < S; row += 2 * NGW) {
        const int row1 = (row + NGW < S) ? row + NGW : row;
        const u32x2* xr0 = (const u32x2*)(X1 + (size_t)row * D) + lane; const u32x2* xr1 = (const u32x2*)(X1 + (size_t)row1 * D) + lane;
        f32x4 v0[4], v1[4], h0[4], h1[4]; float ss0 = 0.f, ss1 = 0.f;
#pragma unroll
        for (int j = 0; j < 4; ++j) { v0[j] = unpk4(xr0[64 * j]); v1[j] = unpk4(xr1[64 * j]); }
#pragma unroll
        for (int j = 0; j < 4; ++j) { ss0 += (v0[j].x * v0[j].x + v0[j].y * v0[j].y) + (v0[j].z * v0[j].z + v0[j].w * v0[j].w); ss1 += (v1[j].x * v1[j].x + v1[j].y * v1[j].y) + (v1[j].z * v1[j].z + v1[j].w * v1[j].w); }
        ss0 = wave_sum(ss0); ss1 = wave_sum(ss1);
        norm_mod_row_f8(v0, ss0, w, scale, shift, HB + (size_t)row * D, lane, h0);
        norm_mod_row_f8(v1, ss1, w, scale, shift, HB + (size_t)row1 * D, lane, h1);
        LAS float* wt = WT + 4 * lane; asm volatile("" : "+v"(wt));
        f32x4 lg0[4], lg1[4];
#pragma unroll
        for (int e = 0; e < 16; ++e) {
            float a0 = 0.f, a1 = 0.f;
#pragma unroll
            for (int j = 0; j < 4; ++j) { const f32x4 ww = *(const LAS f32x4*)(wt + e * D + 256 * j);
                a0 += (h0[j].x * ww.x + h0[j].y * ww.y) + (h0[j].z * ww.z + h0[j].w * ww.w); a1 += (h1[j].x * ww.x + h1[j].y * ww.y) + (h1[j].z * ww.z + h1[j].w * ww.w); }
            lg0[e >> 2][e & 3] = wave_sum(a0); lg1[e >> 2][e & 3] = wave_sum(a1);
        }
#pragma unroll
        for (int rr = 0; rr < 2; ++rr) {
            f32x4 (&lgv)[4] = rr ? lg1 : lg0;
            float mx = -1e30f;
#pragma unroll
            for (int e4 = 0; e4 < 4; ++e4) mx = fmaxf(mx, fmaxf(fmaxf(lgv[e4].x, lgv[e4].y), fmaxf(lgv[e4].z, lgv[e4].w)));
            float den = 0.f;
#pragma unroll
            for (int e4 = 0; e4 < 4; ++e4) { lgv[e4].x = __expf(lgv[e4].x - mx); lgv[e4].y = __expf(lgv[e4].y - mx); lgv[e4].z = __expf(lgv[e4].z - mx); lgv[e4].w = __expf(lgv[e4].w - mx);
                den += (lgv[e4].x + lgv[e4].y) + (lgv[e4].z + lgv[e4].w); }
            const float inv = 1.0f / den;
            const f32x4 s8a = (lane & 8) ? lgv[2] : lgv[0], s8b = (lane & 8) ? lgv[3] : lgv[1];
            const f32x4 s4 = (lane & 4) ? s8b : s8a;
            const float s2a = (lane & 2) ? s4.z : s4.x, s2b = (lane & 2) ? s4.w : s4.y;
            const float mine = ((lane & 1) ? s2b : s2a) * inv;
            const int rw = rr ? row1 : row;
            if (lane < 16 && (rr == 0 || row1 != row)) AFF[(size_t)lane * S + rw] = mine;
        }
    }
    __syncthreads();
}
__device__ __forceinline__ void ph_topk(Frame& F, LAS unsigned char* lds, int e, const float* __restrict__ AFF, int* __restrict__ IDX, float* __restrict__ TOPW, int* __restrict__ SLOT) {
    LAS unsigned* hist = (LAS unsigned*)lds;
    LAS unsigned* hsum = hist + 4096;
    LAS unsigned* shv = hsum + 256;
    LAS unsigned* scan = hsum + 512;
    OPAQUE_LANE(); const int tid = t_;
    const unsigned* vals = (const unsigned*)(AFF + (size_t)e * S);
    unsigned u[32];
#pragma unroll
    for (int i = 0; i < 8; ++i) { const u32x4 q = *(const u32x4*)(vals + tid * 32 + 4 * i); u[4 * i] = q.x; u[4 * i + 1] = q.y; u[4 * i + 2] = q.z; u[4 * i + 3] = q.w; }
    if (tid == 0) { shv[0] = 0u; shv[1] = CAP; }
    LAS unsigned* myh = hist + (lane & 15) * 256;
    __syncthreads();
    for (int pass = 3; pass >= 0; --pass) {
        const int shift = pass * 8;
        const unsigned mask = pass == 3 ? 0u : (0xFFFFFFFFu << (shift + 8));
#pragma unroll
        for (int i = 0; i < 8; ++i) hist[tid + 512 * i] = 0u;
        __syncthreads();
        const unsigned prefix = shv[0];
#pragma unroll
        for (int i = 0; i < 32; ++i) if ((u[i] & mask) == (prefix & mask)) __hip_atomic_fetch_add(&myh[(u[i] >> shift) & 255u], 1u, __ATOMIC_RELAXED, __HIP_MEMORY_SCOPE_WORKGROUP);
        __syncthreads();
        if (tid < 256) { unsigned s = 0u;
#pragma unroll
            for (int c = 0; c < 16; ++c) s += hist[c * 256 + tid];
            hsum[tid] = s; }
        __syncthreads();
        if (tid < 64) {
            const unsigned kk = shv[1];
            const unsigned h0 = hsum[4 * lane], h1 = hsum[4 * lane + 1], h2 = hsum[4 * lane + 2], h3 = hsum[4 * lane + 3];
            const unsigned tot = (h0 + h1) + (h2 + h3);
            unsigned inc = tot;
#pragma unroll
            for (int o = 1; o < 64; o <<= 1) { const unsigned v = __shfl_down(inc, o); if (lane + o < 64) inc += v; }
            unsigned c = inc - tot; int bin = -1; unsigned rem = 0u;
            if (c < kk && c + h3 >= kk) { bin = 4 * lane + 3; rem = kk - c; } c += h3;
            if (c < kk && c + h2 >= kk) { bin = 4 * lane + 2; rem = kk - c; } c += h2;
            if (c < kk && c + h1 >= kk) { bin = 4 * lane + 1; rem = kk - c; } c += h1;
            if (c < kk && c + h0 >= kk) { bin = 4 * lane; rem = kk - c; }
            if (bin >= 0) { shv[1] = rem; shv[0] = prefix | ((unsigned)bin << shift); }
        }
        __syncthreads();
    }
    const unsigned T = shv[0], need_eq = shv[1];
    unsigned ceq = 0u;
#pragma unroll
    for (int i = 0; i < 32; ++i) ceq += (u[i] == T) ? 1u : 0u;
    scan[tid] = ceq; __syncthreads();
    for (int off = 1; off < 512; off <<= 1) { const unsigned tv = tid >= off ? scan[tid - off] : 0u; __syncthreads(); scan[tid] += tv; __syncthreads(); }
    unsigned eq_rank = scan[tid] - ceq;
    __syncthreads();
    unsigned selmask = 0u, csel = 0u;
#pragma unroll
    for (int i = 0; i < 32; ++i) { bool sel = u[i] > T; if (u[i] == T) { sel = eq_rank < need_eq; ++eq_rank; } if (sel) { selmask |= 1u << i; ++csel; } }
    scan[tid] = csel; __syncthreads();
    for (int off = 1; off < 512; off <<= 1) { const unsigned tv = tid >= off ? scan[tid - off] : 0u; __syncthreads(); scan[tid] += tv; __syncthreads(); }
    unsigned slot = scan[tid] - csel;
#pragma unroll
    for (int i = 0; i < 32; ++i) {
        const int t = tid * 32 + i; int sl = -1;
        if (selmask & (1u << i)) { sl = (int)slot; ++slot; if (sl < CAP) { IDX[e * CAP + sl] = t; TOPW[e * CAP + sl] = __uint_as_float(u[i]); } }
        SLOT[(size_t)e * S + t] = sl < CAP ? sl : -1;
    }
    __syncthreads();
}
__device__ __forceinline__ void ph_combine(Frame& F, const bf16_t* __restrict__ X1, const bf16_t* __restrict__ YE, const int* __restrict__ SLOT, const float* __restrict__ gate,
                                           void* __restrict__ xout_, const float* __restrict__ w, const float* __restrict__ scale, const float* __restrict__ shift, bf16_t* __restrict__ HB, unsigned char* __restrict__ HB8, bool do_norm) {
    OPAQUE_LANE();
    const int gw = F.vcu * NWAVES + F.wave, NGW = F.G * NWAVES;
    for (int row = gw; row < S; row += 2 * NGW) {
        const bool two = row + NGW < S; const int row1 = two ? row + NGW : row;
        const int sl0 = lane < NE ? SLOT[(size_t)lane * S + row] : -1, sl1 = lane < NE ? SLOT[(size_t)lane * S + row1] : -1;
        const u32x2* xr0 = (const u32x2*)(X1 + (size_t)row * D) + lane; const u32x2* xr1 = (const u32x2*)(X1 + (size_t)row1 * D) + lane;
        f32x4 v0[4], v1[4];
#pragma unroll
        for (int j = 0; j < 4; ++j) { v0[j] = unpk4(xr0[64 * j]); v1[j] = unpk4(xr1[64 * j]); }
        f32x4 acc0[4], acc1[4];
#pragma unroll
        for (int j = 0; j < 4; ++j) { acc0[j] = f32x4{0.f, 0.f, 0.f, 0.f}; acc1[j] = acc0[j]; }
        unsigned m0 = (unsigned)__ballot(sl0 >= 0) & 0xffffu, m1 = (unsigned)__ballot(sl1 >= 0) & 0xffffu;
        while (m0 | m1) {
            const int e0 = m0 ? __builtin_ctz(m0) : 0, e1 = m1 ? __builtin_ctz(m1) : 0;
            const float f0 = m0 ? 1.f : 0.f, f1 = m1 ? 1.f : 0.f;
            const int s0 = m0 ? __builtin_amdgcn_readlane(sl0, e0) : 0, s1 = m1 ? __builtin_amdgcn_readlane(sl1, e1) : 0;
            m0 &= m0 - 1u; m1 &= m1 - 1u;
            const bf16_t* y0 = YE + ((size_t)e0 * CAP + s0) * D + 4 * lane; const bf16_t* y1 = YE + ((size_t)e1 * CAP + s1) * D + 4 * lane;
            u32x2 q0[4], q1[4];
#pragma unroll
            for (int j = 0; j < 4; ++j) { q0[j] = *(const u32x2*)(y0 + 256 * j); q1[j] = *(const u32x2*)(y1 + 256 * j); }
#pragma unroll
            for (int j = 0; j < 4; ++j) { acc0[j].x += f0 * bflo(q0[j].x); acc0[j].y += f0 * bfhi(q0[j].x); acc0[j].z += f0 * bflo(q0[j].y); acc0[j].w += f0 * bfhi(q0[j].y);
                                          acc1[j].x += f1 * bflo(q1[j].x); acc1[j].y += f1 * bfhi(q1[j].x); acc1[j].z += f1 * bflo(q1[j].y); acc1[j].w += f1 * bfhi(q1[j].y); }
        }
        f32x4 h[4]; float ss0 = 0.f, ss1 = 0.f;
#pragma unroll
        for (int j = 0; j < 4; ++j) { const f32x4 gv = *(const f32x4*)(gate + 4 * lane + 256 * j); v0[j] = v0[j] + gv * acc0[j]; v1[j] = v1[j] + gv * acc1[j];
            if (do_norm) { u32x2 o0, o1; o0.x = pk2(v0[j].x, v0[j].y); o0.y = pk2(v0[j].z, v0[j].w); o1.x = pk2(v1[j].x, v1[j].y); o1.y = pk2(v1[j].z, v1[j].w);
                ((u32x2*)((bf16_t*)xout_ + (size_t)row * D) + lane)[64 * j] = o0; if (two) ((u32x2*)((bf16_t*)xout_ + (size_t)row1 * D) + lane)[64 * j] = o1; }
            else { ((f32x4*)((float*)xout_ + (size_t)row * D) + lane)[64 * j] = v0[j]; if (two) ((f32x4*)((float*)xout_ + (size_t)row1 * D) + lane)[64 * j] = v1[j]; }
            ss0 += (v0[j].x * v0[j].x + v0[j].y * v0[j].y) + (v0[j].z * v0[j].z + v0[j].w * v0[j].w); ss1 += (v1[j].x * v1[j].x + v1[j].y * v1[j].y) + (v1[j].z * v1[j].z + v1[j].w * v1[j].w); }
        if (do_norm) { ss0 = wave_sum(ss0); ss1 = wave_sum(ss1); norm_mod_row(v0, ss0, w, scale, shift, HB + (size_t)row * D, lane, h); if (two) norm_mod_row(v1, ss1, w, scale, shift, HB + (size_t)row1 * D, lane, h); }
    }
}

__global__ void __launch_bounds__(NWAVES * 64, 2) mega(Params p) {
    extern __shared__ __attribute__((aligned(16))) unsigned char lds[];
    Frame F;
    F.lds = (LAS unsigned char*)lds;
    volatile LAS unsigned* MISC = (volatile LAS unsigned*)(F.lds + MISC_OFF);
    F.tid = threadIdx.x; F.lane = F.tid & 63; F.wave = __builtin_amdgcn_readfirstlane(F.tid >> 6);
    F.G = gridDim.x; { const int bx = blockIdx.x; F.vcu = (F.G % 8 == 0) ? (bx % 8) * (F.G / 8) + bx / 8 : bx; }
    unsigned char* ws = p.ws;
    unsigned* ctl = (unsigned*)(ws + WS_CTL);
    for (int u = F.tid; u < (LDS_BYTES - LDSCTL_OFF) / 4; u += NWAVES * 64) ((LAS unsigned*)(F.lds + LDSCTL_OFF))[u] = 0u;
    __syncthreads();
    XcdBarrier bar = xcd_barrier_post(ctl + CW_BAR + p.li * XCD_BAR_WORDS, MISC + 8);
    const int lo = p.ph_lo, hi = p.ph_hi;
#define IN(k) (lo <= (k) && (k) < hi)
#define SEAM(k) do { if (IN(k) && IN((k) + 1)) xcd_barrier(bar); } while (0)
#define REFRESH() do { F.lane = lane_id_opaque(); F.tid = F.wave * 64 + F.lane; } while (0)

#define WSP(T, off) ((T*)(GAS T*)(wsl + (off)))
#define WSL() GAS unsigned char* wsl = (GAS unsigned char*)p.ws; asm volatile("" : "+s"(wsl))
    LAS float* scr = (LAS float*)(F.lds + RING_OFF + F.wave * 8704);

    if (IN(PH_PRO)) { REFRESH(); WSL();
        mod_units(F, p);
        for (int l = 0; l < NL; ++l) {
            conv_matrix(F, p.w_in + (size_t)l * D * INW, INW, D, INW, WSP(bf16_t, WS_WIN) + (size_t)l * INW * D, scr);
            conv_matrix(F, p.w_ba + (size_t)l * 512 * D, D, 512, D, WSP(bf16_t, WS_WBA) + (size_t)l * D * 512, scr);
            conv_matrix(F, p.w_bh + (size_t)l * 512 * D, D, 512, D, WSP(bf16_t, WS_WBH) + (size_t)l * D * 512, scr);
            conv_matrix(F, p.w_out + (size_t)l * D * D, D, D, D, WSP(bf16_t, WS_WOUT) + (size_t)l * D * D, scr);
        }
        ph_rope_table(F, WSP(float, WS_ROPE));
    }
    SEAM(PH_PRO);
    if (IN(PH_NORM1)) { REFRESH(); WSL(); ph_norm1(F, p.x, p.norm_mix_w, WSP(float, WS_MOD) + 1 * D, WSP(float, WS_MOD) + 0 * D, WSP(bf16_t, WS_HB), WSP(unsigned char, WS_HBF8)); }
    SEAM(PH_NORM1);

    for (int l = 0; l < NL; ++l) {
        const int pb = PH_L0 + l * NPL;
        if (IN(pb + P_G1)) { WSL();
            pg8::Gemm g{WSP(bf16_t, WS_HB), WSP(bf16_t, WS_WIN) + (size_t)l * INW * D, S, 3072, D}; pg8::StaticOrder So; So.init(S, 3072, F.G, (int)blockIdx.x);
            pg8::EpiInproj E{WSP(bf16_t, WS_QR), WSP(bf16_t, WS_KR), WSP(bf16_t, WS_VV), WSP(bf16_t, WS_HQ), WSP(bf16_t, WS_KF), WSP(bf16_t, WS_HV), WSP(bf16_t, WS_HG), WSP(bf16_t, WS_GG), WSP(float, WS_LF), WSP(float, WS_LBV) + l * 1024, 1.0f};
            for (int rep_ = 0; rep_ < REP_G; ++rep_) pg8::gemm_phase<pg8::EpiInproj, pg8::StaticOrder, true, true>(F.lds + RING_OFF, g, So, E, F.wave);
        }
        SEAM(pb + P_G1);
        if (IN(pb + P_QKP)) { WSL();
            {
              pg8::Gemm g{WSP(bf16_t, WS_HB), WSP(bf16_t, WS_WIN) + (size_t)l * INW * D + (size_t)3072 * D, S, 2304, D}; pg8::OffOrder So; So.So.init(S, 2304, F.G, (int)blockIdx.x); So.off = 12;
              pg8::EpiInproj E{WSP(bf16_t, WS_QR), WSP(bf16_t, WS_KR), WSP(bf16_t, WS_VV), WSP(bf16_t, WS_HQ), WSP(bf16_t, WS_KF), WSP(bf16_t, WS_HV), WSP(bf16_t, WS_HG), WSP(bf16_t, WS_GG), WSP(float, WS_LF), WSP(float, WS_LBV) + l * 1024, 1.0f};
              for (int rep_ = 0; rep_ < REP_G; ++rep_) pg8::gemm_phase<pg8::EpiInproj, pg8::OffOrder, true, true>(F.lds + RING_OFF, g, So, E, F.wave); }
            { const bool even = (F.G == 256); const int rk = even ? (int)blockIdx.x - 64 : (int)blockIdx.x, nr = even ? 192 : F.G;
              for (int rep_ = 0; rep_ < REP_QK; ++rep_) ph_qkprep(F, WSP(bf16_t, WS_QR), WSP(bf16_t, WS_KR), p.q_norm_w + l * 64, p.k_norm_w + l * 64, WSP(float, WS_ROPE), WSP(bf16_t, WS_QN), WSP(bf16_t, WS_KN), WSP(unsigned char, WS_Q8), WSP(unsigned char, WS_K8), rk, nr);
              ph_v8t(F, WSP(bf16_t, WS_VV), WSP(unsigned char, WS_V8T)); }
            for (int rep_ = 0; rep_ < REP_HG; ++rep_) for (int u = blockIdx.x; u < 256; u += F.G) hg::segment<false>(F.lds, u, WSP(bf16_t, WS_HQ), WSP(float, WS_LF), WSP(bf16_t, WS_KF), WSP(bf16_t, WS_HV), WSP(float, WS_HST), WSP(float, WS_HST + 16 * MiB), nullptr, F.wave);
        }
        SEAM(pb + P_QKP);
        if (IN(pb + P_HGB)) { WSL(); OPAQUE_LANE(); (void)lane;
            for (int gid = blockIdx.x * 512 + t_; gid < 8 * 16384; gid += F.G * 512) hg::carry(WSP(float, WS_HST), WSP(float, WS_HST + 16 * MiB), gid);
        }
        SEAM(pb + P_HGB);
        if (IN(pb + P_HGC)) { WSL();
            for (int rep_ = 0; rep_ < REP_HG; ++rep_) for (int u = blockIdx.x; u < 256; u += F.G) hg::segment<true>(F.lds, u, WSP(bf16_t, WS_HQ), WSP(float, WS_LF), WSP(bf16_t, WS_KF), WSP(bf16_t, WS_HV), WSP(float, WS_HST), WSP(float, WS_HST + 16 * MiB), WSP(float, WS_OF), F.wave);
        }
        SEAM(pb + P_HGC);
        if (IN(pb + P_ATT)) { WSL();
            for (int rep_ = 0; rep_ < REP_QK; ++rep_) ph_hgfin(F, WSP(float, WS_OF), WSP(bf16_t, WS_HG), p.hg_norm_w + l * 128, WSP(bf16_t, WS_OHG));
            float negM;
            { const int ln = lane_id_opaque(); float mq = fabsf(p.q_norm_w[l * 64 + ln]), mk = fabsf(p.k_norm_w[l * 64 + ln]);
#pragma unroll
              for (int o_ = 1; o_ < 64; o_ <<= 1) { mq = fmaxf(mq, __shfl_xor(mq, o_)); mk = fmaxf(mk, __shfl_xor(mk, o_)); }
              negM = -(64.0f * C2) * mq * mk * 1.05f; }
            const attn8::Tensors AT{WSP(unsigned char, WS_Q8), WSP(unsigned char, WS_K8), WSP(unsigned char, WS_V8T), (attn8::bf16*)WSP(bf16_t, WS_OATT)};
            { BgConv bg; bg.init(p, l, F.lds + attn8::LDS_BYTES + F.wave * 1280, lane_id_opaque(), F.vcu * NWAVES + F.wave, F.G * NWAVES);
              attn8::phase((char*)lds + RING_OFF, AT, (int)F.G, (int)blockIdx.x, F.wave, negM + 8.0f, bg); bg.finish(); }
        }
        SEAM(pb + P_ATT);
        if (IN(pb + P_G2)) { WSL();
            pg8::Gemm g{WSP(bf16_t, WS_OATT), WSP(bf16_t, WS_WBA) + (size_t)l * D * 512, S, D, 512, WSP(bf16_t, WS_OHG), WSP(bf16_t, WS_WBH) + (size_t)l * D * 512};
            pg8::ChainOrder So; So.So.init(S, D, F.G, (int)blockIdx.x);
            pg8::EpiMerge E{WSP(bf16_t, WS_GG), WSP(bf16_t, WS_MG)};
            for (int rep_ = 0; rep_ < REP_G; ++rep_) pg8::gemm_phase<pg8::EpiMerge, pg8::ChainOrder, false, true>(F.lds + RING_OFF, g, So, E, F.wave);
        }
        SEAM(pb + P_G2);
        if (IN(pb + P_G3)) { WSL();
            pg8::Gemm g{WSP(bf16_t, WS_MG), WSP(bf16_t, WS_WOUT) + (size_t)l * D * D, S, D, D}; pg8::StaticOrder So; So.init(S, D, F.G, (int)blockIdx.x);
            pg8::EpiOut E{l == 0 ? (const void*)p.x : (const void*)WSP(bf16_t, WS_X2), WSP(float, WS_MOD) + l * 6 * D + 2 * D, WSP(bf16_t, WS_X1), l == 0 ? 0 : 1};
            for (int rep_ = 0; rep_ < REP_G; ++rep_) pg8::gemm_phase<pg8::EpiOut, pg8::StaticOrder, false, true>(F.lds + RING_OFF, g, So, E, F.wave);
        }
        SEAM(pb + P_G3);
        if (IN(pb + P_N2R)) { WSL();
            for (int rep_ = 0; rep_ < REP_ROW; ++rep_) ph_norm2_router(F, WSP(bf16_t, WS_X1), p.norm_ffn_w + l * D, WSP(float, WS_MOD) + l * 6 * D + 4 * D, WSP(float, WS_MOD) + l * 6 * D + 3 * D, p.w_router + (size_t)l * D * NE, WSP(unsigned char, WS_HB8), WSP(float, WS_AFF));
        }
        SEAM(pb + P_N2R);
        if (IN(pb + P_TOPK)) { WSL();
            for (int rep_ = 0; rep_ < REP_TK; ++rep_) for (int e = blockIdx.x; e < NE; e += F.G) ph_topk(F, F.lds, e, WSP(float, WS_AFF), WSP(int, WS_IDX), WSP(float, WS_TOPW), WSP(int, WS_SLOT));
        }
        SEAM(pb + P_TOPK);
        if (IN(pb + P_G4)) { WSL();
            pg8::Gemm g{(const bf16_t*)WSP(unsigned char, WS_HB8), (const bf16_t*)(WSP(unsigned char, WS_WGU) + (size_t)l * 64 * MiB), NE * CAP, NE * 4096, D / 2, nullptr, nullptr, WSP(int, WS_IDX)}; pg8::GroupOrder So; So.init(16, F.G, (int)blockIdx.x);
            pg8::EpiGU8 E{WSP(unsigned char, WS_HID8)};
            for (int rep_ = 0; rep_ < REP_G; ++rep_) pg8::gemm_phase<pg8::EpiGU8, pg8::GroupOrder, true, true, true, true>(F.lds + RING_OFF, g, So, E, F.wave);
        }
        SEAM(pb + P_G4);
        if (IN(pb + P_G5)) { WSL();
            pg8::Gemm g{(const bf16_t*)WSP(unsigned char, WS_HID8), (const bf16_t*)(WSP(unsigned char, WS_WD) + (size_t)l * 32 * MiB), NE * CAP, NE * 1024, FF / 2}; pg8::GroupOrder So; So.init(4, F.G, (int)blockIdx.x);
            pg8::EpiDown E{WSP(bf16_t, WS_YE), WSP(float, WS_TOPW), 0.015625f};
            for (int rep_ = 0; rep_ < REP_G; ++rep_) pg8::gemm_phase<pg8::EpiDown, pg8::GroupOrder, true, true, true>(F.lds + RING_OFF, g, So, E, F.wave);
        }
        SEAM(pb + P_G5);
        if (IN(pb + P_COMB)) { WSL();
            const bool last = (l + 1 == NL); const int ln = last ? l : l + 1;
            for (int rep_ = 0; rep_ < REP_ROW; ++rep_) ph_combine(F, WSP(bf16_t, WS_X1), WSP(bf16_t, WS_YE), WSP(int, WS_SLOT), WSP(float, WS_MOD) + l * 6 * D + 5 * D, last ? (void*)p.out : (void*)WSP(bf16_t, WS_X2),
                       p.norm_mix_w + ln * D, WSP(float, WS_MOD) + ln * 6 * D + 1 * D, WSP(float, WS_MOD) + ln * 6 * D + 0 * D, WSP(bf16_t, WS_HB), WSP(unsigned char, WS_HBF8), !last);
        }
        SEAM(pb + P_COMB);
    }
#undef IN
#undef SEAM
}

#ifndef N_LAUNCH_MODE
#define N_LAUNCH_MODE 1
#endif
static int g_grid = 0;
extern "C" void kernel_launch(void* const* d_in, const int* in_sizes, int n_in, void* d_out, int out_size, void* d_ws, size_t ws_size, hipStream_t stream) {
    if (n_in != 18 || out_size != S * D || ws_size < WS_END) { fprintf(stderr, "kernel_launch: unexpected shapes (n_in %d out %d ws %zu)\n", n_in, out_size, ws_size); return; }
    if (g_grid == 0) {
        int dev = 0, cus = 0;
        if (hipGetDevice(&dev) != hipSuccess || hipDeviceGetAttribute(&cus, hipDeviceAttributeMultiprocessorCount, dev) != hipSuccess) { g_grid = -1; return; }
        if (hipFuncSetAttribute((const void*)mega, hipFuncAttributeMaxDynamicSharedMemorySize, LDS_BYTES) != hipSuccess) { g_grid = -1; return; }
        int per_cu = 0;
        if (hipOccupancyMaxActiveBlocksPerMultiprocessor(&per_cu, (const void*)mega, NWAVES * 64, LDS_BYTES) != hipSuccess || per_cu < 1) { fprintf(stderr, "occupancy query: %d\n", per_cu); }
        (void)hipGetLastError();
        g_grid = cus;
    }
    if (g_grid < 0) return;
    unsigned char* ws = (unsigned char*)d_ws;
    (void)hipMemsetAsync(ws + WS_CTL, 0, 1 * MiB, stream);
    Params p{};
    p.x = (const float*)d_in[0]; p.c = (const float*)d_in[1]; p.ada_w = (const float*)d_in[2]; p.ada_b = (const float*)d_in[3]; p.norm_mix_w = (const float*)d_in[4];
    p.norm_ffn_w = (const float*)d_in[5]; p.w_in = (const float*)d_in[6]; p.q_norm_w = (const float*)d_in[7]; p.k_norm_w = (const float*)d_in[8]; p.hlb = (const float*)d_in[9];
    p.hg_norm_w = (const float*)d_in[10]; p.w_ba = (const float*)d_in[11]; p.w_bh = (const float*)d_in[12]; p.w_out = (const float*)d_in[13]; p.w_router = (const float*)d_in[14];
    p.w_eg = (const float*)d_in[15]; p.w_eu = (const float*)d_in[16]; p.w_ed = (const float*)d_in[17];
    p.out = (float*)d_out; p.ws = ws;
#if defined(DBG_ATT)
    { const int cut = PH_L0 + P_ATT + 1;
      p.ph_lo = 0; p.ph_hi = cut; p.li = 0; p.pad = 0; hipLaunchKernelGGL(mega, dim3(g_grid), dim3(NWAVES * 64), LDS_BYTES, stream, p);
      hipMemcpyAsync(ws + 900 * MiB, ws + WS_OATT, 16 * MiB, hipMemcpyDeviceToDevice, stream);
      k_attn_naive<<<dim3(S / 64, 8), dim3(64), 0, stream>>>((const bf16_t*)(ws + WS_QN), (const bf16_t*)(ws + WS_KN), (const bf16_t*)(ws + WS_VV), (bf16_t*)(ws + WS_OATT));
      k_cmp_bf16<<<dim3(2048), dim3(256), 0, stream>>>((const bf16_t*)(ws + 900 * MiB), (const bf16_t*)(ws + WS_OATT), (size_t)8 * MiB, 512, 0, 512, (float*)(ws + 512 * 1024));
      p.ph_lo = cut; p.ph_hi = PH_END; p.li = 1; hipLaunchKernelGGL(mega, dim3(g_grid), dim3(NWAVES * 64), LDS_BYTES, stream, p);
      k_scale_out<<<dim3(2048), dim3(256), 0, stream>>>((float*)d_out, (size_t)S * D, (const float*)(ws + 512 * 1024)); }
#elif N_LAUNCH_MODE == 1
    p.ph_lo = 0; p.ph_hi = PH_END; p.li = 0; p.pad = 0;
    hipLaunchKernelGGL(mega, dim3(g_grid), dim3(NWAVES * 64), LDS_BYTES, stream, p);
#else
    for (int k = 0; k < PH_END; ++k) { p.ph_lo = k; p.ph_hi = k + 1; p.li = k; p.pad = 0; hipLaunchKernelGGL(mega, dim3(g_grid), dim3(NWAVES * 64), LDS_BYTES, stream, p); }
#endif
}
```

```cpp
#include <hip/hip_runtime.h>
#include <cstdio>
#include <cstdint>

typedef unsigned short bf16_t;
typedef float f32x4 __attribute__((ext_vector_type(4)));
typedef float f32x16 __attribute__((ext_vector_type(16)));
typedef unsigned u32x4 __attribute__((ext_vector_type(4)));
typedef unsigned u32x2 __attribute__((ext_vector_type(2)));

constexpr int S = 16384, D = 1024, NL = 2, INW = 5376;
constexpr int NE = 16, CAP = 2048, FF = 2048;
constexpr float EPS = 1e-6f;
constexpr float C2 = 0.125f * 1.4426950408889634f;
constexpr int C_AQ = 0, C_AK = 512, C_AV = 640, C_HQ = 768, C_ZF = 1280, C_ZB = 1792, C_HI = 2304, C_HGT = 2816, C_GL = 3328;

constexpr size_t MiB = 1u << 20;
constexpr size_t WS_CTL = 0;
constexpr size_t WS_MOD = 1 * MiB;
constexpr size_t WS_LBV = WS_MOD + 64 * 1024;
constexpr size_t WS_IDX = WS_MOD + 128 * 1024;
constexpr size_t WS_TOPW = WS_IDX + 128 * 1024;
constexpr size_t WS_ROPE = WS_MOD + 512 * 1024;
constexpr size_t WS_AFF = 2 * MiB;
constexpr size_t WS_SLOT = 3 * MiB;
constexpr size_t WS_HB = 4 * MiB;
constexpr size_t WS_QR = 36 * MiB;
constexpr size_t WS_KR = 52 * MiB;
constexpr size_t WS_VV = 56 * MiB;
constexpr size_t WS_QN = 60 * MiB;
constexpr size_t WS_KN = 76 * MiB;
constexpr size_t WS_HQ = 80 * MiB;
constexpr size_t WS_LF = 96 * MiB;
constexpr size_t WS_KF = 160 * MiB;
constexpr size_t WS_HV = 192 * MiB;
constexpr size_t WS_HG = 208 * MiB;
constexpr size_t WS_GG = 224 * MiB;
constexpr size_t WS_OATT = 288 * MiB;
constexpr size_t WS_OF = 304 * MiB;
constexpr size_t WS_OHG = 368 * MiB;
constexpr size_t WS_MP = 384 * MiB;
constexpr size_t WS_MG = 448 * MiB;
constexpr size_t WS_HB8 = 36 * MiB;
constexpr size_t WS_XE8 = 52 * MiB;
constexpr size_t WS_HID8 = 100 * MiB;
constexpr size_t WS_XE = 36 * MiB;
constexpr size_t WS_HID = 100 * MiB;
constexpr size_t WS_YE = 228 * MiB;
constexpr size_t WS_X1 = 480 * MiB;
constexpr size_t WS_X2 = 544 * MiB;
constexpr size_t WS_WIN = 608 * MiB;
constexpr size_t WS_WBA = 630 * MiB;
constexpr size_t WS_WBH = 632 * MiB;
constexpr size_t WS_WOUT = 634 * MiB;
constexpr size_t WS_WGU = 638 * MiB;
constexpr size_t WS_WD = 766 * MiB;
constexpr size_t WS_HST = 830 * MiB;
constexpr size_t WS_Q8 = 912 * MiB;
constexpr size_t WS_K8 = 920 * MiB;
constexpr size_t WS_V8T = 922 * MiB;
constexpr size_t WS_WIN8 = 900 * MiB;
constexpr size_t WS_HBF8 = 906 * MiB;
constexpr size_t WS_END = 924 * MiB;
static_assert(WS_END <= 1024 * MiB, "workspace");

__device__ __forceinline__ float bf2f(bf16_t v) { return __uint_as_float((unsigned)v << 16); }
__device__ __forceinline__ bf16_t f2bf(float f) { unsigned u = __float_as_uint(f); return (bf16_t)((u + 0x7fffu + ((u >> 16) & 1u)) >> 16); }
__device__ __forceinline__ unsigned pk2(float lo, float hi) { return (unsigned)f2bf(lo) | ((unsigned)f2bf(hi) << 16); }
__device__ __forceinline__ float bflo(unsigned w) { return __uint_as_float(w << 16); }
__device__ __forceinline__ float bfhi(unsigned w) { return __uint_as_float(w & 0xffff0000u); }
__device__ __forceinline__ float sigmoidf_(float v) { return __builtin_amdgcn_rcpf(1.0f + __expf(-v)); }
__device__ __forceinline__ float siluf_(float v) { return v * __builtin_amdgcn_rcpf(1.0f + __expf(-v)); }
__device__ __forceinline__ float wave_sum(float v) {
#pragma unroll
    for (int o = 1; o < 64; o <<= 1) v += __shfl_xor(v, o);
    return v;
}
__device__ __forceinline__ int crow(int r, int hi) { return (r & 3) + 8 * (r >> 2) + 4 * hi; }
__device__ __forceinline__ int lane_id_opaque() { int l; asm volatile("v_mbcnt_lo_u32_b32 %0, -1, 0\n\tv_mbcnt_hi_u32_b32 %0, -1, %0" : "=v"(l)); return l; }

#define GAS __attribute__((address_space(1)))
#define LAS __attribute__((address_space(3)))

namespace pg8 {
#define PG8_LAS __attribute__((address_space(3)))
typedef unsigned short bf16_t;
typedef short bf16x8 __attribute__((ext_vector_type(8)));
typedef float f32x4 __attribute__((ext_vector_type(4)));
typedef unsigned u32x4 __attribute__((ext_vector_type(4)));
constexpr int BM = 256, BK = 64, HALF = 128, HTB = HALF * BK * 2  , STAGE_BYTES = 8 * HTB, NXCD = 8, WGM = 8;

__host__ __device__ __forceinline__ int lds_byte(int r, int c) { const int st = (r >> 4) * 2 + (c >> 5), rr = r & 15, cc = c & 31, ob = rr * 64 + cc * 2; return st * 1024 + (ob ^ (((ob >> 9) & 1) << 5)); }
__host__ __device__ __forceinline__ void stage_rc(int b, int& R, int& C) { const int st = b / 1024, sb = b % 1024, swz = sb ^ (((sb >> 9) & 1) << 5); R = (st >> 1) * 16 + swz / 64; C = (st & 1) * 32 + (swz % 64) / 2; }
__host__ __device__ __forceinline__ int perm32(int rho) { const int n = rho >> 4, i = rho & 15; return 8 * (i >> 2) + 4 * n + (i & 3); }

struct Unit { int pm, pn, pb, sel; };
struct Gemm { const bf16_t* A; const bf16_t* Bt; int M, N, K; const bf16_t* A2 = nullptr; const bf16_t* Bt2 = nullptr; const int* rowidx = nullptr; };

struct StaticOrder {
    int nM, nN, nwg, G, c;
    __host__ __device__ void init(int M, int N, int G_, int c_) { nM = M / BM; nN = N / BM; nwg = nM * nN; G = G_; c = c_; }
    __host__ __device__ bool next(int i, Unit& u) const {
        const long L = (long)i * G + c; if (L >= nwg) return false;
        int wgid = (int)L; { const int q = nwg / NXCD, r = nwg % NXCD, xcd = wgid % NXCD, off = wgid / NXCD; wgid = (xcd < r ? xcd * (q + 1) : r * (q + 1) + (xcd - r) * q) + off; }
        const int nig = WGM * nN, gid = wgid / nig, fm = gid * WGM, gsz = (nM - fm) < WGM ? (nM - fm) : WGM;
        u.pm = fm + ((wgid % nig) % gsz); u.pn = (wgid % nig) / gsz; u.pb = u.pn; u.sel = 0; return true;
    }
    __device__ __forceinline__ void a_ready(const Unit&) const {}
    __device__ __forceinline__ void done(const Unit&) const {}
};

typedef float f32x2_c __attribute__((ext_vector_type(2))); typedef __bf16 bf16x2_c __attribute__((ext_vector_type(2)));
__device__ __forceinline__ unsigned cvt_pk_bf16(float lo, float hi) { f32x2_c v = {lo, hi}; bf16x2_c b = __builtin_convertvector(v, bf16x2_c); return __builtin_bit_cast(unsigned, b); }

typedef unsigned u32x2 __attribute__((ext_vector_type(2)));
__device__ __forceinline__ float e_bflo(unsigned w) { return __uint_as_float(w << 16); }
__device__ __forceinline__ float e_bfhi(unsigned w) { return __uint_as_float(w & 0xffff0000u); }
__device__ __forceinline__ float e_sig(float v) { return __builtin_amdgcn_rcpf(1.0f + __expf(-v)); }
__device__ __forceinline__ u32x4 pack8(const f32x4 a, const f32x4 b) { u32x4 w; w.x = cvt_pk_bf16(a[0], a[1]); w.y = cvt_pk_bf16(a[2], a[3]); w.z = cvt_pk_bf16(b[0], b[1]); w.w = cvt_pk_bf16(b[2], b[3]); return w; }

typedef int i32x4_ __attribute__((ext_vector_type(4))); typedef int i32x8_ __attribute__((ext_vector_type(8)));
__device__ __forceinline__ i32x8_ pg8_cat(const bf16x8 lo, const bf16x8 hi) { return __builtin_shufflevector(__builtin_bit_cast(i32x4_, lo), __builtin_bit_cast(i32x4_, hi), 0, 1, 2, 3, 4, 5, 6, 7); }
__device__ __forceinline__ u32x2 pack8_fp8(const f32x4 a, const f32x4 b) { int w0 = 0, w1 = 0;
    w0 = __builtin_amdgcn_cvt_pk_fp8_f32(a[0], a[1], w0, false); w0 = __builtin_amdgcn_cvt_pk_fp8_f32(a[2], a[3], w0, true);
    w1 = __builtin_amdgcn_cvt_pk_fp8_f32(b[0], b[1], w1, false); w1 = __builtin_amdgcn_cvt_pk_fp8_f32(b[2], b[3], w1, true);
    u32x2 r; r.x = (unsigned)w0; r.y = (unsigned)w1; return r; }
struct EpiInproj {
    static constexpr bool PERM = true, AFTER_DRAIN = false, CHAIN = false;
    bf16_t *QR, *KR, *VV, *HQ, *KF, *HV, *HG, *GG; float* LF; const float* lbv; float ascale;
    __device__ __forceinline__ void operator()(const f32x4 (&acc)[2][2][4][2], const Unit& u, int wr, int wc, int fr, int fq) const {
        const int row0 = u.pm * BM + wr * 64 + fr, cl = wc * 32 + 8 * fq;
#pragma unroll
        for (int bj = 0; bj < 2; ++bj) {
            const int colg = u.pn * BM + bj * HALF;
            int kind; bf16_t* dst; int pitch, c0; int dir = 0;
            if (colg < 512) { kind = 0; dst = QR; pitch = 512; c0 = colg; }
            else if (colg < 640) { kind = 0; dst = KR; pitch = 128; c0 = colg - 512; }
            else if (colg < 768) { kind = 0; dst = VV; pitch = 128; c0 = colg - 640; }
            else if (colg < 1280) { kind = 1; dst = HQ; pitch = 512; c0 = colg - 768; }
            else if (colg < 2304) { kind = 3; dir = colg >= 1792; dst = KF + (size_t)dir * 16384 * 512; pitch = 512; c0 = colg - (dir ? 1792 : 1280); }
            else if (colg < 2816) { kind = 0; dst = HV; pitch = 512; c0 = colg - 2304; }
            else if (colg < 3328) { kind = 1; dst = HG; pitch = 512; c0 = colg - 2816; }
            else { kind = 2; dst = GG; pitch = 2048; c0 = colg - 3328; }
            c0 += cl;
            if (kind == 0) {
#pragma unroll
                for (int ai = 0; ai < 2; ++ai)
#pragma unroll
                    for (int m = 0; m < 4; ++m) *(u32x4*)(dst + (size_t)(row0 + ai * HALF + m * 16) * pitch + c0) = pack8(acc[ai][bj][m][0] * ascale, acc[ai][bj][m][1] * ascale);
            } else if (kind == 1) {
#pragma unroll
                for (int ai = 0; ai < 2; ++ai)
#pragma unroll
                    for (int m = 0; m < 4; ++m) { f32x4 a = acc[ai][bj][m][0] * ascale, b = acc[ai][bj][m][1] * ascale;
#pragma unroll
                        for (int i = 0; i < 4; ++i) { a[i] = a[i] * e_sig(a[i]); b[i] = b[i] * e_sig(b[i]); }
                        *(u32x4*)(dst + (size_t)(row0 + ai * HALF + m * 16) * pitch + c0) = pack8(a, b); }
            } else if (kind == 2) {
#pragma unroll
                for (int ai = 0; ai < 2; ++ai)
#pragma unroll
                    for (int m = 0; m < 4; ++m) { f32x4 a = acc[ai][bj][m][0] * ascale, b = acc[ai][bj][m][1] * ascale;
#pragma unroll
                        for (int i = 0; i < 4; ++i) { a[i] = e_sig(a[i]); b[i] = e_sig(b[i]); }
                        *(u32x4*)(dst + (size_t)(row0 + ai * HALF + m * 16) * pitch + c0) = pack8(a, b); }
            } else {
                const f32x4 lb0 = *(const f32x4*)(lbv + dir * 512 + c0), lb1 = *(const f32x4*)(lbv + dir * 512 + c0 + 4);
                float* lf = LF + (size_t)dir * 16384 * 512;
#pragma unroll
                for (int ai = 0; ai < 2; ++ai)
#pragma unroll
                    for (int m = 0; m < 4; ++m) { const f32x4 a = acc[ai][bj][m][0] * ascale, b = acc[ai][bj][m][1] * ascale; f32x4 la, lb_, ka, kb;
#pragma unroll
                        for (int i = 0; i < 4; ++i) {
                            const float sa = e_sig(a[i]), sb = e_sig(b[i]);
                            la[i] = __logf(fmaxf(lb0[i] + (1.0f - lb0[i]) * sa, 1e-6f)); ka[i] = (1.0f - lb0[i]) * (1.0f - sa);
                            lb_[i] = __logf(fmaxf(lb1[i] + (1.0f - lb1[i]) * sb, 1e-6f)); kb[i] = (1.0f - lb1[i]) * (1.0f - sb); }
                        const size_t o = (size_t)(row0 + ai * HALF + m * 16) * 512 + c0;
                        *(f32x4*)(lf + o) = la; *(f32x4*)(lf + o + 4) = lb_;
                        *(u32x4*)(dst + o) = pack8(ka, kb); }
            }
        }
    }
};
struct EpiBrA {
    static constexpr bool PERM = true, AFTER_DRAIN = false, CHAIN = false;
    const bf16_t* GG; float* MP;
    __device__ __forceinline__ void operator()(const f32x4 (&acc)[2][2][4][2], const Unit& u, int wr, int wc, int fr, int fq) const {
        const int row0 = u.pm * BM + wr * 64 + fr, col0 = u.pn * BM + wc * 32 + 8 * fq;
#pragma unroll
        for (int ai = 0; ai < 2; ++ai)
#pragma unroll
            for (int m = 0; m < 4; ++m) { const size_t r = (size_t)(row0 + ai * HALF + m * 16);
#pragma unroll
                for (int bj = 0; bj < 2; ++bj) { const int c = col0 + bj * HALF; const u32x4 g = *(const u32x4*)(GG + r * 2048 + c);
                    f32x4 a = acc[ai][bj][m][0], b = acc[ai][bj][m][1];
                    a[0] *= e_bflo(g.x); a[1] *= e_bfhi(g.x); a[2] *= e_bflo(g.y); a[3] *= e_bfhi(g.y); b[0] *= e_bflo(g.z); b[1] *= e_bfhi(g.z); b[2] *= e_bflo(g.w); b[3] *= e_bfhi(g.w);
                    *(f32x4*)(MP + r * 1024 + c) = a; *(f32x4*)(MP + r * 1024 + c + 4) = b; } }
    }
};
struct EpiBrH {
    static constexpr bool PERM = true, AFTER_DRAIN = false, CHAIN = false;
    const bf16_t* GG; const float* MP; bf16_t* MG;
    __device__ __forceinline__ void operator()(const f32x4 (&acc)[2][2][4][2], const Unit& u, int wr, int wc, int fr, int fq) const {
        const int row0 = u.pm * BM + wr * 64 + fr, col0 = u.pn * BM + wc * 32 + 8 * fq;
#pragma unroll
        for (int ai = 0; ai < 2; ++ai)
#pragma unroll
            for (int m = 0; m < 4; ++m) { const size_t r = (size_t)(row0 + ai * HALF + m * 16);
#pragma unroll
                for (int bj = 0; bj < 2; ++bj) { const int c = col0 + bj * HALF; const u32x4 g = *(const u32x4*)(GG + r * 2048 + 1024 + c);
                    f32x4 a = acc[ai][bj][m][0], b = acc[ai][bj][m][1]; const f32x4 pa = *(const f32x4*)(MP + r * 1024 + c), pb = *(const f32x4*)(MP + r * 1024 + c + 4);
                    a[0] = pa[0] + a[0] * e_bflo(g.x); a[1] = pa[1] + a[1] * e_bfhi(g.x); a[2] = pa[2] + a[2] * e_bflo(g.y); a[3] = pa[3] + a[3] * e_bfhi(g.y);
                    b[0] = pb[0] + b[0] * e_bflo(g.z); b[1] = pb[1] + b[1] * e_bfhi(g.z); b[2] = pb[2] + b[2] * e_bflo(g.w); b[3] = pb[3] + b[3] * e_bfhi(g.w);
                    *(u32x4*)(MG + r * 1024 + c) = pack8(a, b); } }
    }
};
struct EpiMerge {
    static constexpr bool PERM = true, AFTER_DRAIN = false, CHAIN = true;
    const bf16_t* GG; bf16_t* MG;
    __device__ __forceinline__ void mid(f32x4 (&acc)[2][2][4][2], const Unit& u, int wr, int wc, int fr, int fq) const {
        const int row0 = u.pm * BM + wr * 64 + fr, col0 = u.pn * BM + wc * 32 + 8 * fq;
#pragma unroll
        for (int ai = 0; ai < 2; ++ai)
#pragma unroll
            for (int m = 0; m < 4; ++m) { const size_t r = (size_t)(row0 + ai * HALF + m * 16);
#pragma unroll
                for (int bj = 0; bj < 2; ++bj) { const int c = col0 + bj * HALF; const u32x4 g0 = *(const u32x4*)(GG + r * 2048 + c), g1 = *(const u32x4*)(GG + r * 2048 + 1024 + c);
                    f32x4& a = acc[ai][bj][m][0]; f32x4& b = acc[ai][bj][m][1];
                    a[0] *= e_bflo(g0.x) * __builtin_amdgcn_rcpf(e_bflo(g1.x)); a[1] *= e_bfhi(g0.x) * __builtin_amdgcn_rcpf(e_bfhi(g1.x));
                    a[2] *= e_bflo(g0.y) * __builtin_amdgcn_rcpf(e_bflo(g1.y)); a[3] *= e_bfhi(g0.y) * __builtin_amdgcn_rcpf(e_bfhi(g1.y));
                    b[0] *= e_bflo(g0.z) * __builtin_amdgcn_rcpf(e_bflo(g1.z)); b[1] *= e_bfhi(g0.z) * __builtin_amdgcn_rcpf(e_bfhi(g1.z));
                    b[2] *= e_bflo(g0.w) * __builtin_amdgcn_rcpf(e_bflo(g1.w)); b[3] *= e_bfhi(g0.w) * __builtin_amdgcn_rcpf(e_bfhi(g1.w)); } }
    }
    __device__ __forceinline__ void operator()(const f32x4 (&acc)[2][2][4][2], const Unit& u, int wr, int wc, int fr, int fq) const {
        const int row0 = u.pm * BM + wr * 64 + fr, col0 = u.pn * BM + wc * 32 + 8 * fq;
#pragma unroll
        for (int ai = 0; ai < 2; ++ai)
#pragma unroll
            for (int m = 0; m < 4; ++m) { const size_t r = (size_t)(row0 + ai * HALF + m * 16);
#pragma unroll
                for (int bj = 0; bj < 2; ++bj) { const int c = col0 + bj * HALF; const u32x4 g = *(const u32x4*)(GG + r * 2048 + 1024 + c);
                    f32x4 a = acc[ai][bj][m][0], b = acc[ai][bj][m][1];
                    a[0] *= e_bflo(g.x); a[1] *= e_bfhi(g.x); a[2] *= e_bflo(g.y); a[3] *= e_bfhi(g.y); b[0] *= e_bflo(g.z); b[1] *= e_bfhi(g.z); b[2] *= e_bflo(g.w); b[3] *= e_bfhi(g.w);
                    *(u32x4*)(MG + r * 1024 + c) = pack8(a, b); } }
    }
};
struct OffOrder {
    StaticOrder So; int off;
    __device__ bool next(int i, Unit& u) const { if (!So.next(i, u)) return false; u.pb = u.pn; u.pn += off; return true; }
    __device__ __forceinline__ void a_ready(const Unit&) const {}
    __device__ __forceinline__ void done(const Unit&) const {}
};
struct ChainOrder {
    StaticOrder So;
    __device__ bool next(int i, Unit& u) const { if (!So.next(i >> 1, u)) return false; u.sel = i & 1; return true; }
    __device__ __forceinline__ void a_ready(const Unit&) const {}
    __device__ __forceinline__ void done(const Unit&) const {}
};
struct EpiOut {
    static constexpr bool PERM = true, AFTER_DRAIN = false, CHAIN = false;
    const void* xin; const float* gate; bf16_t* X1; int xin_bf16;
    __device__ __forceinline__ void operator()(const f32x4 (&acc)[2][2][4][2], const Unit& u, int wr, int wc, int fr, int fq) const {
        const int row0 = u.pm * BM + wr * 64 + fr, col0 = u.pn * BM + wc * 32 + 8 * fq;
#pragma unroll
        for (int bj = 0; bj < 2; ++bj) { const int c = col0 + bj * HALF; const f32x4 g0 = *(const f32x4*)(gate + c), g1 = *(const f32x4*)(gate + c + 4);
#pragma unroll
            for (int ai = 0; ai < 2; ++ai)
#pragma unroll
                for (int m = 0; m < 4; ++m) { const size_t o = (size_t)(row0 + ai * HALF + m * 16) * 1024 + c; f32x4 ra, rb;
                    if (xin_bf16) { const u32x4 q = *(const u32x4*)((const bf16_t*)xin + o); ra = f32x4{__uint_as_float(q.x << 16), __uint_as_float(q.x & 0xffff0000u), __uint_as_float(q.y << 16), __uint_as_float(q.y & 0xffff0000u)};
                        rb = f32x4{__uint_as_float(q.z << 16), __uint_as_float(q.z & 0xffff0000u), __uint_as_float(q.w << 16), __uint_as_float(q.w & 0xffff0000u)}; }
                    else { ra = *(const f32x4*)((const float*)xin + o); rb = *(const f32x4*)((const float*)xin + o + 4); }
                    *(u32x4*)(X1 + o) = pack8(ra + g0 * acc[ai][bj][m][0], rb + g1 * acc[ai][bj][m][1]); } }
    }
};
struct EpiGU {
    static constexpr bool PERM = true, AFTER_DRAIN = false, CHAIN = false;
    bf16_t* HID;
    __device__ __forceinline__ void operator()(const f32x4 (&acc)[2][2][4][2], const Unit& u, int wr, int wc, int fr, int fq) const {
        const int row0 = u.pm * BM + wr * 64 + fr, col0 = u.pn * HALF + wc * 32 + 8 * fq;
#pragma unroll
        for (int ai = 0; ai < 2; ++ai)
#pragma unroll
            for (int m = 0; m < 4; ++m) { f32x4 a = acc[ai][0][m][0], b = acc[ai][0][m][1]; const f32x4 ua = acc[ai][1][m][0], ub = acc[ai][1][m][1];
#pragma unroll
                for (int i = 0; i < 4; ++i) { a[i] = a[i] * e_sig(a[i]) * ua[i]; b[i] = b[i] * e_sig(b[i]) * ub[i]; }
                *(u32x4*)(HID + (size_t)(row0 + ai * HALF + m * 16) * 2048 + col0) = pack8(a, b); }
    }
};
struct EpiGU8 {
    static constexpr bool PERM = true, AFTER_DRAIN = false, CHAIN = false;
    unsigned char* HID;
    __device__ __forceinline__ void operator()(const f32x4 (&acc)[2][2][4][2], const Unit& u, int wr, int wc, int fr, int fq) const {
        const int row0 = u.pm * BM + wr * 64 + fr, col0 = u.pn * HALF + wc * 32 + 8 * fq;
#pragma unroll
        for (int ai = 0; ai < 2; ++ai)
#pragma unroll
            for (int m = 0; m < 4; ++m) { f32x4 a = acc[ai][0][m][0], b = acc[ai][0][m][1]; const f32x4 ua = acc[ai][1][m][0], ub = acc[ai][1][m][1];
#pragma unroll
                for (int i = 0; i < 4; ++i) { const float ga = a[i] * 0.015625f, gb = b[i] * 0.015625f; a[i] = ga * e_sig(ga) * (ua[i] * 0.015625f); b[i] = gb * e_sig(gb) * (ub[i] * 0.015625f); }
                *(u32x2*)(HID + (size_t)(row0 + ai * HALF + m * 16) * 2048 + col0) = pack8_fp8(a, b); }
    }
};
struct EpiDown {
    static constexpr bool PERM = true, AFTER_DRAIN = false, CHAIN = false;
    bf16_t* YE; const float* topw; float wscale;
    __device__ __forceinline__ void operator()(const f32x4 (&acc)[2][2][4][2], const Unit& u, int wr, int wc, int fr, int fq) const {
        const int row0 = u.pm * BM + wr * 64 + fr, col0 = u.pn * BM + wc * 32 + 8 * fq;
#pragma unroll
        for (int ai = 0; ai < 2; ++ai)
#pragma unroll
            for (int m = 0; m < 4; ++m) { const int r = row0 + ai * HALF + m * 16; const float w = topw[r] * wscale;
#pragma unroll
                for (int bj = 0; bj < 2; ++bj) *(u32x4*)(YE + (size_t)r * 1024 + col0 + bj * HALF) = pack8(acc[ai][bj][m][0] * w, acc[ai][bj][m][1] * w); }
    }
};
struct GroupOrder {
    int nNe, nwg, G, c;
    __device__ void init(int nNe_, int G_, int c_) { nNe = nNe_; nwg = 16 * 8 * nNe_; G = G_; c = c_; }
    __device__ bool next(int i, Unit& u) const {
        const long L = (long)i * G + c; if (L >= nwg) return false;
        int wgid = (int)L; { const int q = nwg / NXCD, xcd = wgid % NXCD, off = wgid / NXCD; wgid = xcd * q + off; }
        const int per = 8 * nNe, e = wgid / per, w = wgid % per;
        u.pm = e * 8 + (w & 7); u.pn = w >> 3; u.pb = e * nNe + u.pn; u.sel = 0; return true;
    }
    __device__ __forceinline__ void a_ready(const Unit&) const {}
    __device__ __forceinline__ void done(const Unit&) const {}
};

template <class Epi, class Sched, bool ALIGN_EPI = false, bool SP2 = false, bool FP8 = false, bool GATHER = false>
__device__ __forceinline__ void gemm_phase(PG8_LAS unsigned char* lds, const Gemm g, const Sched& S, const Epi& E, int wave_) {
    const int tid_ = wave_ * 64 + lane_id_opaque();
    const int tid = tid_, wid = __builtin_amdgcn_readfirstlane(tid >> 6), lane = tid & 63, wr = wid >> 2, wc = wid & 3, fr = lane & 15, fq = lane >> 4;
    int K_ = g.K; asm volatile("" : "+s"(K_));
    const int K = K_, nt = K / BK;
    unsigned voffA[2], voffB[2];
#pragma unroll
    for (int i = 0; i < 2; ++i) { int R, C; stage_rc(tid * 16 + i * 8192, R, C); const int Rb = Epi::PERM ? ((R & ~31) + perm32(R & 31)) : R;
        voffA[i] = (unsigned)(R * K + C) * 2u; voffB[i] = (unsigned)(Rb * K + C) * 2u; }
    unsigned vA[2][2] = {{0u, 0u}, {0u, 0u}}, vN[2][2] = {{0u, 0u}, {0u, 0u}};
#define PG8_GOFF(dst, u_) do { if constexpr (GATHER) { _Pragma("unroll") for (int h_ = 0; h_ < 2; ++h_) _Pragma("unroll") for (int i_ = 0; i_ < 2; ++i_) \
        { int R_, C_; stage_rc(tid * 16 + i_ * 8192, R_, C_);     \
          dst[h_][i_] = (unsigned)((const __attribute__((address_space(1))) int*)g.rowidx)[(u_).pm * BM + h_ * HALF + R_] * (unsigned)(K * 2) + (unsigned)C_ * 2u; } } } while (0)
    const size_t kstep = (size_t)(BK * 2);
    const size_t hstep = (size_t)HALF * K * 2;
    const size_t tstep = 2 * hstep;
    const unsigned ldsbase = (unsigned)__builtin_amdgcn_readfirstlane((int)(unsigned)(size_t)lds + wid * 1024);
    const int aoff = lds_byte(wr * 64 + fr, fq * 8), boff = lds_byte(wc * 32 + fr, fq * 8);
#define PG8_SA(b, h) (((b) * 2 + (h)) * HTB)
#define PG8_SB(b, h) ((4 + (b) * 2 + (h)) * HTB)
#define PG8_STAGE(bufoff, gbase, voff) do { _Pragma("unroll") for (int _i = 0; _i < 2; ++_i) { unsigned keep_; \
        asm volatile("s_mov_b32 %0, m0\n\ts_mov_b32 m0, %3\n\ts_nop 0\n\tglobal_load_lds_dwordx4 %1, %2\n\ts_mov_b32 m0, %0" : "=&s"(keep_) : "v"((voff)[_i]), "s"((const char*)(gbase)), "s"(ldsbase + (unsigned)((bufoff) + _i * 8192)) : "memory"); } } while (0)
#define PG8_STAGE_A(bufoff, gptr, half, nsel) do { if constexpr (GATHER) { unsigned vs_[2]; vs_[0] = (nsel) ? vN[half][0] : vA[half][0]; vs_[1] = (nsel) ? vN[half][1] : vA[half][1]; PG8_STAGE(bufoff, gptr, vs_); } \
        else { PG8_STAGE(bufoff, (gptr) + (half) * hstep, voffA); } } while (0)
#define PG8_LDA(dst, b, h) do { if constexpr (FP8) { _Pragma("unroll") for (int m = 0; m < 4; ++m) dst##8[m] = pg8_cat(*(const PG8_LAS bf16x8*)(lds + PG8_SA(b, h) + aoff + m * 2048), *(const PG8_LAS bf16x8*)(lds + PG8_SA(b, h) + aoff + m * 2048 + 1024)); } else { \
        _Pragma("unroll") for (int m = 0; m < 4; ++m) _Pragma("unroll") for (int k = 0; k < 2; ++k) dst[m][k] = *(const PG8_LAS bf16x8*)(lds + PG8_SA(b, h) + aoff + m * 2048 + k * 1024); } } while (0)
#define PG8_LDB(dst, b, h) do { if constexpr (FP8) { _Pragma("unroll") for (int n = 0; n < 2; ++n) dst##8[n] = pg8_cat(*(const PG8_LAS bf16x8*)(lds + PG8_SB(b, h) + boff + n * 2048), *(const PG8_LAS bf16x8*)(lds + PG8_SB(b, h) + boff + n * 2048 + 1024)); } else { \
        _Pragma("unroll") for (int n = 0; n < 2; ++n) _Pragma("unroll") for (int k = 0; k < 2; ++k) dst[n][k] = *(const PG8_LAS bf16x8*)(lds + PG8_SB(b, h) + boff + n * 2048 + k * 1024); } } while (0)
#define PG8_MMA(ai, bj, At, Bt) do { __builtin_amdgcn_s_setprio(1); if constexpr (FP8) { \
        _Pragma("unroll") for (int m = 0; m < 4; ++m) _Pragma("unroll") for (int n = 0; n < 2; ++n) \
        asm volatile("v_mfma_f32_16x16x128_f8f6f4 %0, %1, %2, %0" : "+v"(acc[ai][bj][m][n]) : "v"(Bt##8[n]), "v"(At##8[m])); } else {     \
        _Pragma("unroll") for (int m = 0; m < 4; ++m) _Pragma("unroll") for (int n = 0; n < 2; ++n) _Pragma("unroll") for (int k = 0; k < 2; ++k) \
        acc[ai][bj][m][n] = __builtin_amdgcn_mfma_f32_16x16x32_bf16(Bt[n][k], At[m][k], acc[ai][bj][m][n], 0, 0, 0); } __builtin_amdgcn_s_setprio(0); } while (0)
#define PG8_WAIT_V(n) asm volatile("s_waitcnt vmcnt(" #n ")" ::: "memory")
#define PG8_WAIT_L(n) asm volatile("s_waitcnt lgkmcnt(" #n ")" ::: "memory")
#define PG8_BAR __builtin_amdgcn_s_barrier()
#define PG8_SCHED __builtin_amdgcn_sched_barrier(0)
    Unit cur, nxt; int ui = 0;
    if (!S.next(0, cur)) return;
    f32x4 acc[2][2][4][2];
#pragma unroll
    for (int a = 0; a < 2; ++a)
#pragma unroll
        for (int b = 0; b < 2; ++b)
#pragma unroll
            for (int m = 0; m < 4; ++m)
#pragma unroll
                for (int n = 0; n < 2; ++n) acc[a][b][m][n] = (f32x4){0.f, 0.f, 0.f, 0.f};
    bf16x8 At[4][2], B0[2][2], B1[2][2]; i32x8_ At8[4], B08[2], B18[2];
    const char* cA = GATHER ? (const char*)g.A : (const char*)(cur.sel ? g.A2 : g.A) + (size_t)cur.pm * tstep; PG8_GOFF(vA, cur); const char* cB = (const char*)(cur.sel ? g.Bt2 : g.Bt) + (size_t)cur.pb * tstep;
    S.a_ready(cur);
    if constexpr (SP2) {
        PG8_STAGE(PG8_SB(0, 0), cB, voffB); PG8_STAGE(PG8_SB(0, 1), cB + hstep, voffB); PG8_STAGE_A(PG8_SA(0, 0), cA, 0, false); PG8_STAGE_A(PG8_SA(0, 1), cA, 1, false);
        if (wr == 1) PG8_BAR;
        PG8_WAIT_V(2); PG8_BAR;
        PG8_STAGE(PG8_SB(1, 0), cB + kstep, voffB); PG8_STAGE_A(PG8_SA(1, 0), cA + kstep, 0, false); PG8_STAGE(PG8_SB(1, 1), cB + hstep + kstep, voffB);
        PG8_WAIT_V(6); PG8_BAR;
    } else {
        PG8_STAGE(PG8_SB(0, 0), cB, voffB); PG8_STAGE_A(PG8_SA(0, 0), cA, 0, false); PG8_STAGE(PG8_SB(0, 1), cB + hstep, voffB); PG8_STAGE_A(PG8_SA(0, 1), cA, 1, false);
        if (wr == 1) PG8_BAR;
        PG8_WAIT_V(4); PG8_BAR;
        PG8_STAGE(PG8_SB(1, 0), cB + kstep, voffB); PG8_STAGE_A(PG8_SA(1, 0), cA + kstep, 0, false); PG8_STAGE(PG8_SB(1, 1), cB + hstep + kstep, voffB);
        PG8_WAIT_V(6); PG8_BAR;
    }
    for (;;) {
        const bool has_next = S.next(ui + 1, nxt);
        if (has_next) PG8_GOFF(vN, nxt); else { if constexpr (GATHER) { vN[0][0] = vA[0][0]; vN[0][1] = vA[0][1]; vN[1][0] = vA[1][0]; vN[1][1] = vA[1][1]; } }
        const char* nA = GATHER ? (const char*)g.A : has_next ? (const char*)(nxt.sel ? g.A2 : g.A) + (size_t)nxt.pm * tstep : cA; const char* nB = has_next ? (const char*)(nxt.sel ? g.Bt2 : g.Bt) + (size_t)nxt.pb * tstep : cB;
#pragma unroll 1
        for (int t = 0; t < nt; t += 2) {
            const bool last = (t == nt - 2);
            const char* a1 = cA + (size_t)(t + 1) * kstep;
            const char* a2 = last ? nA : cA + (size_t)(t + 2) * kstep; const char* b2 = last ? nB : cB + (size_t)(t + 2) * kstep;
            const char* a3 = a2 + kstep; const char* b3 = b2 + kstep;
            if (last && has_next) S.a_ready(nxt);
            if constexpr (SP2) {
            PG8_LDB(B0, 0, 0); PG8_LDB(B1, 0, 1); PG8_SCHED; PG8_LDA(At, 0, 0); PG8_STAGE_A(PG8_SA(1, 1), a1, 1, false);
            PG8_WAIT_V(8); PG8_WAIT_L(0); PG8_BAR; PG8_MMA(0, 0, At, B0); PG8_MMA(0, 1, At, B1); PG8_BAR; PG8_SCHED;
            PG8_LDA(At, 0, 1); PG8_STAGE(PG8_SB(0, 0), b2, voffB); PG8_STAGE(PG8_SB(0, 1), b2 + hstep, voffB); PG8_STAGE_A(PG8_SA(0, 0), a2, 0, last);
            PG8_WAIT_V(8); PG8_WAIT_L(0); PG8_BAR; PG8_MMA(1, 0, At, B0); PG8_MMA(1, 1, At, B1); PG8_BAR; PG8_SCHED;
            PG8_LDB(B0, 1, 0); PG8_LDB(B1, 1, 1); PG8_SCHED; PG8_LDA(At, 1, 0); PG8_STAGE_A(PG8_SA(0, 1), a2, 1, last);
            PG8_WAIT_V(8); PG8_WAIT_L(0); PG8_BAR; PG8_MMA(0, 0, At, B0); PG8_MMA(0, 1, At, B1); PG8_BAR; PG8_SCHED;
            PG8_LDA(At, 1, 1); PG8_STAGE(PG8_SB(1, 0), b3, voffB); PG8_STAGE(PG8_SB(1, 1), b3 + hstep, voffB); PG8_STAGE_A(PG8_SA(1, 0), a3, 0, last);
            PG8_WAIT_V(8); PG8_WAIT_L(0); PG8_BAR; PG8_MMA(1, 0, At, B0); PG8_MMA(1, 1, At, B1); PG8_BAR; PG8_SCHED;
            } else {
            PG8_LDB(B0, 0, 0); PG8_SCHED; PG8_LDA(At, 0, 0); PG8_STAGE_A(PG8_SA(1, 1), a1, 1, false);
            PG8_WAIT_L(8); PG8_BAR; PG8_WAIT_L(0); PG8_MMA(0, 0, At, B0); PG8_BAR; PG8_SCHED;
            PG8_LDB(B1, 0, 1); PG8_STAGE(PG8_SB(0, 0), b2, voffB);
            PG8_BAR; PG8_WAIT_L(0); PG8_MMA(0, 1, At, B1); PG8_BAR;
            PG8_LDA(At, 0, 1); PG8_STAGE_A(PG8_SA(0, 0), a2, 0, last);
            PG8_BAR; PG8_WAIT_L(0); PG8_MMA(1, 0, At, B0); PG8_BAR; PG8_SCHED;
            PG8_STAGE(PG8_SB(0, 1), b2 + hstep, voffB);
            PG8_WAIT_V(6); PG8_BAR; PG8_MMA(1, 1, At, B1); PG8_BAR;
            PG8_LDB(B0, 1, 0); PG8_SCHED; PG8_LDA(At, 1, 0); PG8_STAGE_A(PG8_SA(0, 1), a2, 1, last);
            PG8_WAIT_L(8); PG8_BAR; PG8_WAIT_L(0); PG8_MMA(0, 0, At, B0); PG8_BAR; PG8_SCHED;
            PG8_LDB(B1, 1, 1); PG8_STAGE(PG8_SB(1, 0), b3, voffB);
            PG8_BAR; PG8_WAIT_L(0); PG8_MMA(0, 1, At, B1); PG8_BAR;
            PG8_LDA(At, 1, 1); PG8_STAGE_A(PG8_SA(1, 0), a3, 0, last);
            PG8_BAR; PG8_WAIT_L(0); PG8_MMA(1, 0, At, B0); PG8_BAR; PG8_SCHED;
            PG8_STAGE(PG8_SB(1, 1), b3 + hstep, voffB);
            PG8_WAIT_V(6); PG8_BAR; PG8_MMA(1, 1, At, B1); PG8_BAR;
            }
        }
        if constexpr (FP8) asm volatile("s_nop 15\n\ts_nop 7" ::: "memory");
        if constexpr (ALIGN_EPI) { if (wr == 0) PG8_BAR; }
        bool fin = true; if constexpr (Epi::CHAIN) fin = (cur.sel != 0);
        if constexpr (!Epi::AFTER_DRAIN) { const int le_ = lane_id_opaque(), fre = le_ & 15, fqe = le_ >> 4;
            if (fin) E(acc, cur, wr, wc, fre, fqe); else { if constexpr (Epi::CHAIN) E.mid(acc, cur, wr, wc, fre, fqe); } S.done(cur); }
        if (!has_next) break;
        if (fin)
#pragma unroll
        for (int a = 0; a < 2; ++a)
#pragma unroll
            for (int b = 0; b < 2; ++b)
#pragma unroll
                for (int m = 0; m < 4; ++m)
#pragma unroll
                    for (int n = 0; n < 2; ++n) acc[a][b][m][n] = (f32x4){0.f, 0.f, 0.f, 0.f};
        cur = nxt; cA = nA; cB = nB; ++ui;
        if constexpr (GATHER) { vA[0][0] = vN[0][0]; vA[0][1] = vN[0][1]; vA[1][0] = vN[1][0]; vA[1][1] = vN[1][1]; }
        if constexpr (ALIGN_EPI) { if (wr == 1) PG8_BAR; }
    }
    PG8_WAIT_V(0);
    if constexpr (!ALIGN_EPI) { if (wr == 0) PG8_BAR; }
    PG8_BAR;
    if constexpr (Epi::AFTER_DRAIN) { E.fused(acc, cur, wr, wc, fr, fq, lds, wid, lane); S.done(cur); }
#undef PG8_SA
#undef PG8_STAGE_A
#undef PG8_GOFF
#undef PG8_SB
#undef PG8_STAGE
#undef PG8_LDA
#undef PG8_LDB
#undef PG8_MMA
#undef PG8_WAIT_V
#undef PG8_WAIT_L
#undef PG8_BAR
#undef PG8_SCHED
}
}

#include <hip/hip_bf16.h>
#include <cmath>

namespace attn8 {
using bf16 = __hip_bfloat16;
typedef int i32x8 __attribute__((ext_vector_type(8)));
typedef int i32x4 __attribute__((ext_vector_type(4)));
typedef float f32x16 __attribute__((ext_vector_type(16)));
typedef unsigned u32x4 __attribute__((ext_vector_type(4)));
constexpr int NHEAD = 8, SEQ = 16384, QBLK = 32, NW = 8, QB = 256, KVBLK = 64, NQB = SEQ / QB, NT = SEQ / KVBLK;
constexpr int NS = 8, SLOT = 4096;
constexpr int LDS_K = 0, LDS_V = NS * SLOT, LDS_WS = 2 * NS * SLOT, LDS_OST = LDS_WS + NW * 256, LDS_BYTES = LDS_OST + NW * 4096;
__device__ __forceinline__ int crow(int r, int hi) { return (r & 3) + 8 * (r >> 2) + 4 * hi; }
__device__ __forceinline__ void glds16(const void* gsrc, unsigned lds_dst) { unsigned keep;
    asm volatile("s_mov_b32 %0, m0\n\ts_mov_b32 m0, %2\n\ts_nop 0\n\tglobal_load_lds_dwordx4 %1, off\n\ts_mov_b32 m0, %0" : "=&s"(keep) : "v"(gsrc), "s"(lds_dst) : "memory"); }
typedef __attribute__((address_space(3))) const char* lds_cptr;
__device__ __forceinline__ i32x8 frag(lds_cptr p) {
    const i32x4 lo = *(const __attribute__((address_space(3))) i32x4*)(p), hi = *(const __attribute__((address_space(3))) i32x4*)(p + 1024);
    return __builtin_shufflevector(lo, hi, 0, 1, 2, 3, 4, 5, 6, 7); }
#define A8_MFMA(a, b, c) __builtin_amdgcn_mfma_scale_f32_32x32x64_f8f6f4((a), (b), (c), 0, 0, 0, 0, 0, 0)
struct Tensors { const unsigned char* Q8; const unsigned char* K8; const unsigned char* V8T; bf16* O; };

template <class Bg>
__device__ __forceinline__ void unit(int h, int qb, const Tensors& T, char* shm, int wave_, float negM8, Bg& bg) {
    const int tid = wave_ * 64 + lane_id_opaque(), lane = tid & 63, r32 = lane & 31, hi = lane >> 5; const int wid = __builtin_amdgcn_readfirstlane(tid >> 6);
    const int kvh = h >> 2, q0 = qb * QB;
    const unsigned lds0 = (unsigned)(uintptr_t)shm;
    float* wsf = (float*)(shm + LDS_WS) + wid * 64;
    const bool isk = wid < 4; const int c = wid & 3;
    const unsigned char* src0 = isk ? T.K8 + (size_t)lane * 128 + kvh * 64 + c * 16 : T.V8T + (size_t)kvh * NT * 4096 + (size_t)lane * 64 + c * 16;
    const size_t tstep = isk ? (size_t)KVBLK * 128 : (size_t)4096;
    const unsigned dst0 = lds0 + (isk ? LDS_K : LDS_V) + c * 1024;
#define A8_DMA(t) glds16(src0 + (size_t)(t) * tstep, (unsigned)__builtin_amdgcn_readfirstlane(dst0 + ((t) & (NS - 1)) * SLOT))
#pragma unroll
    for (int t = 0; t < 3; ++t) A8_DMA(t);
    if (isk) { A8_DMA(3); A8_DMA(4); }
    const unsigned char* qp = T.Q8 + (size_t)(q0 + wid * QBLK + r32) * 512 + h * 64 + 32 * hi;
    const i32x4 qlo = *(const i32x4*)qp, qhi = *(const i32x4*)(qp + 16);
    const i32x8 qf = __builtin_shufflevector(qlo, qhi, 0, 1, 2, 3, 4, 5, 6, 7);
    f32x16 negm;
#pragma unroll
    for (int r = 0; r < 16; ++r) negm[r] = negM8;
    f32x16 o0 = f32x16{}, o1 = f32x16{}, lacc = f32x16{};
    i32x8 ones8;
#pragma unroll
    for (int k = 0; k < 8; ++k) ones8[k] = 0x38383838;
    const lds_cptr kbase = (lds_cptr)shm + LDS_K + (2 * hi) * 1024 + r32 * 16, vbase = (lds_cptr)shm + LDS_V + (2 * hi) * 1024 + r32 * 16;
    if (isk) asm volatile("s_waitcnt vmcnt(4)" ::: "memory"); else asm volatile("s_waitcnt vmcnt(2)" ::: "memory");
    asm volatile("s_waitcnt lgkmcnt(0)\n\ts_barrier" ::: "memory");
    asm volatile("" : "+v"(ones8));
    f32x16 sA0 = A8_MFMA(frag(kbase), qf, negm), sA1 = A8_MFMA(frag(kbase + 512), qf, negm), sB0, sB1;
#define A8_SB() __builtin_amdgcn_sched_barrier(0)
#define A8_EX8(X, b) do { _Pragma("unroll") for (int r = 0; r < 8; ++r) X[(b) + r] = __builtin_amdgcn_exp2f(X[(b) + r]); } while (0)
#define A8_TILE(C0, C1, N0, N1, PP, PC, kt, vt) do { \
        const lds_cptr kp_ = kbase + ((kt) & (NS - 1)) * SLOT, vp_ = vbase + ((vt) & (NS - 1)) * SLOT; \
        const i32x8 kf0_ = frag(kp_), kf1_ = frag(kp_ + 512), vf0_ = frag(vp_), vf1_ = frag(vp_ + 512); A8_SB(); \
        N0 = A8_MFMA(kf0_, qf, negm); A8_SB(); A8_EX8(C0, 0); A8_SB(); \
        N1 = A8_MFMA(kf1_, qf, negm); A8_SB(); A8_EX8(C0, 8); A8_SB(); \
        o0 = A8_MFMA(PP, vf0_, o0); A8_SB(); A8_EX8(C1, 0); A8_SB(); \
        o1 = A8_MFMA(PP, vf1_, o1); A8_SB(); A8_EX8(C1, 8); A8_SB(); \
        lacc = A8_MFMA(PP, ones8, lacc); A8_SB(); \
        _Pragma("unroll") for (int k = 0; k < 4; ++k) { int w_; asm volatile("" : "=v"(w_)); w_ = __builtin_amdgcn_cvt_pk_fp8_f32(C0[4 * k], C0[4 * k + 1], w_, false); w_ = __builtin_amdgcn_cvt_pk_fp8_f32(C0[4 * k + 2], C0[4 * k + 3], w_, true); PC[k] = w_; \
            int v_; asm volatile("" : "=v"(v_)); v_ = __builtin_amdgcn_cvt_pk_fp8_f32(C1[4 * k], C1[4 * k + 1], v_, false); v_ = __builtin_amdgcn_cvt_pk_fp8_f32(C1[4 * k + 2], C1[4 * k + 3], v_, true); PC[4 + k] = v_; } \
        A8_SB(); } while (0)
    i32x8 pA, pB;
#pragma unroll
    for (int k = 0; k < 8; ++k) { pA[k] = 0; pB[k] = 0; }
    for (int t = 0; t < NT; t += 4) {
        asm volatile("s_waitcnt vmcnt(0) lgkmcnt(0)\n\ts_barrier" ::: "memory");
        if (isk) {
#pragma unroll
            for (int j = 5; j <= 8; ++j) if (t + j < NT) A8_DMA(t + j);
        } else {
#pragma unroll
            for (int j = 3; j <= 6; ++j) if (t + j < NT) A8_DMA(t + j);
        }
        bg.step();
        A8_TILE(sA0, sA1, sB0, sB1, pB, pA, t + 1, (t > 0 ? t - 1 : 0));
        A8_TILE(sB0, sB1, sA0, sA1, pA, pB, t + 2, t);
        A8_TILE(sA0, sA1, sB0, sB1, pB, pA, t + 3, t + 1);
        A8_TILE(sB0, sB1, sA0, sA1, pA, pB, t + 4, t + 2);
    }
    asm volatile("s_waitcnt vmcnt(0) lgkmcnt(0)\n\ts_barrier" ::: "memory");
    {
        const lds_cptr vp_ = vbase + ((NT - 1) & (NS - 1)) * SLOT; const i32x8 vf0_ = frag(vp_), vf1_ = frag(vp_ + 512);
        o0 = A8_MFMA(pB, vf0_, o0); o1 = A8_MFMA(pB, vf1_, o1); lacc = A8_MFMA(pB, ones8, lacc); }
#undef A8_EX8
#undef A8_TILE
#undef A8_SB
    (void)wsf;
    float rli[16];
#pragma unroll
    for (int r = 0; r < 16; ++r) rli[r] = __builtin_amdgcn_rcpf(lacc[r]);
    bf16* Ow = T.O + (size_t)(q0 + wid * QBLK) * 512 + h * 64;
    { bf16* stg = (bf16*)(shm + LDS_OST) + wid * 2048;
#pragma unroll
      for (int r = 0; r < 16; ++r) { const int orow = crow(r, hi); stg[orow * 64 + r32] = __float2bfloat16(o0[r] * rli[r]); stg[orow * 64 + 32 + r32] = __float2bfloat16(o1[r] * rli[r]); }
      asm volatile("s_waitcnt lgkmcnt(0)" ::: "memory");
#pragma unroll
      for (int i = 0; i < 4; ++i) { const int row = i * 8 + (lane >> 3), ch = lane & 7; const u32x4 v = *(const u32x4*)(stg + row * 64 + ch * 8); *(u32x4*)(Ow + (size_t)row * 512 + ch * 8) = v; } }
    asm volatile("s_waitcnt vmcnt(0) lgkmcnt(0)\n\ts_barrier" ::: "memory");
#undef A8_DMA
}
template <class Bg>
__device__ __forceinline__ void phase(char* lds, const Tensors& T, int grid, int block, int wave_, float negM8, Bg& bg) {
    const int vcu = (grid % 8 == 0) ? (block % 8) * (grid / 8) + block / 8 : block;
    constexpr int NU = NHEAD * NQB;
    if (NU % grid == 0) { const int per = NU / grid; for (int i = 0; i < per; ++i) { const int uu = vcu * per + i; unit(uu / NQB, uu % NQB, T, lds, wave_, negM8, bg); } }
    else for (int uu = vcu; uu < NU; uu += grid) unit(uu / NQB, uu % NQB, T, lds, wave_, negM8, bg);
}
#undef A8_MFMA
}

namespace hg {
typedef short bf16x8 __attribute__((ext_vector_type(8)));
typedef short s16x4 __attribute__((ext_vector_type(4)));
constexpr int CH = 32, SEGT = 512, NSEG = S / SEGT, NCH = SEGT / CH;
constexpr int RS = 272, TS = 80;
constexpr int QOFF = 0, KOFF = 32 * RS, KTOFF = 2 * 32 * RS, VTOFF = KTOFF + 128 * TS, DOFF = VTOFF + 128 * TS, GOFF = DOFF + 512, BUFB = GOFF + 4096;
static_assert(2 * BUFB <= 131072, "hgrn LDS");
#define HG_MFMA(a, b, c) __builtin_amdgcn_mfma_f32_16x16x32_bf16((a), (b), (c), 0, 0, 0)
__device__ __forceinline__ unsigned pkbf(float lo, float hi) { typedef float f2 __attribute__((ext_vector_type(2))); typedef __bf16 b2 __attribute__((ext_vector_type(2))); f2 v = {lo, hi}; b2 b = __builtin_convertvector(v, b2); return __builtin_bit_cast(unsigned, b); }

typedef float f32x2h __attribute__((ext_vector_type(2)));
template <bool OUT>
__device__ __forceinline__ void chunk_matrix(LAS unsigned char* B, f32x4 (&Sacc)[8], int c16, int g, int e0, int dir, int h, int p0c, float* __restrict__ OF) {
    if (OUT) {
        f32x4 X00 = {0.f, 0.f, 0.f, 0.f}, X01 = X00, X11 = X00;
#pragma unroll
        for (int s = 0; s < 4; ++s) {
            const bf16x8 aK0 = *(const LAS bf16x8*)(B + KOFF + c16 * RS + (32 * s + 8 * g) * 2), aK1 = *(const LAS bf16x8*)(B + KOFF + (16 + c16) * RS + (32 * s + 8 * g) * 2);
            const bf16x8 bQ0 = *(const LAS bf16x8*)(B + QOFF + c16 * RS + (32 * s + 8 * g) * 2), bQ1 = *(const LAS bf16x8*)(B + QOFF + (16 + c16) * RS + (32 * s + 8 * g) * 2);
            X00 = HG_MFMA(aK0, bQ0, X00); X01 = HG_MFMA(aK0, bQ1, X01); X11 = HG_MFMA(aK1, bQ1, X11);
        }
#pragma unroll
        for (int r = 0; r < 4; ++r) { const bool keep = (4 * g + r) <= c16; X00[r] = keep ? X00[r] : 0.f; X11[r] = keep ? X11[r] : 0.f; }
        u32x4 a0w, a1w; a0w.x = pkbf(X00[0], X00[1]); a0w.y = pkbf(X00[2], X00[3]); a0w.z = 0u; a0w.w = 0u;
        a1w.x = pkbf(X01[0], X01[1]); a1w.y = pkbf(X01[2], X01[3]); a1w.z = pkbf(X11[0], X11[1]); a1w.w = pkbf(X11[2], X11[3]);
        const u32x2 vlo = *(const LAS u32x2*)(B + VTOFF + (e0 + c16) * TS + (4 * g) * 2), vhi = *(const LAS u32x2*)(B + VTOFF + (e0 + c16) * TS + (16 + 4 * g) * 2);
        u32x4 vbw; vbw.x = vlo.x; vbw.y = vlo.y; vbw.z = vhi.x; vbw.w = vhi.y;
        const bf16x8 vb = __builtin_bit_cast(bf16x8, vbw);
        f32x4 O0 = {0.f, 0.f, 0.f, 0.f}, O1 = O0;
        O0 = HG_MFMA(__builtin_bit_cast(bf16x8, a0w), vb, O0); O1 = HG_MFMA(__builtin_bit_cast(bf16x8, a1w), vb, O1);
#pragma unroll
        for (int s = 0; s < 4; ++s) {
            u32x4 sw; sw.x = pkbf(Sacc[2 * s][0], Sacc[2 * s][1]); sw.y = pkbf(Sacc[2 * s][2], Sacc[2 * s][3]); sw.z = pkbf(Sacc[2 * s + 1][0], Sacc[2 * s + 1][1]); sw.w = pkbf(Sacc[2 * s + 1][2], Sacc[2 * s + 1][3]);
            const bf16x8 sb = __builtin_bit_cast(bf16x8, sw);
            const u32x2 q0l = *(const LAS u32x2*)(B + QOFF + c16 * RS + (32 * s + 4 * g) * 2), q0h = *(const LAS u32x2*)(B + QOFF + c16 * RS + (32 * s + 16 + 4 * g) * 2);
            const u32x2 q1l = *(const LAS u32x2*)(B + QOFF + (16 + c16) * RS + (32 * s + 4 * g) * 2), q1h = *(const LAS u32x2*)(B + QOFF + (16 + c16) * RS + (32 * s + 16 + 4 * g) * 2);
            u32x4 q0w, q1w; q0w.x = q0l.x; q0w.y = q0l.y; q0w.z = q0h.x; q0w.w = q0h.y; q1w.x = q1l.x; q1w.y = q1l.y; q1w.z = q1h.x; q1w.w = q1h.y;
            O0 = HG_MFMA(__builtin_bit_cast(bf16x8, q0w), sb, O0); O1 = HG_MFMA(__builtin_bit_cast(bf16x8, q1w), sb, O1);
        }
        { const int gm = dir ? 3 - g : g; const unsigned ooff = (unsigned)(4 * gm) * 512u + (unsigned)(e0 + c16);
          GAS float* ofu = (GAS float*)OF + (size_t)dir * S * 512 + h * 128;
          const int Tb = dir ? (S - 32 - p0c) : p0c;
#pragma unroll
          for (int r = 0; r < 4; ++r) {
              ofu[(size_t)(Tb + (dir ? 16 + 3 - r : r)) * 512 + ooff] = O0[r];
              ofu[(size_t)(Tb + (dir ? 3 - r : 16 + r)) * 512 + ooff] = O1[r];
          } }
    }
    {
        const bf16x8 vB = *(const LAS bf16x8*)(B + VTOFF + (e0 + c16) * TS + (8 * g) * 2);
#pragma unroll
        for (int dt = 0; dt < 8; ++dt) {
            const bf16x8 aT = *(const LAS bf16x8*)(B + KTOFF + (16 * dt + c16) * TS + (8 * g) * 2);
            Sacc[dt] = HG_MFMA(aT, vB, Sacc[dt]);
            const f32x4 dv = *(const LAS f32x4*)(B + DOFF + (16 * dt + 4 * g) * 4);
            Sacc[dt] = Sacc[dt] * dv;
        }
    }
}
template <bool OUT>
__device__ __forceinline__ void segment(LAS unsigned char* lds, int unit, const bf16_t* __restrict__ HQ, const float* __restrict__ LF, const bf16_t* __restrict__ KF,
                                        const bf16_t* __restrict__ HV, float* __restrict__ HST, float* __restrict__ HSD, float* __restrict__ OF, int wave_) {
    const int tid_ = wave_ * 64 + lane_id_opaque();
    const int tid = tid_, lane = tid & 63, w = __builtin_amdgcn_readfirstlane(tid >> 6), c16 = lane & 15, g = lane >> 4;
    const int dir = unit >> 7, h = (unit >> 5) & 3, seg = unit & 31;
    const int d0 = 2 * (tid & 63), tg = tid >> 6;
    f32x4 Sacc[8];
    float* hst = HST + (size_t)unit * 16384 + (size_t)w * 2048 + lane;
    if (OUT) {
#pragma unroll
        for (int dt = 0; dt < 8; ++dt) { Sacc[dt][0] = hst[(dt * 4 + 0) * 64]; Sacc[dt][1] = hst[(dt * 4 + 1) * 64]; Sacc[dt][2] = hst[(dt * 4 + 2) * 64]; Sacc[dt][3] = hst[(dt * 4 + 3) * 64]; }
    } else {
#pragma unroll
        for (int dt = 0; dt < 8; ++dt) Sacc[dt] = f32x4{0.f, 0.f, 0.f, 0.f};
    }
    f32x2h segsum = {0.f, 0.f};
    const int e0 = 16 * w;
    constexpr int RING = 2;
    f32x2h rl[RING][4]; unsigned rk[RING][4], rq[RING][4], rv[RING][4];
    const int tgm = dir ? 7 - tg : tg;
    const unsigned toff = (unsigned)(4 * tgm) * 512u + (unsigned)d0;
    const GAS float* lfu = (const GAS float*)LF + (size_t)dir * S * 512 + h * 128;
    const GAS bf16_t* kfu = (const GAS bf16_t*)KF + (size_t)dir * S * 512 + h * 128;
    const GAS bf16_t* hqu = (const GAS bf16_t*)HQ + h * 128; const GAS bf16_t* hvu = (const GAS bf16_t*)HV + h * 128;
#define HG_LOAD(sl, cc) do { const int Tb_ = dir ? (S - 32 - (seg * SEGT + (cc) * CH)) : (seg * SEGT + (cc) * CH); \
        _Pragma("unroll") for (int jj = 0; jj < 4; ++jj) { const size_t ub_ = (size_t)(Tb_ + (dir ? 3 - jj : jj)) * 512; \
        rl[sl][jj] = *(const GAS f32x2h*)(lfu + ub_ + toff); rk[sl][jj] = *(const GAS unsigned*)(kfu + ub_ + toff); rv[sl][jj] = *(const GAS unsigned*)(hvu + ub_ + toff); \
        rq[sl][jj] = OUT ? *(const GAS unsigned*)(hqu + ub_ + toff) : 0u; } } while (0)
#pragma unroll
    for (int sl = 0; sl < RING; ++sl) HG_LOAD(sl, sl);
    for (int c4 = 0; c4 < NCH; c4 += RING) {
#pragma unroll
        for (int sl = 0; sl < RING; ++sl) {
            const int c = c4 + sl;
            LAS unsigned char* B = lds + (c & 1) * BUFB;
            f32x2h cs[4]; unsigned kk[4], qq[4], vv[4];
#pragma unroll
            for (int jj = 0; jj < 4; ++jj) { cs[jj] = rl[sl][jj]; kk[jj] = rk[sl][jj]; qq[jj] = rq[sl][jj]; vv[jj] = rv[sl][jj]; }
            if (c + RING < NCH) HG_LOAD(sl, c + RING);
#pragma unroll
            for (int jj = 1; jj < 4; ++jj) cs[jj] += cs[jj - 1];
            LAS float* gs = (LAS float*)(B + GOFF);
            *(LAS f32x2h*)(gs + tg * 128 + d0) = cs[3];
            __syncthreads();
            f32x2h off = {0.f, 0.f}, tot = {0.f, 0.f};
#pragma unroll
            for (int q = 0; q < 8; ++q) { const f32x2h gq = *(const LAS f32x2h*)(gs + q * 128 + d0); tot += gq; if (q < tg) off += gq; }
            float kt0[4], kt1[4];
#pragma unroll
            for (int jj = 0; jj < 4; ++jj) {
                const float b0 = fmaxf(off.x + cs[jj].x, -80.f), b1 = fmaxf(off.y + cs[jj].y, -80.f);
                kt0[jj] = bflo(kk[jj]) * __expf(-b0); kt1[jj] = bfhi(kk[jj]) * __expf(-b1);
                if (OUT) {
                    *(LAS unsigned*)(B + QOFF + (4 * tg + jj) * RS + d0 * 2) = pkbf(bflo(qq[jj]) * __expf(b0), bfhi(qq[jj]) * __expf(b1));
                    *(LAS unsigned*)(B + KOFF + (4 * tg + jj) * RS + d0 * 2) = pkbf(kt0[jj], kt1[jj]);
                }
            }
            { u32x2 o0, o1; o0.x = pkbf(kt0[0], kt0[1]); o0.y = pkbf(kt0[2], kt0[3]); o1.x = pkbf(kt1[0], kt1[1]); o1.y = pkbf(kt1[2], kt1[3]);
              *(LAS u32x2*)(B + KTOFF + d0 * TS + 8 * tg) = o0; *(LAS u32x2*)(B + KTOFF + (d0 + 1) * TS + 8 * tg) = o1;
              u32x2 v0, v1; v0.x = (vv[0] & 0xffffu) | (vv[1] << 16); v0.y = (vv[2] & 0xffffu) | (vv[3] << 16); v1.x = (vv[0] >> 16) | (vv[1] & 0xffff0000u); v1.y = (vv[2] >> 16) | (vv[3] & 0xffff0000u);
              *(LAS u32x2*)(B + VTOFF + d0 * TS + 8 * tg) = v0; *(LAS u32x2*)(B + VTOFF + (d0 + 1) * TS + 8 * tg) = v1; }
            if (tg == 0) { f32x2h dv; dv.x = __expf(fmaxf(tot.x, -80.f)); dv.y = __expf(fmaxf(tot.y, -80.f)); *(LAS f32x2h*)(B + DOFF + d0 * 4) = dv; }
            segsum += tot;
            __syncthreads();
            chunk_matrix<OUT>(B, Sacc, c16, g, e0, dir, h, seg * SEGT + c * CH, OF);
        }
    }
    if (!OUT) {
#pragma unroll
        for (int dt = 0; dt < 8; ++dt) { hst[(dt * 4 + 0) * 64] = Sacc[dt][0]; hst[(dt * 4 + 1) * 64] = Sacc[dt][1]; hst[(dt * 4 + 2) * 64] = Sacc[dt][2]; hst[(dt * 4 + 3) * 64] = Sacc[dt][3]; }
        if (tid < 64) { f32x2h dd; dd.x = __expf(fmaxf(segsum.x, -80.f)); dd.y = __expf(fmaxf(segsum.y, -80.f)); *(f32x2h*)(HSD + (size_t)unit * 128 + d0) = dd; }
    }
    __syncthreads();
}
__device__ __forceinline__ void carry(float* __restrict__ HST, const float* __restrict__ HSD, int gid) {
    const int chain = gid >> 14, el = gid & 16383, dt = (el >> 8) & 7, r = (el >> 6) & 3, ln = el & 63, d = 16 * dt + 4 * (ln >> 4) + r;
    float cy = 0.f;
    for (int sg = 0; sg < NSEG; ++sg) {
        const int u = chain * NSEG + sg;
        const float tmp = HST[(size_t)u * 16384 + el];
        HST[(size_t)u * 16384 + el] = cy;
        cy = HSD[(size_t)u * 128 + d] * cy + tmp;
    }
}
#undef HG_MFMA
#undef HG_LOAD
}

#define XB_TMO      128
#define XB_XCNT(j)  (256  + 64 * (j))
#define XB_XSUB(j)  (1280 + 64 * (j))
#define XB_XGEN(j)  (2304 + 64 * (j))
#define XB_TOP      3328
#define XB_TOPGEN   3392
#define XCD_BAR_WORDS 3456
#define XB_SPIN_CAP (1u << 18)

__device__ __forceinline__ unsigned xb_ld(unsigned* p)              { return __hip_atomic_load(p, __ATOMIC_RELAXED, __HIP_MEMORY_SCOPE_AGENT); }
__device__ __forceinline__ unsigned xb_add(unsigned* p, unsigned v) { return __hip_atomic_fetch_add(p, v, __ATOMIC_RELAXED, __HIP_MEMORY_SCOPE_AGENT); }
__device__ __forceinline__ unsigned xb_xcc_id() { return (unsigned)__builtin_amdgcn_s_getreg((3 << 11) | 20) & 0xFu; }
#define XB_SPIN(cond, bar) do { unsigned _sp = 0; while (cond) { __builtin_amdgcn_s_sleep(1); \
    if ((++_sp & 255u) == 0u) { if (xb_ld(&(bar)[XB_TMO])) break; if (_sp > XB_SPIN_CAP) { atomicAdd(&(bar)[XB_TMO], 1u); break; } } } } while (0)

struct XcdBarrier {
    int wv;
    unsigned* bar; unsigned x;
    volatile LAS unsigned* st;
};

__device__ __forceinline__ XcdBarrier xcd_barrier_post(unsigned* bar, volatile LAS unsigned* st) {
    XcdBarrier b; b.bar = bar; b.x = xb_xcc_id(); b.st = st; b.wv = __builtin_amdgcn_readfirstlane((int)threadIdx.x >> 6);
    if (threadIdx.x == 0) (void)xb_add(&bar[XB_XCNT(b.x)], 1u);
    return b;
}
__device__ __forceinline__ void xcd_barrier_complete(unsigned* bar, unsigned x, unsigned& nloc, unsigned& nx) {
    const unsigned G = gridDim.x * gridDim.y * gridDim.z;
    unsigned sum, cnt, mine, sp = 0u;
    for (;;) {
        sum = 0u; cnt = 0u; mine = 0u;
#pragma unroll
        for (unsigned j = 0; j < 16; ++j) { const unsigned c = xb_ld(&bar[XB_XCNT(j)]); sum += c; cnt += (c > 0u) ? 1u : 0u; mine = (j == x) ? c : mine; }
        if (sum == G) break;
        __builtin_amdgcn_s_sleep(1);
        if ((++sp & 255u) == 0u) { if (xb_ld(&bar[XB_TMO])) break; if (sp > XB_SPIN_CAP) { atomicAdd(&bar[XB_TMO], 1u); break; } }
    }
    nloc = mine > 0u ? mine : 1u; nx = cnt > 0u ? cnt : 1u;
}

__device__ __forceinline__ void xcd_barrier(const XcdBarrier& b) {
    asm volatile("s_waitcnt vmcnt(0)" ::: "memory");
    __syncthreads();
    if (b.wv == 0 && lane_id_opaque() == 0) {
        unsigned* bar = b.bar;
        __builtin_amdgcn_s_waitcnt(0);
        unsigned nloc = b.st[0], nx = b.st[1];
        if (nloc == 0u) { xcd_barrier_complete(bar, b.x, nloc, nx); b.st[0] = nloc; b.st[1] = nx; }
        const unsigned old = xb_add(&bar[XB_XSUB(b.x)], 1u);
        const unsigned gen = old / nloc;
        if (old + 1u == (gen + 1u) * nloc) {
            __builtin_amdgcn_fence(__ATOMIC_RELEASE, "agent");
            asm volatile("s_waitcnt vmcnt(0)" ::: "memory");
            const unsigned og = xb_add(&bar[XB_TOP], 1u);
            const unsigned tg = og / nx;
            if (og + 1u == (tg + 1u) * nx) xb_add(&bar[XB_TOPGEN], 1u);
            else XB_SPIN(xb_ld(&bar[XB_TOPGEN]) == tg, bar);
            __builtin_amdgcn_fence(__ATOMIC_ACQUIRE, "agent");
            xb_add(&bar[XB_XGEN(b.x)], 1u);
            asm volatile("s_waitcnt vmcnt(0)" ::: "memory");
        } else {
            XB_SPIN(xb_ld(&bar[XB_XGEN(b.x)]) == gen, bar);
            __builtin_amdgcn_fence(__ATOMIC_ACQUIRE, "agent");
            asm volatile("s_waitcnt vmcnt(0)" ::: "memory");
        }
    }
    __syncthreads();
}

constexpr int NWAVES = 8;
constexpr int RING_OFF = 0, RING_BYTES = 131072;
constexpr int LDSCTL_OFF = RING_BYTES, MISC_OFF = LDSCTL_OFF + 320;
constexpr int LDS_BYTES = 147456;
constexpr int CW_BAR = 4096;
constexpr int NPL = 12;
constexpr int PH_PRO = 0, PH_NORM1 = 1, PH_L0 = 2, PH_END = PH_L0 + NL * NPL;
enum { P_G1 = 0, P_QKP = 1, P_HGB = 2, P_HGC = 3, P_ATT = 4, P_G2 = 5, P_G3 = 6, P_N2R = 7, P_TOPK = 8, P_G4 = 9, P_G5 = 10, P_COMB = 11 };

#ifndef KEEP_BF16_QK
#define KEEP_BF16_QK 0
#endif
#ifndef REP_HG
#define REP_HG 1
#endif
#ifndef REP_PRO
#define REP_PRO 1
#endif
#ifndef REP_ROW
#define REP_ROW 1
#endif
#ifndef REP_G
#define REP_G 1
#endif
#ifndef REP_TK
#define REP_TK 1
#endif
#ifndef REP_QK
#define REP_QK 1
#endif
#ifndef REP_ATT
#define REP_ATT 1
#endif
struct Params {
    const float *x, *c, *ada_w, *ada_b, *norm_mix_w, *norm_ffn_w, *w_in, *q_norm_w, *k_norm_w, *hlb, *hg_norm_w, *w_ba, *w_bh, *w_out, *w_router, *w_eg, *w_eu, *w_ed;
    float* out; unsigned char* ws;
    int ph_lo, ph_hi, li, pad;
};
struct Frame {
    LAS unsigned char* lds;
    int tid, lane, wave, vcu, G;
};

__device__ __forceinline__ void tr_tile(const float* __restrict__ src, int ldw, bf16_t* __restrict__ dst, int Kd, LAS float* scr, int lane) {
    f32x4 v[8];
#pragma unroll
    for (int i = 0; i < 8; ++i) v[i] = *(const f32x4*)(src + (size_t)(8 * i + (lane >> 3)) * ldw + 4 * (lane & 7));
#pragma unroll
    for (int i = 0; i < 8; ++i) { LAS float* s = scr + (8 * i + (lane >> 3)) * 33 + 4 * (lane & 7); s[0] = v[i].x; s[1] = v[i].y; s[2] = v[i].z; s[3] = v[i].w; }
    asm volatile("s_waitcnt lgkmcnt(0)" ::: "memory");
    const int cch = lane & 7;
#pragma unroll
    for (int j = 0; j < 4; ++j) { const int n = (lane >> 3) + 8 * j; const LAS float* s = scr + (8 * cch) * 33 + n;
        u32x4 o; o.x = pk2(s[0 * 33], s[1 * 33]); o.y = pk2(s[2 * 33], s[3 * 33]); o.z = pk2(s[4 * 33], s[5 * 33]); o.w = pk2(s[6 * 33], s[7 * 33]);
        *(u32x4*)(dst + (size_t)n * Kd + 8 * cch) = o; }
    asm volatile("s_waitcnt lgkmcnt(0)" ::: "memory");
}
struct ConvItem { const float* src; unsigned char* dst; int ldw, Kd; };
__device__ __forceinline__ ConvItem conv_item_f8(const Params& p, int l, int it) {
    ConvItem c;
    const int which = it / (NE * 1024), r0 = it % (NE * 1024), e = r0 >> 10, r = r0 & 1023;
    if (which < 2) {
        const int kb = r >> 6, nb = r & 63, n0 = 32 * nb;
        const float* W = (which == 0 ? p.w_eg : p.w_eu) + (size_t)(l * NE + e) * D * FF;
        const int rho = e * 4096 + (n0 >> 7) * 256 + which * 128 + (n0 & 127);
        c.src = W + (size_t)(64 * kb) * FF + n0; c.ldw = FF; c.dst = p.ws + WS_WGU + (size_t)l * 64 * MiB + (size_t)rho * D + 64 * kb; c.Kd = D;
    } else {
        const int kb = r >> 5, nb = r & 31, n0 = 32 * nb;
        const float* W = p.w_ed + (size_t)(l * NE + e) * FF * D;
        c.src = W + (size_t)(64 * kb) * D + n0; c.ldw = D; c.dst = p.ws + WS_WD + (size_t)l * 32 * MiB + (size_t)(e * 1024 + n0) * FF + 64 * kb; c.Kd = FF;
    }
    return c;
}
__device__ __forceinline__ void conv_load8(const ConvItem& c, int lane, f32x4 (&v)[8]) {
#pragma unroll
    for (int i = 0; i < 8; ++i) v[i] = *(const f32x4*)(c.src + (size_t)(8 * i + (lane >> 3)) * c.ldw + 4 * (lane & 7));
}
__device__ __forceinline__ void conv_store_f8(const ConvItem& c, int lane, const f32x4 (&v)[8], LAS float* scr, float scale) {
#pragma unroll
    for (int i = 0; i < 8; ++i) { LAS float* s = scr + (8 * i + (lane >> 3)) * 33 + 4 * (lane & 7); s[0] = v[i].x; s[1] = v[i].y; s[2] = v[i].z; s[3] = v[i].w; }
    asm volatile("s_waitcnt lgkmcnt(0)" ::: "memory");
    const int cch = lane & 7;
#pragma unroll
    for (int j = 0; j < 4; ++j) { const int n = (lane >> 3) + 8 * j; const LAS float* s = scr + (8 * cch) * 33 + n;
        const f32x4 a = {s[0 * 33] * scale, s[1 * 33] * scale, s[2 * 33] * scale, s[3 * 33] * scale}, b = {s[4 * 33] * scale, s[5 * 33] * scale, s[6 * 33] * scale, s[7 * 33] * scale};
        *(u32x2*)(c.dst + (size_t)n * c.Kd + 8 * cch) = pg8::pack8_fp8(a, b); }
    asm volatile("s_waitcnt lgkmcnt(0)" ::: "memory");
}
struct BgNone { __device__ __forceinline__ void step() {} };
struct BgConv {
    const float *eg, *eu, *ed; unsigned char* ws; LAS unsigned char* scr; int lane, it, stride, nit, l; bool have; ConvItem cur; f32x4 v[4];
    __device__ __forceinline__ ConvItem item(int i) const {
        ConvItem c; const int it_ = i;
        const int which = it_ / (NE * 2048), r0 = it_ % (NE * 2048), e = r0 >> 11, r = r0 & 2047;
        if (which < 2) { const int kb = r >> 6, nb = r & 63, n0 = 32 * nb; const float* W = (which == 0 ? eg : eu) + (size_t)(l * NE + e) * D * FF;
            const int rho = e * 4096 + (n0 >> 7) * 256 + which * 128 + (n0 & 127);
            c.src = W + (size_t)(32 * kb) * FF + n0; c.ldw = FF; c.dst = ws + WS_WGU + (size_t)l * 64 * MiB + (size_t)rho * D + 32 * kb; c.Kd = D; }
        else { const int kb = r >> 5, nb = r & 31, n0 = 32 * nb; const float* W = ed + (size_t)(l * NE + e) * FF * D;
            c.src = W + (size_t)(32 * kb) * D + n0; c.ldw = D; c.dst = ws + WS_WD + (size_t)l * 32 * MiB + (size_t)(e * 1024 + n0) * FF + 32 * kb; c.Kd = FF; }
        return c; }
    __device__ __forceinline__ void load(const ConvItem& c) {
#pragma unroll
        for (int i = 0; i < 4; ++i) v[i] = *(const GAS f32x4*)((const GAS float*)c.src + (size_t)(8 * i + (lane >> 3)) * c.ldw + 4 * (lane & 7));
    }
    __device__ __forceinline__ void init(const Params& p, int layer, LAS unsigned char* scr_, int lane_, int gw, int ngw) {
        eg = p.w_eg; eu = p.w_eu; ed = p.w_ed; ws = p.ws; l = layer; scr = scr_; lane = lane_; it = gw; stride = ngw; nit = 3 * NE * 2048; have = it < nit;
        if (have) { cur = item(it); load(cur); }
    }
    __device__ __forceinline__ void process(const ConvItem& c, const f32x4 (&w)[4]) {
        LAS unsigned* s32 = (LAS unsigned*)scr;
#pragma unroll
        for (int i = 0; i < 4; ++i) { int wd; asm volatile("" : "=v"(wd)); wd = __builtin_amdgcn_cvt_pk_fp8_f32(w[i].x * 64.0f, w[i].y * 64.0f, wd, false); wd = __builtin_amdgcn_cvt_pk_fp8_f32(w[i].z * 64.0f, w[i].w * 64.0f, wd, true);
            s32[(8 * i + (lane >> 3)) * 10 + (lane & 7)] = (unsigned)wd; }
        asm volatile("s_waitcnt lgkmcnt(0)" ::: "memory");
        typedef int v2i_ __attribute__((ext_vector_type(2)));
        const int gq = lane >> 4, i16 = lane & 15;
#pragma unroll
        for (int nh = 0; nh < 2; ++nh) {
            const v2i_ r = __builtin_amdgcn_ds_read_tr8_b64_v2i32((LAS v2i_*)(scr + (8 * gq + (i16 >> 1)) * 40 + 16 * nh + 8 * (i16 & 1)));
            u32x2 o; o.x = (unsigned)r.x; o.y = (unsigned)r.y;
            *(GAS u32x2*)((GAS unsigned char*)c.dst + (size_t)(16 * nh + i16) * c.Kd + 8 * gq) = o; }
        asm volatile("s_waitcnt lgkmcnt(0)" ::: "memory");
    }
    __device__ __forceinline__ void step() {
        if (!have) return;
        const ConvItem c = cur; f32x4 w[4];
#pragma unroll
        for (int i = 0; i < 4; ++i) w[i] = v[i];
        it += stride; have = it < nit;
        if (have) { cur = item(it); load(cur); }
        process(c, w);
    }
    __device__ __forceinline__ void finish() { while (have) step(); }
};
__device__ __forceinline__ void conv_experts_f8(Frame& F, const Params& p, int l, LAS float* scr) {
    const int gw = F.vcu * NWAVES + F.wave, NGW = F.G * NWAVES, NIT = 3 * NE * 1024;
    int it = gw; if (it >= NIT) return;
    ConvItem cur = conv_item_f8(p, l, it); f32x4 va[8], vb[8];
    conv_load8(cur, F.lane, va);
    for (;;) {
        const int it1 = it + NGW; const bool h1 = it1 < NIT; ConvItem c1 = conv_item_f8(p, l, h1 ? it1 : it);
        if (h1) conv_load8(c1, F.lane, vb);
        conv_store_f8(cur, F.lane, va, scr, 64.0f);
        if (!h1) break;
        const int it2 = it1 + NGW; const bool h2 = it2 < NIT; ConvItem c2 = conv_item_f8(p, l, h2 ? it2 : it1);
        if (h2) conv_load8(c2, F.lane, va);
        conv_store_f8(c1, F.lane, vb, scr, 64.0f);
        if (!h2) break;
        cur = c2; it = it2;
    }
}
__device__ __forceinline__ void conv_matrix(Frame& F, const float* W, int ldw, int K, int N, bf16_t* WT, LAS float* scr) {
    const int gw = F.vcu * NWAVES + F.wave, NGW = F.G * NWAVES, nblk = N / 32, nitems = (K / 64) * nblk;
    for (int it = gw; it < nitems; it += NGW) { const int kb = it / nblk, nb = it % nblk;
        tr_tile(W + (size_t)(64 * kb) * ldw + 32 * nb, ldw, WT + (size_t)(32 * nb) * K + 64 * kb, K, scr, F.lane); }
}
__device__ __forceinline__ void conv_matrix_f8(Frame& F, const float* W, int ldw, int K, int N, unsigned char* WT, LAS float* scr, float scale) {
    const int gw = F.vcu * NWAVES + F.wave, NGW = F.G * NWAVES, nblk = N / 32, nitems = (K / 64) * nblk;
    for (int it = gw; it < nitems; it += NGW) { const int kb = it / nblk, nb = it % nblk;
        ConvItem c; c.src = W + (size_t)(64 * kb) * ldw + 32 * nb; c.ldw = ldw; c.dst = WT + (size_t)(32 * nb) * K + 64 * kb; c.Kd = K;
        f32x4 v[8]; conv_load8(c, F.lane, v); conv_store_f8(c, F.lane, v, scr, scale); }
}
__device__ __forceinline__ void conv_experts(Frame& F, const Params& p, int l, LAS float* scr) {
    const int gw = F.vcu * NWAVES + F.wave, NGW = F.G * NWAVES;
    bf16_t* WGU = (bf16_t*)(p.ws + WS_WGU); bf16_t* WD = (bf16_t*)(p.ws + WS_WD);
    for (int it = gw; it < 3 * NE * 1024; it += NGW) {
        const int which = it / (NE * 1024), r0 = it % (NE * 1024), e = r0 >> 10, r = r0 & 1023;
        if (which < 2) {
            const int kb = r >> 6, nb = r & 63, n0 = 32 * nb;
            const float* W = (which == 0 ? p.w_eg : p.w_eu) + (size_t)(l * NE + e) * D * FF;
            const int rho = e * 4096 + (n0 >> 7) * 256 + which * 128 + (n0 & 127);
            tr_tile(W + (size_t)(64 * kb) * FF + n0, FF, WGU + (size_t)rho * D + 64 * kb, D, scr, F.lane);
        } else {
            const int kb = r >> 5, nb = r & 31, n0 = 32 * nb;
            const float* W = p.w_ed + (size_t)(l * NE + e) * FF * D;
            tr_tile(W + (size_t)(64 * kb) * D + n0, D, WD + (size_t)(e * 1024 + n0) * FF + 64 * kb, FF, scr, F.lane);
        }
    }
}
__device__ __forceinline__ void mod_units(Frame& F, const Params& p) {
    LAS float* sc = (LAS float*)(F.lds + 96 * 1024);
    LAS float* red = sc + 1024;
    float* MOD = (float*)(p.ws + WS_MOD); float* LBV = (float*)(p.ws + WS_LBV);
    for (int u = blockIdx.x; u < NL * 96; u += F.G) {
        for (int i = F.tid; i < D; i += 512) sc[i] = siluf_(p.c[i]);
        __syncthreads();
        const int l = u / 96, j = (u % 96) * 64 + (F.tid & 63), kp = F.tid >> 6;
        const float* w = p.ada_w + (size_t)l * D * 6 * D + (size_t)(kp * 128) * 6 * D + j;
        float acc = 0.f;
#pragma unroll 8
        for (int k = 0; k < 128; ++k) acc += sc[kp * 128 + k] * w[(size_t)k * 6 * D];
        red[kp * 64 + (F.tid & 63)] = acc;
        __syncthreads();
        if (F.tid < 64) { float s = 0.f;
#pragma unroll
            for (int q = 0; q < 8; ++q) s += red[q * 64 + F.tid];
            MOD[l * 6 * D + j] = s + p.ada_b[l * 6 * D + j]; }
        __syncthreads();
    }
    const int n = blockIdx.x * 512 + F.tid;
    if (n < NL * 1024) { const int l = n / 1024, r = n % 1024; float v = 0.f;
        if (l == 1) { const float b0 = p.hlb[r], b1 = p.hlb[1024 + r]; v = 1.0f / (1.0f + __expf(b0 - b1)); }
        LBV[n] = v; }
}

__device__ __forceinline__ f32x4 unpk4(const u32x2 q) { return f32x4{bflo(q.x), bfhi(q.x), bflo(q.y), bfhi(q.y)}; }
__device__ __forceinline__ void norm_mod_row(const f32x4 (&v)[4], float ss, const float* __restrict__ w, const float* __restrict__ scale,
                                             const float* __restrict__ shift, bf16_t* __restrict__ orow, int lane, f32x4 (&h)[4], unsigned char* __restrict__ orow8 = nullptr) {
    const float r = rsqrtf(ss * (1.0f / D) + EPS);
#pragma unroll
    for (int j = 0; j < 4; ++j) {
        const int c0 = 4 * lane + 256 * j;
        const f32x4 wv = *(const f32x4*)(w + c0), sv = *(const f32x4*)(scale + c0), bv = *(const f32x4*)(shift + c0);
        h[j] = (v[j] * r) * wv * (sv + 1.0f) + bv;
        u32x2 o; o.x = pk2(h[j].x, h[j].y); o.y = pk2(h[j].z, h[j].w);
        *(u32x2*)(orow + c0) = o;
        if (orow8) { int wd = 0; wd = __builtin_amdgcn_cvt_pk_fp8_f32(h[j].x, h[j].y, wd, false); wd = __builtin_amdgcn_cvt_pk_fp8_f32(h[j].z, h[j].w, wd, true); *(int*)(orow8 + c0) = wd; }
    }
}
__device__ __forceinline__ void norm_mod_row_f8(const f32x4 (&v)[4], float ss, const float* __restrict__ w, const float* __restrict__ scale,
                                                const float* __restrict__ shift, unsigned char* __restrict__ orow, int lane, f32x4 (&h)[4]) {
    const float r = rsqrtf(ss * (1.0f / D) + EPS);
#pragma unroll
    for (int j = 0; j < 4; ++j) {
        const int c0 = 4 * lane + 256 * j;
        const f32x4 wv = *(const f32x4*)(w + c0), sv = *(const f32x4*)(scale + c0), bv = *(const f32x4*)(shift + c0);
        h[j] = (v[j] * r) * wv * (sv + 1.0f) + bv;
        int wd = 0; wd = __builtin_amdgcn_cvt_pk_fp8_f32(h[j].x, h[j].y, wd, false); wd = __builtin_amdgcn_cvt_pk_fp8_f32(h[j].z, h[j].w, wd, true);
        *(int*)(orow + c0) = wd;
    }
}
__device__ __forceinline__ void ph_norm1(Frame& F, const float* x, const float* w, const float* scale, const float* shift, bf16_t* HB, unsigned char* HB8) {
    const int gw = F.vcu * NWAVES + F.wave, NGW = F.G * NWAVES;
    for (int row = gw; row < S; row += NGW) {
        const f32x4* xr = (const f32x4*)(x + (size_t)row * D) + F.lane;
        f32x4 v[4], h[4]; float ss = 0.f;
#pragma unroll
        for (int j = 0; j < 4; ++j) { v[j] = xr[64 * j]; ss += (v[j].x * v[j].x + v[j].y * v[j].y) + (v[j].z * v[j].z + v[j].w * v[j].w); }
        ss = wave_sum(ss);
        norm_mod_row(v, ss, w, scale, shift, HB + (size_t)row * D, F.lane, h);
    }
}
__device__ __forceinline__ void ph_gather(Frame& F, const unsigned char* HB8, const int* IDX, unsigned char* XE8) {
    const int gw = F.vcu * NWAVES + F.wave, NGW = F.G * NWAVES;
    constexpr int PER = NE * CAP / 2048;
    if (NGW * PER == NE * CAP) {
        const int r0 = gw * PER;
        const int mine = IDX[r0 + (F.lane & 15)];
#pragma unroll
        for (int q = 0; q < PER; q += 8) {
            u32x4 a[8];
#pragma unroll
            for (int k = 0; k < 8; ++k) { const int t = __builtin_amdgcn_readlane(mine, q + k); a[k] = ((const u32x4*)(HB8 + (size_t)t * D))[F.lane]; }
#pragma unroll
            for (int k = 0; k < 8; ++k) ((u32x4*)(XE8 + (size_t)(r0 + q + k) * D))[F.lane] = a[k];
        }
    } else {
        for (int r = gw; r < NE * CAP; r += NGW) { const int t = IDX[r]; ((u32x4*)(XE8 + (size_t)r * D))[F.lane] = ((const u32x4*)(HB8 + (size_t)t * D))[F.lane]; }
    }
}

#define OPAQUE_LANE() const int lane = lane_id_opaque(); const int t_ = F.wave * 64 + lane
__device__ __forceinline__ void ph_rope_table(Frame& F, float* ROPE) {
    OPAQUE_LANE();
    const int n = blockIdx.x * 512 + t_;
    if (n < 4096) { const int pos = n >> 4, i = n & 15; const float inv = exp2f(-(float)i * (13.287712379549449f / 16.0f)); float sn, cs; sincosf((float)pos * inv, &sn, &cs); ROPE[2 * n] = cs; ROPE[2 * n + 1] = sn; }
}
__device__ __forceinline__ void ph_qkprep(Frame& F, const bf16_t* __restrict__ QR, const bf16_t* __restrict__ KR, const float* __restrict__ qw, const float* __restrict__ kw,
                                          const float* __restrict__ ROPE, bf16_t* __restrict__ QN, bf16_t* __restrict__ KN, unsigned char* __restrict__ Q8, unsigned char* __restrict__ K8, int rank, int nranks) {
    OPAQUE_LANE(); (void)lane;
    if (rank < 0) return;
    for (int gid = rank * 512 + t_; gid < S * 10; gid += nranks * 512) {
        const int t = gid / 10, hh = gid % 10;
        const bool isq = hh < 8;
        const bf16_t* src = isq ? QR + (size_t)t * 512 + hh * 64 : KR + (size_t)t * 128 + (hh - 8) * 64;
        bf16_t* dst = isq ? QN + (size_t)t * 512 + hh * 64 : KN + (size_t)t * 128 + (hh - 8) * 64;
        const float* w = isq ? qw : kw;
        float f[64]; float ss = 0.f;
#pragma unroll
        for (int i = 0; i < 8; ++i) { const u32x4 q = *(const u32x4*)(src + 8 * i);
#pragma unroll
            for (int j = 0; j < 4; ++j) { f[8 * i + 2 * j] = bflo(q[j]); f[8 * i + 2 * j + 1] = bfhi(q[j]); } }
#pragma unroll
        for (int i = 0; i < 64; ++i) ss += f[i] * f[i];
        const float rn = rsqrtf(ss * (1.0f / 64.0f) + EPS), sc = isq ? C2 : 1.0f;
#pragma unroll
        for (int i = 0; i < 16; ++i) { const f32x4 wv = *(const f32x4*)(w + 4 * i);
            f[4 * i] *= rn * wv.x; f[4 * i + 1] *= rn * wv.y; f[4 * i + 2] *= rn * wv.z; f[4 * i + 3] *= rn * wv.w; }
        float o[64];
#pragma unroll
        for (int ax = 0; ax < 2; ++ax) {
            const float* tb = ROPE + (size_t)(ax == 0 ? (t >> 6) : (t & 63)) * 32;
#pragma unroll
            for (int i2 = 0; i2 < 8; ++i2) { const f32x4 cs = *(const f32x4*)(tb + 4 * i2);
#pragma unroll
                for (int k = 0; k < 2; ++k) { const int i = 2 * i2 + k; const float c_ = k ? cs.z : cs.x, s_ = k ? cs.w : cs.y;
                    const float x1 = f[ax * 32 + i], x2 = f[ax * 32 + 16 + i];
                    o[ax * 32 + i] = (x1 * c_ - x2 * s_) * sc; o[ax * 32 + 16 + i] = (x2 * c_ + x1 * s_) * sc; } }
        }
#if KEEP_BF16_QK
#pragma unroll
        for (int i = 0; i < 8; ++i) { u32x4 q;
#pragma unroll
            for (int j = 0; j < 4; ++j) q[j] = pk2(o[8 * i + 2 * j], o[8 * i + 2 * j + 1]);
            *(u32x4*)(dst + 8 * i) = q; }
#else
        (void)dst;
#endif
        unsigned char* dst8 = isq ? Q8 + (size_t)t * 512 + hh * 64 : K8 + (size_t)t * 128 + (hh - 8) * 64;
#pragma unroll
        for (int i = 0; i < 4; ++i) { u32x4 q;
#pragma unroll
            for (int j = 0; j < 4; ++j) { int wd = 0; wd = __builtin_amdgcn_cvt_pk_fp8_f32(o[16 * i + 4 * j], o[16 * i + 4 * j + 1], wd, false); wd = __builtin_amdgcn_cvt_pk_fp8_f32(o[16 * i + 4 * j + 2], o[16 * i + 4 * j + 3], wd, true); q[j] = (unsigned)wd; }
            *(u32x4*)(dst8 + 16 * i) = q; }
    }
}
__device__ __forceinline__ void ph_v8t(Frame& F, const bf16_t* __restrict__ VV, unsigned char* __restrict__ V8T) {
    OPAQUE_LANE();
    const int gw = F.vcu * NWAVES + F.wave, NGW = F.G * NWAVES;
    for (int it = gw; it < 2 * (S / 64); it += NGW) {
        const int kvh = it / (S / 64), tile = it % (S / 64);
        const bf16_t* src = VV + (size_t)(64 * tile) * 128 + kvh * 64 + lane;
        u32x4 ov[4];
#pragma unroll
        for (int hi = 0; hi < 2; ++hi)
#pragma unroll
            for (int k = 0; k < 8; ++k) {
                float v[4];
#pragma unroll
                for (int b = 0; b < 4; ++b) { const int j = 4 * k + b; const int key = j < 16 ? ((j & 3) + 8 * (j >> 2) + 4 * hi) : 32 + (((j - 16) & 3) + 8 * ((j - 16) >> 2) + 4 * hi); v[b] = bf2f(src[(size_t)key * 128]); }
                int wd = 0; wd = __builtin_amdgcn_cvt_pk_fp8_f32(v[0], v[1], wd, false); wd = __builtin_amdgcn_cvt_pk_fp8_f32(v[2], v[3], wd, true);
                ov[hi * 2 + (k >> 2)][k & 3] = (unsigned)wd;
            }
        unsigned char* dst = V8T + ((size_t)it * 64 + lane) * 64;
#pragma unroll
        for (int q = 0; q < 4; ++q) *(u32x4*)(dst + 16 * q) = ov[q];
    }
}
__device__ __forceinline__ void ph_hgfin(Frame& F, const float* __restrict__ OF, const bf16_t* __restrict__ HG, const float* __restrict__ w, bf16_t* __restrict__ OHG) {
    OPAQUE_LANE();
    const int gw = F.vcu * NWAVES + F.wave, NGW = F.G * NWAVES;
    const int e0 = (lane & 15) * 8;
    const f32x4 w0 = *(const f32x4*)(w + e0), w1 = *(const f32x4*)(w + e0 + 4);
    for (int t = gw; t < S; t += NGW) {
        const size_t off = (size_t)t * 512 + lane * 8;
        const f32x4 a0 = *(const f32x4*)(OF + off), a1 = *(const f32x4*)(OF + off + 4), b0 = *(const f32x4*)(OF + (size_t)S * 512 + off), b1 = *(const f32x4*)(OF + (size_t)S * 512 + off + 4);
        const f32x4 s0 = a0 + b0, s1 = a1 + b1;
        float ss = (s0.x * s0.x + s0.y * s0.y) + (s0.z * s0.z + s0.w * s0.w) + (s1.x * s1.x + s1.y * s1.y) + (s1.z * s1.z + s1.w * s1.w);
        ss += __shfl_xor(ss, 1); ss += __shfl_xor(ss, 2); ss += __shfl_xor(ss, 4); ss += __shfl_xor(ss, 8);
        const float r = rsqrtf(ss * (1.0f / 128.0f) + EPS);
        const u32x4 g = *(const u32x4*)(HG + off);
        u32x4 o;
        o.x = pk2(s0.x * r * w0.x * bflo(g.x), s0.y * r * w0.y * bfhi(g.x));
        o.y = pk2(s0.z * r * w0.z * bflo(g.y), s0.w * r * w0.w * bfhi(g.y));
        o.z = pk2(s1.x * r * w1.x * bflo(g.z), s1.y * r * w1.y * bfhi(g.z));
        o.w = pk2(s1.z * r * w1.z * bflo(g.w), s1.w * r * w1.w * bfhi(g.w));
        *(u32x4*)(OHG + off) = o;
    }
}
__device__ __forceinline__ void ph_norm2_router(Frame& F, const bf16_t* __restrict__ X1, const float* __restrict__ w, const float* __restrict__ scale, const float* __restrict__ shift,
                                                const float* __restrict__ wr, unsigned char* __restrict__ HB, float* __restrict__ AFF) {
    OPAQUE_LANE();
    LAS float* WT = (LAS float*)F.lds;
    for (int dd = t_; dd < D; dd += NWAVES * 64) {
        const GAS f32x4* s = (const GAS f32x4*)((const GAS float*)wr + (size_t)dd * 16);
        const f32x4 a = s[0], b = s[1], c = s[2], e = s[3];
        WT[0 * D + dd] = a.x; WT[1 * D + dd] = a.y; WT[2 * D + dd] = a.z; WT[3 * D + dd] = a.w; WT[4 * D + dd] = b.x; WT[5 * D + dd] = b.y; WT[6 * D + dd] = b.z; WT[7 * D + dd] = b.w;
        WT[8 * D + dd] = c.x; WT[9 * D + dd] = c.y; WT[10 * D + dd] = c.z; WT[11 * D + dd] = c.w; WT[12 * D + dd] = e.x; WT[13 * D + dd] = e.y; WT[14 * D + dd] = e.z; WT[15 * D + dd] = e.w;
    }
    __syncthreads();
    const int gw = F.vcu * NWAVES + F.wave, NGW = F.G * NWAVES;
    for (int row = gw; row < S; row += 2 * NGW) {
        const int row1 = (row + NGW < S) ? row + NGW : row;
        const u32x2* xr0 = (const u32x2*)(X1 + (size_t)row * D) + lane; const u32x2* xr1 = (const u32x2*)(X1 + (size_t)row1 * D) + lane;
        f32x4 v0[4], v1[4], h0[4], h1[4]; float ss0 = 0.f, ss1 = 0.f;
#pragma unroll
        for (int j = 0; j < 4; ++j) { v0[j] = unpk4(xr0[64 * j]); v1[j] = unpk4(xr1[64 * j]); }
#pragma unroll
        for (int j = 0; j < 4; ++j) { ss0 += (v0[j].x * v0[j].x + v0[j].y * v0[j].y) + (v0[j].z * v0[j].z + v0[j].w * v0[j].w); ss1 += (v1[j].x * v1[j].x + v1[j].y * v1[j].y) + (v1[j].z * v1[j].z + v1[j].w * v1[j].w); }
        ss0 = wave_sum(ss0); ss1 = wave_sum(ss1);
        norm_mod_row_f8(v0, ss0, w, scale, shift, HB + (size_t)row * D, lane, h0);
        norm_mod_row_f8(v1, ss1, w, scale, shift, HB + (size_t)row1 * D, lane, h1);
        LAS float* wt = WT + 4 * lane; asm volatile("" : "+v"(wt));
        f32x4 lg0[4], lg1[4];
#pragma unroll
        for (int e = 0; e < 16; ++e) {
            float a0 = 0.f, a1 = 0.f;
#pragma unroll
            for (int j = 0; j < 4; ++j) { const f32x4 ww = *(const LAS f32x4*)(wt + e * D + 256 * j);
                a0 += (h0[j].x * ww.x + h0[j].y * ww.y) + (h0[j].z * ww.z + h0[j].w * ww.w); a1 += (h1[j].x * ww.x + h1[j].y * ww.y) + (h1[j].z * ww.z + h1[j].w * ww.w); }
            lg0[e >> 2][e & 3] = wave_sum(a0); lg1[e >> 2][e & 3] = wave_sum(a1);
        }
#pragma unroll
        for (int rr = 0; rr < 2; ++rr) {
            f32x4 (&lgv)[4] = rr ? lg1 : lg0;
            float mx = -1e30f;
#pragma unroll
            for (int e4 = 0; e4 < 4; ++e4) mx = fmaxf(mx, fmaxf(fmaxf(lgv[e4].x, lgv[e4].y), fmaxf(lgv[e4].z, lgv[e4].w)));
            float den = 0.f;
#pragma unroll
            for (int e4 = 0; e4 < 4; ++e4) { lgv[e4].x = __expf(lgv[e4].x - mx); lgv[e4].y = __expf(lgv[e4].y - mx); lgv[e4].z = __expf(lgv[e4].z - mx); lgv[e4].w = __expf(lgv[e4].w - mx);
                den += (lgv[e4].x + lgv[e4].y) + (lgv[e4].z + lgv[e4].w); }
            const float inv = 1.0f / den;
            const f32x4 s8a = (lane & 8) ? lgv[2] : lgv[0], s8b = (lane & 8) ? lgv[3] : lgv[1];
            const f32x4 s4 = (lane & 4) ? s8b : s8a;
            const float s2a = (lane & 2) ? s4.z : s4.x, s2b = (lane & 2) ? s4.w : s4.y;
            const float mine = ((lane & 1) ? s2b : s2a) * inv;
            const int rw = rr ? row1 : row;
            if (lane < 16 && (rr == 0 || row1 != row)) AFF[(size_t)lane * S + rw] = mine;
        }
    }
    __syncthreads();
}
__device__ __forceinline__ unsigned block_excl_scan(unsigned v, LAS unsigned* wsum, int lane, int wave) {
    unsigned inc = v;
#pragma unroll
    for (int o = 1; o < 64; o <<= 1) { const unsigned t = __shfl_up(inc, o); if (lane >= o) inc += t; }
    if (lane == 63) wsum[wave] = inc;
    __syncthreads();
    unsigned base = 0u;
#pragma unroll
    for (int w = 0; w < NWAVES; ++w) { const unsigned s = wsum[w]; if (w < wave) base += s; }
    __syncthreads();
    return base + inc - v;
}
__device__ __forceinline__ void ph_topk(Frame& F, LAS unsigned char* lds, int e, const float* __restrict__ AFF, int* __restrict__ IDX, float* __restrict__ TOPW, int* __restrict__ SLOT) {
    LAS unsigned* hist = (LAS unsigned*)lds;
    LAS unsigned* hsum = hist + 4128;
    LAS unsigned* shv = hsum + 256;
    LAS unsigned* wsum = hsum + 264;
    LAS unsigned* stage = hsum + 512;
    OPAQUE_LANE(); const int tid = t_;
    const unsigned* vals = (const unsigned*)(AFF + (size_t)e * S);
#pragma unroll
    for (int j = 0; j < 32; ++j) { const int t = j * 512 + tid; stage[(t >> 5) * 33 + (t & 31)] = vals[t]; }
    if (tid == 0) { shv[0] = 0u; shv[1] = CAP; }
    LAS unsigned* myh = hist + (lane & 15) * 257;
    __syncthreads();
    unsigned u[32];
#pragma unroll
    for (int i = 0; i < 32; ++i) u[i] = stage[tid * 33 + i];
    for (int pass = 3; pass >= 0; --pass) {
        const int shift = pass * 8;
        const unsigned mask = pass == 3 ? 0u : (0xFFFFFFFFu << (shift + 8));
#pragma unroll
        for (int i = 0; i < 9; ++i) if (tid + 512 * i < 16 * 257) hist[tid + 512 * i] = 0u;
        __syncthreads();
        const unsigned prefix = shv[0];
#pragma unroll
        for (int i = 0; i < 32; ++i) if ((u[i] & mask) == (prefix & mask)) __hip_atomic_fetch_add(&myh[(u[i] >> shift) & 255u], 1u, __ATOMIC_RELAXED, __HIP_MEMORY_SCOPE_WORKGROUP);
        __syncthreads();
        if (tid < 256) { unsigned s = 0u;
#pragma unroll
            for (int c = 0; c < 16; ++c) s += hist[c * 257 + tid];
            hsum[tid] = s; }
        __syncthreads();
        if (tid < 64) {
            const unsigned kk = shv[1];
            const unsigned h0 = hsum[4 * lane], h1 = hsum[4 * lane + 1], h2 = hsum[4 * lane + 2], h3 = hsum[4 * lane + 3];
            const unsigned tot = (h0 + h1) + (h2 + h3);
            unsigned inc = tot;
#pragma unroll
            for (int o = 1; o < 64; o <<= 1) { const unsigned v = __shfl_down(inc, o); if (lane + o < 64) inc += v; }
            unsigned c = inc - tot; int bin = -1; unsigned rem = 0u;
            if (c < kk && c + h3 >= kk) { bin = 4 * lane + 3; rem = kk - c; } c += h3;
            if (c < kk && c + h2 >= kk) { bin = 4 * lane + 2; rem = kk - c; } c += h2;
            if (c < kk && c + h1 >= kk) { bin = 4 * lane + 1; rem = kk - c; } c += h1;
            if (c < kk && c + h0 >= kk) { bin = 4 * lane; rem = kk - c; }
            if (bin >= 0) { shv[1] = rem; shv[0] = prefix | ((unsigned)bin << shift); }
        }
        __syncthreads();
    }
    const unsigned T = shv[0], need_eq = shv[1];
    unsigned ceq = 0u;
#pragma unroll
    for (int i = 0; i < 32; ++i) ceq += (u[i] == T) ? 1u : 0u;
    unsigned eq_rank = block_excl_scan(ceq, wsum, lane, F.wave);
    unsigned selmask = 0u, csel = 0u;
#pragma unroll
    for (int i = 0; i < 32; ++i) { bool sel = u[i] > T; if (u[i] == T) { sel = eq_rank < need_eq; ++eq_rank; } if (sel) { selmask |= 1u << i; ++csel; } }
    unsigned slot = block_excl_scan(csel, wsum, lane, F.wave);
#pragma unroll
    for (int i = 0; i < 32; ++i) {
        const int t = tid * 32 + i; int sl = -1;
        if (selmask & (1u << i)) { sl = (int)slot; ++slot; if (sl < CAP) { IDX[e * CAP + sl] = t; TOPW[e * CAP + sl] = __uint_as_float(u[i]); } }
        stage[tid * 33 + i] = (unsigned)(sl < CAP ? sl : -1);
    }
    __syncthreads();
#pragma unroll
    for (int j = 0; j < 32; ++j) { const int t = j * 512 + tid; SLOT[(size_t)e * S + t] = (int)stage[(t >> 5) * 33 + (t & 31)]; }
    __syncthreads();
}
__device__ __forceinline__ void ph_combine(Frame& F, const bf16_t* __restrict__ X1, const bf16_t* __restrict__ YE, const int* __restrict__ SLOT, const float* __restrict__ gate,
                                           void* __restrict__ xout_, const float* __restrict__ w, const float* __restrict__ scale, const float* __restrict__ shift, bf16_t* __restrict__ HB, unsigned char* __restrict__ HB8, bool do_norm) {
    OPAQUE_LANE();
    const int gw = F.vcu * NWAVES + F.wave, NGW = F.G * NWAVES;
    for (int row = gw; row < S; row += 2 * NGW) {
        const bool two = row + NGW < S; const int row1 = two ? row + NGW : row;
        const int sl0 = lane < NE ? SLOT[(size_t)lane * S + row] : -1, sl1 = lane < NE ? SLOT[(size_t)lane * S + row1] : -1;
        const u32x2* xr0 = (const u32x2*)(X1 + (size_t)row * D) + lane; const u32x2* xr1 = (const u32x2*)(X1 + (size_t)row1 * D) + lane;
        f32x4 v0[4], v1[4];
#pragma unroll
        for (int j = 0; j < 4; ++j) { v0[j] = unpk4(xr0[64 * j]); v1[j] = unpk4(xr1[64 * j]); }
        f32x4 acc0[4], acc1[4];
#pragma unroll
        for (int j = 0; j < 4; ++j) { acc0[j] = f32x4{0.f, 0.f, 0.f, 0.f}; acc1[j] = acc0[j]; }
        unsigned m0 = (unsigned)__ballot(sl0 >= 0) & 0xffffu, m1 = (unsigned)__ballot(sl1 >= 0) & 0xffffu;
        while (m0 | m1) {
            const int e0 = m0 ? __builtin_ctz(m0) : 0, e1 = m1 ? __builtin_ctz(m1) : 0;
            const float f0 = m0 ? 1.f : 0.f, f1 = m1 ? 1.f : 0.f;
            const int s0 = m0 ? __builtin_amdgcn_readlane(sl0, e0) : 0, s1 = m1 ? __builtin_amdgcn_readlane(sl1, e1) : 0;
            m0 &= m0 - 1u; m1 &= m1 - 1u;
            const bf16_t* y0 = YE + ((size_t)e0 * CAP + s0) * D + 4 * lane; const bf16_t* y1 = YE + ((size_t)e1 * CAP + s1) * D + 4 * lane;
            u32x2 q0[4], q1[4];
#pragma unroll
            for (int j = 0; j < 4; ++j) { q0[j] = *(const u32x2*)(y0 + 256 * j); q1[j] = *(const u32x2*)(y1 + 256 * j); }
#pragma unroll
            for (int j = 0; j < 4; ++j) { acc0[j].x += f0 * bflo(q0[j].x); acc0[j].y += f0 * bfhi(q0[j].x); acc0[j].z += f0 * bflo(q0[j].y); acc0[j].w += f0 * bfhi(q0[j].y);
                                          acc1[j].x += f1 * bflo(q1[j].x); acc1[j].y += f1 * bfhi(q1[j].x); acc1[j].z += f1 * bflo(q1[j].y); acc1[j].w += f1 * bfhi(q1[j].y); }
        }
        f32x4 h[4]; float ss0 = 0.f, ss1 = 0.f;
#pragma unroll
        for (int j = 0; j < 4; ++j) { const f32x4 gv = *(const f32x4*)(gate + 4 * lane + 256 * j); v0[j] = v0[j] + gv * acc0[j]; v1[j] = v1[j] + gv * acc1[j];
            if (do_norm) { u32x2 o0, o1; o0.x = pk2(v0[j].x, v0[j].y); o0.y = pk2(v0[j].z, v0[j].w); o1.x = pk2(v1[j].x, v1[j].y); o1.y = pk2(v1[j].z, v1[j].w);
                ((u32x2*)((bf16_t*)xout_ + (size_t)row * D) + lane)[64 * j] = o0; if (two) ((u32x2*)((bf16_t*)xout_ + (size_t)row1 * D) + lane)[64 * j] = o1; }
            else { ((f32x4*)((float*)xout_ + (size_t)row * D) + lane)[64 * j] = v0[j]; if (two) ((f32x4*)((float*)xout_ + (size_t)row1 * D) + lane)[64 * j] = v1[j]; }
            ss0 += (v0[j].x * v0[j].x + v0[j].y * v0[j].y) + (v0[j].z * v0[j].z + v0[j].w * v0[j].w); ss1 += (v1[j].x * v1[j].x + v1[j].y * v1[j].y) + (v1[j].z * v1[j].z + v1[j].w * v1[j].w); }
        if (do_norm) { ss0 = wave_sum(ss0); ss1 = wave_sum(ss1); norm_mod_row(v0, ss0, w, scale, shift, HB + (size_t)row * D, lane, h); if (two) norm_mod_row(v1, ss1, w, scale, shift, HB + (size_t)row1 * D, lane, h); }
    }
}

__global__ void __launch_bounds__(NWAVES * 64, 2) mega(Params p) {
    extern __shared__ __attribute__((aligned(16))) unsigned char lds[];
    Frame F;
    F.lds = (LAS unsigned char*)lds;
    volatile LAS unsigned* MISC = (volatile LAS unsigned*)(F.lds + MISC_OFF);
    F.tid = threadIdx.x; F.lane = F.tid & 63; F.wave = __builtin_amdgcn_readfirstlane(F.tid >> 6);
    F.G = gridDim.x; { const int bx = blockIdx.x; F.vcu = (F.G % 8 == 0) ? (bx % 8) * (F.G / 8) + bx / 8 : bx; }
    unsigned char* ws = p.ws;
    unsigned* ctl = (unsigned*)(ws + WS_CTL);
    for (int u = F.tid; u < (LDS_BYTES - LDSCTL_OFF) / 4; u += NWAVES * 64) ((LAS unsigned*)(F.lds + LDSCTL_OFF))[u] = 0u;
    __syncthreads();
    XcdBarrier bar = xcd_barrier_post(ctl + CW_BAR + p.li * XCD_BAR_WORDS, MISC + 8);
    const int lo = p.ph_lo, hi = p.ph_hi;
#define IN(k) (lo <= (k) && (k) < hi)
#define SEAM(k) do { if (IN(k) && IN((k) + 1)) xcd_barrier(bar); } while (0)
#define REFRESH() do { F.lane = lane_id_opaque(); F.tid = F.wave * 64 + F.lane; } while (0)

#define WSP(T, off) ((T*)(GAS T*)(wsl + (off)))
#define WSL() GAS unsigned char* wsl = (GAS unsigned char*)p.ws; asm volatile("" : "+s"(wsl))
    LAS float* scr = (LAS float*)(F.lds + RING_OFF + F.wave * 8704);

    if (IN(PH_PRO)) { REFRESH(); WSL();
        mod_units(F, p);
        for (int l = 0; l < NL; ++l) {
            conv_matrix(F, p.w_in + (size_t)l * D * INW, INW, D, INW, WSP(bf16_t, WS_WIN) + (size_t)l * INW * D, scr);
            conv_matrix(F, p.w_ba + (size_t)l * 512 * D, D, 512, D, WSP(bf16_t, WS_WBA) + (size_t)l * D * 512, scr);
            conv_matrix(F, p.w_bh + (size_t)l * 512 * D, D, 512, D, WSP(bf16_t, WS_WBH) + (size_t)l * D * 512, scr);
            conv_matrix(F, p.w_out + (size_t)l * D * D, D, D, D, WSP(bf16_t, WS_WOUT) + (size_t)l * D * D, scr);
        }
        ph_rope_table(F, WSP(float, WS_ROPE));
    }
    SEAM(PH_PRO);
    if (IN(PH_NORM1)) { REFRESH(); WSL(); ph_norm1(F, p.x, p.norm_mix_w, WSP(float, WS_MOD) + 1 * D, WSP(float, WS_MOD) + 0 * D, WSP(bf16_t, WS_HB), WSP(unsigned char, WS_HBF8)); }
    SEAM(PH_NORM1);

    for (int l = 0; l < NL; ++l) {
        const int pb = PH_L0 + l * NPL;
        if (IN(pb + P_G1)) { WSL();
            pg8::Gemm g{WSP(bf16_t, WS_HB), WSP(bf16_t, WS_WIN) + (size_t)l * INW * D, S, 3072, D}; pg8::StaticOrder So; So.init(S, 3072, F.G, (int)blockIdx.x);
            pg8::EpiInproj E{WSP(bf16_t, WS_QR), WSP(bf16_t, WS_KR), WSP(bf16_t, WS_VV), WSP(bf16_t, WS_HQ), WSP(bf16_t, WS_KF), WSP(bf16_t, WS_HV), WSP(bf16_t, WS_HG), WSP(bf16_t, WS_GG), WSP(float, WS_LF), WSP(float, WS_LBV) + l * 1024, 1.0f};
            for (int rep_ = 0; rep_ < REP_G; ++rep_) pg8::gemm_phase<pg8::EpiInproj, pg8::StaticOrder, true, true>(F.lds + RING_OFF, g, So, E, F.wave);
        }
        SEAM(pb + P_G1);
        if (IN(pb + P_QKP)) { WSL();
            {
              pg8::Gemm g{WSP(bf16_t, WS_HB), WSP(bf16_t, WS_WIN) + (size_t)l * INW * D + (size_t)3072 * D, S, 2304, D}; pg8::OffOrder So; So.So.init(S, 2304, F.G, (int)blockIdx.x); So.off = 12;
              pg8::EpiInproj E{WSP(bf16_t, WS_QR), WSP(bf16_t, WS_KR), WSP(bf16_t, WS_VV), WSP(bf16_t, WS_HQ), WSP(bf16_t, WS_KF), WSP(bf16_t, WS_HV), WSP(bf16_t, WS_HG), WSP(bf16_t, WS_GG), WSP(float, WS_LF), WSP(float, WS_LBV) + l * 1024, 1.0f};
              for (int rep_ = 0; rep_ < REP_G; ++rep_) pg8::gemm_phase<pg8::EpiInproj, pg8::OffOrder, true, true>(F.lds + RING_OFF, g, So, E, F.wave); }
            { const bool even = (F.G == 256); const int rk = even ? (int)blockIdx.x - 64 : (int)blockIdx.x, nr = even ? 192 : F.G;
              for (int rep_ = 0; rep_ < REP_QK; ++rep_) ph_qkprep(F, WSP(bf16_t, WS_QR), WSP(bf16_t, WS_KR), p.q_norm_w + l * 64, p.k_norm_w + l * 64, WSP(float, WS_ROPE), WSP(bf16_t, WS_QN), WSP(bf16_t, WS_KN), WSP(unsigned char, WS_Q8), WSP(unsigned char, WS_K8), rk, nr);
              ph_v8t(F, WSP(bf16_t, WS_VV), WSP(unsigned char, WS_V8T)); }
            for (int rep_ = 0; rep_ < REP_HG; ++rep_) for (int u = blockIdx.x; u < 256; u += F.G) hg::segment<false>(F.lds, u, WSP(bf16_t, WS_HQ), WSP(float, WS_LF), WSP(bf16_t, WS_KF), WSP(bf16_t, WS_HV), WSP(float, WS_HST), WSP(float, WS_HST + 16 * MiB), nullptr, F.wave);
        }
        SEAM(pb + P_QKP);
        if (IN(pb + P_HGB)) { WSL(); OPAQUE_LANE(); (void)lane;
            for (int gid = blockIdx.x * 512 + t_; gid < 8 * 16384; gid += F.G * 512) hg::carry(WSP(float, WS_HST), WSP(float, WS_HST + 16 * MiB), gid);
        }
        SEAM(pb + P_HGB);
        if (IN(pb + P_HGC)) { WSL();
            for (int rep_ = 0; rep_ < REP_HG; ++rep_) for (int u = blockIdx.x; u < 256; u += F.G) hg::segment<true>(F.lds, u, WSP(bf16_t, WS_HQ), WSP(float, WS_LF), WSP(bf16_t, WS_KF), WSP(bf16_t, WS_HV), WSP(float, WS_HST), WSP(float, WS_HST + 16 * MiB), WSP(float, WS_OF), F.wave);
        }
        SEAM(pb + P_HGC);
        if (IN(pb + P_ATT)) { WSL();
            for (int rep_ = 0; rep_ < REP_QK; ++rep_) ph_hgfin(F, WSP(float, WS_OF), WSP(bf16_t, WS_HG), p.hg_norm_w + l * 128, WSP(bf16_t, WS_OHG));
            float negM;
            { const int ln = lane_id_opaque(); float mq = fabsf(p.q_norm_w[l * 64 + ln]), mk = fabsf(p.k_norm_w[l * 64 + ln]);
#pragma unroll
              for (int o_ = 1; o_ < 64; o_ <<= 1) { mq = fmaxf(mq, __shfl_xor(mq, o_)); mk = fmaxf(mk, __shfl_xor(mk, o_)); }
              negM = -(64.0f * C2) * mq * mk * 1.05f; }
            const attn8::Tensors AT{WSP(unsigned char, WS_Q8), WSP(unsigned char, WS_K8), WSP(unsigned char, WS_V8T), (attn8::bf16*)WSP(bf16_t, WS_OATT)};
            { BgConv bg; bg.init(p, l, F.lds + attn8::LDS_BYTES + F.wave * 1280, lane_id_opaque(), F.vcu * NWAVES + F.wave, F.G * NWAVES);
              attn8::phase((char*)lds + RING_OFF, AT, (int)F.G, (int)blockIdx.x, F.wave, negM + 8.0f, bg); bg.finish(); }
        }
        SEAM(pb + P_ATT);
        if (IN(pb + P_G2)) { WSL();
            pg8::Gemm g{WSP(bf16_t, WS_OATT), WSP(bf16_t, WS_WBA) + (size_t)l * D * 512, S, D, 512, WSP(bf16_t, WS_OHG), WSP(bf16_t, WS_WBH) + (size_t)l * D * 512};
            pg8::ChainOrder So; So.So.init(S, D, F.G, (int)blockIdx.x);
            pg8::EpiMerge E{WSP(bf16_t, WS_GG), WSP(bf16_t, WS_MG)};
            for (int rep_ = 0; rep_ < REP_G; ++rep_) pg8::gemm_phase<pg8::EpiMerge, pg8::ChainOrder, false, true>(F.lds + RING_OFF, g, So, E, F.wave);
        }
        SEAM(pb + P_G2);
        if (IN(pb + P_G3)) { WSL();
            pg8::Gemm g{WSP(bf16_t, WS_MG), WSP(bf16_t, WS_WOUT) + (size_t)l * D * D, S, D, D}; pg8::StaticOrder So; So.init(S, D, F.G, (int)blockIdx.x);
            pg8::EpiOut E{l == 0 ? (const void*)p.x : (const void*)WSP(bf16_t, WS_X2), WSP(float, WS_MOD) + l * 6 * D + 2 * D, WSP(bf16_t, WS_X1), l == 0 ? 0 : 1};
            for (int rep_ = 0; rep_ < REP_G; ++rep_) pg8::gemm_phase<pg8::EpiOut, pg8::StaticOrder, false, true>(F.lds + RING_OFF, g, So, E, F.wave);
        }
        SEAM(pb + P_G3);
        if (IN(pb + P_N2R)) { WSL();
            for (int rep_ = 0; rep_ < REP_ROW; ++rep_) ph_norm2_router(F, WSP(bf16_t, WS_X1), p.norm_ffn_w + l * D, WSP(float, WS_MOD) + l * 6 * D + 4 * D, WSP(float, WS_MOD) + l * 6 * D + 3 * D, p.w_router + (size_t)l * D * NE, WSP(unsigned char, WS_HB8), WSP(float, WS_AFF));
        }
        SEAM(pb + P_N2R);
        if (IN(pb + P_TOPK)) { WSL();
            for (int rep_ = 0; rep_ < REP_TK; ++rep_) for (int e = blockIdx.x; e < NE; e += F.G) ph_topk(F, F.lds, e, WSP(float, WS_AFF), WSP(int, WS_IDX), WSP(float, WS_TOPW), WSP(int, WS_SLOT));
        }
        SEAM(pb + P_TOPK);
        if (IN(pb + P_G4)) { WSL();
            pg8::Gemm g{(const bf16_t*)WSP(unsigned char, WS_HB8), (const bf16_t*)(WSP(unsigned char, WS_WGU) + (size_t)l * 64 * MiB), NE * CAP, NE * 4096, D / 2, nullptr, nullptr, WSP(int, WS_IDX)}; pg8::GroupOrder So; So.init(16, F.G, (int)blockIdx.x);
            pg8::EpiGU8 E{WSP(unsigned char, WS_HID8)};
            for (int rep_ = 0; rep_ < REP_G; ++rep_) pg8::gemm_phase<pg8::EpiGU8, pg8::GroupOrder, true, true, true, true>(F.lds + RING_OFF, g, So, E, F.wave);
        }
        SEAM(pb + P_G4);
        if (IN(pb + P_G5)) { WSL();
            pg8::Gemm g{(const bf16_t*)WSP(unsigned char, WS_HID8), (const bf16_t*)(WSP(unsigned char, WS_WD) + (size_t)l * 32 * MiB), NE * CAP, NE * 1024, FF / 2}; pg8::GroupOrder So; So.init(4, F.G, (int)blockIdx.x);
            pg8::EpiDown E{WSP(bf16_t, WS_YE), WSP(float, WS_TOPW), 0.015625f};
            for (int rep_ = 0; rep_ < REP_G; ++rep_) pg8::gemm_phase<pg8::EpiDown, pg8::GroupOrder, true, true, true>(F.lds + RING_OFF, g, So, E, F.wave);
        }
        SEAM(pb + P_G5);
        if (IN(pb + P_COMB)) { WSL();
            const bool last = (l + 1 == NL); const int ln = last ? l : l + 1;
            for (int rep_ = 0; rep_ < REP_ROW; ++rep_) ph_combine(F, WSP(bf16_t, WS_X1), WSP(bf16_t, WS_YE), WSP(int, WS_SLOT), WSP(float, WS_MOD) + l * 6 * D + 5 * D, last ? (void*)p.out : (void*)WSP(bf16_t, WS_X2),
                       p.norm_mix_w + ln * D, WSP(float, WS_MOD) + ln * 6 * D + 1 * D, WSP(float, WS_MOD) + ln * 6 * D + 0 * D, WSP(bf16_t, WS_HB), WSP(unsigned char, WS_HBF8), !last);
        }
        SEAM(pb + P_COMB);
    }
#undef IN
#undef SEAM
}

#ifndef N_LAUNCH_MODE
#define N_LAUNCH_MODE 1
#endif
static int g_grid = 0;
extern "C" void kernel_launch(void* const* d_in, const int* in_sizes, int n_in, void* d_out, int out_size, void* d_ws, size_t ws_size, hipStream_t stream) {
    if (n_in != 18 || out_size != S * D || ws_size < WS_END) { fprintf(stderr, "kernel_launch: unexpected shapes (n_in %d out %d ws %zu)\n", n_in, out_size, ws_size); return; }
    if (g_grid == 0) {
        int dev = 0, cus = 0;
        if (hipGetDevice(&dev) != hipSuccess || hipDeviceGetAttribute(&cus, hipDeviceAttributeMultiprocessorCount, dev) != hipSuccess) { g_grid = -1; return; }
        if (hipFuncSetAttribute((const void*)mega, hipFuncAttributeMaxDynamicSharedMemorySize, LDS_BYTES) != hipSuccess) { g_grid = -1; return; }
        int per_cu = 0;
        if (hipOccupancyMaxActiveBlocksPerMultiprocessor(&per_cu, (const void*)mega, NWAVES * 64, LDS_BYTES) != hipSuccess || per_cu < 1) { fprintf(stderr, "occupancy query: %d\n", per_cu); }
        (void)hipGetLastError();
        g_grid = cus;
    }
    if (g_grid < 0) return;
    unsigned char* ws = (unsigned char*)d_ws;
    (void)hipMemsetAsync(ws + WS_CTL, 0, 1 * MiB, stream);
    Params p{};
    p.x = (const float*)d_in[0]; p.c = (const float*)d_in[1]; p.ada_w = (const float*)d_in[2]; p.ada_b = (const float*)d_in[3]; p.norm_mix_w = (const float*)d_in[4];
    p.norm_ffn_w = (const float*)d_in[5]; p.w_in = (const float*)d_in[6]; p.q_norm_w = (const float*)d_in[7]; p.k_norm_w = (const float*)d_in[8]; p.hlb = (const float*)d_in[9];
    p.hg_norm_w = (const float*)d_in[10]; p.w_ba = (const float*)d_in[11]; p.w_bh = (const float*)d_in[12]; p.w_out = (const float*)d_in[13]; p.w_router = (const float*)d_in[14];
    p.w_eg = (const float*)d_in[15]; p.w_eu = (const float*)d_in[16]; p.w_ed = (const float*)d_in[17];
    p.out = (float*)d_out; p.ws = ws;
#if defined(DBG_ATT)
    { const int cut = PH_L0 + P_ATT + 1;
      p.ph_lo = 0; p.ph_hi = cut; p.li = 0; p.pad = 0; hipLaunchKernelGGL(mega, dim3(g_grid), dim3(NWAVES * 64), LDS_BYTES, stream, p);
      hipMemcpyAsync(ws + 900 * MiB, ws + WS_OATT, 16 * MiB, hipMemcpyDeviceToDevice, stream);
      k_attn_naive<<<dim3(S / 64, 8), dim3(64), 0, stream>>>((const bf16_t*)(ws + WS_QN), (const bf16_t*)(ws + WS_KN), (const bf16_t*)(ws + WS_VV), (bf16_t*)(ws + WS_OATT));
      k_cmp_bf16<<<dim3(2048), dim3(256), 0, stream>>>((const bf16_t*)(ws + 900 * MiB), (const bf16_t*)(ws + WS_OATT), (size_t)8 * MiB, 512, 0, 512, (float*)(ws + 512 * 1024));
      p.ph_lo = cut; p.ph_hi = PH_END; p.li = 1; hipLaunchKernelGGL(mega, dim3(g_grid), dim3(NWAVES * 64), LDS_BYTES, stream, p);
      k_scale_out<<<dim3(2048), dim3(256), 0, stream>>>((float*)d_out, (size_t)S * D, (const float*)(ws + 512 * 1024)); }
#elif N_LAUNCH_MODE == 1
    p.ph_lo = 0; p.ph_hi = PH_END; p.li = 0; p.pad = 0;
    hipLaunchKernelGGL(mega, dim3(g_grid), dim3(NWAVES * 64), LDS_BYTES, stream, p);
#else
    for (int k = 0; k < PH_END; ++k) { p.ph_lo = k; p.ph_hi = k + 1; p.li = k; p.pad = 0; hipLaunchKernelGGL(mega, dim3(g_grid), dim3(NWAVES * 64), LDS_BYTES, stream, p); }
#endif
}
```
